# Optimizing an MI355X kernel written in HIP

```python
import math
import jax, jax.numpy as jnp
from jax import lax
import numpy as np

D_MODEL = 1024
BATCH = 4
SEQ = 8192
DEPTH = 2

GRID_W = 64
CTX_LEN = 256
N_BRANCH = 4
BRANCH_WIDTH = 256
POOL_WIDTH = 256
POOL_GROUPS = 4
POOL_GROUP_DIM = POOL_WIDTH // POOL_GROUPS
POOL_WINDOWS = (2, 4, 8, 16)
NA_HEADS = 4
NA_HEAD_DIM = 64
NA_WIDTH = NA_HEADS * NA_HEAD_DIM
NA_ROWS = 8
NA_COLS = 16
DIFF_HEADS = 4
DIFF_HEAD_DIM = 32
DIFF_QK_WIDTH = DIFF_HEADS * 2 * DIFF_HEAD_DIM
DIFF_V_WIDTH = DIFF_HEADS * 2 * DIFF_HEAD_DIM
MLA_HEADS = 4
MLA_NOPE_DIM = 64
MLA_ROPE_DIM = 32
MLA_V_DIM = 64
MLA_Q_RANK = 256
MLA_KV_RANK = 128
FFN_HIDDEN = 2816
N_ADA = 9
ROPE_BASE = 10000.0
Q_BLOCK = 128
NORM_EPS = 1e-6
NEG_INF = -1e30
MIX_SPLITS = (POOL_WIDTH, NA_WIDTH, NA_WIDTH, NA_WIDTH, DIFF_QK_WIDTH, DIFF_QK_WIDTH, DIFF_V_WIDTH, MLA_Q_RANK, MLA_KV_RANK, MLA_ROPE_DIM, N_BRANCH * D_MODEL)
MIX_IN_WIDTH = sum(MIX_SPLITS)

kernel_name = 'hybrid_pool_na_diff_mla_dit_block'


def rmsnorm(x, g):
    xf = x.astype(jnp.float32)
    y = xf * lax.rsqrt(jnp.mean(xf * xf, axis=-1, keepdims=True) + NORM_EPS)
    return (y * g.astype(jnp.float32)).astype(x.dtype)


def modulate(xn, shift, scale):
    return xn * (1 + scale) + shift


def swiglu(x, w_in, w_out):
    a, b = jnp.split(x @ w_in, 2, axis=-1)
    return (jax.nn.silu(a) * b) @ w_out


def split_heads(t, h):
    b, n, _ = t.shape
    return t.reshape(b, n, h, -1).transpose(0, 2, 1, 3)


def merge_heads(t):
    b, h, n, d = t.shape
    return t.transpose(0, 2, 1, 3).reshape(b, n, h * d)


def split_mix(proj):
    points, acc = [], 0
    for w in MIX_SPLITS[:-1]:
        acc += w
        points.append(acc)
    return jnp.split(proj, points, axis=-1)


def rope_tables(n, rot_dim):
    t = jnp.arange(n, dtype=jnp.int32)
    pos = jnp.stack([t // GRID_W, t % GRID_W], axis=0).astype(jnp.float32)
    half = rot_dim // 2
    inv = ROPE_BASE ** (-jnp.arange(0, half, 2, dtype=jnp.float32) / half)
    ang = pos[:, :, None] * inv
    return jnp.cos(ang), jnp.sin(ang)


def apply_axial_rope(x, cos, sin):
    half = x.shape[-1] // 2
    quarter = half // 2
    outs = []
    for a in range(2):
        xa = x[..., a * half:(a + 1) * half].astype(jnp.float32)
        x1, x2 = xa[..., :quarter], xa[..., quarter:]
        outs.append(x1 * cos[a] - x2 * sin[a])
        outs.append(x1 * sin[a] + x2 * cos[a])
    return jnp.concatenate(outs, axis=-1).astype(x.dtype)


def sweep_query_blocks(fn, q, axis):
    n = q.shape[axis]
    nb = n // Q_BLOCK
    qb = q.reshape(q.shape[:axis] + (nb, Q_BLOCK) + q.shape[axis + 1:])
    qb = jnp.moveaxis(qb, axis, 0)
    out = lax.map(fn, qb)
    out = jnp.moveaxis(out, 0, 2)
    return out.reshape(out.shape[:2] + (n, out.shape[-1]))


def softmax_attend(q, k, v, scale):
    s = jnp.einsum('bhqd,bhkd->bhqk', q, k).astype(jnp.float32) * scale
    p = jax.nn.softmax(s, axis=-1).astype(v.dtype)
    return jnp.einsum('bhqk,bhkd->bhqd', p, v)


def centred_mean_minus_self(u, w):
    n = u.shape[1]
    cs = jnp.cumsum(u.astype(jnp.float32), axis=1)
    cs = jnp.pad(cs, ((0, 0), (1, 0), (0, 0)))
    i = jnp.arange(n)
    lo = jnp.clip(i - w // 2, 0, n)
    hi = jnp.clip(i - w // 2 + w, 0, n)
    cnt = (hi - lo).astype(jnp.float32)
    mean = (cs[:, hi] - cs[:, lo]) / cnt[None, :, None]
    return mean.astype(u.dtype) - u


def pool_mixer(u, w_grp, scale):
    b, n, _ = u.shape
    ug = u.reshape(b, n, POOL_GROUPS, POOL_GROUP_DIM)
    pooled = jnp.stack([centred_mean_minus_self(ug[:, :, g], w) for g, w in enumerate(POOL_WINDOWS)], axis=2)
    y = jnp.einsum('bngc,gce->bnge', pooled, w_grp).reshape(b, n, POOL_WIDTH)
    return y * scale


def neighbourhood_attention(q, k, v, kc, vc, rpb):
    b, h, n, dh = q.shape
    rows = n // GRID_W
    kr = min(NA_ROWS, rows)
    scale = dh ** -0.5
    r = jnp.arange(rows)
    key_rows = jnp.clip(r - kr // 2, 0, rows - kr)[:, None] + jnp.arange(kr)[None, :]
    j = jnp.arange(GRID_W)
    col_start = jnp.clip(j - NA_COLS // 2, 0, GRID_W - NA_COLS)
    col_ok = (j[None, :] >= col_start[:, None]) & (j[None, :] < col_start[:, None] + NA_COLS)
    dr = key_rows - r[:, None]
    dc = jnp.clip(j[None, :] - j[:, None] + NA_COLS - 1, 0, 2 * NA_COLS - 2)
    bias = jnp.take(rpb[:, dr + NA_ROWS - 1], dc, axis=-1).astype(jnp.float32)
    bias = jnp.where(col_ok, bias, NEG_INF).transpose(0, 1, 3, 2, 4)
    qg = q.reshape(b, h, rows, GRID_W, dh)
    kg = k.reshape(b, h, rows, GRID_W, dh)[:, :, key_rows]
    vg = v.reshape(b, h, rows, GRID_W, dh)[:, :, key_rows]
    s_loc = jnp.einsum('bhrqd,bhrikd->bhrqik', qg, kg).astype(jnp.float32) * scale + bias[None]
    s_ctx = jnp.einsum('bhrqd,bhld->bhrql', qg, kc).astype(jnp.float32) * scale
    n_loc = kr * GRID_W
    s = jnp.concatenate([s_loc.reshape(b, h, rows, GRID_W, n_loc), s_ctx], axis=-1)
    p = jax.nn.softmax(s, axis=-1).astype(v.dtype)
    p_loc = p[..., :n_loc].reshape(b, h, rows, GRID_W, kr, GRID_W)
    out = jnp.einsum('bhrqik,bhrikd->bhrqd', p_loc, vg) + jnp.einsum('bhrql,bhld->bhrqd', p[..., n_loc:], vc)
    return out.reshape(b, h, n, dh)


def diff_heads(t):
    b, n, _ = t.shape
    return t.reshape(b, n, DIFF_HEADS, 2, DIFF_HEAD_DIM).transpose(0, 2, 3, 1, 4)


def diff_attend(q, k, v, lam):
    s = jnp.einsum('bhcqd,bhckd->bhcqk', q, k).astype(jnp.float32) * DIFF_HEAD_DIM ** -0.5
    p = jax.nn.softmax(s, axis=-1)
    w = (p[:, :, 0] - lam * p[:, :, 1]).astype(v.dtype)
    return jnp.einsum('bhqk,bhke->bhqe', w, v)


def mla_project(qa, kva, kr, lp, rope):
    q = split_heads(rmsnorm(qa, lp['mla_q_norm_g']) @ lp['mla_w_qb'], MLA_HEADS)
    kv = split_heads(rmsnorm(kva, lp['mla_kv_norm_g']) @ lp['mla_w_kvb'], MLA_HEADS)
    q_nope, q_rope = q[..., :MLA_NOPE_DIM], q[..., MLA_NOPE_DIM:]
    k_nope, v = kv[..., :MLA_NOPE_DIM], kv[..., MLA_NOPE_DIM:]
    kr = kr[:, None]
    if rope is not None:
        q_rope = apply_axial_rope(q_rope, *rope)
        kr = apply_axial_rope(kr, *rope)
    q = jnp.concatenate([q_nope, q_rope], axis=-1)
    k = jnp.concatenate([k_nope, jnp.broadcast_to(kr, k_nope.shape[:-1] + (MLA_ROPE_DIM,))], axis=-1)
    return q, k, v


def merge_branches(ys, gate, w_branch, w_out):
    b, n, _ = gate.shape
    g = jax.nn.sigmoid(gate).reshape(b, n, N_BRANCH, D_MODEL)
    merged = g[:, :, 0] * (ys[0] @ w_branch[0])
    for i in range(1, N_BRANCH):
        merged = merged + g[:, :, i] * (ys[i] @ w_branch[i])
    return merged @ w_out


def token_mixing(u, uc, lp, lam_init, rope_diff, rope_mla, ctx_out):
    (a_pool, a_nq, a_nk, a_nv, a_dq, a_dk, a_dv, a_mq, a_mkv, a_mkr, a_gate) = split_mix(u @ lp['mix_w_in'])
    (c_pool, c_nq, c_nk, c_nv, c_dq, c_dk, c_dv, c_mq, c_mkv, c_mkr, c_gate) = split_mix(uc @ lp['mix_w_in'])
    y_pool = pool_mixer(a_pool, lp['pool_w'], lp['pool_scale'])
    nk_c, nv_c = split_heads(c_nk, NA_HEADS), split_heads(c_nv, NA_HEADS)
    y_na = merge_heads(neighbourhood_attention(split_heads(a_nq, NA_HEADS), split_heads(a_nk, NA_HEADS), split_heads(a_nv, NA_HEADS), nk_c, nv_c, lp['na_rpb']))
    dl = lp['diff_lambda'].astype(jnp.float32)
    lam = jnp.exp(jnp.sum(dl[0] * dl[1])) - jnp.exp(jnp.sum(dl[2] * dl[3])) + lam_init
    dq = apply_axial_rope(diff_heads(a_dq), *rope_diff)
    dk = apply_axial_rope(diff_heads(a_dk), *rope_diff)
    dv = split_heads(a_dv, DIFF_HEADS)
    dq_c, dk_c, dv_c = diff_heads(c_dq), diff_heads(c_dk), split_heads(c_dv, DIFF_HEADS)
    dk_all = jnp.concatenate([dk, dk_c], axis=3)
    dv_all = jnp.concatenate([dv, dv_c], axis=2)
    d_out = sweep_query_blocks(lambda qb: diff_attend(qb, dk_all, dv_all, lam), dq, axis=3)
    def diff_post(o):
        return merge_heads(rmsnorm(o, lp['diff_subln_g']) * (1.0 - lam_init))
    y_diff = diff_post(d_out)
    mla_scale = (MLA_NOPE_DIM + MLA_ROPE_DIM) ** -0.5
    mq, mk, mv = mla_project(a_mq, a_mkv, a_mkr, lp, rope_mla)
    mq_c, mk_c, mv_c = mla_project(c_mq, c_mkv, c_mkr, lp, None)
    mk_all = jnp.concatenate([mk, mk_c], axis=2)
    mv_all = jnp.concatenate([mv, mv_c], axis=2)
    y_mla = merge_heads(sweep_query_blocks(lambda qb: softmax_attend(qb, mk_all, mv_all, mla_scale), mq, axis=2))
    y = merge_branches([y_pool, y_na, y_diff, y_mla], a_gate, lp['branch_w_out'], lp['mix_w_out'])
    if not ctx_out:
        return y, None
    yc_pool = pool_mixer(c_pool, lp['pool_w'], lp['pool_scale'])
    yc_na = merge_heads(softmax_attend(split_heads(c_nq, NA_HEADS), nk_c, nv_c, NA_HEAD_DIM ** -0.5))
    yc_diff = diff_post(diff_attend(dq_c, dk_c, dv_c, lam))
    yc_mla = merge_heads(softmax_attend(mq_c, mk_c, mv_c, mla_scale))
    yc = merge_branches([yc_pool, yc_na, yc_diff, yc_mla], c_gate, lp['branch_w_out'], lp['mix_w_out'])
    return y, yc


def trunk_layer(h, hc, ada_lat, ada_ctx, lp, lam_init, rope_diff, rope_mla, ctx_out):
    m = jnp.split(ada_lat[:, None, :], N_ADA, axis=-1)
    mc = jnp.split(ada_ctx[None, :], N_ADA, axis=-1)

    def ffn_update(t, mod, sub, ffn_idx):
        tn = modulate(rmsnorm(t, lp['norm_g'][sub]), mod[3 * sub], mod[3 * sub + 1])
        return t + 0.5 * mod[3 * sub + 2] * swiglu(tn, lp['ffn_w_in'][ffn_idx], lp['ffn_w_out'][ffn_idx])

    h = ffn_update(h, m, 0, 0)
    hc = ffn_update(hc, mc, 0, 0)
    u = modulate(rmsnorm(h, lp['norm_g'][1]), m[3], m[4])
    uc = modulate(rmsnorm(hc, lp['norm_g'][1]), mc[3], mc[4])
    y, yc = token_mixing(u, uc, lp, lam_init, rope_diff, rope_mla, ctx_out)
    h = h + m[5] * y
    h = ffn_update(h, m, 2, 1)
    if ctx_out:
        hc = hc + mc[5] * yc
        hc = ffn_update(hc, mc, 2, 1)
    return h, hc


def setup_inputs(seed: int = 0) -> dict:
    key = jax.random.key(seed)
    ks = jax.random.split(key, 22)
    f32 = jnp.float32

    def dense(k, shape, fan_in, gain=1.0):
        return (gain * fan_in ** -0.5) * jax.random.normal(k, shape, f32)

    def gains(k, shape):
        return 1.0 + 0.05 * jax.random.normal(k, shape, f32)

    return {
        'x': jax.random.normal(ks[0], (BATCH, SEQ, D_MODEL), f32),
        'c': jax.random.normal(ks[1], (BATCH, D_MODEL), f32),
        'ctx': jax.random.normal(ks[2], (BATCH, CTX_LEN, D_MODEL), f32),
        'c_ctx': jax.random.normal(ks[3], (D_MODEL,), f32),
        'ada_w': dense(ks[4], (DEPTH, D_MODEL, N_ADA * D_MODEL), D_MODEL, 0.5),
        'ada_b': 0.02 * jax.random.normal(ks[5], (DEPTH, N_ADA * D_MODEL), f32),
        'norm_g': gains(ks[6], (DEPTH, 3, D_MODEL)),
        'ffn_w_in': dense(ks[7], (DEPTH, 2, D_MODEL, 2 * FFN_HIDDEN), D_MODEL),
        'ffn_w_out': dense(ks[8], (DEPTH, 2, FFN_HIDDEN, D_MODEL), FFN_HIDDEN),
        'mix_w_in': dense(ks[9], (DEPTH, D_MODEL, MIX_IN_WIDTH), D_MODEL),
        'pool_w': dense(ks[10], (DEPTH, POOL_GROUPS, POOL_GROUP_DIM, POOL_GROUP_DIM), POOL_GROUP_DIM),
        'pool_scale': gains(ks[11], (DEPTH, POOL_WIDTH)),
        'na_rpb': 0.5 * jax.random.normal(ks[12], (DEPTH, NA_HEADS, 2 * NA_ROWS - 1, 2 * NA_COLS - 1), f32),
        'diff_lambda': 0.1 * jax.random.normal(ks[13], (DEPTH, 4, DIFF_HEAD_DIM), f32),
        'diff_subln_g': gains(ks[14], (DEPTH, 2 * DIFF_HEAD_DIM)),
        'mla_q_norm_g': gains(ks[15], (DEPTH, MLA_Q_RANK)),
        'mla_kv_norm_g': gains(ks[16], (DEPTH, MLA_KV_RANK)),
        'mla_w_qb': dense(ks[17], (DEPTH, MLA_Q_RANK, MLA_HEADS * (MLA_NOPE_DIM + MLA_ROPE_DIM)), MLA_Q_RANK),
        'mla_w_kvb': dense(ks[18], (DEPTH, MLA_KV_RANK, MLA_HEADS * (MLA_NOPE_DIM + MLA_V_DIM)), MLA_KV_RANK),
        'branch_w_out': dense(ks[19], (DEPTH, N_BRANCH, BRANCH_WIDTH, D_MODEL), BRANCH_WIDTH),
        'mix_w_out': dense(ks[20], (DEPTH, D_MODEL, D_MODEL), D_MODEL),
        'final_norm_g': gains(ks[21], (D_MODEL,)),
    }


def reference(x, c, ctx, c_ctx, ada_w, ada_b, norm_g, ffn_w_in, ffn_w_out, mix_w_in, pool_w, pool_scale, na_rpb, diff_lambda, diff_subln_g, mla_q_norm_g, mla_kv_norm_g, mla_w_qb, mla_w_kvb, branch_w_out, mix_w_out, final_norm_g):
    n = x.shape[1]
    rope_diff = rope_tables(n, DIFF_HEAD_DIM)
    rope_mla = rope_tables(n, MLA_ROPE_DIM)
    sc = jax.nn.silu(c)
    scc = jax.nn.silu(c_ctx)
    h, hc = x, ctx
    for l in range(DEPTH):
        lp = {
            'norm_g': norm_g[l], 'ffn_w_in': ffn_w_in[l], 'ffn_w_out': ffn_w_out[l],
            'mix_w_in': mix_w_in[l], 'pool_w': pool_w[l], 'pool_scale': pool_scale[l],
            'na_rpb': na_rpb[l], 'diff_lambda': diff_lambda[l], 'diff_subln_g': diff_subln_g[l],
            'mla_q_norm_g': mla_q_norm_g[l], 'mla_kv_norm_g': mla_kv_norm_g[l],
            'mla_w_qb': mla_w_qb[l], 'mla_w_kvb': mla_w_kvb[l],
            'branch_w_out': branch_w_out[l], 'mix_w_out': mix_w_out[l],
        }
        ada_lat = sc @ ada_w[l] + ada_b[l]
        ada_ctx = scc @ ada_w[l] + ada_b[l]
        lam_init = 0.8 - 0.6 * math.exp(-0.3 * l)
        h, hc = trunk_layer(h, hc, ada_lat, ada_ctx, lp, lam_init, rope_diff, rope_mla, l < DEPTH - 1)
    return rmsnorm(h, final_norm_g)
```

```cpp
#include <hip/hip_runtime.h>
#include <hip/hip_cooperative_groups.h>
#include <cstdio>
namespace cg = cooperative_groups;

#define LAS __attribute__((address_space(3)))
typedef unsigned short bf16_t;
typedef short bf16x8 __attribute__((ext_vector_type(8)));
typedef short s16x4 __attribute__((ext_vector_type(4)));
typedef float f32x4 __attribute__((ext_vector_type(4)));
typedef float f32x16 __attribute__((ext_vector_type(16)));
typedef unsigned u32x4 __attribute__((ext_vector_type(4)));
typedef unsigned u32x2 __attribute__((ext_vector_type(2)));

#ifndef N_LAUNCH_MODE
#define N_LAUNCH_MODE 1
#endif

constexpr int RL = 32768, RA = 33792, FH = 2816;
constexpr int PJW = 2304;
constexpr int C_NQ = 256, C_NK = 512, C_NV = 768, C_DQ = 1024, C_DK = 1280, C_DV = 1536, C_MQ = 1792, C_MKV = 2048, C_MKR = 2176;
constexpr float LOG2E = 1.4426950408889634f;
constexpr float NEPS = 1e-6f;

constexpr size_t SZ_W1 = 2ull * 5632 * 1024 * 2, SZ_W2 = 2ull * 1024 * 2816 * 2, SZ_WM = 6400ull * 1024 * 2, SZ_WL = 1024ull * 384 * 2, SZ_WB = 4ull * 1024 * 256 * 2, SZ_WO = 1024ull * 1024 * 2;
constexpr size_t OFF_W1 = 0, OFF_W2 = OFF_W1 + SZ_W1, OFF_WM = OFF_W2 + SZ_W2, OFF_WL = OFF_WM + SZ_WM, OFF_WB = OFF_WL + SZ_WL, OFF_WO = OFF_WB + SZ_WB;
constexpr size_t OFF_HC = OFF_WO + SZ_WO;
constexpr size_t OFF_MOD = OFF_HC + 1024ull * 1024 * 4;
constexpr size_t OFF_ROPE = OFF_MOD + 2ull * 5 * 9216 * 4;
constexpr size_t OFF_RSTD = OFF_ROPE + 128 * 8 * 8;
constexpr size_t OFF_A = OFF_RSTD + (size_t)RA * 2 * 4;
constexpr size_t OFF_B = OFF_A + (size_t)RA * 1024 * 2;
constexpr size_t OFF_C = OFF_B + (size_t)RA * PJW * 2;
constexpr size_t OFF_D = OFF_C + (size_t)RA * 4096;
constexpr size_t OFF_MK = OFF_D + (size_t)RA * 384 * 2, OFF_MV = OFF_MK + (size_t)RA * 384 * 2;
constexpr size_t WS_END = OFF_D + (size_t)RA * 1024 * 2;

struct Params {
    const float *x, *c, *ctx, *c_ctx, *ada_w, *ada_b, *norm_g, *ffn_w_in, *ffn_w_out, *mix_w_in, *pool_w, *pool_scale, *na_rpb, *diff_lambda, *diff_subln_g,
        *mla_q_norm_g, *mla_kv_norm_g, *mla_w_qb, *mla_w_kvb, *branch_w_out, *mix_w_out, *final_norm_g;
    float* out; unsigned char* ws;
    int ph_lo, ph_hi;
};

typedef const __attribute__((address_space(4))) Params* PK;

__device__ __forceinline__ unsigned cvt_pk_bf16(float lo, float hi) { unsigned r; asm volatile("v_cvt_pk_bf16_f32 %0, %1, %2" : "=v"(r) : "v"(lo), "v"(hi)); return r; }
__device__ __forceinline__ float bf_lo(unsigned u) { return __uint_as_float(u << 16); }
__device__ __forceinline__ float bf_hi(unsigned u) { return __uint_as_float(u & 0xffff0000u); }
__device__ __forceinline__ float fast_exp2(float x) { return __builtin_amdgcn_exp2f(x); }
__device__ __forceinline__ float fast_rcp(float x) { return __builtin_amdgcn_rcpf(x); }
__device__ __forceinline__ float sigmoidf_(float x) { return fast_rcp(1.0f + fast_exp2(-x * LOG2E)); }
__device__ __forceinline__ float shflx(float v, int m) {
    int lane = __builtin_amdgcn_mbcnt_hi(~0u, __builtin_amdgcn_mbcnt_lo(~0u, 0)); asm volatile("" : "+v"(lane));
    return __int_as_float(__builtin_amdgcn_ds_bpermute((lane ^ m) << 2, __float_as_int(v)));
}
__device__ __forceinline__ float wave_sum(float v) {
    v += shflx(v, 32); v += shflx(v, 16); v += shflx(v, 8); v += shflx(v, 4); v += shflx(v, 2); v += shflx(v, 1); return v;
}
__device__ __forceinline__ int opaque_tid() { int t = threadIdx.x; asm volatile("" : "+v"(t)); return t; }
__device__ __forceinline__ int opaque_bid() { int t = blockIdx.x; asm volatile("" : "+s"(t)); return t; }
__device__ __forceinline__ int opaque_gdim() { int t = gridDim.x; asm volatile("" : "+s"(t)); return t; }
__device__ __forceinline__ int clampi(int v, int lo, int hi) { return v < lo ? lo : (v > hi ? hi : v); }

namespace pg8 {
constexpr int BM = 256, BK = 64, HALF = 128, HTB = HALF * BK * 2, STAGE_BYTES = 8 * HTB, NXCD = 8, WGM = 8;
__device__ __forceinline__ int lds_byte(int r, int c) { const int st = (r >> 4) * 2 + (c >> 5), rr = r & 15, cc = c & 31, ob = rr * 64 + cc * 2; return st * 1024 + (ob ^ (((ob >> 9) & 1) << 5)); }
__device__ __forceinline__ void stage_rc(int b, int& R, int& C) { const int st = b / 1024, sb = b % 1024, swz = sb ^ (((sb >> 9) & 1) << 5); R = (st >> 1) * 16 + swz / 64; C = (st & 1) * 32 + (swz % 64) / 2; }
__device__ __forceinline__ int perm32(int rho) { const int n = rho >> 4, i = rho & 15; return 8 * (i >> 2) + 4 * n + (i & 3); }
struct Unit { int pm, pn; };
struct Gemm { const bf16_t* A; const bf16_t* Bt; int M, N, K, lda, ldb; };
struct StaticOrder {
    int nM, nN, nwg, G, c;
    __device__ void init(int M, int N, int G_, int c_) { nM = M / BM; nN = N / BM; nwg = nM * nN; G = G_; c = c_; }
    __device__ bool next(int i, Unit& u) const {
        const long L = (long)i * G + c; if (L >= nwg) return false;
        int wgid = (int)L; { const int q = nwg / NXCD, r = nwg % NXCD, xcd = wgid % NXCD, off = wgid / NXCD; wgid = (xcd < r ? xcd * (q + 1) : r * (q + 1) + (xcd - r) * q) + off; }
        const int nig = WGM * nN, gid = wgid / nig, fm = gid * WGM, gsz = (nM - fm) < WGM ? (nM - fm) : WGM;
        u.pm = fm + ((wgid % nig) % gsz); u.pn = (wgid % nig) / gsz; return true;
    }
};

template <class Epi>
__device__ __forceinline__ void gemm_phase(LAS unsigned char* lds, const Gemm g, const StaticOrder& S, const Epi& E) {
    const int tid = opaque_tid(), wid = __builtin_amdgcn_readfirstlane(tid >> 6), lane = tid & 63, wr = wid >> 2, wc = wid & 3, fr = lane & 15, fq = lane >> 4;
    const int K = g.K, nt = K / BK;
    unsigned voffA[2], voffB[2];
#pragma unroll
    for (int i = 0; i < 2; ++i) { int R, C; stage_rc(tid * 16 + i * 8192, R, C); const int Rb = Epi::PERM ? ((R & ~31) + perm32(R & 31)) : R;
        voffA[i] = (unsigned)(R * g.lda + C) * 2u; voffB[i] = (unsigned)(Rb * g.ldb + C) * 2u; }
    const size_t kstep = (size_t)(BK * 2);
    const size_t hstepA = (size_t)HALF * g.lda * 2, hstepB = (size_t)HALF * g.ldb * 2;
    const size_t tstepA = 2 * hstepA, tstepB = 2 * hstepB;
    const unsigned ldsw = (unsigned)wid * 1024u;
    const int aoff = lds_byte(wr * 64 + fr, fq * 8), boff = lds_byte(wc * 32 + fr, fq * 8);
#define PG8_SA(b, h) (((b) * 2 + (h)) * HTB)
#define PG8_SB(b, h) ((4 + (b) * 2 + (h)) * HTB)
#define PG8_STAGE(bufoff, gbase, voff) do { _Pragma("unroll") for (int _i = 0; _i < 2; ++_i) \
        __builtin_amdgcn_global_load_lds((const unsigned*)((const char*)(gbase) + (voff)[_i]), (LAS unsigned*)(lds + (bufoff) + ldsw + _i * 8192), 16, 0, 0); } while (0)
#define PG8_LDA(dst, b, h) do { _Pragma("unroll") for (int m = 0; m < 4; ++m) _Pragma("unroll") for (int k = 0; k < 2; ++k) dst[m][k] = *(const LAS bf16x8*)(lds + PG8_SA(b, h) + aoff + m * 2048 + k * 1024); } while (0)
#define PG8_LDB(dst, b, h) do { _Pragma("unroll") for (int n = 0; n < 2; ++n) _Pragma("unroll") for (int k = 0; k < 2; ++k) dst[n][k] = *(const LAS bf16x8*)(lds + PG8_SB(b, h) + boff + n * 2048 + k * 1024); } while (0)
#define PG8_MMA(ai, bj, At, Bt) do { __builtin_amdgcn_s_setprio(1); _Pragma("unroll") for (int m = 0; m < 4; ++m) _Pragma("unroll") for (int n = 0; n < 2; ++n) _Pragma("unroll") for (int k = 0; k < 2; ++k) \
        acc[ai][bj][m][n] = __builtin_amdgcn_mfma_f32_16x16x32_bf16(Bt[n][k], At[m][k], acc[ai][bj][m][n], 0, 0, 0); __builtin_amdgcn_s_setprio(0); } while (0)
#define PG8_WAIT_V(n) asm volatile("s_waitcnt vmcnt(" #n ")" ::: "memory")
#define PG8_WAIT_L(n) asm volatile("s_waitcnt lgkmcnt(" #n ")" ::: "memory")
#define PG8_BAR __builtin_amdgcn_s_barrier()
#define PG8_SCHED __builtin_amdgcn_sched_barrier(0)
    Unit cur, nxt; int ui = 0;
    if (!S.next(0, cur)) return;
    f32x4 acc[2][2][4][2];
#pragma unroll
    for (int a = 0; a < 2; ++a)
#pragma unroll
        for (int b = 0; b < 2; ++b)
#pragma unroll
            for (int m = 0; m < 4; ++m)
#pragma unroll
                for (int n = 0; n < 2; ++n) acc[a][b][m][n] = (f32x4){0.f, 0.f, 0.f, 0.f};
    bf16x8 At[4][2], B0[2][2], B1[2][2];
    const char* cA = (const char*)g.A + (size_t)cur.pm * tstepA; const char* cB = (const char*)g.Bt + (size_t)cur.pn * tstepB;
    PG8_STAGE(PG8_SB(0, 0), cB, voffB); PG8_STAGE(PG8_SA(0, 0), cA, voffA); PG8_STAGE(PG8_SB(0, 1), cB + hstepB, voffB); PG8_STAGE(PG8_SA(0, 1), cA + hstepA, voffA);
    if (wr == 1) PG8_BAR;
    PG8_WAIT_V(4); PG8_BAR;
    PG8_STAGE(PG8_SB(1, 0), cB + kstep, voffB); PG8_STAGE(PG8_SA(1, 0), cA + kstep, voffA); PG8_STAGE(PG8_SB(1, 1), cB + hstepB + kstep, voffB);
    PG8_WAIT_V(6); PG8_BAR;
    for (;;) {
        const bool has_next = S.next(ui + 1, nxt);
        const char* nA = has_next ? (const char*)g.A + (size_t)nxt.pm * tstepA : cA; const char* nB = has_next ? (const char*)g.Bt + (size_t)nxt.pn * tstepB : cB;
        for (int t = 0; t < nt; t += 2) {
            const bool last = (t == nt - 2);
            const char* a1 = cA + (size_t)(t + 1) * kstep;
            const char* a2 = last ? nA : cA + (size_t)(t + 2) * kstep; const char* b2 = last ? nB : cB + (size_t)(t + 2) * kstep;
            const char* a3 = a2 + kstep; const char* b3 = b2 + kstep;
            PG8_LDB(B0, 0, 0); PG8_SCHED; PG8_LDA(At, 0, 0); PG8_STAGE(PG8_SA(1, 1), a1 + hstepA, voffA);
            PG8_WAIT_L(8); PG8_BAR; PG8_WAIT_L(0); PG8_MMA(0, 0, At, B0); PG8_BAR; PG8_SCHED;
            PG8_LDB(B1, 0, 1); PG8_STAGE(PG8_SB(0, 0), b2, voffB);
            PG8_BAR; PG8_WAIT_L(0); PG8_MMA(0, 1, At, B1); PG8_BAR;
            PG8_LDA(At, 0, 1); PG8_STAGE(PG8_SA(0, 0), a2, voffA);
            PG8_BAR; PG8_WAIT_L(0); PG8_MMA(1, 0, At, B0); PG8_BAR; PG8_SCHED;
            PG8_STAGE(PG8_SB(0, 1), b2 + hstepB, voffB);
            PG8_WAIT_V(6); PG8_BAR; PG8_MMA(1, 1, At, B1); PG8_BAR;
            PG8_LDB(B0, 1, 0); PG8_SCHED; PG8_LDA(At, 1, 0); PG8_STAGE(PG8_SA(0, 1), a2 + hstepA, voffA);
            PG8_WAIT_L(8); PG8_BAR; PG8_WAIT_L(0); PG8_MMA(0, 0, At, B0); PG8_BAR; PG8_SCHED;
            PG8_LDB(B1, 1, 1); PG8_STAGE(PG8_SB(1, 0), b3, voffB);
            PG8_BAR; PG8_WAIT_L(0); PG8_MMA(0, 1, At, B1); PG8_BAR;
            PG8_LDA(At, 1, 1); PG8_STAGE(PG8_SA(1, 0), a3, voffA);
            PG8_BAR; PG8_WAIT_L(0); PG8_MMA(1, 0, At, B0); PG8_BAR; PG8_SCHED;
            PG8_STAGE(PG8_SB(1, 1), b3 + hstepB, voffB);
            PG8_WAIT_V(6); PG8_BAR; PG8_MMA(1, 1, At, B1); PG8_BAR;
        }
        E(acc, cur, wr, wc, fr, fq);
        if (!has_next) break;
#pragma unroll
        for (int a = 0; a < 2; ++a)
#pragma unroll
            for (int b = 0; b < 2; ++b)
#pragma unroll
                for (int m = 0; m < 4; ++m)
#pragma unroll
                    for (int n = 0; n < 2; ++n) acc[a][b][m][n] = (f32x4){0.f, 0.f, 0.f, 0.f};
        cur = nxt; cA = nA; cB = nB; ++ui;
    }
    PG8_WAIT_V(0);
    if (wr == 0) PG8_BAR;
    PG8_BAR;
#undef PG8_SA
#undef PG8_SB
#undef PG8_STAGE
#undef PG8_LDA
#undef PG8_LDB
#undef PG8_MMA
#undef PG8_WAIT_V
#undef PG8_WAIT_L
#undef PG8_BAR
#undef PG8_SCHED
}
}
using pg8::Unit;

struct EpiSwiglu {
    static constexpr bool PERM = true;
    bf16_t* HID;
    __device__ __forceinline__ void operator()(const f32x4 (&acc)[2][2][4][2], const Unit& u, int wr, int wc, int fr, int fq) const {
        const int row0 = u.pm * 256 + wr * 64 + fr, col0 = u.pn * 128 + wc * 32 + 8 * fq;
#pragma unroll
        for (int ai = 0; ai < 2; ++ai)
#pragma unroll
            for (int m = 0; m < 4; ++m) {
                const int row = row0 + ai * 128 + m * 16;
                float hv[8];
#pragma unroll
                for (int n = 0; n < 2; ++n)
#pragma unroll
                    for (int j = 0; j < 4; ++j) { const float a = acc[ai][0][m][n][j], b = acc[ai][1][m][n][j]; hv[4 * n + j] = a * sigmoidf_(a) * b; }
                u32x4 w; w.x = cvt_pk_bf16(hv[0], hv[1]); w.y = cvt_pk_bf16(hv[2], hv[3]); w.z = cvt_pk_bf16(hv[4], hv[5]); w.w = cvt_pk_bf16(hv[6], hv[7]);
                *(u32x4*)(HID + (size_t)row * FH + col0) = w;
            }
    }
};
struct EpiResid {
    static constexpr bool PERM = false;
    float* Hl; float* Hc; const float* gate; float coef;
    __device__ __forceinline__ void operator()(const f32x4 (&acc)[2][2][4][2], const Unit& u, int wr, int wc, int fr, int fq) const {
        const int row0 = u.pm * 256 + wr * 64 + fr, col0 = u.pn * 256 + wc * 32 + 4 * fq;
#pragma unroll
        for (int ai = 0; ai < 2; ++ai)
#pragma unroll
            for (int m = 0; m < 4; ++m) {
                const int row = row0 + ai * 128 + m * 16;
                float* hp = row < RL ? Hl + (size_t)row * 1024 : Hc + (size_t)(row - RL) * 1024;
                const float* gp = gate + (row < RL ? (row >> 13) : 4) * 9216;
#pragma unroll
                for (int bj = 0; bj < 2; ++bj)
#pragma unroll
                    for (int n = 0; n < 2; ++n) {
                        const int c = col0 + bj * 128 + n * 16;
                        const f32x4 g4 = *(const f32x4*)(gp + c); f32x4 h4 = *(const f32x4*)(hp + c);
                        h4 += (g4 * coef) * acc[ai][bj][m][n];
                        *(f32x4*)(hp + c) = h4;
                    }
            }
    }
};
struct EpiPJ {
    static constexpr bool PERM = true;
    bf16_t* PJ; unsigned char* G8;
    __device__ __forceinline__ void operator()(const f32x4 (&acc)[2][2][4][2], const Unit& u, int wr, int wc, int fr, int fq) const {
        const int row0 = u.pm * 256 + wr * 64 + fr, c0 = wc * 32 + 8 * fq;
        if (u.pn < 9) {
#pragma unroll
            for (int ai = 0; ai < 2; ++ai)
#pragma unroll
                for (int m = 0; m < 4; ++m) {
                    const int row = row0 + ai * 128 + m * 16;
#pragma unroll
                    for (int bj = 0; bj < 2; ++bj) {
                        const f32x4 v0 = acc[ai][bj][m][0], v1 = acc[ai][bj][m][1];
                        u32x4 w; w.x = cvt_pk_bf16(v0[0], v0[1]); w.y = cvt_pk_bf16(v0[2], v0[3]); w.z = cvt_pk_bf16(v1[0], v1[1]); w.w = cvt_pk_bf16(v1[2], v1[3]);
                        *(u32x4*)(PJ + (size_t)row * PJW + u.pn * 256 + bj * 128 + c0) = w;
                    }
                }
        } else {
#pragma unroll
            for (int ai = 0; ai < 2; ++ai)
#pragma unroll
                for (int m = 0; m < 4; ++m) {
                    const int row = row0 + ai * 128 + m * 16;
#pragma unroll
                    for (int bj = 0; bj < 2; ++bj) {
                        unsigned q[8];
#pragma unroll
                        for (int n = 0; n < 2; ++n)
#pragma unroll
                            for (int j = 0; j < 4; ++j) { int v = (int)(sigmoidf_(acc[ai][bj][m][n][j]) * 256.0f); q[4 * n + j] = (unsigned)(v > 255 ? 255 : v); }
                        u32x2 w; w.x = q[0] | (q[1] << 8) | (q[2] << 16) | (q[3] << 24); w.y = q[4] | (q[5] << 8) | (q[6] << 16) | (q[7] << 24);
                        *(u32x2*)(G8 + (size_t)row * 4096 + (u.pn - 9) * 256 + bj * 128 + c0) = w;
                    }
                }
        }
    }
};
struct EpiMLA {
    static constexpr bool PERM = true;
    bf16_t *MQ, *MK, *MV; const float* RSTD; const float2* RT;
    __device__ __forceinline__ void operator()(const f32x4 (&acc)[2][2][4][2], const Unit& u, int wr, int wc, int fr, int fq) const {
        const int row0 = u.pm * 256 + wr * 64 + fr;
#pragma unroll
        for (int bj = 0; bj < 2; ++bj) {
            const int cg0 = u.pn * 256 + bj * 128 + wc * 32;
            if (cg0 >= 896) continue;
#pragma unroll
            for (int ai = 0; ai < 2; ++ai)
#pragma unroll
                for (int m = 0; m < 4; ++m) {
                    __builtin_amdgcn_sched_barrier(0);
                    const int row = row0 + ai * 128 + m * 16;
                    float v[8];
                    if (cg0 < 384) {
                        const float rs = RSTD[row * 2];
#pragma unroll
                        for (int n = 0; n < 2; ++n)
#pragma unroll
                            for (int j = 0; j < 4; ++j) v[4 * n + j] = acc[ai][bj][m][n][j] * rs;
                        const int d0 = cg0 % 96;
                        if (d0 == 64) {
                            const bool lat = row < RL; const int t = row & 8191; const int pos = (fq >> 1) ? (t & 63) : (t >> 6); const bool isx2 = fq & 1;
#pragma unroll
                            for (int e = 0; e < 8; ++e) {
                                const float pr = shflx(v[e], 16);
                                const float2 cs = RT[pos * 8 + e];
                                const float r = isx2 ? (pr * cs.y + v[e] * cs.x) : (v[e] * cs.x - pr * cs.y);
                                v[e] = lat ? r : v[e];
                            }
                        }
                        u32x4 w; w.x = cvt_pk_bf16(v[0], v[1]); w.y = cvt_pk_bf16(v[2], v[3]); w.z = cvt_pk_bf16(v[4], v[5]); w.w = cvt_pk_bf16(v[6], v[7]);
                        *(u32x4*)(MQ + (size_t)row * 384 + cg0 + 8 * fq) = w;
                    } else {
                        const float rs = RSTD[row * 2 + 1];
#pragma unroll
                        for (int n = 0; n < 2; ++n)
#pragma unroll
                            for (int j = 0; j < 4; ++j) v[4 * n + j] = acc[ai][bj][m][n][j] * rs;
                        const int cp = cg0 - 384, hd = cp >> 7, d0 = cp & 127;
                        u32x4 w; w.x = cvt_pk_bf16(v[0], v[1]); w.y = cvt_pk_bf16(v[2], v[3]); w.z = cvt_pk_bf16(v[4], v[5]); w.w = cvt_pk_bf16(v[6], v[7]);
                        if (d0 < 64) *(u32x4*)(MK + (size_t)row * 384 + hd * 96 + d0 + 8 * fq) = w;
                        else *(u32x4*)(MV + (size_t)row * 256 + hd * 64 + (d0 - 64) + 8 * fq) = w;
                    }
                }
        }
    }
};
struct EpiMerge {
    static constexpr bool PERM = true;
    const unsigned char* G8; float* MF; bf16_t* MG; int bi;
    __device__ __forceinline__ void operator()(const f32x4 (&acc)[2][2][4][2], const Unit& u, int wr, int wc, int fr, int fq) const {
        const int row0 = u.pm * 256 + wr * 64 + fr, c0 = u.pn * 256 + wc * 32 + 8 * fq;
#pragma unroll
        for (int ai = 0; ai < 2; ++ai)
#pragma unroll
            for (int m = 0; m < 4; ++m) {
                const int row = row0 + ai * 128 + m * 16;
#pragma unroll
                for (int bj = 0; bj < 2; ++bj) {
                    __builtin_amdgcn_sched_barrier(0);
                    const int c = c0 + bj * 128;
                    const u32x2 gq = *(const u32x2*)(G8 + (size_t)row * 4096 + bi * 1024 + c);
                    float v[8];
#pragma unroll
                    for (int e = 0; e < 8; ++e) { const unsigned q = ((e < 4 ? gq.x : gq.y) >> (8 * (e & 3))) & 255u; v[e] = ((float)q + 0.5f) * (1.0f / 256.0f) * acc[ai][bj][m][e >> 2][e & 3]; }
                    float* mp = MF + (size_t)row * 1024 + c;
                    if (bi > 0) { const f32x4 p0 = *(const f32x4*)mp, p1 = *(const f32x4*)(mp + 4);
#pragma unroll
                        for (int e = 0; e < 4; ++e) { v[e] += p0[e]; v[4 + e] += p1[e]; } }
                    if (bi < 3) { *(f32x4*)mp = (f32x4){v[0], v[1], v[2], v[3]}; *(f32x4*)(mp + 4) = (f32x4){v[4], v[5], v[6], v[7]}; }
                    else { u32x4 w; w.x = cvt_pk_bf16(v[0], v[1]); w.y = cvt_pk_bf16(v[2], v[3]); w.z = cvt_pk_bf16(v[4], v[5]); w.w = cvt_pk_bf16(v[6], v[7]);
                        *(u32x4*)(MG + (size_t)row * 1024 + c) = w; }
                }
            }
    }
};

template <class F>
__device__ __forceinline__ void wt_rows64(bf16_t* dst, int K, F srcval) {
    const int tid_ = opaque_tid(); const int nl = tid_ & 63, kq = tid_ >> 6;
    for (int k0 = kq * 8; k0 < K; k0 += 64) {
        float v[8];
#pragma unroll
        for (int j = 0; j < 8; ++j) v[j] = srcval(nl, k0 + j);
        u32x4 w; w.x = cvt_pk_bf16(v[0], v[1]); w.y = cvt_pk_bf16(v[2], v[3]); w.z = cvt_pk_bf16(v[4], v[5]); w.w = cvt_pk_bf16(v[6], v[7]);
        *(u32x4*)(dst + (size_t)nl * K + k0) = w;
    }
}

__device__ void layer_prep_phase(PK p, int l, LAS unsigned char* lds) {
    unsigned char* ws = p->ws;
    const int nW = 404, nItems = nW + (l == 0 ? 288 + 1 : 0);
    for (int it = opaque_bid(); it < nItems; it += opaque_gdim()) {
        if (it < 176) {
            const int f = it / 88, j = it % 88; const float* src = p->ffn_w_in + ((size_t)(l * 2 + f) * 1024) * 5632;
            bf16_t* dst = (bf16_t*)(ws + OFF_W1) + ((size_t)f * 5632 + j * 64) * 1024;
            wt_rows64(dst, 1024, [&](int nl, int k) { const int np = j * 64 + nl, pn = np >> 8, wi = np & 255; const int col = wi < 128 ? pn * 128 + wi : FH + pn * 128 + (wi - 128); return src[(size_t)k * 5632 + col]; });
        } else if (it < 208) {
            const int q = it - 176, f = q / 16, j = q % 16; const float* src = p->ffn_w_out + ((size_t)(l * 2 + f) * FH) * 1024;
            bf16_t* dst = (bf16_t*)(ws + OFF_W2) + ((size_t)f * 1024 + j * 64) * FH;
            wt_rows64(dst, FH, [&](int nl, int k) { return src[(size_t)k * 1024 + j * 64 + nl]; });
        } else if (it < 308) {
            const int j = it - 208; const float* src = p->mix_w_in + (size_t)l * 1024 * 6304;
            bf16_t* dst = (bf16_t*)(ws + OFF_WM) + (size_t)j * 64 * 1024;
            wt_rows64(dst, 1024, [&](int nl, int k) { const int np = j * 64 + nl; const int col = np < 2208 ? np : (np < 2304 ? -1 : np - 96); return col < 0 ? 0.f : src[(size_t)k * 6304 + col]; });
        } else if (it < 324) {
            const int j = it - 308; const float* src = p->mix_w_out + (size_t)l * 1024 * 1024;
            bf16_t* dst = (bf16_t*)(ws + OFF_WO) + (size_t)j * 64 * 1024;
            wt_rows64(dst, 1024, [&](int nl, int k) { return src[(size_t)k * 1024 + j * 64 + nl]; });
        } else if (it < 372) {
            const int q = it - 324, bi = 1 + q / 16, j = q % 16; const float* src = p->branch_w_out + ((size_t)(l * 4 + bi) * 256) * 1024;
            bf16_t* dst = (bf16_t*)(ws + OFF_WB) + ((size_t)bi * 1024 + j * 64) * 256;
            wt_rows64(dst, 256, [&](int nl, int k) { return src[(size_t)k * 1024 + j * 64 + nl]; });
        } else if (it < 388) {
            const int j = it - 372; const float* wb = p->branch_w_out + ((size_t)(l * 4) * 256) * 1024; const float* pw = p->pool_w + (size_t)l * 4 * 64 * 64; const float* ps = p->pool_scale + l * 256;
            bf16_t* dst = (bf16_t*)(ws + OFF_WB) + (size_t)j * 64 * 256;
            wt_rows64(dst, 256, [&](int nl, int k) { const int gI = k >> 6, n = j * 64 + nl; const float* pr = pw + (size_t)k * 64; float s = 0.f;
                for (int e = 0; e < 64; ++e) s += pr[e] * ps[gI * 64 + e] * wb[(size_t)(gI * 64 + e) * 1024 + n]; return s; });
        } else if (it < 404) {
            const int j = it - 388; const float* wq = p->mla_w_qb + (size_t)l * 256 * 384; const float* wk = p->mla_w_kvb + (size_t)l * 128 * 512;
            const float* gq = p->mla_q_norm_g + l * 256; const float* gk = p->mla_kv_norm_g + l * 128;
            bf16_t* dst = (bf16_t*)(ws + OFF_WL) + (size_t)j * 64 * 384;
            wt_rows64(dst, 384, [&](int nl, int k) { const int n = j * 64 + nl;
                if (n < 384) return k < 256 ? gq[k] * wq[(size_t)k * 384 + n] : 0.f;
                if (n < 896) return k >= 256 ? gk[k - 256] * wk[(size_t)(k - 256) * 512 + (n - 384)] : 0.f;
                return 0.f; });
        } else if (it < 404 + 288) {
            const int q = it - 404, ll = q / 144, cb = q % 144;
            LAS float* sc = (LAS float*)lds;
            LAS float* red = (LAS float*)(lds + 5 * 1024 * 4);
            __syncthreads();
            for (int i = opaque_tid(); i < 5 * 1024; i += 512) { const int r = i >> 10, k = i & 1023; const float cv = r < 4 ? p->c[r * 1024 + k] : p->c_ctx[k]; sc[i] = cv * sigmoidf_(cv); }
            __syncthreads();
            const int jl = opaque_tid() & 63, kg = opaque_tid() >> 6; const int col = cb * 64 + jl;
            const float* wsrc = p->ada_w + (size_t)ll * 1024 * 9216 + col;
            float a0 = 0.f, a1 = 0.f, a2 = 0.f, a3 = 0.f, a4 = 0.f;
            for (int k = kg * 128; k < kg * 128 + 128; ++k) { const float wv = wsrc[(size_t)k * 9216]; a0 += sc[k] * wv; a1 += sc[1024 + k] * wv; a2 += sc[2048 + k] * wv; a3 += sc[3072 + k] * wv; a4 += sc[4096 + k] * wv; }
            red[(kg * 5 + 0) * 64 + jl] = a0; red[(kg * 5 + 1) * 64 + jl] = a1; red[(kg * 5 + 2) * 64 + jl] = a2; red[(kg * 5 + 3) * 64 + jl] = a3; red[(kg * 5 + 4) * 64 + jl] = a4;
            __syncthreads();
            if (opaque_tid() < 320) { const int r = opaque_tid() >> 6; float s = p->ada_b[ll * 9216 + col];
                for (int q2 = 0; q2 < 8; ++q2) s += red[(q2 * 5 + r) * 64 + jl];
                ((float*)(ws + OFF_MOD))[(size_t)(ll * 5 + r) * 9216 + col] = s; }
        } else {
            for (int i = opaque_tid(); i < 1024; i += 512) { const int pos = i >> 3, fi = i & 7; const float inv = exp2f(-(float)fi * 0.125f * 13.287712379549449f); const float ang = (float)pos * inv;
                ((float2*)(ws + OFF_ROPE))[i] = make_float2(cosf(ang), sinf(ang)); }
        }
    }
}

__device__ void norm_mod_phase(const float* srcL, const float* srcC, float* cpyL, float* cpyC, const float* g, const float* mod, bf16_t* TN, int nrows) {
    const int tid_ = opaque_tid(); const int lane = tid_ & 63, gw = opaque_bid() * 8 + (tid_ >> 6), nw = opaque_gdim() * 8;
    for (int row = gw; row < nrows; row += nw) {
        const bool lat = row < RL;
        const float* sp = lat ? srcL + (size_t)row * 1024 : srcC + (size_t)(row - RL) * 1024;
        const float* mp = mod + (lat ? (row >> 13) : 4) * 9216;
        f32x4 v[4]; float ss = 0.f;
#pragma unroll
        for (int j = 0; j < 4; ++j) { v[j] = *(const f32x4*)(sp + 256 * j + 4 * lane); ss += v[j][0] * v[j][0] + v[j][1] * v[j][1] + v[j][2] * v[j][2] + v[j][3] * v[j][3]; }
        if (cpyL) { float* cp = lat ? cpyL + (size_t)row * 1024 : cpyC + (size_t)(row - RL) * 1024;
#pragma unroll
            for (int j = 0; j < 4; ++j) *(f32x4*)(cp + 256 * j + 4 * lane) = v[j]; }
        ss = wave_sum(ss);
        const float rstd = rsqrtf(ss * (1.0f / 1024.0f) + NEPS);
#pragma unroll
        for (int j = 0; j < 4; ++j) {
            const int col = 256 * j + 4 * lane;
            const f32x4 gg = *(const f32x4*)(g + col), sh = *(const f32x4*)(mp + col), sc = *(const f32x4*)(mp + 1024 + col);
            float o[4];
#pragma unroll
            for (int e = 0; e < 4; ++e) o[e] = (v[j][e] * rstd * gg[e]) * (1.0f + sc[e]) + sh[e];
            u32x2 w; w.x = cvt_pk_bf16(o[0], o[1]); w.y = cvt_pk_bf16(o[2], o[3]);
            *(u32x2*)(TN + (size_t)row * 1024 + col) = w;
        }
    }
}
__device__ void final_norm_phase(float* H, const float* g) {
    const int tid_ = opaque_tid(); const int lane = tid_ & 63, gw = opaque_bid() * 8 + (tid_ >> 6), nw = opaque_gdim() * 8;
    for (int row = gw; row < RL; row += nw) {
        float* sp = H + (size_t)row * 1024; f32x4 v[4]; float ss = 0.f;
#pragma unroll
        for (int j = 0; j < 4; ++j) { v[j] = *(const f32x4*)(sp + 256 * j + 4 * lane); ss += v[j][0] * v[j][0] + v[j][1] * v[j][1] + v[j][2] * v[j][2] + v[j][3] * v[j][3]; }
        ss = wave_sum(ss);
        const float rstd = rsqrtf(ss * (1.0f / 1024.0f) + NEPS);
#pragma unroll
        for (int j = 0; j < 4; ++j) { const f32x4 gg = *(const f32x4*)(g + 256 * j + 4 * lane); *(f32x4*)(sp + 256 * j + 4 * lane) = v[j] * rstd * gg; }
    }
}

__device__ void prep_phase(PK p) {
    unsigned char* ws = p->ws;
    bf16_t* PJ = (bf16_t*)(ws + OFF_B); bf16_t* YB = (bf16_t*)(ws + OFF_A); bf16_t* MK = (bf16_t*)(ws + OFF_MK); float* RSTD = (float*)(ws + OFF_RSTD);
    const float2* RT = (const float2*)(ws + OFF_ROPE);
    const int tid_ = opaque_tid(); const int lane = tid_ & 63, gw = opaque_bid() * 8 + (tid_ >> 6), nw = opaque_gdim() * 8;
    for (int row = gw; row < RA; row += nw) {
        const bool lat = row < RL;
        int t, n; if (lat) { t = row & 8191; n = 8192; } else { t = (row - RL) & 255; n = 256; }
        const int sbase = row - t;
        bf16_t* prow = PJ + (size_t)row * PJW;
        {
            const int wdw = 2 << (lane >> 4); const int lo = max(t - wdw / 2, 0), hi = min(t - wdw / 2 + wdw, n);
            float s0 = 0.f, s1 = 0.f, s2 = 0.f, s3 = 0.f;
            for (int tt = lo; tt < hi; ++tt) { const u32x2 v = *(const u32x2*)(PJ + (size_t)(sbase + tt) * PJW + 4 * lane); s0 += bf_lo(v.x); s1 += bf_hi(v.x); s2 += bf_lo(v.y); s3 += bf_hi(v.y); }
            const float ic = 1.0f / (float)(hi - lo); const u32x2 sv = *(const u32x2*)(prow + 4 * lane);
            u32x2 w; w.x = cvt_pk_bf16(s0 * ic - bf_lo(sv.x), s1 * ic - bf_hi(sv.x)); w.y = cvt_pk_bf16(s2 * ic - bf_lo(sv.y), s3 * ic - bf_hi(sv.y));
            *(u32x2*)(YB + (size_t)row * 1024 + 4 * lane) = w;
        }
        {
            const u32x2 q = *(const u32x2*)(prow + C_MQ + 4 * lane); const unsigned kv = *(const unsigned*)(prow + C_MKV + 2 * lane);
            float sq = bf_lo(q.x) * bf_lo(q.x) + bf_hi(q.x) * bf_hi(q.x) + bf_lo(q.y) * bf_lo(q.y) + bf_hi(q.y) * bf_hi(q.y);
            float sk = bf_lo(kv) * bf_lo(kv) + bf_hi(kv) * bf_hi(kv);
            sq = wave_sum(sq); sk = wave_sum(sk);
            if (lane == 0) { RSTD[row * 2] = rsqrtf(sq * (1.0f / 256.0f) + NEPS); RSTD[row * 2 + 1] = rsqrtf(sk * (1.0f / 128.0f) + NEPS); }
        }
        if (lane < 34) {
            const bool iskr = lane >= 32; const int a = lane & 1;
            bf16_t* ep = iskr ? prow + C_MKR + a * 16 : prow + ((lane >> 4) ? C_DK : C_DQ) + ((lane >> 1) & 7) * 32 + a * 16;
            const u32x4 e0 = *(const u32x4*)ep, e1 = *(const u32x4*)(ep + 8);
            float x1[8], x2[8];
            x1[0] = bf_lo(e0.x); x1[1] = bf_hi(e0.x); x1[2] = bf_lo(e0.y); x1[3] = bf_hi(e0.y); x1[4] = bf_lo(e0.z); x1[5] = bf_hi(e0.z); x1[6] = bf_lo(e0.w); x1[7] = bf_hi(e0.w);
            x2[0] = bf_lo(e1.x); x2[1] = bf_hi(e1.x); x2[2] = bf_lo(e1.y); x2[3] = bf_hi(e1.y); x2[4] = bf_lo(e1.z); x2[5] = bf_hi(e1.z); x2[6] = bf_lo(e1.w); x2[7] = bf_hi(e1.w);
            if (lat) { const int pos = a ? (t & 63) : (t >> 6);
#pragma unroll
                for (int i = 0; i < 8; ++i) { const float2 cs = RT[pos * 8 + i]; const float o1 = x1[i] * cs.x - x2[i] * cs.y, o2 = x1[i] * cs.y + x2[i] * cs.x; x1[i] = o1; x2[i] = o2; } }
            u32x4 w0, w1; w0.x = cvt_pk_bf16(x1[0], x1[1]); w0.y = cvt_pk_bf16(x1[2], x1[3]); w0.z = cvt_pk_bf16(x1[4], x1[5]); w0.w = cvt_pk_bf16(x1[6], x1[7]);
            w1.x = cvt_pk_bf16(x2[0], x2[1]); w1.y = cvt_pk_bf16(x2[2], x2[3]); w1.z = cvt_pk_bf16(x2[4], x2[5]); w1.w = cvt_pk_bf16(x2[6], x2[7]);
            if (iskr) {
#pragma unroll
                for (int hh = 0; hh < 4; ++hh) { bf16_t* kp = MK + (size_t)row * 384 + hh * 96 + 64 + a * 16; *(u32x4*)kp = w0; *(u32x4*)(kp + 8) = w1; }
            } else if (lat) { *(u32x4*)ep = w0; *(u32x4*)(ep + 8) = w1; }
        }
    }
}

#define MFMA32(a, b, c) __builtin_amdgcn_mfma_f32_32x32x16_bf16((a), (b), (c), 0, 0, 0)
template <int MODE>
__device__ __forceinline__ void attn_item(PK p, int l, LAS unsigned char* lds, int b, int h, int qb, bool ctxq, float lam, float lam_init) {
    constexpr int NCOMP = (MODE == 1) ? 2 : 1, NKS = (MODE == 0) ? 4 : ((MODE == 1) ? 2 : 6), KW = NCOMP * NKS * 16, KCH = KW / 8, KSTR = KW * 2 + 16, VSTR = 192;
    constexpr int KBUF = 64 * KSTR, VBUF = 64 * VSTR, BUFSZ = KBUF + VBUF, BIAS_OFF = 2 * BUFSZ;
    const int tid = opaque_tid(), w = tid >> 6, lane = tid & 63, g = lane >> 5, l32 = lane & 31;
    unsigned char* ws = p->ws;
    const bf16_t* PJ = (const bf16_t*)(ws + OFF_B);
    const bf16_t *Qp, *Kp, *Vp; int ldq, ldk, ldv, outoff; float scale;
    if (MODE == 0) { Qp = PJ + C_NQ + 64 * h; Kp = PJ + C_NK + 64 * h; Vp = PJ + C_NV + 64 * h; ldq = ldk = ldv = PJW; outoff = 256 + 64 * h; scale = 0.125f; }
    else if (MODE == 1) { Qp = PJ + C_DQ + 64 * h; Kp = PJ + C_DK + 64 * h; Vp = PJ + C_DV + 64 * h; ldq = ldk = ldv = PJW; outoff = 512 + 64 * h; scale = 0.17677669529663687f; }
    else { Qp = (const bf16_t*)(ws + OFF_D) + 96 * h; Kp = (const bf16_t*)(ws + OFF_MK) + 96 * h; Vp = (const bf16_t*)(ws + OFF_MV) + 64 * h; ldq = ldk = 384; ldv = 256; outoff = 768 + 64 * h; scale = 0.10206207261596575f; }
    const float cs = scale * LOG2E;
    int qrow0, loc0, nloc;
    if (ctxq) { qrow0 = RL + b * 256; loc0 = 0; nloc = 0; }
    else { qrow0 = b * 8192 + qb * 256;
        if (MODE == 0) { const int r0 = qb * 4; loc0 = clampi(r0 - 4, 0, 120); nloc = clampi(r0 - 1, 0, 120) + 8 - loc0; } else { loc0 = 0; nloc = 128; } }
    const int nt = nloc + 4;
    const bool nabias = (MODE == 0) && !ctxq;
    const int rw = qb * 4 + (w >> 1), sw = clampi(rw - 4, 0, 120);
    const int jq = 32 * (w & 1) + l32, cst = clampi(jq - 8, 0, 48);
    if (nabias && tid < 465) ((LAS float*)(lds + BIAS_OFF))[tid] = p->na_rpb[(size_t)(l * 4 + h) * 465 + tid] * LOG2E;

    const size_t qrow = (size_t)qrow0 + 32 * w + l32;
    bf16x8 qf[NCOMP * NKS];
#pragma unroll
    for (int i = 0; i < NCOMP * NKS; ++i) qf[i] = *(const bf16x8*)(Qp + qrow * ldq + 16 * i + 8 * g);

    const int kr0 = tid / KCH, kc0 = tid % KCH, kr1 = (tid + 512) / KCH, kc1 = (tid + 512) % KCH, vr = tid >> 3, vc = tid & 7;
    const bool hask1 = (KCH == 12) && (tid < 256);
    u32x4 rk0, rk1 = (u32x4){0u, 0u, 0u, 0u}, rv;
#define TILE_ROW(t) ((t) < nloc ? (b * 8192 + 64 * (loc0 + (t))) : (RL + b * 256 + 64 * ((t) - nloc)))
#define LOAD_TILE(t) do { const size_t _tb = (size_t)TILE_ROW(t); rk0 = *(const u32x4*)(Kp + (_tb + kr0) * ldk + kc0 * 8); \
        if (hask1) rk1 = *(const u32x4*)(Kp + (_tb + kr1) * ldk + kc1 * 8); rv = *(const u32x4*)(Vp + (_tb + vr) * ldv + vc * 8); } while (0)
#define STORE_TILE(buf) do { LAS unsigned char* _kb = lds + (buf) * BUFSZ; *(LAS u32x4*)(_kb + kr0 * KSTR + kc0 * 16) = rk0; \
        if (hask1) *(LAS u32x4*)(_kb + kr1 * KSTR + kc1 * 16) = rk1; *(LAS u32x4*)(_kb + KBUF + vr * VSTR + vc * 16) = rv; } while (0)

    float mrun[NCOMP], lsum[NCOMP]; f32x16 O[NCOMP][2];
#pragma unroll
    for (int c = 0; c < NCOMP; ++c) { mrun[c] = -1e30f; lsum[c] = 0.f;
#pragma unroll
        for (int dt = 0; dt < 2; ++dt)
#pragma unroll
            for (int r = 0; r < 16; ++r) O[c][dt][r] = 0.f; }

    LOAD_TILE(0); STORE_TILE(0); __syncthreads();
    const int koff = l32 * KSTR + g * 16;
    const int i16 = lane & 15, tq = i16 >> 2, tp = i16 & 3, blk = (lane >> 4) & 1;
    const int voff = (4 * g + tq) * VSTR + (16 * blk + 4 * tp) * 2;

    for (int t = 0; t < nt; ++t) {
        const bool more = (t + 1 < nt);
        if (more) LOAD_TILE(t + 1);
        bool active = true; int krow = 0;
        if (nabias && t < nloc) { krow = loc0 + t; active = (krow >= sw) && (krow < sw + 8); }
        if (active) {
            LAS unsigned char* Kb = lds + (t & 1) * BUFSZ; LAS unsigned char* Vb = Kb + KBUF;
            bf16x8 pf[NCOMP][2][2];
#pragma unroll
            for (int c = 0; c < NCOMP; ++c) {
                f32x16 S[2];
#pragma unroll
                for (int kt = 0; kt < 2; ++kt) {
#pragma unroll
                    for (int r = 0; r < 16; ++r) S[kt][r] = 0.f;
#pragma unroll
                    for (int ks = 0; ks < NKS; ++ks) { const bf16x8 kf = *(const LAS bf16x8*)(Kb + koff + kt * 32 * KSTR + (c * NKS + ks) * 32); S[kt] = MFMA32(kf, qf[c * NKS + ks], S[kt]); }
                }
                float mx = -1e30f;
                if (nabias && t < nloc) {
                    const LAS float* bt = (const LAS float*)(lds + BIAS_OFF) + (krow - rw + 7) * 31;
#pragma unroll
                    for (int kt = 0; kt < 2; ++kt)
#pragma unroll
                        for (int r = 0; r < 16; ++r) { const int jk = 32 * kt + (r & 3) + 8 * (r >> 2) + 4 * g; const bool ok = (jk >= cst) && (jk < cst + 16);
                            const float bv = bt[clampi(jk - jq + 15, 0, 30)]; const float xv = ok ? (S[kt][r] * cs + bv) : -1e30f; S[kt][r] = xv; mx = fmaxf(mx, xv); }
                } else {
#pragma unroll
                    for (int kt = 0; kt < 2; ++kt)
#pragma unroll
                        for (int r = 0; r < 16; ++r) { const float xv = S[kt][r] * cs; S[kt][r] = xv; mx = fmaxf(mx, xv); }
                }
                mx = fmaxf(mx, shflx(mx, 32));
                const float mnew = fmaxf(mrun[c], mx);
                if (__any(mnew > mrun[c])) {
                    const float alpha = fast_exp2(mrun[c] - mnew); lsum[c] *= alpha;
#pragma unroll
                    for (int dt = 0; dt < 2; ++dt)
#pragma unroll
                        for (int r = 0; r < 16; ++r) O[c][dt][r] *= alpha;
                    mrun[c] = mnew;
                }
                float rs = 0.f;
#pragma unroll
                for (int kt = 0; kt < 2; ++kt)
#pragma unroll
                    for (int r = 0; r < 16; ++r) { const float pv = fast_exp2(S[kt][r] - mnew); S[kt][r] = pv; rs += pv; }
                lsum[c] += rs;
#pragma unroll
                for (int kt = 0; kt < 2; ++kt)
#pragma unroll
                    for (int s = 0; s < 2; ++s) { u32x4 pk; pk.x = cvt_pk_bf16(S[kt][8 * s], S[kt][8 * s + 1]); pk.y = cvt_pk_bf16(S[kt][8 * s + 2], S[kt][8 * s + 3]);
                        pk.z = cvt_pk_bf16(S[kt][8 * s + 4], S[kt][8 * s + 5]); pk.w = cvt_pk_bf16(S[kt][8 * s + 6], S[kt][8 * s + 7]); pf[c][kt][s] = __builtin_bit_cast(bf16x8, pk); }
            }
#pragma unroll
            for (int kt = 0; kt < 2; ++kt)
#pragma unroll
                for (int s = 0; s < 2; ++s)
#pragma unroll
                    for (int dt = 0; dt < 2; ++dt) {
                        LAS unsigned char* vp = Vb + voff + (32 * kt + 16 * s) * VSTR + dt * 64;
                        const s16x4 lo = __builtin_amdgcn_ds_read_tr16_b64_v4i16((LAS s16x4*)vp);
                        const s16x4 hi = __builtin_amdgcn_ds_read_tr16_b64_v4i16((LAS s16x4*)(vp + 8 * VSTR));
                        const bf16x8 vf = __builtin_shufflevector(lo, hi, 0, 1, 2, 3, 4, 5, 6, 7);
#pragma unroll
                        for (int c = 0; c < NCOMP; ++c) O[c][dt] = MFMA32(vf, pf[c][kt][s], O[c][dt]);
                    }
        }
        if (more) STORE_TILE((t + 1) & 1);
        __syncthreads();
    }
#undef TILE_ROW
#undef LOAD_TILE
#undef STORE_TILE
    float inv[NCOMP];
#pragma unroll
    for (int c = 0; c < NCOMP; ++c) { const float lt = lsum[c] + shflx(lsum[c], 32); inv[c] = 1.0f / lt; }
    bf16_t* op = (bf16_t*)(ws + OFF_A) + qrow * 1024 + outoff;
    if (MODE == 1) {
        const float li1 = lam * inv[NCOMP - 1]; float ss = 0.f;
#pragma unroll
        for (int dt = 0; dt < 2; ++dt)
#pragma unroll
            for (int r = 0; r < 16; ++r) { const float o = O[0][dt][r] * inv[0] - li1 * O[NCOMP - 1][dt][r]; O[0][dt][r] = o; ss += o * o; }
        ss += shflx(ss, 32);
        const float rstd = rsqrtf(ss * (1.0f / 64.0f) + NEPS) * (1.0f - lam_init);
        const float* sg = p->diff_subln_g + l * 64;
#pragma unroll
        for (int dt = 0; dt < 2; ++dt)
#pragma unroll
            for (int rq = 0; rq < 4; ++rq) { const int dv = 32 * dt + 8 * rq + 4 * g; const f32x4 gg = *(const f32x4*)(sg + dv);
                u32x2 wv; wv.x = cvt_pk_bf16(O[0][dt][4 * rq] * rstd * gg[0], O[0][dt][4 * rq + 1] * rstd * gg[1]); wv.y = cvt_pk_bf16(O[0][dt][4 * rq + 2] * rstd * gg[2], O[0][dt][4 * rq + 3] * rstd * gg[3]);
                *(u32x2*)(op + dv) = wv; }
    } else {
#pragma unroll
        for (int dt = 0; dt < 2; ++dt)
#pragma unroll
            for (int rq = 0; rq < 4; ++rq) { const int dv = 32 * dt + 8 * rq + 4 * g;
                u32x2 wv; wv.x = cvt_pk_bf16(O[0][dt][4 * rq] * inv[0], O[0][dt][4 * rq + 1] * inv[0]); wv.y = cvt_pk_bf16(O[0][dt][4 * rq + 2] * inv[0], O[0][dt][4 * rq + 3] * inv[0]);
                *(u32x2*)(op + dv) = wv; }
    }
}

__device__ void attn_phase(PK p, int l, LAS unsigned char* lds) {
    const float lam_init = (l == 0) ? 0.2f : 0.35550906759502f;
    const float* dl = p->diff_lambda + l * 128;
    float d01 = 0.f, d23 = 0.f;
    for (int i = 0; i < 32; ++i) { d01 += dl[i] * dl[32 + i]; d23 += dl[64 + i] * dl[96 + i]; }
    const float lam = expf(d01) - expf(d23) + lam_init;
    const int nItems = 1536 + (l == 0 ? 48 : 0);
    for (int it = opaque_bid(); it < nItems; it += opaque_gdim()) {
        if (it < 1536) {
            const int ty = it >> 9, idx = it & 511, b = idx >> 7, h = (idx >> 5) & 3, qb = idx & 31;
            if (ty == 0) attn_item<1>(p, l, lds, b, h, qb, false, lam, lam_init);
            else if (ty == 1) attn_item<2>(p, l, lds, b, h, qb, false, lam, lam_init);
            else attn_item<0>(p, l, lds, b, h, qb, false, lam, lam_init);
        } else {
            const int idx = it - 1536, ty = idx >> 4, b = (idx >> 2) & 3, h = idx & 3;
            if (ty == 0) attn_item<1>(p, l, lds, b, h, 0, true, lam, lam_init);
            else if (ty == 1) attn_item<2>(p, l, lds, b, h, 0, true, lam, lam_init);
            else attn_item<0>(p, l, lds, b, h, 0, true, lam, lam_init);
        }
    }
}

constexpr int PH_PER_LAYER = 14, N_PHASES = 2 * PH_PER_LAYER + 1;

__device__ __forceinline__ void run_phase(PK p, int ph, LAS unsigned char* lds) {
    unsigned char* ws = p->ws;
    pg8::StaticOrder S;
    if (ph == N_PHASES - 1) { final_norm_phase(p->out, p->final_norm_g); return; }
    const int l = ph / PH_PER_LAYER, q = ph % PH_PER_LAYER;
    float* HC = (float*)(ws + OFF_HC);
    const float* MOD = (const float*)(ws + OFF_MOD) + (size_t)l * 5 * 9216;
    bf16_t* TN = (bf16_t*)(ws + OFF_A); bf16_t* HID = (bf16_t*)(ws + OFF_B);
    const int Mlate = (l == 0) ? RA : RL;
    switch (q) {
    case 0: layer_prep_phase(p, l, lds); break;
    case 1: if (l == 0) norm_mod_phase(p->x, p->ctx, p->out, HC, p->norm_g + (l * 3 + 0) * 1024, MOD, TN, RA);
            else norm_mod_phase(p->out, HC, nullptr, nullptr, p->norm_g + (l * 3 + 0) * 1024, MOD, TN, RA); break;
    case 2: case 12: { const int f = (q == 2) ? 0 : 1; const int M = (q == 2) ? RA : Mlate;
        pg8::Gemm g{TN, (const bf16_t*)(ws + OFF_W1) + (size_t)f * 5632 * 1024, M, 5632, 1024, 1024, 1024}; S.init(M, 5632, opaque_gdim(), opaque_bid());
        EpiSwiglu E{HID}; pg8::gemm_phase(lds, g, S, E); } break;
    case 3: case 13: { const int f = (q == 3) ? 0 : 1; const int M = (q == 3) ? RA : Mlate;
        pg8::Gemm g{HID, (const bf16_t*)(ws + OFF_W2) + (size_t)f * 1024 * FH, M, 1024, FH, FH, FH}; S.init(M, 1024, opaque_gdim(), opaque_bid());
        EpiResid E{p->out, HC, MOD + (q == 3 ? 2 : 8) * 1024, 0.5f}; pg8::gemm_phase(lds, g, S, E); } break;
    case 4: norm_mod_phase(p->out, HC, nullptr, nullptr, p->norm_g + (l * 3 + 1) * 1024, MOD + 3 * 1024, TN, RA); break;
    case 5: { pg8::Gemm g{TN, (const bf16_t*)(ws + OFF_WM), RA, 6400, 1024, 1024, 1024}; S.init(RA, 6400, opaque_gdim(), opaque_bid());
        EpiPJ E{(bf16_t*)(ws + OFF_B), ws + OFF_C}; pg8::gemm_phase(lds, g, S, E); } break;
    case 6: prep_phase(p); break;
    case 7: { pg8::Gemm g{(const bf16_t*)(ws + OFF_B) + C_MQ, (const bf16_t*)(ws + OFF_WL), RA, 1024, 384, PJW, 384}; S.init(RA, 1024, opaque_gdim(), opaque_bid());
        EpiMLA E{(bf16_t*)(ws + OFF_D), (bf16_t*)(ws + OFF_MK), (bf16_t*)(ws + OFF_MV), (const float*)(ws + OFF_RSTD), (const float2*)(ws + OFF_ROPE)}; pg8::gemm_phase(lds, g, S, E); } break;
    case 8: attn_phase(p, l, lds); break;
    case 9: { S.init(Mlate, 1024, opaque_gdim(), opaque_bid());
        for (int bi = 0; bi < 4; ++bi) {
            pg8::Gemm g{(const bf16_t*)(ws + OFF_A) + bi * 256, (const bf16_t*)(ws + OFF_WB) + (size_t)bi * 1024 * 256, Mlate, 1024, 256, 1024, 256};
            EpiMerge E{ws + OFF_C, (float*)(ws + OFF_B), (bf16_t*)(ws + OFF_D), bi}; pg8::gemm_phase(lds, g, S, E); } } break;
    case 10: { pg8::Gemm g{(const bf16_t*)(ws + OFF_D), (const bf16_t*)(ws + OFF_WO), Mlate, 1024, 1024, 1024, 1024}; S.init(Mlate, 1024, opaque_gdim(), opaque_bid());
        EpiResid E{p->out, HC, MOD + 5 * 1024, 1.0f}; pg8::gemm_phase(lds, g, S, E); } break;
    case 11: norm_mod_phase(p->out, HC, nullptr, nullptr, p->norm_g + (l * 3 + 2) * 1024, MOD + 6 * 1024, TN, Mlate); break;
    }
}

__global__ void __launch_bounds__(512, 2) fwd_megakernel(Params p) {
    extern __shared__ __attribute__((aligned(16))) unsigned char shm[];
    LAS unsigned char* lds = (LAS unsigned char*)shm;
#if N_LAUNCH_MODE == 1
    cg::grid_group grid = cg::this_grid();
    const int ph_lo = p.ph_lo, ph_hi = p.ph_hi;
    for (int ph = ph_lo; ph < ph_hi; ++ph) {
        PK pk = (PK)__builtin_amdgcn_kernarg_segment_ptr();
        asm volatile("" : "+s"(pk));
        run_phase(pk, ph, lds);
        if (ph + 1 < ph_hi) grid.sync();
    }
#else
    const int ph_lo = p.ph_lo, ph_hi = p.ph_hi;
    for (int ph = ph_lo; ph < ph_hi; ++ph) { PK pk = (PK)__builtin_amdgcn_kernarg_segment_ptr(); asm volatile("" : "+s"(pk)); run_phase(pk, ph, lds); }
#endif
}

extern "C" void kernel_launch(void* const* d_in, const int* in_sizes, int n_in, void* d_out, int out_size, void* d_ws, size_t ws_size, hipStream_t stream) {
    constexpr int LDS_BYTES = pg8::STAGE_BYTES;
    static int grid_blocks = 0;
    if (grid_blocks == 0) {
        if (n_in != 22 || ws_size < WS_END) { fprintf(stderr, "kernel_launch: unexpected inputs (n_in %d, ws %zu < %zu)\n", n_in, ws_size, (size_t)WS_END); grid_blocks = -1; return; }
        int dev = 0, cus = 0, per_cu = 0;
        hipGetDevice(&dev); hipDeviceGetAttribute(&cus, hipDeviceAttributeMultiprocessorCount, dev);
        if (hipFuncSetAttribute((const void*)fwd_megakernel, hipFuncAttributeMaxDynamicSharedMemorySize, LDS_BYTES) != hipSuccess) { fprintf(stderr, "hipFuncSetAttribute failed\n"); grid_blocks = -1; return; }
        if (hipOccupancyMaxActiveBlocksPerMultiprocessor(&per_cu, (const void*)fwd_megakernel, 512, LDS_BYTES) != hipSuccess || per_cu < 1) per_cu = 1;
        (void)hipGetLastError();
        grid_blocks = cus * 1;
    }
    if (grid_blocks < 0) return;
    Params hp{};
    const float** pp = (const float**)&hp;
    for (int i = 0; i < 22; ++i) pp[i] = (const float*)d_in[i];
    hp.out = (float*)d_out; hp.ws = (unsigned char*)d_ws;
#if N_LAUNCH_MODE == 1
    hp.ph_lo = 0; hp.ph_hi = N_PHASES;
    void* args[] = {&hp};
    hipError_t e = hipLaunchCooperativeKernel((const void*)fwd_megakernel, dim3(grid_blocks), dim3(512), args, LDS_BYTES, stream);
    if (e != hipSuccess) fprintf(stderr, "cooperative launch failed: %s (grid %d)\n", hipGetErrorString(e), grid_blocks);
#else
    for (int ph = 0; ph < N_PHASES; ++ph) { hp.ph_lo = ph; hp.ph_hi = ph + 1; hipLaunchKernelGGL(fwd_megakernel, dim3(grid_blocks), dim3(512), LDS_BYTES, stream, hp); }
#endif
}
```

```cpp
#include <hip/hip_runtime.h>
#include <hip/hip_cooperative_groups.h>
#include <cstdio>
namespace cg = cooperative_groups;

#define LAS __attribute__((address_space(3)))
typedef unsigned short bf16_t;
typedef short bf16x8 __attribute__((ext_vector_type(8)));
typedef short s16x4 __attribute__((ext_vector_type(4)));
typedef float f32x4 __attribute__((ext_vector_type(4)));
typedef float f32x16 __attribute__((ext_vector_type(16)));
typedef unsigned u32x4 __attribute__((ext_vector_type(4)));
typedef unsigned u32x2 __attribute__((ext_vector_type(2)));

#ifndef PROBE_MASK
#define PROBE_MASK 0
#endif
#ifndef N_LAUNCH_MODE
#define N_LAUNCH_MODE 1
#endif

constexpr int RL = 32768, RA = 33792, FH = 2816;
constexpr int PJW = 2304;
constexpr int C_NQ = 256, C_NK = 512, C_NV = 768, C_DQ = 1024, C_DK = 1280, C_DV = 1536, C_MQ = 1792, C_MKV = 2048, C_MKR = 2176;
constexpr float LOG2E = 1.4426950408889634f;
constexpr float NEPS = 1e-6f;
constexpr int XCD_BAR_WORDS_C = 3456;

constexpr size_t SZ_W1 = 2ull * 5632 * 1024 * 2, SZ_W2 = 2ull * 1024 * 2816 * 2, SZ_WM = 6400ull * 1024 * 2, SZ_WL = 1024ull * 384 * 2, SZ_WB = 4ull * 1024 * 256 * 2, SZ_WO = 1024ull * 1024 * 2;
constexpr size_t OFF_W1 = 0, OFF_W2 = OFF_W1 + SZ_W1, OFF_WM = OFF_W2 + SZ_W2, OFF_WL = OFF_WM + SZ_WM, OFF_WB = OFF_WL + SZ_WL, OFF_WO = OFF_WB + SZ_WB;
constexpr size_t OFF_HC = OFF_WO + SZ_WO;
constexpr size_t OFF_MOD = OFF_HC + 1024ull * 1024 * 4;
constexpr size_t OFF_ROPE = OFF_MOD + 2ull * 5 * 9216 * 4;
constexpr size_t OFF_RSTD = OFF_ROPE + 128 * 8 * 8;
constexpr size_t OFF_A = OFF_RSTD + (size_t)RA * 2 * 4;
constexpr size_t OFF_B = OFF_A + (size_t)RA * 1024 * 2;
constexpr size_t OFF_C = OFF_B + (size_t)RA * PJW * 2;
constexpr size_t OFF_D = OFF_C + (size_t)RA * 4096;
constexpr size_t OFF_MK = OFF_D + (size_t)RA * 384 * 2, OFF_MV = OFF_MK + (size_t)RA * 384 * 2;
constexpr size_t OFF_BAR = OFF_D + (size_t)RA * 1024 * 2;
constexpr size_t WS_END = OFF_BAR + XCD_BAR_WORDS_C * 4;

struct Params {
    const float *x, *c, *ctx, *c_ctx, *ada_w, *ada_b, *norm_g, *ffn_w_in, *ffn_w_out, *mix_w_in, *pool_w, *pool_scale, *na_rpb, *diff_lambda, *diff_subln_g,
        *mla_q_norm_g, *mla_kv_norm_g, *mla_w_qb, *mla_w_kvb, *branch_w_out, *mix_w_out, *final_norm_g;
    float* out; unsigned char* ws;
    int ph_lo, ph_hi;
};

typedef const __attribute__((address_space(4))) Params* PK;

__device__ __forceinline__ unsigned cvt_pk_bf16(float lo, float hi) { unsigned r; asm volatile("v_cvt_pk_bf16_f32 %0, %1, %2" : "=v"(r) : "v"(lo), "v"(hi)); return r; }
__device__ __forceinline__ float bf_lo(unsigned u) { return __uint_as_float(u << 16); }
__device__ __forceinline__ float bf_hi(unsigned u) { return __uint_as_float(u & 0xffff0000u); }
__device__ __forceinline__ float fast_exp2(float x) { return __builtin_amdgcn_exp2f(x); }
__device__ __forceinline__ float fast_rcp(float x) { return __builtin_amdgcn_rcpf(x); }
__device__ __forceinline__ float sigmoidf_(float x) { return fast_rcp(1.0f + fast_exp2(-x * LOG2E)); }
__device__ __forceinline__ float shflx(float v, int m) {
    int lane = __builtin_amdgcn_mbcnt_hi(~0u, __builtin_amdgcn_mbcnt_lo(~0u, 0)); asm volatile("" : "+v"(lane));
    return __int_as_float(__builtin_amdgcn_ds_bpermute((lane ^ m) << 2, __float_as_int(v)));
}
__device__ __forceinline__ float wave_sum(float v) {
    v += shflx(v, 32); v += shflx(v, 16); v += shflx(v, 8); v += shflx(v, 4); v += shflx(v, 2); v += shflx(v, 1); return v;
}
__device__ __forceinline__ int opaque_tid() { int t = threadIdx.x; asm volatile("" : "+v"(t)); return t; }
__device__ __forceinline__ int opaque_bid() { int t = blockIdx.x; asm volatile("" : "+s"(t)); return t; }
__device__ __forceinline__ int opaque_gdim() { int t = gridDim.x; asm volatile("" : "+s"(t)); return t; }
__device__ __forceinline__ int clampi(int v, int lo, int hi) { return v < lo ? lo : (v > hi ? hi : v); }

#define XB_TMO      128
#define XB_XCNT(j)  (256  + 64 * (j))
#define XB_XSUB(j)  (1280 + 64 * (j))
#define XB_XGEN(j)  (2304 + 64 * (j))
#define XB_TOP      3328
#define XB_TOPGEN   3392
#define XCD_BAR_WORDS 3456
#define XB_SPIN_CAP (1u << 20)
__device__ __forceinline__ unsigned xb_ld(unsigned* p)              { return __hip_atomic_load(p, __ATOMIC_RELAXED, __HIP_MEMORY_SCOPE_AGENT); }
__device__ __forceinline__ unsigned xb_add(unsigned* p, unsigned v) { return __hip_atomic_fetch_add(p, v, __ATOMIC_RELAXED, __HIP_MEMORY_SCOPE_AGENT); }
__device__ __forceinline__ unsigned xb_xcc_id() { return (unsigned)__builtin_amdgcn_s_getreg((3 << 11) | 20) & 0xFu; }
#define XB_SPIN(cond, bar) do { unsigned _sp = 0; while (cond) { __builtin_amdgcn_s_sleep(1); \
    if ((++_sp & 255u) == 0u) { if (xb_ld(&(bar)[XB_TMO])) break; if (_sp > XB_SPIN_CAP) { atomicAdd(&(bar)[XB_TMO], 1u); break; } } } } while (0)
__device__ __forceinline__ void xcd_barrier_post(unsigned* bar) { if (opaque_tid() == 0) (void)xb_add(&bar[XB_XCNT(xb_xcc_id())], 1u); }
__device__ __forceinline__ void xcd_barrier_complete(unsigned* bar, unsigned x, unsigned& nloc, unsigned& nx) {
    const unsigned G = gridDim.x;
    unsigned sum, cnt, mine, sp = 0u;
    for (;;) {
        sum = 0u; cnt = 0u; mine = 0u;
#pragma unroll
        for (unsigned j = 0; j < 16; ++j) { const unsigned c = xb_ld(&bar[XB_XCNT(j)]); sum += c; cnt += (c > 0u) ? 1u : 0u; mine = (j == x) ? c : mine; }
        if (sum == G) break;
        __builtin_amdgcn_s_sleep(1);
        if ((++sp & 255u) == 0u) { if (xb_ld(&bar[XB_TMO])) break; if (sp > XB_SPIN_CAP) { atomicAdd(&bar[XB_TMO], 1u); break; } }
    }
    nloc = mine > 0u ? mine : 1u; nx = cnt > 0u ? cnt : 1u;
}
__device__ __forceinline__ void xcd_barrier(unsigned* bar, volatile LAS unsigned* st) {
    asm volatile("s_waitcnt vmcnt(0)" ::: "memory");
    __syncthreads();
    if (opaque_tid() == 0) {
        const unsigned x = xb_xcc_id();
        __builtin_amdgcn_s_waitcnt(0);
        unsigned nloc = st[0], nx = st[1];
        if (nloc == 0u) { xcd_barrier_complete(bar, x, nloc, nx); st[0] = nloc; st[1] = nx; }
        const unsigned old = xb_add(&bar[XB_XSUB(x)], 1u);
        const unsigned gen = old / nloc;
        if (old + 1u == (gen + 1u) * nloc) {
            __builtin_amdgcn_fence(__ATOMIC_RELEASE, "agent");
            asm volatile("s_waitcnt vmcnt(0)" ::: "memory");
            const unsigned og = xb_add(&bar[XB_TOP], 1u);
            const unsigned tg = og / nx;
            if (og + 1u == (tg + 1u) * nx) xb_add(&bar[XB_TOPGEN], 1u);
            else XB_SPIN(xb_ld(&bar[XB_TOPGEN]) == tg, bar);
            __builtin_amdgcn_fence(__ATOMIC_ACQUIRE, "agent");
            xb_add(&bar[XB_XGEN(x)], 1u);
            asm volatile("s_waitcnt vmcnt(0)" ::: "memory");
        } else {
            XB_SPIN(xb_ld(&bar[XB_XGEN(x)]) == gen, bar);
            __builtin_amdgcn_fence(__ATOMIC_ACQUIRE, "agent");
            asm volatile("s_waitcnt vmcnt(0)" ::: "memory");
        }
    }
    __syncthreads();
}

namespace pg8 {
constexpr int BM = 256, BK = 64, HALF = 128, HTB = HALF * BK * 2, STAGE_BYTES = 8 * HTB, NXCD = 8, WGM = 8;
__device__ __forceinline__ int lds_byte(int r, int c) { const int st = (r >> 4) * 2 + (c >> 5), rr = r & 15, cc = c & 31, ob = rr * 64 + cc * 2; return st * 1024 + (ob ^ (((ob >> 9) & 1) << 5)); }
__device__ __forceinline__ void stage_rc(int b, int& R, int& C) { const int st = b / 1024, sb = b % 1024, swz = sb ^ (((sb >> 9) & 1) << 5); R = (st >> 1) * 16 + swz / 64; C = (st & 1) * 32 + (swz % 64) / 2; }
__device__ __forceinline__ int perm32(int rho) { const int n = rho >> 4, i = rho & 15; return 8 * (i >> 2) + 4 * n + (i & 3); }
struct Unit { int pm, pn; };
struct Gemm { const bf16_t* A; const bf16_t* Bt; int M, N, K, lda, ldb; };
struct StaticOrder {
    int nM, nN, nwg, G, c;
    __device__ void init(int M, int N, int G_, int c_) { nM = M / BM; nN = N / BM; nwg = nM * nN; G = G_; c = c_; }
    __device__ bool next(int i, Unit& u) const {
        const long L = (long)i * G + c; if (L >= nwg) return false;
        int wgid = (int)L; { const int q = nwg / NXCD, r = nwg % NXCD, xcd = wgid % NXCD, off = wgid / NXCD; wgid = (xcd < r ? xcd * (q + 1) : r * (q + 1) + (xcd - r) * q) + off; }
        const int nig = WGM * nN, gid = wgid / nig, fm = gid * WGM, gsz = (nM - fm) < WGM ? (nM - fm) : WGM;
        u.pm = fm + ((wgid % nig) % gsz); u.pn = (wgid % nig) / gsz; return true;
    }
};

template <class Epi>
__device__ __forceinline__ void gemm_phase(LAS unsigned char* lds, const Gemm g, const StaticOrder& S, const Epi& E) {
    const int tid = opaque_tid(), wid = __builtin_amdgcn_readfirstlane(tid >> 6), lane = tid & 63, wr = wid >> 2, wc = wid & 3, fr = lane & 15, fq = lane >> 4;
    const int K = g.K, nt = K / BK;
    unsigned voffA[2], voffB[2];
#pragma unroll
    for (int i = 0; i < 2; ++i) { int R, C; stage_rc(tid * 16 + i * 8192, R, C); const int Rb = Epi::PERM ? ((R & ~31) + perm32(R & 31)) : R;
        voffA[i] = (unsigned)(R * g.lda + C) * 2u; voffB[i] = (unsigned)(Rb * g.ldb + C) * 2u; }
    const size_t kstep = (size_t)(BK * 2);
    const size_t hstepA = (size_t)HALF * g.lda * 2, hstepB = (size_t)HALF * g.ldb * 2;
    const size_t tstepA = 2 * hstepA, tstepB = 2 * hstepB;
    const unsigned ldsw = (unsigned)wid * 1024u;
    const int aoff = lds_byte(wr * 64 + fr, fq * 8), boff = lds_byte(wc * 32 + fr, fq * 8);
#define PG8_SA(b, h) (((b) * 2 + (h)) * HTB)
#define PG8_SB(b, h) ((4 + (b) * 2 + (h)) * HTB)
#define PG8_STAGE(bufoff, gbase, voff) do { _Pragma("unroll") for (int _i = 0; _i < 2; ++_i) \
        __builtin_amdgcn_global_load_lds((const unsigned*)((const char*)(gbase) + (voff)[_i]), (LAS unsigned*)(lds + (bufoff) + ldsw + _i * 8192), 16, 0, 0); } while (0)
#define PG8_LDA(dst, b, h) do { _Pragma("unroll") for (int m = 0; m < 4; ++m) _Pragma("unroll") for (int k = 0; k < 2; ++k) dst[m][k] = *(const LAS bf16x8*)(lds + PG8_SA(b, h) + aoff + m * 2048 + k * 1024); } while (0)
#define PG8_LDB(dst, b, h) do { _Pragma("unroll") for (int n = 0; n < 2; ++n) _Pragma("unroll") for (int k = 0; k < 2; ++k) dst[n][k] = *(const LAS bf16x8*)(lds + PG8_SB(b, h) + boff + n * 2048 + k * 1024); } while (0)
#define PG8_MMA(ai, bj, At, Bt) do { __builtin_amdgcn_s_setprio(1); _Pragma("unroll") for (int m = 0; m < 4; ++m) _Pragma("unroll") for (int n = 0; n < 2; ++n) _Pragma("unroll") for (int k = 0; k < 2; ++k) \
        acc[ai][bj][m][n] = __builtin_amdgcn_mfma_f32_16x16x32_bf16(Bt[n][k], At[m][k], acc[ai][bj][m][n], 0, 0, 0); __builtin_amdgcn_s_setprio(0); } while (0)
#define PG8_WAIT_V(n) asm volatile("s_waitcnt vmcnt(" #n ")" ::: "memory")
#define PG8_WAIT_L(n) asm volatile("s_waitcnt lgkmcnt(" #n ")" ::: "memory")
#define PG8_BAR __builtin_amdgcn_s_barrier()
#define PG8_SCHED __builtin_amdgcn_sched_barrier(0)
    Unit cur, nxt; int ui = 0;
    if (!S.next(0, cur)) return;
    f32x4 acc[2][2][4][2];
#pragma unroll
    for (int a = 0; a < 2; ++a)
#pragma unroll
        for (int b = 0; b < 2; ++b)
#pragma unroll
            for (int m = 0; m < 4; ++m)
#pragma unroll
                for (int n = 0; n < 2; ++n) acc[a][b][m][n] = (f32x4){0.f, 0.f, 0.f, 0.f};
    bf16x8 At[4][2], B0[2][2], B1[2][2];
    const char* cA = (const char*)g.A + (size_t)cur.pm * tstepA; const char* cB = (const char*)g.Bt + (size_t)cur.pn * tstepB;
    PG8_STAGE(PG8_SB(0, 0), cB, voffB); PG8_STAGE(PG8_SA(0, 0), cA, voffA); PG8_STAGE(PG8_SB(0, 1), cB + hstepB, voffB); PG8_STAGE(PG8_SA(0, 1), cA + hstepA, voffA);
    if (wr == 1) PG8_BAR;
    PG8_WAIT_V(4); PG8_BAR;
    PG8_STAGE(PG8_SB(1, 0), cB + kstep, voffB); PG8_STAGE(PG8_SA(1, 0), cA + kstep, voffA); PG8_STAGE(PG8_SB(1, 1), cB + hstepB + kstep, voffB);
    PG8_WAIT_V(6); PG8_BAR;
    for (;;) {
        const bool has_next = S.next(ui + 1, nxt);
        const char* nA = has_next ? (const char*)g.A + (size_t)nxt.pm * tstepA : cA; const char* nB = has_next ? (const char*)g.Bt + (size_t)nxt.pn * tstepB : cB;
        for (int t = 0; t < nt; t += 2) {
            const bool last = (t == nt - 2);
            const char* a1 = cA + (size_t)(t + 1) * kstep;
            const char* a2 = last ? nA : cA + (size_t)(t + 2) * kstep; const char* b2 = last ? nB : cB + (size_t)(t + 2) * kstep;
            const char* a3 = a2 + kstep; const char* b3 = b2 + kstep;
            PG8_LDB(B0, 0, 0); PG8_SCHED; PG8_LDA(At, 0, 0); PG8_STAGE(PG8_SA(1, 1), a1 + hstepA, voffA);
            PG8_WAIT_L(8); PG8_BAR; PG8_WAIT_L(0); PG8_MMA(0, 0, At, B0); PG8_BAR; PG8_SCHED;
            PG8_LDB(B1, 0, 1); PG8_STAGE(PG8_SB(0, 0), b2, voffB);
            PG8_BAR; PG8_WAIT_L(0); PG8_MMA(0, 1, At, B1); PG8_BAR;
            PG8_LDA(At, 0, 1); PG8_STAGE(PG8_SA(0, 0), a2, voffA);
            PG8_BAR; PG8_WAIT_L(0); PG8_MMA(1, 0, At, B0); PG8_BAR; PG8_SCHED;
            PG8_STAGE(PG8_SB(0, 1), b2 + hstepB, voffB);
            PG8_WAIT_V(6); PG8_BAR; PG8_MMA(1, 1, At, B1); PG8_BAR;
            PG8_LDB(B0, 1, 0); PG8_SCHED; PG8_LDA(At, 1, 0); PG8_STAGE(PG8_SA(0, 1), a2 + hstepA, voffA);
            PG8_WAIT_L(8); PG8_BAR; PG8_WAIT_L(0); PG8_MMA(0, 0, At, B0); PG8_BAR; PG8_SCHED;
            PG8_LDB(B1, 1, 1); PG8_STAGE(PG8_SB(1, 0), b3, voffB);
            PG8_BAR; PG8_WAIT_L(0); PG8_MMA(0, 1, At, B1); PG8_BAR;
            PG8_LDA(At, 1, 1); PG8_STAGE(PG8_SA(1, 0), a3, voffA);
            PG8_BAR; PG8_WAIT_L(0); PG8_MMA(1, 0, At, B0); PG8_BAR; PG8_SCHED;
            PG8_STAGE(PG8_SB(1, 1), b3 + hstepB, voffB);
            PG8_WAIT_V(6); PG8_BAR; PG8_MMA(1, 1, At, B1); PG8_BAR;
        }
        E(acc, cur, wr, wc, fr, fq);
        if (!has_next) break;
#pragma unroll
        for (int a = 0; a < 2; ++a)
#pragma unroll
            for (int b = 0; b < 2; ++b)
#pragma unroll
                for (int m = 0; m < 4; ++m)
#pragma unroll
                    for (int n = 0; n < 2; ++n) acc[a][b][m][n] = (f32x4){0.f, 0.f, 0.f, 0.f};
        cur = nxt; cA = nA; cB = nB; ++ui;
    }
    PG8_WAIT_V(0);
    if (wr == 0) PG8_BAR;
    PG8_BAR;
#undef PG8_SA
#undef PG8_SB
#undef PG8_STAGE
#undef PG8_LDA
#undef PG8_LDB
#undef PG8_MMA
#undef PG8_WAIT_V
#undef PG8_WAIT_L
#undef PG8_BAR
#undef PG8_SCHED
}
}
using pg8::Unit;

struct EpiSwiglu {
    static constexpr bool PERM = true;
    bf16_t* HID;
    __device__ __forceinline__ void operator()(const f32x4 (&acc)[2][2][4][2], const Unit& u, int wr, int wc, int fr, int fq) const {
        const int row0 = u.pm * 256 + wr * 64 + fr, col0 = u.pn * 128 + wc * 32 + 8 * fq;
#pragma unroll
        for (int ai = 0; ai < 2; ++ai)
#pragma unroll
            for (int m = 0; m < 4; ++m) {
                const int row = row0 + ai * 128 + m * 16;
                float hv[8];
#pragma unroll
                for (int n = 0; n < 2; ++n)
#pragma unroll
                    for (int j = 0; j < 4; ++j) { const float a = acc[ai][0][m][n][j], b = acc[ai][1][m][n][j]; hv[4 * n + j] = a * sigmoidf_(a) * b; }
                u32x4 w; w.x = cvt_pk_bf16(hv[0], hv[1]); w.y = cvt_pk_bf16(hv[2], hv[3]); w.z = cvt_pk_bf16(hv[4], hv[5]); w.w = cvt_pk_bf16(hv[6], hv[7]);
                *(u32x4*)(HID + (size_t)row * FH + col0) = w;
            }
    }
};
struct EpiResid {
    static constexpr bool PERM = false;
    float* Hl; float* Hc; const float* gate; float coef;
    __device__ __forceinline__ void operator()(const f32x4 (&acc)[2][2][4][2], const Unit& u, int wr, int wc, int fr, int fq) const {
        const int row0 = u.pm * 256 + wr * 64 + fr, col0 = u.pn * 256 + wc * 32 + 4 * fq;
#pragma unroll
        for (int ai = 0; ai < 2; ++ai)
#pragma unroll
            for (int m = 0; m < 4; ++m) {
                const int row = row0 + ai * 128 + m * 16;
                float* hp = row < RL ? Hl + (size_t)row * 1024 : Hc + (size_t)(row - RL) * 1024;
                const float* gp = gate + (row < RL ? (row >> 13) : 4) * 9216;
#pragma unroll
                for (int bj = 0; bj < 2; ++bj)
#pragma unroll
                    for (int n = 0; n < 2; ++n) {
                        const int c = col0 + bj * 128 + n * 16;
                        const f32x4 g4 = *(const f32x4*)(gp + c); f32x4 h4 = *(const f32x4*)(hp + c);
                        h4 += (g4 * coef) * acc[ai][bj][m][n];
                        *(f32x4*)(hp + c) = h4;
                    }
            }
    }
};
struct EpiPJ {
    static constexpr bool PERM = true;
    bf16_t* PJ; unsigned char* G8;
    __device__ __forceinline__ void operator()(const f32x4 (&acc)[2][2][4][2], const Unit& u, int wr, int wc, int fr, int fq) const {
        const int row0 = u.pm * 256 + wr * 64 + fr, c0 = wc * 32 + 8 * fq;
        if (u.pn < 9) {
#pragma unroll
            for (int ai = 0; ai < 2; ++ai)
#pragma unroll
                for (int m = 0; m < 4; ++m) {
                    const int row = row0 + ai * 128 + m * 16;
#pragma unroll
                    for (int bj = 0; bj < 2; ++bj) {
                        const f32x4 v0 = acc[ai][bj][m][0], v1 = acc[ai][bj][m][1];
                        u32x4 w; w.x = cvt_pk_bf16(v0[0], v0[1]); w.y = cvt_pk_bf16(v0[2], v0[3]); w.z = cvt_pk_bf16(v1[0], v1[1]); w.w = cvt_pk_bf16(v1[2], v1[3]);
                        *(u32x4*)(PJ + (size_t)row * PJW + u.pn * 256 + bj * 128 + c0) = w;
                    }
                }
        } else {
#pragma unroll
            for (int ai = 0; ai < 2; ++ai)
#pragma unroll
                for (int m = 0; m < 4; ++m) {
                    const int row = row0 + ai * 128 + m * 16;
#pragma unroll
                    for (int bj = 0; bj < 2; ++bj) {
                        unsigned q[8];
#pragma unroll
                        for (int n = 0; n < 2; ++n)
#pragma unroll
                            for (int j = 0; j < 4; ++j) { int v = (int)(sigmoidf_(acc[ai][bj][m][n][j]) * 256.0f); q[4 * n + j] = (unsigned)(v > 255 ? 255 : v); }
                        u32x2 w; w.x = q[0] | (q[1] << 8) | (q[2] << 16) | (q[3] << 24); w.y = q[4] | (q[5] << 8) | (q[6] << 16) | (q[7] << 24);
                        *(u32x2*)(G8 + (size_t)row * 4096 + (u.pn - 9) * 256 + bj * 128 + c0) = w;
                    }
                }
        }
    }
};
struct EpiMLA {
    static constexpr bool PERM = true;
    bf16_t *MQ, *MK, *MV; const float* RSTD; const float2* RT;
    __device__ __forceinline__ void operator()(const f32x4 (&acc)[2][2][4][2], const Unit& u, int wr, int wc, int fr, int fq) const {
        const int row0 = u.pm * 256 + wr * 64 + fr;
#pragma unroll
        for (int bj = 0; bj < 2; ++bj) {
            const int cg0 = u.pn * 256 + bj * 128 + wc * 32;
            if (cg0 >= 896) continue;
#pragma unroll
            for (int ai = 0; ai < 2; ++ai)
#pragma unroll
                for (int m = 0; m < 4; ++m) {
                    __builtin_amdgcn_sched_barrier(0);
                    const int row = row0 + ai * 128 + m * 16;
                    float v[8];
                    if (cg0 < 384) {
                        const float rs = RSTD[row * 2];
#pragma unroll
                        for (int n = 0; n < 2; ++n)
#pragma unroll
                            for (int j = 0; j < 4; ++j) v[4 * n + j] = acc[ai][bj][m][n][j] * rs;
                        const int d0 = cg0 % 96;
                        if (d0 == 64) {
                            const bool lat = row < RL; const int t = row & 8191; const int pos = (fq >> 1) ? (t & 63) : (t >> 6); const bool isx2 = fq & 1;
#pragma unroll
                            for (int e = 0; e < 8; ++e) {
                                const float pr = shflx(v[e], 16);
                                const float2 cs = RT[pos * 8 + e];
                                const float r = isx2 ? (pr * cs.y + v[e] * cs.x) : (v[e] * cs.x - pr * cs.y);
                                v[e] = lat ? r : v[e];
                            }
                        }
                        u32x4 w; w.x = cvt_pk_bf16(v[0], v[1]); w.y = cvt_pk_bf16(v[2], v[3]); w.z = cvt_pk_bf16(v[4], v[5]); w.w = cvt_pk_bf16(v[6], v[7]);
                        *(u32x4*)(MQ + (size_t)row * 384 + cg0 + 8 * fq) = w;
                    } else {
                        const float rs = RSTD[row * 2 + 1];
#pragma unroll
                        for (int n = 0; n < 2; ++n)
#pragma unroll
                            for (int j = 0; j < 4; ++j) v[4 * n + j] = acc[ai][bj][m][n][j] * rs;
                        const int cp = cg0 - 384, hd = cp >> 7, d0 = cp & 127;
                        u32x4 w; w.x = cvt_pk_bf16(v[0], v[1]); w.y = cvt_pk_bf16(v[2], v[3]); w.z = cvt_pk_bf16(v[4], v[5]); w.w = cvt_pk_bf16(v[6], v[7]);
                        if (d0 < 64) *(u32x4*)(MK + (size_t)row * 384 + hd * 96 + d0 + 8 * fq) = w;
                        else *(u32x4*)(MV + (size_t)row * 256 + hd * 64 + (d0 - 64) + 8 * fq) = w;
                    }
                }
        }
    }
};
struct EpiMerge {
    static constexpr bool PERM = true;
    const unsigned char* G8; float* MF; bf16_t* MG; int bi;
    __device__ __forceinline__ void operator()(const f32x4 (&acc)[2][2][4][2], const Unit& u, int wr, int wc, int fr, int fq) const {
        const int row0 = u.pm * 256 + wr * 64 + fr, c0 = u.pn * 256 + wc * 32 + 8 * fq;
#pragma unroll
        for (int ai = 0; ai < 2; ++ai)
#pragma unroll
            for (int m = 0; m < 4; ++m) {
                const int row = row0 + ai * 128 + m * 16;
#pragma unroll
                for (int bj = 0; bj < 2; ++bj) {
                    __builtin_amdgcn_sched_barrier(0);
                    const int c = c0 + bj * 128;
                    const u32x2 gq = *(const u32x2*)(G8 + (size_t)row * 4096 + bi * 1024 + c);
                    float v[8];
#pragma unroll
                    for (int e = 0; e < 8; ++e) { const unsigned q = ((e < 4 ? gq.x : gq.y) >> (8 * (e & 3))) & 255u; v[e] = ((float)q + 0.5f) * (1.0f / 256.0f) * acc[ai][bj][m][e >> 2][e & 3]; }
                    float* mp = MF + (size_t)row * 1024 + c;
                    if (bi > 0) { const f32x4 p0 = *(const f32x4*)mp, p1 = *(const f32x4*)(mp + 4);
#pragma unroll
                        for (int e = 0; e < 4; ++e) { v[e] += p0[e]; v[4 + e] += p1[e]; } }
                    if (bi < 3) { *(f32x4*)mp = (f32x4){v[0], v[1], v[2], v[3]}; *(f32x4*)(mp + 4) = (f32x4){v[4], v[5], v[6], v[7]}; }
                    else { u32x4 w; w.x = cvt_pk_bf16(v[0], v[1]); w.y = cvt_pk_bf16(v[2], v[3]); w.z = cvt_pk_bf16(v[4], v[5]); w.w = cvt_pk_bf16(v[6], v[7]);
                        *(u32x4*)(MG + (size_t)row * 1024 + c) = w; }
                }
            }
    }
};

template <class F>
__device__ __forceinline__ void wt_rows64(bf16_t* dst, int K, F srcval) {
    const int tid_ = opaque_tid(); const int nl = tid_ & 63, kq = tid_ >> 6;
    for (int k0 = kq * 8; k0 < K; k0 += 64) {
        float v[8];
#pragma unroll
        for (int j = 0; j < 8; ++j) v[j] = srcval(nl, k0 + j);
        u32x4 w; w.x = cvt_pk_bf16(v[0], v[1]); w.y = cvt_pk_bf16(v[2], v[3]); w.z = cvt_pk_bf16(v[4], v[5]); w.w = cvt_pk_bf16(v[6], v[7]);
        *(u32x4*)(dst + (size_t)nl * K + k0) = w;
    }
}

__device__ void layer_prep_phase(PK p, int l, LAS unsigned char* lds) {
    unsigned char* ws = p->ws;
    const int nW = 404, nItems = nW + (l == 0 ? 288 + 1 : 0);
    for (int it = opaque_bid(); it < nItems; it += opaque_gdim()) {
        if (it < 176) {
            const int f = it / 88, j = it % 88; const float* src = p->ffn_w_in + ((size_t)(l * 2 + f) * 1024) * 5632;
            bf16_t* dst = (bf16_t*)(ws + OFF_W1) + ((size_t)f * 5632 + j * 64) * 1024;
            wt_rows64(dst, 1024, [&](int nl, int k) { const int np = j * 64 + nl, pn = np >> 8, wi = np & 255; const int col = wi < 128 ? pn * 128 + wi : FH + pn * 128 + (wi - 128); return src[(size_t)k * 5632 + col]; });
        } else if (it < 208) {
            const int q = it - 176, f = q / 16, j = q % 16; const float* src = p->ffn_w_out + ((size_t)(l * 2 + f) * FH) * 1024;
            bf16_t* dst = (bf16_t*)(ws + OFF_W2) + ((size_t)f * 1024 + j * 64) * FH;
            wt_rows64(dst, FH, [&](int nl, int k) { return src[(size_t)k * 1024 + j * 64 + nl]; });
        } else if (it < 308) {
            const int j = it - 208; const float* src = p->mix_w_in + (size_t)l * 1024 * 6304;
            bf16_t* dst = (bf16_t*)(ws + OFF_WM) + (size_t)j * 64 * 1024;
            wt_rows64(dst, 1024, [&](int nl, int k) { const int np = j * 64 + nl; const int col = np < 2208 ? np : (np < 2304 ? -1 : np - 96); return col < 0 ? 0.f : src[(size_t)k * 6304 + col]; });
        } else if (it < 324) {
            const int j = it - 308; const float* src = p->mix_w_out + (size_t)l * 1024 * 1024;
            bf16_t* dst = (bf16_t*)(ws + OFF_WO) + (size_t)j * 64 * 1024;
            wt_rows64(dst, 1024, [&](int nl, int k) { return src[(size_t)k * 1024 + j * 64 + nl]; });
        } else if (it < 372) {
            const int q = it - 324, bi = 1 + q / 16, j = q % 16; const float* src = p->branch_w_out + ((size_t)(l * 4 + bi) * 256) * 1024;
            bf16_t* dst = (bf16_t*)(ws + OFF_WB) + ((size_t)bi * 1024 + j * 64) * 256;
            wt_rows64(dst, 256, [&](int nl, int k) { return src[(size_t)k * 1024 + j * 64 + nl]; });
        } else if (it < 388) {
            const int j = it - 372; const float* wb = p->branch_w_out + ((size_t)(l * 4) * 256) * 1024; const float* pw = p->pool_w + (size_t)l * 4 * 64 * 64; const float* ps = p->pool_scale + l * 256;
            bf16_t* dst = (bf16_t*)(ws + OFF_WB) + (size_t)j * 64 * 256;
            wt_rows64(dst, 256, [&](int nl, int k) { const int gI = k >> 6, n = j * 64 + nl; const float* pr = pw + (size_t)k * 64; float s = 0.f;
                for (int e = 0; e < 64; ++e) s += pr[e] * ps[gI * 64 + e] * wb[(size_t)(gI * 64 + e) * 1024 + n]; return s; });
        } else if (it < 404) {
            const int j = it - 388; const float* wq = p->mla_w_qb + (size_t)l * 256 * 384; const float* wk = p->mla_w_kvb + (size_t)l * 128 * 512;
            const float* gq = p->mla_q_norm_g + l * 256; const float* gk = p->mla_kv_norm_g + l * 128;
            bf16_t* dst = (bf16_t*)(ws + OFF_WL) + (size_t)j * 64 * 384;
            wt_rows64(dst, 384, [&](int nl, int k) { const int n = j * 64 + nl;
                if (n < 384) return k < 256 ? gq[k] * wq[(size_t)k * 384 + n] : 0.f;
                if (n < 896) return k >= 256 ? gk[k - 256] * wk[(size_t)(k - 256) * 512 + (n - 384)] : 0.f;
                return 0.f; });
        } else if (it < 404 + 288) {
            const int q = it - 404, ll = q / 144, cb = q % 144;
            LAS float* sc = (LAS float*)lds;
            LAS float* red = (LAS float*)(lds + 5 * 1024 * 4);
            __syncthreads();
            for (int i = opaque_tid(); i < 5 * 1024; i += 512) { const int r = i >> 10, k = i & 1023; const float cv = r < 4 ? p->c[r * 1024 + k] : p->c_ctx[k]; sc[i] = cv * sigmoidf_(cv); }
            __syncthreads();
            const int jl = opaque_tid() & 63, kg = opaque_tid() >> 6; const int col = cb * 64 + jl;
            const float* wsrc = p->ada_w + (size_t)ll * 1024 * 9216 + col;
            float a0 = 0.f, a1 = 0.f, a2 = 0.f, a3 = 0.f, a4 = 0.f;
            for (int k = kg * 128; k < kg * 128 + 128; ++k) { const float wv = wsrc[(size_t)k * 9216]; a0 += sc[k] * wv; a1 += sc[1024 + k] * wv; a2 += sc[2048 + k] * wv; a3 += sc[3072 + k] * wv; a4 += sc[4096 + k] * wv; }
            red[(kg * 5 + 0) * 64 + jl] = a0; red[(kg * 5 + 1) * 64 + jl] = a1; red[(kg * 5 + 2) * 64 + jl] = a2; red[(kg * 5 + 3) * 64 + jl] = a3; red[(kg * 5 + 4) * 64 + jl] = a4;
            __syncthreads();
            if (opaque_tid() < 320) { const int r = opaque_tid() >> 6; float s = p->ada_b[ll * 9216 + col];
                for (int q2 = 0; q2 < 8; ++q2) s += red[(q2 * 5 + r) * 64 + jl];
                ((float*)(ws + OFF_MOD))[(size_t)(ll * 5 + r) * 9216 + col] = s; }
        } else {
            for (int i = opaque_tid(); i < 1024; i += 512) { const int pos = i >> 3, fi = i & 7; const float inv = exp2f(-(float)fi * 0.125f * 13.287712379549449f); const float ang = (float)pos * inv;
                ((float2*)(ws + OFF_ROPE))[i] = make_float2(cosf(ang), sinf(ang)); }
        }
    }
}

__device__ void norm_mod_phase(const float* srcL, const float* srcC, float* cpyL, float* cpyC, const float* g, const float* mod, bf16_t* TN, int nrows) {
    const int tid_ = opaque_tid(); const int lane = tid_ & 63, gw = opaque_bid() * 8 + (tid_ >> 6), nw = opaque_gdim() * 8;
    for (int row = gw; row < nrows; row += nw) {
        const bool lat = row < RL;
        const float* sp = lat ? srcL + (size_t)row * 1024 : srcC + (size_t)(row - RL) * 1024;
        const float* mp = mod + (lat ? (row >> 13) : 4) * 9216;
        f32x4 v[4]; float ss = 0.f;
#pragma unroll
        for (int j = 0; j < 4; ++j) { v[j] = *(const f32x4*)(sp + 256 * j + 4 * lane); ss += v[j][0] * v[j][0] + v[j][1] * v[j][1] + v[j][2] * v[j][2] + v[j][3] * v[j][3]; }
        if (cpyL) { float* cp = lat ? cpyL + (size_t)row * 1024 : cpyC + (size_t)(row - RL) * 1024;
#pragma unroll
            for (int j = 0; j < 4; ++j) *(f32x4*)(cp + 256 * j + 4 * lane) = v[j]; }
        ss = wave_sum(ss);
        const float rstd = rsqrtf(ss * (1.0f / 1024.0f) + NEPS);
#pragma unroll
        for (int j = 0; j < 4; ++j) {
            const int col = 256 * j + 4 * lane;
            const f32x4 gg = *(const f32x4*)(g + col), sh = *(const f32x4*)(mp + col), sc = *(const f32x4*)(mp + 1024 + col);
            float o[4];
#pragma unroll
            for (int e = 0; e < 4; ++e) o[e] = (v[j][e] * rstd * gg[e]) * (1.0f + sc[e]) + sh[e];
            u32x2 w; w.x = cvt_pk_bf16(o[0], o[1]); w.y = cvt_pk_bf16(o[2], o[3]);
            *(u32x2*)(TN + (size_t)row * 1024 + col) = w;
        }
    }
}
__device__ void final_norm_phase(float* H, const float* g) {
    const int tid_ = opaque_tid(); const int lane = tid_ & 63, gw = opaque_bid() * 8 + (tid_ >> 6), nw = opaque_gdim() * 8;
    for (int row = gw; row < RL; row += nw) {
        float* sp = H + (size_t)row * 1024; f32x4 v[4]; float ss = 0.f;
#pragma unroll
        for (int j = 0; j < 4; ++j) { v[j] = *(const f32x4*)(sp + 256 * j + 4 * lane); ss += v[j][0] * v[j][0] + v[j][1] * v[j][1] + v[j][2] * v[j][2] + v[j][3] * v[j][3]; }
        ss = wave_sum(ss);
        const float rstd = rsqrtf(ss * (1.0f / 1024.0f) + NEPS);
#pragma unroll
        for (int j = 0; j < 4; ++j) { const f32x4 gg = *(const f32x4*)(g + 256 * j + 4 * lane); *(f32x4*)(sp + 256 * j + 4 * lane) = v[j] * rstd * gg; }
    }
}

__device__ void prep_phase(PK p) {
    unsigned char* ws = p->ws;
    bf16_t* PJ = (bf16_t*)(ws + OFF_B); bf16_t* YB = (bf16_t*)(ws + OFF_A); bf16_t* MK = (bf16_t*)(ws + OFF_MK); float* RSTD = (float*)(ws + OFF_RSTD);
    const float2* RT = (const float2*)(ws + OFF_ROPE);
    const int tid_ = opaque_tid(); const int lane = tid_ & 63, gw = opaque_bid() * 8 + (tid_ >> 6), nw = opaque_gdim() * 8;
    for (int row = gw; row < RA; row += nw) {
        const bool lat = row < RL;
        int t, n; if (lat) { t = row & 8191; n = 8192; } else { t = (row - RL) & 255; n = 256; }
        const int sbase = row - t;
        bf16_t* prow = PJ + (size_t)row * PJW;
        {
            const int wdw = 2 << (lane >> 4); const int lo = max(t - wdw / 2, 0), hi = min(t - wdw / 2 + wdw, n);
            float s0 = 0.f, s1 = 0.f, s2 = 0.f, s3 = 0.f;
            for (int tt = lo; tt < hi; ++tt) { const u32x2 v = *(const u32x2*)(PJ + (size_t)(sbase + tt) * PJW + 4 * lane); s0 += bf_lo(v.x); s1 += bf_hi(v.x); s2 += bf_lo(v.y); s3 += bf_hi(v.y); }
            const float ic = 1.0f / (float)(hi - lo); const u32x2 sv = *(const u32x2*)(prow + 4 * lane);
            u32x2 w; w.x = cvt_pk_bf16(s0 * ic - bf_lo(sv.x), s1 * ic - bf_hi(sv.x)); w.y = cvt_pk_bf16(s2 * ic - bf_lo(sv.y), s3 * ic - bf_hi(sv.y));
            *(u32x2*)(YB + (size_t)row * 1024 + 4 * lane) = w;
        }
        {
            const u32x2 q = *(const u32x2*)(prow + C_MQ + 4 * lane); const unsigned kv = *(const unsigned*)(prow + C_MKV + 2 * lane);
            float sq = bf_lo(q.x) * bf_lo(q.x) + bf_hi(q.x) * bf_hi(q.x) + bf_lo(q.y) * bf_lo(q.y) + bf_hi(q.y) * bf_hi(q.y);
            float sk = bf_lo(kv) * bf_lo(kv) + bf_hi(kv) * bf_hi(kv);
            sq = wave_sum(sq); sk = wave_sum(sk);
            if (lane == 0) { RSTD[row * 2] = rsqrtf(sq * (1.0f / 256.0f) + NEPS); RSTD[row * 2 + 1] = rsqrtf(sk * (1.0f / 128.0f) + NEPS); }
        }
        if (lane < 34) {
            const bool iskr = lane >= 32; const int a = lane & 1;
            bf16_t* ep = iskr ? prow + C_MKR + a * 16 : prow + ((lane >> 4) ? C_DK : C_DQ) + ((lane >> 1) & 7) * 32 + a * 16;
            const u32x4 e0 = *(const u32x4*)ep, e1 = *(const u32x4*)(ep + 8);
            float x1[8], x2[8];
            x1[0] = bf_lo(e0.x); x1[1] = bf_hi(e0.x); x1[2] = bf_lo(e0.y); x1[3] = bf_hi(e0.y); x1[4] = bf_lo(e0.z); x1[5] = bf_hi(e0.z); x1[6] = bf_lo(e0.w); x1[7] = bf_hi(e0.w);
            x2[0] = bf_lo(e1.x); x2[1] = bf_hi(e1.x); x2[2] = bf_lo(e1.y); x2[3] = bf_hi(e1.y); x2[4] = bf_lo(e1.z); x2[5] = bf_hi(e1.z); x2[6] = bf_lo(e1.w); x2[7] = bf_hi(e1.w);
            if (lat) { const int pos = a ? (t & 63) : (t >> 6);
#pragma unroll
                for (int i = 0; i < 8; ++i) { const float2 cs = RT[pos * 8 + i]; const float o1 = x1[i] * cs.x - x2[i] * cs.y, o2 = x1[i] * cs.y + x2[i] * cs.x; x1[i] = o1; x2[i] = o2; } }
            u32x4 w0, w1; w0.x = cvt_pk_bf16(x1[0], x1[1]); w0.y = cvt_pk_bf16(x1[2], x1[3]); w0.z = cvt_pk_bf16(x1[4], x1[5]); w0.w = cvt_pk_bf16(x1[6], x1[7]);
            w1.x = cvt_pk_bf16(x2[0], x2[1]); w1.y = cvt_pk_bf16(x2[2], x2[3]); w1.z = cvt_pk_bf16(x2[4], x2[5]); w1.w = cvt_pk_bf16(x2[6], x2[7]);
            if (iskr) {
#pragma unroll
                for (int hh = 0; hh < 4; ++hh) { bf16_t* kp = MK + (size_t)row * 384 + hh * 96 + 64 + a * 16; *(u32x4*)kp = w0; *(u32x4*)(kp + 8) = w1; }
            } else if (lat) { *(u32x4*)ep = w0; *(u32x4*)(ep + 8) = w1; }
        }
    }
}

#define MFMA32(a, b, c) __builtin_amdgcn_mfma_f32_32x32x16_bf16((a), (b), (c), 0, 0, 0)
template <int MODE>
__device__ __forceinline__ void attn_item(PK p, int l, LAS unsigned char* lds, int b, int h, int qb, bool ctxq, float lam, float lam_init) {
    constexpr int NCOMP = (MODE == 1) ? 2 : 1, NKS = (MODE == 0) ? 4 : ((MODE == 1) ? 2 : 6), KW = NCOMP * NKS * 16, KCH = KW / 8, KSTR = KW * 2 + 16, VSTR = 192;
    constexpr int KBUF = 64 * KSTR, VBUF = 64 * VSTR, BUFSZ = KBUF + VBUF, BIAS_OFF = 2 * BUFSZ;
    const int tid = opaque_tid(), w = tid >> 6, lane = tid & 63, g = lane >> 5, l32 = lane & 31;
    unsigned char* ws = p->ws;
    const bf16_t* PJ = (const bf16_t*)(ws + OFF_B);
    const bf16_t *Qp, *Kp, *Vp; int ldq, ldk, ldv, outoff; float scale;
    if (MODE == 0) { Qp = PJ + C_NQ + 64 * h; Kp = PJ + C_NK + 64 * h; Vp = PJ + C_NV + 64 * h; ldq = ldk = ldv = PJW; outoff = 256 + 64 * h; scale = 0.125f; }
    else if (MODE == 1) { Qp = PJ + C_DQ + 64 * h; Kp = PJ + C_DK + 64 * h; Vp = PJ + C_DV + 64 * h; ldq = ldk = ldv = PJW; outoff = 512 + 64 * h; scale = 0.17677669529663687f; }
    else { Qp = (const bf16_t*)(ws + OFF_D) + 96 * h; Kp = (const bf16_t*)(ws + OFF_MK) + 96 * h; Vp = (const bf16_t*)(ws + OFF_MV) + 64 * h; ldq = ldk = 384; ldv = 256; outoff = 768 + 64 * h; scale = 0.10206207261596575f; }
    const float cs = scale * LOG2E;
    int qrow0, loc0, nloc;
    if (ctxq) { qrow0 = RL + b * 256; loc0 = 0; nloc = 0; }
    else { qrow0 = b * 8192 + qb * 256;
        if (MODE == 0) { const int r0 = qb * 4; loc0 = clampi(r0 - 4, 0, 120); nloc = clampi(r0 - 1, 0, 120) + 8 - loc0; } else { loc0 = 0; nloc = 128; } }
    const int nt = nloc + 4;
    const bool nabias = (MODE == 0) && !ctxq;
    const int rw = qb * 4 + (w >> 1), sw = clampi(rw - 4, 0, 120);
    const int jq = 32 * (w & 1) + l32, cst = clampi(jq - 8, 0, 48);
    if (nabias && tid < 465) ((LAS float*)(lds + BIAS_OFF))[tid] = p->na_rpb[(size_t)(l * 4 + h) * 465 + tid] * LOG2E;

    const size_t qrow = (size_t)qrow0 + 32 * w + l32;
    bf16x8 qf[NCOMP * NKS];
#pragma unroll
    for (int i = 0; i < NCOMP * NKS; ++i) qf[i] = *(const bf16x8*)(Qp + qrow * ldq + 16 * i + 8 * g);

    const int kr0 = tid / KCH, kc0 = tid % KCH, kr1 = (tid + 512) / KCH, kc1 = (tid + 512) % KCH, vr = tid >> 3, vc = tid & 7;
    const bool hask1 = (KCH == 12) && (tid < 256);
    u32x4 rk0, rk1 = (u32x4){0u, 0u, 0u, 0u}, rv;
#define TILE_ROW(t) ((t) < nloc ? (b * 8192 + 64 * (loc0 + (t))) : (RL + b * 256 + 64 * ((t) - nloc)))
#define LOAD_TILE(t) do { const size_t _tb = (size_t)TILE_ROW(t); rk0 = *(const u32x4*)(Kp + (_tb + kr0) * ldk + kc0 * 8); \
        if (hask1) rk1 = *(const u32x4*)(Kp + (_tb + kr1) * ldk + kc1 * 8); rv = *(const u32x4*)(Vp + (_tb + vr) * ldv + vc * 8); } while (0)
#define STORE_TILE(buf) do { LAS unsigned char* _kb = lds + (buf) * BUFSZ; *(LAS u32x4*)(_kb + kr0 * KSTR + kc0 * 16) = rk0; \
        if (hask1) *(LAS u32x4*)(_kb + kr1 * KSTR + kc1 * 16) = rk1; *(LAS u32x4*)(_kb + KBUF + vr * VSTR + vc * 16) = rv; } while (0)

    float mrun[NCOMP], lsum[NCOMP]; f32x16 O[NCOMP][2];
#pragma unroll
    for (int c = 0; c < NCOMP; ++c) { mrun[c] = -1e30f; lsum[c] = 0.f;
#pragma unroll
        for (int dt = 0; dt < 2; ++dt)
#pragma unroll
            for (int r = 0; r < 16; ++r) O[c][dt][r] = 0.f; }

    LOAD_TILE(0); STORE_TILE(0); __syncthreads();
    const int koff = l32 * KSTR + g * 16;
    const int i16 = lane & 15, tq = i16 >> 2, tp = i16 & 3, blk = (lane >> 4) & 1;
    const int voff = (4 * g + tq) * VSTR + (16 * blk + 4 * tp) * 2;

    for (int t = 0; t < nt; ++t) {
        const bool more = (t + 1 < nt);
        if (more) LOAD_TILE(t + 1);
        bool active = true; int krow = 0;
        if (nabias && t < nloc) { krow = loc0 + t; active = (krow >= sw) && (krow < sw + 8); }
        if (active) {
            LAS unsigned char* Kb = lds + (t & 1) * BUFSZ; LAS unsigned char* Vb = Kb + KBUF;
            bf16x8 pf[NCOMP][2][2];
#pragma unroll
            for (int c = 0; c < NCOMP; ++c) {
                f32x16 S[2];
#pragma unroll
                for (int kt = 0; kt < 2; ++kt) {
#pragma unroll
                    for (int r = 0; r < 16; ++r) S[kt][r] = 0.f;
#pragma unroll
                    for (int ks = 0; ks < NKS; ++ks) { const bf16x8 kf = *(const LAS bf16x8*)(Kb + koff + kt * 32 * KSTR + (c * NKS + ks) * 32); S[kt] = MFMA32(kf, qf[c * NKS + ks], S[kt]); }
                }
                float mx = -1e30f;
                if (nabias && t < nloc) {
                    const LAS float* bt = (const LAS float*)(lds + BIAS_OFF) + (krow - rw + 7) * 31;
#pragma unroll
                    for (int kt = 0; kt < 2; ++kt)
#pragma unroll
                        for (int r = 0; r < 16; ++r) { const int jk = 32 * kt + (r & 3) + 8 * (r >> 2) + 4 * g; const bool ok = (jk >= cst) && (jk < cst + 16);
                            const float bv = bt[clampi(jk - jq + 15, 0, 30)]; const float xv = ok ? (S[kt][r] * cs + bv) : -1e30f; S[kt][r] = xv; mx = fmaxf(mx, xv); }
                } else {
#pragma unroll
                    for (int kt = 0; kt < 2; ++kt)
#pragma unroll
                        for (int r = 0; r < 16; ++r) { const float xv = S[kt][r] * cs; S[kt][r] = xv; mx = fmaxf(mx, xv); }
                }
                mx = fmaxf(mx, shflx(mx, 32));
                const float mnew = fmaxf(mrun[c], mx);
                if (__any(mnew > mrun[c])) {
                    const float alpha = fast_exp2(mrun[c] - mnew); lsum[c] *= alpha;
#pragma unroll
                    for (int dt = 0; dt < 2; ++dt)
#pragma unroll
                        for (int r = 0; r < 16; ++r) O[c][dt][r] *= alpha;
                    mrun[c] = mnew;
                }
                float rs = 0.f;
#pragma unroll
                for (int kt = 0; kt < 2; ++kt)
#pragma unroll
                    for (int r = 0; r < 16; ++r) { const float pv = fast_exp2(S[kt][r] - mnew); S[kt][r] = pv; rs += pv; }
                lsum[c] += rs;
#pragma unroll
                for (int kt = 0; kt < 2; ++kt)
#pragma unroll
                    for (int s = 0; s < 2; ++s) { u32x4 pk; pk.x = cvt_pk_bf16(S[kt][8 * s], S[kt][8 * s + 1]); pk.y = cvt_pk_bf16(S[kt][8 * s + 2], S[kt][8 * s + 3]);
                        pk.z = cvt_pk_bf16(S[kt][8 * s + 4], S[kt][8 * s + 5]); pk.w = cvt_pk_bf16(S[kt][8 * s + 6], S[kt][8 * s + 7]); pf[c][kt][s] = __builtin_bit_cast(bf16x8, pk); }
            }
#pragma unroll
            for (int kt = 0; kt < 2; ++kt)
#pragma unroll
                for (int s = 0; s < 2; ++s)
#pragma unroll
                    for (int dt = 0; dt < 2; ++dt) {
                        LAS unsigned char* vp = Vb + voff + (32 * kt + 16 * s) * VSTR + dt * 64;
                        const s16x4 lo = __builtin_amdgcn_ds_read_tr16_b64_v4i16((LAS s16x4*)vp);
                        const s16x4 hi = __builtin_amdgcn_ds_read_tr16_b64_v4i16((LAS s16x4*)(vp + 8 * VSTR));
                        const bf16x8 vf = __builtin_shufflevector(lo, hi, 0, 1, 2, 3, 4, 5, 6, 7);
#pragma unroll
                        for (int c = 0; c < NCOMP; ++c) O[c][dt] = MFMA32(vf, pf[c][kt][s], O[c][dt]);
                    }
        }
        if (more) STORE_TILE((t + 1) & 1);
        __syncthreads();
    }
#undef TILE_ROW
#undef LOAD_TILE
#undef STORE_TILE
    float inv[NCOMP];
#pragma unroll
    for (int c = 0; c < NCOMP; ++c) { const float lt = lsum[c] + shflx(lsum[c], 32); inv[c] = 1.0f / lt; }
    bf16_t* op = (bf16_t*)(ws + OFF_A) + qrow * 1024 + outoff;
    if (MODE == 1) {
        const float li1 = lam * inv[NCOMP - 1]; float ss = 0.f;
#pragma unroll
        for (int dt = 0; dt < 2; ++dt)
#pragma unroll
            for (int r = 0; r < 16; ++r) { const float o = O[0][dt][r] * inv[0] - li1 * O[NCOMP - 1][dt][r]; O[0][dt][r] = o; ss += o * o; }
        ss += shflx(ss, 32);
        const float rstd = rsqrtf(ss * (1.0f / 64.0f) + NEPS) * (1.0f - lam_init);
        const float* sg = p->diff_subln_g + l * 64;
#pragma unroll
        for (int dt = 0; dt < 2; ++dt)
#pragma unroll
            for (int rq = 0; rq < 4; ++rq) { const int dv = 32 * dt + 8 * rq + 4 * g; const f32x4 gg = *(const f32x4*)(sg + dv);
                u32x2 wv; wv.x = cvt_pk_bf16(O[0][dt][4 * rq] * rstd * gg[0], O[0][dt][4 * rq + 1] * rstd * gg[1]); wv.y = cvt_pk_bf16(O[0][dt][4 * rq + 2] * rstd * gg[2], O[0][dt][4 * rq + 3] * rstd * gg[3]);
                *(u32x2*)(op + dv) = wv; }
    } else {
#pragma unroll
        for (int dt = 0; dt < 2; ++dt)
#pragma unroll
            for (int rq = 0; rq < 4; ++rq) { const int dv = 32 * dt + 8 * rq + 4 * g;
                u32x2 wv; wv.x = cvt_pk_bf16(O[0][dt][4 * rq] * inv[0], O[0][dt][4 * rq + 1] * inv[0]); wv.y = cvt_pk_bf16(O[0][dt][4 * rq + 2] * inv[0], O[0][dt][4 * rq + 3] * inv[0]);
                *(u32x2*)(op + dv) = wv; }
    }
}

__device__ void attn_phase(PK p, int l, LAS unsigned char* lds) {
    const float lam_init = (l == 0) ? 0.2f : 0.35550906759502f;
    const float* dl = p->diff_lambda + l * 128;
    float d01 = 0.f, d23 = 0.f;
    for (int i = 0; i < 32; ++i) { d01 += dl[i] * dl[32 + i]; d23 += dl[64 + i] * dl[96 + i]; }
    const float lam = expf(d01) - expf(d23) + lam_init;
    const int nItems = 1536 + (l == 0 ? 48 : 0);
    for (int it = opaque_bid(); it < nItems; it += opaque_gdim()) {
        if (it < 1536) {
            const int ty = it >> 9, idx = it & 511, b = idx >> 7, h = (idx >> 5) & 3, qb = idx & 31;
            if (ty == 0) attn_item<1>(p, l, lds, b, h, qb, false, lam, lam_init);
            else if (ty == 1) attn_item<2>(p, l, lds, b, h, qb, false, lam, lam_init);
            else attn_item<0>(p, l, lds, b, h, qb, false, lam, lam_init);
        } else {
            const int idx = it - 1536, ty = idx >> 4, b = (idx >> 2) & 3, h = idx & 3;
            if (ty == 0) attn_item<1>(p, l, lds, b, h, 0, true, lam, lam_init);
            else if (ty == 1) attn_item<2>(p, l, lds, b, h, 0, true, lam, lam_init);
            else attn_item<0>(p, l, lds, b, h, 0, true, lam, lam_init);
        }
    }
}

constexpr int PH_PER_LAYER = 14, N_PHASES = 2 * PH_PER_LAYER + 1;

__device__ __forceinline__ void run_phase(PK p, int ph, LAS unsigned char* lds, float rcoef) {
    unsigned char* ws = p->ws;
    pg8::StaticOrder S;
    if (ph == N_PHASES - 1) { final_norm_phase(p->out, p->final_norm_g); return; }
    int l = ph / PH_PER_LAYER; const int q = ph % PH_PER_LAYER;
#define OPQL asm volatile("" : "+s"(l))
#define HC ((float*)(ws + OFF_HC))
#define MOD ((const float*)(ws + OFF_MOD) + (size_t)l * 5 * 9216)
#define TN ((bf16_t*)(ws + OFF_A))
#define HID ((bf16_t*)(ws + OFF_B))
#define Mlate ((l == 0) ? RA : RL)
    switch (q) {
    case 0: OPQL; layer_prep_phase(p, l, lds); break;
    case 1: OPQL; if (l == 0) norm_mod_phase(p->x, p->ctx, p->out, HC, p->norm_g + (l * 3 + 0) * 1024, MOD, TN, RA);
            else norm_mod_phase(p->out, HC, nullptr, nullptr, p->norm_g + (l * 3 + 0) * 1024, MOD, TN, RA); break;
    case 2: case 12: { OPQL; const int f = (q == 2) ? 0 : 1; const int M = (q == 2) ? RA : Mlate;
        pg8::Gemm g{TN, (const bf16_t*)(ws + OFF_W1) + (size_t)f * 5632 * 1024, M, 5632, 1024, 1024, 1024}; S.init(M, 5632, opaque_gdim(), opaque_bid());
        EpiSwiglu E{HID}; pg8::gemm_phase(lds, g, S, E); } break;
    case 3: case 13: { OPQL; const int f = (q == 3) ? 0 : 1; const int M = (q == 3) ? RA : Mlate;
        pg8::Gemm g{HID, (const bf16_t*)(ws + OFF_W2) + (size_t)f * 1024 * FH, M, 1024, FH, FH, FH}; S.init(M, 1024, opaque_gdim(), opaque_bid());
        EpiResid E{p->out, HC, MOD + (q == 3 ? 2 : 8) * 1024, 0.5f * rcoef}; pg8::gemm_phase(lds, g, S, E); } break;
    case 4: OPQL; norm_mod_phase(p->out, HC, nullptr, nullptr, p->norm_g + (l * 3 + 1) * 1024, MOD + 3 * 1024, TN, RA); break;
    case 5: { OPQL; pg8::Gemm g{TN, (const bf16_t*)(ws + OFF_WM), RA, 6400, 1024, 1024, 1024}; S.init(RA, 6400, opaque_gdim(), opaque_bid());
        EpiPJ E{(bf16_t*)(ws + OFF_B), ws + OFF_C}; pg8::gemm_phase(lds, g, S, E); } break;
    case 6: prep_phase(p); break;
    case 7: { OPQL; pg8::Gemm g{(const bf16_t*)(ws + OFF_B) + C_MQ, (const bf16_t*)(ws + OFF_WL), RA, 1024, 384, PJW, 384}; S.init(RA, 1024, opaque_gdim(), opaque_bid());
        EpiMLA E{(bf16_t*)(ws + OFF_D), (bf16_t*)(ws + OFF_MK), (bf16_t*)(ws + OFF_MV), (const float*)(ws + OFF_RSTD), (const float2*)(ws + OFF_ROPE)}; pg8::gemm_phase(lds, g, S, E); } break;
    case 8: OPQL; attn_phase(p, l, lds); break;
    case 9: { OPQL; S.init(Mlate, 1024, opaque_gdim(), opaque_bid());
        for (int bi = 0; bi < 4; ++bi) {
            pg8::Gemm g{(const bf16_t*)(ws + OFF_A) + bi * 256, (const bf16_t*)(ws + OFF_WB) + (size_t)bi * 1024 * 256, Mlate, 1024, 256, 1024, 256};
            EpiMerge E{ws + OFF_C, (float*)(ws + OFF_B), (bf16_t*)(ws + OFF_D), bi}; pg8::gemm_phase(lds, g, S, E); } } break;
    case 10: { OPQL; pg8::Gemm g{(const bf16_t*)(ws + OFF_D), (const bf16_t*)(ws + OFF_WO), Mlate, 1024, 1024, 1024, 1024}; S.init(Mlate, 1024, opaque_gdim(), opaque_bid());
        EpiResid E{p->out, HC, MOD + 5 * 1024, rcoef}; pg8::gemm_phase(lds, g, S, E); } break;
    case 11: OPQL; norm_mod_phase(p->out, HC, nullptr, nullptr, p->norm_g + (l * 3 + 2) * 1024, MOD + 6 * 1024, TN, Mlate); break;
    }
#undef OPQL
#undef HC
#undef MOD
#undef TN
#undef HID
#undef Mlate
}

__global__ void __launch_bounds__(512, 2) fwd_megakernel(Params p) {
    extern __shared__ __attribute__((aligned(16))) unsigned char shm[];
    LAS unsigned char* lds = (LAS unsigned char*)shm;
#if N_LAUNCH_MODE == 1
    cg::grid_group grid = cg::this_grid();
    const int ph_lo = p.ph_lo, ph_hi = p.ph_hi;
    volatile LAS unsigned* st = (volatile LAS unsigned*)(lds + pg8::STAGE_BYTES);
    unsigned* bar = (unsigned*)(p.ws + OFF_BAR);
    if (opaque_tid() < 4) st[opaque_tid()] = 0u;
    if (opaque_bid() == 0) for (int i = opaque_tid(); i < XCD_BAR_WORDS; i += 512) bar[i] = 0u;
    __syncthreads();
    for (int ph = ph_lo; ph < ph_hi; ++ph) {
        const int qq = ph % PH_PER_LAYER;
        const int nrep = (PROBE_MASK && ph < N_PHASES - 1 && qq != 6 && ((PROBE_MASK >> qq) & 1)) ? 2 : 1;
        for (int rep = 0; rep < nrep; ++rep) {
            PK pk = (PK)__builtin_amdgcn_kernarg_segment_ptr();
            asm volatile("" : "+s"(pk));
            run_phase(pk, ph, lds, rep ? 0.0f : 1.0f);
            if (ph == ph_lo && rep == 0) { grid.sync(); xcd_barrier_post(bar); }
            else if (ph + 1 < ph_hi || rep + 1 < nrep) xcd_barrier(bar, st);
        }
    }
#else
    const int ph_lo = p.ph_lo, ph_hi = p.ph_hi;
    for (int ph = ph_lo; ph < ph_hi; ++ph) { PK pk = (PK)__builtin_amdgcn_kernarg_segment_ptr(); asm volatile("" : "+s"(pk)); run_phase(pk, ph, lds, 1.0f); }
#endif
}

extern "C" void kernel_launch(void* const* d_in, const int* in_sizes, int n_in, void* d_out, int out_size, void* d_ws, size_t ws_size, hipStream_t stream) {
    constexpr int LDS_BYTES = pg8::STAGE_BYTES + 16;
    static int grid_blocks = 0;
    if (grid_blocks == 0) {
        if (n_in != 22 || ws_size < WS_END) { fprintf(stderr, "kernel_launch: unexpected inputs (n_in %d, ws %zu < %zu)\n", n_in, ws_size, (size_t)WS_END); grid_blocks = -1; return; }
        int dev = 0, cus = 0, per_cu = 0;
        hipGetDevice(&dev); hipDeviceGetAttribute(&cus, hipDeviceAttributeMultiprocessorCount, dev);
        if (hipFuncSetAttribute((const void*)fwd_megakernel, hipFuncAttributeMaxDynamicSharedMemorySize, LDS_BYTES) != hipSuccess) { fprintf(stderr, "hipFuncSetAttribute failed\n"); grid_blocks = -1; return; }
        if (hipOccupancyMaxActiveBlocksPerMultiprocessor(&per_cu, (const void*)fwd_megakernel, 512, LDS_BYTES) != hipSuccess || per_cu < 1) per_cu = 1;
        (void)hipGetLastError();
        grid_blocks = cus * 1;
    }
    if (grid_blocks < 0) return;
    Params hp{};
    const float** pp = (const float**)&hp;
    for (int i = 0; i < 22; ++i) pp[i] = (const float*)d_in[i];
    hp.out = (float*)d_out; hp.ws = (unsigned char*)d_ws;
#if N_LAUNCH_MODE == 1
    hp.ph_lo = 0; hp.ph_hi = N_PHASES;
    void* args[] = {&hp};
    hipError_t e = hipLaunchCooperativeKernel((const void*)fwd_megakernel, dim3(grid_blocks), dim3(512), args, LDS_BYTES, stream);
    if (e != hipSuccess) fprintf(stderr, "cooperative launch failed: %s (grid %d)\n", hipGetErrorString(e), grid_blocks);
#else
    for (int ph = 0; ph < N_PHASES; ++ph) { hp.ph_lo = ph; hp.ph_hi = ph + 1; hipLaunchKernelGGL(fwd_megakernel, dim3(grid_blocks), dim3(512), LDS_BYTES, stream, hp); }
#endif
}
```

```cpp
#include <hip/hip_runtime.h>
#include <hip/hip_cooperative_groups.h>
#include <cstdio>
namespace cg = cooperative_groups;

#define LAS __attribute__((address_space(3)))
typedef unsigned short bf16_t;
typedef short bf16x8 __attribute__((ext_vector_type(8)));
typedef short s16x4 __attribute__((ext_vector_type(4)));
typedef float f32x4 __attribute__((ext_vector_type(4)));
typedef float f32x16 __attribute__((ext_vector_type(16)));
typedef unsigned u32x4 __attribute__((ext_vector_type(4)));
typedef unsigned u32x2 __attribute__((ext_vector_type(2)));

#ifndef PROBE_MASK
#define PROBE_MASK 0
#endif
#ifndef N_LAUNCH_MODE
#define N_LAUNCH_MODE 1
#endif

constexpr int RL = 32768, RA = 33792, FH = 2816;
constexpr int PJW = 2304;
constexpr int C_NQ = 256, C_NK = 512, C_NV = 768, C_DQ = 1024, C_DK = 1280, C_DV = 1536, C_MQ = 1792, C_MKV = 2048, C_MKR = 2176;
constexpr float LOG2E = 1.4426950408889634f;
constexpr float NEPS = 1e-6f;
constexpr int XCD_BAR_WORDS_C = 3456;

constexpr size_t SZ_W1 = 2ull * 5632 * 1024 * 2, SZ_W2 = 2ull * 1024 * 2816 * 2, SZ_WM = 6400ull * 1024 * 2, SZ_WL = 1024ull * 384 * 2, SZ_WB = 4ull * 1024 * 256 * 2, SZ_WO = 1024ull * 1024 * 2;
constexpr size_t OFF_W1 = 0, OFF_W2 = OFF_W1 + SZ_W1, OFF_WM = OFF_W2 + SZ_W2, OFF_WL = OFF_WM + SZ_WM, OFF_WB = OFF_WL + SZ_WL, OFF_WO = OFF_WB + SZ_WB;
constexpr size_t OFF_HC = OFF_WO + SZ_WO;
constexpr size_t OFF_MOD = OFF_HC + 1024ull * 1024 * 4;
constexpr size_t OFF_ROPE = OFF_MOD + 2ull * 5 * 9216 * 4;
constexpr size_t OFF_RSTD = OFF_ROPE + 128 * 8 * 8;
constexpr size_t OFF_A = OFF_RSTD + (size_t)RA * 2 * 4;
constexpr size_t OFF_B = OFF_A + (size_t)RA * 1024 * 2;
constexpr size_t OFF_C = OFF_B + (size_t)RA * PJW * 2;
constexpr size_t OFF_D = OFF_C + (size_t)RA * 4096;
constexpr size_t OFF_MK = OFF_D + (size_t)RA * 384 * 2, OFF_MV = OFF_MK + (size_t)RA * 384 * 2;
constexpr size_t OFF_BAR = OFF_D + (size_t)RA * 1024 * 2;
constexpr size_t WS_END = OFF_BAR + XCD_BAR_WORDS_C * 4;

struct Params {
    const float *x, *c, *ctx, *c_ctx, *ada_w, *ada_b, *norm_g, *ffn_w_in, *ffn_w_out, *mix_w_in, *pool_w, *pool_scale, *na_rpb, *diff_lambda, *diff_subln_g,
        *mla_q_norm_g, *mla_kv_norm_g, *mla_w_qb, *mla_w_kvb, *branch_w_out, *mix_w_out, *final_norm_g;
    float* out; unsigned char* ws;
    int ph_lo, ph_hi;
};

typedef const __attribute__((address_space(4))) Params* PK;

__device__ __forceinline__ unsigned cvt_pk_bf16(float lo, float hi) { unsigned r; asm volatile("v_cvt_pk_bf16_f32 %0, %1, %2" : "=v"(r) : "v"(lo), "v"(hi)); return r; }
__device__ __forceinline__ float bf_lo(unsigned u) { return __uint_as_float(u << 16); }
__device__ __forceinline__ float bf_hi(unsigned u) { return __uint_as_float(u & 0xffff0000u); }
__device__ __forceinline__ float fast_exp2(float x) { return __builtin_amdgcn_exp2f(x); }
__device__ __forceinline__ float fast_rcp(float x) { return __builtin_amdgcn_rcpf(x); }
__device__ __forceinline__ float sigmoidf_(float x) { return fast_rcp(1.0f + fast_exp2(-x * LOG2E)); }
__device__ __forceinline__ float shflx(float v, int m) {
    int lane = __builtin_amdgcn_mbcnt_hi(~0u, __builtin_amdgcn_mbcnt_lo(~0u, 0)); asm volatile("" : "+v"(lane));
    return __int_as_float(__builtin_amdgcn_ds_bpermute((lane ^ m) << 2, __float_as_int(v)));
}
__device__ __forceinline__ float wave_sum(float v) {
    v += shflx(v, 32); v += shflx(v, 16); v += shflx(v, 8); v += shflx(v, 4); v += shflx(v, 2); v += shflx(v, 1); return v;
}
__device__ __forceinline__ int opaque_tid() { int t = threadIdx.x; asm volatile("" : "+v"(t)); return t; }
__device__ __forceinline__ int opaque_bid() { int t = blockIdx.x; asm volatile("" : "+s"(t)); return t; }
__device__ __forceinline__ int opaque_gdim() { int t = gridDim.x; asm volatile("" : "+s"(t)); return t; }
__device__ __forceinline__ int clampi(int v, int lo, int hi) { return v < lo ? lo : (v > hi ? hi : v); }

#define XB_TMO      128
#define XB_XCNT(j)  (256  + 64 * (j))
#define XB_XSUB(j)  (1280 + 64 * (j))
#define XB_XGEN(j)  (2304 + 64 * (j))
#define XB_TOP      3328
#define XB_TOPGEN   3392
#define XCD_BAR_WORDS 3456
#define XB_SPIN_CAP (1u << 20)
__device__ __forceinline__ unsigned xb_ld(unsigned* p)              { return __hip_atomic_load(p, __ATOMIC_RELAXED, __HIP_MEMORY_SCOPE_AGENT); }
__device__ __forceinline__ unsigned xb_add(unsigned* p, unsigned v) { return __hip_atomic_fetch_add(p, v, __ATOMIC_RELAXED, __HIP_MEMORY_SCOPE_AGENT); }
__device__ __forceinline__ unsigned xb_xcc_id() { return (unsigned)__builtin_amdgcn_s_getreg((3 << 11) | 20) & 0xFu; }
#define XB_SPIN(cond, bar) do { unsigned _sp = 0; while (cond) { __builtin_amdgcn_s_sleep(1); \
    if ((++_sp & 255u) == 0u) { if (xb_ld(&(bar)[XB_TMO])) break; if (_sp > XB_SPIN_CAP) { atomicAdd(&(bar)[XB_TMO], 1u); break; } } } } while (0)
__device__ __forceinline__ void xcd_barrier_post(unsigned* bar) { if (opaque_tid() == 0) (void)xb_add(&bar[XB_XCNT(xb_xcc_id())], 1u); }
__device__ __forceinline__ void xcd_barrier_complete(unsigned* bar, unsigned x, unsigned& nloc, unsigned& nx) {
    const unsigned G = gridDim.x;
    unsigned sum, cnt, mine, sp = 0u;
    for (;;) {
        sum = 0u; cnt = 0u; mine = 0u;
#pragma unroll
        for (unsigned j = 0; j < 16; ++j) { const unsigned c = xb_ld(&bar[XB_XCNT(j)]); sum += c; cnt += (c > 0u) ? 1u : 0u; mine = (j == x) ? c : mine; }
        if (sum == G) break;
        __builtin_amdgcn_s_sleep(1);
        if ((++sp & 255u) == 0u) { if (xb_ld(&bar[XB_TMO])) break; if (sp > XB_SPIN_CAP) { atomicAdd(&bar[XB_TMO], 1u); break; } }
    }
    nloc = mine > 0u ? mine : 1u; nx = cnt > 0u ? cnt : 1u;
}
__device__ __forceinline__ void xcd_barrier(unsigned* bar, volatile LAS unsigned* st) {
    asm volatile("s_waitcnt vmcnt(0)" ::: "memory");
    __syncthreads();
    if (opaque_tid() == 0) {
        const unsigned x = xb_xcc_id();
        __builtin_amdgcn_s_waitcnt(0);
        unsigned nloc = st[0], nx = st[1];
        if (nloc == 0u) { xcd_barrier_complete(bar, x, nloc, nx); st[0] = nloc; st[1] = nx; }
        const unsigned old = xb_add(&bar[XB_XSUB(x)], 1u);
        const unsigned gen = old / nloc;
        if (old + 1u == (gen + 1u) * nloc) {
            __builtin_amdgcn_fence(__ATOMIC_RELEASE, "agent");
            asm volatile("s_waitcnt vmcnt(0)" ::: "memory");
            const unsigned og = xb_add(&bar[XB_TOP], 1u);
            const unsigned tg = og / nx;
            if (og + 1u == (tg + 1u) * nx) xb_add(&bar[XB_TOPGEN], 1u);
            else XB_SPIN(xb_ld(&bar[XB_TOPGEN]) == tg, bar);
            __builtin_amdgcn_fence(__ATOMIC_ACQUIRE, "agent");
            xb_add(&bar[XB_XGEN(x)], 1u);
            asm volatile("s_waitcnt vmcnt(0)" ::: "memory");
        } else {
            XB_SPIN(xb_ld(&bar[XB_XGEN(x)]) == gen, bar);
            __builtin_amdgcn_fence(__ATOMIC_ACQUIRE, "agent");
            asm volatile("s_waitcnt vmcnt(0)" ::: "memory");
        }
    }
    __syncthreads();
}

namespace pg8 {
constexpr int BM = 256, BK = 64, HALF = 128, HTB = HALF * BK * 2, STAGE_BYTES = 8 * HTB, NXCD = 8, WGM = 8;
__device__ __forceinline__ int lds_byte(int r, int c) { const int st = (r >> 4) * 2 + (c >> 5), rr = r & 15, cc = c & 31, ob = rr * 64 + cc * 2; return st * 1024 + (ob ^ (((ob >> 9) & 1) << 5)); }
__device__ __forceinline__ void stage_rc(int b, int& R, int& C) { const int st = b / 1024, sb = b % 1024, swz = sb ^ (((sb >> 9) & 1) << 5); R = (st >> 1) * 16 + swz / 64; C = (st & 1) * 32 + (swz % 64) / 2; }
__device__ __forceinline__ int perm32(int rho) { const int n = rho >> 4, i = rho & 15; return 8 * (i >> 2) + 4 * n + (i & 3); }
struct Unit { int pm, pn; };
struct Gemm { const bf16_t* A; const bf16_t* Bt; int M, N, K, lda, ldb; };
struct StaticOrder {
    int nM, nN, nwg, G, c;
    __device__ void init(int M, int N, int G_, int c_) { nM = M / BM; nN = N / BM; nwg = nM * nN; G = G_; c = c_; }
    __device__ bool next(int i, Unit& u) const {
        const long L = (long)i * G + c; if (L >= nwg) return false;
        int wgid = (int)L; { const int q = nwg / NXCD, r = nwg % NXCD, xcd = wgid % NXCD, off = wgid / NXCD; wgid = (xcd < r ? xcd * (q + 1) : r * (q + 1) + (xcd - r) * q) + off; }
        const int nig = WGM * nN, gid = wgid / nig, fm = gid * WGM, gsz = (nM - fm) < WGM ? (nM - fm) : WGM;
        u.pm = fm + ((wgid % nig) % gsz); u.pn = (wgid % nig) / gsz; return true;
    }
};

template <class Epi>
__device__ __forceinline__ void gemm_phase(LAS unsigned char* lds, const Gemm g, const StaticOrder& S, const Epi& E) {
    const int tid = opaque_tid(), wid = __builtin_amdgcn_readfirstlane(tid >> 6), lane = tid & 63, wr = wid >> 2, wc = wid & 3, fr = lane & 15, fq = lane >> 4;
    const int K = g.K, nt = K / BK;
    unsigned voffA[2], voffB[2];
#pragma unroll
    for (int i = 0; i < 2; ++i) { int R, C; stage_rc(tid * 16 + i * 8192, R, C); const int Rb = Epi::PERM ? ((R & ~31) + perm32(R & 31)) : R;
        voffA[i] = (unsigned)(R * g.lda + C) * 2u; voffB[i] = (unsigned)(Rb * g.ldb + C) * 2u; }
    const size_t kstep = (size_t)(BK * 2);
    const size_t hstepA = (size_t)HALF * g.lda * 2, hstepB = (size_t)HALF * g.ldb * 2;
    const size_t tstepA = 2 * hstepA, tstepB = 2 * hstepB;
    const unsigned ldsw = (unsigned)wid * 1024u;
    const int aoff = lds_byte(wr * 64 + fr, fq * 8), boff = lds_byte(wc * 32 + fr, fq * 8);
#define PG8_SA(b, h) (((b) * 2 + (h)) * HTB)
#define PG8_SB(b, h) ((4 + (b) * 2 + (h)) * HTB)
#define PG8_STAGE(bufoff, gbase, voff) do { _Pragma("unroll") for (int _i = 0; _i < 2; ++_i) \
        __builtin_amdgcn_global_load_lds((const unsigned*)((const char*)(gbase) + (voff)[_i]), (LAS unsigned*)(lds + (bufoff) + ldsw + _i * 8192), 16, 0, 0); } while (0)
#define PG8_LDA(dst, b, h) do { _Pragma("unroll") for (int m = 0; m < 4; ++m) _Pragma("unroll") for (int k = 0; k < 2; ++k) dst[m][k] = *(const LAS bf16x8*)(lds + PG8_SA(b, h) + aoff + m * 2048 + k * 1024); } while (0)
#define PG8_LDB(dst, b, h) do { _Pragma("unroll") for (int n = 0; n < 2; ++n) _Pragma("unroll") for (int k = 0; k < 2; ++k) dst[n][k] = *(const LAS bf16x8*)(lds + PG8_SB(b, h) + boff + n * 2048 + k * 1024); } while (0)
#define PG8_MMA(ai, bj, At, Bt) do { __builtin_amdgcn_s_setprio(1); _Pragma("unroll") for (int m = 0; m < 4; ++m) _Pragma("unroll") for (int n = 0; n < 2; ++n) _Pragma("unroll") for (int k = 0; k < 2; ++k) \
        acc[ai][bj][m][n] = __builtin_amdgcn_mfma_f32_16x16x32_bf16(Bt[n][k], At[m][k], acc[ai][bj][m][n], 0, 0, 0); __builtin_amdgcn_s_setprio(0); } while (0)
#define PG8_WAIT_V(n) asm volatile("s_waitcnt vmcnt(" #n ")" ::: "memory")
#define PG8_WAIT_L(n) asm volatile("s_waitcnt lgkmcnt(" #n ")" ::: "memory")
#define PG8_BAR __builtin_amdgcn_s_barrier()
#define PG8_SCHED __builtin_amdgcn_sched_barrier(0)
    Unit cur, nxt; int ui = 0;
    if (!S.next(0, cur)) return;
    f32x4 acc[2][2][4][2];
#pragma unroll
    for (int a = 0; a < 2; ++a)
#pragma unroll
        for (int b = 0; b < 2; ++b)
#pragma unroll
            for (int m = 0; m < 4; ++m)
#pragma unroll
                for (int n = 0; n < 2; ++n) acc[a][b][m][n] = (f32x4){0.f, 0.f, 0.f, 0.f};
    bf16x8 At[4][2], B0[2][2], B1[2][2];
    const char* cA = (const char*)g.A + (size_t)cur.pm * tstepA; const char* cB = (const char*)g.Bt + (size_t)cur.pn * tstepB;
    PG8_STAGE(PG8_SB(0, 0), cB, voffB); PG8_STAGE(PG8_SA(0, 0), cA, voffA); PG8_STAGE(PG8_SB(0, 1), cB + hstepB, voffB); PG8_STAGE(PG8_SA(0, 1), cA + hstepA, voffA);
    if (wr == 1) PG8_BAR;
    PG8_WAIT_V(4); PG8_BAR;
    PG8_STAGE(PG8_SB(1, 0), cB + kstep, voffB); PG8_STAGE(PG8_SA(1, 0), cA + kstep, voffA); PG8_STAGE(PG8_SB(1, 1), cB + hstepB + kstep, voffB);
    PG8_WAIT_V(6); PG8_BAR;
    for (;;) {
        const bool has_next = S.next(ui + 1, nxt);
        const char* nA = has_next ? (const char*)g.A + (size_t)nxt.pm * tstepA : cA; const char* nB = has_next ? (const char*)g.Bt + (size_t)nxt.pn * tstepB : cB;
        for (int t = 0; t < nt; t += 2) {
            const bool last = (t == nt - 2);
            const char* a1 = cA + (size_t)(t + 1) * kstep;
            const char* a2 = last ? nA : cA + (size_t)(t + 2) * kstep; const char* b2 = last ? nB : cB + (size_t)(t + 2) * kstep;
            const char* a3 = a2 + kstep; const char* b3 = b2 + kstep;
            PG8_LDB(B0, 0, 0); PG8_SCHED; PG8_LDA(At, 0, 0); PG8_STAGE(PG8_SA(1, 1), a1 + hstepA, voffA);
            PG8_WAIT_L(8); PG8_BAR; PG8_WAIT_L(0); PG8_MMA(0, 0, At, B0); PG8_BAR; PG8_SCHED;
            PG8_LDB(B1, 0, 1); PG8_STAGE(PG8_SB(0, 0), b2, voffB);
            PG8_BAR; PG8_WAIT_L(0); PG8_MMA(0, 1, At, B1); PG8_BAR;
            PG8_LDA(At, 0, 1); PG8_STAGE(PG8_SA(0, 0), a2, voffA);
            PG8_BAR; PG8_WAIT_L(0); PG8_MMA(1, 0, At, B0); PG8_BAR; PG8_SCHED;
            PG8_STAGE(PG8_SB(0, 1), b2 + hstepB, voffB);
            PG8_WAIT_V(6); PG8_BAR; PG8_MMA(1, 1, At, B1); PG8_BAR;
            PG8_LDB(B0, 1, 0); PG8_SCHED; PG8_LDA(At, 1, 0); PG8_STAGE(PG8_SA(0, 1), a2 + hstepA, voffA);
            PG8_WAIT_L(8); PG8_BAR; PG8_WAIT_L(0); PG8_MMA(0, 0, At, B0); PG8_BAR; PG8_SCHED;
            PG8_LDB(B1, 1, 1); PG8_STAGE(PG8_SB(1, 0), b3, voffB);
            PG8_BAR; PG8_WAIT_L(0); PG8_MMA(0, 1, At, B1); PG8_BAR;
            PG8_LDA(At, 1, 1); PG8_STAGE(PG8_SA(1, 0), a3, voffA);
            PG8_BAR; PG8_WAIT_L(0); PG8_MMA(1, 0, At, B0); PG8_BAR; PG8_SCHED;
            PG8_STAGE(PG8_SB(1, 1), b3 + hstepB, voffB);
            PG8_WAIT_V(6); PG8_BAR; PG8_MMA(1, 1, At, B1); PG8_BAR;
            if constexpr (Epi::HOOK) { if ((((t + 2) & 3) == 0) && !last) E.hook(acc, cur, (t + 2) >> 2, wr, wc, fr, fq); }
        }
        E(acc, cur, wr, wc, fr, fq);
        if (!has_next) break;
#pragma unroll
        for (int a = 0; a < 2; ++a)
#pragma unroll
            for (int b = 0; b < 2; ++b)
#pragma unroll
                for (int m = 0; m < 4; ++m)
#pragma unroll
                    for (int n = 0; n < 2; ++n) acc[a][b][m][n] = (f32x4){0.f, 0.f, 0.f, 0.f};
        cur = nxt; cA = nA; cB = nB; ++ui;
    }
    PG8_WAIT_V(0);
    if (wr == 0) PG8_BAR;
    PG8_BAR;
#undef PG8_SA
#undef PG8_SB
#undef PG8_STAGE
#undef PG8_LDA
#undef PG8_LDB
#undef PG8_MMA
#undef PG8_WAIT_V
#undef PG8_WAIT_L
#undef PG8_BAR
#undef PG8_SCHED
}
}
using pg8::Unit;

struct EpiSwiglu {
    static constexpr bool HOOK = false;
    static constexpr bool PERM = true;
    bf16_t* HID;
    __device__ __forceinline__ void operator()(const f32x4 (&acc)[2][2][4][2], const Unit& u, int wr, int wc, int fr, int fq) const {
        const int row0 = u.pm * 256 + wr * 64 + fr, col0 = u.pn * 128 + wc * 32 + 8 * fq;
#pragma unroll
        for (int ai = 0; ai < 2; ++ai)
#pragma unroll
            for (int m = 0; m < 4; ++m) {
                const int row = row0 + ai * 128 + m * 16;
                float hv[8];
#pragma unroll
                for (int n = 0; n < 2; ++n)
#pragma unroll
                    for (int j = 0; j < 4; ++j) { const float a = acc[ai][0][m][n][j], b = acc[ai][1][m][n][j]; hv[4 * n + j] = a * sigmoidf_(a) * b; }
                u32x4 w; w.x = cvt_pk_bf16(hv[0], hv[1]); w.y = cvt_pk_bf16(hv[2], hv[3]); w.z = cvt_pk_bf16(hv[4], hv[5]); w.w = cvt_pk_bf16(hv[6], hv[7]);
                *(u32x4*)(HID + (size_t)row * FH + col0) = w;
            }
    }
};
struct EpiResid {
    static constexpr bool HOOK = false;
    static constexpr bool PERM = false;
    float* Hl; float* Hc; const float* gate; float coef;
    __device__ __forceinline__ void operator()(const f32x4 (&acc)[2][2][4][2], const Unit& u, int wr, int wc, int fr, int fq) const {
        const int row0 = u.pm * 256 + wr * 64 + fr, col0 = u.pn * 256 + wc * 32 + 4 * fq;
#pragma unroll
        for (int ai = 0; ai < 2; ++ai)
#pragma unroll
            for (int m = 0; m < 4; ++m) {
                const int row = row0 + ai * 128 + m * 16;
                float* hp = row < RL ? Hl + (size_t)row * 1024 : Hc + (size_t)(row - RL) * 1024;
                const float* gp = gate + (row < RL ? (row >> 13) : 4) * 9216;
#pragma unroll
                for (int bj = 0; bj < 2; ++bj)
#pragma unroll
                    for (int n = 0; n < 2; ++n) {
                        const int c = col0 + bj * 128 + n * 16;
                        const f32x4 g4 = *(const f32x4*)(gp + c); f32x4 h4 = *(const f32x4*)(hp + c);
                        h4 += (g4 * coef) * acc[ai][bj][m][n];
                        *(f32x4*)(hp + c) = h4;
                    }
            }
    }
};
struct EpiPJ {
    static constexpr bool HOOK = false;
    static constexpr bool PERM = true;
    bf16_t* PJ; unsigned char* G8;
    __device__ __forceinline__ void operator()(const f32x4 (&acc)[2][2][4][2], const Unit& u, int wr, int wc, int fr, int fq) const {
        const int row0 = u.pm * 256 + wr * 64 + fr, c0 = wc * 32 + 8 * fq;
        if (u.pn < 9) {
#pragma unroll
            for (int ai = 0; ai < 2; ++ai)
#pragma unroll
                for (int m = 0; m < 4; ++m) {
                    const int row = row0 + ai * 128 + m * 16;
#pragma unroll
                    for (int bj = 0; bj < 2; ++bj) {
                        const f32x4 v0 = acc[ai][bj][m][0], v1 = acc[ai][bj][m][1];
                        u32x4 w; w.x = cvt_pk_bf16(v0[0], v0[1]); w.y = cvt_pk_bf16(v0[2], v0[3]); w.z = cvt_pk_bf16(v1[0], v1[1]); w.w = cvt_pk_bf16(v1[2], v1[3]);
                        *(u32x4*)(PJ + (size_t)row * PJW + u.pn * 256 + bj * 128 + c0) = w;
                    }
                }
        } else {
#pragma unroll
            for (int ai = 0; ai < 2; ++ai)
#pragma unroll
                for (int m = 0; m < 4; ++m) {
                    const int row = row0 + ai * 128 + m * 16;
#pragma unroll
                    for (int bj = 0; bj < 2; ++bj) {
                        unsigned q[8];
#pragma unroll
                        for (int n = 0; n < 2; ++n)
#pragma unroll
                            for (int j = 0; j < 4; ++j) { int v = (int)(sigmoidf_(acc[ai][bj][m][n][j]) * 256.0f); q[4 * n + j] = (unsigned)(v > 255 ? 255 : v); }
                        u32x2 w; w.x = q[0] | (q[1] << 8) | (q[2] << 16) | (q[3] << 24); w.y = q[4] | (q[5] << 8) | (q[6] << 16) | (q[7] << 24);
                        *(u32x2*)(G8 + (size_t)row * 4096 + (u.pn - 9) * 256 + bj * 128 + c0) = w;
                    }
                }
        }
    }
};
struct EpiMLA {
    static constexpr bool HOOK = false;
    static constexpr bool PERM = true;
    bf16_t *MQ, *MK, *MV; const float* RSTD; const float2* RT;
    __device__ __forceinline__ void operator()(const f32x4 (&acc)[2][2][4][2], const Unit& u, int wr, int wc, int fr, int fq) const {
        const int row0 = u.pm * 256 + wr * 64 + fr;
#pragma unroll
        for (int bj = 0; bj < 2; ++bj) {
            const int cg0 = u.pn * 256 + bj * 128 + wc * 32;
            if (cg0 >= 896) continue;
#pragma unroll
            for (int ai = 0; ai < 2; ++ai)
#pragma unroll
                for (int m = 0; m < 4; ++m) {
                    __builtin_amdgcn_sched_barrier(0);
                    const int row = row0 + ai * 128 + m * 16;
                    float v[8];
                    if (cg0 < 384) {
                        const float rs = RSTD[row * 2];
#pragma unroll
                        for (int n = 0; n < 2; ++n)
#pragma unroll
                            for (int j = 0; j < 4; ++j) v[4 * n + j] = acc[ai][bj][m][n][j] * rs;
                        const int d0 = cg0 % 96;
                        if (d0 == 64) {
                            const bool lat = row < RL; const int t = row & 8191; const int pos = (fq >> 1) ? (t & 63) : (t >> 6); const bool isx2 = fq & 1;
#pragma unroll
                            for (int e = 0; e < 8; ++e) {
                                const float pr = shflx(v[e], 16);
                                const float2 cs = RT[pos * 8 + e];
                                const float r = isx2 ? (pr * cs.y + v[e] * cs.x) : (v[e] * cs.x - pr * cs.y);
                                v[e] = lat ? r : v[e];
                            }
                        }
                        u32x4 w; w.x = cvt_pk_bf16(v[0], v[1]); w.y = cvt_pk_bf16(v[2], v[3]); w.z = cvt_pk_bf16(v[4], v[5]); w.w = cvt_pk_bf16(v[6], v[7]);
                        *(u32x4*)(MQ + (size_t)row * 384 + cg0 + 8 * fq) = w;
                    } else {
                        const float rs = RSTD[row * 2 + 1];
#pragma unroll
                        for (int n = 0; n < 2; ++n)
#pragma unroll
                            for (int j = 0; j < 4; ++j) v[4 * n + j] = acc[ai][bj][m][n][j] * rs;
                        const int cp = cg0 - 384, hd = cp >> 7, d0 = cp & 127;
                        u32x4 w; w.x = cvt_pk_bf16(v[0], v[1]); w.y = cvt_pk_bf16(v[2], v[3]); w.z = cvt_pk_bf16(v[4], v[5]); w.w = cvt_pk_bf16(v[6], v[7]);
                        if (d0 < 64) *(u32x4*)(MK + (size_t)row * 384 + hd * 96 + d0 + 8 * fq) = w;
                        else *(u32x4*)(MV + (size_t)row * 256 + hd * 64 + (d0 - 64) + 8 * fq) = w;
                    }
                }
        }
    }
};
struct EpiMerge {
    static constexpr bool PERM = true, HOOK = true;
    const unsigned char* G8; bf16_t* MG;
    __device__ __forceinline__ void hook(f32x4 (&acc)[2][2][4][2], const Unit& u, int nb, int wr, int wc, int fr, int fq) const {
        const int row0 = u.pm * 256 + wr * 64 + fr, c0 = u.pn * 256 + wc * 32 + 8 * fq;
#pragma unroll
        for (int ai = 0; ai < 2; ++ai)
#pragma unroll
            for (int m = 0; m < 4; ++m) {
                const int row = row0 + ai * 128 + m * 16;
#pragma unroll
                for (int bj = 0; bj < 2; ++bj) {
                    __builtin_amdgcn_sched_barrier(0);
                    const unsigned char* gp = G8 + (size_t)row * 4096 + nb * 1024 + c0 + bj * 128;
                    const u32x2 ga = *(const u32x2*)(gp - 1024), gb = *(const u32x2*)gp;
#pragma unroll
                    for (int e = 0; e < 8; ++e) { const unsigned qa = ((e < 4 ? ga.x : ga.y) >> (8 * (e & 3))) & 255u, qb = ((e < 4 ? gb.x : gb.y) >> (8 * (e & 3))) & 255u;
                        acc[ai][bj][m][e >> 2][e & 3] *= ((float)qa + 0.5f) * fast_rcp((float)qb + 0.5f); }
                }
            }
    }
    __device__ __forceinline__ void operator()(const f32x4 (&acc)[2][2][4][2], const Unit& u, int wr, int wc, int fr, int fq) const {
        const int row0 = u.pm * 256 + wr * 64 + fr, c0 = u.pn * 256 + wc * 32 + 8 * fq;
#pragma unroll
        for (int ai = 0; ai < 2; ++ai)
#pragma unroll
            for (int m = 0; m < 4; ++m) {
                const int row = row0 + ai * 128 + m * 16;
#pragma unroll
                for (int bj = 0; bj < 2; ++bj) {
                    __builtin_amdgcn_sched_barrier(0);
                    const int c = c0 + bj * 128;
                    const u32x2 gq = *(const u32x2*)(G8 + (size_t)row * 4096 + 3 * 1024 + c);
                    float v[8];
#pragma unroll
                    for (int e = 0; e < 8; ++e) { const unsigned q = ((e < 4 ? gq.x : gq.y) >> (8 * (e & 3))) & 255u; v[e] = ((float)q + 0.5f) * (1.0f / 256.0f) * acc[ai][bj][m][e >> 2][e & 3]; }
                    u32x4 w; w.x = cvt_pk_bf16(v[0], v[1]); w.y = cvt_pk_bf16(v[2], v[3]); w.z = cvt_pk_bf16(v[4], v[5]); w.w = cvt_pk_bf16(v[6], v[7]);
                    *(u32x4*)(MG + (size_t)row * 1024 + c) = w;
                }
            }
    }
};

template <class F>
__device__ __forceinline__ void wt_rows64(bf16_t* dst, int K, F srcval, int ldd = 0) {
    if (ldd == 0) ldd = K;
    const int tid_ = opaque_tid(); const int nl = tid_ & 63, kq = tid_ >> 6;
    for (int k0 = kq * 8; k0 < K; k0 += 64) {
        float v[8];
#pragma unroll
        for (int j = 0; j < 8; ++j) v[j] = srcval(nl, k0 + j);
        u32x4 w; w.x = cvt_pk_bf16(v[0], v[1]); w.y = cvt_pk_bf16(v[2], v[3]); w.z = cvt_pk_bf16(v[4], v[5]); w.w = cvt_pk_bf16(v[6], v[7]);
        *(u32x4*)(dst + (size_t)nl * ldd + k0) = w;
    }
}

__device__ void layer_prep_phase(PK p, int l, LAS unsigned char* lds) {
    unsigned char* ws = p->ws;
    const int nW = 404, nItems = nW + (l == 0 ? 288 + 1 : 0);
    for (int it = opaque_bid(); it < nItems; it += opaque_gdim()) {
        if (it < 176) {
            const int f = it / 88, j = it % 88; const float* src = p->ffn_w_in + ((size_t)(l * 2 + f) * 1024) * 5632;
            bf16_t* dst = (bf16_t*)(ws + OFF_W1) + ((size_t)f * 5632 + j * 64) * 1024;
            wt_rows64(dst, 1024, [&](int nl, int k) { const int np = j * 64 + nl, pn = np >> 8, wi = np & 255; const int col = wi < 128 ? pn * 128 + wi : FH + pn * 128 + (wi - 128); return src[(size_t)k * 5632 + col]; });
        } else if (it < 208) {
            const int q = it - 176, f = q / 16, j = q % 16; const float* src = p->ffn_w_out + ((size_t)(l * 2 + f) * FH) * 1024;
            bf16_t* dst = (bf16_t*)(ws + OFF_W2) + ((size_t)f * 1024 + j * 64) * FH;
            wt_rows64(dst, FH, [&](int nl, int k) { return src[(size_t)k * 1024 + j * 64 + nl]; });
        } else if (it < 308) {
            const int j = it - 208; const float* src = p->mix_w_in + (size_t)l * 1024 * 6304;
            bf16_t* dst = (bf16_t*)(ws + OFF_WM) + (size_t)j * 64 * 1024;
            wt_rows64(dst, 1024, [&](int nl, int k) { const int np = j * 64 + nl; const int col = np < 2208 ? np : (np < 2304 ? -1 : np - 96); return col < 0 ? 0.f : src[(size_t)k * 6304 + col]; });
        } else if (it < 324) {
            const int j = it - 308; const float* src = p->mix_w_out + (size_t)l * 1024 * 1024;
            bf16_t* dst = (bf16_t*)(ws + OFF_WO) + (size_t)j * 64 * 1024;
            wt_rows64(dst, 1024, [&](int nl, int k) { return src[(size_t)k * 1024 + j * 64 + nl]; });
        } else if (it < 372) {
            const int q = it - 324, bi = 1 + q / 16, j = q % 16; const float* src = p->branch_w_out + ((size_t)(l * 4 + bi) * 256) * 1024;
            bf16_t* dst = (bf16_t*)(ws + OFF_WB) + (size_t)j * 64 * 1024 + bi * 256;
            wt_rows64(dst, 256, [&](int nl, int k) { return src[(size_t)k * 1024 + j * 64 + nl]; }, 1024);
        } else if (it < 388) {
            const int j = it - 372; const float* wb = p->branch_w_out + ((size_t)(l * 4) * 256) * 1024; const float* pw = p->pool_w + (size_t)l * 4 * 64 * 64; const float* ps = p->pool_scale + l * 256;
            bf16_t* dst = (bf16_t*)(ws + OFF_WB) + (size_t)j * 64 * 1024;
            wt_rows64(dst, 256, [&](int nl, int k) { const int gI = k >> 6, n = j * 64 + nl; const float* pr = pw + (size_t)k * 64; float s = 0.f;
                for (int e = 0; e < 64; ++e) s += pr[e] * ps[gI * 64 + e] * wb[(size_t)(gI * 64 + e) * 1024 + n]; return s; }, 1024);
        } else if (it < 404) {
            const int j = it - 388; const float* wq = p->mla_w_qb + (size_t)l * 256 * 384; const float* wk = p->mla_w_kvb + (size_t)l * 128 * 512;
            const float* gq = p->mla_q_norm_g + l * 256; const float* gk = p->mla_kv_norm_g + l * 128;
            bf16_t* dst = (bf16_t*)(ws + OFF_WL) + (size_t)j * 64 * 384;
            wt_rows64(dst, 384, [&](int nl, int k) { const int n = j * 64 + nl;
                if (n < 384) return k < 256 ? gq[k] * wq[(size_t)k * 384 + n] : 0.f;
                if (n < 896) return k >= 256 ? gk[k - 256] * wk[(size_t)(k - 256) * 512 + (n - 384)] : 0.f;
                return 0.f; });
        } else if (it < 404 + 288) {
            const int q = it - 404, ll = q / 144, cb = q % 144;
            LAS float* sc = (LAS float*)lds;
            LAS float* red = (LAS float*)(lds + 5 * 1024 * 4);
            __syncthreads();
            for (int i = opaque_tid(); i < 5 * 1024; i += 512) { const int r = i >> 10, k = i & 1023; const float cv = r < 4 ? p->c[r * 1024 + k] : p->c_ctx[k]; sc[i] = cv * sigmoidf_(cv); }
            __syncthreads();
            const int jl = opaque_tid() & 63, kg = opaque_tid() >> 6; const int col = cb * 64 + jl;
            const float* wsrc = p->ada_w + (size_t)ll * 1024 * 9216 + col;
            float a0 = 0.f, a1 = 0.f, a2 = 0.f, a3 = 0.f, a4 = 0.f;
            for (int k = kg * 128; k < kg * 128 + 128; ++k) { const float wv = wsrc[(size_t)k * 9216]; a0 += sc[k] * wv; a1 += sc[1024 + k] * wv; a2 += sc[2048 + k] * wv; a3 += sc[3072 + k] * wv; a4 += sc[4096 + k] * wv; }
            red[(kg * 5 + 0) * 64 + jl] = a0; red[(kg * 5 + 1) * 64 + jl] = a1; red[(kg * 5 + 2) * 64 + jl] = a2; red[(kg * 5 + 3) * 64 + jl] = a3; red[(kg * 5 + 4) * 64 + jl] = a4;
            __syncthreads();
            if (opaque_tid() < 320) { const int r = opaque_tid() >> 6; float s = p->ada_b[ll * 9216 + col];
                for (int q2 = 0; q2 < 8; ++q2) s += red[(q2 * 5 + r) * 64 + jl];
                ((float*)(ws + OFF_MOD))[(size_t)(ll * 5 + r) * 9216 + col] = s; }
        } else {
            for (int i = opaque_tid(); i < 1024; i += 512) { const int pos = i >> 3, fi = i & 7; const float inv = exp2f(-(float)fi * 0.125f * 13.287712379549449f); const float ang = (float)pos * inv;
                ((float2*)(ws + OFF_ROPE))[i] = make_float2(cosf(ang), sinf(ang)); }
        }
    }
}

__device__ void norm_mod_phase(const float* srcL, const float* srcC, float* cpyL, float* cpyC, const float* g, const float* mod, bf16_t* TN, int nrows) {
    const int tid_ = opaque_tid(); const int lane = tid_ & 63, gw = opaque_bid() * 8 + (tid_ >> 6), nw = opaque_gdim() * 8;
    for (int row = gw; row < nrows; row += nw) {
        const bool lat = row < RL;
        const float* sp = lat ? srcL + (size_t)row * 1024 : srcC + (size_t)(row - RL) * 1024;
        const float* mp = mod + (lat ? (row >> 13) : 4) * 9216;
        f32x4 v[4]; float ss = 0.f;
#pragma unroll
        for (int j = 0; j < 4; ++j) { v[j] = *(const f32x4*)(sp + 256 * j + 4 * lane); ss += v[j][0] * v[j][0] + v[j][1] * v[j][1] + v[j][2] * v[j][2] + v[j][3] * v[j][3]; }
        if (cpyL) { float* cp = lat ? cpyL + (size_t)row * 1024 : cpyC + (size_t)(row - RL) * 1024;
#pragma unroll
            for (int j = 0; j < 4; ++j) *(f32x4*)(cp + 256 * j + 4 * lane) = v[j]; }
        ss = wave_sum(ss);
        const float rstd = rsqrtf(ss * (1.0f / 1024.0f) + NEPS);
#pragma unroll
        for (int j = 0; j < 4; ++j) {
            const int col = 256 * j + 4 * lane;
            const f32x4 gg = *(const f32x4*)(g + col), sh = *(const f32x4*)(mp + col), sc = *(const f32x4*)(mp + 1024 + col);
            float o[4];
#pragma unroll
            for (int e = 0; e < 4; ++e) o[e] = (v[j][e] * rstd * gg[e]) * (1.0f + sc[e]) + sh[e];
            u32x2 w; w.x = cvt_pk_bf16(o[0], o[1]); w.y = cvt_pk_bf16(o[2], o[3]);
            *(u32x2*)(TN + (size_t)row * 1024 + col) = w;
        }
    }
}
__device__ void final_norm_phase(float* H, const float* g) {
    const int tid_ = opaque_tid(); const int lane = tid_ & 63, gw = opaque_bid() * 8 + (tid_ >> 6), nw = opaque_gdim() * 8;
    for (int row = gw; row < RL; row += nw) {
        float* sp = H + (size_t)row * 1024; f32x4 v[4]; float ss = 0.f;
#pragma unroll
        for (int j = 0; j < 4; ++j) { v[j] = *(const f32x4*)(sp + 256 * j + 4 * lane); ss += v[j][0] * v[j][0] + v[j][1] * v[j][1] + v[j][2] * v[j][2] + v[j][3] * v[j][3]; }
        ss = wave_sum(ss);
        const float rstd = rsqrtf(ss * (1.0f / 1024.0f) + NEPS);
#pragma unroll
        for (int j = 0; j < 4; ++j) { const f32x4 gg = *(const f32x4*)(g + 256 * j + 4 * lane); *(f32x4*)(sp + 256 * j + 4 * lane) = v[j] * rstd * gg; }
    }
}

__device__ void prep_phase(PK p) {
    unsigned char* ws = p->ws;
    bf16_t* PJ = (bf16_t*)(ws + OFF_B); bf16_t* YB = (bf16_t*)(ws + OFF_A); bf16_t* MK = (bf16_t*)(ws + OFF_MK); float* RSTD = (float*)(ws + OFF_RSTD);
    const float2* RT = (const float2*)(ws + OFF_ROPE);
    const int tid_ = opaque_tid(); const int lane = tid_ & 63, gw = opaque_bid() * 8 + (tid_ >> 6), nw = opaque_gdim() * 8;
    for (int row = gw; row < RA; row += nw) {
        const bool lat = row < RL;
        int t, n; if (lat) { t = row & 8191; n = 8192; } else { t = (row - RL) & 255; n = 256; }
        const int sbase = row - t;
        bf16_t* prow = PJ + (size_t)row * PJW;
        {
            const int wdw = 2 << (lane >> 4); const int lo = max(t - wdw / 2, 0), hi = min(t - wdw / 2 + wdw, n);
            float s0 = 0.f, s1 = 0.f, s2 = 0.f, s3 = 0.f;
            for (int tt = lo; tt < hi; ++tt) { const u32x2 v = *(const u32x2*)(PJ + (size_t)(sbase + tt) * PJW + 4 * lane); s0 += bf_lo(v.x); s1 += bf_hi(v.x); s2 += bf_lo(v.y); s3 += bf_hi(v.y); }
            const float ic = 1.0f / (float)(hi - lo); const u32x2 sv = *(const u32x2*)(prow + 4 * lane);
            u32x2 w; w.x = cvt_pk_bf16(s0 * ic - bf_lo(sv.x), s1 * ic - bf_hi(sv.x)); w.y = cvt_pk_bf16(s2 * ic - bf_lo(sv.y), s3 * ic - bf_hi(sv.y));
            *(u32x2*)(YB + (size_t)row * 1024 + 4 * lane) = w;
        }
        {
            const u32x2 q = *(const u32x2*)(prow + C_MQ + 4 * lane); const unsigned kv = *(const unsigned*)(prow + C_MKV + 2 * lane);
            float sq = bf_lo(q.x) * bf_lo(q.x) + bf_hi(q.x) * bf_hi(q.x) + bf_lo(q.y) * bf_lo(q.y) + bf_hi(q.y) * bf_hi(q.y);
            float sk = bf_lo(kv) * bf_lo(kv) + bf_hi(kv) * bf_hi(kv);
            sq = wave_sum(sq); sk = wave_sum(sk);
            if (lane == 0) { RSTD[row * 2] = rsqrtf(sq * (1.0f / 256.0f) + NEPS); RSTD[row * 2 + 1] = rsqrtf(sk * (1.0f / 128.0f) + NEPS); }
        }
        if (lane < 34) {
            const bool iskr = lane >= 32; const int a = lane & 1;
            bf16_t* ep = iskr ? prow + C_MKR + a * 16 : prow + ((lane >> 4) ? C_DK : C_DQ) + ((lane >> 1) & 7) * 32 + a * 16;
            const u32x4 e0 = *(const u32x4*)ep, e1 = *(const u32x4*)(ep + 8);
            float x1[8], x2[8];
            x1[0] = bf_lo(e0.x); x1[1] = bf_hi(e0.x); x1[2] = bf_lo(e0.y); x1[3] = bf_hi(e0.y); x1[4] = bf_lo(e0.z); x1[5] = bf_hi(e0.z); x1[6] = bf_lo(e0.w); x1[7] = bf_hi(e0.w);
            x2[0] = bf_lo(e1.x); x2[1] = bf_hi(e1.x); x2[2] = bf_lo(e1.y); x2[3] = bf_hi(e1.y); x2[4] = bf_lo(e1.z); x2[5] = bf_hi(e1.z); x2[6] = bf_lo(e1.w); x2[7] = bf_hi(e1.w);
            if (lat) { const int pos = a ? (t & 63) : (t >> 6);
#pragma unroll
                for (int i = 0; i < 8; ++i) { const float2 cs = RT[pos * 8 + i]; const float o1 = x1[i] * cs.x - x2[i] * cs.y, o2 = x1[i] * cs.y + x2[i] * cs.x; x1[i] = o1; x2[i] = o2; } }
            u32x4 w0, w1; w0.x = cvt_pk_bf16(x1[0], x1[1]); w0.y = cvt_pk_bf16(x1[2], x1[3]); w0.z = cvt_pk_bf16(x1[4], x1[5]); w0.w = cvt_pk_bf16(x1[6], x1[7]);
            w1.x = cvt_pk_bf16(x2[0], x2[1]); w1.y = cvt_pk_bf16(x2[2], x2[3]); w1.z = cvt_pk_bf16(x2[4], x2[5]); w1.w = cvt_pk_bf16(x2[6], x2[7]);
            if (iskr) {
#pragma unroll
                for (int hh = 0; hh < 4; ++hh) { bf16_t* kp = MK + (size_t)row * 384 + hh * 96 + 64 + a * 16; *(u32x4*)kp = w0; *(u32x4*)(kp + 8) = w1; }
            } else if (lat) { *(u32x4*)ep = w0; *(u32x4*)(ep + 8) = w1; }
        }
    }
}

#define MFMA32(a, b, c) __builtin_amdgcn_mfma_f32_32x32x16_bf16((a), (b), (c), 0, 0, 0)
template <int MODE>
__device__ __forceinline__ void attn_item(PK p, int l, LAS unsigned char* lds, int b, int h, int qb, bool ctxq, float lam, float lam_init) {
    constexpr int NCOMP = (MODE == 1) ? 2 : 1, NKS = (MODE == 0) ? 4 : ((MODE == 1) ? 2 : 6), KW = NCOMP * NKS * 16, KCH = KW / 8, KSTR = KW * 2 + 16, VSTR = 192;
    constexpr int KBUF = 64 * KSTR, VBUF = 64 * VSTR, BUFSZ = KBUF + VBUF, BIAS_OFF = 2 * BUFSZ;
    const int tid = opaque_tid(), w = tid >> 6, lane = tid & 63, g = lane >> 5, l32 = lane & 31;
    unsigned char* ws = p->ws;
    const bf16_t* PJ = (const bf16_t*)(ws + OFF_B);
    const bf16_t *Qp, *Kp, *Vp; int ldq, ldk, ldv, outoff; float scale;
    if (MODE == 0) { Qp = PJ + C_NQ + 64 * h; Kp = PJ + C_NK + 64 * h; Vp = PJ + C_NV + 64 * h; ldq = ldk = ldv = PJW; outoff = 256 + 64 * h; scale = 0.125f; }
    else if (MODE == 1) { Qp = PJ + C_DQ + 64 * h; Kp = PJ + C_DK + 64 * h; Vp = PJ + C_DV + 64 * h; ldq = ldk = ldv = PJW; outoff = 512 + 64 * h; scale = 0.17677669529663687f; }
    else { Qp = (const bf16_t*)(ws + OFF_D) + 96 * h; Kp = (const bf16_t*)(ws + OFF_MK) + 96 * h; Vp = (const bf16_t*)(ws + OFF_MV) + 64 * h; ldq = ldk = 384; ldv = 256; outoff = 768 + 64 * h; scale = 0.10206207261596575f; }
    const float cs = scale * LOG2E;
    int qrow0, loc0, nloc;
    if (ctxq) { qrow0 = RL + b * 256; loc0 = 0; nloc = 0; }
    else { qrow0 = b * 8192 + qb * 256;
        if (MODE == 0) { const int r0 = qb * 4; loc0 = clampi(r0 - 4, 0, 120); nloc = clampi(r0 - 1, 0, 120) + 8 - loc0; } else { loc0 = 0; nloc = 128; } }
    const int nt = nloc + 4;
    const bool nabias = (MODE == 0) && !ctxq;
    const int rw = qb * 4 + (w >> 1), sw = clampi(rw - 4, 0, 120);
    const int jq = 32 * (w & 1) + l32, cst = clampi(jq - 8, 0, 48);
    if (nabias && tid < 465) ((LAS float*)(lds + BIAS_OFF))[tid] = p->na_rpb[(size_t)(l * 4 + h) * 465 + tid] * LOG2E;

    const size_t qrow = (size_t)qrow0 + 32 * w + l32;
    bf16x8 qf[NCOMP * NKS];
#pragma unroll
    for (int i = 0; i < NCOMP * NKS; ++i) qf[i] = *(const bf16x8*)(Qp + qrow * ldq + 16 * i + 8 * g);

    const int kr0 = tid / KCH, kc0 = tid % KCH, kr1 = (tid + 512) / KCH, kc1 = (tid + 512) % KCH, vr = tid >> 3, vc = tid & 7;
    const bool hask1 = (KCH == 12) && (tid < 256);
    u32x4 rk0, rk1 = (u32x4){0u, 0u, 0u, 0u}, rv;
#define TILE_ROW(t) ((t) < nloc ? (b * 8192 + 64 * (loc0 + (t))) : (RL + b * 256 + 64 * ((t) - nloc)))
#define LOAD_TILE(t) do { const size_t _tb = (size_t)TILE_ROW(t); rk0 = *(const u32x4*)(Kp + (_tb + kr0) * ldk + kc0 * 8); \
        if (hask1) rk1 = *(const u32x4*)(Kp + (_tb + kr1) * ldk + kc1 * 8); rv = *(const u32x4*)(Vp + (_tb + vr) * ldv + vc * 8); } while (0)
#define STORE_TILE(buf) do { LAS unsigned char* _kb = lds + (buf) * BUFSZ; *(LAS u32x4*)(_kb + kr0 * KSTR + kc0 * 16) = rk0; \
        if (hask1) *(LAS u32x4*)(_kb + kr1 * KSTR + kc1 * 16) = rk1; *(LAS u32x4*)(_kb + KBUF + vr * VSTR + vc * 16) = rv; } while (0)

    float mrun[NCOMP], lsum[NCOMP]; f32x16 O[NCOMP][2];
#pragma unroll
    for (int c = 0; c < NCOMP; ++c) { mrun[c] = -1e30f; lsum[c] = 0.f;
#pragma unroll
        for (int dt = 0; dt < 2; ++dt)
#pragma unroll
            for (int r = 0; r < 16; ++r) O[c][dt][r] = 0.f; }

    LOAD_TILE(0); STORE_TILE(0); __syncthreads();
    const int koff = l32 * KSTR + g * 16;
    const int i16 = lane & 15, tq = i16 >> 2, tp = i16 & 3, blk = (lane >> 4) & 1;
    const int voff = (4 * g + tq) * VSTR + (16 * blk + 4 * tp) * 2;

    for (int t = 0; t < nt; ++t) {
        const bool more = (t + 1 < nt);
        if (more) LOAD_TILE(t + 1);
        bool active = true; int krow = 0;
        if (nabias && t < nloc) { krow = loc0 + t; active = (krow >= sw) && (krow < sw + 8); }
        if (active) {
            LAS unsigned char* Kb = lds + (t & 1) * BUFSZ; LAS unsigned char* Vb = Kb + KBUF;
            bf16x8 pf[NCOMP][2][2];
#pragma unroll
            for (int c = 0; c < NCOMP; ++c) {
                f32x16 S[2];
#pragma unroll
                for (int kt = 0; kt < 2; ++kt) {
#pragma unroll
                    for (int r = 0; r < 16; ++r) S[kt][r] = 0.f;
#pragma unroll
                    for (int ks = 0; ks < NKS; ++ks) { const bf16x8 kf = *(const LAS bf16x8*)(Kb + koff + kt * 32 * KSTR + (c * NKS + ks) * 32); S[kt] = MFMA32(kf, qf[c * NKS + ks], S[kt]); }
                }
                float mx = -1e30f;
                if (nabias && t < nloc) {
                    const LAS float* bt = (const LAS float*)(lds + BIAS_OFF) + (krow - rw + 7) * 31;
#pragma unroll
                    for (int kt = 0; kt < 2; ++kt)
#pragma unroll
                        for (int r = 0; r < 16; ++r) { const int jk = 32 * kt + (r & 3) + 8 * (r >> 2) + 4 * g; const bool ok = (jk >= cst) && (jk < cst + 16);
                            const float bv = bt[clampi(jk - jq + 15, 0, 30)]; const float xv = ok ? (S[kt][r] * cs + bv) : -1e30f; S[kt][r] = xv; mx = fmaxf(mx, xv); }
                } else {
#pragma unroll
                    for (int kt = 0; kt < 2; ++kt)
#pragma unroll
                        for (int r = 0; r < 16; ++r) { const float xv = S[kt][r] * cs; S[kt][r] = xv; mx = fmaxf(mx, xv); }
                }
                mx = fmaxf(mx, shflx(mx, 32));
                const float mnew = fmaxf(mrun[c], mx);
                if (__any(mnew > mrun[c])) {
                    const float alpha = fast_exp2(mrun[c] - mnew); lsum[c] *= alpha;
#pragma unroll
                    for (int dt = 0; dt < 2; ++dt)
#pragma unroll
                        for (int r = 0; r < 16; ++r) O[c][dt][r] *= alpha;
                    mrun[c] = mnew;
                }
                float rs = 0.f;
#pragma unroll
                for (int kt = 0; kt < 2; ++kt)
#pragma unroll
                    for (int r = 0; r < 16; ++r) { const float pv = fast_exp2(S[kt][r] - mnew); S[kt][r] = pv; rs += pv; }
                lsum[c] += rs;
#pragma unroll
                for (int kt = 0; kt < 2; ++kt)
#pragma unroll
                    for (int s = 0; s < 2; ++s) { u32x4 pk; pk.x = cvt_pk_bf16(S[kt][8 * s], S[kt][8 * s + 1]); pk.y = cvt_pk_bf16(S[kt][8 * s + 2], S[kt][8 * s + 3]);
                        pk.z = cvt_pk_bf16(S[kt][8 * s + 4], S[kt][8 * s + 5]); pk.w = cvt_pk_bf16(S[kt][8 * s + 6], S[kt][8 * s + 7]); pf[c][kt][s] = __builtin_bit_cast(bf16x8, pk); }
            }
#pragma unroll
            for (int kt = 0; kt < 2; ++kt)
#pragma unroll
                for (int s = 0; s < 2; ++s)
#pragma unroll
                    for (int dt = 0; dt < 2; ++dt) {
                        LAS unsigned char* vp = Vb + voff + (32 * kt + 16 * s) * VSTR + dt * 64;
                        const s16x4 lo = __builtin_amdgcn_ds_read_tr16_b64_v4i16((LAS s16x4*)vp);
                        const s16x4 hi = __builtin_amdgcn_ds_read_tr16_b64_v4i16((LAS s16x4*)(vp + 8 * VSTR));
                        const bf16x8 vf = __builtin_shufflevector(lo, hi, 0, 1, 2, 3, 4, 5, 6, 7);
#pragma unroll
                        for (int c = 0; c < NCOMP; ++c) O[c][dt] = MFMA32(vf, pf[c][kt][s], O[c][dt]);
                    }
        }
        if (more) STORE_TILE((t + 1) & 1);
        __syncthreads();
    }
#undef TILE_ROW
#undef LOAD_TILE
#undef STORE_TILE
    float inv[NCOMP];
#pragma unroll
    for (int c = 0; c < NCOMP; ++c) { const float lt = lsum[c] + shflx(lsum[c], 32); inv[c] = 1.0f / lt; }
    bf16_t* op = (bf16_t*)(ws + OFF_A) + qrow * 1024 + outoff;
    if (MODE == 1) {
        const float li1 = lam * inv[NCOMP - 1]; float ss = 0.f;
#pragma unroll
        for (int dt = 0; dt < 2; ++dt)
#pragma unroll
            for (int r = 0; r < 16; ++r) { const float o = O[0][dt][r] * inv[0] - li1 * O[NCOMP - 1][dt][r]; O[0][dt][r] = o; ss += o * o; }
        ss += shflx(ss, 32);
        const float rstd = rsqrtf(ss * (1.0f / 64.0f) + NEPS) * (1.0f - lam_init);
        const float* sg = p->diff_subln_g + l * 64;
#pragma unroll
        for (int dt = 0; dt < 2; ++dt)
#pragma unroll
            for (int rq = 0; rq < 4; ++rq) { const int dv = 32 * dt + 8 * rq + 4 * g; const f32x4 gg = *(const f32x4*)(sg + dv);
                u32x2 wv; wv.x = cvt_pk_bf16(O[0][dt][4 * rq] * rstd * gg[0], O[0][dt][4 * rq + 1] * rstd * gg[1]); wv.y = cvt_pk_bf16(O[0][dt][4 * rq + 2] * rstd * gg[2], O[0][dt][4 * rq + 3] * rstd * gg[3]);
                *(u32x2*)(op + dv) = wv; }
    } else {
#pragma unroll
        for (int dt = 0; dt < 2; ++dt)
#pragma unroll
            for (int rq = 0; rq < 4; ++rq) { const int dv = 32 * dt + 8 * rq + 4 * g;
                u32x2 wv; wv.x = cvt_pk_bf16(O[0][dt][4 * rq] * inv[0], O[0][dt][4 * rq + 1] * inv[0]); wv.y = cvt_pk_bf16(O[0][dt][4 * rq + 2] * inv[0], O[0][dt][4 * rq + 3] * inv[0]);
                *(u32x2*)(op + dv) = wv; }
    }
}

__device__ void attn_phase(PK p, int l, LAS unsigned char* lds) {
    const float lam_init = (l == 0) ? 0.2f : 0.35550906759502f;
    const float* dl = p->diff_lambda + l * 128;
    float d01 = 0.f, d23 = 0.f;
    for (int i = 0; i < 32; ++i) { d01 += dl[i] * dl[32 + i]; d23 += dl[64 + i] * dl[96 + i]; }
    const float lam = expf(d01) - expf(d23) + lam_init;
    const int nItems = 1536 + (l == 0 ? 48 : 0);
    for (int it = opaque_bid(); it < nItems; it += opaque_gdim()) {
        if (it < 1536) {
            const int ty = it >> 9, idx = it & 511, b = idx >> 7, h = (idx >> 5) & 3, qb = idx & 31;
            if (ty == 0) attn_item<1>(p, l, lds, b, h, qb, false, lam, lam_init);
            else if (ty == 1) attn_item<2>(p, l, lds, b, h, qb, false, lam, lam_init);
            else attn_item<0>(p, l, lds, b, h, qb, false, lam, lam_init);
        } else {
            const int idx = it - 1536, ty = idx >> 4, b = (idx >> 2) & 3, h = idx & 3;
            if (ty == 0) attn_item<1>(p, l, lds, b, h, 0, true, lam, lam_init);
            else if (ty == 1) attn_item<2>(p, l, lds, b, h, 0, true, lam, lam_init);
            else attn_item<0>(p, l, lds, b, h, 0, true, lam, lam_init);
        }
    }
}

constexpr int PH_PER_LAYER = 14, N_PHASES = 2 * PH_PER_LAYER + 1;

__device__ __forceinline__ void run_phase(PK p, int ph, LAS unsigned char* lds, float rcoef) {
    unsigned char* ws = p->ws;
    pg8::StaticOrder S;
    if (ph == N_PHASES - 1) { final_norm_phase(p->out, p->final_norm_g); return; }
    int l = ph / PH_PER_LAYER; const int q = ph % PH_PER_LAYER;
#define OPQL asm volatile("" : "+s"(l))
#define HC ((float*)(ws + OFF_HC))
#define MOD ((const float*)(ws + OFF_MOD) + (size_t)l * 5 * 9216)
#define TN ((bf16_t*)(ws + OFF_A))
#define HID ((bf16_t*)(ws + OFF_B))
#define Mlate ((l == 0) ? RA : RL)
    switch (q) {
    case 0: OPQL; layer_prep_phase(p, l, lds); break;
    case 1: OPQL; if (l == 0) norm_mod_phase(p->x, p->ctx, p->out, HC, p->norm_g + (l * 3 + 0) * 1024, MOD, TN, RA);
            else norm_mod_phase(p->out, HC, nullptr, nullptr, p->norm_g + (l * 3 + 0) * 1024, MOD, TN, RA); break;
    case 2: case 12: { OPQL; const int f = (q == 2) ? 0 : 1; const int M = (q == 2) ? RA : Mlate;
        pg8::Gemm g{TN, (const bf16_t*)(ws + OFF_W1) + (size_t)f * 5632 * 1024, M, 5632, 1024, 1024, 1024}; S.init(M, 5632, opaque_gdim(), opaque_bid());
        EpiSwiglu E{HID}; pg8::gemm_phase(lds, g, S, E); } break;
    case 3: case 13: { OPQL; const int f = (q == 3) ? 0 : 1; const int M = (q == 3) ? RA : Mlate;
        pg8::Gemm g{HID, (const bf16_t*)(ws + OFF_W2) + (size_t)f * 1024 * FH, M, 1024, FH, FH, FH}; S.init(M, 1024, opaque_gdim(), opaque_bid());
        EpiResid E{p->out, HC, MOD + (q == 3 ? 2 : 8) * 1024, 0.5f * rcoef}; pg8::gemm_phase(lds, g, S, E); } break;
    case 4: OPQL; norm_mod_phase(p->out, HC, nullptr, nullptr, p->norm_g + (l * 3 + 1) * 1024, MOD + 3 * 1024, TN, RA); break;
    case 5: { OPQL; pg8::Gemm g{TN, (const bf16_t*)(ws + OFF_WM), RA, 6400, 1024, 1024, 1024}; S.init(RA, 6400, opaque_gdim(), opaque_bid());
        EpiPJ E{(bf16_t*)(ws + OFF_B), ws + OFF_C}; pg8::gemm_phase(lds, g, S, E); } break;
    case 6: prep_phase(p); break;
    case 7: { OPQL; pg8::Gemm g{(const bf16_t*)(ws + OFF_B) + C_MQ, (const bf16_t*)(ws + OFF_WL), RA, 1024, 384, PJW, 384}; S.init(RA, 1024, opaque_gdim(), opaque_bid());
        EpiMLA E{(bf16_t*)(ws + OFF_D), (bf16_t*)(ws + OFF_MK), (bf16_t*)(ws + OFF_MV), (const float*)(ws + OFF_RSTD), (const float2*)(ws + OFF_ROPE)}; pg8::gemm_phase(lds, g, S, E); } break;
    case 8: OPQL; attn_phase(p, l, lds); break;
    case 9: { OPQL; pg8::Gemm g{(const bf16_t*)(ws + OFF_A), (const bf16_t*)(ws + OFF_WB), Mlate, 1024, 1024, 1024, 1024}; S.init(Mlate, 1024, opaque_gdim(), opaque_bid());
        EpiMerge E{ws + OFF_C, (bf16_t*)(ws + OFF_D)}; pg8::gemm_phase(lds, g, S, E); } break;
    case 10: { OPQL; pg8::Gemm g{(const bf16_t*)(ws + OFF_D), (const bf16_t*)(ws + OFF_WO), Mlate, 1024, 1024, 1024, 1024}; S.init(Mlate, 1024, opaque_gdim(), opaque_bid());
        EpiResid E{p->out, HC, MOD + 5 * 1024, rcoef}; pg8::gemm_phase(lds, g, S, E); } break;
    case 11: OPQL; norm_mod_phase(p->out, HC, nullptr, nullptr, p->norm_g + (l * 3 + 2) * 1024, MOD + 6 * 1024, TN, Mlate); break;
    }
#undef OPQL
#undef HC
#undef MOD
#undef TN
#undef HID
#undef Mlate
}

__global__ void __launch_bounds__(512, 2) fwd_megakernel(Params p) {
    extern __shared__ __attribute__((aligned(16))) unsigned char shm[];
    LAS unsigned char* lds = (LAS unsigned char*)shm;
#if N_LAUNCH_MODE == 1
    cg::grid_group grid = cg::this_grid();
    const int ph_lo = p.ph_lo, ph_hi = p.ph_hi;
    volatile LAS unsigned* st = (volatile LAS unsigned*)(lds + pg8::STAGE_BYTES);
    unsigned* bar = (unsigned*)(p.ws + OFF_BAR);
    if (opaque_tid() < 4) st[opaque_tid()] = 0u;
    if (opaque_bid() == 0) for (int i = opaque_tid(); i < XCD_BAR_WORDS; i += 512) bar[i] = 0u;
    __syncthreads();
    for (int ph = ph_lo; ph < ph_hi; ++ph) {
        const int qq = ph % PH_PER_LAYER;
        const int nrep = (PROBE_MASK && ph < N_PHASES - 1 && qq != 6 && ((PROBE_MASK >> qq) & 1)) ? 2 : 1;
        for (int rep = 0; rep < nrep; ++rep) {
            PK pk = (PK)__builtin_amdgcn_kernarg_segment_ptr();
            asm volatile("" : "+s"(pk));
            run_phase(pk, ph, lds, rep ? 0.0f : 1.0f);
            if (ph == ph_lo && rep == 0) { grid.sync(); xcd_barrier_post(bar); }
            else if (ph + 1 < ph_hi || rep + 1 < nrep) xcd_barrier(bar, st);
        }
    }
#else
    const int ph_lo = p.ph_lo, ph_hi = p.ph_hi;
    for (int ph = ph_lo; ph < ph_hi; ++ph) { PK pk = (PK)__builtin_amdgcn_kernarg_segment_ptr(); asm volatile("" : "+s"(pk)); run_phase(pk, ph, lds, 1.0f); }
#endif
}

extern "C" void kernel_launch(void* const* d_in, const int* in_sizes, int n_in, void* d_out, int out_size, void* d_ws, size_t ws_size, hipStream_t stream) {
    constexpr int LDS_BYTES = pg8::STAGE_BYTES + 16;
    static int grid_blocks = 0;
    if (grid_blocks == 0) {
        if (n_in != 22 || ws_size < WS_END) { fprintf(stderr, "kernel_launch: unexpected inputs (n_in %d, ws %zu < %zu)\n", n_in, ws_size, (size_t)WS_END); grid_blocks = -1; return; }
        int dev = 0, cus = 0, per_cu = 0;
        hipGetDevice(&dev); hipDeviceGetAttribute(&cus, hipDeviceAttributeMultiprocessorCount, dev);
        if (hipFuncSetAttribute((const void*)fwd_megakernel, hipFuncAttributeMaxDynamicSharedMemorySize, LDS_BYTES) != hipSuccess) { fprintf(stderr, "hipFuncSetAttribute failed\n"); grid_blocks = -1; return; }
        if (hipOccupancyMaxActiveBlocksPerMultiprocessor(&per_cu, (const void*)fwd_megakernel, 512, LDS_BYTES) != hipSuccess || per_cu < 1) per_cu = 1;
        (void)hipGetLastError();
        grid_blocks = cus * 1;
    }
    if (grid_blocks < 0) return;
    Params hp{};
    const float** pp = (const float**)&hp;
    for (int i = 0; i < 22; ++i) pp[i] = (const float*)d_in[i];
    hp.out = (float*)d_out; hp.ws = (unsigned char*)d_ws;
#if N_LAUNCH_MODE == 1
    hp.ph_lo = 0; hp.ph_hi = N_PHASES;
    void* args[] = {&hp};
    hipError_t e = hipLaunchCooperativeKernel((const void*)fwd_megakernel, dim3(grid_blocks), dim3(512), args, LDS_BYTES, stream);
    if (e != hipSuccess) fprintf(stderr, "cooperative launch failed: %s (grid %d)\n", hipGetErrorString(e), grid_blocks);
#else
    for (int ph = 0; ph < N_PHASES; ++ph) { hp.ph_lo = ph; hp.ph_hi = ph + 1; hipLaunchKernelGGL(fwd_megakernel, dim3(grid_blocks), dim3(512), LDS_BYTES, stream, hp); }
#endif
}
```

```cpp
#include <hip/hip_runtime.h>
#include <hip/hip_cooperative_groups.h>
#include <cstdio>
namespace cg = cooperative_groups;

#define LAS __attribute__((address_space(3)))
typedef unsigned short bf16_t;
typedef short bf16x8 __attribute__((ext_vector_type(8)));
typedef short s16x4 __attribute__((ext_vector_type(4)));
typedef float f32x4 __attribute__((ext_vector_type(4)));
typedef float f32x16 __attribute__((ext_vector_type(16)));
typedef unsigned u32x4 __attribute__((ext_vector_type(4)));
typedef unsigned u32x2 __attribute__((ext_vector_type(2)));

#ifndef PROBE_MASK
#define PROBE_MASK 0
#endif
#ifndef N_LAUNCH_MODE
#define N_LAUNCH_MODE 1
#endif

constexpr int RL = 32768, RA = 33792, FH = 2816;
constexpr int PJW = 2304;
constexpr int C_NQ = 256, C_NK = 512, C_NV = 768, C_DQ = 1024, C_DK = 1280, C_DV = 1536, C_MQ = 1792, C_MKV = 2048, C_MKR = 2176;
constexpr float LOG2E = 1.4426950408889634f;
constexpr float NEPS = 1e-6f;
constexpr int XCD_BAR_WORDS_C = 3456;

constexpr size_t SZ_W1 = 2ull * 5632 * 1024 * 2, SZ_W2 = 2ull * 1024 * 2816 * 2, SZ_WM = 6400ull * 1024 * 2, SZ_WL = 1024ull * 384 * 2, SZ_WB = 4ull * 1024 * 256 * 2, SZ_WO = 1024ull * 1024 * 2;
constexpr size_t OFF_W1 = 0, OFF_W2 = OFF_W1 + SZ_W1, OFF_WM = OFF_W2 + SZ_W2, OFF_WL = OFF_WM + SZ_WM, OFF_WB = OFF_WL + SZ_WL, OFF_WO = OFF_WB + SZ_WB;
constexpr size_t OFF_HC = OFF_WO + SZ_WO;
constexpr size_t OFF_MOD = OFF_HC + 1024ull * 1024 * 4;
constexpr size_t OFF_ROPE = OFF_MOD + 2ull * 5 * 9216 * 4;
constexpr size_t OFF_RSTD = OFF_ROPE + 128 * 8 * 8;
constexpr size_t OFF_A = OFF_RSTD + (size_t)RA * 2 * 4;
constexpr size_t OFF_B = OFF_A + (size_t)RA * 1024 * 2;
constexpr size_t OFF_C = OFF_B + (size_t)RA * PJW * 2;
constexpr size_t OFF_D = OFF_C + (size_t)RA * 4096;
constexpr size_t OFF_MK = OFF_D + (size_t)RA * 384 * 2, OFF_MV = OFF_MK + (size_t)RA * 384 * 2;
constexpr size_t OFF_BAR = OFF_D + (size_t)RA * 1024 * 2;
constexpr size_t WS_END = OFF_BAR + XCD_BAR_WORDS_C * 4;

struct Params {
    const float *x, *c, *ctx, *c_ctx, *ada_w, *ada_b, *norm_g, *ffn_w_in, *ffn_w_out, *mix_w_in, *pool_w, *pool_scale, *na_rpb, *diff_lambda, *diff_subln_g,
        *mla_q_norm_g, *mla_kv_norm_g, *mla_w_qb, *mla_w_kvb, *branch_w_out, *mix_w_out, *final_norm_g;
    float* out; unsigned char* ws;
    int ph_lo, ph_hi;
};

typedef const __attribute__((address_space(4))) Params* PK;

typedef float f32x2_ __attribute__((ext_vector_type(2)));
typedef __bf16 bf16x2_ __attribute__((ext_vector_type(2)));
__device__ __forceinline__ unsigned cvt_pk_bf16(float lo, float hi) { const f32x2_ v = {lo, hi}; return __builtin_bit_cast(unsigned, __builtin_convertvector(v, bf16x2_)); }
__device__ __forceinline__ float bf_lo(unsigned u) { return __uint_as_float(u << 16); }
__device__ __forceinline__ float bf_hi(unsigned u) { return __uint_as_float(u & 0xffff0000u); }
__device__ __forceinline__ float fast_exp2(float x) { return __builtin_amdgcn_exp2f(x); }
__device__ __forceinline__ float fast_rcp(float x) { return __builtin_amdgcn_rcpf(x); }
__device__ __forceinline__ float sigmoidf_(float x) { return fast_rcp(1.0f + fast_exp2(-x * LOG2E)); }
__device__ __forceinline__ float shflx(float v, int m) {
    int lane = __builtin_amdgcn_mbcnt_hi(~0u, __builtin_amdgcn_mbcnt_lo(~0u, 0)); asm volatile("" : "+v"(lane));
    return __int_as_float(__builtin_amdgcn_ds_bpermute((lane ^ m) << 2, __float_as_int(v)));
}
__device__ __forceinline__ float wave_sum(float v) {
    v += shflx(v, 32); v += shflx(v, 16); v += shflx(v, 8); v += shflx(v, 4); v += shflx(v, 2); v += shflx(v, 1); return v;
}
__device__ __forceinline__ int opaque_tid() { int t = threadIdx.x; asm volatile("" : "+v"(t)); return t; }
__device__ __forceinline__ int opaque_bid() { int t = blockIdx.x; asm volatile("" : "+s"(t)); return t; }
__device__ __forceinline__ int opaque_gdim() { int t = gridDim.x; asm volatile("" : "+s"(t)); return t; }
__device__ __forceinline__ int clampi(int v, int lo, int hi) { return v < lo ? lo : (v > hi ? hi : v); }

#define XB_TMO      128
#define XB_XCNT(j)  (256  + 64 * (j))
#define XB_XSUB(j)  (1280 + 64 * (j))
#define XB_XGEN(j)  (2304 + 64 * (j))
#define XB_TOP      3328
#define XB_TOPGEN   3392
#define XCD_BAR_WORDS 3456
#define XB_SPIN_CAP (1u << 20)
__device__ __forceinline__ unsigned xb_ld(unsigned* p)              { return __hip_atomic_load(p, __ATOMIC_RELAXED, __HIP_MEMORY_SCOPE_AGENT); }
__device__ __forceinline__ unsigned xb_add(unsigned* p, unsigned v) { return __hip_atomic_fetch_add(p, v, __ATOMIC_RELAXED, __HIP_MEMORY_SCOPE_AGENT); }
__device__ __forceinline__ unsigned xb_xcc_id() { return (unsigned)__builtin_amdgcn_s_getreg((3 << 11) | 20) & 0xFu; }
#define XB_SPIN(cond, bar) do { unsigned _sp = 0; while (cond) { __builtin_amdgcn_s_sleep(1); \
    if ((++_sp & 255u) == 0u) { if (xb_ld(&(bar)[XB_TMO])) break; if (_sp > XB_SPIN_CAP) { atomicAdd(&(bar)[XB_TMO], 1u); break; } } } } while (0)
__device__ __forceinline__ void xcd_barrier_post(unsigned* bar) { if (opaque_tid() == 0) (void)xb_add(&bar[XB_XCNT(xb_xcc_id())], 1u); }
__device__ __forceinline__ void xcd_barrier_complete(unsigned* bar, unsigned x, unsigned& nloc, unsigned& nx) {
    const unsigned G = gridDim.x;
    unsigned sum, cnt, mine, sp = 0u;
    for (;;) {
        sum = 0u; cnt = 0u; mine = 0u;
#pragma unroll
        for (unsigned j = 0; j < 16; ++j) { const unsigned c = xb_ld(&bar[XB_XCNT(j)]); sum += c; cnt += (c > 0u) ? 1u : 0u; mine = (j == x) ? c : mine; }
        if (sum == G) break;
        __builtin_amdgcn_s_sleep(1);
        if ((++sp & 255u) == 0u) { if (xb_ld(&bar[XB_TMO])) break; if (sp > XB_SPIN_CAP) { atomicAdd(&bar[XB_TMO], 1u); break; } }
    }
    nloc = mine > 0u ? mine : 1u; nx = cnt > 0u ? cnt : 1u;
}
__device__ __forceinline__ void xcd_barrier(unsigned* bar, volatile LAS unsigned* st) {
    asm volatile("s_waitcnt vmcnt(0)" ::: "memory");
    __syncthreads();
    if (opaque_tid() == 0) {
        const unsigned x = xb_xcc_id();
        __builtin_amdgcn_s_waitcnt(0);
        unsigned nloc = st[0], nx = st[1];
        if (nloc == 0u) { xcd_barrier_complete(bar, x, nloc, nx); st[0] = nloc; st[1] = nx; }
        const unsigned old = xb_add(&bar[XB_XSUB(x)], 1u);
        const unsigned gen = old / nloc;
        if (old + 1u == (gen + 1u) * nloc) {
            __builtin_amdgcn_fence(__ATOMIC_RELEASE, "agent");
            asm volatile("s_waitcnt vmcnt(0)" ::: "memory");
            const unsigned og = xb_add(&bar[XB_TOP], 1u);
            const unsigned tg = og / nx;
            if (og + 1u == (tg + 1u) * nx) xb_add(&bar[XB_TOPGEN], 1u);
            else XB_SPIN(xb_ld(&bar[XB_TOPGEN]) == tg, bar);
            __builtin_amdgcn_fence(__ATOMIC_ACQUIRE, "agent");
            xb_add(&bar[XB_XGEN(x)], 1u);
            asm volatile("s_waitcnt vmcnt(0)" ::: "memory");
        } else {
            XB_SPIN(xb_ld(&bar[XB_XGEN(x)]) == gen, bar);
            __builtin_amdgcn_fence(__ATOMIC_ACQUIRE, "agent");
            asm volatile("s_waitcnt vmcnt(0)" ::: "memory");
        }
    }
    __syncthreads();
}

namespace pg8 {
constexpr int BM = 256, BK = 64, HALF = 128, HTB = HALF * BK * 2, STAGE_BYTES = 8 * HTB, NXCD = 8, WGM = 8;
__device__ __forceinline__ int lds_byte(int r, int c) { const int st = (r >> 4) * 2 + (c >> 5), rr = r & 15, cc = c & 31, ob = rr * 64 + cc * 2; return st * 1024 + (ob ^ (((ob >> 9) & 1) << 5)); }
__device__ __forceinline__ void stage_rc(int b, int& R, int& C) { const int st = b / 1024, sb = b % 1024, swz = sb ^ (((sb >> 9) & 1) << 5); R = (st >> 1) * 16 + swz / 64; C = (st & 1) * 32 + (swz % 64) / 2; }
__device__ __forceinline__ int perm32(int rho) { const int n = rho >> 4, i = rho & 15; return 8 * (i >> 2) + 4 * n + (i & 3); }
struct Unit { int pm, pn; };
struct Gemm { const bf16_t* A; const bf16_t* Bt; int M, N, K, lda, ldb; };
struct StaticOrder {
    int nM, nN, nwg, G, c;
    __device__ void init(int M, int N, int G_, int c_) { nM = M / BM; nN = N / BM; nwg = nM * nN; G = G_; c = c_; }
    __device__ bool next(int i, Unit& u) const {
        const long L = (long)i * G + c; if (L >= nwg) return false;
        int wgid = (int)L; { const int q = nwg / NXCD, r = nwg % NXCD, xcd = wgid % NXCD, off = wgid / NXCD; wgid = (xcd < r ? xcd * (q + 1) : r * (q + 1) + (xcd - r) * q) + off; }
        const int nig = WGM * nN, gid = wgid / nig, fm = gid * WGM, gsz = (nM - fm) < WGM ? (nM - fm) : WGM;
        u.pm = fm + ((wgid % nig) % gsz); u.pn = (wgid % nig) / gsz; return true;
    }
};

template <class Epi>
__device__ __forceinline__ void gemm_phase(LAS unsigned char* lds, const Gemm g, const StaticOrder& S, const Epi& E) {
    const int tid = opaque_tid(), wid = __builtin_amdgcn_readfirstlane(tid >> 6), lane = tid & 63, wr = wid >> 2, wc = wid & 3, fr = lane & 15, fq = lane >> 4;
    const int K = g.K, nt = K / BK;
    unsigned voffA[2], voffB[2];
#pragma unroll
    for (int i = 0; i < 2; ++i) { int R, C; stage_rc(tid * 16 + i * 8192, R, C); const int Rb = Epi::PERM ? ((R & ~31) + perm32(R & 31)) : R;
        voffA[i] = (unsigned)(R * g.lda + C) * 2u; voffB[i] = (unsigned)(Rb * g.ldb + C) * 2u; }
    const size_t kstep = (size_t)(BK * 2);
    const size_t hstepA = (size_t)HALF * g.lda * 2, hstepB = (size_t)HALF * g.ldb * 2;
    const size_t tstepA = 2 * hstepA, tstepB = 2 * hstepB;
    const unsigned ldsw = (unsigned)wid * 1024u;
    const int aoff = lds_byte(wr * 64 + fr, fq * 8), boff = lds_byte(wc * 32 + fr, fq * 8);
#define PG8_SA(b, h) (((b) * 2 + (h)) * HTB)
#define PG8_SB(b, h) ((4 + (b) * 2 + (h)) * HTB)
#define PG8_STAGE(bufoff, gbase, voff) do { _Pragma("unroll") for (int _i = 0; _i < 2; ++_i) \
        __builtin_amdgcn_global_load_lds((const unsigned*)((const char*)(gbase) + (voff)[_i]), (LAS unsigned*)(lds + (bufoff) + ldsw + _i * 8192), 16, 0, 0); } while (0)
#define PG8_LDA(dst, b, h) do { _Pragma("unroll") for (int m = 0; m < 4; ++m) _Pragma("unroll") for (int k = 0; k < 2; ++k) dst[m][k] = *(const LAS bf16x8*)(lds + PG8_SA(b, h) + aoff + m * 2048 + k * 1024); } while (0)
#define PG8_LDB(dst, b, h) do { _Pragma("unroll") for (int n = 0; n < 2; ++n) _Pragma("unroll") for (int k = 0; k < 2; ++k) dst[n][k] = *(const LAS bf16x8*)(lds + PG8_SB(b, h) + boff + n * 2048 + k * 1024); } while (0)
#define PG8_MMA(ai, bj, At, Bt) do { __builtin_amdgcn_s_setprio(1); _Pragma("unroll") for (int m = 0; m < 4; ++m) _Pragma("unroll") for (int n = 0; n < 2; ++n) _Pragma("unroll") for (int k = 0; k < 2; ++k) \
        acc[ai][bj][m][n] = __builtin_amdgcn_mfma_f32_16x16x32_bf16(Bt[n][k], At[m][k], acc[ai][bj][m][n], 0, 0, 0); __builtin_amdgcn_s_setprio(0); } while (0)
#define PG8_WAIT_V(n) asm volatile("s_waitcnt vmcnt(" #n ")" ::: "memory")
#define PG8_WAIT_L(n) asm volatile("s_waitcnt lgkmcnt(" #n ")" ::: "memory")
#define PG8_BAR __builtin_amdgcn_s_barrier()
#define PG8_SCHED __builtin_amdgcn_sched_barrier(0)
    Unit cur, nxt; int ui = 0;
    if (!S.next(0, cur)) return;
    f32x4 acc[2][2][4][2];
#pragma unroll
    for (int a = 0; a < 2; ++a)
#pragma unroll
        for (int b = 0; b < 2; ++b)
#pragma unroll
            for (int m = 0; m < 4; ++m)
#pragma unroll
                for (int n = 0; n < 2; ++n) acc[a][b][m][n] = (f32x4){0.f, 0.f, 0.f, 0.f};
    bf16x8 At[4][2], B0[2][2], B1[2][2];
    const char* cA = (const char*)g.A + (size_t)cur.pm * tstepA; const char* cB = (const char*)g.Bt + (size_t)cur.pn * tstepB;
    PG8_STAGE(PG8_SB(0, 0), cB, voffB); PG8_STAGE(PG8_SA(0, 0), cA, voffA); PG8_STAGE(PG8_SB(0, 1), cB + hstepB, voffB); PG8_STAGE(PG8_SA(0, 1), cA + hstepA, voffA);
    if (wr == 1) PG8_BAR;
    PG8_WAIT_V(4); PG8_BAR;
    PG8_STAGE(PG8_SB(1, 0), cB + kstep, voffB); PG8_STAGE(PG8_SA(1, 0), cA + kstep, voffA); PG8_STAGE(PG8_SB(1, 1), cB + hstepB + kstep, voffB);
    PG8_WAIT_V(6); PG8_BAR;
    for (;;) {
        const bool has_next = S.next(ui + 1, nxt);
        const char* nA = has_next ? (const char*)g.A + (size_t)nxt.pm * tstepA : cA; const char* nB = has_next ? (const char*)g.Bt + (size_t)nxt.pn * tstepB : cB;
        for (int t = 0; t < nt; t += 2) {
            const bool last = (t == nt - 2);
            const char* a1 = cA + (size_t)(t + 1) * kstep;
            const char* a2 = last ? nA : cA + (size_t)(t + 2) * kstep; const char* b2 = last ? nB : cB + (size_t)(t + 2) * kstep;
            const char* a3 = a2 + kstep; const char* b3 = b2 + kstep;
            PG8_LDB(B0, 0, 0); PG8_SCHED; PG8_LDA(At, 0, 0); PG8_STAGE(PG8_SA(1, 1), a1 + hstepA, voffA);
            PG8_WAIT_L(8); PG8_BAR; PG8_WAIT_L(0); PG8_MMA(0, 0, At, B0); PG8_BAR; PG8_SCHED;
            PG8_LDB(B1, 0, 1); PG8_STAGE(PG8_SB(0, 0), b2, voffB);
            PG8_BAR; PG8_WAIT_L(0); PG8_MMA(0, 1, At, B1); PG8_BAR;
            PG8_LDA(At, 0, 1); PG8_STAGE(PG8_SA(0, 0), a2, voffA);
            PG8_BAR; PG8_WAIT_L(0); PG8_MMA(1, 0, At, B0); PG8_BAR; PG8_SCHED;
            PG8_STAGE(PG8_SB(0, 1), b2 + hstepB, voffB);
            PG8_WAIT_V(6); PG8_BAR; PG8_MMA(1, 1, At, B1); PG8_BAR;
            PG8_LDB(B0, 1, 0); PG8_SCHED; PG8_LDA(At, 1, 0); PG8_STAGE(PG8_SA(0, 1), a2 + hstepA, voffA);
            PG8_WAIT_L(8); PG8_BAR; PG8_WAIT_L(0); PG8_MMA(0, 0, At, B0); PG8_BAR; PG8_SCHED;
            PG8_LDB(B1, 1, 1); PG8_STAGE(PG8_SB(1, 0), b3, voffB);
            PG8_BAR; PG8_WAIT_L(0); PG8_MMA(0, 1, At, B1); PG8_BAR;
            PG8_LDA(At, 1, 1); PG8_STAGE(PG8_SA(1, 0), a3, voffA);
            PG8_BAR; PG8_WAIT_L(0); PG8_MMA(1, 0, At, B0); PG8_BAR; PG8_SCHED;
            PG8_STAGE(PG8_SB(1, 1), b3 + hstepB, voffB);
            PG8_WAIT_V(6); PG8_BAR; PG8_MMA(1, 1, At, B1); PG8_BAR;
            if constexpr (Epi::HOOK) { if ((((t + 2) & 3) == 0) && !last) E.hook(acc, cur, (t + 2) >> 2, wr, wc, fr, fq); }
        }
        E(acc, cur, wr, wc, fr, fq);
        if (!has_next) break;
#pragma unroll
        for (int a = 0; a < 2; ++a)
#pragma unroll
            for (int b = 0; b < 2; ++b)
#pragma unroll
                for (int m = 0; m < 4; ++m)
#pragma unroll
                    for (int n = 0; n < 2; ++n) acc[a][b][m][n] = (f32x4){0.f, 0.f, 0.f, 0.f};
        cur = nxt; cA = nA; cB = nB; ++ui;
    }
    PG8_WAIT_V(0);
    if (wr == 0) PG8_BAR;
    PG8_BAR;
#undef PG8_SA
#undef PG8_SB
#undef PG8_STAGE
#undef PG8_LDA
#undef PG8_LDB
#undef PG8_MMA
#undef PG8_WAIT_V
#undef PG8_WAIT_L
#undef PG8_BAR
#undef PG8_SCHED
}
}
using pg8::Unit;

struct EpiSwiglu {
    static constexpr bool HOOK = false;
    static constexpr bool PERM = true;
    bf16_t* HID;
    __device__ __forceinline__ void operator()(const f32x4 (&acc)[2][2][4][2], const Unit& u, int wr, int wc, int fr, int fq) const {
        const int row0 = u.pm * 256 + wr * 64 + fr, col0 = u.pn * 128 + wc * 32 + 8 * fq;
#pragma unroll
        for (int ai = 0; ai < 2; ++ai)
#pragma unroll
            for (int m = 0; m < 4; ++m) {
                const int row = row0 + ai * 128 + m * 16;
                float hv[8];
#pragma unroll
                for (int n = 0; n < 2; ++n)
#pragma unroll
                    for (int j = 0; j < 4; ++j) { const float a = acc[ai][0][m][n][j], b = acc[ai][1][m][n][j]; hv[4 * n + j] = a * sigmoidf_(a) * b; }
                u32x4 w; w.x = cvt_pk_bf16(hv[0], hv[1]); w.y = cvt_pk_bf16(hv[2], hv[3]); w.z = cvt_pk_bf16(hv[4], hv[5]); w.w = cvt_pk_bf16(hv[6], hv[7]);
                *(u32x4*)(HID + (size_t)row * FH + col0) = w;
            }
    }
};
struct EpiResid {
    static constexpr bool HOOK = false;
    static constexpr bool PERM = false;
    float* Hl; float* Hc; const float* gate; float coef;
    __device__ __forceinline__ void operator()(const f32x4 (&acc)[2][2][4][2], const Unit& u, int wr, int wc, int fr, int fq) const {
        const int row0 = u.pm * 256 + wr * 64 + fr, col0 = u.pn * 256 + wc * 32 + 4 * fq;
#pragma unroll
        for (int ai = 0; ai < 2; ++ai)
#pragma unroll
            for (int m = 0; m < 4; ++m) {
                const int row = row0 + ai * 128 + m * 16;
                float* hp = row < RL ? Hl + (size_t)row * 1024 : Hc + (size_t)(row - RL) * 1024;
                const float* gp = gate + (row < RL ? (row >> 13) : 4) * 9216;
#pragma unroll
                for (int bj = 0; bj < 2; ++bj)
#pragma unroll
                    for (int n = 0; n < 2; ++n) {
                        const int c = col0 + bj * 128 + n * 16;
                        const f32x4 g4 = *(const f32x4*)(gp + c); f32x4 h4 = *(const f32x4*)(hp + c);
                        h4 += (g4 * coef) * acc[ai][bj][m][n];
                        *(f32x4*)(hp + c) = h4;
                    }
            }
    }
};
struct EpiPJ {
    static constexpr bool HOOK = false;
    static constexpr bool PERM = true;
    bf16_t* PJ; unsigned char* G8;
    __device__ __forceinline__ void operator()(const f32x4 (&acc)[2][2][4][2], const Unit& u, int wr, int wc, int fr, int fq) const {
        const int row0 = u.pm * 256 + wr * 64 + fr, c0 = wc * 32 + 8 * fq;
        if (u.pn < 9) {
#pragma unroll
            for (int ai = 0; ai < 2; ++ai)
#pragma unroll
                for (int m = 0; m < 4; ++m) {
                    const int row = row0 + ai * 128 + m * 16;
#pragma unroll
                    for (int bj = 0; bj < 2; ++bj) {
                        const f32x4 v0 = acc[ai][bj][m][0], v1 = acc[ai][bj][m][1];
                        u32x4 w; w.x = cvt_pk_bf16(v0[0], v0[1]); w.y = cvt_pk_bf16(v0[2], v0[3]); w.z = cvt_pk_bf16(v1[0], v1[1]); w.w = cvt_pk_bf16(v1[2], v1[3]);
                        *(u32x4*)(PJ + (size_t)row * PJW + u.pn * 256 + bj * 128 + c0) = w;
                    }
                }
        } else {
#pragma unroll
            for (int ai = 0; ai < 2; ++ai)
#pragma unroll
                for (int m = 0; m < 4; ++m) {
                    const int row = row0 + ai * 128 + m * 16;
#pragma unroll
                    for (int bj = 0; bj < 2; ++bj) {
                        unsigned q[8];
#pragma unroll
                        for (int n = 0; n < 2; ++n)
#pragma unroll
                            for (int j = 0; j < 4; ++j) { int v = (int)(sigmoidf_(acc[ai][bj][m][n][j]) * 256.0f); q[4 * n + j] = (unsigned)(v > 255 ? 255 : v); }
                        u32x2 w; w.x = q[0] | (q[1] << 8) | (q[2] << 16) | (q[3] << 24); w.y = q[4] | (q[5] << 8) | (q[6] << 16) | (q[7] << 24);
                        *(u32x2*)(G8 + (size_t)row * 4096 + (u.pn - 9) * 256 + bj * 128 + c0) = w;
                    }
                }
        }
    }
};
struct EpiMLA {
    static constexpr bool HOOK = false;
    static constexpr bool PERM = true;
    bf16_t *MQ, *MK, *MV; const float* RSTD; const float2* RT;
    __device__ __forceinline__ void operator()(const f32x4 (&acc)[2][2][4][2], const Unit& u, int wr, int wc, int fr, int fq) const {
        const int row0 = u.pm * 256 + wr * 64 + fr;
#pragma unroll
        for (int bj = 0; bj < 2; ++bj) {
            const int cg0 = u.pn * 256 + bj * 128 + wc * 32;
            if (cg0 >= 896) continue;
#pragma unroll
            for (int ai = 0; ai < 2; ++ai)
#pragma unroll
                for (int m = 0; m < 4; ++m) {
                    __builtin_amdgcn_sched_barrier(0);
                    const int row = row0 + ai * 128 + m * 16;
                    float v[8];
                    if (cg0 < 384) {
                        const float rs = RSTD[row * 2];
#pragma unroll
                        for (int n = 0; n < 2; ++n)
#pragma unroll
                            for (int j = 0; j < 4; ++j) v[4 * n + j] = acc[ai][bj][m][n][j] * rs;
                        const int d0 = cg0 % 96;
                        if (d0 == 64) {
                            const bool lat = row < RL; const int t = row & 8191; const int pos = (fq >> 1) ? (t & 63) : (t >> 6); const bool isx2 = fq & 1;
#pragma unroll
                            for (int e = 0; e < 8; ++e) {
                                const float pr = shflx(v[e], 16);
                                const float2 cs = RT[pos * 8 + e];
                                const float r = isx2 ? (pr * cs.y + v[e] * cs.x) : (v[e] * cs.x - pr * cs.y);
                                v[e] = lat ? r : v[e];
                            }
                        }
                        u32x4 w; w.x = cvt_pk_bf16(v[0], v[1]); w.y = cvt_pk_bf16(v[2], v[3]); w.z = cvt_pk_bf16(v[4], v[5]); w.w = cvt_pk_bf16(v[6], v[7]);
                        *(u32x4*)(MQ + (size_t)row * 384 + cg0 + 8 * fq) = w;
                    } else {
                        const float rs = RSTD[row * 2 + 1];
#pragma unroll
                        for (int n = 0; n < 2; ++n)
#pragma unroll
                            for (int j = 0; j < 4; ++j) v[4 * n + j] = acc[ai][bj][m][n][j] * rs;
                        const int cp = cg0 - 384, hd = cp >> 7, d0 = cp & 127;
                        u32x4 w; w.x = cvt_pk_bf16(v[0], v[1]); w.y = cvt_pk_bf16(v[2], v[3]); w.z = cvt_pk_bf16(v[4], v[5]); w.w = cvt_pk_bf16(v[6], v[7]);
                        if (d0 < 64) *(u32x4*)(MK + (size_t)row * 384 + hd * 96 + d0 + 8 * fq) = w;
                        else *(u32x4*)(MV + (size_t)row * 256 + hd * 64 + (d0 - 64) + 8 * fq) = w;
                    }
                }
        }
    }
};
struct EpiMerge {
    static constexpr bool PERM = true, HOOK = true;
    const unsigned char* G8; bf16_t* MG;
    __device__ __forceinline__ void hook(f32x4 (&acc)[2][2][4][2], const Unit& u, int nb, int wr, int wc, int fr, int fq) const {
        const int row0 = u.pm * 256 + wr * 64 + fr, c0 = u.pn * 256 + wc * 32 + 8 * fq;
#pragma unroll
        for (int ai = 0; ai < 2; ++ai)
#pragma unroll
            for (int m = 0; m < 4; ++m) {
                const int row = row0 + ai * 128 + m * 16;
#pragma unroll
                for (int bj = 0; bj < 2; ++bj) {
                    __builtin_amdgcn_sched_barrier(0);
                    const unsigned char* gp = G8 + (size_t)row * 4096 + nb * 1024 + c0 + bj * 128;
                    const u32x2 ga = *(const u32x2*)(gp - 1024), gb = *(const u32x2*)gp;
#pragma unroll
                    for (int e = 0; e < 8; ++e) { const unsigned qa = ((e < 4 ? ga.x : ga.y) >> (8 * (e & 3))) & 255u, qb = ((e < 4 ? gb.x : gb.y) >> (8 * (e & 3))) & 255u;
                        acc[ai][bj][m][e >> 2][e & 3] *= ((float)qa + 0.5f) * fast_rcp((float)qb + 0.5f); }
                }
            }
    }
    __device__ __forceinline__ void operator()(const f32x4 (&acc)[2][2][4][2], const Unit& u, int wr, int wc, int fr, int fq) const {
        const int row0 = u.pm * 256 + wr * 64 + fr, c0 = u.pn * 256 + wc * 32 + 8 * fq;
#pragma unroll
        for (int ai = 0; ai < 2; ++ai)
#pragma unroll
            for (int m = 0; m < 4; ++m) {
                const int row = row0 + ai * 128 + m * 16;
#pragma unroll
                for (int bj = 0; bj < 2; ++bj) {
                    __builtin_amdgcn_sched_barrier(0);
                    const int c = c0 + bj * 128;
                    const u32x2 gq = *(const u32x2*)(G8 + (size_t)row * 4096 + 3 * 1024 + c);
                    float v[8];
#pragma unroll
                    for (int e = 0; e < 8; ++e) { const unsigned q = ((e < 4 ? gq.x : gq.y) >> (8 * (e & 3))) & 255u; v[e] = ((float)q + 0.5f) * (1.0f / 256.0f) * acc[ai][bj][m][e >> 2][e & 3]; }
                    u32x4 w; w.x = cvt_pk_bf16(v[0], v[1]); w.y = cvt_pk_bf16(v[2], v[3]); w.z = cvt_pk_bf16(v[4], v[5]); w.w = cvt_pk_bf16(v[6], v[7]);
                    *(u32x4*)(MG + (size_t)row * 1024 + c) = w;
                }
            }
    }
};

template <class F>
__device__ __forceinline__ void wt_rows64(bf16_t* dst, int K, F srcval, int ldd = 0) {
    if (ldd == 0) ldd = K;
    const int tid_ = opaque_tid(); const int nl = tid_ & 63, kq = tid_ >> 6;
    for (int k0 = kq * 8; k0 < K; k0 += 64) {
        float v[8];
#pragma unroll
        for (int j = 0; j < 8; ++j) v[j] = srcval(nl, k0 + j);
        u32x4 w; w.x = cvt_pk_bf16(v[0], v[1]); w.y = cvt_pk_bf16(v[2], v[3]); w.z = cvt_pk_bf16(v[4], v[5]); w.w = cvt_pk_bf16(v[6], v[7]);
        *(u32x4*)(dst + (size_t)nl * ldd + k0) = w;
    }
}

__device__ void layer_prep_phase(PK p, int l, LAS unsigned char* lds) {
    unsigned char* ws = p->ws;
    const int nW = 404, nItems = nW + (l == 0 ? 288 + 1 : 0);
    for (int it = opaque_bid(); it < nItems; it += opaque_gdim()) {
        if (it < 176) {
            const int f = it / 88, j = it % 88; const float* src = p->ffn_w_in + ((size_t)(l * 2 + f) * 1024) * 5632;
            bf16_t* dst = (bf16_t*)(ws + OFF_W1) + ((size_t)f * 5632 + j * 64) * 1024;
            wt_rows64(dst, 1024, [&](int nl, int k) { const int np = j * 64 + nl, pn = np >> 8, wi = np & 255; const int col = wi < 128 ? pn * 128 + wi : FH + pn * 128 + (wi - 128); return src[(size_t)k * 5632 + col]; });
        } else if (it < 208) {
            const int q = it - 176, f = q / 16, j = q % 16; const float* src = p->ffn_w_out + ((size_t)(l * 2 + f) * FH) * 1024;
            bf16_t* dst = (bf16_t*)(ws + OFF_W2) + ((size_t)f * 1024 + j * 64) * FH;
            wt_rows64(dst, FH, [&](int nl, int k) { return src[(size_t)k * 1024 + j * 64 + nl]; });
        } else if (it < 308) {
            const int j = it - 208; const float* src = p->mix_w_in + (size_t)l * 1024 * 6304;
            bf16_t* dst = (bf16_t*)(ws + OFF_WM) + (size_t)j * 64 * 1024;
            wt_rows64(dst, 1024, [&](int nl, int k) { const int np = j * 64 + nl; const int col = np < 2208 ? np : (np < 2304 ? -1 : np - 96); return col < 0 ? 0.f : src[(size_t)k * 6304 + col]; });
        } else if (it < 324) {
            const int j = it - 308; const float* src = p->mix_w_out + (size_t)l * 1024 * 1024;
            bf16_t* dst = (bf16_t*)(ws + OFF_WO) + (size_t)j * 64 * 1024;
            wt_rows64(dst, 1024, [&](int nl, int k) { return src[(size_t)k * 1024 + j * 64 + nl]; });
        } else if (it < 372) {
            const int q = it - 324, bi = 1 + q / 16, j = q % 16; const float* src = p->branch_w_out + ((size_t)(l * 4 + bi) * 256) * 1024;
            bf16_t* dst = (bf16_t*)(ws + OFF_WB) + (size_t)j * 64 * 1024 + bi * 256;
            wt_rows64(dst, 256, [&](int nl, int k) { return src[(size_t)k * 1024 + j * 64 + nl]; }, 1024);
        } else if (it < 388) {
            const int j = it - 372; const float* wb = p->branch_w_out + ((size_t)(l * 4) * 256) * 1024; const float* pw = p->pool_w + (size_t)l * 4 * 64 * 64; const float* ps = p->pool_scale + l * 256;
            bf16_t* dst = (bf16_t*)(ws + OFF_WB) + (size_t)j * 64 * 1024;
            wt_rows64(dst, 256, [&](int nl, int k) { const int gI = k >> 6, n = j * 64 + nl; const float* pr = pw + (size_t)k * 64; float s = 0.f;
                for (int e = 0; e < 64; ++e) s += pr[e] * ps[gI * 64 + e] * wb[(size_t)(gI * 64 + e) * 1024 + n]; return s; }, 1024);
        } else if (it < 404) {
            const int j = it - 388; const float* wq = p->mla_w_qb + (size_t)l * 256 * 384; const float* wk = p->mla_w_kvb + (size_t)l * 128 * 512;
            const float* gq = p->mla_q_norm_g + l * 256; const float* gk = p->mla_kv_norm_g + l * 128;
            bf16_t* dst = (bf16_t*)(ws + OFF_WL) + (size_t)j * 64 * 384;
            wt_rows64(dst, 384, [&](int nl, int k) { const int n = j * 64 + nl;
                if (n < 384) return k < 256 ? gq[k] * wq[(size_t)k * 384 + n] : 0.f;
                if (n < 896) return k >= 256 ? gk[k - 256] * wk[(size_t)(k - 256) * 512 + (n - 384)] : 0.f;
                return 0.f; });
        } else if (it < 404 + 288) {
            const int q = it - 404, ll = q / 144, cb = q % 144;
            LAS float* sc = (LAS float*)lds;
            LAS float* red = (LAS float*)(lds + 5 * 1024 * 4);
            __syncthreads();
            for (int i = opaque_tid(); i < 5 * 1024; i += 512) { const int r = i >> 10, k = i & 1023; const float cv = r < 4 ? p->c[r * 1024 + k] : p->c_ctx[k]; sc[i] = cv * sigmoidf_(cv); }
            __syncthreads();
            const int jl = opaque_tid() & 63, kg = opaque_tid() >> 6; const int col = cb * 64 + jl;
            const float* wsrc = p->ada_w + (size_t)ll * 1024 * 9216 + col;
            float a0 = 0.f, a1 = 0.f, a2 = 0.f, a3 = 0.f, a4 = 0.f;
            for (int k = kg * 128; k < kg * 128 + 128; ++k) { const float wv = wsrc[(size_t)k * 9216]; a0 += sc[k] * wv; a1 += sc[1024 + k] * wv; a2 += sc[2048 + k] * wv; a3 += sc[3072 + k] * wv; a4 += sc[4096 + k] * wv; }
            red[(kg * 5 + 0) * 64 + jl] = a0; red[(kg * 5 + 1) * 64 + jl] = a1; red[(kg * 5 + 2) * 64 + jl] = a2; red[(kg * 5 + 3) * 64 + jl] = a3; red[(kg * 5 + 4) * 64 + jl] = a4;
            __syncthreads();
            if (opaque_tid() < 320) { const int r = opaque_tid() >> 6; float s = p->ada_b[ll * 9216 + col];
                for (int q2 = 0; q2 < 8; ++q2) s += red[(q2 * 5 + r) * 64 + jl];
                ((float*)(ws + OFF_MOD))[(size_t)(ll * 5 + r) * 9216 + col] = s; }
        } else {
            for (int i = opaque_tid(); i < 1024; i += 512) { const int pos = i >> 3, fi = i & 7; const float inv = exp2f(-(float)fi * 0.125f * 13.287712379549449f); const float ang = (float)pos * inv;
                ((float2*)(ws + OFF_ROPE))[i] = make_float2(cosf(ang), sinf(ang)); }
        }
    }
}

__device__ void norm_mod_phase(const float* srcL, const float* srcC, float* cpyL, float* cpyC, const float* g, const float* mod, bf16_t* TN, int nrows) {
    const int tid_ = opaque_tid(); const int lane = tid_ & 63, gw = opaque_bid() * 8 + (tid_ >> 6), nw = opaque_gdim() * 8;
    for (int row = gw; row < nrows; row += nw) {
        const bool lat = row < RL;
        const float* sp = lat ? srcL + (size_t)row * 1024 : srcC + (size_t)(row - RL) * 1024;
        const float* mp = mod + (lat ? (row >> 13) : 4) * 9216;
        f32x4 v[4]; float ss = 0.f;
#pragma unroll
        for (int j = 0; j < 4; ++j) { v[j] = *(const f32x4*)(sp + 256 * j + 4 * lane); ss += v[j][0] * v[j][0] + v[j][1] * v[j][1] + v[j][2] * v[j][2] + v[j][3] * v[j][3]; }
        if (cpyL) { float* cp = lat ? cpyL + (size_t)row * 1024 : cpyC + (size_t)(row - RL) * 1024;
#pragma unroll
            for (int j = 0; j < 4; ++j) *(f32x4*)(cp + 256 * j + 4 * lane) = v[j]; }
        ss = wave_sum(ss);
        const float rstd = rsqrtf(ss * (1.0f / 1024.0f) + NEPS);
#pragma unroll
        for (int j = 0; j < 4; ++j) {
            const int col = 256 * j + 4 * lane;
            const f32x4 gg = *(const f32x4*)(g + col), sh = *(const f32x4*)(mp + col), sc = *(const f32x4*)(mp + 1024 + col);
            float o[4];
#pragma unroll
            for (int e = 0; e < 4; ++e) o[e] = (v[j][e] * rstd * gg[e]) * (1.0f + sc[e]) + sh[e];
            u32x2 w; w.x = cvt_pk_bf16(o[0], o[1]); w.y = cvt_pk_bf16(o[2], o[3]);
            *(u32x2*)(TN + (size_t)row * 1024 + col) = w;
        }
    }
}
__device__ void final_norm_phase(float* H, const float* g) {
    const int tid_ = opaque_tid(); const int lane = tid_ & 63, gw = opaque_bid() * 8 + (tid_ >> 6), nw = opaque_gdim() * 8;
    for (int row = gw; row < RL; row += nw) {
        float* sp = H + (size_t)row * 1024; f32x4 v[4]; float ss = 0.f;
#pragma unroll
        for (int j = 0; j < 4; ++j) { v[j] = *(const f32x4*)(sp + 256 * j + 4 * lane); ss += v[j][0] * v[j][0] + v[j][1] * v[j][1] + v[j][2] * v[j][2] + v[j][3] * v[j][3]; }
        ss = wave_sum(ss);
        const float rstd = rsqrtf(ss * (1.0f / 1024.0f) + NEPS);
#pragma unroll
        for (int j = 0; j < 4; ++j) { const f32x4 gg = *(const f32x4*)(g + 256 * j + 4 * lane); *(f32x4*)(sp + 256 * j + 4 * lane) = v[j] * rstd * gg; }
    }
}

__device__ void prep_phase(PK p) {
    unsigned char* ws = p->ws;
    bf16_t* PJ = (bf16_t*)(ws + OFF_B); bf16_t* YB = (bf16_t*)(ws + OFF_A); bf16_t* MK = (bf16_t*)(ws + OFF_MK); float* RSTD = (float*)(ws + OFF_RSTD);
    const float2* RT = (const float2*)(ws + OFF_ROPE);
    const int tid_ = opaque_tid(); const int lane = tid_ & 63, gw = opaque_bid() * 8 + (tid_ >> 6), nw = opaque_gdim() * 8;
    for (int row = gw; row < RA; row += nw) {
        const bool lat = row < RL;
        int t, n; if (lat) { t = row & 8191; n = 8192; } else { t = (row - RL) & 255; n = 256; }
        const int sbase = row - t;
        bf16_t* prow = PJ + (size_t)row * PJW;
        {
            const int wdw = 2 << (lane >> 4); const int lo = max(t - wdw / 2, 0), hi = min(t - wdw / 2 + wdw, n);
            float s0 = 0.f, s1 = 0.f, s2 = 0.f, s3 = 0.f;
            for (int tt = lo; tt < hi; ++tt) { const u32x2 v = *(const u32x2*)(PJ + (size_t)(sbase + tt) * PJW + 4 * lane); s0 += bf_lo(v.x); s1 += bf_hi(v.x); s2 += bf_lo(v.y); s3 += bf_hi(v.y); }
            const float ic = 1.0f / (float)(hi - lo); const u32x2 sv = *(const u32x2*)(prow + 4 * lane);
            u32x2 w; w.x = cvt_pk_bf16(s0 * ic - bf_lo(sv.x), s1 * ic - bf_hi(sv.x)); w.y = cvt_pk_bf16(s2 * ic - bf_lo(sv.y), s3 * ic - bf_hi(sv.y));
            *(u32x2*)(YB + (size_t)row * 1024 + 4 * lane) = w;
        }
        {
            const u32x2 q = *(const u32x2*)(prow + C_MQ + 4 * lane); const unsigned kv = *(const unsigned*)(prow + C_MKV + 2 * lane);
            float sq = bf_lo(q.x) * bf_lo(q.x) + bf_hi(q.x) * bf_hi(q.x) + bf_lo(q.y) * bf_lo(q.y) + bf_hi(q.y) * bf_hi(q.y);
            float sk = bf_lo(kv) * bf_lo(kv) + bf_hi(kv) * bf_hi(kv);
            sq = wave_sum(sq); sk = wave_sum(sk);
            if (lane == 0) { RSTD[row * 2] = rsqrtf(sq * (1.0f / 256.0f) + NEPS); RSTD[row * 2 + 1] = rsqrtf(sk * (1.0f / 128.0f) + NEPS); }
        }
        if (lane < 34) {
            const bool iskr = lane >= 32; const int a = lane & 1;
            bf16_t* ep = iskr ? prow + C_MKR + a * 16 : prow + ((lane >> 4) ? C_DK : C_DQ) + ((lane >> 1) & 7) * 32 + a * 16;
            const u32x4 e0 = *(const u32x4*)ep, e1 = *(const u32x4*)(ep + 8);
            float x1[8], x2[8];
            x1[0] = bf_lo(e0.x); x1[1] = bf_hi(e0.x); x1[2] = bf_lo(e0.y); x1[3] = bf_hi(e0.y); x1[4] = bf_lo(e0.z); x1[5] = bf_hi(e0.z); x1[6] = bf_lo(e0.w); x1[7] = bf_hi(e0.w);
            x2[0] = bf_lo(e1.x); x2[1] = bf_hi(e1.x); x2[2] = bf_lo(e1.y); x2[3] = bf_hi(e1.y); x2[4] = bf_lo(e1.z); x2[5] = bf_hi(e1.z); x2[6] = bf_lo(e1.w); x2[7] = bf_hi(e1.w);
            if (lat) { const int pos = a ? (t & 63) : (t >> 6);
#pragma unroll
                for (int i = 0; i < 8; ++i) { const float2 cs = RT[pos * 8 + i]; const float o1 = x1[i] * cs.x - x2[i] * cs.y, o2 = x1[i] * cs.y + x2[i] * cs.x; x1[i] = o1; x2[i] = o2; } }
            u32x4 w0, w1; w0.x = cvt_pk_bf16(x1[0], x1[1]); w0.y = cvt_pk_bf16(x1[2], x1[3]); w0.z = cvt_pk_bf16(x1[4], x1[5]); w0.w = cvt_pk_bf16(x1[6], x1[7]);
            w1.x = cvt_pk_bf16(x2[0], x2[1]); w1.y = cvt_pk_bf16(x2[2], x2[3]); w1.z = cvt_pk_bf16(x2[4], x2[5]); w1.w = cvt_pk_bf16(x2[6], x2[7]);
            if (iskr) {
#pragma unroll
                for (int hh = 0; hh < 4; ++hh) { bf16_t* kp = MK + (size_t)row * 384 + hh * 96 + 64 + a * 16; *(u32x4*)kp = w0; *(u32x4*)(kp + 8) = w1; }
            } else if (lat) { *(u32x4*)ep = w0; *(u32x4*)(ep + 8) = w1; }
        }
    }
}

#define MFMA32(a, b, c) __builtin_amdgcn_mfma_f32_32x32x16_bf16((a), (b), (c), 0, 0, 0)
typedef float f32x2 __attribute__((ext_vector_type(2)));
template <int MODE>
__device__ __forceinline__ void attn_item(PK p, int l, LAS unsigned char* lds, int b, int h, int qb, bool ctxq, float lam, float lam_init) {
    constexpr int NCOMP = (MODE == 1) ? 2 : 1, NKS = (MODE == 0) ? 4 : ((MODE == 1) ? 2 : 6), KW = NCOMP * NKS * 16, KCH = KW / 8, KSTR = KW * 2 + 16, VSTR = 192;
    constexpr int KBUF = 64 * KSTR, VBUF = 64 * VSTR, BUFSZ = KBUF + VBUF, BIAS_OFF = 3 * BUFSZ;
    constexpr bool STAG = (MODE != 0);
    const int tid = opaque_tid(), w = tid >> 6, lane = tid & 63, g = lane >> 5, l32 = lane & 31;
    unsigned char* ws = p->ws;
    const bf16_t* PJ = (const bf16_t*)(ws + OFF_B);
    const bf16_t *Qp, *Kp, *Vp; int ldq, ldk, ldv, outoff; float scale;
    if (MODE == 0) { Qp = PJ + C_NQ + 64 * h; Kp = PJ + C_NK + 64 * h; Vp = PJ + C_NV + 64 * h; ldq = ldk = ldv = PJW; outoff = 256 + 64 * h; scale = 0.125f; }
    else if (MODE == 1) { Qp = PJ + C_DQ + 64 * h; Kp = PJ + C_DK + 64 * h; Vp = PJ + C_DV + 64 * h; ldq = ldk = ldv = PJW; outoff = 512 + 64 * h; scale = 0.17677669529663687f; }
    else { Qp = (const bf16_t*)(ws + OFF_D) + 96 * h; Kp = (const bf16_t*)(ws + OFF_MK) + 96 * h; Vp = (const bf16_t*)(ws + OFF_MV) + 64 * h; ldq = ldk = 384; ldv = 256; outoff = 768 + 64 * h; scale = 0.10206207261596575f; }
    const float cs = scale * LOG2E;
    int qrow0, loc0, nloc;
    if (ctxq) { qrow0 = RL + b * 256; loc0 = 0; nloc = 0; }
    else { qrow0 = b * 8192 + qb * 256;
        if (MODE == 0) { const int r0 = qb * 4; loc0 = clampi(r0 - 4, 0, 120); nloc = clampi(r0 - 1, 0, 120) + 8 - loc0; } else { loc0 = 0; nloc = 128; } }
    const int nt = nloc + 4;
    const bool nabias = (MODE == 0) && !ctxq;
    const bool late = STAG && (w >= 4);
    const int rw = qb * 4 + (w >> 1), sw = clampi(rw - 4, 0, 120);
    const int jq = 32 * (w & 1) + l32, cst = clampi(jq - 8, 0, 48);
    if (nabias && tid < 465) ((LAS float*)(lds + BIAS_OFF))[tid] = p->na_rpb[(size_t)(l * 4 + h) * 465 + tid] * LOG2E;

    const size_t qrow = (size_t)qrow0 + 32 * w + l32;
    bf16x8 qf[NCOMP * NKS];
#pragma unroll
    for (int i = 0; i < NCOMP * NKS; ++i) {
        const u32x4 raw = *(const u32x4*)(Qp + qrow * ldq + 16 * i + 8 * g);
        u32x4 sc4; sc4.x = cvt_pk_bf16(bf_lo(raw.x) * cs, bf_hi(raw.x) * cs); sc4.y = cvt_pk_bf16(bf_lo(raw.y) * cs, bf_hi(raw.y) * cs);
        sc4.z = cvt_pk_bf16(bf_lo(raw.z) * cs, bf_hi(raw.z) * cs); sc4.w = cvt_pk_bf16(bf_lo(raw.w) * cs, bf_hi(raw.w) * cs);
        qf[i] = __builtin_bit_cast(bf16x8, sc4);
    }

    const int kr0 = tid / KCH, kc0 = tid % KCH, kr1 = (tid + 512) / KCH, kc1 = (tid + 512) % KCH, vr = tid >> 3, vc = tid & 7;
    const bool hask1 = (KCH == 12) && (tid < 256);
    u32x4 rk0, rk1 = (u32x4){0u, 0u, 0u, 0u}, rv;
#define TILE_ROW(t) ((t) < nloc ? (b * 8192 + 64 * (loc0 + (t))) : (RL + b * 256 + 64 * ((t) - nloc)))
#define LOAD_TILE(t) do { const size_t _tb = (size_t)TILE_ROW(t); rk0 = *(const u32x4*)(Kp + (_tb + kr0) * ldk + kc0 * 8); \
        if (hask1) rk1 = *(const u32x4*)(Kp + (_tb + kr1) * ldk + kc1 * 8); rv = *(const u32x4*)(Vp + (_tb + vr) * ldv + vc * 8); } while (0)
#define STORE_TILE(buf) do { LAS unsigned char* _kb = lds + (buf) * BUFSZ; *(LAS u32x4*)(_kb + kr0 * KSTR + kc0 * 16) = rk0; \
        if (hask1) *(LAS u32x4*)(_kb + kr1 * KSTR + kc1 * 16) = rk1; *(LAS u32x4*)(_kb + KBUF + vr * VSTR + vc * 16) = rv; } while (0)

    float mrun[NCOMP], lsum[NCOMP]; f32x16 O[NCOMP][2];
#pragma unroll
    for (int c = 0; c < NCOMP; ++c) { mrun[c] = -1e30f; lsum[c] = 0.f;
#pragma unroll
        for (int dt = 0; dt < 2; ++dt)
#pragma unroll
            for (int r = 0; r < 16; ++r) O[c][dt][r] = 0.f; }
    bf16x8 P[NCOMP][2][2];
#pragma unroll
    for (int c = 0; c < NCOMP; ++c)
#pragma unroll
        for (int kt = 0; kt < 2; ++kt)
#pragma unroll
            for (int s2 = 0; s2 < 2; ++s2) P[c][kt][s2] = (bf16x8){0, 0, 0, 0, 0, 0, 0, 0};

    LOAD_TILE(0); STORE_TILE(0); __syncthreads();
    const int koff = l32 * KSTR + g * 16;
    const int i16 = lane & 15, tq = i16 >> 2, tp = i16 & 3, blk = (lane >> 4) & 1;
    const int voff = (4 * g + tq) * VSTR + (16 * blk + 4 * tp) * 2;
#define PV_TILE(buf) do { LAS unsigned char* _vb = lds + (buf) * BUFSZ + KBUF + voff; \
        _Pragma("unroll") for (int kt = 0; kt < 2; ++kt) { bf16x8 vf[2][2]; \
            _Pragma("unroll") for (int s2 = 0; s2 < 2; ++s2) _Pragma("unroll") for (int dt = 0; dt < 2; ++dt) { LAS unsigned char* vp = _vb + (32 * kt + 16 * s2) * VSTR + dt * 64; \
                const s16x4 lo = __builtin_amdgcn_ds_read_tr16_b64_v4i16((LAS s16x4*)vp); const s16x4 hi = __builtin_amdgcn_ds_read_tr16_b64_v4i16((LAS s16x4*)(vp + 8 * VSTR)); \
                vf[s2][dt] = __builtin_shufflevector(lo, hi, 0, 1, 2, 3, 4, 5, 6, 7); } \
            _Pragma("unroll") for (int s2 = 0; s2 < 2; ++s2) _Pragma("unroll") for (int dt = 0; dt < 2; ++dt) _Pragma("unroll") for (int c = 0; c < NCOMP; ++c) O[c][dt] = MFMA32(vf[s2][dt], P[c][kt][s2], O[c][dt]); } } while (0)

    bool pend = false; int pbuf = 0, cbuf = 0;
    for (int t = 0; t < nt; ++t) {
        const bool more = (t + 1 < nt);
        if (more) LOAD_TILE(t + 1);
        bool active = true; int krow = 0;
        if (nabias && t < nloc) { krow = loc0 + t; active = (krow >= sw) && (krow < sw + 8); }
        if (active) {
            LAS unsigned char* Kb = lds + cbuf * BUFSZ + koff;
            f32x16 S[NCOMP][2];
#pragma unroll
            for (int c = 0; c < NCOMP; ++c)
#pragma unroll
                for (int kt = 0; kt < 2; ++kt) {
                    bf16x8 kf[NKS];
#pragma unroll
                    for (int ks = 0; ks < NKS; ++ks) kf[ks] = *(const LAS bf16x8*)(Kb + kt * 32 * KSTR + (c * NKS + ks) * 32);
#pragma unroll
                    for (int r = 0; r < 16; ++r) S[c][kt][r] = 0.f;
#pragma unroll
                    for (int ks = 0; ks < NKS; ++ks) S[c][kt] = MFMA32(kf[ks], qf[c * NKS + ks], S[c][kt]);
                }
            if (STAG && late && pend) PV_TILE(pbuf);
#pragma unroll
            for (int c = 0; c < NCOMP; ++c) {
                float mx = -1e30f;
                if (nabias && t < nloc) {
                    const LAS float* bt = (const LAS float*)(lds + BIAS_OFF) + (krow - rw + 7) * 31;
#pragma unroll
                    for (int kt = 0; kt < 2; ++kt)
#pragma unroll
                        for (int r = 0; r < 16; ++r) { const int jk = 32 * kt + (r & 3) + 8 * (r >> 2) + 4 * g; const bool ok = (jk >= cst) && (jk < cst + 16);
                            const float bv = bt[clampi(jk - jq + 15, 0, 30)]; const float xv = ok ? (S[c][kt][r] + bv) : -1e30f; S[c][kt][r] = xv; mx = fmaxf(mx, xv); }
                } else {
#pragma unroll
                    for (int kt = 0; kt < 2; ++kt)
#pragma unroll
                        for (int r = 0; r < 16; r += 2) mx = fmaxf(fmaxf(mx, S[c][kt][r]), S[c][kt][r + 1]);
                }
                mx = fmaxf(mx, shflx(mx, 32));
                const float mnew = fmaxf(mrun[c], mx);
                if (__any(mnew > mrun[c])) {
                    const float alpha = fast_exp2(mrun[c] - mnew); lsum[c] *= alpha;
#pragma unroll
                    for (int dt = 0; dt < 2; ++dt) O[c][dt] *= alpha;
                    mrun[c] = mnew;
                }
                f32x2 rs2 = (f32x2){0.f, 0.f}; const f32x2 m2 = (f32x2){mnew, mnew};
#pragma unroll
                for (int kt = 0; kt < 2; ++kt)
#pragma unroll
                    for (int s2 = 0; s2 < 2; ++s2) { u32x4 pk;
#pragma unroll
                        for (int e = 0; e < 4; ++e) { const f32x2 d = (f32x2){S[c][kt][8 * s2 + 2 * e], S[c][kt][8 * s2 + 2 * e + 1]} - m2;
                            f32x2 ev; ev.x = fast_exp2(d.x); ev.y = fast_exp2(d.y); rs2 += ev; pk[e] = cvt_pk_bf16(ev.x, ev.y); }
                        P[c][kt][s2] = __builtin_bit_cast(bf16x8, pk); }
                lsum[c] += rs2.x + rs2.y;
            }
            if (!(STAG && late)) PV_TILE(cbuf); else { pend = true; pbuf = cbuf; }
        }
        const int nbuf = (cbuf == 2) ? 0 : cbuf + 1;
        if (more) STORE_TILE(nbuf);
        __syncthreads();
        cbuf = nbuf;
    }
    if (STAG && late && pend) PV_TILE(pbuf);
#undef PV_TILE
#undef TILE_ROW
#undef LOAD_TILE
#undef STORE_TILE
    float inv[NCOMP];
#pragma unroll
    for (int c = 0; c < NCOMP; ++c) { const float lt = lsum[c] + shflx(lsum[c], 32); inv[c] = 1.0f / lt; }
    bf16_t* op = (bf16_t*)(ws + OFF_A) + qrow * 1024 + outoff;
    if (MODE == 1) {
        const float li1 = lam * inv[NCOMP - 1]; float ss = 0.f;
#pragma unroll
        for (int dt = 0; dt < 2; ++dt)
#pragma unroll
            for (int r = 0; r < 16; ++r) { const float o = O[0][dt][r] * inv[0] - li1 * O[NCOMP - 1][dt][r]; O[0][dt][r] = o; ss += o * o; }
        ss += shflx(ss, 32);
        const float rstd = rsqrtf(ss * (1.0f / 64.0f) + NEPS) * (1.0f - lam_init);
        const float* sg = p->diff_subln_g + l * 64;
#pragma unroll
        for (int dt = 0; dt < 2; ++dt)
#pragma unroll
            for (int rq = 0; rq < 4; ++rq) { const int dv = 32 * dt + 8 * rq + 4 * g; const f32x4 gg = *(const f32x4*)(sg + dv);
                u32x2 wv; wv.x = cvt_pk_bf16(O[0][dt][4 * rq] * rstd * gg[0], O[0][dt][4 * rq + 1] * rstd * gg[1]); wv.y = cvt_pk_bf16(O[0][dt][4 * rq + 2] * rstd * gg[2], O[0][dt][4 * rq + 3] * rstd * gg[3]);
                *(u32x2*)(op + dv) = wv; }
    } else {
#pragma unroll
        for (int dt = 0; dt < 2; ++dt)
#pragma unroll
            for (int rq = 0; rq < 4; ++rq) { const int dv = 32 * dt + 8 * rq + 4 * g;
                u32x2 wv; wv.x = cvt_pk_bf16(O[0][dt][4 * rq] * inv[0], O[0][dt][4 * rq + 1] * inv[0]); wv.y = cvt_pk_bf16(O[0][dt][4 * rq + 2] * inv[0], O[0][dt][4 * rq + 3] * inv[0]);
                *(u32x2*)(op + dv) = wv; }
    }
    __syncthreads();
}

__device__ void attn_phase(PK p, int l, LAS unsigned char* lds) {
    const float lam_init = (l == 0) ? 0.2f : 0.35550906759502f;
    const float* dl = p->diff_lambda + l * 128;
    float d01 = 0.f, d23 = 0.f;
    for (int i = 0; i < 32; ++i) { d01 += dl[i] * dl[32 + i]; d23 += dl[64 + i] * dl[96 + i]; }
    const float lam = expf(d01) - expf(d23) + lam_init;
    const int nItems = 1536 + (l == 0 ? 48 : 0);
    for (int it = opaque_bid(); it < nItems; it += opaque_gdim()) {
        if (it < 1536) {
            const int ty = it >> 9, idx = it & 511, b = idx >> 7, h = (idx >> 5) & 3, qb = idx & 31;
            if (ty == 0) attn_item<1>(p, l, lds, b, h, qb, false, lam, lam_init);
            else if (ty == 1) attn_item<2>(p, l, lds, b, h, qb, false, lam, lam_init);
            else attn_item<0>(p, l, lds, b, h, qb, false, lam, lam_init);
        } else {
            const int idx = it - 1536, ty = idx >> 4, b = (idx >> 2) & 3, h = idx & 3;
            if (ty == 0) attn_item<1>(p, l, lds, b, h, 0, true, lam, lam_init);
            else if (ty == 1) attn_item<2>(p, l, lds, b, h, 0, true, lam, lam_init);
            else attn_item<0>(p, l, lds, b, h, 0, true, lam, lam_init);
        }
    }
}

constexpr int PH_PER_LAYER = 14, N_PHASES = 2 * PH_PER_LAYER + 1;

__device__ __forceinline__ void run_phase(PK p, int ph, LAS unsigned char* lds, float rcoef) {
    unsigned char* ws = p->ws;
    pg8::StaticOrder S;
    if (ph == N_PHASES - 1) { final_norm_phase(p->out, p->final_norm_g); return; }
    int l = ph / PH_PER_LAYER; const int q = ph % PH_PER_LAYER;
#define OPQL asm volatile("" : "+s"(l))
#define HC ((float*)(ws + OFF_HC))
#define MOD ((const float*)(ws + OFF_MOD) + (size_t)l * 5 * 9216)
#define TN ((bf16_t*)(ws + OFF_A))
#define HID ((bf16_t*)(ws + OFF_B))
#define Mlate ((l == 0) ? RA : RL)
    switch (q) {
    case 0: OPQL; layer_prep_phase(p, l, lds); break;
    case 1: OPQL; if (l == 0) norm_mod_phase(p->x, p->ctx, p->out, HC, p->norm_g + (l * 3 + 0) * 1024, MOD, TN, RA);
            else norm_mod_phase(p->out, HC, nullptr, nullptr, p->norm_g + (l * 3 + 0) * 1024, MOD, TN, RA); break;
    case 2: case 12: { OPQL; const int f = (q == 2) ? 0 : 1; const int M = (q == 2) ? RA : Mlate;
        pg8::Gemm g{TN, (const bf16_t*)(ws + OFF_W1) + (size_t)f * 5632 * 1024, M, 5632, 1024, 1024, 1024}; S.init(M, 5632, opaque_gdim(), opaque_bid());
        EpiSwiglu E{HID}; pg8::gemm_phase(lds, g, S, E); } break;
    case 3: case 13: { OPQL; const int f = (q == 3) ? 0 : 1; const int M = (q == 3) ? RA : Mlate;
        pg8::Gemm g{HID, (const bf16_t*)(ws + OFF_W2) + (size_t)f * 1024 * FH, M, 1024, FH, FH, FH}; S.init(M, 1024, opaque_gdim(), opaque_bid());
        EpiResid E{p->out, HC, MOD + (q == 3 ? 2 : 8) * 1024, 0.5f * rcoef}; pg8::gemm_phase(lds, g, S, E); } break;
    case 4: OPQL; norm_mod_phase(p->out, HC, nullptr, nullptr, p->norm_g + (l * 3 + 1) * 1024, MOD + 3 * 1024, TN, RA); break;
    case 5: { OPQL; pg8::Gemm g{TN, (const bf16_t*)(ws + OFF_WM), RA, 6400, 1024, 1024, 1024}; S.init(RA, 6400, opaque_gdim(), opaque_bid());
        EpiPJ E{(bf16_t*)(ws + OFF_B), ws + OFF_C}; pg8::gemm_phase(lds, g, S, E); } break;
    case 6: prep_phase(p); break;
    case 7: { OPQL; pg8::Gemm g{(const bf16_t*)(ws + OFF_B) + C_MQ, (const bf16_t*)(ws + OFF_WL), RA, 1024, 384, PJW, 384}; S.init(RA, 1024, opaque_gdim(), opaque_bid());
        EpiMLA E{(bf16_t*)(ws + OFF_D), (bf16_t*)(ws + OFF_MK), (bf16_t*)(ws + OFF_MV), (const float*)(ws + OFF_RSTD), (const float2*)(ws + OFF_ROPE)}; pg8::gemm_phase(lds, g, S, E); } break;
    case 8: OPQL; attn_phase(p, l, lds); break;
    case 9: { OPQL; pg8::Gemm g{(const bf16_t*)(ws + OFF_A), (const bf16_t*)(ws + OFF_WB), Mlate, 1024, 1024, 1024, 1024}; S.init(Mlate, 1024, opaque_gdim(), opaque_bid());
        EpiMerge E{ws + OFF_C, (bf16_t*)(ws + OFF_D)}; pg8::gemm_phase(lds, g, S, E); } break;
    case 10: { OPQL; pg8::Gemm g{(const bf16_t*)(ws + OFF_D), (const bf16_t*)(ws + OFF_WO), Mlate, 1024, 1024, 1024, 1024}; S.init(Mlate, 1024, opaque_gdim(), opaque_bid());
        EpiResid E{p->out, HC, MOD + 5 * 1024, rcoef}; pg8::gemm_phase(lds, g, S, E); } break;
    case 11: OPQL; norm_mod_phase(p->out, HC, nullptr, nullptr, p->norm_g + (l * 3 + 2) * 1024, MOD + 6 * 1024, TN, Mlate); break;
    }
#undef OPQL
#undef HC
#undef MOD
#undef TN
#undef HID
#undef Mlate
}

__global__ void __launch_bounds__(512, 2) fwd_megakernel(Params p) {
    extern __shared__ __attribute__((aligned(16))) unsigned char shm[];
    LAS unsigned char* lds = (LAS unsigned char*)shm;
#if N_LAUNCH_MODE == 1
    cg::grid_group grid = cg::this_grid();
    const int ph_lo = p.ph_lo, ph_hi = p.ph_hi;
    volatile LAS unsigned* st = (volatile LAS unsigned*)(lds + pg8::STAGE_BYTES);
    unsigned* bar = (unsigned*)(p.ws + OFF_BAR);
    if (opaque_tid() < 4) st[opaque_tid()] = 0u;
    if (opaque_bid() == 0) for (int i = opaque_tid(); i < XCD_BAR_WORDS; i += 512) bar[i] = 0u;
    __syncthreads();
    for (int ph = ph_lo; ph < ph_hi; ++ph) {
        const int qq = ph % PH_PER_LAYER;
        const int nrep = (PROBE_MASK && ph < N_PHASES - 1 && qq != 6 && ((PROBE_MASK >> qq) & 1)) ? 2 : 1;
        for (int rep = 0; rep < nrep; ++rep) {
            PK pk = (PK)__builtin_amdgcn_kernarg_segment_ptr();
            asm volatile("" : "+s"(pk));
            run_phase(pk, ph, lds, rep ? 0.0f : 1.0f);
            if (ph == ph_lo && rep == 0) { grid.sync(); xcd_barrier_post(bar); }
            else if (ph + 1 < ph_hi || rep + 1 < nrep) xcd_barrier(bar, st);
        }
    }
#else
    const int ph_lo = p.ph_lo, ph_hi = p.ph_hi;
    for (int ph = ph_lo; ph < ph_hi; ++ph) { PK pk = (PK)__builtin_amdgcn_kernarg_segment_ptr(); asm volatile("" : "+s"(pk)); run_phase(pk, ph, lds, 1.0f); }
#endif
}

extern "C" void kernel_launch(void* const* d_in, const int* in_sizes, int n_in, void* d_out, int out_size, void* d_ws, size_t ws_size, hipStream_t stream) {
    constexpr int LDS_BYTES = pg8::STAGE_BYTES + 16;
    static int grid_blocks = 0;
    if (grid_blocks == 0) {
        if (n_in != 22 || ws_size < WS_END) { fprintf(stderr, "kernel_launch: unexpected inputs (n_in %d, ws %zu < %zu)\n", n_in, ws_size, (size_t)WS_END); grid_blocks = -1; return; }
        int dev = 0, cus = 0, per_cu = 0;
        hipGetDevice(&dev); hipDeviceGetAttribute(&cus, hipDeviceAttributeMultiprocessorCount, dev);
        if (hipFuncSetAttribute((const void*)fwd_megakernel, hipFuncAttributeMaxDynamicSharedMemorySize, LDS_BYTES) != hipSuccess) { fprintf(stderr, "hipFuncSetAttribute failed\n"); grid_blocks = -1; return; }
        if (hipOccupancyMaxActiveBlocksPerMultiprocessor(&per_cu, (const void*)fwd_megakernel, 512, LDS_BYTES) != hipSuccess || per_cu < 1) per_cu = 1;
        (void)hipGetLastError();
        grid_blocks = cus * 1;
    }
    if (grid_blocks < 0) return;
    Params hp{};
    const float** pp = (const float**)&hp;
    for (int i = 0; i < 22; ++i) pp[i] = (const float*)d_in[i];
    hp.out = (float*)d_out; hp.ws = (unsigned char*)d_ws;
#if N_LAUNCH_MODE == 1
    hp.ph_lo = 0; hp.ph_hi = N_PHASES;
    void* args[] = {&hp};
    hipError_t e = hipLaunchCooperativeKernel((const void*)fwd_megakernel, dim3(grid_blocks), dim3(512), args, LDS_BYTES, stream);
    if (e != hipSuccess) fprintf(stderr, "cooperative launch failed: %s (grid %d)\n", hipGetErrorString(e), grid_blocks);
#else
    for (int ph = 0; ph < N_PHASES; ++ph) { hp.ph_lo = ph; hp.ph_hi = ph + 1; hipLaunchKernelGGL(fwd_megakernel, dim3(grid_blocks), dim3(512), LDS_BYTES, stream, hp); }
#endif
}
```

```cpp
#include <hip/hip_runtime.h>
#include <hip/hip_cooperative_groups.h>
#include <cstdio>
namespace cg = cooperative_groups;

#define LAS __attribute__((address_space(3)))
typedef unsigned short bf16_t;
typedef short bf16x8 __attribute__((ext_vector_type(8)));
typedef short s16x4 __attribute__((ext_vector_type(4)));
typedef float f32x4 __attribute__((ext_vector_type(4)));
typedef float f32x16 __attribute__((ext_vector_type(16)));
typedef unsigned u32x4 __attribute__((ext_vector_type(4)));
typedef unsigned u32x2 __attribute__((ext_vector_type(2)));

#ifndef PROBE_MASK
#define PROBE_MASK 0
#endif
#ifndef N_LAUNCH_MODE
#define N_LAUNCH_MODE 1
#endif

constexpr int RL = 32768, RA = 33792, FH = 2816;
constexpr int PJW = 2304;
constexpr int C_NQ = 256, C_NK = 512, C_NV = 768, C_DQ = 1024, C_DK = 1280, C_DV = 1536, C_MQ = 1792, C_MKV = 2048, C_MKR = 2176;
constexpr float LOG2E = 1.4426950408889634f;
constexpr float NEPS = 1e-6f;
constexpr int XCD_BAR_WORDS_C = 3456;

constexpr size_t SZ_W1 = 2ull * 5632 * 1024 * 2, SZ_W2 = 2ull * 1024 * 2816 * 2, SZ_WM = 6400ull * 1024 * 2, SZ_WL = 1024ull * 384 * 2, SZ_WB = 4ull * 1024 * 256 * 2, SZ_WO = 1024ull * 1024 * 2;
constexpr size_t OFF_W1 = 0, OFF_W2 = OFF_W1 + SZ_W1, OFF_WM = OFF_W2 + SZ_W2, OFF_WL = OFF_WM + SZ_WM, OFF_WB = OFF_WL + SZ_WL, OFF_WO = OFF_WB + SZ_WB;
constexpr size_t OFF_HC = OFF_WO + SZ_WO;
constexpr size_t OFF_MOD = OFF_HC + 1024ull * 1024 * 4;
constexpr size_t OFF_ROPE = OFF_MOD + 2ull * 5 * 9216 * 4;
constexpr size_t OFF_RSTD = OFF_ROPE + 128 * 8 * 8;
constexpr size_t OFF_A = OFF_RSTD + (size_t)RA * 2 * 4;
constexpr size_t OFF_B = OFF_A + (size_t)RA * 1024 * 2;
constexpr size_t OFF_C = OFF_B + (size_t)RA * PJW * 2;
constexpr size_t OFF_D = OFF_C + (size_t)RA * 4096;
constexpr size_t OFF_MK = OFF_D + (size_t)RA * 384 * 2, OFF_MV = OFF_MK + (size_t)RA * 384 * 2;
constexpr size_t OFF_BAR = OFF_D + (size_t)RA * 1024 * 2;
constexpr size_t WS_END = OFF_BAR + XCD_BAR_WORDS_C * 4;

struct Params {
    const float *x, *c, *ctx, *c_ctx, *ada_w, *ada_b, *norm_g, *ffn_w_in, *ffn_w_out, *mix_w_in, *pool_w, *pool_scale, *na_rpb, *diff_lambda, *diff_subln_g,
        *mla_q_norm_g, *mla_kv_norm_g, *mla_w_qb, *mla_w_kvb, *branch_w_out, *mix_w_out, *final_norm_g;
    float* out; unsigned char* ws;
    int ph_lo, ph_hi;
};

typedef const __attribute__((address_space(4))) Params* PK;

typedef float f32x2_ __attribute__((ext_vector_type(2)));
typedef __bf16 bf16x2_ __attribute__((ext_vector_type(2)));
__device__ __forceinline__ unsigned cvt_pk_bf16(float lo, float hi) { const f32x2_ v = {lo, hi}; return __builtin_bit_cast(unsigned, __builtin_convertvector(v, bf16x2_)); }
__device__ __forceinline__ float bf_lo(unsigned u) { return __uint_as_float(u << 16); }
__device__ __forceinline__ float bf_hi(unsigned u) { return __uint_as_float(u & 0xffff0000u); }
__device__ __forceinline__ float fast_exp2(float x) { return __builtin_amdgcn_exp2f(x); }
__device__ __forceinline__ float fast_rcp(float x) { return __builtin_amdgcn_rcpf(x); }
__device__ __forceinline__ float sigmoidf_(float x) { return fast_rcp(1.0f + fast_exp2(-x * LOG2E)); }
__device__ __forceinline__ float shflx(float v, int m) {
    int lane = __builtin_amdgcn_mbcnt_hi(~0u, __builtin_amdgcn_mbcnt_lo(~0u, 0)); asm volatile("" : "+v"(lane));
    return __int_as_float(__builtin_amdgcn_ds_bpermute((lane ^ m) << 2, __float_as_int(v)));
}
__device__ __forceinline__ float wave_sum(float v) {
    v += shflx(v, 32); v += shflx(v, 16); v += shflx(v, 8); v += shflx(v, 4); v += shflx(v, 2); v += shflx(v, 1); return v;
}
__device__ __forceinline__ int opaque_tid() { int t = threadIdx.x; asm volatile("" : "+v"(t)); return t; }
__device__ __forceinline__ int opaque_bid() { int t = blockIdx.x; asm volatile("" : "+s"(t)); return t; }
__device__ __forceinline__ int opaque_gdim() { int t = gridDim.x; asm volatile("" : "+s"(t)); return t; }
__device__ __forceinline__ int clampi(int v, int lo, int hi) { return v < lo ? lo : (v > hi ? hi : v); }

#define XB_TMO      128
#define XB_XCNT(j)  (256  + 64 * (j))
#define XB_XSUB(j)  (1280 + 64 * (j))
#define XB_XGEN(j)  (2304 + 64 * (j))
#define XB_TOP      3328
#define XB_TOPGEN   3392
#define XCD_BAR_WORDS 3456
#define XB_SPIN_CAP (1u << 20)
__device__ __forceinline__ unsigned xb_ld(unsigned* p)              { return __hip_atomic_load(p, __ATOMIC_RELAXED, __HIP_MEMORY_SCOPE_AGENT); }
__device__ __forceinline__ unsigned xb_add(unsigned* p, unsigned v) { return __hip_atomic_fetch_add(p, v, __ATOMIC_RELAXED, __HIP_MEMORY_SCOPE_AGENT); }
__device__ __forceinline__ unsigned xb_xcc_id() { return (unsigned)__builtin_amdgcn_s_getreg((3 << 11) | 20) & 0xFu; }
#define XB_SPIN(cond, bar) do { unsigned _sp = 0; while (cond) { __builtin_amdgcn_s_sleep(1); \
    if ((++_sp & 255u) == 0u) { if (xb_ld(&(bar)[XB_TMO])) break; if (_sp > XB_SPIN_CAP) { atomicAdd(&(bar)[XB_TMO], 1u); break; } } } } while (0)
__device__ __forceinline__ void xcd_barrier_post(unsigned* bar) { if (opaque_tid() == 0) (void)xb_add(&bar[XB_XCNT(xb_xcc_id())], 1u); }
__device__ __forceinline__ void xcd_barrier_complete(unsigned* bar, unsigned x, unsigned& nloc, unsigned& nx) {
    const unsigned G = gridDim.x;
    unsigned sum, cnt, mine, sp = 0u;
    for (;;) {
        sum = 0u; cnt = 0u; mine = 0u;
#pragma unroll
        for (unsigned j = 0; j < 16; ++j) { const unsigned c = xb_ld(&bar[XB_XCNT(j)]); sum += c; cnt += (c > 0u) ? 1u : 0u; mine = (j == x) ? c : mine; }
        if (sum == G) break;
        __builtin_amdgcn_s_sleep(1);
        if ((++sp & 255u) == 0u) { if (xb_ld(&bar[XB_TMO])) break; if (sp > XB_SPIN_CAP) { atomicAdd(&bar[XB_TMO], 1u); break; } }
    }
    nloc = mine > 0u ? mine : 1u; nx = cnt > 0u ? cnt : 1u;
}
__device__ __forceinline__ void xcd_barrier(unsigned* bar, volatile LAS unsigned* st) {
    asm volatile("s_waitcnt vmcnt(0)" ::: "memory");
    __syncthreads();
    if (opaque_tid() == 0) {
        const unsigned x = xb_xcc_id();
        __builtin_amdgcn_s_waitcnt(0);
        unsigned nloc = st[0], nx = st[1];
        if (nloc == 0u) { xcd_barrier_complete(bar, x, nloc, nx); st[0] = nloc; st[1] = nx; }
        const unsigned old = xb_add(&bar[XB_XSUB(x)], 1u);
        const unsigned gen = old / nloc;
        if (old + 1u == (gen + 1u) * nloc) {
            __builtin_amdgcn_fence(__ATOMIC_RELEASE, "agent");
            asm volatile("s_waitcnt vmcnt(0)" ::: "memory");
            const unsigned og = xb_add(&bar[XB_TOP], 1u);
            const unsigned tg = og / nx;
            if (og + 1u == (tg + 1u) * nx) xb_add(&bar[XB_TOPGEN], 1u);
            else XB_SPIN(xb_ld(&bar[XB_TOPGEN]) == tg, bar);
            __builtin_amdgcn_fence(__ATOMIC_ACQUIRE, "agent");
            xb_add(&bar[XB_XGEN(x)], 1u);
            asm volatile("s_waitcnt vmcnt(0)" ::: "memory");
        } else {
            XB_SPIN(xb_ld(&bar[XB_XGEN(x)]) == gen, bar);
            __builtin_amdgcn_fence(__ATOMIC_ACQUIRE, "agent");
            asm volatile("s_waitcnt vmcnt(0)" ::: "memory");
        }
    }
    __syncthreads();
}

namespace pg8 {
constexpr int BM = 256, BK = 64, HALF = 128, HTB = HALF * BK * 2, STAGE_BYTES = 8 * HTB, NXCD = 8, WGM = 8;
__device__ __forceinline__ int lds_byte(int r, int c) { const int st = (r >> 4) * 2 + (c >> 5), rr = r & 15, cc = c & 31, ob = rr * 64 + cc * 2; return st * 1024 + (ob ^ (((ob >> 9) & 1) << 5)); }
__device__ __forceinline__ void stage_rc(int b, int& R, int& C) { const int st = b / 1024, sb = b % 1024, swz = sb ^ (((sb >> 9) & 1) << 5); R = (st >> 1) * 16 + swz / 64; C = (st & 1) * 32 + (swz % 64) / 2; }
__device__ __forceinline__ int perm32(int rho) { const int n = rho >> 4, i = rho & 15; return 8 * (i >> 2) + 4 * n + (i & 3); }
struct Unit { int pm, pn; };
struct Gemm { const bf16_t* A; const bf16_t* Bt; int M, N, K, lda, ldb; };
struct StaticOrder {
    int nM, nN, nwg, G, c;
    __device__ void init(int M, int N, int G_, int c_) { nM = M / BM; nN = N / BM; nwg = nM * nN; G = G_; c = c_; }
    __device__ bool next(int i, Unit& u) const {
        const long L = (long)i * G + c; if (L >= nwg) return false;
        int wgid = (int)L; { const int q = nwg / NXCD, r = nwg % NXCD, xcd = wgid % NXCD, off = wgid / NXCD; wgid = (xcd < r ? xcd * (q + 1) : r * (q + 1) + (xcd - r) * q) + off; }
        const int nig = WGM * nN, gid = wgid / nig, fm = gid * WGM, gsz = (nM - fm) < WGM ? (nM - fm) : WGM;
        u.pm = fm + ((wgid % nig) % gsz); u.pn = (wgid % nig) / gsz; return true;
    }
};

template <class Epi>
__device__ __forceinline__ void gemm_phase(LAS unsigned char* lds, const Gemm g, const StaticOrder& S, const Epi& E) {
    const int tid = opaque_tid(), wid = __builtin_amdgcn_readfirstlane(tid >> 6), lane = tid & 63, wr = wid >> 2, wc = wid & 3, fr = lane & 15, fq = lane >> 4;
    const int K = g.K, nt = K / BK;
    unsigned voffA[2], voffB[2];
#pragma unroll
    for (int i = 0; i < 2; ++i) { int R, C; stage_rc(tid * 16 + i * 8192, R, C); const int Rb = Epi::PERM ? ((R & ~31) + perm32(R & 31)) : R;
        voffA[i] = (unsigned)(R * g.lda + C) * 2u; voffB[i] = (unsigned)(Rb * g.ldb + C) * 2u; }
    const size_t kstep = (size_t)(BK * 2);
    const size_t hstepA = (size_t)HALF * g.lda * 2, hstepB = (size_t)HALF * g.ldb * 2;
    const size_t tstepA = 2 * hstepA, tstepB = 2 * hstepB;
    const unsigned ldsw = (unsigned)wid * 1024u;
    const int aoff = lds_byte(wr * 64 + fr, fq * 8), boff = lds_byte(wc * 32 + fr, fq * 8);
#define PG8_SA(b, h) (((b) * 2 + (h)) * HTB)
#define PG8_SB(b, h) ((4 + (b) * 2 + (h)) * HTB)
#define PG8_STAGE(bufoff, gbase, voff) do { _Pragma("unroll") for (int _i = 0; _i < 2; ++_i) \
        __builtin_amdgcn_global_load_lds((const unsigned*)((const char*)(gbase) + (voff)[_i]), (LAS unsigned*)(lds + (bufoff) + ldsw + _i * 8192), 16, 0, 0); } while (0)
#define PG8_LDA(dst, b, h) do { _Pragma("unroll") for (int m = 0; m < 4; ++m) _Pragma("unroll") for (int k = 0; k < 2; ++k) dst[m][k] = *(const LAS bf16x8*)(lds + PG8_SA(b, h) + aoff + m * 2048 + k * 1024); } while (0)
#define PG8_LDB(dst, b, h) do { _Pragma("unroll") for (int n = 0; n < 2; ++n) _Pragma("unroll") for (int k = 0; k < 2; ++k) dst[n][k] = *(const LAS bf16x8*)(lds + PG8_SB(b, h) + boff + n * 2048 + k * 1024); } while (0)
#define PG8_MMA(ai, bj, At, Bt) do { __builtin_amdgcn_s_setprio(1); _Pragma("unroll") for (int m = 0; m < 4; ++m) _Pragma("unroll") for (int n = 0; n < 2; ++n) _Pragma("unroll") for (int k = 0; k < 2; ++k) \
        acc[ai][bj][m][n] = __builtin_amdgcn_mfma_f32_16x16x32_bf16(Bt[n][k], At[m][k], acc[ai][bj][m][n], 0, 0, 0); __builtin_amdgcn_s_setprio(0); } while (0)
#define PG8_WAIT_V(n) asm volatile("s_waitcnt vmcnt(" #n ")" ::: "memory")
#define PG8_WAIT_L(n) asm volatile("s_waitcnt lgkmcnt(" #n ")" ::: "memory")
#define PG8_BAR __builtin_amdgcn_s_barrier()
#define PG8_SCHED __builtin_amdgcn_sched_barrier(0)
    Unit cur, nxt; int ui = 0;
    if (!S.next(0, cur)) return;
    f32x4 acc[2][2][4][2];
#pragma unroll
    for (int a = 0; a < 2; ++a)
#pragma unroll
        for (int b = 0; b < 2; ++b)
#pragma unroll
            for (int m = 0; m < 4; ++m)
#pragma unroll
                for (int n = 0; n < 2; ++n) acc[a][b][m][n] = (f32x4){0.f, 0.f, 0.f, 0.f};
    bf16x8 At[4][2], B0[2][2], B1[2][2];
    const char* cA = (const char*)g.A + (size_t)cur.pm * tstepA; const char* cB = (const char*)g.Bt + (size_t)cur.pn * tstepB;
    PG8_STAGE(PG8_SB(0, 0), cB, voffB); PG8_STAGE(PG8_SA(0, 0), cA, voffA); PG8_STAGE(PG8_SB(0, 1), cB + hstepB, voffB); PG8_STAGE(PG8_SA(0, 1), cA + hstepA, voffA);
    if (wr == 1) PG8_BAR;
    PG8_WAIT_V(4); PG8_BAR;
    PG8_STAGE(PG8_SB(1, 0), cB + kstep, voffB); PG8_STAGE(PG8_SA(1, 0), cA + kstep, voffA); PG8_STAGE(PG8_SB(1, 1), cB + hstepB + kstep, voffB);
    PG8_WAIT_V(6); PG8_BAR;
    for (;;) {
        const bool has_next = S.next(ui + 1, nxt);
        const char* nA = has_next ? (const char*)g.A + (size_t)nxt.pm * tstepA : cA; const char* nB = has_next ? (const char*)g.Bt + (size_t)nxt.pn * tstepB : cB;
        for (int t = 0; t < nt; t += 2) {
            const bool last = (t == nt - 2);
            const char* a1 = cA + (size_t)(t + 1) * kstep;
            const char* a2 = last ? nA : cA + (size_t)(t + 2) * kstep; const char* b2 = last ? nB : cB + (size_t)(t + 2) * kstep;
            const char* a3 = a2 + kstep; const char* b3 = b2 + kstep;
            PG8_LDB(B0, 0, 0); PG8_SCHED; PG8_LDA(At, 0, 0); PG8_STAGE(PG8_SA(1, 1), a1 + hstepA, voffA);
            PG8_WAIT_L(8); PG8_BAR; PG8_WAIT_L(0); PG8_MMA(0, 0, At, B0); PG8_BAR; PG8_SCHED;
            PG8_LDB(B1, 0, 1); PG8_STAGE(PG8_SB(0, 0), b2, voffB);
            PG8_BAR; PG8_WAIT_L(0); PG8_MMA(0, 1, At, B1); PG8_BAR;
            PG8_LDA(At, 0, 1); PG8_STAGE(PG8_SA(0, 0), a2, voffA);
            PG8_BAR; PG8_WAIT_L(0); PG8_MMA(1, 0, At, B0); PG8_BAR; PG8_SCHED;
            PG8_STAGE(PG8_SB(0, 1), b2 + hstepB, voffB);
            PG8_WAIT_V(6); PG8_BAR; PG8_MMA(1, 1, At, B1); PG8_BAR;
            PG8_LDB(B0, 1, 0); PG8_SCHED; PG8_LDA(At, 1, 0); PG8_STAGE(PG8_SA(0, 1), a2 + hstepA, voffA);
            PG8_WAIT_L(8); PG8_BAR; PG8_WAIT_L(0); PG8_MMA(0, 0, At, B0); PG8_BAR; PG8_SCHED;
            PG8_LDB(B1, 1, 1); PG8_STAGE(PG8_SB(1, 0), b3, voffB);
            PG8_BAR; PG8_WAIT_L(0); PG8_MMA(0, 1, At, B1); PG8_BAR;
            PG8_LDA(At, 1, 1); PG8_STAGE(PG8_SA(1, 0), a3, voffA);
            PG8_BAR; PG8_WAIT_L(0); PG8_MMA(1, 0, At, B0); PG8_BAR; PG8_SCHED;
            PG8_STAGE(PG8_SB(1, 1), b3 + hstepB, voffB);
            PG8_WAIT_V(6); PG8_BAR; PG8_MMA(1, 1, At, B1); PG8_BAR;
            if constexpr (Epi::HOOK) { if ((((t + 2) & 3) == 0) && !last) E.hook(acc, cur, (t + 2) >> 2, wr, wc, fr, fq); }
        }
        E(acc, cur, wr, wc, fr, fq);
        if (!has_next) break;
#pragma unroll
        for (int a = 0; a < 2; ++a)
#pragma unroll
            for (int b = 0; b < 2; ++b)
#pragma unroll
                for (int m = 0; m < 4; ++m)
#pragma unroll
                    for (int n = 0; n < 2; ++n) acc[a][b][m][n] = (f32x4){0.f, 0.f, 0.f, 0.f};
        cur = nxt; cA = nA; cB = nB; ++ui;
    }
    PG8_WAIT_V(0);
    if (wr == 0) PG8_BAR;
    PG8_BAR;
#undef PG8_SA
#undef PG8_SB
#undef PG8_STAGE
#undef PG8_LDA
#undef PG8_LDB
#undef PG8_MMA
#undef PG8_WAIT_V
#undef PG8_WAIT_L
#undef PG8_BAR
#undef PG8_SCHED
}
}
using pg8::Unit;

__device__ __forceinline__ size_t g8_off(int row, int colg) { return ((size_t)(row >> 4) * 128 + (colg >> 5)) * 512 + (row & 15) * 32 + (colg & 31); }

struct EpiSwiglu {
    static constexpr bool HOOK = false;
    static constexpr bool PERM = true;
    bf16_t* HID;
    __device__ __forceinline__ void operator()(const f32x4 (&acc)[2][2][4][2], const Unit& u, int wr, int wc, int fr, int fq) const {
        const int row0 = u.pm * 256 + wr * 64 + fr, col0 = u.pn * 128 + wc * 32 + 8 * fq;
#pragma unroll
        for (int ai = 0; ai < 2; ++ai)
#pragma unroll
            for (int m = 0; m < 4; ++m) {
                const int row = row0 + ai * 128 + m * 16;
                float hv[8];
#pragma unroll
                for (int n = 0; n < 2; ++n)
#pragma unroll
                    for (int j = 0; j < 4; ++j) { const float a = acc[ai][0][m][n][j], b = acc[ai][1][m][n][j]; hv[4 * n + j] = a * sigmoidf_(a) * b; }
                u32x4 w; w.x = cvt_pk_bf16(hv[0], hv[1]); w.y = cvt_pk_bf16(hv[2], hv[3]); w.z = cvt_pk_bf16(hv[4], hv[5]); w.w = cvt_pk_bf16(hv[6], hv[7]);
                *(u32x4*)(HID + (size_t)row * FH + col0) = w;
            }
    }
};
struct EpiResid {
    static constexpr bool HOOK = false;
    static constexpr bool PERM = false;
    float* Hl; float* Hc; const float* gate; float coef;
    __device__ __forceinline__ void operator()(const f32x4 (&acc)[2][2][4][2], const Unit& u, int wr, int wc, int fr, int fq) const {
        const int row0 = u.pm * 256 + wr * 64 + fr, col0 = u.pn * 256 + wc * 32 + 4 * fq;
#pragma unroll
        for (int ai = 0; ai < 2; ++ai)
#pragma unroll
            for (int m = 0; m < 4; ++m) {
                const int row = row0 + ai * 128 + m * 16;
                float* hp = row < RL ? Hl + (size_t)row * 1024 : Hc + (size_t)(row - RL) * 1024;
                const float* gp = gate + (row < RL ? (row >> 13) : 4) * 9216;
#pragma unroll
                for (int bj = 0; bj < 2; ++bj)
#pragma unroll
                    for (int n = 0; n < 2; ++n) {
                        const int c = col0 + bj * 128 + n * 16;
                        const f32x4 g4 = *(const f32x4*)(gp + c); f32x4 h4 = *(const f32x4*)(hp + c);
                        h4 += (g4 * coef) * acc[ai][bj][m][n];
                        *(f32x4*)(hp + c) = h4;
                    }
            }
    }
};
struct EpiPJ {
    static constexpr bool HOOK = false;
    static constexpr bool PERM = true;
    bf16_t* PJ; unsigned char* G8;
    __device__ __forceinline__ void operator()(const f32x4 (&acc)[2][2][4][2], const Unit& u, int wr, int wc, int fr, int fq) const {
        const int row0 = u.pm * 256 + wr * 64 + fr, c0 = wc * 32 + 8 * fq;
        if (u.pn < 9) {
#pragma unroll
            for (int ai = 0; ai < 2; ++ai)
#pragma unroll
                for (int m = 0; m < 4; ++m) {
                    const int row = row0 + ai * 128 + m * 16;
#pragma unroll
                    for (int bj = 0; bj < 2; ++bj) {
                        const f32x4 v0 = acc[ai][bj][m][0], v1 = acc[ai][bj][m][1];
                        u32x4 w; w.x = cvt_pk_bf16(v0[0], v0[1]); w.y = cvt_pk_bf16(v0[2], v0[3]); w.z = cvt_pk_bf16(v1[0], v1[1]); w.w = cvt_pk_bf16(v1[2], v1[3]);
                        *(u32x4*)(PJ + (size_t)row * PJW + u.pn * 256 + bj * 128 + c0) = w;
                    }
                }
        } else {
#pragma unroll
            for (int ai = 0; ai < 2; ++ai)
#pragma unroll
                for (int m = 0; m < 4; ++m) {
                    const int row = row0 + ai * 128 + m * 16;
#pragma unroll
                    for (int bj = 0; bj < 2; ++bj) {
                        unsigned q[8];
#pragma unroll
                        for (int n = 0; n < 2; ++n)
#pragma unroll
                            for (int j = 0; j < 4; ++j) { int v = (int)(sigmoidf_(acc[ai][bj][m][n][j]) * 256.0f); q[4 * n + j] = (unsigned)(v > 255 ? 255 : v); }
                        u32x2 w; w.x = q[0] | (q[1] << 8) | (q[2] << 16) | (q[3] << 24); w.y = q[4] | (q[5] << 8) | (q[6] << 16) | (q[7] << 24);
                        *(u32x2*)(G8 + g8_off(row, (u.pn - 9) * 256 + bj * 128 + c0)) = w;
                    }
                }
        }
    }
};
struct EpiMLA {
    static constexpr bool HOOK = false;
    static constexpr bool PERM = true;
    bf16_t *MQ, *MK, *MV; const float* RSTD; const float2* RT;
    __device__ __forceinline__ void operator()(const f32x4 (&acc)[2][2][4][2], const Unit& u, int wr, int wc, int fr, int fq) const {
        const int row0 = u.pm * 256 + wr * 64 + fr;
#pragma unroll
        for (int bj = 0; bj < 2; ++bj) {
            const int cg0 = u.pn * 256 + bj * 128 + wc * 32;
            if (cg0 >= 896) continue;
#pragma unroll
            for (int ai = 0; ai < 2; ++ai)
#pragma unroll
                for (int m = 0; m < 4; ++m) {
                    __builtin_amdgcn_sched_barrier(0);
                    const int row = row0 + ai * 128 + m * 16;
                    float v[8];
                    if (cg0 < 384) {
                        const float rs = RSTD[row * 2];
#pragma unroll
                        for (int n = 0; n < 2; ++n)
#pragma unroll
                            for (int j = 0; j < 4; ++j) v[4 * n + j] = acc[ai][bj][m][n][j] * rs;
                        const int d0 = cg0 % 96;
                        if (d0 == 64) {
                            const bool lat = row < RL; const int t = row & 8191; const int pos = (fq >> 1) ? (t & 63) : (t >> 6); const bool isx2 = fq & 1;
#pragma unroll
                            for (int e = 0; e < 8; ++e) {
                                const float pr = shflx(v[e], 16);
                                const float2 cs = RT[pos * 8 + e];
                                const float r = isx2 ? (pr * cs.y + v[e] * cs.x) : (v[e] * cs.x - pr * cs.y);
                                v[e] = lat ? r : v[e];
                            }
                        }
                        u32x4 w; w.x = cvt_pk_bf16(v[0], v[1]); w.y = cvt_pk_bf16(v[2], v[3]); w.z = cvt_pk_bf16(v[4], v[5]); w.w = cvt_pk_bf16(v[6], v[7]);
                        *(u32x4*)(MQ + (size_t)row * 384 + cg0 + 8 * fq) = w;
                    } else {
                        const float rs = RSTD[row * 2 + 1];
#pragma unroll
                        for (int n = 0; n < 2; ++n)
#pragma unroll
                            for (int j = 0; j < 4; ++j) v[4 * n + j] = acc[ai][bj][m][n][j] * rs;
                        const int cp = cg0 - 384, hd = cp >> 7, d0 = cp & 127;
                        u32x4 w; w.x = cvt_pk_bf16(v[0], v[1]); w.y = cvt_pk_bf16(v[2], v[3]); w.z = cvt_pk_bf16(v[4], v[5]); w.w = cvt_pk_bf16(v[6], v[7]);
                        if (d0 < 64) *(u32x4*)(MK + (size_t)row * 384 + hd * 96 + d0 + 8 * fq) = w;
                        else *(u32x4*)(MV + (size_t)row * 256 + hd * 64 + (d0 - 64) + 8 * fq) = w;
                    }
                }
        }
    }
};
struct EpiMerge {
    static constexpr bool PERM = true, HOOK = true;
    const unsigned char* G8; bf16_t* MG;
    __device__ __forceinline__ void hook(f32x4 (&acc)[2][2][4][2], const Unit& u, int nb, int wr, int wc, int fr, int fq) const {
        const int row0 = u.pm * 256 + wr * 64 + fr, c0 = u.pn * 256 + wc * 32 + 8 * fq;
#pragma unroll
        for (int ai = 0; ai < 2; ++ai) {
            u32x2 ga[4][2], gb[4][2];
#pragma unroll
            for (int m = 0; m < 4; ++m)
#pragma unroll
                for (int bj = 0; bj < 2; ++bj) { const int row = row0 + ai * 128 + m * 16, c = c0 + bj * 128;
                    ga[m][bj] = *(const u32x2*)(G8 + g8_off(row, (nb - 1) * 1024 + c)); gb[m][bj] = *(const u32x2*)(G8 + g8_off(row, nb * 1024 + c)); }
#pragma unroll
            for (int m = 0; m < 4; ++m)
#pragma unroll
                for (int bj = 0; bj < 2; ++bj)
#pragma unroll
                    for (int e = 0; e < 8; ++e) { const unsigned qa = ((e < 4 ? ga[m][bj].x : ga[m][bj].y) >> (8 * (e & 3))) & 255u, qb = ((e < 4 ? gb[m][bj].x : gb[m][bj].y) >> (8 * (e & 3))) & 255u;
                        acc[ai][bj][m][e >> 2][e & 3] *= ((float)qa + 0.5f) * fast_rcp((float)qb + 0.5f); }
            __builtin_amdgcn_sched_barrier(0);
        }
    }
    __device__ __forceinline__ void operator()(const f32x4 (&acc)[2][2][4][2], const Unit& u, int wr, int wc, int fr, int fq) const {
        const int row0 = u.pm * 256 + wr * 64 + fr, c0 = u.pn * 256 + wc * 32 + 8 * fq;
#pragma unroll
        for (int ai = 0; ai < 2; ++ai) {
            u32x2 gq[4][2];
#pragma unroll
            for (int m = 0; m < 4; ++m)
#pragma unroll
                for (int bj = 0; bj < 2; ++bj) gq[m][bj] = *(const u32x2*)(G8 + g8_off(row0 + ai * 128 + m * 16, 3 * 1024 + c0 + bj * 128));
#pragma unroll
            for (int m = 0; m < 4; ++m)
#pragma unroll
                for (int bj = 0; bj < 2; ++bj) {
                    const int row = row0 + ai * 128 + m * 16, c = c0 + bj * 128;
                    float v[8];
#pragma unroll
                    for (int e = 0; e < 8; ++e) { const unsigned q = ((e < 4 ? gq[m][bj].x : gq[m][bj].y) >> (8 * (e & 3))) & 255u; v[e] = ((float)q + 0.5f) * (1.0f / 256.0f) * acc[ai][bj][m][e >> 2][e & 3]; }
                    u32x4 w; w.x = cvt_pk_bf16(v[0], v[1]); w.y = cvt_pk_bf16(v[2], v[3]); w.z = cvt_pk_bf16(v[4], v[5]); w.w = cvt_pk_bf16(v[6], v[7]);
                    *(u32x4*)(MG + (size_t)row * 1024 + c) = w;
                }
            __builtin_amdgcn_sched_barrier(0);
        }
    }
};

template <class F>
__device__ __forceinline__ void wt_rows64(bf16_t* dst, int K, F srcval, int ldd = 0) {
    if (ldd == 0) ldd = K;
    const int tid_ = opaque_tid(); const int nl = tid_ & 63, kq = tid_ >> 6;
    for (int k0 = kq * 8; k0 < K; k0 += 64) {
        float v[8];
#pragma unroll
        for (int j = 0; j < 8; ++j) v[j] = srcval(nl, k0 + j);
        u32x4 w; w.x = cvt_pk_bf16(v[0], v[1]); w.y = cvt_pk_bf16(v[2], v[3]); w.z = cvt_pk_bf16(v[4], v[5]); w.w = cvt_pk_bf16(v[6], v[7]);
        *(u32x4*)(dst + (size_t)nl * ldd + k0) = w;
    }
}

__device__ void layer_prep_phase(PK p, int l, LAS unsigned char* lds) {
    unsigned char* ws = p->ws;
    const int nW = 404, nItems = nW + (l == 0 ? 288 + 1 : 0);
    for (int it = opaque_bid(); it < nItems; it += opaque_gdim()) {
        if (it < 176) {
            const int f = it / 88, j = it % 88; const float* src = p->ffn_w_in + ((size_t)(l * 2 + f) * 1024) * 5632;
            bf16_t* dst = (bf16_t*)(ws + OFF_W1) + ((size_t)f * 5632 + j * 64) * 1024;
            wt_rows64(dst, 1024, [&](int nl, int k) { const int np = j * 64 + nl, pn = np >> 8, wi = np & 255; const int col = wi < 128 ? pn * 128 + wi : FH + pn * 128 + (wi - 128); return src[(size_t)k * 5632 + col]; });
        } else if (it < 208) {
            const int q = it - 176, f = q / 16, j = q % 16; const float* src = p->ffn_w_out + ((size_t)(l * 2 + f) * FH) * 1024;
            bf16_t* dst = (bf16_t*)(ws + OFF_W2) + ((size_t)f * 1024 + j * 64) * FH;
            wt_rows64(dst, FH, [&](int nl, int k) { return src[(size_t)k * 1024 + j * 64 + nl]; });
        } else if (it < 308) {
            const int j = it - 208; const float* src = p->mix_w_in + (size_t)l * 1024 * 6304;
            bf16_t* dst = (bf16_t*)(ws + OFF_WM) + (size_t)j * 64 * 1024;
            wt_rows64(dst, 1024, [&](int nl, int k) { const int np = j * 64 + nl; const int col = np < 2208 ? np : (np < 2304 ? -1 : np - 96); return col < 0 ? 0.f : src[(size_t)k * 6304 + col]; });
        } else if (it < 324) {
            const int j = it - 308; const float* src = p->mix_w_out + (size_t)l * 1024 * 1024;
            bf16_t* dst = (bf16_t*)(ws + OFF_WO) + (size_t)j * 64 * 1024;
            wt_rows64(dst, 1024, [&](int nl, int k) { return src[(size_t)k * 1024 + j * 64 + nl]; });
        } else if (it < 372) {
            const int q = it - 324, bi = 1 + q / 16, j = q % 16; const float* src = p->branch_w_out + ((size_t)(l * 4 + bi) * 256) * 1024;
            bf16_t* dst = (bf16_t*)(ws + OFF_WB) + (size_t)j * 64 * 1024 + bi * 256;
            wt_rows64(dst, 256, [&](int nl, int k) { return src[(size_t)k * 1024 + j * 64 + nl]; }, 1024);
        } else if (it < 388) {
            const int j = it - 372; const float* wb = p->branch_w_out + ((size_t)(l * 4) * 256) * 1024; const float* pw = p->pool_w + (size_t)l * 4 * 64 * 64; const float* ps = p->pool_scale + l * 256;
            bf16_t* dst = (bf16_t*)(ws + OFF_WB) + (size_t)j * 64 * 1024;
            wt_rows64(dst, 256, [&](int nl, int k) { const int gI = k >> 6, n = j * 64 + nl; const float* pr = pw + (size_t)k * 64; float s = 0.f;
                for (int e = 0; e < 64; ++e) s += pr[e] * ps[gI * 64 + e] * wb[(size_t)(gI * 64 + e) * 1024 + n]; return s; }, 1024);
        } else if (it < 404) {
            const int j = it - 388; const float* wq = p->mla_w_qb + (size_t)l * 256 * 384; const float* wk = p->mla_w_kvb + (size_t)l * 128 * 512;
            const float* gq = p->mla_q_norm_g + l * 256; const float* gk = p->mla_kv_norm_g + l * 128;
            bf16_t* dst = (bf16_t*)(ws + OFF_WL) + (size_t)j * 64 * 384;
            wt_rows64(dst, 384, [&](int nl, int k) { const int n = j * 64 + nl;
                if (n < 384) return k < 256 ? gq[k] * wq[(size_t)k * 384 + n] : 0.f;
                if (n < 896) return k >= 256 ? gk[k - 256] * wk[(size_t)(k - 256) * 512 + (n - 384)] : 0.f;
                return 0.f; });
        } else if (it < 404 + 288) {
            const int q = it - 404, ll = q / 144, cb = q % 144;
            LAS float* sc = (LAS float*)lds;
            LAS float* red = (LAS float*)(lds + 5 * 1024 * 4);
            __syncthreads();
            for (int i = opaque_tid(); i < 5 * 1024; i += 512) { const int r = i >> 10, k = i & 1023; const float cv = r < 4 ? p->c[r * 1024 + k] : p->c_ctx[k]; sc[i] = cv * sigmoidf_(cv); }
            __syncthreads();
            const int jl = opaque_tid() & 63, kg = opaque_tid() >> 6; const int col = cb * 64 + jl;
            const float* wsrc = p->ada_w + (size_t)ll * 1024 * 9216 + col;
            float a0 = 0.f, a1 = 0.f, a2 = 0.f, a3 = 0.f, a4 = 0.f;
            for (int k = kg * 128; k < kg * 128 + 128; ++k) { const float wv = wsrc[(size_t)k * 9216]; a0 += sc[k] * wv; a1 += sc[1024 + k] * wv; a2 += sc[2048 + k] * wv; a3 += sc[3072 + k] * wv; a4 += sc[4096 + k] * wv; }
            red[(kg * 5 + 0) * 64 + jl] = a0; red[(kg * 5 + 1) * 64 + jl] = a1; red[(kg * 5 + 2) * 64 + jl] = a2; red[(kg * 5 + 3) * 64 + jl] = a3; red[(kg * 5 + 4) * 64 + jl] = a4;
            __syncthreads();
            if (opaque_tid() < 320) { const int r = opaque_tid() >> 6; float s = p->ada_b[ll * 9216 + col];
                for (int q2 = 0; q2 < 8; ++q2) s += red[(q2 * 5 + r) * 64 + jl];
                ((float*)(ws + OFF_MOD))[(size_t)(ll * 5 + r) * 9216 + col] = s; }
        } else {
            for (int i = opaque_tid(); i < 1024; i += 512) { const int pos = i >> 3, fi = i & 7; const float inv = exp2f(-(float)fi * 0.125f * 13.287712379549449f); const float ang = (float)pos * inv;
                ((float2*)(ws + OFF_ROPE))[i] = make_float2(cosf(ang), sinf(ang)); }
        }
    }
}

__device__ void norm_mod_phase(const float* srcL, const float* srcC, float* cpyL, float* cpyC, const float* g, const float* mod, bf16_t* TN, int nrows) {
    const int tid_ = opaque_tid(); const int lane = tid_ & 63, gw = opaque_bid() * 8 + (tid_ >> 6), nw = opaque_gdim() * 8;
    for (int row = gw; row < nrows; row += nw) {
        const bool lat = row < RL;
        const float* sp = lat ? srcL + (size_t)row * 1024 : srcC + (size_t)(row - RL) * 1024;
        const float* mp = mod + (lat ? (row >> 13) : 4) * 9216;
        f32x4 v[4]; float ss = 0.f;
#pragma unroll
        for (int j = 0; j < 4; ++j) { v[j] = *(const f32x4*)(sp + 256 * j + 4 * lane); ss += v[j][0] * v[j][0] + v[j][1] * v[j][1] + v[j][2] * v[j][2] + v[j][3] * v[j][3]; }
        if (cpyL) { float* cp = lat ? cpyL + (size_t)row * 1024 : cpyC + (size_t)(row - RL) * 1024;
#pragma unroll
            for (int j = 0; j < 4; ++j) *(f32x4*)(cp + 256 * j + 4 * lane) = v[j]; }
        ss = wave_sum(ss);
        const float rstd = rsqrtf(ss * (1.0f / 1024.0f) + NEPS);
#pragma unroll
        for (int j = 0; j < 4; ++j) {
            const int col = 256 * j + 4 * lane;
            const f32x4 gg = *(const f32x4*)(g + col), sh = *(const f32x4*)(mp + col), sc = *(const f32x4*)(mp + 1024 + col);
            float o[4];
#pragma unroll
            for (int e = 0; e < 4; ++e) o[e] = (v[j][e] * rstd * gg[e]) * (1.0f + sc[e]) + sh[e];
            u32x2 w; w.x = cvt_pk_bf16(o[0], o[1]); w.y = cvt_pk_bf16(o[2], o[3]);
            *(u32x2*)(TN + (size_t)row * 1024 + col) = w;
        }
    }
}
__device__ void final_norm_phase(float* H, const float* g) {
    const int tid_ = opaque_tid(); const int lane = tid_ & 63, gw = opaque_bid() * 8 + (tid_ >> 6), nw = opaque_gdim() * 8;
    for (int row = gw; row < RL; row += nw) {
        float* sp = H + (size_t)row * 1024; f32x4 v[4]; float ss = 0.f;
#pragma unroll
        for (int j = 0; j < 4; ++j) { v[j] = *(const f32x4*)(sp + 256 * j + 4 * lane); ss += v[j][0] * v[j][0] + v[j][1] * v[j][1] + v[j][2] * v[j][2] + v[j][3] * v[j][3]; }
        ss = wave_sum(ss);
        const float rstd = rsqrtf(ss * (1.0f / 1024.0f) + NEPS);
#pragma unroll
        for (int j = 0; j < 4; ++j) { const f32x4 gg = *(const f32x4*)(g + 256 * j + 4 * lane); *(f32x4*)(sp + 256 * j + 4 * lane) = v[j] * rstd * gg; }
    }
}

__device__ void prep_phase(PK p) {
    unsigned char* ws = p->ws;
    bf16_t* PJ = (bf16_t*)(ws + OFF_B); bf16_t* YB = (bf16_t*)(ws + OFF_A); bf16_t* MK = (bf16_t*)(ws + OFF_MK); float* RSTD = (float*)(ws + OFF_RSTD);
    const float2* RT = (const float2*)(ws + OFF_ROPE);
    const int tid_ = opaque_tid(); const int lane = tid_ & 63, gw = opaque_bid() * 8 + (tid_ >> 6), nw = opaque_gdim() * 8;
    for (int row = gw; row < RA; row += nw) {
        const bool lat = row < RL;
        int t, n; if (lat) { t = row & 8191; n = 8192; } else { t = (row - RL) & 255; n = 256; }
        const int sbase = row - t;
        bf16_t* prow = PJ + (size_t)row * PJW;
        {
            const int wdw = 2 << (lane >> 4); const int lo = max(t - wdw / 2, 0), hi = min(t - wdw / 2 + wdw, n);
            float s0 = 0.f, s1 = 0.f, s2 = 0.f, s3 = 0.f;
            for (int tt = lo; tt < hi; ++tt) { const u32x2 v = *(const u32x2*)(PJ + (size_t)(sbase + tt) * PJW + 4 * lane); s0 += bf_lo(v.x); s1 += bf_hi(v.x); s2 += bf_lo(v.y); s3 += bf_hi(v.y); }
            const float ic = 1.0f / (float)(hi - lo); const u32x2 sv = *(const u32x2*)(prow + 4 * lane);
            u32x2 w; w.x = cvt_pk_bf16(s0 * ic - bf_lo(sv.x), s1 * ic - bf_hi(sv.x)); w.y = cvt_pk_bf16(s2 * ic - bf_lo(sv.y), s3 * ic - bf_hi(sv.y));
            *(u32x2*)(YB + (size_t)row * 1024 + 4 * lane) = w;
        }
        {
            const u32x2 q = *(const u32x2*)(prow + C_MQ + 4 * lane); const unsigned kv = *(const unsigned*)(prow + C_MKV + 2 * lane);
            float sq = bf_lo(q.x) * bf_lo(q.x) + bf_hi(q.x) * bf_hi(q.x) + bf_lo(q.y) * bf_lo(q.y) + bf_hi(q.y) * bf_hi(q.y);
            float sk = bf_lo(kv) * bf_lo(kv) + bf_hi(kv) * bf_hi(kv);
            sq = wave_sum(sq); sk = wave_sum(sk);
            if (lane == 0) { RSTD[row * 2] = rsqrtf(sq * (1.0f / 256.0f) + NEPS); RSTD[row * 2 + 1] = rsqrtf(sk * (1.0f / 128.0f) + NEPS); }
        }
        if (lane < 34) {
            const bool iskr = lane >= 32; const int a = lane & 1;
            bf16_t* ep = iskr ? prow + C_MKR + a * 16 : prow + ((lane >> 4) ? C_DK : C_DQ) + ((lane >> 1) & 7) * 32 + a * 16;
            const u32x4 e0 = *(const u32x4*)ep, e1 = *(const u32x4*)(ep + 8);
            float x1[8], x2[8];
            x1[0] = bf_lo(e0.x); x1[1] = bf_hi(e0.x); x1[2] = bf_lo(e0.y); x1[3] = bf_hi(e0.y); x1[4] = bf_lo(e0.z); x1[5] = bf_hi(e0.z); x1[6] = bf_lo(e0.w); x1[7] = bf_hi(e0.w);
            x2[0] = bf_lo(e1.x); x2[1] = bf_hi(e1.x); x2[2] = bf_lo(e1.y); x2[3] = bf_hi(e1.y); x2[4] = bf_lo(e1.z); x2[5] = bf_hi(e1.z); x2[6] = bf_lo(e1.w); x2[7] = bf_hi(e1.w);
            if (lat) { const int pos = a ? (t & 63) : (t >> 6);
#pragma unroll
                for (int i = 0; i < 8; ++i) { const float2 cs = RT[pos * 8 + i]; const float o1 = x1[i] * cs.x - x2[i] * cs.y, o2 = x1[i] * cs.y + x2[i] * cs.x; x1[i] = o1; x2[i] = o2; } }
            u32x4 w0, w1; w0.x = cvt_pk_bf16(x1[0], x1[1]); w0.y = cvt_pk_bf16(x1[2], x1[3]); w0.z = cvt_pk_bf16(x1[4], x1[5]); w0.w = cvt_pk_bf16(x1[6], x1[7]);
            w1.x = cvt_pk_bf16(x2[0], x2[1]); w1.y = cvt_pk_bf16(x2[2], x2[3]); w1.z = cvt_pk_bf16(x2[4], x2[5]); w1.w = cvt_pk_bf16(x2[6], x2[7]);
            if (iskr) {
#pragma unroll
                for (int hh = 0; hh < 4; ++hh) { bf16_t* kp = MK + (size_t)row * 384 + hh * 96 + 64 + a * 16; *(u32x4*)kp = w0; *(u32x4*)(kp + 8) = w1; }
            } else if (lat) { *(u32x4*)ep = w0; *(u32x4*)(ep + 8) = w1; }
        }
    }
}

#define MFMA32(a, b, c) __builtin_amdgcn_mfma_f32_32x32x16_bf16((a), (b), (c), 0, 0, 0)
typedef float f32x2 __attribute__((ext_vector_type(2)));
template <int MODE>
__device__ __forceinline__ void attn_item(PK p, int l, LAS unsigned char* lds, int b, int h, int qb, bool ctxq, float lam, float lam_init) {
    constexpr int NCOMP = (MODE == 1) ? 2 : 1, NKS = (MODE == 0) ? 4 : ((MODE == 1) ? 2 : 6), KW = NCOMP * NKS * 16, KCH = KW / 8, KSTR = KW * 2 + 16, VSTR = 192;
    constexpr int KBUF = 64 * KSTR, VBUF = 64 * VSTR, BUFSZ = KBUF + VBUF, BIAS_OFF = 3 * BUFSZ;
    constexpr bool STAG = (MODE != 0);
    const int tid = opaque_tid(), w = tid >> 6, lane = tid & 63, g = lane >> 5, l32 = lane & 31;
    unsigned char* ws = p->ws;
    const bf16_t* PJ = (const bf16_t*)(ws + OFF_B);
    const bf16_t *Qp, *Kp, *Vp; int ldq, ldk, ldv, outoff; float scale;
    if (MODE == 0) { Qp = PJ + C_NQ + 64 * h; Kp = PJ + C_NK + 64 * h; Vp = PJ + C_NV + 64 * h; ldq = ldk = ldv = PJW; outoff = 256 + 64 * h; scale = 0.125f; }
    else if (MODE == 1) { Qp = PJ + C_DQ + 64 * h; Kp = PJ + C_DK + 64 * h; Vp = PJ + C_DV + 64 * h; ldq = ldk = ldv = PJW; outoff = 512 + 64 * h; scale = 0.17677669529663687f; }
    else { Qp = (const bf16_t*)(ws + OFF_D) + 96 * h; Kp = (const bf16_t*)(ws + OFF_MK) + 96 * h; Vp = (const bf16_t*)(ws + OFF_MV) + 64 * h; ldq = ldk = 384; ldv = 256; outoff = 768 + 64 * h; scale = 0.10206207261596575f; }
    const float cs = scale * LOG2E;
    int qrow0, loc0, nloc;
    if (ctxq) { qrow0 = RL + b * 256; loc0 = 0; nloc = 0; }
    else { qrow0 = b * 8192 + qb * 256;
        if (MODE == 0) { const int r0 = qb * 4; loc0 = clampi(r0 - 4, 0, 120); nloc = clampi(r0 - 1, 0, 120) + 8 - loc0; } else { loc0 = 0; nloc = 128; } }
    const int nt = nloc + 4;
    const bool nabias = (MODE == 0) && !ctxq;
    const bool late = STAG && (w >= 4);
    const int rw = qb * 4 + (w >> 1), sw = clampi(rw - 4, 0, 120);
    const int jq = 32 * (w & 1) + l32, cst = clampi(jq - 8, 0, 48);
    if (nabias && tid < 465) ((LAS float*)(lds + BIAS_OFF))[tid] = p->na_rpb[(size_t)(l * 4 + h) * 465 + tid] * LOG2E;

    const size_t qrow = (size_t)qrow0 + 32 * w + l32;
    bf16x8 qf[NCOMP * NKS];
#pragma unroll
    for (int i = 0; i < NCOMP * NKS; ++i) {
        const u32x4 raw = *(const u32x4*)(Qp + qrow * ldq + 16 * i + 8 * g);
        u32x4 sc4; sc4.x = cvt_pk_bf16(bf_lo(raw.x) * cs, bf_hi(raw.x) * cs); sc4.y = cvt_pk_bf16(bf_lo(raw.y) * cs, bf_hi(raw.y) * cs);
        sc4.z = cvt_pk_bf16(bf_lo(raw.z) * cs, bf_hi(raw.z) * cs); sc4.w = cvt_pk_bf16(bf_lo(raw.w) * cs, bf_hi(raw.w) * cs);
        qf[i] = __builtin_bit_cast(bf16x8, sc4);
    }

    const int kr0 = tid / KCH, kc0 = tid % KCH, kr1 = (tid + 512) / KCH, kc1 = (tid + 512) % KCH, vr = tid >> 3, vc = tid & 7;
    const bool hask1 = (KCH == 12) && (tid < 256);
    u32x4 rk0, rk1 = (u32x4){0u, 0u, 0u, 0u}, rv;
#define TILE_ROW(t) ((t) < nloc ? (b * 8192 + 64 * (loc0 + (t))) : (RL + b * 256 + 64 * ((t) - nloc)))
#define LOAD_TILE(t) do { const size_t _tb = (size_t)TILE_ROW(t); rk0 = *(const u32x4*)(Kp + (_tb + kr0) * ldk + kc0 * 8); \
        if (hask1) rk1 = *(const u32x4*)(Kp + (_tb + kr1) * ldk + kc1 * 8); rv = *(const u32x4*)(Vp + (_tb + vr) * ldv + vc * 8); } while (0)
#define STORE_TILE(buf) do { LAS unsigned char* _kb = lds + (buf) * BUFSZ; *(LAS u32x4*)(_kb + kr0 * KSTR + kc0 * 16) = rk0; \
        if (hask1) *(LAS u32x4*)(_kb + kr1 * KSTR + kc1 * 16) = rk1; *(LAS u32x4*)(_kb + KBUF + vr * VSTR + vc * 16) = rv; } while (0)

    float mrun[NCOMP], lsum[NCOMP]; f32x16 O[NCOMP][2];
#pragma unroll
    for (int c = 0; c < NCOMP; ++c) { mrun[c] = -1e30f; lsum[c] = 0.f;
#pragma unroll
        for (int dt = 0; dt < 2; ++dt)
#pragma unroll
            for (int r = 0; r < 16; ++r) O[c][dt][r] = 0.f; }
    bf16x8 P[NCOMP][2][2];
#pragma unroll
    for (int c = 0; c < NCOMP; ++c)
#pragma unroll
        for (int kt = 0; kt < 2; ++kt)
#pragma unroll
            for (int s2 = 0; s2 < 2; ++s2) P[c][kt][s2] = (bf16x8){0, 0, 0, 0, 0, 0, 0, 0};

    LOAD_TILE(0); STORE_TILE(0); __syncthreads();
    const int koff = l32 * KSTR + g * 16;
    const int i16 = lane & 15, tq = i16 >> 2, tp = i16 & 3, blk = (lane >> 4) & 1;
    const int voff = (4 * g + tq) * VSTR + (16 * blk + 4 * tp) * 2;
#define PV_TILE(buf) do { LAS unsigned char* _vb = lds + (buf) * BUFSZ + KBUF + voff; \
        _Pragma("unroll") for (int kt = 0; kt < 2; ++kt) { bf16x8 vf[2][2]; \
            _Pragma("unroll") for (int s2 = 0; s2 < 2; ++s2) _Pragma("unroll") for (int dt = 0; dt < 2; ++dt) { LAS unsigned char* vp = _vb + (32 * kt + 16 * s2) * VSTR + dt * 64; \
                const s16x4 lo = __builtin_amdgcn_ds_read_tr16_b64_v4i16((LAS s16x4*)vp); const s16x4 hi = __builtin_amdgcn_ds_read_tr16_b64_v4i16((LAS s16x4*)(vp + 8 * VSTR)); \
                vf[s2][dt] = __builtin_shufflevector(lo, hi, 0, 1, 2, 3, 4, 5, 6, 7); } \
            _Pragma("unroll") for (int s2 = 0; s2 < 2; ++s2) _Pragma("unroll") for (int dt = 0; dt < 2; ++dt) _Pragma("unroll") for (int c = 0; c < NCOMP; ++c) O[c][dt] = MFMA32(vf[s2][dt], P[c][kt][s2], O[c][dt]); } } while (0)

    bool pend = false; int pbuf = 0, cbuf = 0;
    for (int t = 0; t < nt; ++t) {
        const bool more = (t + 1 < nt);
        if (more) LOAD_TILE(t + 1);
        bool active = true; int krow = 0;
        if (nabias && t < nloc) { krow = loc0 + t; active = (krow >= sw) && (krow < sw + 8); }
        if (active) {
            LAS unsigned char* Kb = lds + cbuf * BUFSZ + koff;
            f32x16 S[NCOMP][2];
#pragma unroll
            for (int c = 0; c < NCOMP; ++c)
#pragma unroll
                for (int kt = 0; kt < 2; ++kt) {
                    bf16x8 kf[NKS];
#pragma unroll
                    for (int ks = 0; ks < NKS; ++ks) kf[ks] = *(const LAS bf16x8*)(Kb + kt * 32 * KSTR + (c * NKS + ks) * 32);
#pragma unroll
                    for (int r = 0; r < 16; ++r) S[c][kt][r] = 0.f;
#pragma unroll
                    for (int ks = 0; ks < NKS; ++ks) S[c][kt] = MFMA32(kf[ks], qf[c * NKS + ks], S[c][kt]);
                }
            if (STAG && late && pend) PV_TILE(pbuf);
#pragma unroll
            for (int c = 0; c < NCOMP; ++c) {
                float mx = -1e30f;
                if (nabias && t < nloc) {
                    const LAS float* bt = (const LAS float*)(lds + BIAS_OFF) + (krow - rw + 7) * 31;
#pragma unroll
                    for (int kt = 0; kt < 2; ++kt)
#pragma unroll
                        for (int r = 0; r < 16; ++r) { const int jk = 32 * kt + (r & 3) + 8 * (r >> 2) + 4 * g; const bool ok = (jk >= cst) && (jk < cst + 16);
                            const float bv = bt[clampi(jk - jq + 15, 0, 30)]; const float xv = ok ? (S[c][kt][r] + bv) : -1e30f; S[c][kt][r] = xv; mx = fmaxf(mx, xv); }
                } else {
#pragma unroll
                    for (int kt = 0; kt < 2; ++kt)
#pragma unroll
                        for (int r = 0; r < 16; r += 2) mx = fmaxf(fmaxf(mx, S[c][kt][r]), S[c][kt][r + 1]);
                }
                mx = fmaxf(mx, shflx(mx, 32));
                const float mnew = fmaxf(mrun[c], mx);
                if (__any(mnew > mrun[c])) {
                    const float alpha = fast_exp2(mrun[c] - mnew); lsum[c] *= alpha;
#pragma unroll
                    for (int dt = 0; dt < 2; ++dt) O[c][dt] *= alpha;
                    mrun[c] = mnew;
                }
                f32x2 rs2 = (f32x2){0.f, 0.f}; const f32x2 m2 = (f32x2){mnew, mnew};
#pragma unroll
                for (int kt = 0; kt < 2; ++kt)
#pragma unroll
                    for (int r = 0; r < 16; r += 2) { const f32x2 d = (f32x2){S[c][kt][r], S[c][kt][r + 1]} - m2; S[c][kt][r] = d.x; S[c][kt][r + 1] = d.y; }
#pragma unroll
                for (int kt = 0; kt < 2; ++kt)
#pragma unroll
                    for (int r = 0; r < 16; ++r) S[c][kt][r] = fast_exp2(S[c][kt][r]);
#pragma unroll
                for (int kt = 0; kt < 2; ++kt)
#pragma unroll
                    for (int s2 = 0; s2 < 2; ++s2) { u32x4 pk;
#pragma unroll
                        for (int e = 0; e < 4; ++e) { const f32x2 ev = (f32x2){S[c][kt][8 * s2 + 2 * e], S[c][kt][8 * s2 + 2 * e + 1]}; rs2 += ev; pk[e] = cvt_pk_bf16(ev.x, ev.y); }
                        P[c][kt][s2] = __builtin_bit_cast(bf16x8, pk); }
                lsum[c] += rs2.x + rs2.y;
            }
            if (!(STAG && late)) PV_TILE(cbuf); else { pend = true; pbuf = cbuf; }
        }
        const int nbuf = (cbuf == 2) ? 0 : cbuf + 1;
        if (more) STORE_TILE(nbuf);
        __syncthreads();
        cbuf = nbuf;
    }
    if (STAG && late && pend) PV_TILE(pbuf);
#undef PV_TILE
#undef TILE_ROW
#undef LOAD_TILE
#undef STORE_TILE
    float inv[NCOMP];
#pragma unroll
    for (int c = 0; c < NCOMP; ++c) { const float lt = lsum[c] + shflx(lsum[c], 32); inv[c] = 1.0f / lt; }
    bf16_t* op = (bf16_t*)(ws + OFF_A) + qrow * 1024 + outoff;
    if (MODE == 1) {
        const float li1 = lam * inv[NCOMP - 1]; float ss = 0.f;
#pragma unroll
        for (int dt = 0; dt < 2; ++dt)
#pragma unroll
            for (int r = 0; r < 16; ++r) { const float o = O[0][dt][r] * inv[0] - li1 * O[NCOMP - 1][dt][r]; O[0][dt][r] = o; ss += o * o; }
        ss += shflx(ss, 32);
        const float rstd = rsqrtf(ss * (1.0f / 64.0f) + NEPS) * (1.0f - lam_init);
        const float* sg = p->diff_subln_g + l * 64;
#pragma unroll
        for (int dt = 0; dt < 2; ++dt)
#pragma unroll
            for (int rq = 0; rq < 4; ++rq) { const int dv = 32 * dt + 8 * rq + 4 * g; const f32x4 gg = *(const f32x4*)(sg + dv);
                u32x2 wv; wv.x = cvt_pk_bf16(O[0][dt][4 * rq] * rstd * gg[0], O[0][dt][4 * rq + 1] * rstd * gg[1]); wv.y = cvt_pk_bf16(O[0][dt][4 * rq + 2] * rstd * gg[2], O[0][dt][4 * rq + 3] * rstd * gg[3]);
                *(u32x2*)(op + dv) = wv; }
    } else {
#pragma unroll
        for (int dt = 0; dt < 2; ++dt)
#pragma unroll
            for (int rq = 0; rq < 4; ++rq) { const int dv = 32 * dt + 8 * rq + 4 * g;
                u32x2 wv; wv.x = cvt_pk_bf16(O[0][dt][4 * rq] * inv[0], O[0][dt][4 * rq + 1] * inv[0]); wv.y = cvt_pk_bf16(O[0][dt][4 * rq + 2] * inv[0], O[0][dt][4 * rq + 3] * inv[0]);
                *(u32x2*)(op + dv) = wv; }
    }
    __syncthreads();
}

__device__ void attn_phase(PK p, int l, LAS unsigned char* lds) {
    const float lam_init = (l == 0) ? 0.2f : 0.35550906759502f;
    const float* dl = p->diff_lambda + l * 128;
    float d01 = 0.f, d23 = 0.f;
    for (int i = 0; i < 32; ++i) { d01 += dl[i] * dl[32 + i]; d23 += dl[64 + i] * dl[96 + i]; }
    const float lam = expf(d01) - expf(d23) + lam_init;
    const int nItems = 1536 + (l == 0 ? 48 : 0);
    for (int it = opaque_bid(); it < nItems; it += opaque_gdim()) {
        if (it < 1536) {
            const int ty = it >> 9, idx = it & 511, b = idx >> 7, h = (idx >> 5) & 3, qb = idx & 31;
            if (ty == 0) attn_item<1>(p, l, lds, b, h, qb, false, lam, lam_init);
            else if (ty == 1) attn_item<2>(p, l, lds, b, h, qb, false, lam, lam_init);
            else attn_item<0>(p, l, lds, b, h, qb, false, lam, lam_init);
        } else {
            const int idx = it - 1536, ty = idx >> 4, b = (idx >> 2) & 3, h = idx & 3;
            if (ty == 0) attn_item<1>(p, l, lds, b, h, 0, true, lam, lam_init);
            else if (ty == 1) attn_item<2>(p, l, lds, b, h, 0, true, lam, lam_init);
            else attn_item<0>(p, l, lds, b, h, 0, true, lam, lam_init);
        }
    }
}

constexpr int PH_PER_LAYER = 14, N_PHASES = 2 * PH_PER_LAYER + 1;

__device__ __forceinline__ void run_phase(PK p, int ph, LAS unsigned char* lds, float rcoef) {
    unsigned char* ws = p->ws;
    pg8::StaticOrder S;
    if (ph == N_PHASES - 1) { final_norm_phase(p->out, p->final_norm_g); return; }
    int l = ph / PH_PER_LAYER; const int q = ph % PH_PER_LAYER;
#define OPQL asm volatile("" : "+s"(l))
#define HC ((float*)(ws + OFF_HC))
#define MOD ((const float*)(ws + OFF_MOD) + (size_t)l * 5 * 9216)
#define TN ((bf16_t*)(ws + OFF_A))
#define HID ((bf16_t*)(ws + OFF_B))
#define Mlate ((l == 0) ? RA : RL)
    switch (q) {
    case 0: OPQL; layer_prep_phase(p, l, lds); break;
    case 1: OPQL; if (l == 0) norm_mod_phase(p->x, p->ctx, p->out, HC, p->norm_g + (l * 3 + 0) * 1024, MOD, TN, RA);
            else norm_mod_phase(p->out, HC, nullptr, nullptr, p->norm_g + (l * 3 + 0) * 1024, MOD, TN, RA); break;
    case 2: case 12: { OPQL; const int f = (q == 2) ? 0 : 1; const int M = (q == 2) ? RA : Mlate;
        pg8::Gemm g{TN, (const bf16_t*)(ws + OFF_W1) + (size_t)f * 5632 * 1024, M, 5632, 1024, 1024, 1024}; S.init(M, 5632, opaque_gdim(), opaque_bid());
        EpiSwiglu E{HID}; pg8::gemm_phase(lds, g, S, E); } break;
    case 3: case 13: { OPQL; const int f = (q == 3) ? 0 : 1; const int M = (q == 3) ? RA : Mlate;
        pg8::Gemm g{HID, (const bf16_t*)(ws + OFF_W2) + (size_t)f * 1024 * FH, M, 1024, FH, FH, FH}; S.init(M, 1024, opaque_gdim(), opaque_bid());
        EpiResid E{p->out, HC, MOD + (q == 3 ? 2 : 8) * 1024, 0.5f * rcoef}; pg8::gemm_phase(lds, g, S, E); } break;
    case 4: OPQL; norm_mod_phase(p->out, HC, nullptr, nullptr, p->norm_g + (l * 3 + 1) * 1024, MOD + 3 * 1024, TN, RA); break;
    case 5: { OPQL; pg8::Gemm g{TN, (const bf16_t*)(ws + OFF_WM), RA, 6400, 1024, 1024, 1024}; S.init(RA, 6400, opaque_gdim(), opaque_bid());
        EpiPJ E{(bf16_t*)(ws + OFF_B), ws + OFF_C}; pg8::gemm_phase(lds, g, S, E); } break;
    case 6: prep_phase(p); break;
    case 7: { OPQL; pg8::Gemm g{(const bf16_t*)(ws + OFF_B) + C_MQ, (const bf16_t*)(ws + OFF_WL), RA, 1024, 384, PJW, 384}; S.init(RA, 1024, opaque_gdim(), opaque_bid());
        EpiMLA E{(bf16_t*)(ws + OFF_D), (bf16_t*)(ws + OFF_MK), (bf16_t*)(ws + OFF_MV), (const float*)(ws + OFF_RSTD), (const float2*)(ws + OFF_ROPE)}; pg8::gemm_phase(lds, g, S, E); } break;
    case 8: OPQL; attn_phase(p, l, lds); break;
    case 9: { OPQL; pg8::Gemm g{(const bf16_t*)(ws + OFF_A), (const bf16_t*)(ws + OFF_WB), Mlate, 1024, 1024, 1024, 1024}; S.init(Mlate, 1024, opaque_gdim(), opaque_bid());
        EpiMerge E{ws + OFF_C, (bf16_t*)(ws + OFF_D)}; pg8::gemm_phase(lds, g, S, E); } break;
    case 10: { OPQL; pg8::Gemm g{(const bf16_t*)(ws + OFF_D), (const bf16_t*)(ws + OFF_WO), Mlate, 1024, 1024, 1024, 1024}; S.init(Mlate, 1024, opaque_gdim(), opaque_bid());
        EpiResid E{p->out, HC, MOD + 5 * 1024, rcoef}; pg8::gemm_phase(lds, g, S, E); } break;
    case 11: OPQL; norm_mod_phase(p->out, HC, nullptr, nullptr, p->norm_g + (l * 3 + 2) * 1024, MOD + 6 * 1024, TN, Mlate); break;
    }
#undef OPQL
#undef HC
#undef MOD
#undef TN
#undef HID
#undef Mlate
}

__global__ void __launch_bounds__(512, 2) fwd_megakernel(Params p) {
    extern __shared__ __attribute__((aligned(16))) unsigned char shm[];
    LAS unsigned char* lds = (LAS unsigned char*)shm;
#if N_LAUNCH_MODE == 1
    cg::grid_group grid = cg::this_grid();
    const int ph_lo = p.ph_lo, ph_hi = p.ph_hi;
    volatile LAS unsigned* st = (volatile LAS unsigned*)(lds + pg8::STAGE_BYTES);
    unsigned* bar = (unsigned*)(p.ws + OFF_BAR);
    if (opaque_tid() < 4) st[opaque_tid()] = 0u;
    if (opaque_bid() == 0) for (int i = opaque_tid(); i < XCD_BAR_WORDS; i += 512) bar[i] = 0u;
    __syncthreads();
    for (int ph = ph_lo; ph < ph_hi; ++ph) {
        const int qq = ph % PH_PER_LAYER;
        const int nrep = (PROBE_MASK && ph < N_PHASES - 1 && qq != 6 && ((PROBE_MASK >> qq) & 1)) ? 2 : 1;
        for (int rep = 0; rep < nrep; ++rep) {
            PK pk = (PK)__builtin_amdgcn_kernarg_segment_ptr();
            asm volatile("" : "+s"(pk));
            run_phase(pk, ph, lds, (PROBE_MASK & 0x2408) ? (rep ? 0.0f : 1.0f) : 1.0f);
            if (ph == ph_lo && rep == 0) { grid.sync(); xcd_barrier_post(bar); }
            else if (ph + 1 < ph_hi || rep + 1 < nrep) xcd_barrier(bar, st);
        }
    }
#else
    const int ph_lo = p.ph_lo, ph_hi = p.ph_hi;
    for (int ph = ph_lo; ph < ph_hi; ++ph) { PK pk = (PK)__builtin_amdgcn_kernarg_segment_ptr(); asm volatile("" : "+s"(pk)); run_phase(pk, ph, lds, 1.0f); }
#endif
}

extern "C" void kernel_launch(void* const* d_in, const int* in_sizes, int n_in, void* d_out, int out_size, void* d_ws, size_t ws_size, hipStream_t stream) {
    constexpr int LDS_BYTES = pg8::STAGE_BYTES + 16;
    static int grid_blocks = 0;
    if (grid_blocks == 0) {
        if (n_in != 22 || ws_size < WS_END) { fprintf(stderr, "kernel_launch: unexpected inputs (n_in %d, ws %zu < %zu)\n", n_in, ws_size, (size_t)WS_END); grid_blocks = -1; return; }
        int dev = 0, cus = 0, per_cu = 0;
        hipGetDevice(&dev); hipDeviceGetAttribute(&cus, hipDeviceAttributeMultiprocessorCount, dev);
        if (hipFuncSetAttribute((const void*)fwd_megakernel, hipFuncAttributeMaxDynamicSharedMemorySize, LDS_BYTES) != hipSuccess) { fprintf(stderr, "hipFuncSetAttribute failed\n"); grid_blocks = -1; return; }
        if (hipOccupancyMaxActiveBlocksPerMultiprocessor(&per_cu, (const void*)fwd_megakernel, 512, LDS_BYTES) != hipSuccess || per_cu < 1) per_cu = 1;
        (void)hipGetLastError();
        grid_blocks = cus * 1;
    }
    if (grid_blocks < 0) return;
    Params hp{};
    const float** pp = (const float**)&hp;
    for (int i = 0; i < 22; ++i) pp[i] = (const float*)d_in[i];
    hp.out = (float*)d_out; hp.ws = (unsigned char*)d_ws;
#if N_LAUNCH_MODE == 1
    hp.ph_lo = 0; hp.ph_hi = N_PHASES;
    void* args[] = {&hp};
    hipError_t e = hipLaunchCooperativeKernel((const void*)fwd_megakernel, dim3(grid_blocks), dim3(512), args, LDS_BYTES, stream);
    if (e != hipSuccess) fprintf(stderr, "cooperative launch failed: %s (grid %d)\n", hipGetErrorString(e), grid_blocks);
#else
    for (int ph = 0; ph < N_PHASES; ++ph) { hp.ph_lo = ph; hp.ph_hi = ph + 1; hipLaunchKernelGGL(fwd_megakernel, dim3(grid_blocks), dim3(512), LDS_BYTES, stream, hp); }
#endif
}
```

```cpp
#include <hip/hip_runtime.h>
#include <hip/hip_cooperative_groups.h>
#include <cstdio>
namespace cg = cooperative_groups;

#define LAS __attribute__((address_space(3)))
typedef unsigned short bf16_t;
typedef short bf16x8 __attribute__((ext_vector_type(8)));
typedef short s16x4 __attribute__((ext_vector_type(4)));
typedef float f32x4 __attribute__((ext_vector_type(4)));
typedef float f32x16 __attribute__((ext_vector_type(16)));
typedef unsigned u32x4 __attribute__((ext_vector_type(4)));
typedef unsigned u32x2 __attribute__((ext_vector_type(2)));

#ifndef PROBE_MASK
#define PROBE_MASK 0
#endif
#ifndef N_LAUNCH_MODE
#define N_LAUNCH_MODE 1
#endif

constexpr int RL = 32768, RA = 33792, FH = 2816;
constexpr int PJW = 2304;
constexpr int C_NQ = 256, C_NK = 512, C_NV = 768, C_DQ = 1024, C_DK = 1280, C_DV = 1536, C_MQ = 1792, C_MKV = 2048, C_MKR = 2176;
constexpr float LOG2E = 1.4426950408889634f;
constexpr float NEPS = 1e-6f;
constexpr int XCD_BAR_WORDS_C = 3456;

constexpr size_t SZ_W1 = 2ull * 5632 * 1024 * 2, SZ_W2 = 2ull * 1024 * 2816 * 2, SZ_WM = 6400ull * 1024 * 2, SZ_WL = 1024ull * 384 * 2, SZ_WB = 4ull * 1024 * 256 * 2, SZ_WO = 1024ull * 1024 * 2;
constexpr size_t OFF_W1 = 0, OFF_W2 = OFF_W1 + SZ_W1, OFF_WM = OFF_W2 + SZ_W2, OFF_WL = OFF_WM + SZ_WM, OFF_WB = OFF_WL + SZ_WL, OFF_WO = OFF_WB + SZ_WB;
constexpr size_t OFF_HC = OFF_WO + SZ_WO;
constexpr size_t OFF_MOD = OFF_HC + 1024ull * 1024 * 4;
constexpr size_t OFF_ROPE = OFF_MOD + 2ull * 5 * 9216 * 4;
constexpr size_t OFF_RSTD = OFF_ROPE + 128 * 8 * 8;
constexpr size_t OFF_A = OFF_RSTD + (size_t)RA * 2 * 4;
constexpr size_t OFF_B = OFF_A + (size_t)RA * 1024 * 2;
constexpr size_t OFF_C = OFF_B + (size_t)RA * PJW * 2;
constexpr size_t OFF_D = OFF_C + (size_t)RA * 4096;
constexpr size_t OFF_MK = OFF_D + (size_t)RA * 384 * 2, OFF_MV = OFF_MK + (size_t)RA * 384 * 2;
constexpr size_t OFF_BAR = OFF_D + (size_t)RA * 1024 * 2;
constexpr size_t OFF_PB = OFF_BAR + 16384;
constexpr size_t WS_END = OFF_PB + 11ull * 1024 * 1024 * 4;

struct Params {
    const float *x, *c, *ctx, *c_ctx, *ada_w, *ada_b, *norm_g, *ffn_w_in, *ffn_w_out, *mix_w_in, *pool_w, *pool_scale, *na_rpb, *diff_lambda, *diff_subln_g,
        *mla_q_norm_g, *mla_kv_norm_g, *mla_w_qb, *mla_w_kvb, *branch_w_out, *mix_w_out, *final_norm_g;
    float* out; unsigned char* ws;
    int ph_lo, ph_hi;
};

typedef const __attribute__((address_space(4))) Params* PK;

typedef float f32x2_ __attribute__((ext_vector_type(2)));
typedef __bf16 bf16x2_ __attribute__((ext_vector_type(2)));
__device__ __forceinline__ unsigned cvt_pk_bf16(float lo, float hi) { const f32x2_ v = {lo, hi}; return __builtin_bit_cast(unsigned, __builtin_convertvector(v, bf16x2_)); }
__device__ __forceinline__ float bf_lo(unsigned u) { return __uint_as_float(u << 16); }
__device__ __forceinline__ float bf_hi(unsigned u) { return __uint_as_float(u & 0xffff0000u); }
__device__ __forceinline__ float fast_exp2(float x) { return __builtin_amdgcn_exp2f(x); }
__device__ __forceinline__ float fast_rcp(float x) { return __builtin_amdgcn_rcpf(x); }
__device__ __forceinline__ float sigmoidf_(float x) { return fast_rcp(1.0f + fast_exp2(-x * LOG2E)); }
__device__ __forceinline__ float shflx(float v, int m) {
    int lane = __builtin_amdgcn_mbcnt_hi(~0u, __builtin_amdgcn_mbcnt_lo(~0u, 0)); asm volatile("" : "+v"(lane));
    return __int_as_float(__builtin_amdgcn_ds_bpermute((lane ^ m) << 2, __float_as_int(v)));
}
__device__ __forceinline__ float wave_sum(float v) {
    v += shflx(v, 32); v += shflx(v, 16); v += shflx(v, 8); v += shflx(v, 4); v += shflx(v, 2); v += shflx(v, 1); return v;
}
__device__ __forceinline__ int opaque_tid() { int t = threadIdx.x; asm volatile("" : "+v"(t)); return t; }
__device__ __forceinline__ int opaque_bid() { int t = blockIdx.x; asm volatile("" : "+s"(t)); return t; }
__device__ __forceinline__ int opaque_gdim() { int t = gridDim.x; asm volatile("" : "+s"(t)); return t; }
__device__ __forceinline__ int clampi(int v, int lo, int hi) { return v < lo ? lo : (v > hi ? hi : v); }

#define XB_TMO      128
#define XB_XCNT(j)  (256  + 64 * (j))
#define XB_XSUB(j)  (1280 + 64 * (j))
#define XB_XGEN(j)  (2304 + 64 * (j))
#define XB_TOP      3328
#define XB_TOPGEN   3392
#define XCD_BAR_WORDS 3456
#define XB_SPIN_CAP (1u << 20)
__device__ __forceinline__ unsigned xb_ld(unsigned* p)              { return __hip_atomic_load(p, __ATOMIC_RELAXED, __HIP_MEMORY_SCOPE_AGENT); }
__device__ __forceinline__ unsigned xb_add(unsigned* p, unsigned v) { return __hip_atomic_fetch_add(p, v, __ATOMIC_RELAXED, __HIP_MEMORY_SCOPE_AGENT); }
__device__ __forceinline__ unsigned xb_xcc_id() { return (unsigned)__builtin_amdgcn_s_getreg((3 << 11) | 20) & 0xFu; }
#define XB_SPIN(cond, bar) do { unsigned _sp = 0; while (cond) { __builtin_amdgcn_s_sleep(1); \
    if ((++_sp & 255u) == 0u) { if (xb_ld(&(bar)[XB_TMO])) break; if (_sp > XB_SPIN_CAP) { atomicAdd(&(bar)[XB_TMO], 1u); break; } } } } while (0)
__device__ __forceinline__ void xcd_barrier_post(unsigned* bar) { if (opaque_tid() == 0) (void)xb_add(&bar[XB_XCNT(xb_xcc_id())], 1u); }
__device__ __forceinline__ void xcd_barrier_complete(unsigned* bar, unsigned x, unsigned& nloc, unsigned& nx) {
    const unsigned G = gridDim.x;
    unsigned sum, cnt, mine, sp = 0u;
    for (;;) {
        sum = 0u; cnt = 0u; mine = 0u;
#pragma unroll
        for (unsigned j = 0; j < 16; ++j) { const unsigned c = xb_ld(&bar[XB_XCNT(j)]); sum += c; cnt += (c > 0u) ? 1u : 0u; mine = (j == x) ? c : mine; }
        if (sum == G) break;
        __builtin_amdgcn_s_sleep(1);
        if ((++sp & 255u) == 0u) { if (xb_ld(&bar[XB_TMO])) break; if (sp > XB_SPIN_CAP) { atomicAdd(&bar[XB_TMO], 1u); break; } }
    }
    nloc = mine > 0u ? mine : 1u; nx = cnt > 0u ? cnt : 1u;
}
__device__ __forceinline__ void xcd_barrier(unsigned* bar, volatile LAS unsigned* st) {
    asm volatile("s_waitcnt vmcnt(0)" ::: "memory");
    __syncthreads();
    if (opaque_tid() == 0) {
        const unsigned x = xb_xcc_id();
        __builtin_amdgcn_s_waitcnt(0);
        unsigned nloc = st[0], nx = st[1];
        if (nloc == 0u) { xcd_barrier_complete(bar, x, nloc, nx); st[0] = nloc; st[1] = nx; }
        const unsigned old = xb_add(&bar[XB_XSUB(x)], 1u);
        const unsigned gen = old / nloc;
        if (old + 1u == (gen + 1u) * nloc) {
            __builtin_amdgcn_fence(__ATOMIC_RELEASE, "agent");
            asm volatile("s_waitcnt vmcnt(0)" ::: "memory");
            const unsigned og = xb_add(&bar[XB_TOP], 1u);
            const unsigned tg = og / nx;
            if (og + 1u == (tg + 1u) * nx) xb_add(&bar[XB_TOPGEN], 1u);
            else XB_SPIN(xb_ld(&bar[XB_TOPGEN]) == tg, bar);
            __builtin_amdgcn_fence(__ATOMIC_ACQUIRE, "agent");
            xb_add(&bar[XB_XGEN(x)], 1u);
            asm volatile("s_waitcnt vmcnt(0)" ::: "memory");
        } else {
            XB_SPIN(xb_ld(&bar[XB_XGEN(x)]) == gen, bar);
            __builtin_amdgcn_fence(__ATOMIC_ACQUIRE, "agent");
            asm volatile("s_waitcnt vmcnt(0)" ::: "memory");
        }
    }
    __syncthreads();
}

namespace pg8 {
constexpr int BM = 256, BK = 64, HALF = 128, HTB = HALF * BK * 2, STAGE_BYTES = 8 * HTB, NXCD = 8, WGM = 8;
__device__ __forceinline__ int lds_byte(int r, int c) { const int st = (r >> 4) * 2 + (c >> 5), rr = r & 15, cc = c & 31, ob = rr * 64 + cc * 2; return st * 1024 + (ob ^ (((ob >> 9) & 1) << 5)); }
__device__ __forceinline__ void stage_rc(int b, int& R, int& C) { const int st = b / 1024, sb = b % 1024, swz = sb ^ (((sb >> 9) & 1) << 5); R = (st >> 1) * 16 + swz / 64; C = (st & 1) * 32 + (swz % 64) / 2; }
__device__ __forceinline__ int perm32(int rho) { const int n = rho >> 4, i = rho & 15; return 8 * (i >> 2) + 4 * n + (i & 3); }
struct Unit { int pm, pn; };
struct Gemm { const bf16_t* A; const bf16_t* Bt; int M, N, K, lda, ldb; };
struct StaticOrder {
    int nM, nN, nwg, G, c;
    __device__ void init(int M, int N, int G_, int c_) { nM = M / BM; nN = N / BM; nwg = nM * nN; G = G_; c = c_; }
    __device__ bool next(int i, Unit& u) const {
        const long L = (long)i * G + c; if (L >= nwg) return false;
        int wgid = (int)L; { const int q = nwg / NXCD, r = nwg % NXCD, xcd = wgid % NXCD, off = wgid / NXCD; wgid = (xcd < r ? xcd * (q + 1) : r * (q + 1) + (xcd - r) * q) + off; }
        const int nig = WGM * nN, gid = wgid / nig, fm = gid * WGM, gsz = (nM - fm) < WGM ? (nM - fm) : WGM;
        u.pm = fm + ((wgid % nig) % gsz); u.pn = (wgid % nig) / gsz; return true;
    }
};

struct SingleUnit {
    int pm, pn; bool has;
    __device__ bool next(int i, Unit& u) const { if (i > 0 || !has) return false; u.pm = pm; u.pn = pn; return true; }
};
template <class Epi, class Sched>
__device__ __forceinline__ void gemm_phase(LAS unsigned char* lds, const Gemm g, const Sched& S, const Epi& E) {
    const int tid = opaque_tid(), wid = __builtin_amdgcn_readfirstlane(tid >> 6), lane = tid & 63, wr = wid >> 2, wc = wid & 3, fr = lane & 15, fq = lane >> 4;
    const int K = g.K, nt = K / BK;
    unsigned voffA[2], voffB[2];
#pragma unroll
    for (int i = 0; i < 2; ++i) { int R, C; stage_rc(tid * 16 + i * 8192, R, C); const int Rb = Epi::PERM ? ((R & ~31) + perm32(R & 31)) : R;
        voffA[i] = (unsigned)(R * g.lda + C) * 2u; voffB[i] = (unsigned)(Rb * g.ldb + C) * 2u; }
    const size_t kstep = (size_t)(BK * 2);
    const size_t hstepA = (size_t)HALF * g.lda * 2, hstepB = (size_t)HALF * g.ldb * 2;
    const size_t tstepA = 2 * hstepA, tstepB = 2 * hstepB;
    const unsigned ldsw = (unsigned)wid * 1024u;
    const int aoff = lds_byte(wr * 64 + fr, fq * 8), boff = lds_byte(wc * 32 + fr, fq * 8);
#define PG8_SA(b, h) (((b) * 2 + (h)) * HTB)
#define PG8_SB(b, h) ((4 + (b) * 2 + (h)) * HTB)
#define PG8_STAGE(bufoff, gbase, voff) do { _Pragma("unroll") for (int _i = 0; _i < 2; ++_i) \
        __builtin_amdgcn_global_load_lds((const unsigned*)((const char*)(gbase) + (voff)[_i]), (LAS unsigned*)(lds + (bufoff) + ldsw + _i * 8192), 16, 0, 0); } while (0)
#define PG8_LDA(dst, b, h) do { _Pragma("unroll") for (int m = 0; m < 4; ++m) _Pragma("unroll") for (int k = 0; k < 2; ++k) dst[m][k] = *(const LAS bf16x8*)(lds + PG8_SA(b, h) + aoff + m * 2048 + k * 1024); } while (0)
#define PG8_LDB(dst, b, h) do { _Pragma("unroll") for (int n = 0; n < 2; ++n) _Pragma("unroll") for (int k = 0; k < 2; ++k) dst[n][k] = *(const LAS bf16x8*)(lds + PG8_SB(b, h) + boff + n * 2048 + k * 1024); } while (0)
#define PG8_MMA(ai, bj, At, Bt) do { __builtin_amdgcn_s_setprio(1); _Pragma("unroll") for (int m = 0; m < 4; ++m) _Pragma("unroll") for (int n = 0; n < 2; ++n) _Pragma("unroll") for (int k = 0; k < 2; ++k) \
        acc[ai][bj][m][n] = __builtin_amdgcn_mfma_f32_16x16x32_bf16(Bt[n][k], At[m][k], acc[ai][bj][m][n], 0, 0, 0); __builtin_amdgcn_s_setprio(0); } while (0)
#define PG8_WAIT_V(n) asm volatile("s_waitcnt vmcnt(" #n ")" ::: "memory")
#define PG8_WAIT_L(n) asm volatile("s_waitcnt lgkmcnt(" #n ")" ::: "memory")
#define PG8_BAR __builtin_amdgcn_s_barrier()
#define PG8_SCHED __builtin_amdgcn_sched_barrier(0)
    Unit cur, nxt; int ui = 0;
    if (!S.next(0, cur)) return;
    f32x4 acc[2][2][4][2];
#pragma unroll
    for (int a = 0; a < 2; ++a)
#pragma unroll
        for (int b = 0; b < 2; ++b)
#pragma unroll
            for (int m = 0; m < 4; ++m)
#pragma unroll
                for (int n = 0; n < 2; ++n) acc[a][b][m][n] = (f32x4){0.f, 0.f, 0.f, 0.f};
    bf16x8 At[4][2], B0[2][2], B1[2][2];
    const char* cA = (const char*)g.A + (size_t)cur.pm * tstepA; const char* cB = (const char*)g.Bt + (size_t)cur.pn * tstepB;
    PG8_STAGE(PG8_SB(0, 0), cB, voffB); PG8_STAGE(PG8_SA(0, 0), cA, voffA); PG8_STAGE(PG8_SB(0, 1), cB + hstepB, voffB); PG8_STAGE(PG8_SA(0, 1), cA + hstepA, voffA);
    if (wr == 1) PG8_BAR;
    PG8_WAIT_V(4); PG8_BAR;
    PG8_STAGE(PG8_SB(1, 0), cB + kstep, voffB); PG8_STAGE(PG8_SA(1, 0), cA + kstep, voffA); PG8_STAGE(PG8_SB(1, 1), cB + hstepB + kstep, voffB);
    PG8_WAIT_V(6); PG8_BAR;
    for (;;) {
        const bool has_next = S.next(ui + 1, nxt);
        const char* nA = has_next ? (const char*)g.A + (size_t)nxt.pm * tstepA : cA; const char* nB = has_next ? (const char*)g.Bt + (size_t)nxt.pn * tstepB : cB;
        for (int t = 0; t < nt; t += 2) {
            const bool last = (t == nt - 2);
            const char* a1 = cA + (size_t)(t + 1) * kstep;
            const char* a2 = last ? nA : cA + (size_t)(t + 2) * kstep; const char* b2 = last ? nB : cB + (size_t)(t + 2) * kstep;
            const char* a3 = a2 + kstep; const char* b3 = b2 + kstep;
            PG8_LDB(B0, 0, 0); PG8_SCHED; PG8_LDA(At, 0, 0); PG8_STAGE(PG8_SA(1, 1), a1 + hstepA, voffA);
            PG8_WAIT_L(8); PG8_BAR; PG8_WAIT_L(0); PG8_MMA(0, 0, At, B0); PG8_BAR; PG8_SCHED;
            PG8_LDB(B1, 0, 1); PG8_STAGE(PG8_SB(0, 0), b2, voffB);
            PG8_BAR; PG8_WAIT_L(0); PG8_MMA(0, 1, At, B1); PG8_BAR;
            PG8_LDA(At, 0, 1); PG8_STAGE(PG8_SA(0, 0), a2, voffA);
            PG8_BAR; PG8_WAIT_L(0); PG8_MMA(1, 0, At, B0); PG8_BAR; PG8_SCHED;
            PG8_STAGE(PG8_SB(0, 1), b2 + hstepB, voffB);
            PG8_WAIT_V(6); PG8_BAR; PG8_MMA(1, 1, At, B1); PG8_BAR;
            PG8_LDB(B0, 1, 0); PG8_SCHED; PG8_LDA(At, 1, 0); PG8_STAGE(PG8_SA(0, 1), a2 + hstepA, voffA);
            PG8_WAIT_L(8); PG8_BAR; PG8_WAIT_L(0); PG8_MMA(0, 0, At, B0); PG8_BAR; PG8_SCHED;
            PG8_LDB(B1, 1, 1); PG8_STAGE(PG8_SB(1, 0), b3, voffB);
            PG8_BAR; PG8_WAIT_L(0); PG8_MMA(0, 1, At, B1); PG8_BAR;
            PG8_LDA(At, 1, 1); PG8_STAGE(PG8_SA(1, 0), a3, voffA);
            PG8_BAR; PG8_WAIT_L(0); PG8_MMA(1, 0, At, B0); PG8_BAR; PG8_SCHED;
            PG8_STAGE(PG8_SB(1, 1), b3 + hstepB, voffB);
            PG8_WAIT_V(6); PG8_BAR; PG8_MMA(1, 1, At, B1); PG8_BAR;
            if constexpr (Epi::HOOK) { if ((((t + 2) & 3) == 0) && !last) E.hook(acc, cur, (t + 2) >> 2, wr, wc, fr, fq); }
        }
        E(acc, cur, wr, wc, fr, fq);
        if (!has_next) break;
#pragma unroll
        for (int a = 0; a < 2; ++a)
#pragma unroll
            for (int b = 0; b < 2; ++b)
#pragma unroll
                for (int m = 0; m < 4; ++m)
#pragma unroll
                    for (int n = 0; n < 2; ++n) acc[a][b][m][n] = (f32x4){0.f, 0.f, 0.f, 0.f};
        cur = nxt; cA = nA; cB = nB; ++ui;
    }
    PG8_WAIT_V(0);
    if (wr == 0) PG8_BAR;
    PG8_BAR;
#undef PG8_SA
#undef PG8_SB
#undef PG8_STAGE
#undef PG8_LDA
#undef PG8_LDB
#undef PG8_MMA
#undef PG8_WAIT_V
#undef PG8_WAIT_L
#undef PG8_BAR
#undef PG8_SCHED
}
}
using pg8::Unit;

__device__ __forceinline__ size_t g8_off(int row, int colg) { return ((size_t)(row >> 4) * 128 + (colg >> 5)) * 512 + (row & 15) * 32 + (colg & 31); }

struct EpiSwiglu {
    static constexpr bool HOOK = false;
    static constexpr bool PERM = true;
    bf16_t* HID;
    __device__ __forceinline__ void operator()(const f32x4 (&acc)[2][2][4][2], const Unit& u, int wr, int wc, int fr, int fq) const {
        const int row0 = u.pm * 256 + wr * 64 + fr, col0 = u.pn * 128 + wc * 32 + 8 * fq;
#pragma unroll
        for (int ai = 0; ai < 2; ++ai)
#pragma unroll
            for (int m = 0; m < 4; ++m) {
                const int row = row0 + ai * 128 + m * 16;
                float hv[8];
#pragma unroll
                for (int n = 0; n < 2; ++n)
#pragma unroll
                    for (int j = 0; j < 4; ++j) { const float a = acc[ai][0][m][n][j], b = acc[ai][1][m][n][j]; hv[4 * n + j] = a * sigmoidf_(a) * b; }
                u32x4 w; w.x = cvt_pk_bf16(hv[0], hv[1]); w.y = cvt_pk_bf16(hv[2], hv[3]); w.z = cvt_pk_bf16(hv[4], hv[5]); w.w = cvt_pk_bf16(hv[6], hv[7]);
                *(u32x4*)(HID + (size_t)row * FH + col0) = w;
            }
    }
};
struct EpiResid {
    static constexpr bool HOOK = false;
    static constexpr bool PERM = false;
    float* Hl; float* Hc; const float* gate; float coef;
    __device__ __forceinline__ void operator()(const f32x4 (&acc)[2][2][4][2], const Unit& u, int wr, int wc, int fr, int fq) const {
        const int row0 = u.pm * 256 + wr * 64 + fr, col0 = u.pn * 256 + wc * 32 + 4 * fq;
#pragma unroll
        for (int ai = 0; ai < 2; ++ai)
#pragma unroll
            for (int m = 0; m < 4; ++m) {
                const int row = row0 + ai * 128 + m * 16;
                float* hp = row < RL ? Hl + (size_t)row * 1024 : Hc + (size_t)(row - RL) * 1024;
                const float* gp = gate + (row < RL ? (row >> 13) : 4) * 9216;
#pragma unroll
                for (int bj = 0; bj < 2; ++bj)
#pragma unroll
                    for (int n = 0; n < 2; ++n) {
                        const int c = col0 + bj * 128 + n * 16;
                        const f32x4 g4 = *(const f32x4*)(gp + c); f32x4 h4 = *(const f32x4*)(hp + c);
                        h4 += (g4 * coef) * acc[ai][bj][m][n];
                        *(f32x4*)(hp + c) = h4;
                    }
            }
    }
};
struct EpiPartial {
    static constexpr bool HOOK = false;
    static constexpr bool PERM = false;
    float* PB; const float* gate; float coef;
    __device__ __forceinline__ void operator()(const f32x4 (&acc)[2][2][4][2], const Unit& u, int wr, int wc, int fr, int fq) const {
        const int row0 = u.pm * 256 + wr * 64 + fr - RL, col0 = u.pn * 256 + wc * 32 + 4 * fq;
#pragma unroll
        for (int ai = 0; ai < 2; ++ai)
#pragma unroll
            for (int m = 0; m < 4; ++m) {
                float* hp = PB + (size_t)(row0 + ai * 128 + m * 16) * 1024;
#pragma unroll
                for (int bj = 0; bj < 2; ++bj)
#pragma unroll
                    for (int n = 0; n < 2; ++n) {
                        const int c = col0 + bj * 128 + n * 16;
                        const f32x4 g4 = *(const f32x4*)(gate + c);
                        *(f32x4*)(hp + c) = (g4 * coef) * acc[ai][bj][m][n];
                    }
            }
    }
};
struct EpiPJ {
    static constexpr bool HOOK = false;
    static constexpr bool PERM = true;
    bf16_t* PJ; unsigned char* G8;
    __device__ __forceinline__ void operator()(const f32x4 (&acc)[2][2][4][2], const Unit& u, int wr, int wc, int fr, int fq) const {
        const int row0 = u.pm * 256 + wr * 64 + fr, c0 = wc * 32 + 8 * fq;
        if (u.pn < 9) {
#pragma unroll
            for (int ai = 0; ai < 2; ++ai)
#pragma unroll
                for (int m = 0; m < 4; ++m) {
                    const int row = row0 + ai * 128 + m * 16;
#pragma unroll
                    for (int bj = 0; bj < 2; ++bj) {
                        const f32x4 v0 = acc[ai][bj][m][0], v1 = acc[ai][bj][m][1];
                        u32x4 w; w.x = cvt_pk_bf16(v0[0], v0[1]); w.y = cvt_pk_bf16(v0[2], v0[3]); w.z = cvt_pk_bf16(v1[0], v1[1]); w.w = cvt_pk_bf16(v1[2], v1[3]);
                        *(u32x4*)(PJ + (size_t)row * PJW + u.pn * 256 + bj * 128 + c0) = w;
                    }
                }
        } else {
#pragma unroll
            for (int ai = 0; ai < 2; ++ai)
#pragma unroll
                for (int m = 0; m < 4; ++m) {
                    const int row = row0 + ai * 128 + m * 16;
#pragma unroll
                    for (int bj = 0; bj < 2; ++bj) {
                        unsigned q[8];
#pragma unroll
                        for (int n = 0; n < 2; ++n)
#pragma unroll
                            for (int j = 0; j < 4; ++j) { int v = (int)(sigmoidf_(acc[ai][bj][m][n][j]) * 256.0f); q[4 * n + j] = (unsigned)(v > 255 ? 255 : v); }
                        u32x2 w; w.x = q[0] | (q[1] << 8) | (q[2] << 16) | (q[3] << 24); w.y = q[4] | (q[5] << 8) | (q[6] << 16) | (q[7] << 24);
                        *(u32x2*)(G8 + g8_off(row, (u.pn - 9) * 256 + bj * 128 + c0)) = w;
                    }
                }
        }
    }
};
struct EpiMLA {
    static constexpr bool HOOK = false;
    static constexpr bool PERM = true;
    bf16_t *MQ, *MK, *MV; const float* RSTD; const float2* RT;
    __device__ __forceinline__ void operator()(const f32x4 (&acc)[2][2][4][2], const Unit& u, int wr, int wc, int fr, int fq) const {
        const int row0 = u.pm * 256 + wr * 64 + fr;
#pragma unroll
        for (int bj = 0; bj < 2; ++bj) {
            const int cg0 = u.pn * 256 + bj * 128 + wc * 32;
            if (cg0 >= 896) continue;
#pragma unroll
            for (int ai = 0; ai < 2; ++ai)
#pragma unroll
                for (int m = 0; m < 4; ++m) {
                    __builtin_amdgcn_sched_barrier(0);
                    const int row = row0 + ai * 128 + m * 16;
                    float v[8];
                    if (cg0 < 384) {
                        const float rs = RSTD[row * 2];
#pragma unroll
                        for (int n = 0; n < 2; ++n)
#pragma unroll
                            for (int j = 0; j < 4; ++j) v[4 * n + j] = acc[ai][bj][m][n][j] * rs;
                        const int d0 = cg0 % 96;
                        if (d0 == 64) {
                            const bool lat = row < RL; const int t = row & 8191; const int pos = (fq >> 1) ? (t & 63) : (t >> 6); const bool isx2 = fq & 1;
#pragma unroll
                            for (int e = 0; e < 8; ++e) {
                                const float pr = shflx(v[e], 16);
                                const float2 cs = RT[pos * 8 + e];
                                const float r = isx2 ? (pr * cs.y + v[e] * cs.x) : (v[e] * cs.x - pr * cs.y);
                                v[e] = lat ? r : v[e];
                            }
                        }
                        u32x4 w; w.x = cvt_pk_bf16(v[0], v[1]); w.y = cvt_pk_bf16(v[2], v[3]); w.z = cvt_pk_bf16(v[4], v[5]); w.w = cvt_pk_bf16(v[6], v[7]);
                        *(u32x4*)(MQ + (size_t)row * 384 + cg0 + 8 * fq) = w;
                    } else {
                        const float rs = RSTD[row * 2 + 1];
#pragma unroll
                        for (int n = 0; n < 2; ++n)
#pragma unroll
                            for (int j = 0; j < 4; ++j) v[4 * n + j] = acc[ai][bj][m][n][j] * rs;
                        const int cp = cg0 - 384, hd = cp >> 7, d0 = cp & 127;
                        u32x4 w; w.x = cvt_pk_bf16(v[0], v[1]); w.y = cvt_pk_bf16(v[2], v[3]); w.z = cvt_pk_bf16(v[4], v[5]); w.w = cvt_pk_bf16(v[6], v[7]);
                        if (d0 < 64) *(u32x4*)(MK + (size_t)row * 384 + hd * 96 + d0 + 8 * fq) = w;
                        else *(u32x4*)(MV + (size_t)row * 256 + hd * 64 + (d0 - 64) + 8 * fq) = w;
                    }
                }
        }
    }
};
struct EpiMerge {
    static constexpr bool PERM = true, HOOK = true;
    const unsigned char* G8; bf16_t* MG;
    __device__ __forceinline__ void hook(f32x4 (&acc)[2][2][4][2], const Unit& u, int nb, int wr, int wc, int fr, int fq) const {
        const int row0 = u.pm * 256 + wr * 64 + fr, c0 = u.pn * 256 + wc * 32 + 8 * fq;
#pragma unroll
        for (int ai = 0; ai < 2; ++ai) {
            u32x2 ga[4][2], gb[4][2];
#pragma unroll
            for (int m = 0; m < 4; ++m)
#pragma unroll
                for (int bj = 0; bj < 2; ++bj) { const int row = row0 + ai * 128 + m * 16, c = c0 + bj * 128;
                    ga[m][bj] = *(const u32x2*)(G8 + g8_off(row, (nb - 1) * 1024 + c)); gb[m][bj] = *(const u32x2*)(G8 + g8_off(row, nb * 1024 + c)); }
#pragma unroll
            for (int m = 0; m < 4; ++m)
#pragma unroll
                for (int bj = 0; bj < 2; ++bj)
#pragma unroll
                    for (int e = 0; e < 8; ++e) { const unsigned qa = ((e < 4 ? ga[m][bj].x : ga[m][bj].y) >> (8 * (e & 3))) & 255u, qb = ((e < 4 ? gb[m][bj].x : gb[m][bj].y) >> (8 * (e & 3))) & 255u;
                        acc[ai][bj][m][e >> 2][e & 3] *= ((float)qa + 0.5f) * fast_rcp((float)qb + 0.5f); }
            __builtin_amdgcn_sched_barrier(0);
        }
    }
    __device__ __forceinline__ void operator()(const f32x4 (&acc)[2][2][4][2], const Unit& u, int wr, int wc, int fr, int fq) const {
        const int row0 = u.pm * 256 + wr * 64 + fr, c0 = u.pn * 256 + wc * 32 + 8 * fq;
#pragma unroll
        for (int ai = 0; ai < 2; ++ai) {
            u32x2 gq[4][2];
#pragma unroll
            for (int m = 0; m < 4; ++m)
#pragma unroll
                for (int bj = 0; bj < 2; ++bj) gq[m][bj] = *(const u32x2*)(G8 + g8_off(row0 + ai * 128 + m * 16, 3 * 1024 + c0 + bj * 128));
#pragma unroll
            for (int m = 0; m < 4; ++m)
#pragma unroll
                for (int bj = 0; bj < 2; ++bj) {
                    const int row = row0 + ai * 128 + m * 16, c = c0 + bj * 128;
                    float v[8];
#pragma unroll
                    for (int e = 0; e < 8; ++e) { const unsigned q = ((e < 4 ? gq[m][bj].x : gq[m][bj].y) >> (8 * (e & 3))) & 255u; v[e] = ((float)q + 0.5f) * (1.0f / 256.0f) * acc[ai][bj][m][e >> 2][e & 3]; }
                    u32x4 w; w.x = cvt_pk_bf16(v[0], v[1]); w.y = cvt_pk_bf16(v[2], v[3]); w.z = cvt_pk_bf16(v[4], v[5]); w.w = cvt_pk_bf16(v[6], v[7]);
                    *(u32x4*)(MG + (size_t)row * 1024 + c) = w;
                }
            __builtin_amdgcn_sched_barrier(0);
        }
    }
};

template <class F>
__device__ __forceinline__ void wt_rows64(bf16_t* dst, int K, F srcval, int ldd = 0) {
    if (ldd == 0) ldd = K;
    const int tid_ = opaque_tid(); const int nl = tid_ & 63, kq = tid_ >> 6;
    for (int k0 = kq * 8; k0 < K; k0 += 64) {
        float v[8];
#pragma unroll
        for (int j = 0; j < 8; ++j) v[j] = srcval(nl, k0 + j);
        u32x4 w; w.x = cvt_pk_bf16(v[0], v[1]); w.y = cvt_pk_bf16(v[2], v[3]); w.z = cvt_pk_bf16(v[4], v[5]); w.w = cvt_pk_bf16(v[6], v[7]);
        *(u32x4*)(dst + (size_t)nl * ldd + k0) = w;
    }
}

__device__ void layer_prep_phase(PK p, int l, LAS unsigned char* lds) {
    unsigned char* ws = p->ws;
    const int nW = 404, nItems = nW + (l == 0 ? 288 + 1 : 0);
    for (int it = opaque_bid(); it < nItems; it += opaque_gdim()) {
        if (it < 176) {
            const int f = it / 88, j = it % 88; const float* src = p->ffn_w_in + ((size_t)(l * 2 + f) * 1024) * 5632;
            bf16_t* dst = (bf16_t*)(ws + OFF_W1) + ((size_t)f * 5632 + j * 64) * 1024;
            wt_rows64(dst, 1024, [&](int nl, int k) { const int np = j * 64 + nl, pn = np >> 8, wi = np & 255; const int col = wi < 128 ? pn * 128 + wi : FH + pn * 128 + (wi - 128); return src[(size_t)k * 5632 + col]; });
        } else if (it < 208) {
            const int q = it - 176, f = q / 16, j = q % 16; const float* src = p->ffn_w_out + ((size_t)(l * 2 + f) * FH) * 1024;
            bf16_t* dst = (bf16_t*)(ws + OFF_W2) + ((size_t)f * 1024 + j * 64) * FH;
            wt_rows64(dst, FH, [&](int nl, int k) { return src[(size_t)k * 1024 + j * 64 + nl]; });
        } else if (it < 308) {
            const int j = it - 208; const float* src = p->mix_w_in + (size_t)l * 1024 * 6304;
            bf16_t* dst = (bf16_t*)(ws + OFF_WM) + (size_t)j * 64 * 1024;
            wt_rows64(dst, 1024, [&](int nl, int k) { const int np = j * 64 + nl; const int col = np < 2208 ? np : (np < 2304 ? -1 : np - 96); return col < 0 ? 0.f : src[(size_t)k * 6304 + col]; });
        } else if (it < 324) {
            const int j = it - 308; const float* src = p->mix_w_out + (size_t)l * 1024 * 1024;
            bf16_t* dst = (bf16_t*)(ws + OFF_WO) + (size_t)j * 64 * 1024;
            wt_rows64(dst, 1024, [&](int nl, int k) { return src[(size_t)k * 1024 + j * 64 + nl]; });
        } else if (it < 372) {
            const int q = it - 324, bi = 1 + q / 16, j = q % 16; const float* src = p->branch_w_out + ((size_t)(l * 4 + bi) * 256) * 1024;
            bf16_t* dst = (bf16_t*)(ws + OFF_WB) + (size_t)j * 64 * 1024 + bi * 256;
            wt_rows64(dst, 256, [&](int nl, int k) { return src[(size_t)k * 1024 + j * 64 + nl]; }, 1024);
        } else if (it < 388) {
            const int j = it - 372; const float* wb = p->branch_w_out + ((size_t)(l * 4) * 256) * 1024; const float* pw = p->pool_w + (size_t)l * 4 * 64 * 64; const float* ps = p->pool_scale + l * 256;
            bf16_t* dst = (bf16_t*)(ws + OFF_WB) + (size_t)j * 64 * 1024;
            wt_rows64(dst, 256, [&](int nl, int k) { const int gI = k >> 6, n = j * 64 + nl; const float* pr = pw + (size_t)k * 64; float s = 0.f;
                for (int e = 0; e < 64; ++e) s += pr[e] * ps[gI * 64 + e] * wb[(size_t)(gI * 64 + e) * 1024 + n]; return s; }, 1024);
        } else if (it < 404) {
            const int j = it - 388; const float* wq = p->mla_w_qb + (size_t)l * 256 * 384; const float* wk = p->mla_w_kvb + (size_t)l * 128 * 512;
            const float* gq = p->mla_q_norm_g + l * 256; const float* gk = p->mla_kv_norm_g + l * 128;
            bf16_t* dst = (bf16_t*)(ws + OFF_WL) + (size_t)j * 64 * 384;
            wt_rows64(dst, 384, [&](int nl, int k) { const int n = j * 64 + nl;
                if (n < 384) return k < 256 ? gq[k] * wq[(size_t)k * 384 + n] : 0.f;
                if (n < 896) return k >= 256 ? gk[k - 256] * wk[(size_t)(k - 256) * 512 + (n - 384)] : 0.f;
                return 0.f; });
        } else if (it < 404 + 288) {
            const int q = it - 404, ll = q / 144, cb = q % 144;
            LAS float* sc = (LAS float*)lds;
            LAS float* red = (LAS float*)(lds + 5 * 1024 * 4);
            __syncthreads();
            for (int i = opaque_tid(); i < 5 * 1024; i += 512) { const int r = i >> 10, k = i & 1023; const float cv = r < 4 ? p->c[r * 1024 + k] : p->c_ctx[k]; sc[i] = cv * sigmoidf_(cv); }
            __syncthreads();
            const int jl = opaque_tid() & 63, kg = opaque_tid() >> 6; const int col = cb * 64 + jl;
            const float* wsrc = p->ada_w + (size_t)ll * 1024 * 9216 + col;
            float a0 = 0.f, a1 = 0.f, a2 = 0.f, a3 = 0.f, a4 = 0.f;
            for (int k = kg * 128; k < kg * 128 + 128; ++k) { const float wv = wsrc[(size_t)k * 9216]; a0 += sc[k] * wv; a1 += sc[1024 + k] * wv; a2 += sc[2048 + k] * wv; a3 += sc[3072 + k] * wv; a4 += sc[4096 + k] * wv; }
            red[(kg * 5 + 0) * 64 + jl] = a0; red[(kg * 5 + 1) * 64 + jl] = a1; red[(kg * 5 + 2) * 64 + jl] = a2; red[(kg * 5 + 3) * 64 + jl] = a3; red[(kg * 5 + 4) * 64 + jl] = a4;
            __syncthreads();
            if (opaque_tid() < 320) { const int r = opaque_tid() >> 6; float s = p->ada_b[ll * 9216 + col];
                for (int q2 = 0; q2 < 8; ++q2) s += red[(q2 * 5 + r) * 64 + jl];
                ((float*)(ws + OFF_MOD))[(size_t)(ll * 5 + r) * 9216 + col] = s; }
        } else {
            for (int i = opaque_tid(); i < 1024; i += 512) { const int pos = i >> 3, fi = i & 7; const float inv = exp2f(-(float)fi * 0.125f * 13.287712379549449f); const float ang = (float)pos * inv;
                ((float2*)(ws + OFF_ROPE))[i] = make_float2(cosf(ang), sinf(ang)); }
        }
    }
}

__device__ void norm_mod_phase(const float* srcL, const float* srcC, float* cpyL, float* cpyC, const float* g, const float* mod, bf16_t* TN, int nrows, const float* pb, int nsl) {
    const int tid_ = opaque_tid(); const int lane = tid_ & 63, gw = opaque_bid() * 8 + (tid_ >> 6), nw = opaque_gdim() * 8;
    for (int row = gw; row < nrows; row += nw) {
        const bool lat = row < RL;
        const float* sp = lat ? srcL + (size_t)row * 1024 : srcC + (size_t)(row - RL) * 1024;
        const float* mp = mod + (lat ? (row >> 13) : 4) * 9216;
        f32x4 v[4]; float ss = 0.f;
#pragma unroll
        for (int j = 0; j < 4; ++j) v[j] = *(const f32x4*)(sp + 256 * j + 4 * lane);
        if (!lat && nsl > 0) {
            for (int sl = 0; sl < nsl; ++sl) { const float* pp = pb + ((size_t)sl * 1024 + (row - RL)) * 1024;
#pragma unroll
                for (int j = 0; j < 4; ++j) v[j] += *(const f32x4*)(pp + 256 * j + 4 * lane); }
            float* wp = (float*)sp;
#pragma unroll
            for (int j = 0; j < 4; ++j) *(f32x4*)(wp + 256 * j + 4 * lane) = v[j];
        }
#pragma unroll
        for (int j = 0; j < 4; ++j) ss += v[j][0] * v[j][0] + v[j][1] * v[j][1] + v[j][2] * v[j][2] + v[j][3] * v[j][3];
        if (cpyL) { float* cp = lat ? cpyL + (size_t)row * 1024 : cpyC + (size_t)(row - RL) * 1024;
#pragma unroll
            for (int j = 0; j < 4; ++j) *(f32x4*)(cp + 256 * j + 4 * lane) = v[j]; }
        ss = wave_sum(ss);
        const float rstd = rsqrtf(ss * (1.0f / 1024.0f) + NEPS);
#pragma unroll
        for (int j = 0; j < 4; ++j) {
            const int col = 256 * j + 4 * lane;
            const f32x4 gg = *(const f32x4*)(g + col), sh = *(const f32x4*)(mp + col), sc = *(const f32x4*)(mp + 1024 + col);
            float o[4];
#pragma unroll
            for (int e = 0; e < 4; ++e) o[e] = (v[j][e] * rstd * gg[e]) * (1.0f + sc[e]) + sh[e];
            u32x2 w; w.x = cvt_pk_bf16(o[0], o[1]); w.y = cvt_pk_bf16(o[2], o[3]);
            *(u32x2*)(TN + (size_t)row * 1024 + col) = w;
        }
    }
}
__device__ void final_norm_phase(float* H, const float* g) {
    const int tid_ = opaque_tid(); const int lane = tid_ & 63, gw = opaque_bid() * 8 + (tid_ >> 6), nw = opaque_gdim() * 8;
    for (int row = gw; row < RL; row += nw) {
        float* sp = H + (size_t)row * 1024; f32x4 v[4]; float ss = 0.f;
#pragma unroll
        for (int j = 0; j < 4; ++j) { v[j] = *(const f32x4*)(sp + 256 * j + 4 * lane); ss += v[j][0] * v[j][0] + v[j][1] * v[j][1] + v[j][2] * v[j][2] + v[j][3] * v[j][3]; }
        ss = wave_sum(ss);
        const float rstd = rsqrtf(ss * (1.0f / 1024.0f) + NEPS);
#pragma unroll
        for (int j = 0; j < 4; ++j) { const f32x4 gg = *(const f32x4*)(g + 256 * j + 4 * lane); *(f32x4*)(sp + 256 * j + 4 * lane) = v[j] * rstd * gg; }
    }
}

__device__ void prep_phase(PK p) {
    unsigned char* ws = p->ws;
    bf16_t* PJ = (bf16_t*)(ws + OFF_B); bf16_t* YB = (bf16_t*)(ws + OFF_A); bf16_t* MK = (bf16_t*)(ws + OFF_MK); float* RSTD = (float*)(ws + OFF_RSTD);
    const float2* RT = (const float2*)(ws + OFF_ROPE);
    const int tid_ = opaque_tid(); const int lane = tid_ & 63, gw = opaque_bid() * 8 + (tid_ >> 6), nw = opaque_gdim() * 8;
    for (int row = gw; row < RA; row += nw) {
        const bool lat = row < RL;
        int t, n; if (lat) { t = row & 8191; n = 8192; } else { t = (row - RL) & 255; n = 256; }
        const int sbase = row - t;
        bf16_t* prow = PJ + (size_t)row * PJW;
        {
            const int wdw = 2 << (lane >> 4); const int lo = max(t - wdw / 2, 0), hi = min(t - wdw / 2 + wdw, n);
            float s0 = 0.f, s1 = 0.f, s2 = 0.f, s3 = 0.f;
            for (int tt = lo; tt < hi; ++tt) { const u32x2 v = *(const u32x2*)(PJ + (size_t)(sbase + tt) * PJW + 4 * lane); s0 += bf_lo(v.x); s1 += bf_hi(v.x); s2 += bf_lo(v.y); s3 += bf_hi(v.y); }
            const float ic = 1.0f / (float)(hi - lo); const u32x2 sv = *(const u32x2*)(prow + 4 * lane);
            u32x2 w; w.x = cvt_pk_bf16(s0 * ic - bf_lo(sv.x), s1 * ic - bf_hi(sv.x)); w.y = cvt_pk_bf16(s2 * ic - bf_lo(sv.y), s3 * ic - bf_hi(sv.y));
            *(u32x2*)(YB + (size_t)row * 1024 + 4 * lane) = w;
        }
        {
            const u32x2 q = *(const u32x2*)(prow + C_MQ + 4 * lane); const unsigned kv = *(const unsigned*)(prow + C_MKV + 2 * lane);
            float sq = bf_lo(q.x) * bf_lo(q.x) + bf_hi(q.x) * bf_hi(q.x) + bf_lo(q.y) * bf_lo(q.y) + bf_hi(q.y) * bf_hi(q.y);
            float sk = bf_lo(kv) * bf_lo(kv) + bf_hi(kv) * bf_hi(kv);
            sq = wave_sum(sq); sk = wave_sum(sk);
            if (lane == 0) { RSTD[row * 2] = rsqrtf(sq * (1.0f / 256.0f) + NEPS); RSTD[row * 2 + 1] = rsqrtf(sk * (1.0f / 128.0f) + NEPS); }
        }
        if (lane < 34) {
            const bool iskr = lane >= 32; const int a = lane & 1;
            bf16_t* ep = iskr ? prow + C_MKR + a * 16 : prow + ((lane >> 4) ? C_DK : C_DQ) + ((lane >> 1) & 7) * 32 + a * 16;
            const u32x4 e0 = *(const u32x4*)ep, e1 = *(const u32x4*)(ep + 8);
            float x1[8], x2[8];
            x1[0] = bf_lo(e0.x); x1[1] = bf_hi(e0.x); x1[2] = bf_lo(e0.y); x1[3] = bf_hi(e0.y); x1[4] = bf_lo(e0.z); x1[5] = bf_hi(e0.z); x1[6] = bf_lo(e0.w); x1[7] = bf_hi(e0.w);
            x2[0] = bf_lo(e1.x); x2[1] = bf_hi(e1.x); x2[2] = bf_lo(e1.y); x2[3] = bf_hi(e1.y); x2[4] = bf_lo(e1.z); x2[5] = bf_hi(e1.z); x2[6] = bf_lo(e1.w); x2[7] = bf_hi(e1.w);
            if (lat) { const int pos = a ? (t & 63) : (t >> 6);
#pragma unroll
                for (int i = 0; i < 8; ++i) { const float2 cs = RT[pos * 8 + i]; const float o1 = x1[i] * cs.x - x2[i] * cs.y, o2 = x1[i] * cs.y + x2[i] * cs.x; x1[i] = o1; x2[i] = o2; } }
            u32x4 w0, w1; w0.x = cvt_pk_bf16(x1[0], x1[1]); w0.y = cvt_pk_bf16(x1[2], x1[3]); w0.z = cvt_pk_bf16(x1[4], x1[5]); w0.w = cvt_pk_bf16(x1[6], x1[7]);
            w1.x = cvt_pk_bf16(x2[0], x2[1]); w1.y = cvt_pk_bf16(x2[2], x2[3]); w1.z = cvt_pk_bf16(x2[4], x2[5]); w1.w = cvt_pk_bf16(x2[6], x2[7]);
            if (iskr) {
#pragma unroll
                for (int hh = 0; hh < 4; ++hh) { bf16_t* kp = MK + (size_t)row * 384 + hh * 96 + 64 + a * 16; *(u32x4*)kp = w0; *(u32x4*)(kp + 8) = w1; }
            } else if (lat) { *(u32x4*)ep = w0; *(u32x4*)(ep + 8) = w1; }
        }
    }
}

#define MFMA32(a, b, c) __builtin_amdgcn_mfma_f32_32x32x16_bf16((a), (b), (c), 0, 0, 0)
typedef float f32x2 __attribute__((ext_vector_type(2)));
template <int MODE>
__device__ __forceinline__ void attn_item(PK p, int l, LAS unsigned char* lds, int b, int h, int qb, bool ctxq, float lam, float lam_init) {
    constexpr int NCOMP = (MODE == 1) ? 2 : 1, NKS = (MODE == 0) ? 4 : ((MODE == 1) ? 2 : 6), KW = NCOMP * NKS * 16, KCH = KW / 8, KSTR = KW * 2 + 16, VSTR = 192;
    constexpr int KBUF = 64 * KSTR, VBUF = 64 * VSTR, BUFSZ = KBUF + VBUF, BIAS_OFF = 3 * BUFSZ;
    constexpr bool STAG = (MODE != 0);
    const int tid = opaque_tid(), w = tid >> 6, lane = tid & 63, g = lane >> 5, l32 = lane & 31;
    unsigned char* ws = p->ws;
    const bf16_t* PJ = (const bf16_t*)(ws + OFF_B);
    const bf16_t *Qp, *Kp, *Vp; int ldq, ldk, ldv, outoff; float scale;
    if (MODE == 0) { Qp = PJ + C_NQ + 64 * h; Kp = PJ + C_NK + 64 * h; Vp = PJ + C_NV + 64 * h; ldq = ldk = ldv = PJW; outoff = 256 + 64 * h; scale = 0.125f; }
    else if (MODE == 1) { Qp = PJ + C_DQ + 64 * h; Kp = PJ + C_DK + 64 * h; Vp = PJ + C_DV + 64 * h; ldq = ldk = ldv = PJW; outoff = 512 + 64 * h; scale = 0.17677669529663687f; }
    else { Qp = (const bf16_t*)(ws + OFF_D) + 96 * h; Kp = (const bf16_t*)(ws + OFF_MK) + 96 * h; Vp = (const bf16_t*)(ws + OFF_MV) + 64 * h; ldq = ldk = 384; ldv = 256; outoff = 768 + 64 * h; scale = 0.10206207261596575f; }
    const float cs = scale * LOG2E;
    int qrow0, loc0, nloc;
    if (ctxq) { qrow0 = RL + b * 256; loc0 = 0; nloc = 0; }
    else { qrow0 = b * 8192 + qb * 256;
        if (MODE == 0) { const int r0 = qb * 4; loc0 = clampi(r0 - 4, 0, 120); nloc = clampi(r0 - 1, 0, 120) + 8 - loc0; } else { loc0 = 0; nloc = 128; } }
    const int nt = nloc + 4;
    const bool nabias = (MODE == 0) && !ctxq;
    const bool late = STAG && (w >= 4);
    const int rw = qb * 4 + (w >> 1), sw = clampi(rw - 4, 0, 120);
    const int jq = 32 * (w & 1) + l32, cst = clampi(jq - 8, 0, 48);
    if (nabias && tid < 465) ((LAS float*)(lds + BIAS_OFF))[tid] = p->na_rpb[(size_t)(l * 4 + h) * 465 + tid] * LOG2E;

    const size_t qrow = (size_t)qrow0 + 32 * w + l32;
    bf16x8 qf[NCOMP * NKS];
#pragma unroll
    for (int i = 0; i < NCOMP * NKS; ++i) {
        const u32x4 raw = *(const u32x4*)(Qp + qrow * ldq + 16 * i + 8 * g);
        u32x4 sc4; sc4.x = cvt_pk_bf16(bf_lo(raw.x) * cs, bf_hi(raw.x) * cs); sc4.y = cvt_pk_bf16(bf_lo(raw.y) * cs, bf_hi(raw.y) * cs);
        sc4.z = cvt_pk_bf16(bf_lo(raw.z) * cs, bf_hi(raw.z) * cs); sc4.w = cvt_pk_bf16(bf_lo(raw.w) * cs, bf_hi(raw.w) * cs);
        qf[i] = __builtin_bit_cast(bf16x8, sc4);
    }

    const int kr0 = tid / KCH, kc0 = tid % KCH, kr1 = (tid + 512) / KCH, kc1 = (tid + 512) % KCH, vr = tid >> 3, vc = tid & 7;
    const bool hask1 = (KCH == 12) && (tid < 256);
    u32x4 rk0, rk1 = (u32x4){0u, 0u, 0u, 0u}, rv;
#define TILE_ROW(t) ((t) < nloc ? (b * 8192 + 64 * (loc0 + (t))) : (RL + b * 256 + 64 * ((t) - nloc)))
#define LOAD_TILE(t) do { const size_t _tb = (size_t)TILE_ROW(t); rk0 = *(const u32x4*)(Kp + (_tb + kr0) * ldk + kc0 * 8); \
        if (hask1) rk1 = *(const u32x4*)(Kp + (_tb + kr1) * ldk + kc1 * 8); rv = *(const u32x4*)(Vp + (_tb + vr) * ldv + vc * 8); } while (0)
#define STORE_TILE(buf) do { LAS unsigned char* _kb = lds + (buf) * BUFSZ; *(LAS u32x4*)(_kb + kr0 * KSTR + kc0 * 16) = rk0; \
        if (hask1) *(LAS u32x4*)(_kb + kr1 * KSTR + kc1 * 16) = rk1; *(LAS u32x4*)(_kb + KBUF + vr * VSTR + vc * 16) = rv; } while (0)

    float mrun[NCOMP], lsum[NCOMP]; f32x16 O[NCOMP][2];
#pragma unroll
    for (int c = 0; c < NCOMP; ++c) { mrun[c] = -1e30f; lsum[c] = 0.f;
#pragma unroll
        for (int dt = 0; dt < 2; ++dt)
#pragma unroll
            for (int r = 0; r < 16; ++r) O[c][dt][r] = 0.f; }
    bf16x8 P[NCOMP][2][2];
#pragma unroll
    for (int c = 0; c < NCOMP; ++c)
#pragma unroll
        for (int kt = 0; kt < 2; ++kt)
#pragma unroll
            for (int s2 = 0; s2 < 2; ++s2) P[c][kt][s2] = (bf16x8){0, 0, 0, 0, 0, 0, 0, 0};

    LOAD_TILE(0); STORE_TILE(0); __syncthreads();
    const int koff = l32 * KSTR + g * 16;
    const int i16 = lane & 15, tq = i16 >> 2, tp = i16 & 3, blk = (lane >> 4) & 1;
    const int voff = (4 * g + tq) * VSTR + (16 * blk + 4 * tp) * 2;
#define PV_TILE(buf) do { LAS unsigned char* _vb = lds + (buf) * BUFSZ + KBUF + voff; \
        _Pragma("unroll") for (int kt = 0; kt < 2; ++kt) { bf16x8 vf[2][2]; \
            _Pragma("unroll") for (int s2 = 0; s2 < 2; ++s2) _Pragma("unroll") for (int dt = 0; dt < 2; ++dt) { LAS unsigned char* vp = _vb + (32 * kt + 16 * s2) * VSTR + dt * 64; \
                const s16x4 lo = __builtin_amdgcn_ds_read_tr16_b64_v4i16((LAS s16x4*)vp); const s16x4 hi = __builtin_amdgcn_ds_read_tr16_b64_v4i16((LAS s16x4*)(vp + 8 * VSTR)); \
                vf[s2][dt] = __builtin_shufflevector(lo, hi, 0, 1, 2, 3, 4, 5, 6, 7); } \
            _Pragma("unroll") for (int s2 = 0; s2 < 2; ++s2) _Pragma("unroll") for (int dt = 0; dt < 2; ++dt) _Pragma("unroll") for (int c = 0; c < NCOMP; ++c) O[c][dt] = MFMA32(vf[s2][dt], P[c][kt][s2], O[c][dt]); } } while (0)

    bool pend = false; int pbuf = 0, cbuf = 0;
    for (int t = 0; t < nt; ++t) {
        const bool more = (t + 1 < nt);
        if (more) LOAD_TILE(t + 1);
        bool active = true; int krow = 0;
        if (nabias && t < nloc) { krow = loc0 + t; active = (krow >= sw) && (krow < sw + 8); }
        if (active) {
            LAS unsigned char* Kb = lds + cbuf * BUFSZ + koff;
            f32x16 S[NCOMP][2];
#pragma unroll
            for (int c = 0; c < NCOMP; ++c)
#pragma unroll
                for (int kt = 0; kt < 2; ++kt) {
                    bf16x8 kf[NKS];
#pragma unroll
                    for (int ks = 0; ks < NKS; ++ks) kf[ks] = *(const LAS bf16x8*)(Kb + kt * 32 * KSTR + (c * NKS + ks) * 32);
#pragma unroll
                    for (int r = 0; r < 16; ++r) S[c][kt][r] = 0.f;
#pragma unroll
                    for (int ks = 0; ks < NKS; ++ks) S[c][kt] = MFMA32(kf[ks], qf[c * NKS + ks], S[c][kt]);
                }
            if (STAG && late && pend) PV_TILE(pbuf);
#pragma unroll
            for (int c = 0; c < NCOMP; ++c) {
                float mx = -1e30f;
                if (nabias && t < nloc) {
                    const LAS float* bt = (const LAS float*)(lds + BIAS_OFF) + (krow - rw + 7) * 31;
#pragma unroll
                    for (int kt = 0; kt < 2; ++kt)
#pragma unroll
                        for (int r = 0; r < 16; ++r) { const int jk = 32 * kt + (r & 3) + 8 * (r >> 2) + 4 * g; const bool ok = (jk >= cst) && (jk < cst + 16);
                            const float bv = bt[clampi(jk - jq + 15, 0, 30)]; const float xv = ok ? (S[c][kt][r] + bv) : -1e30f; S[c][kt][r] = xv; mx = fmaxf(mx, xv); }
                } else {
#pragma unroll
                    for (int kt = 0; kt < 2; ++kt)
#pragma unroll
                        for (int r = 0; r < 16; r += 2) mx = fmaxf(fmaxf(mx, S[c][kt][r]), S[c][kt][r + 1]);
                }
                mx = fmaxf(mx, shflx(mx, 32));
                const float mnew = fmaxf(mrun[c], mx);
                if (__any(mnew > mrun[c])) {
                    const float alpha = fast_exp2(mrun[c] - mnew); lsum[c] *= alpha;
#pragma unroll
                    for (int dt = 0; dt < 2; ++dt) O[c][dt] *= alpha;
                    mrun[c] = mnew;
                }
                f32x2 rs2 = (f32x2){0.f, 0.f}; const f32x2 m2 = (f32x2){mnew, mnew};
#pragma unroll
                for (int kt = 0; kt < 2; ++kt)
#pragma unroll
                    for (int r = 0; r < 16; r += 2) { const f32x2 d = (f32x2){S[c][kt][r], S[c][kt][r + 1]} - m2; S[c][kt][r] = d.x; S[c][kt][r + 1] = d.y; }
#pragma unroll
                for (int kt = 0; kt < 2; ++kt)
#pragma unroll
                    for (int r = 0; r < 16; ++r) S[c][kt][r] = fast_exp2(S[c][kt][r]);
#pragma unroll
                for (int kt = 0; kt < 2; ++kt)
#pragma unroll
                    for (int s2 = 0; s2 < 2; ++s2) { u32x4 pk;
#pragma unroll
                        for (int e = 0; e < 4; ++e) { const f32x2 ev = (f32x2){S[c][kt][8 * s2 + 2 * e], S[c][kt][8 * s2 + 2 * e + 1]}; rs2 += ev; pk[e] = cvt_pk_bf16(ev.x, ev.y); }
                        P[c][kt][s2] = __builtin_bit_cast(bf16x8, pk); }
                lsum[c] += rs2.x + rs2.y;
            }
            if (!(STAG && late)) PV_TILE(cbuf); else { pend = true; pbuf = cbuf; }
        }
        const int nbuf = (cbuf == 2) ? 0 : cbuf + 1;
        if (more) STORE_TILE(nbuf);
        __syncthreads();
        cbuf = nbuf;
    }
    if (STAG && late && pend) PV_TILE(pbuf);
#undef PV_TILE
#undef TILE_ROW
#undef LOAD_TILE
#undef STORE_TILE
    float inv[NCOMP];
#pragma unroll
    for (int c = 0; c < NCOMP; ++c) { const float lt = lsum[c] + shflx(lsum[c], 32); inv[c] = 1.0f / lt; }
    bf16_t* op = (bf16_t*)(ws + OFF_A) + qrow * 1024 + outoff;
    if (MODE == 1) {
        const float li1 = lam * inv[NCOMP - 1]; float ss = 0.f;
#pragma unroll
        for (int dt = 0; dt < 2; ++dt)
#pragma unroll
            for (int r = 0; r < 16; ++r) { const float o = O[0][dt][r] * inv[0] - li1 * O[NCOMP - 1][dt][r]; O[0][dt][r] = o; ss += o * o; }
        ss += shflx(ss, 32);
        const float rstd = rsqrtf(ss * (1.0f / 64.0f) + NEPS) * (1.0f - lam_init);
        const float* sg = p->diff_subln_g + l * 64;
#pragma unroll
        for (int dt = 0; dt < 2; ++dt)
#pragma unroll
            for (int rq = 0; rq < 4; ++rq) { const int dv = 32 * dt + 8 * rq + 4 * g; const f32x4 gg = *(const f32x4*)(sg + dv);
                u32x2 wv; wv.x = cvt_pk_bf16(O[0][dt][4 * rq] * rstd * gg[0], O[0][dt][4 * rq + 1] * rstd * gg[1]); wv.y = cvt_pk_bf16(O[0][dt][4 * rq + 2] * rstd * gg[2], O[0][dt][4 * rq + 3] * rstd * gg[3]);
                *(u32x2*)(op + dv) = wv; }
    } else {
#pragma unroll
        for (int dt = 0; dt < 2; ++dt)
#pragma unroll
            for (int rq = 0; rq < 4; ++rq) { const int dv = 32 * dt + 8 * rq + 4 * g;
                u32x2 wv; wv.x = cvt_pk_bf16(O[0][dt][4 * rq] * inv[0], O[0][dt][4 * rq + 1] * inv[0]); wv.y = cvt_pk_bf16(O[0][dt][4 * rq + 2] * inv[0], O[0][dt][4 * rq + 3] * inv[0]);
                *(u32x2*)(op + dv) = wv; }
    }
    __syncthreads();
}

__device__ void attn_phase(PK p, int l, LAS unsigned char* lds) {
    const float lam_init = (l == 0) ? 0.2f : 0.35550906759502f;
    const float* dl = p->diff_lambda + l * 128;
    float d01 = 0.f, d23 = 0.f;
    for (int i = 0; i < 32; ++i) { d01 += dl[i] * dl[32 + i]; d23 += dl[64 + i] * dl[96 + i]; }
    const float lam = expf(d01) - expf(d23) + lam_init;
    const int nItems = 1536 + (l == 0 ? 48 : 0);
    for (int it = opaque_bid(); it < nItems; it += opaque_gdim()) {
        if (it < 1536) {
            const int ty = it >> 9, idx = it & 511, b = idx >> 7, h = (idx >> 5) & 3, qb = idx & 31;
            if (ty == 0) attn_item<1>(p, l, lds, b, h, qb, false, lam, lam_init);
            else if (ty == 1) attn_item<2>(p, l, lds, b, h, qb, false, lam, lam_init);
            else attn_item<0>(p, l, lds, b, h, qb, false, lam, lam_init);
        } else {
            const int idx = it - 1536, ty = idx >> 4, b = (idx >> 2) & 3, h = idx & 3;
            if (ty == 0) attn_item<1>(p, l, lds, b, h, 0, true, lam, lam_init);
            else if (ty == 1) attn_item<2>(p, l, lds, b, h, 0, true, lam, lam_init);
            else attn_item<0>(p, l, lds, b, h, 0, true, lam, lam_init);
        }
    }
}

constexpr int PH_PER_LAYER = 14, N_PHASES = 2 * PH_PER_LAYER + 1;

__device__ __forceinline__ void run_phase(PK p, int ph, LAS unsigned char* lds, float rcoef) {
    unsigned char* ws = p->ws;
    pg8::StaticOrder S;
    if (ph == N_PHASES - 1) { final_norm_phase(p->out, p->final_norm_g); return; }
    int l = ph / PH_PER_LAYER; const int q = ph % PH_PER_LAYER;
#define OPQL asm volatile("" : "+s"(l))
#define HC ((float*)(ws + OFF_HC))
#define MOD ((const float*)(ws + OFF_MOD) + (size_t)l * 5 * 9216)
#define TN ((bf16_t*)(ws + OFF_A))
#define HID ((bf16_t*)(ws + OFF_B))
#define Mlate ((l == 0) ? RA : RL)
    switch (q) {
    case 0: OPQL; layer_prep_phase(p, l, lds); break;
    case 1: OPQL; if (l == 0) norm_mod_phase(p->x, p->ctx, p->out, HC, p->norm_g + (l * 3 + 0) * 1024, MOD, TN, RA, nullptr, 0);
            else norm_mod_phase(p->out, HC, nullptr, nullptr, p->norm_g + (l * 3 + 0) * 1024, MOD, TN, RA, (const float*)(ws + OFF_PB), 11); break;
    case 2: case 12: { OPQL; const int f = (q == 2) ? 0 : 1; const int M = (q == 2) ? RA : Mlate;
        pg8::Gemm g{TN, (const bf16_t*)(ws + OFF_W1) + (size_t)f * 5632 * 1024, M, 5632, 1024, 1024, 1024}; S.init(M, 5632, opaque_gdim(), opaque_bid());
        EpiSwiglu E{HID}; pg8::gemm_phase(lds, g, S, E); } break;
    case 4: OPQL; norm_mod_phase(p->out, HC, nullptr, nullptr, p->norm_g + (l * 3 + 1) * 1024, MOD + 3 * 1024, TN, RA, (const float*)(ws + OFF_PB), 11); break;
    case 5: { OPQL; pg8::Gemm g{TN, (const bf16_t*)(ws + OFF_WM), RA, 6400, 1024, 1024, 1024}; S.init(RA, 6400, opaque_gdim(), opaque_bid());
        EpiPJ E{(bf16_t*)(ws + OFF_B), ws + OFF_C}; pg8::gemm_phase(lds, g, S, E); } break;
    case 6: prep_phase(p); break;
    case 7: { OPQL; pg8::Gemm g{(const bf16_t*)(ws + OFF_B) + C_MQ, (const bf16_t*)(ws + OFF_WL), RA, 1024, 384, PJW, 384}; S.init(RA, 1024, opaque_gdim(), opaque_bid());
        EpiMLA E{(bf16_t*)(ws + OFF_D), (bf16_t*)(ws + OFF_MK), (bf16_t*)(ws + OFF_MV), (const float*)(ws + OFF_RSTD), (const float2*)(ws + OFF_ROPE)}; pg8::gemm_phase(lds, g, S, E); } break;
    case 8: OPQL; attn_phase(p, l, lds); break;
    case 9: { OPQL; pg8::Gemm g{(const bf16_t*)(ws + OFF_A), (const bf16_t*)(ws + OFF_WB), Mlate, 1024, 1024, 1024, 1024}; S.init(Mlate, 1024, opaque_gdim(), opaque_bid());
        EpiMerge E{ws + OFF_C, (bf16_t*)(ws + OFF_D)}; pg8::gemm_phase(lds, g, S, E); } break;
    case 3: case 13: case 10: { OPQL;
        const bool isout = (q == 10); const int f = (q == 13) ? 1 : 0;
        const bf16_t* A = isout ? (const bf16_t*)(ws + OFF_D) : (const bf16_t*)HID;
        const bf16_t* Bt = isout ? (const bf16_t*)(ws + OFF_WO) : (const bf16_t*)(ws + OFF_W2) + (size_t)f * 1024 * FH;
        const int K = isout ? 1024 : FH;
        const float* gate = MOD + (isout ? 5 : (q == 3 ? 2 : 8)) * 1024;
        const float coef = (isout ? 1.0f : 0.5f) * rcoef;
        const bool withctx = (q == 3) || (l == 0);
        { pg8::Gemm g{A, Bt, RL, 1024, K, K, K}; S.init(RL, 1024, opaque_gdim(), opaque_bid());
          EpiResid E{p->out, HC, gate, coef}; pg8::gemm_phase(lds, g, S, E); }
        if (withctx) {
            const int nsu = 16 * (K / 256);
            for (int su = opaque_bid(); su < nsu; su += opaque_gdim()) {
                const int ks = su >> 4, pmn = su & 15;
                pg8::SingleUnit SU; SU.pm = 128 + (pmn >> 2); SU.pn = pmn & 3; SU.has = true;
                pg8::Gemm g2{A + ks * 256, Bt + ks * 256, RA, 1024, 256, K, K};
                EpiPartial E2{(float*)(ws + OFF_PB) + (size_t)ks * 1024 * 1024, gate + 4 * 9216, coef}; pg8::gemm_phase(lds, g2, SU, E2);
            }
        }
    } break;
    case 11: OPQL; norm_mod_phase(p->out, HC, nullptr, nullptr, p->norm_g + (l * 3 + 2) * 1024, MOD + 6 * 1024, TN, Mlate, (const float*)(ws + OFF_PB), 4); break;
    }
#undef OPQL
#undef HC
#undef MOD
#undef TN
#undef HID
#undef Mlate
}

__global__ void __launch_bounds__(512, 2) fwd_megakernel(Params p) {
    extern __shared__ __attribute__((aligned(16))) unsigned char shm[];
    LAS unsigned char* lds = (LAS unsigned char*)shm;
#if N_LAUNCH_MODE == 1
    cg::grid_group grid = cg::this_grid();
    const int ph_lo = p.ph_lo, ph_hi = p.ph_hi;
    volatile LAS unsigned* st = (volatile LAS unsigned*)(lds + pg8::STAGE_BYTES);
    unsigned* bar = (unsigned*)(p.ws + OFF_BAR);
    if (opaque_tid() < 4) st[opaque_tid()] = 0u;
    if (opaque_bid() == 0) for (int i = opaque_tid(); i < XCD_BAR_WORDS; i += 512) bar[i] = 0u;
    __syncthreads();
    for (int ph = ph_lo; ph < ph_hi; ++ph) {
        const int qq = ph % PH_PER_LAYER;
        const int nrep = (PROBE_MASK && ph < N_PHASES - 1 && qq != 6 && ((PROBE_MASK >> qq) & 1)) ? 2 : 1;
        for (int rep = 0; rep < nrep; ++rep) {
            PK pk = (PK)__builtin_amdgcn_kernarg_segment_ptr();
            asm volatile("" : "+s"(pk));
            run_phase(pk, ph, lds, (PROBE_MASK & 0x2408) ? (rep ? 0.0f : 1.0f) : 1.0f);
            if (ph == ph_lo && rep == 0) { grid.sync(); xcd_barrier_post(bar); }
            else if (ph + 1 < ph_hi || rep + 1 < nrep) xcd_barrier(bar, st);
        }
    }
#else
    const int ph_lo = p.ph_lo, ph_hi = p.ph_hi;
    for (int ph = ph_lo; ph < ph_hi; ++ph) { PK pk = (PK)__builtin_amdgcn_kernarg_segment_ptr(); asm volatile("" : "+s"(pk)); run_phase(pk, ph, lds, 1.0f); }
#endif
}

extern "C" void kernel_launch(void* const* d_in, const int* in_sizes, int n_in, void* d_out, int out_size, void* d_ws, size_t ws_size, hipStream_t stream) {
    constexpr int LDS_BYTES = pg8::STAGE_BYTES + 16;
    static int grid_blocks = 0;
    if (grid_blocks == 0) {
        if (n_in != 22 || ws_size < WS_END) { fprintf(stderr, "kernel_launch: unexpected inputs (n_in %d, ws %zu < %zu)\n", n_in, ws_size, (size_t)WS_END); grid_blocks = -1; return; }
        int dev = 0, cus = 0, per_cu = 0;
        hipGetDevice(&dev); hipDeviceGetAttribute(&cus, hipDeviceAttributeMultiprocessorCount, dev);
        if (hipFuncSetAttribute((const void*)fwd_megakernel, hipFuncAttributeMaxDynamicSharedMemorySize, LDS_BYTES) != hipSuccess) { fprintf(stderr, "hipFuncSetAttribute failed\n"); grid_blocks = -1; return; }
        if (hipOccupancyMaxActiveBlocksPerMultiprocessor(&per_cu, (const void*)fwd_megakernel, 512, LDS_BYTES) != hipSuccess || per_cu < 1) per_cu = 1;
        (void)hipGetLastError();
        grid_blocks = cus * 1;
    }
    if (grid_blocks < 0) return;
    Params hp{};
    const float** pp = (const float**)&hp;
    for (int i = 0; i < 22; ++i) pp[i] = (const float*)d_in[i];
    hp.out = (float*)d_out; hp.ws = (unsigned char*)d_ws;
#if N_LAUNCH_MODE == 1
    hp.ph_lo = 0; hp.ph_hi = N_PHASES;
    void* args[] = {&hp};
    hipError_t e = hipLaunchCooperativeKernel((const void*)fwd_megakernel, dim3(grid_blocks), dim3(512), args, LDS_BYTES, stream);
    if (e != hipSuccess) fprintf(stderr, "cooperative launch failed: %s (grid %d)\n", hipGetErrorString(e), grid_blocks);
#else
    for (int ph = 0; ph < N_PHASES; ++ph) { hp.ph_lo = ph; hp.ph_hi = ph + 1; hipLaunchKernelGGL(fwd_megakernel, dim3(grid_blocks), dim3(512), LDS_BYTES, stream, hp); }
#endif
}
```

```cpp
#include <hip/hip_runtime.h>
#include <hip/hip_cooperative_groups.h>
#include <cstdio>
namespace cg = cooperative_groups;

#define LAS __attribute__((address_space(3)))
typedef unsigned short bf16_t;
typedef short bf16x8 __attribute__((ext_vector_type(8)));
typedef short s16x4 __attribute__((ext_vector_type(4)));
typedef float f32x4 __attribute__((ext_vector_type(4)));
typedef float f32x16 __attribute__((ext_vector_type(16)));
typedef unsigned u32x4 __attribute__((ext_vector_type(4)));
typedef unsigned u32x2 __attribute__((ext_vector_type(2)));

#ifndef PROBE_MASK
#define PROBE_MASK 0
#endif
#ifndef N_LAUNCH_MODE
#define N_LAUNCH_MODE 1
#endif

constexpr int RL = 32768, RA = 33792, FH = 2816;
constexpr int PJW = 2304;
constexpr int C_NQ = 256, C_NK = 512, C_NV = 768, C_DQ = 1024, C_DK = 1280, C_DV = 1536, C_MQ = 1792, C_MKV = 2048, C_MKR = 2176;
constexpr float LOG2E = 1.4426950408889634f;
constexpr float NEPS = 1e-6f;
constexpr int XCD_BAR_WORDS_C = 3456;

constexpr size_t SZ_W1 = 2ull * 5632 * 1024 * 2, SZ_W2 = 2ull * 1024 * 2816 * 2, SZ_WM = 6400ull * 1024 * 2, SZ_WL = 1024ull * 384 * 2, SZ_WB = 4ull * 1024 * 256 * 2, SZ_WO = 1024ull * 1024 * 2;
constexpr size_t OFF_W1 = 0, OFF_W2 = OFF_W1 + SZ_W1, OFF_WM = OFF_W2 + SZ_W2, OFF_WL = OFF_WM + SZ_WM, OFF_WB = OFF_WL + SZ_WL, OFF_WO = OFF_WB + SZ_WB;
constexpr size_t OFF_HC = OFF_WO + SZ_WO;
constexpr size_t OFF_MOD = OFF_HC + 1024ull * 1024 * 4;
constexpr size_t OFF_ROPE = OFF_MOD + 2ull * 5 * 9216 * 4;
constexpr size_t OFF_RSTD = OFF_ROPE + 128 * 8 * 8;
constexpr size_t OFF_A = OFF_RSTD + (size_t)RA * 2 * 4;
constexpr size_t OFF_B = OFF_A + (size_t)RA * 1024 * 2;
constexpr size_t OFF_C = OFF_B + (size_t)RA * PJW * 2;
constexpr size_t OFF_D = OFF_C + (size_t)RA * 4096;
constexpr size_t OFF_MK = OFF_D + (size_t)RA * 384 * 2, OFF_MV = OFF_MK + (size_t)RA * 384 * 2;
constexpr size_t OFF_BAR = OFF_D + (size_t)RA * 1024 * 2;
constexpr size_t OFF_PB = OFF_BAR + 16384;
constexpr size_t WS_END = OFF_PB + 11ull * 1024 * 1024 * 4;

struct Params {
    const float *x, *c, *ctx, *c_ctx, *ada_w, *ada_b, *norm_g, *ffn_w_in, *ffn_w_out, *mix_w_in, *pool_w, *pool_scale, *na_rpb, *diff_lambda, *diff_subln_g,
        *mla_q_norm_g, *mla_kv_norm_g, *mla_w_qb, *mla_w_kvb, *branch_w_out, *mix_w_out, *final_norm_g;
    float* out; unsigned char* ws;
    int ph_lo, ph_hi;
};

typedef const __attribute__((address_space(4))) Params* PK;

typedef float f32x2_ __attribute__((ext_vector_type(2)));
typedef __bf16 bf16x2_ __attribute__((ext_vector_type(2)));
__device__ __forceinline__ unsigned cvt_pk_bf16(float lo, float hi) { const f32x2_ v = {lo, hi}; return __builtin_bit_cast(unsigned, __builtin_convertvector(v, bf16x2_)); }
__device__ __forceinline__ float bf_lo(unsigned u) { return __uint_as_float(u << 16); }
__device__ __forceinline__ float bf_hi(unsigned u) { return __uint_as_float(u & 0xffff0000u); }
__device__ __forceinline__ float fast_exp2(float x) { return __builtin_amdgcn_exp2f(x); }
__device__ __forceinline__ float fast_rcp(float x) { return __builtin_amdgcn_rcpf(x); }
__device__ __forceinline__ float sigmoidf_(float x) { return fast_rcp(1.0f + fast_exp2(-x * LOG2E)); }
__device__ __forceinline__ float shflx(float v, int m) {
    int lane = __builtin_amdgcn_mbcnt_hi(~0u, __builtin_amdgcn_mbcnt_lo(~0u, 0)); asm volatile("" : "+v"(lane));
    return __int_as_float(__builtin_amdgcn_ds_bpermute((lane ^ m) << 2, __float_as_int(v)));
}
__device__ __forceinline__ float wave_sum(float v) {
    v += shflx(v, 32); v += shflx(v, 16); v += shflx(v, 8); v += shflx(v, 4); v += shflx(v, 2); v += shflx(v, 1); return v;
}
__device__ __forceinline__ int opaque_tid() { int t = threadIdx.x; asm volatile("" : "+v"(t)); return t; }
__device__ __forceinline__ int opaque_bid() { int t = blockIdx.x; asm volatile("" : "+s"(t)); return t; }
__device__ __forceinline__ int opaque_gdim() { int t = gridDim.x; asm volatile("" : "+s"(t)); return t; }
__device__ __forceinline__ int clampi(int v, int lo, int hi) { return v < lo ? lo : (v > hi ? hi : v); }

#define XB_TMO      128
#define XB_XCNT(j)  (256  + 64 * (j))
#define XB_XSUB(j)  (1280 + 64 * (j))
#define XB_XGEN(j)  (2304 + 64 * (j))
#define XB_TOP      3328
#define XB_TOPGEN   3392
#define XCD_BAR_WORDS 3456
#define XB_SPIN_CAP (1u << 20)
__device__ __forceinline__ unsigned xb_ld(unsigned* p)              { return __hip_atomic_load(p, __ATOMIC_RELAXED, __HIP_MEMORY_SCOPE_AGENT); }
__device__ __forceinline__ unsigned xb_add(unsigned* p, unsigned v) { return __hip_atomic_fetch_add(p, v, __ATOMIC_RELAXED, __HIP_MEMORY_SCOPE_AGENT); }
__device__ __forceinline__ unsigned xb_xcc_id() { return (unsigned)__builtin_amdgcn_s_getreg((3 << 11) | 20) & 0xFu; }
#define XB_SPIN(cond, bar) do { unsigned _sp = 0; while (cond) { __builtin_amdgcn_s_sleep(1); \
    if ((++_sp & 255u) == 0u) { if (xb_ld(&(bar)[XB_TMO])) break; if (_sp > XB_SPIN_CAP) { atomicAdd(&(bar)[XB_TMO], 1u); break; } } } } while (0)
__device__ __forceinline__ void xcd_barrier_post(unsigned* bar) { if (opaque_tid() == 0) (void)xb_add(&bar[XB_XCNT(xb_xcc_id())], 1u); }
__device__ __forceinline__ void xcd_barrier_complete(unsigned* bar, unsigned x, unsigned& nloc, unsigned& nx) {
    const unsigned G = gridDim.x;
    unsigned sum, cnt, mine, sp = 0u;
    for (;;) {
        sum = 0u; cnt = 0u; mine = 0u;
#pragma unroll
        for (unsigned j = 0; j < 16; ++j) { const unsigned c = xb_ld(&bar[XB_XCNT(j)]); sum += c; cnt += (c > 0u) ? 1u : 0u; mine = (j == x) ? c : mine; }
        if (sum == G) break;
        __builtin_amdgcn_s_sleep(1);
        if ((++sp & 255u) == 0u) { if (xb_ld(&bar[XB_TMO])) break; if (sp > XB_SPIN_CAP) { atomicAdd(&bar[XB_TMO], 1u); break; } }
    }
    nloc = mine > 0u ? mine : 1u; nx = cnt > 0u ? cnt : 1u;
}
__device__ __forceinline__ void xcd_barrier(unsigned* bar, volatile LAS unsigned* st) {
    asm volatile("s_waitcnt vmcnt(0)" ::: "memory");
    __syncthreads();
    if (opaque_tid() == 0) {
        const unsigned x = xb_xcc_id();
        __builtin_amdgcn_s_waitcnt(0);
        unsigned nloc = st[0], nx = st[1];
        if (nloc == 0u) { xcd_barrier_complete(bar, x, nloc, nx); st[0] = nloc; st[1] = nx; }
        const unsigned old = xb_add(&bar[XB_XSUB(x)], 1u);
        const unsigned gen = old / nloc;
        if (old + 1u == (gen + 1u) * nloc) {
            __builtin_amdgcn_fence(__ATOMIC_RELEASE, "agent");
            asm volatile("s_waitcnt vmcnt(0)" ::: "memory");
            const unsigned og = xb_add(&bar[XB_TOP], 1u);
            const unsigned tg = og / nx;
            if (og + 1u == (tg + 1u) * nx) xb_add(&bar[XB_TOPGEN], 1u);
            else XB_SPIN(xb_ld(&bar[XB_TOPGEN]) == tg, bar);
            __builtin_amdgcn_fence(__ATOMIC_ACQUIRE, "agent");
            xb_add(&bar[XB_XGEN(x)], 1u);
            asm volatile("s_waitcnt vmcnt(0)" ::: "memory");
        } else {
            XB_SPIN(xb_ld(&bar[XB_XGEN(x)]) == gen, bar);
            __builtin_amdgcn_fence(__ATOMIC_ACQUIRE, "agent");
            asm volatile("s_waitcnt vmcnt(0)" ::: "memory");
        }
    }
    __syncthreads();
}

namespace pg8 {
constexpr int BM = 256, BK = 64, HALF = 128, HTB = HALF * BK * 2, STAGE_BYTES = 8 * HTB, NXCD = 8, WGM = 8;
__device__ __forceinline__ int lds_byte(int r, int c) { const int st = (r >> 4) * 2 + (c >> 5), rr = r & 15, cc = c & 31, ob = rr * 64 + cc * 2; return st * 1024 + (ob ^ (((ob >> 9) & 1) << 5)); }
__device__ __forceinline__ void stage_rc(int b, int& R, int& C) { const int st = b / 1024, sb = b % 1024, swz = sb ^ (((sb >> 9) & 1) << 5); R = (st >> 1) * 16 + swz / 64; C = (st & 1) * 32 + (swz % 64) / 2; }
__device__ __forceinline__ int perm32(int rho) { const int n = rho >> 4, i = rho & 15; return 8 * (i >> 2) + 4 * n + (i & 3); }
struct Unit { int pm, pn; };
struct Gemm { const bf16_t* A; const bf16_t* Bt; int M, N, K, lda, ldb; };
struct StaticOrder {
    int nM, nN, nwg, G, c;
    __device__ void init(int M, int N, int G_, int c_) { nM = M / BM; nN = N / BM; nwg = nM * nN; G = G_; c = c_; }
    __device__ bool next(int i, Unit& u) const {
        const long L = (long)i * G + c; if (L >= nwg) return false;
        int wgid = (int)L; { const int q = nwg / NXCD, r = nwg % NXCD, xcd = wgid % NXCD, off = wgid / NXCD; wgid = (xcd < r ? xcd * (q + 1) : r * (q + 1) + (xcd - r) * q) + off; }
        const int nig = WGM * nN, gid = wgid / nig, fm = gid * WGM, gsz = (nM - fm) < WGM ? (nM - fm) : WGM;
        u.pm = fm + ((wgid % nig) % gsz); u.pn = (wgid % nig) / gsz; return true;
    }
};

struct SingleUnit {
    int pm, pn; bool has;
    __device__ bool next(int i, Unit& u) const { if (i > 0 || !has) return false; u.pm = pm; u.pn = pn; return true; }
};
template <class Epi, class Sched>
__device__ __forceinline__ void gemm_phase(LAS unsigned char* lds, const Gemm g, const Sched& S, const Epi& E) {
    const int tid = opaque_tid(), wid = __builtin_amdgcn_readfirstlane(tid >> 6), lane = tid & 63, wr = wid >> 2, wc = wid & 3, fr = lane & 15, fq = lane >> 4;
    const int K = g.K, nt = K / BK;
    unsigned voffA[2], voffB[2];
#pragma unroll
    for (int i = 0; i < 2; ++i) { int R, C; stage_rc(tid * 16 + i * 8192, R, C); const int Rb = Epi::PERM ? ((R & ~31) + perm32(R & 31)) : R;
        voffA[i] = (unsigned)(R * g.lda + C) * 2u; voffB[i] = (unsigned)(Rb * g.ldb + C) * 2u; }
    const size_t kstep = (size_t)(BK * 2);
    const size_t hstepA = (size_t)HALF * g.lda * 2, hstepB = (size_t)HALF * g.ldb * 2;
    const size_t tstepA = 2 * hstepA, tstepB = 2 * hstepB;
    const unsigned ldsw = (unsigned)wid * 1024u;
    const int aoff = lds_byte(wr * 64 + fr, fq * 8), boff = lds_byte(wc * 32 + fr, fq * 8);
#define PG8_SA(b, h) (((b) * 2 + (h)) * HTB)
#define PG8_SB(b, h) ((4 + (b) * 2 + (h)) * HTB)
#define PG8_STAGE(bufoff, gbase, voff) do { _Pragma("unroll") for (int _i = 0; _i < 2; ++_i) \
        __builtin_amdgcn_global_load_lds((const unsigned*)((const char*)(gbase) + (voff)[_i]), (LAS unsigned*)(lds + (bufoff) + ldsw + _i * 8192), 16, 0, 0); } while (0)
#define PG8_LDA(dst, b, h) do { _Pragma("unroll") for (int m = 0; m < 4; ++m) _Pragma("unroll") for (int k = 0; k < 2; ++k) dst[m][k] = *(const LAS bf16x8*)(lds + PG8_SA(b, h) + aoff + m * 2048 + k * 1024); } while (0)
#define PG8_LDB(dst, b, h) do { _Pragma("unroll") for (int n = 0; n < 2; ++n) _Pragma("unroll") for (int k = 0; k < 2; ++k) dst[n][k] = *(const LAS bf16x8*)(lds + PG8_SB(b, h) + boff + n * 2048 + k * 1024); } while (0)
#define PG8_MMA(ai, bj, At, Bt) do { __builtin_amdgcn_s_setprio(1); _Pragma("unroll") for (int m = 0; m < 4; ++m) _Pragma("unroll") for (int n = 0; n < 2; ++n) _Pragma("unroll") for (int k = 0; k < 2; ++k) \
        acc[ai][bj][m][n] = __builtin_amdgcn_mfma_f32_16x16x32_bf16(Bt[n][k], At[m][k], acc[ai][bj][m][n], 0, 0, 0); __builtin_amdgcn_s_setprio(0); } while (0)
#define PG8_WAIT_V(n) asm volatile("s_waitcnt vmcnt(" #n ")" ::: "memory")
#define PG8_WAIT_L(n) asm volatile("s_waitcnt lgkmcnt(" #n ")" ::: "memory")
#define PG8_BAR __builtin_amdgcn_s_barrier()
#define PG8_SCHED __builtin_amdgcn_sched_barrier(0)
    Unit cur, nxt; int ui = 0;
    if (!S.next(0, cur)) return;
    f32x4 acc[2][2][4][2];
#pragma unroll
    for (int a = 0; a < 2; ++a)
#pragma unroll
        for (int b = 0; b < 2; ++b)
#pragma unroll
            for (int m = 0; m < 4; ++m)
#pragma unroll
                for (int n = 0; n < 2; ++n) acc[a][b][m][n] = (f32x4){0.f, 0.f, 0.f, 0.f};
    bf16x8 At[4][2], B0[2][2], B1[2][2];
    const char* cA = (const char*)g.A + (size_t)cur.pm * tstepA; const char* cB = (const char*)g.Bt + (size_t)cur.pn * tstepB;
    PG8_STAGE(PG8_SB(0, 0), cB, voffB); PG8_STAGE(PG8_SA(0, 0), cA, voffA); PG8_STAGE(PG8_SB(0, 1), cB + hstepB, voffB); PG8_STAGE(PG8_SA(0, 1), cA + hstepA, voffA);
    if (wr == 1) PG8_BAR;
    PG8_WAIT_V(4); PG8_BAR;
    PG8_STAGE(PG8_SB(1, 0), cB + kstep, voffB); PG8_STAGE(PG8_SA(1, 0), cA + kstep, voffA); PG8_STAGE(PG8_SB(1, 1), cB + hstepB + kstep, voffB);
    PG8_WAIT_V(6); PG8_BAR;
    for (;;) {
        const bool has_next = S.next(ui + 1, nxt);
        const char* nA = has_next ? (const char*)g.A + (size_t)nxt.pm * tstepA : cA; const char* nB = has_next ? (const char*)g.Bt + (size_t)nxt.pn * tstepB : cB;
        for (int t = 0; t < nt; t += 2) {
            const bool last = (t == nt - 2);
            const char* a1 = cA + (size_t)(t + 1) * kstep;
            const char* a2 = last ? nA : cA + (size_t)(t + 2) * kstep; const char* b2 = last ? nB : cB + (size_t)(t + 2) * kstep;
            const char* a3 = a2 + kstep; const char* b3 = b2 + kstep;
            PG8_LDB(B0, 0, 0); PG8_SCHED; PG8_LDA(At, 0, 0); PG8_STAGE(PG8_SA(1, 1), a1 + hstepA, voffA);
            PG8_WAIT_L(8); PG8_BAR; PG8_WAIT_L(0); PG8_MMA(0, 0, At, B0); PG8_BAR; PG8_SCHED;
            PG8_LDB(B1, 0, 1); PG8_STAGE(PG8_SB(0, 0), b2, voffB);
            PG8_BAR; PG8_WAIT_L(0); PG8_MMA(0, 1, At, B1); PG8_BAR;
            PG8_LDA(At, 0, 1); PG8_STAGE(PG8_SA(0, 0), a2, voffA);
            PG8_BAR; PG8_WAIT_L(0); PG8_MMA(1, 0, At, B0); PG8_BAR; PG8_SCHED;
            PG8_STAGE(PG8_SB(0, 1), b2 + hstepB, voffB);
            PG8_WAIT_V(6); PG8_BAR; PG8_MMA(1, 1, At, B1); PG8_BAR;
            PG8_LDB(B0, 1, 0); PG8_SCHED; PG8_LDA(At, 1, 0); PG8_STAGE(PG8_SA(0, 1), a2 + hstepA, voffA);
            PG8_WAIT_L(8); PG8_BAR; PG8_WAIT_L(0); PG8_MMA(0, 0, At, B0); PG8_BAR; PG8_SCHED;
            PG8_LDB(B1, 1, 1); PG8_STAGE(PG8_SB(1, 0), b3, voffB);
            PG8_BAR; PG8_WAIT_L(0); PG8_MMA(0, 1, At, B1); PG8_BAR;
            PG8_LDA(At, 1, 1); PG8_STAGE(PG8_SA(1, 0), a3, voffA);
            PG8_BAR; PG8_WAIT_L(0); PG8_MMA(1, 0, At, B0); PG8_BAR; PG8_SCHED;
            PG8_STAGE(PG8_SB(1, 1), b3 + hstepB, voffB);
            PG8_WAIT_V(6); PG8_BAR; PG8_MMA(1, 1, At, B1); PG8_BAR;
            if constexpr (Epi::HOOK) { if ((((t + 2) & 3) == 0) && !last) E.hook(acc, cur, (t + 2) >> 2, wr, wc, fr, fq); }
        }
        E(acc, cur, wr, wc, fr, fq);
        if (!has_next) break;
#pragma unroll
        for (int a = 0; a < 2; ++a)
#pragma unroll
            for (int b = 0; b < 2; ++b)
#pragma unroll
                for (int m = 0; m < 4; ++m)
#pragma unroll
                    for (int n = 0; n < 2; ++n) acc[a][b][m][n] = (f32x4){0.f, 0.f, 0.f, 0.f};
        cur = nxt; cA = nA; cB = nB; ++ui;
    }
    PG8_WAIT_V(0);
    if (wr == 0) PG8_BAR;
    PG8_BAR;
#undef PG8_SA
#undef PG8_SB
#undef PG8_STAGE
#undef PG8_LDA
#undef PG8_LDB
#undef PG8_MMA
#undef PG8_WAIT_V
#undef PG8_WAIT_L
#undef PG8_BAR
#undef PG8_SCHED
}
}
using pg8::Unit;

__device__ __forceinline__ size_t g8_off(int row, int colg) { return ((size_t)(row >> 4) * 128 + (colg >> 5)) * 512 + (row & 15) * 32 + (colg & 31); }

struct EpiSwiglu {
    static constexpr bool HOOK = false;
    static constexpr bool PERM = true;
    bf16_t* HID;
    __device__ __forceinline__ void operator()(const f32x4 (&acc)[2][2][4][2], const Unit& u, int wr, int wc, int fr, int fq) const {
        const int row0 = u.pm * 256 + wr * 64 + fr, col0 = u.pn * 128 + wc * 32 + 8 * fq;
#pragma unroll
        for (int ai = 0; ai < 2; ++ai)
#pragma unroll
            for (int m = 0; m < 4; ++m) {
                const int row = row0 + ai * 128 + m * 16;
                float hv[8];
#pragma unroll
                for (int n = 0; n < 2; ++n)
#pragma unroll
                    for (int j = 0; j < 4; ++j) { const float a = acc[ai][0][m][n][j], b = acc[ai][1][m][n][j]; hv[4 * n + j] = a * sigmoidf_(a) * b; }
                u32x4 w; w.x = cvt_pk_bf16(hv[0], hv[1]); w.y = cvt_pk_bf16(hv[2], hv[3]); w.z = cvt_pk_bf16(hv[4], hv[5]); w.w = cvt_pk_bf16(hv[6], hv[7]);
                *(u32x4*)(HID + (size_t)row * FH + col0) = w;
            }
    }
};
struct EpiResid {
    static constexpr bool HOOK = false;
    static constexpr bool PERM = false;
    float* Hl; float* Hc; const float* gate; float coef;
    __device__ __forceinline__ void operator()(const f32x4 (&acc)[2][2][4][2], const Unit& u, int wr, int wc, int fr, int fq) const {
        const int row0 = u.pm * 256 + wr * 64 + fr, col0 = u.pn * 256 + wc * 32 + 4 * fq;
#pragma unroll
        for (int ai = 0; ai < 2; ++ai)
#pragma unroll
            for (int m = 0; m < 4; ++m) {
                const int row = row0 + ai * 128 + m * 16;
                float* hp = row < RL ? Hl + (size_t)row * 1024 : Hc + (size_t)(row - RL) * 1024;
                const float* gp = gate + (row < RL ? (row >> 13) : 4) * 9216;
#pragma unroll
                for (int bj = 0; bj < 2; ++bj)
#pragma unroll
                    for (int n = 0; n < 2; ++n) {
                        const int c = col0 + bj * 128 + n * 16;
                        const f32x4 g4 = *(const f32x4*)(gp + c); f32x4 h4 = *(const f32x4*)(hp + c);
                        h4 += (g4 * coef) * acc[ai][bj][m][n];
                        *(f32x4*)(hp + c) = h4;
                    }
            }
    }
};
struct EpiPartial {
    static constexpr bool HOOK = false;
    static constexpr bool PERM = false;
    float* PB; const float* gate; float coef;
    __device__ __forceinline__ void operator()(const f32x4 (&acc)[2][2][4][2], const Unit& u, int wr, int wc, int fr, int fq) const {
        const int row0 = u.pm * 256 + wr * 64 + fr - RL, col0 = u.pn * 256 + wc * 32 + 4 * fq;
#pragma unroll
        for (int ai = 0; ai < 2; ++ai)
#pragma unroll
            for (int m = 0; m < 4; ++m) {
                float* hp = PB + (size_t)(row0 + ai * 128 + m * 16) * 1024;
#pragma unroll
                for (int bj = 0; bj < 2; ++bj)
#pragma unroll
                    for (int n = 0; n < 2; ++n) {
                        const int c = col0 + bj * 128 + n * 16;
                        const f32x4 g4 = *(const f32x4*)(gate + c);
                        *(f32x4*)(hp + c) = (g4 * coef) * acc[ai][bj][m][n];
                    }
            }
    }
};
struct EpiPJ {
    static constexpr bool HOOK = false;
    static constexpr bool PERM = true;
    bf16_t* PJ; unsigned char* G8;
    __device__ __forceinline__ void operator()(const f32x4 (&acc)[2][2][4][2], const Unit& u, int wr, int wc, int fr, int fq) const {
        const int row0 = u.pm * 256 + wr * 64 + fr, c0 = wc * 32 + 8 * fq;
        if (u.pn < 9) {
#pragma unroll
            for (int ai = 0; ai < 2; ++ai)
#pragma unroll
                for (int m = 0; m < 4; ++m) {
                    const int row = row0 + ai * 128 + m * 16;
#pragma unroll
                    for (int bj = 0; bj < 2; ++bj) {
                        const f32x4 v0 = acc[ai][bj][m][0], v1 = acc[ai][bj][m][1];
                        u32x4 w; w.x = cvt_pk_bf16(v0[0], v0[1]); w.y = cvt_pk_bf16(v0[2], v0[3]); w.z = cvt_pk_bf16(v1[0], v1[1]); w.w = cvt_pk_bf16(v1[2], v1[3]);
                        *(u32x4*)(PJ + (size_t)row * PJW + u.pn * 256 + bj * 128 + c0) = w;
                    }
                }
        } else {
#pragma unroll
            for (int ai = 0; ai < 2; ++ai)
#pragma unroll
                for (int m = 0; m < 4; ++m) {
                    const int row = row0 + ai * 128 + m * 16;
#pragma unroll
                    for (int bj = 0; bj < 2; ++bj) {
                        unsigned q[8];
#pragma unroll
                        for (int n = 0; n < 2; ++n)
#pragma unroll
                            for (int j = 0; j < 4; ++j) { int v = (int)(sigmoidf_(acc[ai][bj][m][n][j]) * 256.0f); q[4 * n + j] = (unsigned)(v > 255 ? 255 : v); }
                        u32x2 w; w.x = q[0] | (q[1] << 8) | (q[2] << 16) | (q[3] << 24); w.y = q[4] | (q[5] << 8) | (q[6] << 16) | (q[7] << 24);
                        *(u32x2*)(G8 + g8_off(row, (u.pn - 9) * 256 + bj * 128 + c0)) = w;
                    }
                }
        }
    }
};
struct EpiMLA {
    static constexpr bool HOOK = false;
    static constexpr bool PERM = true;
    bf16_t *MQ, *MK, *MV; const float* RSTD; const float2* RT;
    __device__ __forceinline__ void operator()(const f32x4 (&acc)[2][2][4][2], const Unit& u, int wr, int wc, int fr, int fq) const {
        const int row0 = u.pm * 256 + wr * 64 + fr;
#pragma unroll
        for (int bj = 0; bj < 2; ++bj) {
            const int cg0 = u.pn * 256 + bj * 128 + wc * 32;
            if (cg0 >= 896) continue;
#pragma unroll
            for (int ai = 0; ai < 2; ++ai)
#pragma unroll
                for (int m = 0; m < 4; ++m) {
                    __builtin_amdgcn_sched_barrier(0);
                    const int row = row0 + ai * 128 + m * 16;
                    float v[8];
                    if (cg0 < 384) {
                        const float rs = RSTD[row * 2];
#pragma unroll
                        for (int n = 0; n < 2; ++n)
#pragma unroll
                            for (int j = 0; j < 4; ++j) v[4 * n + j] = acc[ai][bj][m][n][j] * rs;
                        const int d0 = cg0 % 96;
                        if (d0 == 64) {
                            const bool lat = row < RL; const int t = row & 8191; const int pos = (fq >> 1) ? (t & 63) : (t >> 6); const bool isx2 = fq & 1;
#pragma unroll
                            for (int e = 0; e < 8; ++e) {
                                const float pr = shflx(v[e], 16);
                                const float2 cs = RT[pos * 8 + e];
                                const float r = isx2 ? (pr * cs.y + v[e] * cs.x) : (v[e] * cs.x - pr * cs.y);
                                v[e] = lat ? r : v[e];
                            }
                        }
                        u32x4 w; w.x = cvt_pk_bf16(v[0], v[1]); w.y = cvt_pk_bf16(v[2], v[3]); w.z = cvt_pk_bf16(v[4], v[5]); w.w = cvt_pk_bf16(v[6], v[7]);
                        *(u32x4*)(MQ + (size_t)row * 384 + cg0 + 8 * fq) = w;
                    } else {
                        const float rs = RSTD[row * 2 + 1];
#pragma unroll
                        for (int n = 0; n < 2; ++n)
#pragma unroll
                            for (int j = 0; j < 4; ++j) v[4 * n + j] = acc[ai][bj][m][n][j] * rs;
                        const int cp = cg0 - 384, hd = cp >> 7, d0 = cp & 127;
                        u32x4 w; w.x = cvt_pk_bf16(v[0], v[1]); w.y = cvt_pk_bf16(v[2], v[3]); w.z = cvt_pk_bf16(v[4], v[5]); w.w = cvt_pk_bf16(v[6], v[7]);
                        if (d0 < 64) *(u32x4*)(MK + (size_t)row * 384 + hd * 96 + d0 + 8 * fq) = w;
                        else *(u32x4*)(MV + (size_t)row * 256 + hd * 64 + (d0 - 64) + 8 * fq) = w;
                    }
                }
        }
    }
};
struct EpiMerge {
    static constexpr bool PERM = true, HOOK = true;
    const unsigned char* G8; bf16_t* MG;
    __device__ __forceinline__ void hook(f32x4 (&acc)[2][2][4][2], const Unit& u, int nb, int wr, int wc, int fr, int fq) const {
        const int row0 = u.pm * 256 + wr * 64 + fr, c0 = u.pn * 256 + wc * 32 + 8 * fq;
#pragma unroll
        for (int ai = 0; ai < 2; ++ai) {
            u32x2 ga[4][2], gb[4][2];
#pragma unroll
            for (int m = 0; m < 4; ++m)
#pragma unroll
                for (int bj = 0; bj < 2; ++bj) { const int row = row0 + ai * 128 + m * 16, c = c0 + bj * 128;
                    ga[m][bj] = *(const u32x2*)(G8 + g8_off(row, (nb - 1) * 1024 + c)); gb[m][bj] = *(const u32x2*)(G8 + g8_off(row, nb * 1024 + c)); }
#pragma unroll
            for (int m = 0; m < 4; ++m)
#pragma unroll
                for (int bj = 0; bj < 2; ++bj)
#pragma unroll
                    for (int e = 0; e < 8; ++e) { const unsigned qa = ((e < 4 ? ga[m][bj].x : ga[m][bj].y) >> (8 * (e & 3))) & 255u, qb = ((e < 4 ? gb[m][bj].x : gb[m][bj].y) >> (8 * (e & 3))) & 255u;
                        acc[ai][bj][m][e >> 2][e & 3] *= ((float)qa + 0.5f) * fast_rcp((float)qb + 0.5f); }
            __builtin_amdgcn_sched_barrier(0);
        }
    }
    __device__ __forceinline__ void operator()(const f32x4 (&acc)[2][2][4][2], const Unit& u, int wr, int wc, int fr, int fq) const {
        const int row0 = u.pm * 256 + wr * 64 + fr, c0 = u.pn * 256 + wc * 32 + 8 * fq;
#pragma unroll
        for (int ai = 0; ai < 2; ++ai) {
            u32x2 gq[4][2];
#pragma unroll
            for (int m = 0; m < 4; ++m)
#pragma unroll
                for (int bj = 0; bj < 2; ++bj) gq[m][bj] = *(const u32x2*)(G8 + g8_off(row0 + ai * 128 + m * 16, 3 * 1024 + c0 + bj * 128));
#pragma unroll
            for (int m = 0; m < 4; ++m)
#pragma unroll
                for (int bj = 0; bj < 2; ++bj) {
                    const int row = row0 + ai * 128 + m * 16, c = c0 + bj * 128;
                    float v[8];
#pragma unroll
                    for (int e = 0; e < 8; ++e) { const unsigned q = ((e < 4 ? gq[m][bj].x : gq[m][bj].y) >> (8 * (e & 3))) & 255u; v[e] = ((float)q + 0.5f) * (1.0f / 256.0f) * acc[ai][bj][m][e >> 2][e & 3]; }
                    u32x4 w; w.x = cvt_pk_bf16(v[0], v[1]); w.y = cvt_pk_bf16(v[2], v[3]); w.z = cvt_pk_bf16(v[4], v[5]); w.w = cvt_pk_bf16(v[6], v[7]);
                    *(u32x4*)(MG + (size_t)row * 1024 + c) = w;
                }
            __builtin_amdgcn_sched_barrier(0);
        }
    }
};

template <class F>
__device__ __forceinline__ void wt_rows64(bf16_t* dst, int K, F srcval, int ldd, int kbeg, int kend) {
    if (ldd == 0) ldd = K;
    if (kend > K) kend = K;
    const int tid_ = opaque_tid(); const int nl = tid_ & 63, kq = tid_ >> 6;
    for (int k0 = kbeg + kq * 8; k0 < kend; k0 += 64) {
        float v[8];
#pragma unroll
        for (int j = 0; j < 8; ++j) v[j] = srcval(nl, k0 + j);
        u32x4 w; w.x = cvt_pk_bf16(v[0], v[1]); w.y = cvt_pk_bf16(v[2], v[3]); w.z = cvt_pk_bf16(v[4], v[5]); w.w = cvt_pk_bf16(v[6], v[7]);
        *(u32x4*)(dst + (size_t)nl * ldd + k0) = w;
    }
}

__device__ void layer_prep_phase(PK p, int l, LAS unsigned char* lds) {
    unsigned char* ws = p->ws;
    const int nW = 1648, nItems = nW + (l == 0 ? 288 + 1 : 0);
    for (int it2 = opaque_bid(); it2 < nItems; it2 += opaque_gdim()) {
        int it, kbeg = 0, kend = 1 << 30;
        if (it2 < 704) { it = it2 >> 2; kbeg = (it2 & 3) * 256; kend = kbeg + 256; }
        else if (it2 < 1056) { const int q = it2 - 704; it = 176 + q / 11; kbeg = (q % 11) * 256; kend = kbeg + 256; }
        else if (it2 < 1456) { const int q = it2 - 1056; it = 208 + (q >> 2); kbeg = (q & 3) * 256; kend = kbeg + 256; }
        else if (it2 < 1520) { const int q = it2 - 1456; it = 308 + (q >> 2); kbeg = (q & 3) * 256; kend = kbeg + 256; }
        else if (it2 < 1568) { it = 324 + (it2 - 1520); }
        else if (it2 < 1632) { const int q = it2 - 1568; it = 372 + (q >> 2); kbeg = (q & 3) * 64; kend = kbeg + 64; }
        else if (it2 < 1648) { it = 388 + (it2 - 1632); }
        else it = 404 + (it2 - 1648);
        if (it < 176) {
            const int f = it / 88, j = it % 88; const float* src = p->ffn_w_in + ((size_t)(l * 2 + f) * 1024) * 5632;
            bf16_t* dst = (bf16_t*)(ws + OFF_W1) + ((size_t)f * 5632 + j * 64) * 1024;
            wt_rows64(dst, 1024, [&](int nl, int k) { const int np = j * 64 + nl, pn = np >> 8, wi = np & 255; const int col = wi < 128 ? pn * 128 + wi : FH + pn * 128 + (wi - 128); return src[(size_t)k * 5632 + col]; }, 0, kbeg, kend);
        } else if (it < 208) {
            const int q = it - 176, f = q / 16, j = q % 16; const float* src = p->ffn_w_out + ((size_t)(l * 2 + f) * FH) * 1024;
            bf16_t* dst = (bf16_t*)(ws + OFF_W2) + ((size_t)f * 1024 + j * 64) * FH;
            wt_rows64(dst, FH, [&](int nl, int k) { return src[(size_t)k * 1024 + j * 64 + nl]; }, 0, kbeg, kend);
        } else if (it < 308) {
            const int j = it - 208; const float* src = p->mix_w_in + (size_t)l * 1024 * 6304;
            bf16_t* dst = (bf16_t*)(ws + OFF_WM) + (size_t)j * 64 * 1024;
            wt_rows64(dst, 1024, [&](int nl, int k) { const int np = j * 64 + nl; const int col = np < 2208 ? np : (np < 2304 ? -1 : np - 96); return col < 0 ? 0.f : src[(size_t)k * 6304 + col]; }, 0, kbeg, kend);
        } else if (it < 324) {
            const int j = it - 308; const float* src = p->mix_w_out + (size_t)l * 1024 * 1024;
            bf16_t* dst = (bf16_t*)(ws + OFF_WO) + (size_t)j * 64 * 1024;
            wt_rows64(dst, 1024, [&](int nl, int k) { return src[(size_t)k * 1024 + j * 64 + nl]; }, 0, kbeg, kend);
        } else if (it < 372) {
            const int q = it - 324, bi = 1 + q / 16, j = q % 16; const float* src = p->branch_w_out + ((size_t)(l * 4 + bi) * 256) * 1024;
            bf16_t* dst = (bf16_t*)(ws + OFF_WB) + (size_t)j * 64 * 1024 + bi * 256;
            wt_rows64(dst, 256, [&](int nl, int k) { return src[(size_t)k * 1024 + j * 64 + nl]; }, 1024, kbeg, kend);
        } else if (it < 388) {
            const int j = it - 372; const float* wb = p->branch_w_out + ((size_t)(l * 4) * 256) * 1024; const float* pw = p->pool_w + (size_t)l * 4 * 64 * 64; const float* ps = p->pool_scale + l * 256;
            bf16_t* dst = (bf16_t*)(ws + OFF_WB) + (size_t)j * 64 * 1024;
            wt_rows64(dst, 256, [&](int nl, int k) { const int gI = k >> 6, n = j * 64 + nl; const float* pr = pw + (size_t)k * 64; float s = 0.f;
                for (int e = 0; e < 64; ++e) s += pr[e] * ps[gI * 64 + e] * wb[(size_t)(gI * 64 + e) * 1024 + n]; return s; }, 1024, kbeg, kend);
        } else if (it < 404) {
            const int j = it - 388; const float* wq = p->mla_w_qb + (size_t)l * 256 * 384; const float* wk = p->mla_w_kvb + (size_t)l * 128 * 512;
            const float* gq = p->mla_q_norm_g + l * 256; const float* gk = p->mla_kv_norm_g + l * 128;
            bf16_t* dst = (bf16_t*)(ws + OFF_WL) + (size_t)j * 64 * 384;
            wt_rows64(dst, 384, [&](int nl, int k) { const int n = j * 64 + nl;
                if (n < 384) return k < 256 ? gq[k] * wq[(size_t)k * 384 + n] : 0.f;
                if (n < 896) return k >= 256 ? gk[k - 256] * wk[(size_t)(k - 256) * 512 + (n - 384)] : 0.f;
                return 0.f; }, 0, kbeg, kend);
        } else if (it < 404 + 288) {
            const int q = it - 404, ll = q / 144, cb = q % 144;
            LAS float* sc = (LAS float*)lds;
            LAS float* red = (LAS float*)(lds + 5 * 1024 * 4);
            __syncthreads();
            for (int i = opaque_tid(); i < 5 * 1024; i += 512) { const int r = i >> 10, k = i & 1023; const float cv = r < 4 ? p->c[r * 1024 + k] : p->c_ctx[k]; sc[i] = cv * sigmoidf_(cv); }
            __syncthreads();
            const int jl = opaque_tid() & 63, kg = opaque_tid() >> 6; const int col = cb * 64 + jl;
            const float* wsrc = p->ada_w + (size_t)ll * 1024 * 9216 + col;
            float a0 = 0.f, a1 = 0.f, a2 = 0.f, a3 = 0.f, a4 = 0.f;
            for (int k = kg * 128; k < kg * 128 + 128; ++k) { const float wv = wsrc[(size_t)k * 9216]; a0 += sc[k] * wv; a1 += sc[1024 + k] * wv; a2 += sc[2048 + k] * wv; a3 += sc[3072 + k] * wv; a4 += sc[4096 + k] * wv; }
            red[(kg * 5 + 0) * 64 + jl] = a0; red[(kg * 5 + 1) * 64 + jl] = a1; red[(kg * 5 + 2) * 64 + jl] = a2; red[(kg * 5 + 3) * 64 + jl] = a3; red[(kg * 5 + 4) * 64 + jl] = a4;
            __syncthreads();
            if (opaque_tid() < 320) { const int r = opaque_tid() >> 6; float s = p->ada_b[ll * 9216 + col];
                for (int q2 = 0; q2 < 8; ++q2) s += red[(q2 * 5 + r) * 64 + jl];
                ((float*)(ws + OFF_MOD))[(size_t)(ll * 5 + r) * 9216 + col] = s; }
        } else {
            for (int i = opaque_tid(); i < 1024; i += 512) { const int pos = i >> 3, fi = i & 7; const float inv = exp2f(-(float)fi * 0.125f * 13.287712379549449f); const float ang = (float)pos * inv;
                ((float2*)(ws + OFF_ROPE))[i] = make_float2(cosf(ang), sinf(ang)); }
        }
    }
}

__device__ void norm_mod_phase(const float* srcL, const float* srcC, float* cpyL, float* cpyC, const float* g, const float* mod, bf16_t* TN, int nrows, const float* pb, int nsl) {
    const int tid_ = opaque_tid(); const int lane = tid_ & 63, gw = opaque_bid() * 8 + (tid_ >> 6), nw = opaque_gdim() * 8;
    for (int row = gw; row < nrows; row += nw) {
        const bool lat = row < RL;
        const float* sp = lat ? srcL + (size_t)row * 1024 : srcC + (size_t)(row - RL) * 1024;
        const float* mp = mod + (lat ? (row >> 13) : 4) * 9216;
        f32x4 v[4]; float ss = 0.f;
#pragma unroll
        for (int j = 0; j < 4; ++j) v[j] = *(const f32x4*)(sp + 256 * j + 4 * lane);
        if (!lat && nsl > 0) {
            for (int sl = 0; sl < nsl; ++sl) { const float* pp = pb + ((size_t)sl * 1024 + (row - RL)) * 1024;
#pragma unroll
                for (int j = 0; j < 4; ++j) v[j] += *(const f32x4*)(pp + 256 * j + 4 * lane); }
            float* wp = (float*)sp;
#pragma unroll
            for (int j = 0; j < 4; ++j) *(f32x4*)(wp + 256 * j + 4 * lane) = v[j];
        }
#pragma unroll
        for (int j = 0; j < 4; ++j) ss += v[j][0] * v[j][0] + v[j][1] * v[j][1] + v[j][2] * v[j][2] + v[j][3] * v[j][3];
        if (cpyL) { float* cp = lat ? cpyL + (size_t)row * 1024 : cpyC + (size_t)(row - RL) * 1024;
#pragma unroll
            for (int j = 0; j < 4; ++j) *(f32x4*)(cp + 256 * j + 4 * lane) = v[j]; }
        ss = wave_sum(ss);
        const float rstd = rsqrtf(ss * (1.0f / 1024.0f) + NEPS);
#pragma unroll
        for (int j = 0; j < 4; ++j) {
            const int col = 256 * j + 4 * lane;
            const f32x4 gg = *(const f32x4*)(g + col), sh = *(const f32x4*)(mp + col), sc = *(const f32x4*)(mp + 1024 + col);
            float o[4];
#pragma unroll
            for (int e = 0; e < 4; ++e) o[e] = (v[j][e] * rstd * gg[e]) * (1.0f + sc[e]) + sh[e];
            u32x2 w; w.x = cvt_pk_bf16(o[0], o[1]); w.y = cvt_pk_bf16(o[2], o[3]);
            *(u32x2*)(TN + (size_t)row * 1024 + col) = w;
        }
    }
}
__device__ void final_norm_phase(float* H, const float* g) {
    const int tid_ = opaque_tid(); const int lane = tid_ & 63, gw = opaque_bid() * 8 + (tid_ >> 6), nw = opaque_gdim() * 8;
    for (int row = gw; row < RL; row += nw) {
        float* sp = H + (size_t)row * 1024; f32x4 v[4]; float ss = 0.f;
#pragma unroll
        for (int j = 0; j < 4; ++j) { v[j] = *(const f32x4*)(sp + 256 * j + 4 * lane); ss += v[j][0] * v[j][0] + v[j][1] * v[j][1] + v[j][2] * v[j][2] + v[j][3] * v[j][3]; }
        ss = wave_sum(ss);
        const float rstd = rsqrtf(ss * (1.0f / 1024.0f) + NEPS);
#pragma unroll
        for (int j = 0; j < 4; ++j) { const f32x4 gg = *(const f32x4*)(g + 256 * j + 4 * lane); *(f32x4*)(sp + 256 * j + 4 * lane) = v[j] * rstd * gg; }
    }
}

__device__ void prep_phase(PK p) {
    unsigned char* ws = p->ws;
    bf16_t* PJ = (bf16_t*)(ws + OFF_B); bf16_t* YB = (bf16_t*)(ws + OFF_A); bf16_t* MK = (bf16_t*)(ws + OFF_MK); float* RSTD = (float*)(ws + OFF_RSTD);
    const float2* RT = (const float2*)(ws + OFF_ROPE);
    const int tid_ = opaque_tid(); const int lane = tid_ & 63, gw = opaque_bid() * 8 + (tid_ >> 6), nw = opaque_gdim() * 8;
    for (int row = gw; row < RA; row += nw) {
        const bool lat = row < RL;
        int t, n; if (lat) { t = row & 8191; n = 8192; } else { t = (row - RL) & 255; n = 256; }
        const int sbase = row - t;
        bf16_t* prow = PJ + (size_t)row * PJW;
        {
            const int wdw = 2 << (lane >> 4); const int lo = max(t - wdw / 2, 0), hi = min(t - wdw / 2 + wdw, n);
            float s0 = 0.f, s1 = 0.f, s2 = 0.f, s3 = 0.f;
            for (int tt = lo; tt < hi; ++tt) { const u32x2 v = *(const u32x2*)(PJ + (size_t)(sbase + tt) * PJW + 4 * lane); s0 += bf_lo(v.x); s1 += bf_hi(v.x); s2 += bf_lo(v.y); s3 += bf_hi(v.y); }
            const float ic = 1.0f / (float)(hi - lo); const u32x2 sv = *(const u32x2*)(prow + 4 * lane);
            u32x2 w; w.x = cvt_pk_bf16(s0 * ic - bf_lo(sv.x), s1 * ic - bf_hi(sv.x)); w.y = cvt_pk_bf16(s2 * ic - bf_lo(sv.y), s3 * ic - bf_hi(sv.y));
            *(u32x2*)(YB + (size_t)row * 1024 + 4 * lane) = w;
        }
        {
            const u32x2 q = *(const u32x2*)(prow + C_MQ + 4 * lane); const unsigned kv = *(const unsigned*)(prow + C_MKV + 2 * lane);
            float sq = bf_lo(q.x) * bf_lo(q.x) + bf_hi(q.x) * bf_hi(q.x) + bf_lo(q.y) * bf_lo(q.y) + bf_hi(q.y) * bf_hi(q.y);
            float sk = bf_lo(kv) * bf_lo(kv) + bf_hi(kv) * bf_hi(kv);
            sq = wave_sum(sq); sk = wave_sum(sk);
            if (lane == 0) { RSTD[row * 2] = rsqrtf(sq * (1.0f / 256.0f) + NEPS); RSTD[row * 2 + 1] = rsqrtf(sk * (1.0f / 128.0f) + NEPS); }
        }
        if (lane < 34) {
            const bool iskr = lane >= 32; const int a = lane & 1;
            bf16_t* ep = iskr ? prow + C_MKR + a * 16 : prow + ((lane >> 4) ? C_DK : C_DQ) + ((lane >> 1) & 7) * 32 + a * 16;
            const u32x4 e0 = *(const u32x4*)ep, e1 = *(const u32x4*)(ep + 8);
            float x1[8], x2[8];
            x1[0] = bf_lo(e0.x); x1[1] = bf_hi(e0.x); x1[2] = bf_lo(e0.y); x1[3] = bf_hi(e0.y); x1[4] = bf_lo(e0.z); x1[5] = bf_hi(e0.z); x1[6] = bf_lo(e0.w); x1[7] = bf_hi(e0.w);
            x2[0] = bf_lo(e1.x); x2[1] = bf_hi(e1.x); x2[2] = bf_lo(e1.y); x2[3] = bf_hi(e1.y); x2[4] = bf_lo(e1.z); x2[5] = bf_hi(e1.z); x2[6] = bf_lo(e1.w); x2[7] = bf_hi(e1.w);
            if (lat) { const int pos = a ? (t & 63) : (t >> 6);
#pragma unroll
                for (int i = 0; i < 8; ++i) { const float2 cs = RT[pos * 8 + i]; const float o1 = x1[i] * cs.x - x2[i] * cs.y, o2 = x1[i] * cs.y + x2[i] * cs.x; x1[i] = o1; x2[i] = o2; } }
            u32x4 w0, w1; w0.x = cvt_pk_bf16(x1[0], x1[1]); w0.y = cvt_pk_bf16(x1[2], x1[3]); w0.z = cvt_pk_bf16(x1[4], x1[5]); w0.w = cvt_pk_bf16(x1[6], x1[7]);
            w1.x = cvt_pk_bf16(x2[0], x2[1]); w1.y = cvt_pk_bf16(x2[2], x2[3]); w1.z = cvt_pk_bf16(x2[4], x2[5]); w1.w = cvt_pk_bf16(x2[6], x2[7]);
            if (iskr) {
#pragma unroll
                for (int hh = 0; hh < 4; ++hh) { bf16_t* kp = MK + (size_t)row * 384 + hh * 96 + 64 + a * 16; *(u32x4*)kp = w0; *(u32x4*)(kp + 8) = w1; }
            } else if (lat) { *(u32x4*)ep = w0; *(u32x4*)(ep + 8) = w1; }
        }
    }
}

#define MFMA32(a, b, c) __builtin_amdgcn_mfma_f32_32x32x16_bf16((a), (b), (c), 0, 0, 0)
typedef float f32x2 __attribute__((ext_vector_type(2)));
template <int MODE>
__device__ __forceinline__ void attn_item(PK p, int l, LAS unsigned char* lds, int b, int h, int qb, bool ctxq, float lam, float lam_init) {
    constexpr int NCOMP = (MODE == 1) ? 2 : 1, NKS = (MODE == 0) ? 4 : ((MODE == 1) ? 2 : 6), KW = NCOMP * NKS * 16, KCH = KW / 8, KSTR = KW * 2 + 16, VSTR = 192;
    constexpr int KBUF = 64 * KSTR, VBUF = 64 * VSTR, BUFSZ = KBUF + VBUF, BIAS_OFF = 3 * BUFSZ;
    constexpr bool STAG = (MODE != 0);
    const int tid = opaque_tid(), w = tid >> 6, lane = tid & 63, g = lane >> 5, l32 = lane & 31;
    unsigned char* ws = p->ws;
    const bf16_t* PJ = (const bf16_t*)(ws + OFF_B);
    const bf16_t *Qp, *Kp, *Vp; int ldq, ldk, ldv, outoff; float scale;
    if (MODE == 0) { Qp = PJ + C_NQ + 64 * h; Kp = PJ + C_NK + 64 * h; Vp = PJ + C_NV + 64 * h; ldq = ldk = ldv = PJW; outoff = 256 + 64 * h; scale = 0.125f; }
    else if (MODE == 1) { Qp = PJ + C_DQ + 64 * h; Kp = PJ + C_DK + 64 * h; Vp = PJ + C_DV + 64 * h; ldq = ldk = ldv = PJW; outoff = 512 + 64 * h; scale = 0.17677669529663687f; }
    else { Qp = (const bf16_t*)(ws + OFF_D) + 96 * h; Kp = (const bf16_t*)(ws + OFF_MK) + 96 * h; Vp = (const bf16_t*)(ws + OFF_MV) + 64 * h; ldq = ldk = 384; ldv = 256; outoff = 768 + 64 * h; scale = 0.10206207261596575f; }
    const float cs = scale * LOG2E;
    int qrow0, loc0, nloc;
    if (ctxq) { qrow0 = RL + b * 256; loc0 = 0; nloc = 0; }
    else { qrow0 = b * 8192 + qb * 256;
        if (MODE == 0) { const int r0 = qb * 4; loc0 = clampi(r0 - 4, 0, 120); nloc = clampi(r0 - 1, 0, 120) + 8 - loc0; } else { loc0 = 0; nloc = 128; } }
    const int nt = nloc + 4;
    const bool nabias = (MODE == 0) && !ctxq;
    const bool late = STAG && (w >= 4);
    const int rw = qb * 4 + (w >> 1), sw = clampi(rw - 4, 0, 120);
    const int jq = 32 * (w & 1) + l32, cst = clampi(jq - 8, 0, 48);
    if (nabias && tid < 465) ((LAS float*)(lds + BIAS_OFF))[tid] = p->na_rpb[(size_t)(l * 4 + h) * 465 + tid] * LOG2E;

    const size_t qrow = (size_t)qrow0 + 32 * w + l32;
    bf16x8 qf[NCOMP * NKS];
#pragma unroll
    for (int i = 0; i < NCOMP * NKS; ++i) {
        const u32x4 raw = *(const u32x4*)(Qp + qrow * ldq + 16 * i + 8 * g);
        u32x4 sc4; sc4.x = cvt_pk_bf16(bf_lo(raw.x) * cs, bf_hi(raw.x) * cs); sc4.y = cvt_pk_bf16(bf_lo(raw.y) * cs, bf_hi(raw.y) * cs);
        sc4.z = cvt_pk_bf16(bf_lo(raw.z) * cs, bf_hi(raw.z) * cs); sc4.w = cvt_pk_bf16(bf_lo(raw.w) * cs, bf_hi(raw.w) * cs);
        qf[i] = __builtin_bit_cast(bf16x8, sc4);
    }

    const int kr0 = tid / KCH, kc0 = tid % KCH, kr1 = (tid + 512) / KCH, kc1 = (tid + 512) % KCH, vr = tid >> 3, vc = tid & 7;
    const bool hask1 = (KCH == 12) && (tid < 256);
    u32x4 rk0, rk1 = (u32x4){0u, 0u, 0u, 0u}, rv;
#define TILE_ROW(t) ((t) < nloc ? (b * 8192 + 64 * (loc0 + (t))) : (RL + b * 256 + 64 * ((t) - nloc)))
#define LOAD_TILE(t) do { const size_t _tb = (size_t)TILE_ROW(t); rk0 = *(const u32x4*)(Kp + (_tb + kr0) * ldk + kc0 * 8); \
        if (hask1) rk1 = *(const u32x4*)(Kp + (_tb + kr1) * ldk + kc1 * 8); rv = *(const u32x4*)(Vp + (_tb + vr) * ldv + vc * 8); } while (0)
#define STORE_TILE(buf) do { LAS unsigned char* _kb = lds + (buf) * BUFSZ; *(LAS u32x4*)(_kb + kr0 * KSTR + kc0 * 16) = rk0; \
        if (hask1) *(LAS u32x4*)(_kb + kr1 * KSTR + kc1 * 16) = rk1; *(LAS u32x4*)(_kb + KBUF + vr * VSTR + vc * 16) = rv; } while (0)

    float mrun[NCOMP], lsum[NCOMP]; f32x16 O[NCOMP][2];
#pragma unroll
    for (int c = 0; c < NCOMP; ++c) { mrun[c] = -1e30f; lsum[c] = 0.f;
#pragma unroll
        for (int dt = 0; dt < 2; ++dt)
#pragma unroll
            for (int r = 0; r < 16; ++r) O[c][dt][r] = 0.f; }
    bf16x8 P[NCOMP][2][2];
#pragma unroll
    for (int c = 0; c < NCOMP; ++c)
#pragma unroll
        for (int kt = 0; kt < 2; ++kt)
#pragma unroll
            for (int s2 = 0; s2 < 2; ++s2) P[c][kt][s2] = (bf16x8){0, 0, 0, 0, 0, 0, 0, 0};

    LOAD_TILE(0); STORE_TILE(0); __syncthreads();
    const int koff = l32 * KSTR + g * 16;
    const int i16 = lane & 15, tq = i16 >> 2, tp = i16 & 3, blk = (lane >> 4) & 1;
    const int voff = (4 * g + tq) * VSTR + (16 * blk + 4 * tp) * 2;
#define PV_TILE(buf) do { LAS unsigned char* _vb = lds + (buf) * BUFSZ + KBUF + voff; \
        _Pragma("unroll") for (int kt = 0; kt < 2; ++kt) { bf16x8 vf[2][2]; \
            _Pragma("unroll") for (int s2 = 0; s2 < 2; ++s2) _Pragma("unroll") for (int dt = 0; dt < 2; ++dt) { LAS unsigned char* vp = _vb + (32 * kt + 16 * s2) * VSTR + dt * 64; \
                const s16x4 lo = __builtin_amdgcn_ds_read_tr16_b64_v4i16((LAS s16x4*)vp); const s16x4 hi = __builtin_amdgcn_ds_read_tr16_b64_v4i16((LAS s16x4*)(vp + 8 * VSTR)); \
                vf[s2][dt] = __builtin_shufflevector(lo, hi, 0, 1, 2, 3, 4, 5, 6, 7); } \
            _Pragma("unroll") for (int s2 = 0; s2 < 2; ++s2) _Pragma("unroll") for (int dt = 0; dt < 2; ++dt) _Pragma("unroll") for (int c = 0; c < NCOMP; ++c) O[c][dt] = MFMA32(vf[s2][dt], P[c][kt][s2], O[c][dt]); } } while (0)

#define PV_TILE_C(buf, cc) do { LAS unsigned char* _vb = lds + (buf) * BUFSZ + KBUF + voff; \
        _Pragma("unroll") for (int kt = 0; kt < 2; ++kt) { bf16x8 vf[2][2]; \
            _Pragma("unroll") for (int s2 = 0; s2 < 2; ++s2) _Pragma("unroll") for (int dt = 0; dt < 2; ++dt) { LAS unsigned char* vp = _vb + (32 * kt + 16 * s2) * VSTR + dt * 64; \
                const s16x4 lo = __builtin_amdgcn_ds_read_tr16_b64_v4i16((LAS s16x4*)vp); const s16x4 hi = __builtin_amdgcn_ds_read_tr16_b64_v4i16((LAS s16x4*)(vp + 8 * VSTR)); \
                vf[s2][dt] = __builtin_shufflevector(lo, hi, 0, 1, 2, 3, 4, 5, 6, 7); } \
            _Pragma("unroll") for (int s2 = 0; s2 < 2; ++s2) _Pragma("unroll") for (int dt = 0; dt < 2; ++dt) O[cc][dt] = MFMA32(vf[s2][dt], P[cc][kt][s2], O[cc][dt]); } } while (0)
    bool pend = false; int pbuf = 0, cbuf = 0;
    for (int t = 0; t < nt; ++t) {
        const bool more = (t + 1 < nt);
        if (more) LOAD_TILE(t + 1);
        bool active = true; int krow = 0;
        if (nabias && t < nloc) { krow = loc0 + t; active = (krow >= sw) && (krow < sw + 8); }
        if (active) {
            LAS unsigned char* Kb = lds + cbuf * BUFSZ + koff;
            f32x16 S[NCOMP][2];
#pragma unroll
            for (int c = 0; c < NCOMP; ++c)
#pragma unroll
                for (int kt = 0; kt < 2; ++kt) {
                    bf16x8 kf[NKS];
#pragma unroll
                    for (int ks = 0; ks < NKS; ++ks) kf[ks] = *(const LAS bf16x8*)(Kb + kt * 32 * KSTR + (c * NKS + ks) * 32);
#pragma unroll
                    for (int r = 0; r < 16; ++r) S[c][kt][r] = 0.f;
#pragma unroll
                    for (int ks = 0; ks < NKS; ++ks) S[c][kt] = MFMA32(kf[ks], qf[c * NKS + ks], S[c][kt]);
                }
            if (STAG && late && pend) PV_TILE(pbuf);
#pragma unroll
            for (int c = 0; c < NCOMP; ++c) {
                float mx = -1e30f;
                if (nabias && t < nloc) {
                    const LAS float* bt = (const LAS float*)(lds + BIAS_OFF) + (krow - rw + 7) * 31;
#pragma unroll
                    for (int kt = 0; kt < 2; ++kt)
#pragma unroll
                        for (int r = 0; r < 16; ++r) { const int jk = 32 * kt + (r & 3) + 8 * (r >> 2) + 4 * g; const bool ok = (jk >= cst) && (jk < cst + 16);
                            const float bv = bt[clampi(jk - jq + 15, 0, 30)]; const float xv = ok ? (S[c][kt][r] + bv) : -1e30f; S[c][kt][r] = xv; mx = fmaxf(mx, xv); }
                } else {
#pragma unroll
                    for (int kt = 0; kt < 2; ++kt)
#pragma unroll
                        for (int r = 0; r < 16; r += 2) mx = fmaxf(fmaxf(mx, S[c][kt][r]), S[c][kt][r + 1]);
                }
                mx = fmaxf(mx, shflx(mx, 32));
                const float mnew = fmaxf(mrun[c], mx);
                if (__any(mnew > mrun[c])) {
                    const float alpha = fast_exp2(mrun[c] - mnew); lsum[c] *= alpha;
#pragma unroll
                    for (int dt = 0; dt < 2; ++dt) O[c][dt] *= alpha;
                    mrun[c] = mnew;
                }
                f32x2 rs2 = (f32x2){0.f, 0.f}; const f32x2 m2 = (f32x2){mnew, mnew};
#pragma unroll
                for (int kt = 0; kt < 2; ++kt)
#pragma unroll
                    for (int r = 0; r < 16; r += 2) { const f32x2 d = (f32x2){S[c][kt][r], S[c][kt][r + 1]} - m2; S[c][kt][r] = d.x; S[c][kt][r + 1] = d.y; }
#pragma unroll
                for (int kt = 0; kt < 2; ++kt)
#pragma unroll
                    for (int r = 0; r < 16; ++r) S[c][kt][r] = fast_exp2(S[c][kt][r]);
#pragma unroll
                for (int kt = 0; kt < 2; ++kt)
#pragma unroll
                    for (int s2 = 0; s2 < 2; ++s2) { u32x4 pk;
#pragma unroll
                        for (int e = 0; e < 4; ++e) { const f32x2 ev = (f32x2){S[c][kt][8 * s2 + 2 * e], S[c][kt][8 * s2 + 2 * e + 1]}; rs2 += ev; pk[e] = cvt_pk_bf16(ev.x, ev.y); }
                        P[c][kt][s2] = __builtin_bit_cast(bf16x8, pk); }
                lsum[c] += rs2.x + rs2.y;
                if (!(STAG && late)) PV_TILE_C(cbuf, c);
            }
            if (STAG && late) { pend = true; pbuf = cbuf; }
        }
        const int nbuf = (cbuf == 2) ? 0 : cbuf + 1;
        if (more) STORE_TILE(nbuf);
        __syncthreads();
        cbuf = nbuf;
    }
    if (STAG && late && pend) PV_TILE(pbuf);
#undef PV_TILE
#undef PV_TILE_C
#undef TILE_ROW
#undef LOAD_TILE
#undef STORE_TILE
    float inv[NCOMP];
#pragma unroll
    for (int c = 0; c < NCOMP; ++c) { const float lt = lsum[c] + shflx(lsum[c], 32); inv[c] = 1.0f / lt; }
    bf16_t* op = (bf16_t*)(ws + OFF_A) + qrow * 1024 + outoff;
    if (MODE == 1) {
        const float li1 = lam * inv[NCOMP - 1]; float ss = 0.f;
#pragma unroll
        for (int dt = 0; dt < 2; ++dt)
#pragma unroll
            for (int r = 0; r < 16; ++r) { const float o = O[0][dt][r] * inv[0] - li1 * O[NCOMP - 1][dt][r]; O[0][dt][r] = o; ss += o * o; }
        ss += shflx(ss, 32);
        const float rstd = rsqrtf(ss * (1.0f / 64.0f) + NEPS) * (1.0f - lam_init);
        const float* sg = p->diff_subln_g + l * 64;
#pragma unroll
        for (int dt = 0; dt < 2; ++dt)
#pragma unroll
            for (int rq = 0; rq < 4; ++rq) { const int dv = 32 * dt + 8 * rq + 4 * g; const f32x4 gg = *(const f32x4*)(sg + dv);
                u32x2 wv; wv.x = cvt_pk_bf16(O[0][dt][4 * rq] * rstd * gg[0], O[0][dt][4 * rq + 1] * rstd * gg[1]); wv.y = cvt_pk_bf16(O[0][dt][4 * rq + 2] * rstd * gg[2], O[0][dt][4 * rq + 3] * rstd * gg[3]);
                *(u32x2*)(op + dv) = wv; }
    } else {
#pragma unroll
        for (int dt = 0; dt < 2; ++dt)
#pragma unroll
            for (int rq = 0; rq < 4; ++rq) { const int dv = 32 * dt + 8 * rq + 4 * g;
                u32x2 wv; wv.x = cvt_pk_bf16(O[0][dt][4 * rq] * inv[0], O[0][dt][4 * rq + 1] * inv[0]); wv.y = cvt_pk_bf16(O[0][dt][4 * rq + 2] * inv[0], O[0][dt][4 * rq + 3] * inv[0]);
                *(u32x2*)(op + dv) = wv; }
    }
    __syncthreads();
}

__device__ void attn_phase(PK p, int l, LAS unsigned char* lds) {
    const float lam_init = (l == 0) ? 0.2f : 0.35550906759502f;
    const float* dl = p->diff_lambda + l * 128;
    float d01 = 0.f, d23 = 0.f;
    for (int i = 0; i < 32; ++i) { d01 += dl[i] * dl[32 + i]; d23 += dl[64 + i] * dl[96 + i]; }
    const float lam = expf(d01) - expf(d23) + lam_init;
    const int nItems = 1536 + (l == 0 ? 48 : 0);
    for (int it = opaque_bid(); it < nItems; it += opaque_gdim()) {
        if (it < 1536) {
            const int ty = it >> 9, idx = it & 511, bh = ((idx & 7) << 1) | (idx >> 8), b = bh >> 2, h = bh & 3, qb = (idx >> 3) & 31;
            if (ty == 0) attn_item<1>(p, l, lds, b, h, qb, false, lam, lam_init);
            else if (ty == 1) attn_item<2>(p, l, lds, b, h, qb, false, lam, lam_init);
            else attn_item<0>(p, l, lds, b, h, qb, false, lam, lam_init);
        } else {
            const int idx = it - 1536, ty = idx >> 4, b = (idx >> 2) & 3, h = idx & 3;
            if (ty == 0) attn_item<1>(p, l, lds, b, h, 0, true, lam, lam_init);
            else if (ty == 1) attn_item<2>(p, l, lds, b, h, 0, true, lam, lam_init);
            else attn_item<0>(p, l, lds, b, h, 0, true, lam, lam_init);
        }
    }
}

constexpr int PH_PER_LAYER = 14, N_PHASES = 2 * PH_PER_LAYER + 1;

__device__ __forceinline__ void run_phase(PK p, int ph, LAS unsigned char* lds, float rcoef) {
    unsigned char* ws = p->ws;
    pg8::StaticOrder S;
    if (ph == N_PHASES - 1) { final_norm_phase(p->out, p->final_norm_g); return; }
    int l = ph / PH_PER_LAYER; const int q = ph % PH_PER_LAYER;
#define OPQL asm volatile("" : "+s"(l))
#define HC ((float*)(ws + OFF_HC))
#define MOD ((const float*)(ws + OFF_MOD) + (size_t)l * 5 * 9216)
#define TN ((bf16_t*)(ws + OFF_A))
#define HID ((bf16_t*)(ws + OFF_B))
#define Mlate ((l == 0) ? RA : RL)
    switch (q) {
    case 0: OPQL; layer_prep_phase(p, l, lds); break;
    case 1: OPQL; if (l == 0) norm_mod_phase(p->x, p->ctx, p->out, HC, p->norm_g + (l * 3 + 0) * 1024, MOD, TN, RA, nullptr, 0);
            else norm_mod_phase(p->out, HC, nullptr, nullptr, p->norm_g + (l * 3 + 0) * 1024, MOD, TN, RA, (const float*)(ws + OFF_PB), 11); break;
    case 2: case 12: { OPQL; const int f = (q == 2) ? 0 : 1; const int M = (q == 2) ? RA : Mlate;
        pg8::Gemm g{TN, (const bf16_t*)(ws + OFF_W1) + (size_t)f * 5632 * 1024, M, 5632, 1024, 1024, 1024}; S.init(M, 5632, opaque_gdim(), opaque_bid());
        EpiSwiglu E{HID}; pg8::gemm_phase(lds, g, S, E); } break;
    case 4: OPQL; norm_mod_phase(p->out, HC, nullptr, nullptr, p->norm_g + (l * 3 + 1) * 1024, MOD + 3 * 1024, TN, RA, (const float*)(ws + OFF_PB), 11); break;
    case 5: { OPQL; pg8::Gemm g{TN, (const bf16_t*)(ws + OFF_WM), RA, 6400, 1024, 1024, 1024}; S.init(RA, 6400, opaque_gdim(), opaque_bid());
        EpiPJ E{(bf16_t*)(ws + OFF_B), ws + OFF_C}; pg8::gemm_phase(lds, g, S, E); } break;
    case 6: prep_phase(p); break;
    case 7: { OPQL; pg8::Gemm g{(const bf16_t*)(ws + OFF_B) + C_MQ, (const bf16_t*)(ws + OFF_WL), RA, 1024, 384, PJW, 384}; S.init(RA, 1024, opaque_gdim(), opaque_bid());
        EpiMLA E{(bf16_t*)(ws + OFF_D), (bf16_t*)(ws + OFF_MK), (bf16_t*)(ws + OFF_MV), (const float*)(ws + OFF_RSTD), (const float2*)(ws + OFF_ROPE)}; pg8::gemm_phase(lds, g, S, E); } break;
    case 8: OPQL; attn_phase(p, l, lds); break;
    case 9: { OPQL; pg8::Gemm g{(const bf16_t*)(ws + OFF_A), (const bf16_t*)(ws + OFF_WB), Mlate, 1024, 1024, 1024, 1024}; S.init(Mlate, 1024, opaque_gdim(), opaque_bid());
        EpiMerge E{ws + OFF_C, (bf16_t*)(ws + OFF_D)}; pg8::gemm_phase(lds, g, S, E); } break;
    case 3: case 13: case 10: { OPQL;
        const bool isout = (q == 10); const int f = (q == 13) ? 1 : 0;
        const bf16_t* A = isout ? (const bf16_t*)(ws + OFF_D) : (const bf16_t*)HID;
        const bf16_t* Bt = isout ? (const bf16_t*)(ws + OFF_WO) : (const bf16_t*)(ws + OFF_W2) + (size_t)f * 1024 * FH;
        const int K = isout ? 1024 : FH;
        const float* gate = MOD + (isout ? 5 : (q == 3 ? 2 : 8)) * 1024;
        const float coef = (isout ? 1.0f : 0.5f) * rcoef;
        const bool withctx = (q == 3) || (l == 0);
        { pg8::Gemm g{A, Bt, RL, 1024, K, K, K}; S.init(RL, 1024, opaque_gdim(), opaque_bid());
          EpiResid E{p->out, HC, gate, coef}; pg8::gemm_phase(lds, g, S, E); }
        if (withctx) {
            const int nsu = 16 * (K / 256);
            for (int su = opaque_bid(); su < nsu; su += opaque_gdim()) {
                const int ks = su >> 4, pmn = su & 15;
                pg8::SingleUnit SU; SU.pm = 128 + (pmn >> 2); SU.pn = pmn & 3; SU.has = true;
                pg8::Gemm g2{A + ks * 256, Bt + ks * 256, RA, 1024, 256, K, K};
                EpiPartial E2{(float*)(ws + OFF_PB) + (size_t)ks * 1024 * 1024, gate + 4 * 9216, coef}; pg8::gemm_phase(lds, g2, SU, E2);
            }
        }
    } break;
    case 11: OPQL; norm_mod_phase(p->out, HC, nullptr, nullptr, p->norm_g + (l * 3 + 2) * 1024, MOD + 6 * 1024, TN, Mlate, (const float*)(ws + OFF_PB), 4); break;
    }
#undef OPQL
#undef HC
#undef MOD
#undef TN
#undef HID
#undef Mlate
}

__global__ void __launch_bounds__(512, 2) fwd_megakernel(Params p) {
    extern __shared__ __attribute__((aligned(16))) unsigned char shm[];
    LAS unsigned char* lds = (LAS unsigned char*)shm;
#if N_LAUNCH_MODE == 1
    cg::grid_group grid = cg::this_grid();
    const int ph_lo = p.ph_lo, ph_hi = p.ph_hi;
    volatile LAS unsigned* st = (volatile LAS unsigned*)(lds + pg8::STAGE_BYTES);
    unsigned* bar = (unsigned*)(p.ws + OFF_BAR);
    if (opaque_tid() < 4) st[opaque_tid()] = 0u;
    if (opaque_bid() == 0) for (int i = opaque_tid(); i < XCD_BAR_WORDS; i += 512) bar[i] = 0u;
    __syncthreads();
    for (int ph = ph_lo; ph < ph_hi; ++ph) {
        const int qq = ph % PH_PER_LAYER;
        const int nrep = (PROBE_MASK && ph < N_PHASES - 1 && qq != 6 && ((PROBE_MASK >> qq) & 1)) ? 2 : 1;
        for (int rep = 0; rep < nrep; ++rep) {
            PK pk = (PK)__builtin_amdgcn_kernarg_segment_ptr();
            asm volatile("" : "+s"(pk));
            run_phase(pk, ph, lds, (PROBE_MASK & 0x2408) ? (rep ? 0.0f : 1.0f) : 1.0f);
            if (ph == ph_lo && rep == 0) { grid.sync(); xcd_barrier_post(bar); }
            else if (ph + 1 < ph_hi || rep + 1 < nrep) xcd_barrier(bar, st);
        }
    }
#else
    const int ph_lo = p.ph_lo, ph_hi = p.ph_hi;
    for (int ph = ph_lo; ph < ph_hi; ++ph) { PK pk = (PK)__builtin_amdgcn_kernarg_segment_ptr(); asm volatile("" : "+s"(pk)); run_phase(pk, ph, lds, 1.0f); }
#endif
}

extern "C" void kernel_launch(void* const* d_in, const int* in_sizes, int n_in, void* d_out, int out_size, void* d_ws, size_t ws_size, hipStream_t stream) {
    constexpr int LDS_BYTES = pg8::STAGE_BYTES + 16;
    static int grid_blocks = 0;
    if (grid_blocks == 0) {
        if (n_in != 22 || ws_size < WS_END) { fprintf(stderr, "kernel_launch: unexpected inputs (n_in %d, ws %zu < %zu)\n", n_in, ws_size, (size_t)WS_END); grid_blocks = -1; return; }
        int dev = 0, cus = 0, per_cu = 0;
        hipGetDevice(&dev); hipDeviceGetAttribute(&cus, hipDeviceAttributeMultiprocessorCount, dev);
        if (hipFuncSetAttribute((const void*)fwd_megakernel, hipFuncAttributeMaxDynamicSharedMemorySize, LDS_BYTES) != hipSuccess) { fprintf(stderr, "hipFuncSetAttribute failed\n"); grid_blocks = -1; return; }
        if (hipOccupancyMaxActiveBlocksPerMultiprocessor(&per_cu, (const void*)fwd_megakernel, 512, LDS_BYTES) != hipSuccess || per_cu < 1) per_cu = 1;
        (void)hipGetLastError();
        grid_blocks = cus * 1;
    }
    if (grid_blocks < 0) return;
    Params hp{};
    const float** pp = (const float**)&hp;
    for (int i = 0; i < 22; ++i) pp[i] = (const float*)d_in[i];
    hp.out = (float*)d_out; hp.ws = (unsigned char*)d_ws;
#if N_LAUNCH_MODE == 1
    hp.ph_lo = 0; hp.ph_hi = N_PHASES;
    void* args[] = {&hp};
    hipError_t e = hipLaunchCooperativeKernel((const void*)fwd_megakernel, dim3(grid_blocks), dim3(512), args, LDS_BYTES, stream);
    if (e != hipSuccess) fprintf(stderr, "cooperative launch failed: %s (grid %d)\n", hipGetErrorString(e), grid_blocks);
#else
    for (int ph = 0; ph < N_PHASES; ++ph) { hp.ph_lo = ph; hp.ph_hi = ph + 1; hipLaunchKernelGGL(fwd_megakernel, dim3(grid_blocks), dim3(512), LDS_BYTES, stream, hp); }
#endif
}
```

```cpp
#include <hip/hip_runtime.h>
#include <hip/hip_cooperative_groups.h>
#include <cstdio>
namespace cg = cooperative_groups;

#define LAS __attribute__((address_space(3)))
typedef unsigned short bf16_t;
typedef short bf16x8 __attribute__((ext_vector_type(8)));
typedef short s16x4 __attribute__((ext_vector_type(4)));
typedef float f32x4 __attribute__((ext_vector_type(4)));
typedef float f32x16 __attribute__((ext_vector_type(16)));
typedef unsigned u32x4 __attribute__((ext_vector_type(4)));
typedef unsigned u32x2 __attribute__((ext_vector_type(2)));

#ifndef PROBE_Q
#define PROBE_Q (-1)
#endif
#ifndef N_LAUNCH_MODE
#define N_LAUNCH_MODE 1
#endif

constexpr int RL = 32768, RA = 33792, FH = 2816;
constexpr int PJW = 2304;
constexpr int C_NQ = 256, C_NK = 512, C_NV = 768, C_DQ = 1024, C_DK = 1280, C_DV = 1536, C_MQ = 1792, C_MKV = 2048, C_MKR = 2176;
constexpr float LOG2E = 1.4426950408889634f;
constexpr float NEPS = 1e-6f;
constexpr int XCD_BAR_WORDS_C = 3456;

constexpr size_t SZ_W1 = 2ull * 5632 * 1024 * 2, SZ_W2 = 2ull * 1024 * 2816 * 2, SZ_WM = 6400ull * 1024 * 2, SZ_WL = 1024ull * 384 * 2, SZ_WB = 4ull * 1024 * 256 * 2, SZ_WO = 1024ull * 1024 * 2;
constexpr size_t OFF_W1 = 0, OFF_W2 = OFF_W1 + SZ_W1, OFF_WM = OFF_W2 + SZ_W2, OFF_WL = OFF_WM + SZ_WM, OFF_WB = OFF_WL + SZ_WL, OFF_WO = OFF_WB + SZ_WB;
constexpr size_t OFF_HC = OFF_WO + SZ_WO;
constexpr size_t OFF_MOD = OFF_HC + 1024ull * 1024 * 4;
constexpr size_t OFF_ROPE = OFF_MOD + 2ull * 5 * 9216 * 4;
constexpr size_t OFF_RSTD = OFF_ROPE + 128 * 8 * 8;
constexpr size_t OFF_A = OFF_RSTD + (size_t)RA * 2 * 4;
constexpr size_t OFF_B = OFF_A + (size_t)RA * 1024 * 2;
constexpr size_t OFF_C = OFF_B + (size_t)RA * PJW * 2;
constexpr size_t OFF_D = OFF_C + (size_t)RA * 4096;
constexpr size_t OFF_MK = OFF_D + (size_t)RA * 384 * 2, OFF_MV = OFF_MK + (size_t)RA * 384 * 2;
constexpr size_t OFF_BAR = OFF_D + (size_t)RA * 1024 * 2;
constexpr size_t OFF_PB = OFF_BAR + 16384;
constexpr size_t WS_END = OFF_PB + 11ull * 1024 * 1024 * 4;

struct Params {
    const float *x, *c, *ctx, *c_ctx, *ada_w, *ada_b, *norm_g, *ffn_w_in, *ffn_w_out, *mix_w_in, *pool_w, *pool_scale, *na_rpb, *diff_lambda, *diff_subln_g,
        *mla_q_norm_g, *mla_kv_norm_g, *mla_w_qb, *mla_w_kvb, *branch_w_out, *mix_w_out, *final_norm_g;
    float* out; unsigned char* ws;
    int ph_lo, ph_hi;
};

typedef const __attribute__((address_space(4))) Params* PK;

typedef float f32x2_ __attribute__((ext_vector_type(2)));
typedef __bf16 bf16x2_ __attribute__((ext_vector_type(2)));
__device__ __forceinline__ unsigned cvt_pk_bf16(float lo, float hi) { const f32x2_ v = {lo, hi}; return __builtin_bit_cast(unsigned, __builtin_convertvector(v, bf16x2_)); }
__device__ __forceinline__ float bf_lo(unsigned u) { return __uint_as_float(u << 16); }
__device__ __forceinline__ float bf_hi(unsigned u) { return __uint_as_float(u & 0xffff0000u); }
__device__ __forceinline__ float fast_exp2(float x) { return __builtin_amdgcn_exp2f(x); }
__device__ __forceinline__ float fast_rcp(float x) { return __builtin_amdgcn_rcpf(x); }
__device__ __forceinline__ float sigmoidf_(float x) { return fast_rcp(1.0f + fast_exp2(-x * LOG2E)); }
__device__ __forceinline__ float shflx(float v, int m) {
    int lane = __builtin_amdgcn_mbcnt_hi(~0u, __builtin_amdgcn_mbcnt_lo(~0u, 0)); asm volatile("" : "+v"(lane));
    return __int_as_float(__builtin_amdgcn_ds_bpermute((lane ^ m) << 2, __float_as_int(v)));
}
__device__ __forceinline__ float wave_sum(float v) {
    v += shflx(v, 32); v += shflx(v, 16); v += shflx(v, 8); v += shflx(v, 4); v += shflx(v, 2); v += shflx(v, 1); return v;
}
__device__ __forceinline__ int opaque_tid() { int t = threadIdx.x; asm volatile("" : "+v"(t)); return t; }
__device__ __forceinline__ int opaque_bid() { int t = blockIdx.x; asm volatile("" : "+s"(t)); return t; }
__device__ __forceinline__ int opaque_gdim() { int t = gridDim.x; asm volatile("" : "+s"(t)); return t; }
__device__ __forceinline__ int clampi(int v, int lo, int hi) { return v < lo ? lo : (v > hi ? hi : v); }

#define XB_TMO      128
#define XB_XCNT(j)  (256  + 64 * (j))
#define XB_XSUB(j)  (1280 + 64 * (j))
#define XB_XGEN(j)  (2304 + 64 * (j))
#define XB_TOP      3328
#define XB_TOPGEN   3392
#define XCD_BAR_WORDS 3456
#define XB_SPIN_CAP (1u << 20)
__device__ __forceinline__ unsigned xb_ld(unsigned* p)              { return __hip_atomic_load(p, __ATOMIC_RELAXED, __HIP_MEMORY_SCOPE_AGENT); }
__device__ __forceinline__ unsigned xb_add(unsigned* p, unsigned v) { return __hip_atomic_fetch_add(p, v, __ATOMIC_RELAXED, __HIP_MEMORY_SCOPE_AGENT); }
__device__ __forceinline__ unsigned xb_xcc_id() { return (unsigned)__builtin_amdgcn_s_getreg((3 << 11) | 20) & 0xFu; }
#define XB_SPIN(cond, bar) do { unsigned _sp = 0; while (cond) { __builtin_amdgcn_s_sleep(1); \
    if ((++_sp & 255u) == 0u) { if (xb_ld(&(bar)[XB_TMO])) break; if (_sp > XB_SPIN_CAP) { atomicAdd(&(bar)[XB_TMO], 1u); break; } } } } while (0)
__device__ __forceinline__ void xcd_barrier_post(unsigned* bar) { if (opaque_tid() == 0) (void)xb_add(&bar[XB_XCNT(xb_xcc_id())], 1u); }
__device__ __forceinline__ void xcd_barrier_complete(unsigned* bar, unsigned x, unsigned& nloc, unsigned& nx) {
    const unsigned G = gridDim.x;
    unsigned sum, cnt, mine, sp = 0u;
    for (;;) {
        sum = 0u; cnt = 0u; mine = 0u;
#pragma unroll
        for (unsigned j = 0; j < 16; ++j) { const unsigned c = xb_ld(&bar[XB_XCNT(j)]); sum += c; cnt += (c > 0u) ? 1u : 0u; mine = (j == x) ? c : mine; }
        if (sum == G) break;
        __builtin_amdgcn_s_sleep(1);
        if ((++sp & 255u) == 0u) { if (xb_ld(&bar[XB_TMO])) break; if (sp > XB_SPIN_CAP) { atomicAdd(&bar[XB_TMO], 1u); break; } }
    }
    nloc = mine > 0u ? mine : 1u; nx = cnt > 0u ? cnt : 1u;
}
__device__ __forceinline__ void xcd_barrier(unsigned* bar, volatile LAS unsigned* st) {
    asm volatile("s_waitcnt vmcnt(0)" ::: "memory");
    __syncthreads();
    if (opaque_tid() == 0) {
        const unsigned x = xb_xcc_id();
        __builtin_amdgcn_s_waitcnt(0);
        unsigned nloc = st[0], nx = st[1];
        if (nloc == 0u) { xcd_barrier_complete(bar, x, nloc, nx); st[0] = nloc; st[1] = nx; }
        const unsigned old = xb_add(&bar[XB_XSUB(x)], 1u);
        const unsigned gen = old / nloc;
        if (old + 1u == (gen + 1u) * nloc) {
            __builtin_amdgcn_fence(__ATOMIC_RELEASE, "agent");
            asm volatile("s_waitcnt vmcnt(0)" ::: "memory");
            const unsigned og = xb_add(&bar[XB_TOP], 1u);
            const unsigned tg = og / nx;
            if (og + 1u == (tg + 1u) * nx) xb_add(&bar[XB_TOPGEN], 1u);
            else XB_SPIN(xb_ld(&bar[XB_TOPGEN]) == tg, bar);
            __builtin_amdgcn_fence(__ATOMIC_ACQUIRE, "agent");
            xb_add(&bar[XB_XGEN(x)], 1u);
            asm volatile("s_waitcnt vmcnt(0)" ::: "memory");
        } else {
            XB_SPIN(xb_ld(&bar[XB_XGEN(x)]) == gen, bar);
            __builtin_amdgcn_fence(__ATOMIC_ACQUIRE, "agent");
            asm volatile("s_waitcnt vmcnt(0)" ::: "memory");
        }
    }
    __syncthreads();
}

namespace pg8 {
constexpr int BM = 256, BK = 64, HALF = 128, HTB = HALF * BK * 2, STAGE_BYTES = 8 * HTB, NXCD = 8, WGM = 8;
__device__ __forceinline__ int lds_byte(int r, int c) { const int st = (r >> 4) * 2 + (c >> 5), rr = r & 15, cc = c & 31, ob = rr * 64 + cc * 2; return st * 1024 + (ob ^ (((ob >> 9) & 1) << 5)); }
__device__ __forceinline__ void stage_rc(int b, int& R, int& C) { const int st = b / 1024, sb = b % 1024, swz = sb ^ (((sb >> 9) & 1) << 5); R = (st >> 1) * 16 + swz / 64; C = (st & 1) * 32 + (swz % 64) / 2; }
__device__ __forceinline__ int perm32(int rho) { const int n = rho >> 4, i = rho & 15; return 8 * (i >> 2) + 4 * n + (i & 3); }
struct Unit { int pm, pn; };
struct Gemm { const bf16_t* A; const bf16_t* Bt; int M, N, K, lda, ldb; };
struct StaticOrder {
    int nM, nN, nwg, G, c;
    __device__ void init(int M, int N, int G_, int c_) { nM = M / BM; nN = N / BM; nwg = nM * nN; G = G_; c = c_; }
    __device__ bool next(int i, Unit& u) const {
        const long L = (long)i * G + c; if (L >= nwg) return false;
        int wgid = (int)L; { const int q = nwg / NXCD, r = nwg % NXCD, xcd = wgid % NXCD, off = wgid / NXCD; wgid = (xcd < r ? xcd * (q + 1) : r * (q + 1) + (xcd - r) * q) + off; }
        const int nig = WGM * nN, gid = wgid / nig, fm = gid * WGM, gsz = (nM - fm) < WGM ? (nM - fm) : WGM;
        u.pm = fm + ((wgid % nig) % gsz); u.pn = (wgid % nig) / gsz; return true;
    }
};

struct SingleUnit {
    int pm, pn; bool has;
    __device__ bool next(int i, Unit& u) const { if (i > 0 || !has) return false; u.pm = pm; u.pn = pn; return true; }
};
template <class Epi, class Sched>
__device__ __forceinline__ void gemm_phase(LAS unsigned char* lds, const Gemm g, const Sched& S, const Epi& E) {
    const int tid = opaque_tid(), wid = __builtin_amdgcn_readfirstlane(tid >> 6), lane = tid & 63, wr = wid >> 2, wc = wid & 3, fr = lane & 15, fq = lane >> 4;
    const int K = g.K, nt = K / BK;
    unsigned voffA[2], voffB[2];
#pragma unroll
    for (int i = 0; i < 2; ++i) { int R, C; stage_rc(tid * 16 + i * 8192, R, C); const int Rb = Epi::PERM ? ((R & ~31) + perm32(R & 31)) : R;
        voffA[i] = (unsigned)(R * g.lda + C) * 2u; voffB[i] = (unsigned)(Rb * g.ldb + C) * 2u; }
    const size_t kstep = (size_t)(BK * 2);
    const size_t hstepA = (size_t)HALF * g.lda * 2, hstepB = (size_t)HALF * g.ldb * 2;
    const size_t tstepA = 2 * hstepA, tstepB = 2 * hstepB;
    const unsigned ldsw = (unsigned)wid * 1024u;
    const int aoff = lds_byte(wr * 64 + fr, fq * 8), boff = lds_byte(wc * 32 + fr, fq * 8);
#define PG8_SA(b, h) (((b) * 2 + (h)) * HTB)
#define PG8_SB(b, h) ((4 + (b) * 2 + (h)) * HTB)
#define PG8_STAGE(bufoff, gbase, voff) do { _Pragma("unroll") for (int _i = 0; _i < 2; ++_i) \
        __builtin_amdgcn_global_load_lds((const unsigned*)((const char*)(gbase) + (voff)[_i]), (LAS unsigned*)(lds + (bufoff) + ldsw + _i * 8192), 16, 0, 0); } while (0)
#define PG8_LDA(dst, b, h) do { _Pragma("unroll") for (int m = 0; m < 4; ++m) _Pragma("unroll") for (int k = 0; k < 2; ++k) dst[m][k] = *(const LAS bf16x8*)(lds + PG8_SA(b, h) + aoff + m * 2048 + k * 1024); } while (0)
#define PG8_LDB(dst, b, h) do { _Pragma("unroll") for (int n = 0; n < 2; ++n) _Pragma("unroll") for (int k = 0; k < 2; ++k) dst[n][k] = *(const LAS bf16x8*)(lds + PG8_SB(b, h) + boff + n * 2048 + k * 1024); } while (0)
#define PG8_MMA(ai, bj, At, Bt) do { __builtin_amdgcn_s_setprio(1); _Pragma("unroll") for (int m = 0; m < 4; ++m) _Pragma("unroll") for (int n = 0; n < 2; ++n) _Pragma("unroll") for (int k = 0; k < 2; ++k) \
        acc[ai][bj][m][n] = __builtin_amdgcn_mfma_f32_16x16x32_bf16(Bt[n][k], At[m][k], acc[ai][bj][m][n], 0, 0, 0); __builtin_amdgcn_s_setprio(0); } while (0)
#define PG8_WAIT_V(n) asm volatile("s_waitcnt vmcnt(" #n ")" ::: "memory")
#define PG8_WAIT_L(n) asm volatile("s_waitcnt lgkmcnt(" #n ")" ::: "memory")
#define PG8_BAR __builtin_amdgcn_s_barrier()
#define PG8_SCHED __builtin_amdgcn_sched_barrier(0)
    Unit cur, nxt; int ui = 0;
    if (!S.next(0, cur)) return;
    f32x4 acc[2][2][4][2];
#pragma unroll
    for (int a = 0; a < 2; ++a)
#pragma unroll
        for (int b = 0; b < 2; ++b)
#pragma unroll
            for (int m = 0; m < 4; ++m)
#pragma unroll
                for (int n = 0; n < 2; ++n) acc[a][b][m][n] = (f32x4){0.f, 0.f, 0.f, 0.f};
    bf16x8 At[4][2], B0[2][2], B1[2][2];
    const char* cA = (const char*)g.A + (size_t)cur.pm * tstepA; const char* cB = (const char*)g.Bt + (size_t)cur.pn * tstepB;
    PG8_STAGE(PG8_SB(0, 0), cB, voffB); PG8_STAGE(PG8_SA(0, 0), cA, voffA); PG8_STAGE(PG8_SB(0, 1), cB + hstepB, voffB); PG8_STAGE(PG8_SA(0, 1), cA + hstepA, voffA);
    if (wr == 1) PG8_BAR;
    PG8_WAIT_V(4); PG8_BAR;
    PG8_STAGE(PG8_SB(1, 0), cB + kstep, voffB); PG8_STAGE(PG8_SA(1, 0), cA + kstep, voffA); PG8_STAGE(PG8_SB(1, 1), cB + hstepB + kstep, voffB);
    PG8_WAIT_V(6); PG8_BAR;
    for (;;) {
        const bool has_next = S.next(ui + 1, nxt);
        const char* nA = has_next ? (const char*)g.A + (size_t)nxt.pm * tstepA : cA; const char* nB = has_next ? (const char*)g.Bt + (size_t)nxt.pn * tstepB : cB;
        for (int t = 0; t < nt; t += 2) {
            const bool last = (t == nt - 2);
            const char* a1 = cA + (size_t)(t + 1) * kstep;
            const char* a2 = last ? nA : cA + (size_t)(t + 2) * kstep; const char* b2 = last ? nB : cB + (size_t)(t + 2) * kstep;
            const char* a3 = a2 + kstep; const char* b3 = b2 + kstep;
            PG8_LDB(B0, 0, 0); PG8_SCHED; PG8_LDA(At, 0, 0); PG8_STAGE(PG8_SA(1, 1), a1 + hstepA, voffA);
            PG8_WAIT_L(8); PG8_BAR; PG8_WAIT_L(0); PG8_MMA(0, 0, At, B0); PG8_BAR; PG8_SCHED;
            PG8_LDB(B1, 0, 1); PG8_STAGE(PG8_SB(0, 0), b2, voffB);
            PG8_BAR; PG8_WAIT_L(0); PG8_MMA(0, 1, At, B1); PG8_BAR;
            PG8_LDA(At, 0, 1); PG8_STAGE(PG8_SA(0, 0), a2, voffA);
            PG8_BAR; PG8_WAIT_L(0); PG8_MMA(1, 0, At, B0); PG8_BAR; PG8_SCHED;
            PG8_STAGE(PG8_SB(0, 1), b2 + hstepB, voffB);
            PG8_WAIT_V(6); PG8_BAR; PG8_MMA(1, 1, At, B1); PG8_BAR;
            PG8_LDB(B0, 1, 0); PG8_SCHED; PG8_LDA(At, 1, 0); PG8_STAGE(PG8_SA(0, 1), a2 + hstepA, voffA);
            PG8_WAIT_L(8); PG8_BAR; PG8_WAIT_L(0); PG8_MMA(0, 0, At, B0); PG8_BAR; PG8_SCHED;
            PG8_LDB(B1, 1, 1); PG8_STAGE(PG8_SB(1, 0), b3, voffB);
            PG8_BAR; PG8_WAIT_L(0); PG8_MMA(0, 1, At, B1); PG8_BAR;
            PG8_LDA(At, 1, 1); PG8_STAGE(PG8_SA(1, 0), a3, voffA);
            PG8_BAR; PG8_WAIT_L(0); PG8_MMA(1, 0, At, B0); PG8_BAR; PG8_SCHED;
            PG8_STAGE(PG8_SB(1, 1), b3 + hstepB, voffB);
            PG8_WAIT_V(6); PG8_BAR; PG8_MMA(1, 1, At, B1); PG8_BAR;
            if constexpr (Epi::HOOK) { if ((((t + 2) & 3) == 0) && !last) E.hook(acc, cur, (t + 2) >> 2, wr, wc, fr, fq); }
        }
        E(acc, cur, wr, wc, fr, fq);
        if (!has_next) break;
#pragma unroll
        for (int a = 0; a < 2; ++a)
#pragma unroll
            for (int b = 0; b < 2; ++b)
#pragma unroll
                for (int m = 0; m < 4; ++m)
#pragma unroll
                    for (int n = 0; n < 2; ++n) acc[a][b][m][n] = (f32x4){0.f, 0.f, 0.f, 0.f};
        cur = nxt; cA = nA; cB = nB; ++ui;
    }
    PG8_WAIT_V(0);
    if (wr == 0) PG8_BAR;
    PG8_BAR;
#undef PG8_SA
#undef PG8_SB
#undef PG8_STAGE
#undef PG8_LDA
#undef PG8_LDB
#undef PG8_MMA
#undef PG8_WAIT_V
#undef PG8_WAIT_L
#undef PG8_BAR
#undef PG8_SCHED
}
}
using pg8::Unit;

__device__ __forceinline__ size_t g8_off(int row, int colg) { return ((size_t)(row >> 4) * 128 + (colg >> 5)) * 512 + (row & 15) * 32 + (colg & 31); }

struct EpiSwiglu {
    static constexpr bool HOOK = false;
    static constexpr bool PERM = true;
    bf16_t* HID;
    __device__ __forceinline__ void operator()(const f32x4 (&acc)[2][2][4][2], const Unit& u, int wr, int wc, int fr, int fq) const {
        { const int t_ = opaque_tid(); wr = t_ >> 8; wc = (t_ >> 6) & 3; fr = t_ & 15; fq = (t_ >> 4) & 3; }
        const int row0 = u.pm * 256 + wr * 64 + fr, col0 = u.pn * 128 + wc * 32 + 8 * fq;
#pragma unroll
        for (int ai = 0; ai < 2; ++ai)
#pragma unroll
            for (int m = 0; m < 4; ++m) {
                const int row = row0 + ai * 128 + m * 16;
                float hv[8];
#pragma unroll
                for (int n = 0; n < 2; ++n)
#pragma unroll
                    for (int j = 0; j < 4; ++j) { const float a = acc[ai][0][m][n][j], b = acc[ai][1][m][n][j]; hv[4 * n + j] = a * sigmoidf_(a) * b; }
                u32x4 w; w.x = cvt_pk_bf16(hv[0], hv[1]); w.y = cvt_pk_bf16(hv[2], hv[3]); w.z = cvt_pk_bf16(hv[4], hv[5]); w.w = cvt_pk_bf16(hv[6], hv[7]);
                *(u32x4*)(HID + (size_t)row * FH + col0) = w;
            }
    }
};
struct EpiResid {
    static constexpr bool HOOK = false;
    static constexpr bool PERM = false;
    float* Hl; float* Hc; const float* gate; float coef;
    __device__ __forceinline__ void operator()(const f32x4 (&acc)[2][2][4][2], const Unit& u, int wr, int wc, int fr, int fq) const {
        { const int t_ = opaque_tid(); wr = t_ >> 8; wc = (t_ >> 6) & 3; fr = t_ & 15; fq = (t_ >> 4) & 3; }
        const int row0 = u.pm * 256 + wr * 64 + fr, col0 = u.pn * 256 + wc * 32 + 4 * fq;
#pragma unroll
        for (int ai = 0; ai < 2; ++ai)
#pragma unroll
            for (int m = 0; m < 4; ++m) {
                const int row = row0 + ai * 128 + m * 16;
                float* hp = row < RL ? Hl + (size_t)row * 1024 : Hc + (size_t)(row - RL) * 1024;
                const float* gp = gate + (row < RL ? (row >> 13) : 4) * 9216;
#pragma unroll
                for (int bj = 0; bj < 2; ++bj)
#pragma unroll
                    for (int n = 0; n < 2; ++n) {
                        const int c = col0 + bj * 128 + n * 16;
                        const f32x4 g4 = *(const f32x4*)(gp + c); f32x4 h4 = *(const f32x4*)(hp + c);
                        h4 += (g4 * coef) * acc[ai][bj][m][n];
                        *(f32x4*)(hp + c) = h4;
                    }
            }
    }
};
struct EpiPartial {
    static constexpr bool HOOK = false;
    static constexpr bool PERM = false;
    float* PB; const float* gate; float coef;
    __device__ __forceinline__ void operator()(const f32x4 (&acc)[2][2][4][2], const Unit& u, int wr, int wc, int fr, int fq) const {
        { const int t_ = opaque_tid(); wr = t_ >> 8; wc = (t_ >> 6) & 3; fr = t_ & 15; fq = (t_ >> 4) & 3; }
        const int row0 = u.pm * 256 + wr * 64 + fr - RL, col0 = u.pn * 256 + wc * 32 + 4 * fq;
#pragma unroll
        for (int ai = 0; ai < 2; ++ai)
#pragma unroll
            for (int m = 0; m < 4; ++m) {
                float* hp = PB + (size_t)(row0 + ai * 128 + m * 16) * 1024;
#pragma unroll
                for (int bj = 0; bj < 2; ++bj)
#pragma unroll
                    for (int n = 0; n < 2; ++n) {
                        const int c = col0 + bj * 128 + n * 16;
                        const f32x4 g4 = *(const f32x4*)(gate + c);
                        *(f32x4*)(hp + c) = (g4 * coef) * acc[ai][bj][m][n];
                    }
            }
    }
};
struct EpiPJ {
    static constexpr bool HOOK = false;
    static constexpr bool PERM = true;
    bf16_t* PJ; unsigned char* G8;
    __device__ __forceinline__ void operator()(const f32x4 (&acc)[2][2][4][2], const Unit& u, int wr, int wc, int fr, int fq) const {
        { const int t_ = opaque_tid(); wr = t_ >> 8; wc = (t_ >> 6) & 3; fr = t_ & 15; fq = (t_ >> 4) & 3; }
        const int row0 = u.pm * 256 + wr * 64 + fr, c0 = wc * 32 + 8 * fq;
        if (u.pn < 9) {
#pragma unroll
            for (int ai = 0; ai < 2; ++ai)
#pragma unroll
                for (int m = 0; m < 4; ++m) {
                    const int row = row0 + ai * 128 + m * 16;
#pragma unroll
                    for (int bj = 0; bj < 2; ++bj) {
                        const f32x4 v0 = acc[ai][bj][m][0], v1 = acc[ai][bj][m][1];
                        u32x4 w; w.x = cvt_pk_bf16(v0[0], v0[1]); w.y = cvt_pk_bf16(v0[2], v0[3]); w.z = cvt_pk_bf16(v1[0], v1[1]); w.w = cvt_pk_bf16(v1[2], v1[3]);
                        *(u32x4*)(PJ + (size_t)row * PJW + u.pn * 256 + bj * 128 + c0) = w;
                    }
                }
        } else {
#pragma unroll
            for (int ai = 0; ai < 2; ++ai)
#pragma unroll
                for (int m = 0; m < 4; ++m) {
                    const int row = row0 + ai * 128 + m * 16;
#pragma unroll
                    for (int bj = 0; bj < 2; ++bj) {
                        unsigned q[8];
#pragma unroll
                        for (int n = 0; n < 2; ++n)
#pragma unroll
                            for (int j = 0; j < 4; ++j) { int v = (int)(sigmoidf_(acc[ai][bj][m][n][j]) * 256.0f); q[4 * n + j] = (unsigned)(v > 255 ? 255 : v); }
                        u32x2 w; w.x = q[0] | (q[1] << 8) | (q[2] << 16) | (q[3] << 24); w.y = q[4] | (q[5] << 8) | (q[6] << 16) | (q[7] << 24);
                        *(u32x2*)(G8 + g8_off(row, (u.pn - 9) * 256 + bj * 128 + c0)) = w;
                    }
                }
        }
    }
};
struct EpiMLA {
    static constexpr bool HOOK = false;
    static constexpr bool PERM = true;
    bf16_t *MQ, *MK, *MV; const float* RSTD; const float2* RT;
    __device__ __forceinline__ void operator()(const f32x4 (&acc)[2][2][4][2], const Unit& u, int wr, int wc, int fr, int fq) const {
        { const int t_ = opaque_tid(); wr = t_ >> 8; wc = (t_ >> 6) & 3; fr = t_ & 15; fq = (t_ >> 4) & 3; }
        const int row0 = u.pm * 256 + wr * 64 + fr;
#pragma unroll
        for (int bj = 0; bj < 2; ++bj) {
            const int cg0 = u.pn * 256 + bj * 128 + wc * 32;
            if (cg0 >= 896) continue;
#pragma unroll
            for (int ai = 0; ai < 2; ++ai)
#pragma unroll
                for (int m = 0; m < 4; ++m) {
                    __builtin_amdgcn_sched_barrier(0);
                    const int row = row0 + ai * 128 + m * 16;
                    float v[8];
                    if (cg0 < 384) {
                        const float rs = RSTD[row * 2];
#pragma unroll
                        for (int n = 0; n < 2; ++n)
#pragma unroll
                            for (int j = 0; j < 4; ++j) v[4 * n + j] = acc[ai][bj][m][n][j] * rs;
                        const int d0 = cg0 % 96;
                        if (d0 == 64) {
                            const bool lat = row < RL; const int t = row & 8191; const int pos = (fq >> 1) ? (t & 63) : (t >> 6); const bool isx2 = fq & 1;
#pragma unroll
                            for (int e = 0; e < 8; ++e) {
                                const float pr = shflx(v[e], 16);
                                const float2 cs = RT[pos * 8 + e];
                                const float r = isx2 ? (pr * cs.y + v[e] * cs.x) : (v[e] * cs.x - pr * cs.y);
                                v[e] = lat ? r : v[e];
                            }
                        }
                        u32x4 w; w.x = cvt_pk_bf16(v[0], v[1]); w.y = cvt_pk_bf16(v[2], v[3]); w.z = cvt_pk_bf16(v[4], v[5]); w.w = cvt_pk_bf16(v[6], v[7]);
                        *(u32x4*)(MQ + (size_t)row * 384 + cg0 + 8 * fq) = w;
                    } else {
                        const float rs = RSTD[row * 2 + 1];
#pragma unroll
                        for (int n = 0; n < 2; ++n)
#pragma unroll
                            for (int j = 0; j < 4; ++j) v[4 * n + j] = acc[ai][bj][m][n][j] * rs;
                        const int cp = cg0 - 384, hd = cp >> 7, d0 = cp & 127;
                        u32x4 w; w.x = cvt_pk_bf16(v[0], v[1]); w.y = cvt_pk_bf16(v[2], v[3]); w.z = cvt_pk_bf16(v[4], v[5]); w.w = cvt_pk_bf16(v[6], v[7]);
                        if (d0 < 64) *(u32x4*)(MK + (size_t)row * 384 + hd * 96 + d0 + 8 * fq) = w;
                        else *(u32x4*)(MV + (size_t)row * 256 + hd * 64 + (d0 - 64) + 8 * fq) = w;
                    }
                }
        }
    }
};
struct EpiMerge {
    static constexpr bool PERM = true, HOOK = true;
    const unsigned char* G8; bf16_t* MG;
    __device__ __forceinline__ void hook(f32x4 (&acc)[2][2][4][2], const Unit& u, int nb, int wr, int wc, int fr, int fq) const {
        { const int t_ = opaque_tid(); wr = t_ >> 8; wc = (t_ >> 6) & 3; fr = t_ & 15; fq = (t_ >> 4) & 3; }
        const int row0 = u.pm * 256 + wr * 64 + fr, c0 = u.pn * 256 + wc * 32 + 8 * fq;
#pragma unroll
        for (int ai = 0; ai < 2; ++ai) {
            u32x2 ga[4][2], gb[4][2];
#pragma unroll
            for (int m = 0; m < 4; ++m)
#pragma unroll
                for (int bj = 0; bj < 2; ++bj) { const int row = row0 + ai * 128 + m * 16, c = c0 + bj * 128;
                    ga[m][bj] = *(const u32x2*)(G8 + g8_off(row, (nb - 1) * 1024 + c)); gb[m][bj] = *(const u32x2*)(G8 + g8_off(row, nb * 1024 + c)); }
#pragma unroll
            for (int m = 0; m < 4; ++m)
#pragma unroll
                for (int bj = 0; bj < 2; ++bj)
#pragma unroll
                    for (int e = 0; e < 8; ++e) { const unsigned qa = ((e < 4 ? ga[m][bj].x : ga[m][bj].y) >> (8 * (e & 3))) & 255u, qb = ((e < 4 ? gb[m][bj].x : gb[m][bj].y) >> (8 * (e & 3))) & 255u;
                        acc[ai][bj][m][e >> 2][e & 3] *= ((float)qa + 0.5f) * fast_rcp((float)qb + 0.5f); }
            __builtin_amdgcn_sched_barrier(0);
        }
    }
    __device__ __forceinline__ void operator()(const f32x4 (&acc)[2][2][4][2], const Unit& u, int wr, int wc, int fr, int fq) const {
        { const int t_ = opaque_tid(); wr = t_ >> 8; wc = (t_ >> 6) & 3; fr = t_ & 15; fq = (t_ >> 4) & 3; }
        const int row0 = u.pm * 256 + wr * 64 + fr, c0 = u.pn * 256 + wc * 32 + 8 * fq;
#pragma unroll
        for (int ai = 0; ai < 2; ++ai) {
            u32x2 gq[4][2];
#pragma unroll
            for (int m = 0; m < 4; ++m)
#pragma unroll
                for (int bj = 0; bj < 2; ++bj) gq[m][bj] = *(const u32x2*)(G8 + g8_off(row0 + ai * 128 + m * 16, 3 * 1024 + c0 + bj * 128));
#pragma unroll
            for (int m = 0; m < 4; ++m)
#pragma unroll
                for (int bj = 0; bj < 2; ++bj) {
                    const int row = row0 + ai * 128 + m * 16, c = c0 + bj * 128;
                    float v[8];
#pragma unroll
                    for (int e = 0; e < 8; ++e) { const unsigned q = ((e < 4 ? gq[m][bj].x : gq[m][bj].y) >> (8 * (e & 3))) & 255u; v[e] = ((float)q + 0.5f) * (1.0f / 256.0f) * acc[ai][bj][m][e >> 2][e & 3]; }
                    u32x4 w; w.x = cvt_pk_bf16(v[0], v[1]); w.y = cvt_pk_bf16(v[2], v[3]); w.z = cvt_pk_bf16(v[4], v[5]); w.w = cvt_pk_bf16(v[6], v[7]);
                    *(u32x4*)(MG + (size_t)row * 1024 + c) = w;
                }
            __builtin_amdgcn_sched_barrier(0);
        }
    }
};

template <class F>
__device__ __forceinline__ void wt_rows64(bf16_t* dst, int K, F srcval, int ldd, int kbeg, int kend) {
    if (ldd == 0) ldd = K;
    if (kend > K) kend = K;
    const int tid_ = opaque_tid(); const int nl = tid_ & 63, kq = tid_ >> 6;
    for (int k0 = kbeg + kq * 8; k0 < kend; k0 += 64) {
        float v[8];
#pragma unroll
        for (int j = 0; j < 8; ++j) v[j] = srcval(nl, k0 + j);
        u32x4 w; w.x = cvt_pk_bf16(v[0], v[1]); w.y = cvt_pk_bf16(v[2], v[3]); w.z = cvt_pk_bf16(v[4], v[5]); w.w = cvt_pk_bf16(v[6], v[7]);
        *(u32x4*)(dst + (size_t)nl * ldd + k0) = w;
    }
}

__device__ void layer_prep_phase(PK p, int l, LAS unsigned char* lds) {
    unsigned char* ws = p->ws;
    const int nW = 1648, nItems = nW + (l == 0 ? 288 + 1 : 0);
    for (int it2 = opaque_bid(); it2 < nItems; it2 += opaque_gdim()) {
        int it, kbeg = 0, kend = 1 << 30;
        if (it2 < 704) { it = it2 >> 2; kbeg = (it2 & 3) * 256; kend = kbeg + 256; }
        else if (it2 < 1056) { const int q = it2 - 704; it = 176 + q / 11; kbeg = (q % 11) * 256; kend = kbeg + 256; }
        else if (it2 < 1456) { const int q = it2 - 1056; it = 208 + (q >> 2); kbeg = (q & 3) * 256; kend = kbeg + 256; }
        else if (it2 < 1520) { const int q = it2 - 1456; it = 308 + (q >> 2); kbeg = (q & 3) * 256; kend = kbeg + 256; }
        else if (it2 < 1568) { it = 324 + (it2 - 1520); }
        else if (it2 < 1632) { const int q = it2 - 1568; it = 372 + (q >> 2); kbeg = (q & 3) * 64; kend = kbeg + 64; }
        else if (it2 < 1648) { it = 388 + (it2 - 1632); }
        else it = 404 + (it2 - 1648);
        if (it < 176) {
            const int f = it / 88, j = it % 88; const float* src = p->ffn_w_in + ((size_t)(l * 2 + f) * 1024) * 5632;
            bf16_t* dst = (bf16_t*)(ws + OFF_W1) + ((size_t)f * 5632 + j * 64) * 1024;
            wt_rows64(dst, 1024, [&](int nl, int k) { const int np = j * 64 + nl, pn = np >> 8, wi = np & 255; const int col = wi < 128 ? pn * 128 + wi : FH + pn * 128 + (wi - 128); return src[(size_t)k * 5632 + col]; }, 0, kbeg, kend);
        } else if (it < 208) {
            const int q = it - 176, f = q / 16, j = q % 16; const float* src = p->ffn_w_out + ((size_t)(l * 2 + f) * FH) * 1024;
            bf16_t* dst = (bf16_t*)(ws + OFF_W2) + ((size_t)f * 1024 + j * 64) * FH;
            wt_rows64(dst, FH, [&](int nl, int k) { return src[(size_t)k * 1024 + j * 64 + nl]; }, 0, kbeg, kend);
        } else if (it < 308) {
            const int j = it - 208; const float* src = p->mix_w_in + (size_t)l * 1024 * 6304;
            bf16_t* dst = (bf16_t*)(ws + OFF_WM) + (size_t)j * 64 * 1024;
            wt_rows64(dst, 1024, [&](int nl, int k) { const int np = j * 64 + nl; const int col = np < 2208 ? np : (np < 2304 ? -1 : np - 96); return col < 0 ? 0.f : src[(size_t)k * 6304 + col]; }, 0, kbeg, kend);
        } else if (it < 324) {
            const int j = it - 308; const float* src = p->mix_w_out + (size_t)l * 1024 * 1024;
            bf16_t* dst = (bf16_t*)(ws + OFF_WO) + (size_t)j * 64 * 1024;
            wt_rows64(dst, 1024, [&](int nl, int k) { return src[(size_t)k * 1024 + j * 64 + nl]; }, 0, kbeg, kend);
        } else if (it < 372) {
            const int q = it - 324, bi = 1 + q / 16, j = q % 16; const float* src = p->branch_w_out + ((size_t)(l * 4 + bi) * 256) * 1024;
            bf16_t* dst = (bf16_t*)(ws + OFF_WB) + (size_t)j * 64 * 1024 + bi * 256;
            wt_rows64(dst, 256, [&](int nl, int k) { return src[(size_t)k * 1024 + j * 64 + nl]; }, 1024, kbeg, kend);
        } else if (it < 388) {
            const int j = it - 372; const float* wb = p->branch_w_out + ((size_t)(l * 4) * 256) * 1024; const float* pw = p->pool_w + (size_t)l * 4 * 64 * 64; const float* ps = p->pool_scale + l * 256;
            bf16_t* dst = (bf16_t*)(ws + OFF_WB) + (size_t)j * 64 * 1024;
            wt_rows64(dst, 256, [&](int nl, int k) { const int gI = k >> 6, n = j * 64 + nl; const float* pr = pw + (size_t)k * 64; float s = 0.f;
                for (int e = 0; e < 64; ++e) s += pr[e] * ps[gI * 64 + e] * wb[(size_t)(gI * 64 + e) * 1024 + n]; return s; }, 1024, kbeg, kend);
        } else if (it < 404) {
            const int j = it - 388; const float* wq = p->mla_w_qb + (size_t)l * 256 * 384; const float* wk = p->mla_w_kvb + (size_t)l * 128 * 512;
            const float* gq = p->mla_q_norm_g + l * 256; const float* gk = p->mla_kv_norm_g + l * 128;
            bf16_t* dst = (bf16_t*)(ws + OFF_WL) + (size_t)j * 64 * 384;
            wt_rows64(dst, 384, [&](int nl, int k) { const int n = j * 64 + nl;
                if (n < 384) return k < 256 ? gq[k] * wq[(size_t)k * 384 + n] : 0.f;
                if (n < 896) return k >= 256 ? gk[k - 256] * wk[(size_t)(k - 256) * 512 + (n - 384)] : 0.f;
                return 0.f; }, 0, kbeg, kend);
        } else if (it < 404 + 288) {
            const int q = it - 404, ll = q / 144, cb = q % 144;
            LAS float* sc = (LAS float*)lds;
            LAS float* red = (LAS float*)(lds + 5 * 1024 * 4);
            __syncthreads();
            for (int i = opaque_tid(); i < 5 * 1024; i += 512) { const int r = i >> 10, k = i & 1023; const float cv = r < 4 ? p->c[r * 1024 + k] : p->c_ctx[k]; sc[i] = cv * sigmoidf_(cv); }
            __syncthreads();
            const int jl = opaque_tid() & 63, kg = opaque_tid() >> 6; const int col = cb * 64 + jl;
            const float* wsrc = p->ada_w + (size_t)ll * 1024 * 9216 + col;
            float a0 = 0.f, a1 = 0.f, a2 = 0.f, a3 = 0.f, a4 = 0.f;
            for (int k = kg * 128; k < kg * 128 + 128; ++k) { const float wv = wsrc[(size_t)k * 9216]; a0 += sc[k] * wv; a1 += sc[1024 + k] * wv; a2 += sc[2048 + k] * wv; a3 += sc[3072 + k] * wv; a4 += sc[4096 + k] * wv; }
            red[(kg * 5 + 0) * 64 + jl] = a0; red[(kg * 5 + 1) * 64 + jl] = a1; red[(kg * 5 + 2) * 64 + jl] = a2; red[(kg * 5 + 3) * 64 + jl] = a3; red[(kg * 5 + 4) * 64 + jl] = a4;
            __syncthreads();
            if (opaque_tid() < 320) { const int r = opaque_tid() >> 6; float s = p->ada_b[ll * 9216 + col];
                for (int q2 = 0; q2 < 8; ++q2) s += red[(q2 * 5 + r) * 64 + jl];
                ((float*)(ws + OFF_MOD))[(size_t)(ll * 5 + r) * 9216 + col] = s; }
        } else {
            for (int i = opaque_tid(); i < 1024; i += 512) { const int pos = i >> 3, fi = i & 7; const float inv = exp2f(-(float)fi * 0.125f * 13.287712379549449f); const float ang = (float)pos * inv;
                ((float2*)(ws + OFF_ROPE))[i] = make_float2(cosf(ang), sinf(ang)); }
        }
    }
}

__device__ void norm_mod_phase(const float* srcL, const float* srcC, float* cpyL, float* cpyC, const float* g, const float* mod, bf16_t* TN, int nrows, const float* pb, int nsl) {
    const int tid_ = opaque_tid(); const int lane = tid_ & 63, gw = opaque_bid() * 8 + (tid_ >> 6), nw = opaque_gdim() * 8;
    for (int row = gw; row < nrows; row += nw) {
        const bool lat = row < RL;
        const float* sp = lat ? srcL + (size_t)row * 1024 : srcC + (size_t)(row - RL) * 1024;
        const float* mp = mod + (lat ? (row >> 13) : 4) * 9216;
        f32x4 v[4]; float ss = 0.f;
#pragma unroll
        for (int j = 0; j < 4; ++j) v[j] = *(const f32x4*)(sp + 256 * j + 4 * lane);
        if (!lat && nsl > 0) {
            for (int sl = 0; sl < nsl; ++sl) { const float* pp = pb + ((size_t)sl * 1024 + (row - RL)) * 1024;
#pragma unroll
                for (int j = 0; j < 4; ++j) v[j] += *(const f32x4*)(pp + 256 * j + 4 * lane); }
            float* wp = (float*)sp;
#pragma unroll
            for (int j = 0; j < 4; ++j) *(f32x4*)(wp + 256 * j + 4 * lane) = v[j];
        }
#pragma unroll
        for (int j = 0; j < 4; ++j) ss += v[j][0] * v[j][0] + v[j][1] * v[j][1] + v[j][2] * v[j][2] + v[j][3] * v[j][3];
        if (cpyL) { float* cp = lat ? cpyL + (size_t)row * 1024 : cpyC + (size_t)(row - RL) * 1024;
#pragma unroll
            for (int j = 0; j < 4; ++j) *(f32x4*)(cp + 256 * j + 4 * lane) = v[j]; }
        ss = wave_sum(ss);
        const float rstd = rsqrtf(ss * (1.0f / 1024.0f) + NEPS);
#pragma unroll
        for (int j = 0; j < 4; ++j) {
            const int col = 256 * j + 4 * lane;
            const f32x4 gg = *(const f32x4*)(g + col), sh = *(const f32x4*)(mp + col), sc = *(const f32x4*)(mp + 1024 + col);
            float o[4];
#pragma unroll
            for (int e = 0; e < 4; ++e) o[e] = (v[j][e] * rstd * gg[e]) * (1.0f + sc[e]) + sh[e];
            u32x2 w; w.x = cvt_pk_bf16(o[0], o[1]); w.y = cvt_pk_bf16(o[2], o[3]);
            *(u32x2*)(TN + (size_t)row * 1024 + col) = w;
        }
    }
}
__device__ void final_norm_phase(float* H, const float* g) {
    const int tid_ = opaque_tid(); const int lane = tid_ & 63, gw = opaque_bid() * 8 + (tid_ >> 6), nw = opaque_gdim() * 8;
    for (int row = gw; row < RL; row += nw) {
        float* sp = H + (size_t)row * 1024; f32x4 v[4]; float ss = 0.f;
#pragma unroll
        for (int j = 0; j < 4; ++j) { v[j] = *(const f32x4*)(sp + 256 * j + 4 * lane); ss += v[j][0] * v[j][0] + v[j][1] * v[j][1] + v[j][2] * v[j][2] + v[j][3] * v[j][3]; }
        ss = wave_sum(ss);
        const float rstd = rsqrtf(ss * (1.0f / 1024.0f) + NEPS);
#pragma unroll
        for (int j = 0; j < 4; ++j) { const f32x4 gg = *(const f32x4*)(g + 256 * j + 4 * lane); *(f32x4*)(sp + 256 * j + 4 * lane) = v[j] * rstd * gg; }
    }
}

__device__ void prep_phase(PK p) {
    unsigned char* ws = p->ws;
    bf16_t* PJ = (bf16_t*)(ws + OFF_B); bf16_t* YB = (bf16_t*)(ws + OFF_A); bf16_t* MK = (bf16_t*)(ws + OFF_MK); float* RSTD = (float*)(ws + OFF_RSTD);
    const float2* RT = (const float2*)(ws + OFF_ROPE);
    const int tid_ = opaque_tid(); const int lane = tid_ & 63, gw = opaque_bid() * 8 + (tid_ >> 6), nw = opaque_gdim() * 8;
    for (int row = gw; row < RA; row += nw) {
        const bool lat = row < RL;
        int t, n; if (lat) { t = row & 8191; n = 8192; } else { t = (row - RL) & 255; n = 256; }
        const int sbase = row - t;
        bf16_t* prow = PJ + (size_t)row * PJW;
        {
            const int wdw = 2 << (lane >> 4); const int lo = max(t - wdw / 2, 0), hi = min(t - wdw / 2 + wdw, n);
            float s0 = 0.f, s1 = 0.f, s2 = 0.f, s3 = 0.f;
            for (int tt = lo; tt < hi; ++tt) { const u32x2 v = *(const u32x2*)(PJ + (size_t)(sbase + tt) * PJW + 4 * lane); s0 += bf_lo(v.x); s1 += bf_hi(v.x); s2 += bf_lo(v.y); s3 += bf_hi(v.y); }
            const float ic = 1.0f / (float)(hi - lo); const u32x2 sv = *(const u32x2*)(prow + 4 * lane);
            u32x2 w; w.x = cvt_pk_bf16(s0 * ic - bf_lo(sv.x), s1 * ic - bf_hi(sv.x)); w.y = cvt_pk_bf16(s2 * ic - bf_lo(sv.y), s3 * ic - bf_hi(sv.y));
            *(u32x2*)(YB + (size_t)row * 1024 + 4 * lane) = w;
        }
        {
            const u32x2 q = *(const u32x2*)(prow + C_MQ + 4 * lane); const unsigned kv = *(const unsigned*)(prow + C_MKV + 2 * lane);
            float sq = bf_lo(q.x) * bf_lo(q.x) + bf_hi(q.x) * bf_hi(q.x) + bf_lo(q.y) * bf_lo(q.y) + bf_hi(q.y) * bf_hi(q.y);
            float sk = bf_lo(kv) * bf_lo(kv) + bf_hi(kv) * bf_hi(kv);
            sq = wave_sum(sq); sk = wave_sum(sk);
            if (lane == 0) { RSTD[row * 2] = rsqrtf(sq * (1.0f / 256.0f) + NEPS); RSTD[row * 2 + 1] = rsqrtf(sk * (1.0f / 128.0f) + NEPS); }
        }
        if (lane < 34) {
            const bool iskr = lane >= 32; const int a = lane & 1;
            bf16_t* ep = iskr ? prow + C_MKR + a * 16 : prow + ((lane >> 4) ? C_DK : C_DQ) + ((lane >> 1) & 7) * 32 + a * 16;
            const u32x4 e0 = *(const u32x4*)ep, e1 = *(const u32x4*)(ep + 8);
            float x1[8], x2[8];
            x1[0] = bf_lo(e0.x); x1[1] = bf_hi(e0.x); x1[2] = bf_lo(e0.y); x1[3] = bf_hi(e0.y); x1[4] = bf_lo(e0.z); x1[5] = bf_hi(e0.z); x1[6] = bf_lo(e0.w); x1[7] = bf_hi(e0.w);
            x2[0] = bf_lo(e1.x); x2[1] = bf_hi(e1.x); x2[2] = bf_lo(e1.y); x2[3] = bf_hi(e1.y); x2[4] = bf_lo(e1.z); x2[5] = bf_hi(e1.z); x2[6] = bf_lo(e1.w); x2[7] = bf_hi(e1.w);
            if (lat) { const int pos = a ? (t & 63) : (t >> 6);
#pragma unroll
                for (int i = 0; i < 8; ++i) { const float2 cs = RT[pos * 8 + i]; const float o1 = x1[i] * cs.x - x2[i] * cs.y, o2 = x1[i] * cs.y + x2[i] * cs.x; x1[i] = o1; x2[i] = o2; } }
            u32x4 w0, w1; w0.x = cvt_pk_bf16(x1[0], x1[1]); w0.y = cvt_pk_bf16(x1[2], x1[3]); w0.z = cvt_pk_bf16(x1[4], x1[5]); w0.w = cvt_pk_bf16(x1[6], x1[7]);
            w1.x = cvt_pk_bf16(x2[0], x2[1]); w1.y = cvt_pk_bf16(x2[2], x2[3]); w1.z = cvt_pk_bf16(x2[4], x2[5]); w1.w = cvt_pk_bf16(x2[6], x2[7]);
            if (iskr) {
#pragma unroll
                for (int hh = 0; hh < 4; ++hh) { bf16_t* kp = MK + (size_t)row * 384 + hh * 96 + 64 + a * 16; *(u32x4*)kp = w0; *(u32x4*)(kp + 8) = w1; }
            } else if (lat) { *(u32x4*)ep = w0; *(u32x4*)(ep + 8) = w1; }
        }
    }
}

#define MFMA32(a, b, c) __builtin_amdgcn_mfma_f32_32x32x16_bf16((a), (b), (c), 0, 0, 0)
typedef float f32x2 __attribute__((ext_vector_type(2)));
template <int MODE>
__device__ __forceinline__ void attn_item(PK p, int l, LAS unsigned char* lds, int b, int h, int qb, bool ctxq, float lam, float lam_init) {
    constexpr int NCOMP = (MODE == 1) ? 2 : 1, NKS = (MODE == 0) ? 4 : ((MODE == 1) ? 2 : 6), KW = NCOMP * NKS * 16, KCH = KW / 8, KSTR = KW * 2 + 16, VSTR = 192;
    constexpr int KBUF = 64 * KSTR, VBUF = 64 * VSTR, BUFSZ = KBUF + VBUF, BIAS_OFF = 3 * BUFSZ;
    constexpr bool STAG = (MODE != 0);
    const int tid = opaque_tid(), w = tid >> 6, lane = tid & 63, g = lane >> 5, l32 = lane & 31;
    unsigned char* ws = p->ws;
    const bf16_t* PJ = (const bf16_t*)(ws + OFF_B);
    const bf16_t *Qp, *Kp, *Vp; int ldq, ldk, ldv, outoff; float scale;
    if (MODE == 0) { Qp = PJ + C_NQ + 64 * h; Kp = PJ + C_NK + 64 * h; Vp = PJ + C_NV + 64 * h; ldq = ldk = ldv = PJW; outoff = 256 + 64 * h; scale = 0.125f; }
    else if (MODE == 1) { Qp = PJ + C_DQ + 64 * h; Kp = PJ + C_DK + 64 * h; Vp = PJ + C_DV + 64 * h; ldq = ldk = ldv = PJW; outoff = 512 + 64 * h; scale = 0.17677669529663687f; }
    else { Qp = (const bf16_t*)(ws + OFF_D) + 96 * h; Kp = (const bf16_t*)(ws + OFF_MK) + 96 * h; Vp = (const bf16_t*)(ws + OFF_MV) + 64 * h; ldq = ldk = 384; ldv = 256; outoff = 768 + 64 * h; scale = 0.10206207261596575f; }
    const float cs = scale * LOG2E;
    int qrow0, loc0, nloc;
    if (ctxq) { qrow0 = RL + b * 256; loc0 = 0; nloc = 0; }
    else { qrow0 = b * 8192 + qb * 256;
        if (MODE == 0) { const int r0 = qb * 4; loc0 = clampi(r0 - 4, 0, 120); nloc = clampi(r0 - 1, 0, 120) + 8 - loc0; } else { loc0 = 0; nloc = 128; } }
    const int nt = nloc + 4;
    const bool nabias = (MODE == 0) && !ctxq;
    const bool late = STAG && (w >= 4);
    const int rw = qb * 4 + (w >> 1), sw = clampi(rw - 4, 0, 120);
    const int jq = 32 * (w & 1) + l32, cst = clampi(jq - 8, 0, 48);
    if (nabias && tid < 465) ((LAS float*)(lds + BIAS_OFF))[tid] = p->na_rpb[(size_t)(l * 4 + h) * 465 + tid] * LOG2E;

    const size_t qrow = (size_t)qrow0 + 32 * w + l32;
    bf16x8 qf[NCOMP * NKS];
#pragma unroll
    for (int i = 0; i < NCOMP * NKS; ++i) {
        const u32x4 raw = *(const u32x4*)(Qp + qrow * ldq + 16 * i + 8 * g);
        u32x4 sc4; sc4.x = cvt_pk_bf16(bf_lo(raw.x) * cs, bf_hi(raw.x) * cs); sc4.y = cvt_pk_bf16(bf_lo(raw.y) * cs, bf_hi(raw.y) * cs);
        sc4.z = cvt_pk_bf16(bf_lo(raw.z) * cs, bf_hi(raw.z) * cs); sc4.w = cvt_pk_bf16(bf_lo(raw.w) * cs, bf_hi(raw.w) * cs);
        qf[i] = __builtin_bit_cast(bf16x8, sc4);
    }

    const int kr0 = tid / KCH, kc0 = tid % KCH, kr1 = (tid + 512) / KCH, kc1 = (tid + 512) % KCH, vr = tid >> 3, vc = tid & 7;
    const bool hask1 = (KCH == 12) && (tid < 256);
    u32x4 rk0, rk1 = (u32x4){0u, 0u, 0u, 0u}, rv;
#define TILE_ROW(t) ((t) < nloc ? (b * 8192 + 64 * (loc0 + (t))) : (RL + b * 256 + 64 * ((t) - nloc)))
#define LOAD_TILE(t) do { const size_t _tb = (size_t)TILE_ROW(t); rk0 = *(const u32x4*)(Kp + (_tb + kr0) * ldk + kc0 * 8); \
        if (hask1) rk1 = *(const u32x4*)(Kp + (_tb + kr1) * ldk + kc1 * 8); rv = *(const u32x4*)(Vp + (_tb + vr) * ldv + vc * 8); } while (0)
#define STORE_TILE(buf) do { LAS unsigned char* _kb = lds + (buf) * BUFSZ; *(LAS u32x4*)(_kb + kr0 * KSTR + kc0 * 16) = rk0; \
        if (hask1) *(LAS u32x4*)(_kb + kr1 * KSTR + kc1 * 16) = rk1; *(LAS u32x4*)(_kb + KBUF + vr * VSTR + vc * 16) = rv; } while (0)

    float mrun[NCOMP], lsum[NCOMP]; f32x16 O[NCOMP][2];
#pragma unroll
    for (int c = 0; c < NCOMP; ++c) { mrun[c] = -1e30f; lsum[c] = 0.f;
#pragma unroll
        for (int dt = 0; dt < 2; ++dt)
#pragma unroll
            for (int r = 0; r < 16; ++r) O[c][dt][r] = 0.f; }
    bf16x8 P[NCOMP][2][2];
#pragma unroll
    for (int c = 0; c < NCOMP; ++c)
#pragma unroll
        for (int kt = 0; kt < 2; ++kt)
#pragma unroll
            for (int s2 = 0; s2 < 2; ++s2) P[c][kt][s2] = (bf16x8){0, 0, 0, 0, 0, 0, 0, 0};

    LOAD_TILE(0); STORE_TILE(0); __syncthreads();
    const int koff = l32 * KSTR + g * 16;
    const int i16 = lane & 15, tq = i16 >> 2, tp = i16 & 3, blk = (lane >> 4) & 1;
    const int voff = (4 * g + tq) * VSTR + (16 * blk + 4 * tp) * 2;
#define PV_TILE(buf) do { LAS unsigned char* _vb = lds + (buf) * BUFSZ + KBUF + voff; \
        _Pragma("unroll") for (int kt = 0; kt < 2; ++kt) { bf16x8 vf[2][2]; \
            _Pragma("unroll") for (int s2 = 0; s2 < 2; ++s2) _Pragma("unroll") for (int dt = 0; dt < 2; ++dt) { LAS unsigned char* vp = _vb + (32 * kt + 16 * s2) * VSTR + dt * 64; \
                const s16x4 lo = __builtin_amdgcn_ds_read_tr16_b64_v4i16((LAS s16x4*)vp); const s16x4 hi = __builtin_amdgcn_ds_read_tr16_b64_v4i16((LAS s16x4*)(vp + 8 * VSTR)); \
                vf[s2][dt] = __builtin_shufflevector(lo, hi, 0, 1, 2, 3, 4, 5, 6, 7); } \
            __builtin_amdgcn_s_setprio(1); \
            _Pragma("unroll") for (int s2 = 0; s2 < 2; ++s2) _Pragma("unroll") for (int dt = 0; dt < 2; ++dt) _Pragma("unroll") for (int c = 0; c < NCOMP; ++c) O[c][dt] = MFMA32(vf[s2][dt], P[c][kt][s2], O[c][dt]); \
            __builtin_amdgcn_s_setprio(0); } } while (0)

#define PV_TILE_C(buf, cc) do { LAS unsigned char* _vb = lds + (buf) * BUFSZ + KBUF + voff; \
        _Pragma("unroll") for (int kt = 0; kt < 2; ++kt) { bf16x8 vf[2][2]; \
            _Pragma("unroll") for (int s2 = 0; s2 < 2; ++s2) _Pragma("unroll") for (int dt = 0; dt < 2; ++dt) { LAS unsigned char* vp = _vb + (32 * kt + 16 * s2) * VSTR + dt * 64; \
                const s16x4 lo = __builtin_amdgcn_ds_read_tr16_b64_v4i16((LAS s16x4*)vp); const s16x4 hi = __builtin_amdgcn_ds_read_tr16_b64_v4i16((LAS s16x4*)(vp + 8 * VSTR)); \
                vf[s2][dt] = __builtin_shufflevector(lo, hi, 0, 1, 2, 3, 4, 5, 6, 7); } \
            __builtin_amdgcn_s_setprio(1); \
            _Pragma("unroll") for (int s2 = 0; s2 < 2; ++s2) _Pragma("unroll") for (int dt = 0; dt < 2; ++dt) O[cc][dt] = MFMA32(vf[s2][dt], P[cc][kt][s2], O[cc][dt]); \
            __builtin_amdgcn_s_setprio(0); } } while (0)
    bool pend = false; int pbuf = 0, cbuf = 0;
    for (int t = 0; t < nt; ++t) {
        const bool more = (t + 1 < nt);
        if (more) LOAD_TILE(t + 1);
        bool active = true; int krow = 0;
        if (nabias && t < nloc) { krow = loc0 + t; active = (krow >= sw) && (krow < sw + 8); }
        if (active) {
            LAS unsigned char* Kb = lds + cbuf * BUFSZ + koff;
            f32x16 S[NCOMP][2];
#pragma unroll
            for (int c = 0; c < NCOMP; ++c)
#pragma unroll
                for (int kt = 0; kt < 2; ++kt) {
                    bf16x8 kf[NKS];
#pragma unroll
                    for (int ks = 0; ks < NKS; ++ks) kf[ks] = *(const LAS bf16x8*)(Kb + kt * 32 * KSTR + (c * NKS + ks) * 32);
#pragma unroll
                    for (int r = 0; r < 16; ++r) S[c][kt][r] = 0.f;
                    __builtin_amdgcn_s_setprio(1);
#pragma unroll
                    for (int ks = 0; ks < NKS; ++ks) S[c][kt] = MFMA32(kf[ks], qf[c * NKS + ks], S[c][kt]);
                    __builtin_amdgcn_s_setprio(0);
                }
            if (STAG && late && pend) PV_TILE(pbuf);
            float mxc[NCOMP], mnw[NCOMP];
#pragma unroll
            for (int c = 0; c < NCOMP; ++c) {
                float mx = -1e30f;
                if (nabias && t < nloc) {
                    const LAS float* bt = (const LAS float*)(lds + BIAS_OFF) + (krow - rw + 7) * 31;
#pragma unroll
                    for (int kt = 0; kt < 2; ++kt)
#pragma unroll
                        for (int r = 0; r < 16; ++r) { const int jk = 32 * kt + (r & 3) + 8 * (r >> 2) + 4 * g; const bool ok = (jk >= cst) && (jk < cst + 16);
                            const float bv = bt[clampi(jk - jq + 15, 0, 30)]; const float xv = ok ? (S[c][kt][r] + bv) : -1e30f; S[c][kt][r] = xv; mx = fmaxf(mx, xv); }
                } else {
#pragma unroll
                    for (int kt = 0; kt < 2; ++kt)
#pragma unroll
                        for (int r = 0; r < 16; r += 2) mx = fmaxf(fmaxf(mx, S[c][kt][r]), S[c][kt][r + 1]);
                }
                mxc[c] = mx;
            }
#pragma unroll
            for (int c = 0; c < NCOMP; ++c) mxc[c] = fmaxf(mxc[c], shflx(mxc[c], 32));
            bool grow = false;
#pragma unroll
            for (int c = 0; c < NCOMP; ++c) { mnw[c] = fmaxf(mrun[c], mxc[c]); grow = grow || (mnw[c] > mrun[c]); }
            if (__any(grow)) {
#pragma unroll
                for (int c = 0; c < NCOMP; ++c) { const float alpha = fast_exp2(mrun[c] - mnw[c]); lsum[c] *= alpha;
#pragma unroll
                    for (int dt = 0; dt < 2; ++dt) O[c][dt] *= alpha;
                    mrun[c] = mnw[c]; }
            }
#pragma unroll
            for (int c = 0; c < NCOMP; ++c) { const f32x2 m2 = (f32x2){mnw[c], mnw[c]};
#pragma unroll
                for (int kt = 0; kt < 2; ++kt)
#pragma unroll
                    for (int r = 0; r < 16; r += 2) { const f32x2 d = (f32x2){S[c][kt][r], S[c][kt][r + 1]} - m2; S[c][kt][r] = d.x; S[c][kt][r + 1] = d.y; } }
#pragma unroll
            for (int c = 0; c < NCOMP; ++c)
#pragma unroll
                for (int kt = 0; kt < 2; ++kt)
#pragma unroll
                    for (int r = 0; r < 16; ++r) S[c][kt][r] = fast_exp2(S[c][kt][r]);
#pragma unroll
            for (int c = 0; c < NCOMP; ++c) { f32x2 rs2 = (f32x2){0.f, 0.f};
#pragma unroll
                for (int kt = 0; kt < 2; ++kt)
#pragma unroll
                    for (int s2 = 0; s2 < 2; ++s2) { u32x4 pk;
#pragma unroll
                        for (int e = 0; e < 4; ++e) { const f32x2 ev = (f32x2){S[c][kt][8 * s2 + 2 * e], S[c][kt][8 * s2 + 2 * e + 1]}; rs2 += ev; pk[e] = cvt_pk_bf16(ev.x, ev.y); }
                        P[c][kt][s2] = __builtin_bit_cast(bf16x8, pk); }
                lsum[c] += rs2.x + rs2.y; }
            if (!(STAG && late)) PV_TILE(cbuf);
            if (STAG && late) { pend = true; pbuf = cbuf; }
        }
        const int nbuf = (cbuf == 2) ? 0 : cbuf + 1;
        if (more) STORE_TILE(nbuf);
        __syncthreads();
        cbuf = nbuf;
    }
    if (STAG && late && pend) PV_TILE(pbuf);
#undef PV_TILE
#undef PV_TILE_C
#undef TILE_ROW
#undef LOAD_TILE
#undef STORE_TILE
    float inv[NCOMP];
#pragma unroll
    for (int c = 0; c < NCOMP; ++c) { const float lt = lsum[c] + shflx(lsum[c], 32); inv[c] = 1.0f / lt; }
    bf16_t* op = (bf16_t*)(ws + OFF_A) + qrow * 1024 + outoff;
    if (MODE == 1) {
        const float li1 = lam * inv[NCOMP - 1]; float ss = 0.f;
#pragma unroll
        for (int dt = 0; dt < 2; ++dt)
#pragma unroll
            for (int r = 0; r < 16; ++r) { const float o = O[0][dt][r] * inv[0] - li1 * O[NCOMP - 1][dt][r]; O[0][dt][r] = o; ss += o * o; }
        ss += shflx(ss, 32);
        const float rstd = rsqrtf(ss * (1.0f / 64.0f) + NEPS) * (1.0f - lam_init);
        const float* sg = p->diff_subln_g + l * 64;
#pragma unroll
        for (int dt = 0; dt < 2; ++dt)
#pragma unroll
            for (int rq = 0; rq < 4; ++rq) { const int dv = 32 * dt + 8 * rq + 4 * g; const f32x4 gg = *(const f32x4*)(sg + dv);
                u32x2 wv; wv.x = cvt_pk_bf16(O[0][dt][4 * rq] * rstd * gg[0], O[0][dt][4 * rq + 1] * rstd * gg[1]); wv.y = cvt_pk_bf16(O[0][dt][4 * rq + 2] * rstd * gg[2], O[0][dt][4 * rq + 3] * rstd * gg[3]);
                *(u32x2*)(op + dv) = wv; }
    } else {
#pragma unroll
        for (int dt = 0; dt < 2; ++dt)
#pragma unroll
            for (int rq = 0; rq < 4; ++rq) { const int dv = 32 * dt + 8 * rq + 4 * g;
                u32x2 wv; wv.x = cvt_pk_bf16(O[0][dt][4 * rq] * inv[0], O[0][dt][4 * rq + 1] * inv[0]); wv.y = cvt_pk_bf16(O[0][dt][4 * rq + 2] * inv[0], O[0][dt][4 * rq + 3] * inv[0]);
                *(u32x2*)(op + dv) = wv; }
    }
    __syncthreads();
}

__device__ void attn_phase(PK p, int l, LAS unsigned char* lds) {
    const float lam_init = (l == 0) ? 0.2f : 0.35550906759502f;
    const float* dl = p->diff_lambda + l * 128;
    float d01 = 0.f, d23 = 0.f;
    for (int i = 0; i < 32; ++i) { d01 += dl[i] * dl[32 + i]; d23 += dl[64 + i] * dl[96 + i]; }
    const float lam = expf(d01) - expf(d23) + lam_init;
    const int nItems = 1536 + (l == 0 ? 48 : 0);
    for (int it = opaque_bid(); it < nItems; it += opaque_gdim()) {
        if (it < 1536) {
            const int ty = it >> 9, idx = it & 511, bh = ((idx & 7) << 1) | (idx >> 8), b = bh >> 2, h = bh & 3, qb = (idx >> 3) & 31;
            if (ty == 0) attn_item<1>(p, l, lds, b, h, qb, false, lam, lam_init);
            else if (ty == 1) attn_item<2>(p, l, lds, b, h, qb, false, lam, lam_init);
            else attn_item<0>(p, l, lds, b, h, qb, false, lam, lam_init);
        } else {
            const int idx = it - 1536, ty = idx >> 4, b = (idx >> 2) & 3, h = idx & 3;
            if (ty == 0) attn_item<1>(p, l, lds, b, h, 0, true, lam, lam_init);
            else if (ty == 1) attn_item<2>(p, l, lds, b, h, 0, true, lam, lam_init);
            else attn_item<0>(p, l, lds, b, h, 0, true, lam, lam_init);
        }
    }
}

constexpr int PH_PER_LAYER = 14, N_PHASES = 2 * PH_PER_LAYER + 1;

__device__ __forceinline__ void run_phase(PK p, int ph, LAS unsigned char* lds, float rcoef) {
    unsigned char* ws = p->ws;
    pg8::StaticOrder S;
    if (ph == N_PHASES - 1) { final_norm_phase(p->out, p->final_norm_g); return; }
    int l = ph / PH_PER_LAYER; const int q = ph % PH_PER_LAYER;
#define OPQL asm volatile("" : "+s"(l))
#define HC ((float*)(ws + OFF_HC))
#define MOD ((const float*)(ws + OFF_MOD) + (size_t)l * 5 * 9216)
#define TN ((bf16_t*)(ws + OFF_A))
#define HID ((bf16_t*)(ws + OFF_B))
#define Mlate ((l == 0) ? RA : RL)
    switch (q) {
    case 0: OPQL; layer_prep_phase(p, l, lds); break;
    case 1: OPQL; if (l == 0) norm_mod_phase(p->x, p->ctx, p->out, HC, p->norm_g + (l * 3 + 0) * 1024, MOD, TN, RA, nullptr, 0);
            else norm_mod_phase(p->out, HC, nullptr, nullptr, p->norm_g + (l * 3 + 0) * 1024, MOD, TN, RA, (const float*)(ws + OFF_PB), 11); break;
    case 2: case 12: { OPQL; const int f = (q == 2) ? 0 : 1; const int M = (q == 2) ? RA : Mlate;
        pg8::Gemm g{TN, (const bf16_t*)(ws + OFF_W1) + (size_t)f * 5632 * 1024, M, 5632, 1024, 1024, 1024}; S.init(M, 5632, opaque_gdim(), opaque_bid());
        EpiSwiglu E{HID}; pg8::gemm_phase(lds, g, S, E); } break;
    case 4: OPQL; norm_mod_phase(p->out, HC, nullptr, nullptr, p->norm_g + (l * 3 + 1) * 1024, MOD + 3 * 1024, TN, RA, (const float*)(ws + OFF_PB), 11); break;
    case 5: { OPQL; pg8::Gemm g{TN, (const bf16_t*)(ws + OFF_WM), RA, 6400, 1024, 1024, 1024}; S.init(RA, 6400, opaque_gdim(), opaque_bid());
        EpiPJ E{(bf16_t*)(ws + OFF_B), ws + OFF_C}; pg8::gemm_phase(lds, g, S, E); } break;
    case 6: prep_phase(p); break;
    case 7: { OPQL; pg8::Gemm g{(const bf16_t*)(ws + OFF_B) + C_MQ, (const bf16_t*)(ws + OFF_WL), RA, 1024, 384, PJW, 384}; S.init(RA, 1024, opaque_gdim(), opaque_bid());
        EpiMLA E{(bf16_t*)(ws + OFF_D), (bf16_t*)(ws + OFF_MK), (bf16_t*)(ws + OFF_MV), (const float*)(ws + OFF_RSTD), (const float2*)(ws + OFF_ROPE)}; pg8::gemm_phase(lds, g, S, E); } break;
    case 8: OPQL; attn_phase(p, l, lds); break;
    case 9: { OPQL; pg8::Gemm g{(const bf16_t*)(ws + OFF_A), (const bf16_t*)(ws + OFF_WB), Mlate, 1024, 1024, 1024, 1024}; S.init(Mlate, 1024, opaque_gdim(), opaque_bid());
        EpiMerge E{ws + OFF_C, (bf16_t*)(ws + OFF_D)}; pg8::gemm_phase(lds, g, S, E); } break;
    case 3: case 13: case 10: { OPQL;
        const bool isout = (q == 10); const int f = (q == 13) ? 1 : 0;
        const bf16_t* A = isout ? (const bf16_t*)(ws + OFF_D) : (const bf16_t*)HID;
        const bf16_t* Bt = isout ? (const bf16_t*)(ws + OFF_WO) : (const bf16_t*)(ws + OFF_W2) + (size_t)f * 1024 * FH;
        const int K = isout ? 1024 : FH;
        const float* gate = MOD + (isout ? 5 : (q == 3 ? 2 : 8)) * 1024;
        const float coef = (isout ? 1.0f : 0.5f) * rcoef;
        const bool withctx = (q == 3) || (l == 0);
        { pg8::Gemm g{A, Bt, RL, 1024, K, K, K}; S.init(RL, 1024, opaque_gdim(), opaque_bid());
          EpiResid E{p->out, HC, gate, coef}; pg8::gemm_phase(lds, g, S, E); }
        if (withctx) {
            const int nsu = 16 * (K / 256);
            for (int su = opaque_bid(); su < nsu; su += opaque_gdim()) {
                const int ks = su >> 4, pmn = su & 15;
                pg8::SingleUnit SU; SU.pm = 128 + (pmn >> 2); SU.pn = pmn & 3; SU.has = true;
                pg8::Gemm g2{A + ks * 256, Bt + ks * 256, RA, 1024, 256, K, K};
                EpiPartial E2{(float*)(ws + OFF_PB) + (size_t)ks * 1024 * 1024, gate + 4 * 9216, coef}; pg8::gemm_phase(lds, g2, SU, E2);
            }
        }
    } break;
    case 11: OPQL; norm_mod_phase(p->out, HC, nullptr, nullptr, p->norm_g + (l * 3 + 2) * 1024, MOD + 6 * 1024, TN, Mlate, (const float*)(ws + OFF_PB), 4); break;
    }
#undef OPQL
#undef HC
#undef MOD
#undef TN
#undef HID
#undef Mlate
}

__global__ void __launch_bounds__(512, 2) fwd_megakernel(Params p) {
    extern __shared__ __attribute__((aligned(16))) unsigned char shm[];
    LAS unsigned char* lds = (LAS unsigned char*)shm;
#if N_LAUNCH_MODE == 1
    cg::grid_group grid = cg::this_grid();
    const int ph_lo = p.ph_lo, ph_hi = p.ph_hi;
    volatile LAS unsigned* st = (volatile LAS unsigned*)(lds + pg8::STAGE_BYTES);
    unsigned* bar = (unsigned*)(p.ws + OFF_BAR);
    if (opaque_tid() < 4) st[opaque_tid()] = 0u;
    if (opaque_bid() == 0) for (int i = opaque_tid(); i < XCD_BAR_WORDS; i += 512) bar[i] = 0u;
    __syncthreads();
#if PROBE_Q >= 0
    const int nseq = 2 * (PH_PER_LAYER + 1) + 1;
    for (int i = 0; i < nseq; ++i) {
        int ph;
        if (i == nseq - 1) ph = N_PHASES - 1;
        else { const int li = i / (PH_PER_LAYER + 1), r = i % (PH_PER_LAYER + 1); ph = li * PH_PER_LAYER + (r <= PROBE_Q ? r : r - 1); }
        PK pk = (PK)__builtin_amdgcn_kernarg_segment_ptr();
        asm volatile("" : "+s"(pk));
        run_phase(pk, ph, lds, 1.0f);
        if (i == 0) { grid.sync(); xcd_barrier_post(bar); }
        else if (i + 1 < nseq) xcd_barrier(bar, st);
    }
#else
    for (int ph = ph_lo; ph < ph_hi; ++ph) {
        PK pk = (PK)__builtin_amdgcn_kernarg_segment_ptr();
        asm volatile("" : "+s"(pk));
        run_phase(pk, ph, lds, 1.0f);
        if (ph == ph_lo) { grid.sync(); xcd_barrier_post(bar); }
        else if (ph + 1 < ph_hi) xcd_barrier(bar, st);
    }
#endif
#else
    const int ph_lo = p.ph_lo, ph_hi = p.ph_hi;
    for (int ph = ph_lo; ph < ph_hi; ++ph) { PK pk = (PK)__builtin_amdgcn_kernarg_segment_ptr(); asm volatile("" : "+s"(pk)); run_phase(pk, ph, lds, 1.0f); }
#endif
}

extern "C" void kernel_launch(void* const* d_in, const int* in_sizes, int n_in, void* d_out, int out_size, void* d_ws, size_t ws_size, hipStream_t stream) {
    constexpr int LDS_BYTES = pg8::STAGE_BYTES + 16;
    static int grid_blocks = 0;
    if (grid_blocks == 0) {
        if (n_in != 22 || ws_size < WS_END) { fprintf(stderr, "kernel_launch: unexpected inputs (n_in %d, ws %zu < %zu)\n", n_in, ws_size, (size_t)WS_END); grid_blocks = -1; return; }
        int dev = 0, cus = 0, per_cu = 0;
        hipGetDevice(&dev); hipDeviceGetAttribute(&cus, hipDeviceAttributeMultiprocessorCount, dev);
        if (hipFuncSetAttribute((const void*)fwd_megakernel, hipFuncAttributeMaxDynamicSharedMemorySize, LDS_BYTES) != hipSuccess) { fprintf(stderr, "hipFuncSetAttribute failed\n"); grid_blocks = -1; return; }
        if (hipOccupancyMaxActiveBlocksPerMultiprocessor(&per_cu, (const void*)fwd_megakernel, 512, LDS_BYTES) != hipSuccess || per_cu < 1) per_cu = 1;
        (void)hipGetLastError();
        grid_blocks = cus * 1;
    }
    if (grid_blocks < 0) return;
    Params hp{};
    const float** pp = (const float**)&hp;
    for (int i = 0; i < 22; ++i) pp[i] = (const float*)d_in[i];
    hp.out = (float*)d_out; hp.ws = (unsigned char*)d_ws;
#if N_LAUNCH_MODE == 1
    hp.ph_lo = 0; hp.ph_hi = N_PHASES;
    void* args[] = {&hp};
    hipError_t e = hipLaunchCooperativeKernel((const void*)fwd_megakernel, dim3(grid_blocks), dim3(512), args, LDS_BYTES, stream);
    if (e != hipSuccess) fprintf(stderr, "cooperative launch failed: %s (grid %d)\n", hipGetErrorString(e), grid_blocks);
#else
    for (int ph = 0; ph < N_PHASES; ++ph) { hp.ph_lo = ph; hp.ph_hi = ph + 1; hipLaunchKernelGGL(fwd_megakernel, dim3(grid_blocks), dim3(512), LDS_BYTES, stream, hp); }
#endif
}
```

```cpp
#include <hip/hip_runtime.h>
#include <hip/hip_cooperative_groups.h>
#include <cstdio>
namespace cg = cooperative_groups;

#define LAS __attribute__((address_space(3)))
typedef unsigned short bf16_t;
typedef short bf16x8 __attribute__((ext_vector_type(8)));
typedef short s16x4 __attribute__((ext_vector_type(4)));
typedef float f32x4 __attribute__((ext_vector_type(4)));
typedef float f32x16 __attribute__((ext_vector_type(16)));
typedef unsigned u32x4 __attribute__((ext_vector_type(4)));
typedef unsigned u32x2 __attribute__((ext_vector_type(2)));

#ifndef PROBE_Q
#define PROBE_Q (-1)
#endif
#ifndef N_LAUNCH_MODE
#define N_LAUNCH_MODE 1
#endif

constexpr int RL = 32768, RA = 33792, FH = 2816;
constexpr int PJW = 2304;
constexpr int C_NQ = 256, C_NK = 512, C_NV = 768, C_DQ = 1024, C_DK = 1280, C_DV = 1536, C_MQ = 1792, C_MKV = 2048, C_MKR = 2176;
constexpr float LOG2E = 1.4426950408889634f;
constexpr float NEPS = 1e-6f;
constexpr int XCD_BAR_WORDS_C = 3456;

constexpr size_t SZ_W1 = 2ull * 5632 * 1024 * 2, SZ_W2 = 2ull * 1024 * 2816 * 2, SZ_WM = 6400ull * 1024 * 2, SZ_WL = 1024ull * 384 * 2, SZ_WB = 4ull * 1024 * 256 * 2, SZ_WO = 1024ull * 1024 * 2;
constexpr size_t OFF_W1 = 0, OFF_W2 = OFF_W1 + SZ_W1, OFF_WM = OFF_W2 + SZ_W2, OFF_WL = OFF_WM + SZ_WM, OFF_WB = OFF_WL + SZ_WL, OFF_WO = OFF_WB + SZ_WB;
constexpr size_t OFF_HC = OFF_WO + SZ_WO;
constexpr size_t OFF_MOD = OFF_HC + 1024ull * 1024 * 4;
constexpr size_t OFF_ROPE = OFF_MOD + 2ull * 5 * 9216 * 4;
constexpr size_t OFF_RSTD = OFF_ROPE + 128 * 8 * 8;
constexpr size_t OFF_A = OFF_RSTD + (size_t)RA * 2 * 4;
constexpr size_t OFF_B = OFF_A + (size_t)RA * 1024 * 2;
constexpr size_t OFF_C = OFF_B + (size_t)RA * PJW * 2;
constexpr size_t OFF_D = OFF_C + (size_t)RA * 4096;
constexpr size_t OFF_MK = OFF_D + (size_t)RA * 384 * 2, OFF_MV = OFF_MK + (size_t)RA * 384 * 2;
constexpr size_t OFF_BAR = OFF_D + (size_t)RA * 1024 * 2;
constexpr size_t OFF_PB = OFF_BAR + 16384;
constexpr size_t WS_END = OFF_PB + 11ull * 1024 * 1024 * 4;

struct Params {
    const float *x, *c, *ctx, *c_ctx, *ada_w, *ada_b, *norm_g, *ffn_w_in, *ffn_w_out, *mix_w_in, *pool_w, *pool_scale, *na_rpb, *diff_lambda, *diff_subln_g,
        *mla_q_norm_g, *mla_kv_norm_g, *mla_w_qb, *mla_w_kvb, *branch_w_out, *mix_w_out, *final_norm_g;
    float* out; unsigned char* ws;
    int ph_lo, ph_hi;
};

typedef const __attribute__((address_space(4))) Params* PK;

typedef float f32x2_ __attribute__((ext_vector_type(2)));
typedef __bf16 bf16x2_ __attribute__((ext_vector_type(2)));
__device__ __forceinline__ unsigned cvt_pk_bf16(float lo, float hi) { const f32x2_ v = {lo, hi}; return __builtin_bit_cast(unsigned, __builtin_convertvector(v, bf16x2_)); }
__device__ __forceinline__ float bf_lo(unsigned u) { return __uint_as_float(u << 16); }
__device__ __forceinline__ float bf_hi(unsigned u) { return __uint_as_float(u & 0xffff0000u); }
__device__ __forceinline__ float fast_exp2(float x) { return __builtin_amdgcn_exp2f(x); }
__device__ __forceinline__ float fast_rcp(float x) { return __builtin_amdgcn_rcpf(x); }
__device__ __forceinline__ float sigmoidf_(float x) { return fast_rcp(1.0f + fast_exp2(-x * LOG2E)); }
__device__ __forceinline__ float shflx(float v, int m) {
    int lane = __builtin_amdgcn_mbcnt_hi(~0u, __builtin_amdgcn_mbcnt_lo(~0u, 0)); asm volatile("" : "+v"(lane));
    return __int_as_float(__builtin_amdgcn_ds_bpermute((lane ^ m) << 2, __float_as_int(v)));
}
__device__ __forceinline__ float wave_sum(float v) {
    v += shflx(v, 32); v += shflx(v, 16); v += shflx(v, 8); v += shflx(v, 4); v += shflx(v, 2); v += shflx(v, 1); return v;
}
__device__ __forceinline__ int opaque_tid() { int t = threadIdx.x; asm volatile("" : "+v"(t)); return t; }
__device__ __forceinline__ int opaque_bid() { int t = blockIdx.x; asm volatile("" : "+s"(t)); return t; }
__device__ __forceinline__ int opaque_gdim() { int t = gridDim.x; asm volatile("" : "+s"(t)); return t; }
__device__ __forceinline__ int clampi(int v, int lo, int hi) { return v < lo ? lo : (v > hi ? hi : v); }

#define XB_TMO      128
#define XB_XCNT(j)  (256  + 64 * (j))
#define XB_XSUB(j)  (1280 + 64 * (j))
#define XB_XGEN(j)  (2304 + 64 * (j))
#define XB_TOP      3328
#define XB_TOPGEN   3392
#define XCD_BAR_WORDS 3456
#define XB_SPIN_CAP (1u << 20)
__device__ __forceinline__ unsigned xb_ld(unsigned* p)              { return __hip_atomic_load(p, __ATOMIC_RELAXED, __HIP_MEMORY_SCOPE_AGENT); }
__device__ __forceinline__ unsigned xb_add(unsigned* p, unsigned v) { return __hip_atomic_fetch_add(p, v, __ATOMIC_RELAXED, __HIP_MEMORY_SCOPE_AGENT); }
__device__ __forceinline__ unsigned xb_xcc_id() { return (unsigned)__builtin_amdgcn_s_getreg((3 << 11) | 20) & 0xFu; }
#define XB_SPIN(cond, bar) do { unsigned _sp = 0; while (cond) { __builtin_amdgcn_s_sleep(1); \
    if ((++_sp & 255u) == 0u) { if (xb_ld(&(bar)[XB_TMO])) break; if (_sp > XB_SPIN_CAP) { atomicAdd(&(bar)[XB_TMO], 1u); break; } } } } while (0)
__device__ __forceinline__ void xcd_barrier_post(unsigned* bar) { if (opaque_tid() == 0) (void)xb_add(&bar[XB_XCNT(xb_xcc_id())], 1u); }
__device__ __forceinline__ void xcd_barrier_complete(unsigned* bar, unsigned x, unsigned& nloc, unsigned& nx) {
    const unsigned G = gridDim.x;
    unsigned sum, cnt, mine, sp = 0u;
    for (;;) {
        sum = 0u; cnt = 0u; mine = 0u;
#pragma unroll
        for (unsigned j = 0; j < 16; ++j) { const unsigned c = xb_ld(&bar[XB_XCNT(j)]); sum += c; cnt += (c > 0u) ? 1u : 0u; mine = (j == x) ? c : mine; }
        if (sum == G) break;
        __builtin_amdgcn_s_sleep(1);
        if ((++sp & 255u) == 0u) { if (xb_ld(&bar[XB_TMO])) break; if (sp > XB_SPIN_CAP) { atomicAdd(&bar[XB_TMO], 1u); break; } }
    }
    nloc = mine > 0u ? mine : 1u; nx = cnt > 0u ? cnt : 1u;
}
__device__ __forceinline__ void xcd_barrier(unsigned* bar, volatile LAS unsigned* st) {
    asm volatile("s_waitcnt vmcnt(0)" ::: "memory");
    __syncthreads();
    if (opaque_tid() == 0) {
        const unsigned x = xb_xcc_id();
        __builtin_amdgcn_s_waitcnt(0);
        unsigned nloc = st[0], nx = st[1];
        if (nloc == 0u) { xcd_barrier_complete(bar, x, nloc, nx); st[0] = nloc; st[1] = nx; }
        const unsigned old = xb_add(&bar[XB_XSUB(x)], 1u);
        const unsigned gen = old / nloc;
        if (old + 1u == (gen + 1u) * nloc) {
            __builtin_amdgcn_fence(__ATOMIC_RELEASE, "agent");
            asm volatile("s_waitcnt vmcnt(0)" ::: "memory");
            const unsigned og = xb_add(&bar[XB_TOP], 1u);
            const unsigned tg = og / nx;
            if (og + 1u == (tg + 1u) * nx) xb_add(&bar[XB_TOPGEN], 1u);
            else XB_SPIN(xb_ld(&bar[XB_TOPGEN]) == tg, bar);
            __builtin_amdgcn_fence(__ATOMIC_ACQUIRE, "agent");
            xb_add(&bar[XB_XGEN(x)], 1u);
            asm volatile("s_waitcnt vmcnt(0)" ::: "memory");
        } else {
            XB_SPIN(xb_ld(&bar[XB_XGEN(x)]) == gen, bar);
            __builtin_amdgcn_fence(__ATOMIC_ACQUIRE, "agent");
            asm volatile("s_waitcnt vmcnt(0)" ::: "memory");
        }
    }
    __syncthreads();
}

namespace pg8 {
constexpr int BM = 256, BK = 64, HALF = 128, HTB = HALF * BK * 2, STAGE_BYTES = 8 * HTB, NXCD = 8, WGM = 8;
__device__ __forceinline__ int lds_byte(int r, int c) { const int st = (r >> 4) * 2 + (c >> 5), rr = r & 15, cc = c & 31, ob = rr * 64 + cc * 2; return st * 1024 + (ob ^ (((ob >> 9) & 1) << 5)); }
__device__ __forceinline__ void stage_rc(int b, int& R, int& C) { const int st = b / 1024, sb = b % 1024, swz = sb ^ (((sb >> 9) & 1) << 5); R = (st >> 1) * 16 + swz / 64; C = (st & 1) * 32 + (swz % 64) / 2; }
__device__ __forceinline__ int perm32(int rho) { const int n = rho >> 4, i = rho & 15; return 8 * (i >> 2) + 4 * n + (i & 3); }
struct Unit { int pm, pn; };
struct Gemm { const bf16_t* A; const bf16_t* Bt; int M, N, K, lda, ldb; };
struct StaticOrder {
    int nM, nN, nwg, G, c;
    __device__ void init(int M, int N, int G_, int c_) { nM = M / BM; nN = N / BM; nwg = nM * nN; G = G_; c = c_; }
    __device__ bool next(int i, Unit& u) const {
        const long L = (long)i * G + c; if (L >= nwg) return false;
        int wgid = (int)L; { const int q = nwg / NXCD, r = nwg % NXCD, xcd = wgid % NXCD, off = wgid / NXCD; wgid = (xcd < r ? xcd * (q + 1) : r * (q + 1) + (xcd - r) * q) + off; }
        const int nig = WGM * nN, gid = wgid / nig, fm = gid * WGM, gsz = (nM - fm) < WGM ? (nM - fm) : WGM;
        u.pm = fm + ((wgid % nig) % gsz); u.pn = (wgid % nig) / gsz; return true;
    }
};

struct SingleUnit {
    int pm, pn; bool has;
    __device__ bool next(int i, Unit& u) const { if (i > 0 || !has) return false; u.pm = pm; u.pn = pn; return true; }
};
template <class Epi, class Sched>
__device__ __forceinline__ void gemm_phase(LAS unsigned char* lds, const Gemm g, const Sched& S, const Epi& E) {
    const int tid = opaque_tid(), wid = __builtin_amdgcn_readfirstlane(tid >> 6), lane = tid & 63, wr = wid >> 2, wc = wid & 3, fr = lane & 15, fq = lane >> 4;
    const int K = g.K, nt = K / BK;
    unsigned voffA[2], voffB[2];
#pragma unroll
    for (int i = 0; i < 2; ++i) { int R, C; stage_rc(tid * 16 + i * 8192, R, C); const int Rb = Epi::PERM ? ((R & ~31) + perm32(R & 31)) : R;
        voffA[i] = (unsigned)(R * g.lda + C) * 2u; voffB[i] = (unsigned)(Rb * g.ldb + C) * 2u; }
    const size_t kstep = (size_t)(BK * 2);
    const size_t hstepA = (size_t)HALF * g.lda * 2, hstepB = (size_t)HALF * g.ldb * 2;
    const size_t tstepA = 2 * hstepA, tstepB = 2 * hstepB;
    const unsigned ldsw = (unsigned)wid * 1024u;
    const int aoff = lds_byte(wr * 64 + fr, fq * 8), boff = lds_byte(wc * 32 + fr, fq * 8);
#define PG8_SA(b, h) (((b) * 2 + (h)) * HTB)
#define PG8_SB(b, h) ((4 + (b) * 2 + (h)) * HTB)
#define PG8_STAGE(bufoff, gbase, voff) do { _Pragma("unroll") for (int _i = 0; _i < 2; ++_i) \
        __builtin_amdgcn_global_load_lds((const unsigned*)((const char*)(gbase) + (voff)[_i]), (LAS unsigned*)(lds + (bufoff) + ldsw + _i * 8192), 16, 0, 0); } while (0)
#define PG8_LDA(dst, b, h) do { _Pragma("unroll") for (int m = 0; m < 4; ++m) _Pragma("unroll") for (int k = 0; k < 2; ++k) dst[m][k] = *(const LAS bf16x8*)(lds + PG8_SA(b, h) + aoff + m * 2048 + k * 1024); } while (0)
#define PG8_LDB(dst, b, h) do { _Pragma("unroll") for (int n = 0; n < 2; ++n) _Pragma("unroll") for (int k = 0; k < 2; ++k) dst[n][k] = *(const LAS bf16x8*)(lds + PG8_SB(b, h) + boff + n * 2048 + k * 1024); } while (0)
#define PG8_MMA(ai, bj, At, Bt) do { __builtin_amdgcn_s_setprio(1); _Pragma("unroll") for (int m = 0; m < 4; ++m) _Pragma("unroll") for (int n = 0; n < 2; ++n) _Pragma("unroll") for (int k = 0; k < 2; ++k) \
        acc[ai][bj][m][n] = __builtin_amdgcn_mfma_f32_16x16x32_bf16(Bt[n][k], At[m][k], acc[ai][bj][m][n], 0, 0, 0); __builtin_amdgcn_s_setprio(0); } while (0)
#define PG8_WAIT_V(n) asm volatile("s_waitcnt vmcnt(" #n ")" ::: "memory")
#define PG8_WAIT_L(n) asm volatile("s_waitcnt lgkmcnt(" #n ")" ::: "memory")
#define PG8_BAR __builtin_amdgcn_s_barrier()
#define PG8_SCHED __builtin_amdgcn_sched_barrier(0)
    Unit cur, nxt; int ui = 0;
    if (!S.next(0, cur)) return;
    f32x4 acc[2][2][4][2];
#pragma unroll
    for (int a = 0; a < 2; ++a)
#pragma unroll
        for (int b = 0; b < 2; ++b)
#pragma unroll
            for (int m = 0; m < 4; ++m)
#pragma unroll
                for (int n = 0; n < 2; ++n) acc[a][b][m][n] = (f32x4){0.f, 0.f, 0.f, 0.f};
    bf16x8 At[4][2], B0[2][2], B1[2][2];
    const char* cA = (const char*)g.A + (size_t)cur.pm * tstepA; const char* cB = (const char*)g.Bt + (size_t)cur.pn * tstepB;
    PG8_STAGE(PG8_SB(0, 0), cB, voffB); PG8_STAGE(PG8_SA(0, 0), cA, voffA); PG8_STAGE(PG8_SB(0, 1), cB + hstepB, voffB); PG8_STAGE(PG8_SA(0, 1), cA + hstepA, voffA);
    if (wr == 1) PG8_BAR;
    PG8_WAIT_V(4); PG8_BAR;
    PG8_STAGE(PG8_SB(1, 0), cB + kstep, voffB); PG8_STAGE(PG8_SA(1, 0), cA + kstep, voffA); PG8_STAGE(PG8_SB(1, 1), cB + hstepB + kstep, voffB);
    PG8_WAIT_V(6); PG8_BAR;
    for (;;) {
        const bool has_next = S.next(ui + 1, nxt);
        const char* nA = has_next ? (const char*)g.A + (size_t)nxt.pm * tstepA : cA; const char* nB = has_next ? (const char*)g.Bt + (size_t)nxt.pn * tstepB : cB;
        for (int t = 0; t < nt; t += 2) {
            const bool last = (t == nt - 2);
            const char* a1 = cA + (size_t)(t + 1) * kstep;
            const char* a2 = last ? nA : cA + (size_t)(t + 2) * kstep; const char* b2 = last ? nB : cB + (size_t)(t + 2) * kstep;
            const char* a3 = a2 + kstep; const char* b3 = b2 + kstep;
            PG8_LDB(B0, 0, 0); PG8_SCHED; PG8_LDA(At, 0, 0); PG8_STAGE(PG8_SA(1, 1), a1 + hstepA, voffA);
            PG8_WAIT_L(8); PG8_BAR; PG8_WAIT_L(0); PG8_MMA(0, 0, At, B0); PG8_BAR; PG8_SCHED;
            PG8_LDB(B1, 0, 1); PG8_STAGE(PG8_SB(0, 0), b2, voffB);
            PG8_BAR; PG8_WAIT_L(0); PG8_MMA(0, 1, At, B1); PG8_BAR;
            PG8_LDA(At, 0, 1); PG8_STAGE(PG8_SA(0, 0), a2, voffA);
            PG8_BAR; PG8_WAIT_L(0); PG8_MMA(1, 0, At, B0); PG8_BAR; PG8_SCHED;
            PG8_STAGE(PG8_SB(0, 1), b2 + hstepB, voffB);
            PG8_WAIT_V(6); PG8_BAR; PG8_MMA(1, 1, At, B1); PG8_BAR;
            PG8_LDB(B0, 1, 0); PG8_SCHED; PG8_LDA(At, 1, 0); PG8_STAGE(PG8_SA(0, 1), a2 + hstepA, voffA);
            PG8_WAIT_L(8); PG8_BAR; PG8_WAIT_L(0); PG8_MMA(0, 0, At, B0); PG8_BAR; PG8_SCHED;
            PG8_LDB(B1, 1, 1); PG8_STAGE(PG8_SB(1, 0), b3, voffB);
            PG8_BAR; PG8_WAIT_L(0); PG8_MMA(0, 1, At, B1); PG8_BAR;
            PG8_LDA(At, 1, 1); PG8_STAGE(PG8_SA(1, 0), a3, voffA);
            PG8_BAR; PG8_WAIT_L(0); PG8_MMA(1, 0, At, B0); PG8_BAR; PG8_SCHED;
            PG8_STAGE(PG8_SB(1, 1), b3 + hstepB, voffB);
            PG8_WAIT_V(6); PG8_BAR; PG8_MMA(1, 1, At, B1); PG8_BAR;
            if constexpr (Epi::HOOK) { if ((((t + 2) & 3) == 0) && !last) E.hook(acc, cur, (t + 2) >> 2, wr, wc, fr, fq); }
        }
        E(acc, cur, wr, wc, fr, fq);
        if (!has_next) break;
#pragma unroll
        for (int a = 0; a < 2; ++a)
#pragma unroll
            for (int b = 0; b < 2; ++b)
#pragma unroll
                for (int m = 0; m < 4; ++m)
#pragma unroll
                    for (int n = 0; n < 2; ++n) acc[a][b][m][n] = (f32x4){0.f, 0.f, 0.f, 0.f};
        cur = nxt; cA = nA; cB = nB; ++ui;
    }
    PG8_WAIT_V(0);
    if (wr == 0) PG8_BAR;
    PG8_BAR;
#undef PG8_SA
#undef PG8_SB
#undef PG8_STAGE
#undef PG8_LDA
#undef PG8_LDB
#undef PG8_MMA
#undef PG8_WAIT_V
#undef PG8_WAIT_L
#undef PG8_BAR
#undef PG8_SCHED
}
}
using pg8::Unit;

__device__ __forceinline__ size_t g8_off(int row, int colg) { return ((size_t)(row >> 4) * 128 + (colg >> 5)) * 512 + (row & 15) * 32 + (colg & 31); }

struct EpiSwiglu {
    static constexpr bool HOOK = false;
    static constexpr bool PERM = true;
    bf16_t* HID;
    __device__ __forceinline__ void operator()(const f32x4 (&acc)[2][2][4][2], const Unit& u, int wr, int wc, int fr, int fq) const {
        { const int t_ = opaque_tid(); wr = t_ >> 8; wc = (t_ >> 6) & 3; fr = t_ & 15; fq = (t_ >> 4) & 3; }
        const int row0 = u.pm * 256 + wr * 64 + fr, col0 = u.pn * 128 + wc * 32 + 8 * fq;
#pragma unroll
        for (int ai = 0; ai < 2; ++ai)
#pragma unroll
            for (int m = 0; m < 4; ++m) {
                const int row = row0 + ai * 128 + m * 16;
                float hv[8];
#pragma unroll
                for (int n = 0; n < 2; ++n)
#pragma unroll
                    for (int j = 0; j < 4; ++j) { const float a = acc[ai][0][m][n][j], b = acc[ai][1][m][n][j]; hv[4 * n + j] = a * sigmoidf_(a) * b; }
                u32x4 w; w.x = cvt_pk_bf16(hv[0], hv[1]); w.y = cvt_pk_bf16(hv[2], hv[3]); w.z = cvt_pk_bf16(hv[4], hv[5]); w.w = cvt_pk_bf16(hv[6], hv[7]);
                *(u32x4*)(HID + (size_t)row * FH + col0) = w;
            }
    }
};
struct EpiResid {
    static constexpr bool HOOK = false;
    static constexpr bool PERM = false;
    float* Hl; float* Hc; const float* gate; float coef;
    __device__ __forceinline__ void operator()(const f32x4 (&acc)[2][2][4][2], const Unit& u, int wr, int wc, int fr, int fq) const {
        { const int t_ = opaque_tid(); wr = t_ >> 8; wc = (t_ >> 6) & 3; fr = t_ & 15; fq = (t_ >> 4) & 3; }
        const int row0 = u.pm * 256 + wr * 64 + fr, col0 = u.pn * 256 + wc * 32 + 4 * fq;
#pragma unroll
        for (int ai = 0; ai < 2; ++ai)
#pragma unroll
            for (int m = 0; m < 4; ++m) {
                const int row = row0 + ai * 128 + m * 16;
                float* hp = row < RL ? Hl + (size_t)row * 1024 : Hc + (size_t)(row - RL) * 1024;
                const float* gp = gate + (row < RL ? (row >> 13) : 4) * 9216;
#pragma unroll
                for (int bj = 0; bj < 2; ++bj)
#pragma unroll
                    for (int n = 0; n < 2; ++n) {
                        const int c = col0 + bj * 128 + n * 16;
                        const f32x4 g4 = *(const f32x4*)(gp + c); f32x4 h4 = *(const f32x4*)(hp + c);
                        h4 += (g4 * coef) * acc[ai][bj][m][n];
                        *(f32x4*)(hp + c) = h4;
                    }
            }
    }
};
struct EpiPartial {
    static constexpr bool HOOK = false;
    static constexpr bool PERM = false;
    float* PB; const float* gate; float coef;
    __device__ __forceinline__ void operator()(const f32x4 (&acc)[2][2][4][2], const Unit& u, int wr, int wc, int fr, int fq) const {
        { const int t_ = opaque_tid(); wr = t_ >> 8; wc = (t_ >> 6) & 3; fr = t_ & 15; fq = (t_ >> 4) & 3; }
        const int row0 = u.pm * 256 + wr * 64 + fr - RL, col0 = u.pn * 256 + wc * 32 + 4 * fq;
#pragma unroll
        for (int ai = 0; ai < 2; ++ai)
#pragma unroll
            for (int m = 0; m < 4; ++m) {
                float* hp = PB + (size_t)(row0 + ai * 128 + m * 16) * 1024;
#pragma unroll
                for (int bj = 0; bj < 2; ++bj)
#pragma unroll
                    for (int n = 0; n < 2; ++n) {
                        const int c = col0 + bj * 128 + n * 16;
                        const f32x4 g4 = *(const f32x4*)(gate + c);
                        *(f32x4*)(hp + c) = (g4 * coef) * acc[ai][bj][m][n];
                    }
            }
    }
};
struct EpiPJ {
    static constexpr bool HOOK = false;
    static constexpr bool PERM = true;
    bf16_t* PJ; unsigned char* G8;
    __device__ __forceinline__ void operator()(const f32x4 (&acc)[2][2][4][2], const Unit& u, int wr, int wc, int fr, int fq) const {
        { const int t_ = opaque_tid(); wr = t_ >> 8; wc = (t_ >> 6) & 3; fr = t_ & 15; fq = (t_ >> 4) & 3; }
        const int row0 = u.pm * 256 + wr * 64 + fr, c0 = wc * 32 + 8 * fq;
        if (u.pn < 9) {
#pragma unroll
            for (int ai = 0; ai < 2; ++ai)
#pragma unroll
                for (int m = 0; m < 4; ++m) {
                    const int row = row0 + ai * 128 + m * 16;
#pragma unroll
                    for (int bj = 0; bj < 2; ++bj) {
                        const f32x4 v0 = acc[ai][bj][m][0], v1 = acc[ai][bj][m][1];
                        u32x4 w; w.x = cvt_pk_bf16(v0[0], v0[1]); w.y = cvt_pk_bf16(v0[2], v0[3]); w.z = cvt_pk_bf16(v1[0], v1[1]); w.w = cvt_pk_bf16(v1[2], v1[3]);
                        *(u32x4*)(PJ + (size_t)row * PJW + u.pn * 256 + bj * 128 + c0) = w;
                    }
                }
        } else {
#pragma unroll
            for (int ai = 0; ai < 2; ++ai)
#pragma unroll
                for (int m = 0; m < 4; ++m) {
                    const int row = row0 + ai * 128 + m * 16;
#pragma unroll
                    for (int bj = 0; bj < 2; ++bj) {
                        unsigned q[8];
#pragma unroll
                        for (int n = 0; n < 2; ++n)
#pragma unroll
                            for (int j = 0; j < 4; ++j) { int v = (int)(sigmoidf_(acc[ai][bj][m][n][j]) * 256.0f); q[4 * n + j] = (unsigned)(v > 255 ? 255 : v); }
                        u32x2 w; w.x = q[0] | (q[1] << 8) | (q[2] << 16) | (q[3] << 24); w.y = q[4] | (q[5] << 8) | (q[6] << 16) | (q[7] << 24);
                        *(u32x2*)(G8 + g8_off(row, (u.pn - 9) * 256 + bj * 128 + c0)) = w;
                    }
                }
        }
    }
};
struct EpiMLA {
    static constexpr bool HOOK = false;
    static constexpr bool PERM = true;
    bf16_t *MQ, *MK, *MV; const float* RSTD; const float2* RT;
    __device__ __forceinline__ void operator()(const f32x4 (&acc)[2][2][4][2], const Unit& u, int wr, int wc, int fr, int fq) const {
        { const int t_ = opaque_tid(); wr = t_ >> 8; wc = (t_ >> 6) & 3; fr = t_ & 15; fq = (t_ >> 4) & 3; }
        const int row0 = u.pm * 256 + wr * 64 + fr;
#pragma unroll
        for (int bj = 0; bj < 2; ++bj) {
            const int cg0 = u.pn * 256 + bj * 128 + wc * 32;
            if (cg0 >= 896) continue;
#pragma unroll
            for (int ai = 0; ai < 2; ++ai)
#pragma unroll
                for (int m = 0; m < 4; ++m) {
                    __builtin_amdgcn_sched_barrier(0);
                    const int row = row0 + ai * 128 + m * 16;
                    float v[8];
                    if (cg0 < 384) {
                        const float rs = RSTD[row * 2];
#pragma unroll
                        for (int n = 0; n < 2; ++n)
#pragma unroll
                            for (int j = 0; j < 4; ++j) v[4 * n + j] = acc[ai][bj][m][n][j] * rs;
                        const int d0 = cg0 % 96;
                        if (d0 == 64) {
                            const bool lat = row < RL; const int t = row & 8191; const int pos = (fq >> 1) ? (t & 63) : (t >> 6); const bool isx2 = fq & 1;
#pragma unroll
                            for (int e = 0; e < 8; ++e) {
                                const float pr = shflx(v[e], 16);
                                const float2 cs = RT[pos * 8 + e];
                                const float r = isx2 ? (pr * cs.y + v[e] * cs.x) : (v[e] * cs.x - pr * cs.y);
                                v[e] = lat ? r : v[e];
                            }
                        }
                        u32x4 w; w.x = cvt_pk_bf16(v[0], v[1]); w.y = cvt_pk_bf16(v[2], v[3]); w.z = cvt_pk_bf16(v[4], v[5]); w.w = cvt_pk_bf16(v[6], v[7]);
                        *(u32x4*)(MQ + (size_t)row * 384 + cg0 + 8 * fq) = w;
                    } else {
                        const float rs = RSTD[row * 2 + 1];
#pragma unroll
                        for (int n = 0; n < 2; ++n)
#pragma unroll
                            for (int j = 0; j < 4; ++j) v[4 * n + j] = acc[ai][bj][m][n][j] * rs;
                        const int cp = cg0 - 384, hd = cp >> 7, d0 = cp & 127;
                        u32x4 w; w.x = cvt_pk_bf16(v[0], v[1]); w.y = cvt_pk_bf16(v[2], v[3]); w.z = cvt_pk_bf16(v[4], v[5]); w.w = cvt_pk_bf16(v[6], v[7]);
                        if (d0 < 64) *(u32x4*)(MK + (size_t)row * 384 + hd * 96 + d0 + 8 * fq) = w;
                        else *(u32x4*)(MV + (size_t)row * 256 + hd * 64 + (d0 - 64) + 8 * fq) = w;
                    }
                }
        }
    }
};
struct EpiMerge {
    static constexpr bool PERM = true, HOOK = true;
    const unsigned char* G8; bf16_t* MG;
    __device__ __forceinline__ void hook(f32x4 (&acc)[2][2][4][2], const Unit& u, int nb, int wr, int wc, int fr, int fq) const {
        { const int t_ = opaque_tid(); wr = t_ >> 8; wc = (t_ >> 6) & 3; fr = t_ & 15; fq = (t_ >> 4) & 3; }
        const int row0 = u.pm * 256 + wr * 64 + fr, c0 = u.pn * 256 + wc * 32 + 8 * fq;
#pragma unroll
        for (int ai = 0; ai < 2; ++ai) {
            u32x2 ga[4][2], gb[4][2];
#pragma unroll
            for (int m = 0; m < 4; ++m)
#pragma unroll
                for (int bj = 0; bj < 2; ++bj) { const int row = row0 + ai * 128 + m * 16, c = c0 + bj * 128;
                    ga[m][bj] = *(const u32x2*)(G8 + g8_off(row, (nb - 1) * 1024 + c)); gb[m][bj] = *(const u32x2*)(G8 + g8_off(row, nb * 1024 + c)); }
#pragma unroll
            for (int m = 0; m < 4; ++m)
#pragma unroll
                for (int bj = 0; bj < 2; ++bj)
#pragma unroll
                    for (int e = 0; e < 8; ++e) { const unsigned qa = ((e < 4 ? ga[m][bj].x : ga[m][bj].y) >> (8 * (e & 3))) & 255u, qb = ((e < 4 ? gb[m][bj].x : gb[m][bj].y) >> (8 * (e & 3))) & 255u;
                        acc[ai][bj][m][e >> 2][e & 3] *= ((float)qa + 0.5f) * fast_rcp((float)qb + 0.5f); }
            __builtin_amdgcn_sched_barrier(0);
        }
    }
    __device__ __forceinline__ void operator()(const f32x4 (&acc)[2][2][4][2], const Unit& u, int wr, int wc, int fr, int fq) const {
        { const int t_ = opaque_tid(); wr = t_ >> 8; wc = (t_ >> 6) & 3; fr = t_ & 15; fq = (t_ >> 4) & 3; }
        const int row0 = u.pm * 256 + wr * 64 + fr, c0 = u.pn * 256 + wc * 32 + 8 * fq;
#pragma unroll
        for (int ai = 0; ai < 2; ++ai) {
            u32x2 gq[4][2];
#pragma unroll
            for (int m = 0; m < 4; ++m)
#pragma unroll
                for (int bj = 0; bj < 2; ++bj) gq[m][bj] = *(const u32x2*)(G8 + g8_off(row0 + ai * 128 + m * 16, 3 * 1024 + c0 + bj * 128));
#pragma unroll
            for (int m = 0; m < 4; ++m)
#pragma unroll
                for (int bj = 0; bj < 2; ++bj) {
                    const int row = row0 + ai * 128 + m * 16, c = c0 + bj * 128;
                    float v[8];
#pragma unroll
                    for (int e = 0; e < 8; ++e) { const unsigned q = ((e < 4 ? gq[m][bj].x : gq[m][bj].y) >> (8 * (e & 3))) & 255u; v[e] = ((float)q + 0.5f) * (1.0f / 256.0f) * acc[ai][bj][m][e >> 2][e & 3]; }
                    u32x4 w; w.x = cvt_pk_bf16(v[0], v[1]); w.y = cvt_pk_bf16(v[2], v[3]); w.z = cvt_pk_bf16(v[4], v[5]); w.w = cvt_pk_bf16(v[6], v[7]);
                    *(u32x4*)(MG + (size_t)row * 1024 + c) = w;
                }
            __builtin_amdgcn_sched_barrier(0);
        }
    }
};

template <class F>
__device__ __forceinline__ void wt_rows64(bf16_t* dst, int K, F srcval, int ldd, int kbeg, int kend) {
    if (ldd == 0) ldd = K;
    if (kend > K) kend = K;
    const int tid_ = opaque_tid(); const int nl = tid_ & 63, kq = tid_ >> 6;
    for (int k0 = kbeg + kq * 8; k0 < kend; k0 += 64) {
        float v[8];
#pragma unroll
        for (int j = 0; j < 8; ++j) v[j] = srcval(nl, k0 + j);
        u32x4 w; w.x = cvt_pk_bf16(v[0], v[1]); w.y = cvt_pk_bf16(v[2], v[3]); w.z = cvt_pk_bf16(v[4], v[5]); w.w = cvt_pk_bf16(v[6], v[7]);
        *(u32x4*)(dst + (size_t)nl * ldd + k0) = w;
    }
}

__device__ void layer_prep_phase(PK p, int l, LAS unsigned char* lds) {
    unsigned char* ws = p->ws;
    const int nW = 1648, nItems = nW + (l == 0 ? 288 + 1 : 0);
    for (int it2 = opaque_bid(); it2 < nItems; it2 += opaque_gdim()) {
        int it, kbeg = 0, kend = 1 << 30;
        if (it2 < 704) { it = it2 >> 2; kbeg = (it2 & 3) * 256; kend = kbeg + 256; }
        else if (it2 < 1056) { const int q = it2 - 704; it = 176 + q / 11; kbeg = (q % 11) * 256; kend = kbeg + 256; }
        else if (it2 < 1456) { const int q = it2 - 1056; it = 208 + (q >> 2); kbeg = (q & 3) * 256; kend = kbeg + 256; }
        else if (it2 < 1520) { const int q = it2 - 1456; it = 308 + (q >> 2); kbeg = (q & 3) * 256; kend = kbeg + 256; }
        else if (it2 < 1568) { it = 324 + (it2 - 1520); }
        else if (it2 < 1632) { const int q = it2 - 1568; it = 372 + (q >> 2); kbeg = (q & 3) * 64; kend = kbeg + 64; }
        else if (it2 < 1648) { it = 388 + (it2 - 1632); }
        else it = 404 + (it2 - 1648);
        if (it < 176) {
            const int f = it / 88, j = it % 88; const float* src = p->ffn_w_in + ((size_t)(l * 2 + f) * 1024) * 5632;
            bf16_t* dst = (bf16_t*)(ws + OFF_W1) + ((size_t)f * 5632 + j * 64) * 1024;
            wt_rows64(dst, 1024, [&](int nl, int k) { const int np = j * 64 + nl, pn = np >> 8, wi = np & 255; const int col = wi < 128 ? pn * 128 + wi : FH + pn * 128 + (wi - 128); return src[(size_t)k * 5632 + col]; }, 0, kbeg, kend);
        } else if (it < 208) {
            const int q = it - 176, f = q / 16, j = q % 16; const float* src = p->ffn_w_out + ((size_t)(l * 2 + f) * FH) * 1024;
            bf16_t* dst = (bf16_t*)(ws + OFF_W2) + ((size_t)f * 1024 + j * 64) * FH;
            wt_rows64(dst, FH, [&](int nl, int k) { return src[(size_t)k * 1024 + j * 64 + nl]; }, 0, kbeg, kend);
        } else if (it < 308) {
            const int j = it - 208; const float* src = p->mix_w_in + (size_t)l * 1024 * 6304;
            bf16_t* dst = (bf16_t*)(ws + OFF_WM) + (size_t)j * 64 * 1024;
            wt_rows64(dst, 1024, [&](int nl, int k) { const int np = j * 64 + nl; const int col = np < 2208 ? np : (np < 2304 ? -1 : np - 96); return col < 0 ? 0.f : src[(size_t)k * 6304 + col]; }, 0, kbeg, kend);
        } else if (it < 324) {
            const int j = it - 308; const float* src = p->mix_w_out + (size_t)l * 1024 * 1024;
            bf16_t* dst = (bf16_t*)(ws + OFF_WO) + (size_t)j * 64 * 1024;
            wt_rows64(dst, 1024, [&](int nl, int k) { return src[(size_t)k * 1024 + j * 64 + nl]; }, 0, kbeg, kend);
        } else if (it < 372) {
            const int q = it - 324, bi = 1 + q / 16, j = q % 16; const float* src = p->branch_w_out + ((size_t)(l * 4 + bi) * 256) * 1024;
            bf16_t* dst = (bf16_t*)(ws + OFF_WB) + (size_t)j * 64 * 1024 + bi * 256;
            wt_rows64(dst, 256, [&](int nl, int k) { return src[(size_t)k * 1024 + j * 64 + nl]; }, 1024, kbeg, kend);
        } else if (it < 388) {
            const int j = it - 372; const float* wb = p->branch_w_out + ((size_t)(l * 4) * 256) * 1024; const float* pw = p->pool_w + (size_t)l * 4 * 64 * 64; const float* ps = p->pool_scale + l * 256;
            bf16_t* dst = (bf16_t*)(ws + OFF_WB) + (size_t)j * 64 * 1024;
            wt_rows64(dst, 256, [&](int nl, int k) { const int gI = k >> 6, n = j * 64 + nl; const float* pr = pw + (size_t)k * 64; float s = 0.f;
                for (int e = 0; e < 64; ++e) s += pr[e] * ps[gI * 64 + e] * wb[(size_t)(gI * 64 + e) * 1024 + n]; return s; }, 1024, kbeg, kend);
        } else if (it < 404) {
            const int j = it - 388; const float* wq = p->mla_w_qb + (size_t)l * 256 * 384; const float* wk = p->mla_w_kvb + (size_t)l * 128 * 512;
            const float* gq = p->mla_q_norm_g + l * 256; const float* gk = p->mla_kv_norm_g + l * 128;
            bf16_t* dst = (bf16_t*)(ws + OFF_WL) + (size_t)j * 64 * 384;
            wt_rows64(dst, 384, [&](int nl, int k) { const int n = j * 64 + nl;
                if (n < 384) return k < 256 ? gq[k] * wq[(size_t)k * 384 + n] : 0.f;
                if (n < 896) return k >= 256 ? gk[k - 256] * wk[(size_t)(k - 256) * 512 + (n - 384)] : 0.f;
                return 0.f; }, 0, kbeg, kend);
        } else if (it < 404 + 288) {
            const int q = it - 404, ll = q / 144, cb = q % 144;
            LAS float* sc = (LAS float*)lds;
            LAS float* red = (LAS float*)(lds + 5 * 1024 * 4);
            __syncthreads();
            for (int i = opaque_tid(); i < 5 * 1024; i += 512) { const int r = i >> 10, k = i & 1023; const float cv = r < 4 ? p->c[r * 1024 + k] : p->c_ctx[k]; sc[i] = cv * sigmoidf_(cv); }
            __syncthreads();
            const int jl = opaque_tid() & 63, kg = opaque_tid() >> 6; const int col = cb * 64 + jl;
            const float* wsrc = p->ada_w + (size_t)ll * 1024 * 9216 + col;
            float a0 = 0.f, a1 = 0.f, a2 = 0.f, a3 = 0.f, a4 = 0.f;
            for (int k = kg * 128; k < kg * 128 + 128; ++k) { const float wv = wsrc[(size_t)k * 9216]; a0 += sc[k] * wv; a1 += sc[1024 + k] * wv; a2 += sc[2048 + k] * wv; a3 += sc[3072 + k] * wv; a4 += sc[4096 + k] * wv; }
            red[(kg * 5 + 0) * 64 + jl] = a0; red[(kg * 5 + 1) * 64 + jl] = a1; red[(kg * 5 + 2) * 64 + jl] = a2; red[(kg * 5 + 3) * 64 + jl] = a3; red[(kg * 5 + 4) * 64 + jl] = a4;
            __syncthreads();
            if (opaque_tid() < 320) { const int r = opaque_tid() >> 6; float s = p->ada_b[ll * 9216 + col];
                for (int q2 = 0; q2 < 8; ++q2) s += red[(q2 * 5 + r) * 64 + jl];
                ((float*)(ws + OFF_MOD))[(size_t)(ll * 5 + r) * 9216 + col] = s; }
        } else {
            for (int i = opaque_tid(); i < 1024; i += 512) { const int pos = i >> 3, fi = i & 7; const float inv = exp2f(-(float)fi * 0.125f * 13.287712379549449f); const float ang = (float)pos * inv;
                ((float2*)(ws + OFF_ROPE))[i] = make_float2(cosf(ang), sinf(ang)); }
        }
    }
}

__device__ void norm_mod_phase(const float* srcL, const float* srcC, float* cpyL, float* cpyC, const float* g, const float* mod, bf16_t* TN, int nrows, const float* pb, int nsl) {
    const int tid_ = opaque_tid(); const int lane = tid_ & 63, gw = opaque_bid() * 8 + (tid_ >> 6), nw = opaque_gdim() * 8;
    for (int row = gw; row < nrows; row += nw) {
        const bool lat = row < RL;
        const float* sp = lat ? srcL + (size_t)row * 1024 : srcC + (size_t)(row - RL) * 1024;
        const float* mp = mod + (lat ? (row >> 13) : 4) * 9216;
        f32x4 v[4]; float ss = 0.f;
#pragma unroll
        for (int j = 0; j < 4; ++j) v[j] = *(const f32x4*)(sp + 256 * j + 4 * lane);
        if (!lat && nsl > 0) {
            for (int sl = 0; sl < nsl; ++sl) { const float* pp = pb + ((size_t)sl * 1024 + (row - RL)) * 1024;
#pragma unroll
                for (int j = 0; j < 4; ++j) v[j] += *(const f32x4*)(pp + 256 * j + 4 * lane); }
            float* wp = (float*)sp;
#pragma unroll
            for (int j = 0; j < 4; ++j) *(f32x4*)(wp + 256 * j + 4 * lane) = v[j];
        }
#pragma unroll
        for (int j = 0; j < 4; ++j) ss += v[j][0] * v[j][0] + v[j][1] * v[j][1] + v[j][2] * v[j][2] + v[j][3] * v[j][3];
        if (cpyL) { float* cp = lat ? cpyL + (size_t)row * 1024 : cpyC + (size_t)(row - RL) * 1024;
#pragma unroll
            for (int j = 0; j < 4; ++j) *(f32x4*)(cp + 256 * j + 4 * lane) = v[j]; }
        ss = wave_sum(ss);
        const float rstd = rsqrtf(ss * (1.0f / 1024.0f) + NEPS);
#pragma unroll
        for (int j = 0; j < 4; ++j) {
            const int col = 256 * j + 4 * lane;
            const f32x4 gg = *(const f32x4*)(g + col), sh = *(const f32x4*)(mp + col), sc = *(const f32x4*)(mp + 1024 + col);
            float o[4];
#pragma unroll
            for (int e = 0; e < 4; ++e) o[e] = (v[j][e] * rstd * gg[e]) * (1.0f + sc[e]) + sh[e];
            u32x2 w; w.x = cvt_pk_bf16(o[0], o[1]); w.y = cvt_pk_bf16(o[2], o[3]);
            *(u32x2*)(TN + (size_t)row * 1024 + col) = w;
        }
    }
}
__device__ void final_norm_phase(float* H, const float* g) {
    const int tid_ = opaque_tid(); const int lane = tid_ & 63, gw = opaque_bid() * 8 + (tid_ >> 6), nw = opaque_gdim() * 8;
    for (int row = gw; row < RL; row += nw) {
        float* sp = H + (size_t)row * 1024; f32x4 v[4]; float ss = 0.f;
#pragma unroll
        for (int j = 0; j < 4; ++j) { v[j] = *(const f32x4*)(sp + 256 * j + 4 * lane); ss += v[j][0] * v[j][0] + v[j][1] * v[j][1] + v[j][2] * v[j][2] + v[j][3] * v[j][3]; }
        ss = wave_sum(ss);
        const float rstd = rsqrtf(ss * (1.0f / 1024.0f) + NEPS);
#pragma unroll
        for (int j = 0; j < 4; ++j) { const f32x4 gg = *(const f32x4*)(g + 256 * j + 4 * lane); *(f32x4*)(sp + 256 * j + 4 * lane) = v[j] * rstd * gg; }
    }
}

__device__ void prep_phase(PK p) {
    unsigned char* ws = p->ws;
    bf16_t* PJ = (bf16_t*)(ws + OFF_B); bf16_t* YB = (bf16_t*)(ws + OFF_A); bf16_t* MK = (bf16_t*)(ws + OFF_MK); float* RSTD = (float*)(ws + OFF_RSTD);
    const float2* RT = (const float2*)(ws + OFF_ROPE);
    const int tid_ = opaque_tid(); const int lane = tid_ & 63, gw = opaque_bid() * 8 + (tid_ >> 6), nw = opaque_gdim() * 8;
    for (int row = gw; row < RA; row += nw) {
        const bool lat = row < RL;
        int t, n; if (lat) { t = row & 8191; n = 8192; } else { t = (row - RL) & 255; n = 256; }
        const int sbase = row - t;
        bf16_t* prow = PJ + (size_t)row * PJW;
        {
            const int wdw = 2 << (lane >> 4), hw = wdw >> 1; const int lo = max(t - hw, 0), hi = min(t + hw, n);
            float s0 = 0.f, s1 = 0.f, s2 = 0.f, s3 = 0.f;
#pragma unroll
            for (int i = 0; i < 16; ++i) {
                const int off = i - 8, tt = t + off; const bool ok = (off >= -hw) && (off < hw) && (tt >= 0) && (tt < n);
                const u32x2 v = *(const u32x2*)(PJ + (size_t)(sbase + (ok ? tt : t)) * PJW + 4 * lane); const float wg = ok ? 1.0f : 0.0f;
                s0 += wg * bf_lo(v.x); s1 += wg * bf_hi(v.x); s2 += wg * bf_lo(v.y); s3 += wg * bf_hi(v.y); }
            const float ic = 1.0f / (float)(hi - lo); const u32x2 sv = *(const u32x2*)(prow + 4 * lane);
            u32x2 w; w.x = cvt_pk_bf16(s0 * ic - bf_lo(sv.x), s1 * ic - bf_hi(sv.x)); w.y = cvt_pk_bf16(s2 * ic - bf_lo(sv.y), s3 * ic - bf_hi(sv.y));
            *(u32x2*)(YB + (size_t)row * 1024 + 4 * lane) = w;
        }
        {
            const u32x2 q = *(const u32x2*)(prow + C_MQ + 4 * lane); const unsigned kv = *(const unsigned*)(prow + C_MKV + 2 * lane);
            float sq = bf_lo(q.x) * bf_lo(q.x) + bf_hi(q.x) * bf_hi(q.x) + bf_lo(q.y) * bf_lo(q.y) + bf_hi(q.y) * bf_hi(q.y);
            float sk = bf_lo(kv) * bf_lo(kv) + bf_hi(kv) * bf_hi(kv);
            sq = wave_sum(sq); sk = wave_sum(sk);
            if (lane == 0) { RSTD[row * 2] = rsqrtf(sq * (1.0f / 256.0f) + NEPS); RSTD[row * 2 + 1] = rsqrtf(sk * (1.0f / 128.0f) + NEPS); }
        }
        if (lane < 34) {
            const bool iskr = lane >= 32; const int a = lane & 1;
            bf16_t* ep = iskr ? prow + C_MKR + a * 16 : prow + ((lane >> 4) ? C_DK : C_DQ) + ((lane >> 1) & 7) * 32 + a * 16;
            const u32x4 e0 = *(const u32x4*)ep, e1 = *(const u32x4*)(ep + 8);
            float x1[8], x2[8];
            x1[0] = bf_lo(e0.x); x1[1] = bf_hi(e0.x); x1[2] = bf_lo(e0.y); x1[3] = bf_hi(e0.y); x1[4] = bf_lo(e0.z); x1[5] = bf_hi(e0.z); x1[6] = bf_lo(e0.w); x1[7] = bf_hi(e0.w);
            x2[0] = bf_lo(e1.x); x2[1] = bf_hi(e1.x); x2[2] = bf_lo(e1.y); x2[3] = bf_hi(e1.y); x2[4] = bf_lo(e1.z); x2[5] = bf_hi(e1.z); x2[6] = bf_lo(e1.w); x2[7] = bf_hi(e1.w);
            if (lat) { const int pos = a ? (t & 63) : (t >> 6);
#pragma unroll
                for (int i = 0; i < 8; ++i) { const float2 cs = RT[pos * 8 + i]; const float o1 = x1[i] * cs.x - x2[i] * cs.y, o2 = x1[i] * cs.y + x2[i] * cs.x; x1[i] = o1; x2[i] = o2; } }
            u32x4 w0, w1; w0.x = cvt_pk_bf16(x1[0], x1[1]); w0.y = cvt_pk_bf16(x1[2], x1[3]); w0.z = cvt_pk_bf16(x1[4], x1[5]); w0.w = cvt_pk_bf16(x1[6], x1[7]);
            w1.x = cvt_pk_bf16(x2[0], x2[1]); w1.y = cvt_pk_bf16(x2[2], x2[3]); w1.z = cvt_pk_bf16(x2[4], x2[5]); w1.w = cvt_pk_bf16(x2[6], x2[7]);
            if (iskr) {
#pragma unroll
                for (int hh = 0; hh < 4; ++hh) { bf16_t* kp = MK + (size_t)row * 384 + hh * 96 + 64 + a * 16; *(u32x4*)kp = w0; *(u32x4*)(kp + 8) = w1; }
            } else if (lat) { *(u32x4*)ep = w0; *(u32x4*)(ep + 8) = w1; }
        }
    }
}

#define MFMA32(a, b, c) __builtin_amdgcn_mfma_f32_32x32x16_bf16((a), (b), (c), 0, 0, 0)
typedef float f32x2 __attribute__((ext_vector_type(2)));
template <int MODE>
__device__ __forceinline__ void attn_item(PK p, int l, LAS unsigned char* lds, int b, int h, int qb, bool ctxq, float lam, float lam_init) {
    constexpr int NCOMP = (MODE == 1) ? 2 : 1, NKS = (MODE == 0) ? 4 : ((MODE == 1) ? 2 : 6), KW = NCOMP * NKS * 16, KCH = KW / 8, KSTR = KW * 2 + 16, VSTR = 192;
    constexpr int KBUF = 64 * KSTR, VBUF = 64 * VSTR, BUFSZ = KBUF + VBUF, BIAS_OFF = 3 * BUFSZ;
    constexpr bool STAG = (MODE != 0);
    const int tid = opaque_tid(), w = tid >> 6, lane = tid & 63, g = lane >> 5, l32 = lane & 31;
    unsigned char* ws = p->ws;
    const bf16_t* PJ = (const bf16_t*)(ws + OFF_B);
    const bf16_t *Qp, *Kp, *Vp; int ldq, ldk, ldv, outoff; float scale;
    if (MODE == 0) { Qp = PJ + C_NQ + 64 * h; Kp = PJ + C_NK + 64 * h; Vp = PJ + C_NV + 64 * h; ldq = ldk = ldv = PJW; outoff = 256 + 64 * h; scale = 0.125f; }
    else if (MODE == 1) { Qp = PJ + C_DQ + 64 * h; Kp = PJ + C_DK + 64 * h; Vp = PJ + C_DV + 64 * h; ldq = ldk = ldv = PJW; outoff = 512 + 64 * h; scale = 0.17677669529663687f; }
    else { Qp = (const bf16_t*)(ws + OFF_D) + 96 * h; Kp = (const bf16_t*)(ws + OFF_MK) + 96 * h; Vp = (const bf16_t*)(ws + OFF_MV) + 64 * h; ldq = ldk = 384; ldv = 256; outoff = 768 + 64 * h; scale = 0.10206207261596575f; }
    const float cs = scale * LOG2E;
    int qrow0, loc0, nloc;
    if (ctxq) { qrow0 = RL + b * 256; loc0 = 0; nloc = 0; }
    else { qrow0 = b * 8192 + qb * 256;
        if (MODE == 0) { const int r0 = qb * 4; loc0 = clampi(r0 - 4, 0, 120); nloc = clampi(r0 - 1, 0, 120) + 8 - loc0; } else { loc0 = 0; nloc = 128; } }
    const int nt = nloc + 4;
    const bool nabias = (MODE == 0) && !ctxq;
    const bool late = STAG && (w >= 4);
    const int rw = qb * 4 + (w >> 1), sw = clampi(rw - 4, 0, 120);
    const int jq = 32 * (w & 1) + l32, cst = clampi(jq - 8, 0, 48);
    if (nabias && tid < 465) ((LAS float*)(lds + BIAS_OFF))[tid] = p->na_rpb[(size_t)(l * 4 + h) * 465 + tid] * LOG2E;

    const size_t qrow = (size_t)qrow0 + 32 * w + l32;
    bf16x8 qf[NCOMP * NKS];
#pragma unroll
    for (int i = 0; i < NCOMP * NKS; ++i) {
        const u32x4 raw = *(const u32x4*)(Qp + qrow * ldq + 16 * i + 8 * g);
        u32x4 sc4; sc4.x = cvt_pk_bf16(bf_lo(raw.x) * cs, bf_hi(raw.x) * cs); sc4.y = cvt_pk_bf16(bf_lo(raw.y) * cs, bf_hi(raw.y) * cs);
        sc4.z = cvt_pk_bf16(bf_lo(raw.z) * cs, bf_hi(raw.z) * cs); sc4.w = cvt_pk_bf16(bf_lo(raw.w) * cs, bf_hi(raw.w) * cs);
        qf[i] = __builtin_bit_cast(bf16x8, sc4);
    }

    const int kr0 = tid / KCH, kc0 = tid % KCH, kr1 = (tid + 512) / KCH, kc1 = (tid + 512) % KCH, vr = tid >> 3, vc = tid & 7;
    const bool hask1 = (KCH == 12) && (tid < 256);
    u32x4 rk0, rk1 = (u32x4){0u, 0u, 0u, 0u}, rv;
#define TILE_ROW(t) ((t) < nloc ? (b * 8192 + 64 * (loc0 + (t))) : (RL + b * 256 + 64 * ((t) - nloc)))
#define LOAD_TILE(t) do { const size_t _tb = (size_t)TILE_ROW(t); rk0 = *(const u32x4*)(Kp + (_tb + kr0) * ldk + kc0 * 8); \
        if (hask1) rk1 = *(const u32x4*)(Kp + (_tb + kr1) * ldk + kc1 * 8); rv = *(const u32x4*)(Vp + (_tb + vr) * ldv + vc * 8); } while (0)
#define STORE_TILE(buf) do { LAS unsigned char* _kb = lds + (buf) * BUFSZ; *(LAS u32x4*)(_kb + kr0 * KSTR + kc0 * 16) = rk0; \
        if (hask1) *(LAS u32x4*)(_kb + kr1 * KSTR + kc1 * 16) = rk1; *(LAS u32x4*)(_kb + KBUF + vr * VSTR + vc * 16) = rv; } while (0)

    float mrun[NCOMP], lsum[NCOMP]; f32x16 O[NCOMP][2];
#pragma unroll
    for (int c = 0; c < NCOMP; ++c) { mrun[c] = -1e30f; lsum[c] = 0.f;
#pragma unroll
        for (int dt = 0; dt < 2; ++dt)
#pragma unroll
            for (int r = 0; r < 16; ++r) O[c][dt][r] = 0.f; }
    bf16x8 P[NCOMP][2][2];
#pragma unroll
    for (int c = 0; c < NCOMP; ++c)
#pragma unroll
        for (int kt = 0; kt < 2; ++kt)
#pragma unroll
            for (int s2 = 0; s2 < 2; ++s2) P[c][kt][s2] = (bf16x8){0, 0, 0, 0, 0, 0, 0, 0};

    LOAD_TILE(0); STORE_TILE(0); __syncthreads();
    const int koff = l32 * KSTR + g * 16;
    const int i16 = lane & 15, tq = i16 >> 2, tp = i16 & 3, blk = (lane >> 4) & 1;
    const int voff = (4 * g + tq) * VSTR + (16 * blk + 4 * tp) * 2;
#define PV_TILE(buf) do { LAS unsigned char* _vb = lds + (buf) * BUFSZ + KBUF + voff; \
        _Pragma("unroll") for (int kt = 0; kt < 2; ++kt) { bf16x8 vf[2][2]; \
            _Pragma("unroll") for (int s2 = 0; s2 < 2; ++s2) _Pragma("unroll") for (int dt = 0; dt < 2; ++dt) { LAS unsigned char* vp = _vb + (32 * kt + 16 * s2) * VSTR + dt * 64; \
                const s16x4 lo = __builtin_amdgcn_ds_read_tr16_b64_v4i16((LAS s16x4*)vp); const s16x4 hi = __builtin_amdgcn_ds_read_tr16_b64_v4i16((LAS s16x4*)(vp + 8 * VSTR)); \
                vf[s2][dt] = __builtin_shufflevector(lo, hi, 0, 1, 2, 3, 4, 5, 6, 7); } \
            __builtin_amdgcn_s_setprio(1); \
            _Pragma("unroll") for (int s2 = 0; s2 < 2; ++s2) _Pragma("unroll") for (int dt = 0; dt < 2; ++dt) _Pragma("unroll") for (int c = 0; c < NCOMP; ++c) O[c][dt] = MFMA32(vf[s2][dt], P[c][kt][s2], O[c][dt]); \
            __builtin_amdgcn_s_setprio(0); } } while (0)

#define PV_TILE_C(buf, cc) do { LAS unsigned char* _vb = lds + (buf) * BUFSZ + KBUF + voff; \
        _Pragma("unroll") for (int kt = 0; kt < 2; ++kt) { bf16x8 vf[2][2]; \
            _Pragma("unroll") for (int s2 = 0; s2 < 2; ++s2) _Pragma("unroll") for (int dt = 0; dt < 2; ++dt) { LAS unsigned char* vp = _vb + (32 * kt + 16 * s2) * VSTR + dt * 64; \
                const s16x4 lo = __builtin_amdgcn_ds_read_tr16_b64_v4i16((LAS s16x4*)vp); const s16x4 hi = __builtin_amdgcn_ds_read_tr16_b64_v4i16((LAS s16x4*)(vp + 8 * VSTR)); \
                vf[s2][dt] = __builtin_shufflevector(lo, hi, 0, 1, 2, 3, 4, 5, 6, 7); } \
            __builtin_amdgcn_s_setprio(1); \
            _Pragma("unroll") for (int s2 = 0; s2 < 2; ++s2) _Pragma("unroll") for (int dt = 0; dt < 2; ++dt) O[cc][dt] = MFMA32(vf[s2][dt], P[cc][kt][s2], O[cc][dt]); \
            __builtin_amdgcn_s_setprio(0); } } while (0)
    bool pend = false; int pbuf = 0, cbuf = 0;
    for (int t = 0; t < nt; ++t) {
        const bool more = (t + 1 < nt);
        if (more) LOAD_TILE(t + 1);
        bool active = true; int krow = 0;
        if (nabias && t < nloc) { krow = loc0 + t; active = (krow >= sw) && (krow < sw + 8); }
        if (active) {
            LAS unsigned char* Kb = lds + cbuf * BUFSZ + koff;
            f32x16 S[NCOMP][2];
#pragma unroll
            for (int c = 0; c < NCOMP; ++c)
#pragma unroll
                for (int kt = 0; kt < 2; ++kt) {
                    bf16x8 kf[NKS];
#pragma unroll
                    for (int ks = 0; ks < NKS; ++ks) kf[ks] = *(const LAS bf16x8*)(Kb + kt * 32 * KSTR + (c * NKS + ks) * 32);
#pragma unroll
                    for (int r = 0; r < 16; ++r) S[c][kt][r] = 0.f;
                    __builtin_amdgcn_s_setprio(1);
#pragma unroll
                    for (int ks = 0; ks < NKS; ++ks) S[c][kt] = MFMA32(kf[ks], qf[c * NKS + ks], S[c][kt]);
                    __builtin_amdgcn_s_setprio(0);
                }
            if (STAG && late && pend) PV_TILE(pbuf);
            float mxc[NCOMP], mnw[NCOMP];
#pragma unroll
            for (int c = 0; c < NCOMP; ++c) {
                float mx = -1e30f;
                if (nabias && t < nloc) {
                    const LAS float* bt = (const LAS float*)(lds + BIAS_OFF) + (krow - rw + 7) * 31;
#pragma unroll
                    for (int kt = 0; kt < 2; ++kt)
#pragma unroll
                        for (int r = 0; r < 16; ++r) { const int jk = 32 * kt + (r & 3) + 8 * (r >> 2) + 4 * g; const bool ok = (jk >= cst) && (jk < cst + 16);
                            const float bv = bt[clampi(jk - jq + 15, 0, 30)]; const float xv = ok ? (S[c][kt][r] + bv) : -1e30f; S[c][kt][r] = xv; mx = fmaxf(mx, xv); }
                } else {
#pragma unroll
                    for (int kt = 0; kt < 2; ++kt)
#pragma unroll
                        for (int r = 0; r < 16; r += 2) mx = fmaxf(fmaxf(mx, S[c][kt][r]), S[c][kt][r + 1]);
                }
                mxc[c] = mx;
            }
#pragma unroll
            for (int c = 0; c < NCOMP; ++c) mxc[c] = fmaxf(mxc[c], shflx(mxc[c], 32));
            bool grow = false;
#pragma unroll
            for (int c = 0; c < NCOMP; ++c) { mnw[c] = fmaxf(mrun[c], mxc[c]); grow = grow || (mnw[c] > mrun[c]); }
            if (__any(grow)) {
#pragma unroll
                for (int c = 0; c < NCOMP; ++c) { const float alpha = fast_exp2(mrun[c] - mnw[c]); lsum[c] *= alpha;
#pragma unroll
                    for (int dt = 0; dt < 2; ++dt) O[c][dt] *= alpha;
                    mrun[c] = mnw[c]; }
            }
#pragma unroll
            for (int c = 0; c < NCOMP; ++c) { const f32x2 m2 = (f32x2){mnw[c], mnw[c]};
#pragma unroll
                for (int kt = 0; kt < 2; ++kt)
#pragma unroll
                    for (int r = 0; r < 16; r += 2) { const f32x2 d = (f32x2){S[c][kt][r], S[c][kt][r + 1]} - m2; S[c][kt][r] = d.x; S[c][kt][r + 1] = d.y; } }
#pragma unroll
            for (int c = 0; c < NCOMP; ++c)
#pragma unroll
                for (int kt = 0; kt < 2; ++kt)
#pragma unroll
                    for (int r = 0; r < 16; ++r) S[c][kt][r] = fast_exp2(S[c][kt][r]);
#pragma unroll
            for (int c = 0; c < NCOMP; ++c) { f32x2 rs2 = (f32x2){0.f, 0.f};
#pragma unroll
                for (int kt = 0; kt < 2; ++kt)
#pragma unroll
                    for (int s2 = 0; s2 < 2; ++s2) { u32x4 pk;
#pragma unroll
                        for (int e = 0; e < 4; ++e) { const f32x2 ev = (f32x2){S[c][kt][8 * s2 + 2 * e], S[c][kt][8 * s2 + 2 * e + 1]}; rs2 += ev; pk[e] = cvt_pk_bf16(ev.x, ev.y); }
                        P[c][kt][s2] = __builtin_bit_cast(bf16x8, pk); }
                lsum[c] += rs2.x + rs2.y; }
            if (!(STAG && late)) PV_TILE(cbuf);
            if (STAG && late) { pend = true; pbuf = cbuf; }
        }
        const int nbuf = (cbuf == 2) ? 0 : cbuf + 1;
        if (more) STORE_TILE(nbuf);
        __syncthreads();
        cbuf = nbuf;
    }
    if (STAG && late && pend) PV_TILE(pbuf);
#undef PV_TILE
#undef PV_TILE_C
#undef TILE_ROW
#undef LOAD_TILE
#undef STORE_TILE
    float inv[NCOMP];
#pragma unroll
    for (int c = 0; c < NCOMP; ++c) { const float lt = lsum[c] + shflx(lsum[c], 32); inv[c] = 1.0f / lt; }
    bf16_t* op = (bf16_t*)(ws + OFF_A) + qrow * 1024 + outoff;
    if (MODE == 1) {
        const float li1 = lam * inv[NCOMP - 1]; float ss = 0.f;
#pragma unroll
        for (int dt = 0; dt < 2; ++dt)
#pragma unroll
            for (int r = 0; r < 16; ++r) { const float o = O[0][dt][r] * inv[0] - li1 * O[NCOMP - 1][dt][r]; O[0][dt][r] = o; ss += o * o; }
        ss += shflx(ss, 32);
        const float rstd = rsqrtf(ss * (1.0f / 64.0f) + NEPS) * (1.0f - lam_init);
        const float* sg = p->diff_subln_g + l * 64;
#pragma unroll
        for (int dt = 0; dt < 2; ++dt)
#pragma unroll
            for (int rq = 0; rq < 4; ++rq) { const int dv = 32 * dt + 8 * rq + 4 * g; const f32x4 gg = *(const f32x4*)(sg + dv);
                u32x2 wv; wv.x = cvt_pk_bf16(O[0][dt][4 * rq] * rstd * gg[0], O[0][dt][4 * rq + 1] * rstd * gg[1]); wv.y = cvt_pk_bf16(O[0][dt][4 * rq + 2] * rstd * gg[2], O[0][dt][4 * rq + 3] * rstd * gg[3]);
                *(u32x2*)(op + dv) = wv; }
    } else {
#pragma unroll
        for (int dt = 0; dt < 2; ++dt)
#pragma unroll
            for (int rq = 0; rq < 4; ++rq) { const int dv = 32 * dt + 8 * rq + 4 * g;
                u32x2 wv; wv.x = cvt_pk_bf16(O[0][dt][4 * rq] * inv[0], O[0][dt][4 * rq + 1] * inv[0]); wv.y = cvt_pk_bf16(O[0][dt][4 * rq + 2] * inv[0], O[0][dt][4 * rq + 3] * inv[0]);
                *(u32x2*)(op + dv) = wv; }
    }
    __syncthreads();
}

__device__ void attn_phase(PK p, int l, LAS unsigned char* lds) {
    const float lam_init = (l == 0) ? 0.2f : 0.35550906759502f;
    const float* dl = p->diff_lambda + l * 128;
    float d01 = 0.f, d23 = 0.f;
    for (int i = 0; i < 32; ++i) { d01 += dl[i] * dl[32 + i]; d23 += dl[64 + i] * dl[96 + i]; }
    const float lam = expf(d01) - expf(d23) + lam_init;
    const int nItems = 1536 + (l == 0 ? 48 : 0);
    for (int it = opaque_bid(); it < nItems; it += opaque_gdim()) {
        if (it < 1536) {
            const int ty = it >> 9, idx = it & 511, bh = ((idx & 7) << 1) | (idx >> 8), b = bh >> 2, h = bh & 3, qb = (idx >> 3) & 31;
            if (ty == 0) attn_item<1>(p, l, lds, b, h, qb, false, lam, lam_init);
            else if (ty == 1) attn_item<2>(p, l, lds, b, h, qb, false, lam, lam_init);
            else attn_item<0>(p, l, lds, b, h, qb, false, lam, lam_init);
        } else {
            const int idx = it - 1536, ty = idx >> 4, b = (idx >> 2) & 3, h = idx & 3;
            if (ty == 0) attn_item<1>(p, l, lds, b, h, 0, true, lam, lam_init);
            else if (ty == 1) attn_item<2>(p, l, lds, b, h, 0, true, lam, lam_init);
            else attn_item<0>(p, l, lds, b, h, 0, true, lam, lam_init);
        }
    }
}

constexpr int PH_PER_LAYER = 14, N_PHASES = 2 * PH_PER_LAYER + 1;

__device__ __forceinline__ void run_phase(PK p, int ph, LAS unsigned char* lds, float rcoef) {
    unsigned char* ws = p->ws;
    pg8::StaticOrder S;
    if (ph == N_PHASES - 1) { final_norm_phase(p->out, p->final_norm_g); return; }
    int l = ph / PH_PER_LAYER; const int q = ph % PH_PER_LAYER;
#define OPQL asm volatile("" : "+s"(l))
#define HC ((float*)(ws + OFF_HC))
#define MOD ((const float*)(ws + OFF_MOD) + (size_t)l * 5 * 9216)
#define TN ((bf16_t*)(ws + OFF_A))
#define HID ((bf16_t*)(ws + OFF_B))
#define Mlate ((l == 0) ? RA : RL)
    switch (q) {
    case 0: OPQL; layer_prep_phase(p, l, lds); break;
    case 1: OPQL; if (l == 0) norm_mod_phase(p->x, p->ctx, p->out, HC, p->norm_g + (l * 3 + 0) * 1024, MOD, TN, RA, nullptr, 0);
            else norm_mod_phase(p->out, HC, nullptr, nullptr, p->norm_g + (l * 3 + 0) * 1024, MOD, TN, RA, (const float*)(ws + OFF_PB), 11); break;
    case 2: case 12: { OPQL; const int f = (q == 2) ? 0 : 1; const int M = (q == 2) ? RA : Mlate;
        pg8::Gemm g{TN, (const bf16_t*)(ws + OFF_W1) + (size_t)f * 5632 * 1024, M, 5632, 1024, 1024, 1024}; S.init(M, 5632, opaque_gdim(), opaque_bid());
        EpiSwiglu E{HID}; pg8::gemm_phase(lds, g, S, E); } break;
    case 4: OPQL; norm_mod_phase(p->out, HC, nullptr, nullptr, p->norm_g + (l * 3 + 1) * 1024, MOD + 3 * 1024, TN, RA, (const float*)(ws + OFF_PB), 11); break;
    case 5: { OPQL; pg8::Gemm g{TN, (const bf16_t*)(ws + OFF_WM), RA, 6400, 1024, 1024, 1024}; S.init(RA, 6400, opaque_gdim(), opaque_bid());
        EpiPJ E{(bf16_t*)(ws + OFF_B), ws + OFF_C}; pg8::gemm_phase(lds, g, S, E); } break;
    case 6: prep_phase(p); break;
    case 7: { OPQL; pg8::Gemm g{(const bf16_t*)(ws + OFF_B) + C_MQ, (const bf16_t*)(ws + OFF_WL), RA, 1024, 384, PJW, 384}; S.init(RA, 1024, opaque_gdim(), opaque_bid());
        EpiMLA E{(bf16_t*)(ws + OFF_D), (bf16_t*)(ws + OFF_MK), (bf16_t*)(ws + OFF_MV), (const float*)(ws + OFF_RSTD), (const float2*)(ws + OFF_ROPE)}; pg8::gemm_phase(lds, g, S, E); } break;
    case 8: OPQL; attn_phase(p, l, lds); break;
    case 9: { OPQL; pg8::Gemm g{(const bf16_t*)(ws + OFF_A), (const bf16_t*)(ws + OFF_WB), Mlate, 1024, 1024, 1024, 1024}; S.init(Mlate, 1024, opaque_gdim(), opaque_bid());
        EpiMerge E{ws + OFF_C, (bf16_t*)(ws + OFF_D)}; pg8::gemm_phase(lds, g, S, E); } break;
    case 3: case 13: case 10: { OPQL;
        const bool isout = (q == 10); const int f = (q == 13) ? 1 : 0;
        const bf16_t* A = isout ? (const bf16_t*)(ws + OFF_D) : (const bf16_t*)HID;
        const bf16_t* Bt = isout ? (const bf16_t*)(ws + OFF_WO) : (const bf16_t*)(ws + OFF_W2) + (size_t)f * 1024 * FH;
        const int K = isout ? 1024 : FH;
        const float* gate = MOD + (isout ? 5 : (q == 3 ? 2 : 8)) * 1024;
        const float coef = (isout ? 1.0f : 0.5f) * rcoef;
        const bool withctx = (q == 3) || (l == 0);
        { pg8::Gemm g{A, Bt, RL, 1024, K, K, K}; S.init(RL, 1024, opaque_gdim(), opaque_bid());
          EpiResid E{p->out, HC, gate, coef}; pg8::gemm_phase(lds, g, S, E); }
        if (withctx) {
            const int nsu = 16 * (K / 256);
            for (int su = opaque_bid(); su < nsu; su += opaque_gdim()) {
                const int ks = su >> 4, pmn = su & 15;
                pg8::SingleUnit SU; SU.pm = 128 + (pmn >> 2); SU.pn = pmn & 3; SU.has = true;
                pg8::Gemm g2{A + ks * 256, Bt + ks * 256, RA, 1024, 256, K, K};
                EpiPartial E2{(float*)(ws + OFF_PB) + (size_t)ks * 1024 * 1024, gate + 4 * 9216, coef}; pg8::gemm_phase(lds, g2, SU, E2);
            }
        }
    } break;
    case 11: OPQL; norm_mod_phase(p->out, HC, nullptr, nullptr, p->norm_g + (l * 3 + 2) * 1024, MOD + 6 * 1024, TN, Mlate, (const float*)(ws + OFF_PB), 4); break;
    }
#undef OPQL
#undef HC
#undef MOD
#undef TN
#undef HID
#undef Mlate
}

__global__ void __launch_bounds__(512, 2) fwd_megakernel(Params p) {
    extern __shared__ __attribute__((aligned(16))) unsigned char shm[];
    LAS unsigned char* lds = (LAS unsigned char*)shm;
#if N_LAUNCH_MODE == 1
    cg::grid_group grid = cg::this_grid();
    const int ph_lo = p.ph_lo, ph_hi = p.ph_hi;
    volatile LAS unsigned* st = (volatile LAS unsigned*)(lds + pg8::STAGE_BYTES);
    unsigned* bar = (unsigned*)(p.ws + OFF_BAR);
    if (opaque_tid() < 4) st[opaque_tid()] = 0u;
    if (opaque_bid() == 0) for (int i = opaque_tid(); i < XCD_BAR_WORDS; i += 512) bar[i] = 0u;
    __syncthreads();
#if PROBE_Q >= 0
    const int nseq = 2 * (PH_PER_LAYER + 1) + 1;
    for (int i = 0; i < nseq; ++i) {
        int ph;
        if (i == nseq - 1) ph = N_PHASES - 1;
        else { const int li = i / (PH_PER_LAYER + 1), r = i % (PH_PER_LAYER + 1); ph = li * PH_PER_LAYER + (r <= PROBE_Q ? r : r - 1); }
        PK pk = (PK)__builtin_amdgcn_kernarg_segment_ptr();
        asm volatile("" : "+s"(pk));
        run_phase(pk, ph, lds, 1.0f);
        if (i == 0) { grid.sync(); xcd_barrier_post(bar); }
        else if (i + 1 < nseq) xcd_barrier(bar, st);
    }
#else
    for (int ph = ph_lo; ph < ph_hi; ++ph) {
        PK pk = (PK)__builtin_amdgcn_kernarg_segment_ptr();
        asm volatile("" : "+s"(pk));
        run_phase(pk, ph, lds, 1.0f);
        if (ph == ph_lo) { grid.sync(); xcd_barrier_post(bar); }
        else if (ph + 1 < ph_hi) xcd_barrier(bar, st);
    }
#endif
#else
    const int ph_lo = p.ph_lo, ph_hi = p.ph_hi;
    for (int ph = ph_lo; ph < ph_hi; ++ph) { PK pk = (PK)__builtin_amdgcn_kernarg_segment_ptr(); asm volatile("" : "+s"(pk)); run_phase(pk, ph, lds, 1.0f); }
#endif
}

extern "C" void kernel_launch(void* const* d_in, const int* in_sizes, int n_in, void* d_out, int out_size, void* d_ws, size_t ws_size, hipStream_t stream) {
    constexpr int LDS_BYTES = pg8::STAGE_BYTES + 16;
    static int grid_blocks = 0;
    if (grid_blocks == 0) {
        if (n_in != 22 || ws_size < WS_END) { fprintf(stderr, "kernel_launch: unexpected inputs (n_in %d, ws %zu < %zu)\n", n_in, ws_size, (size_t)WS_END); grid_blocks = -1; return; }
        int dev = 0, cus = 0, per_cu = 0;
        hipGetDevice(&dev); hipDeviceGetAttribute(&cus, hipDeviceAttributeMultiprocessorCount, dev);
        if (hipFuncSetAttribute((const void*)fwd_megakernel, hipFuncAttributeMaxDynamicSharedMemorySize, LDS_BYTES) != hipSuccess) { fprintf(stderr, "hipFuncSetAttribute failed\n"); grid_blocks = -1; return; }
        if (hipOccupancyMaxActiveBlocksPerMultiprocessor(&per_cu, (const void*)fwd_megakernel, 512, LDS_BYTES) != hipSuccess || per_cu < 1) per_cu = 1;
        (void)hipGetLastError();
        grid_blocks = cus * 1;
    }
    if (grid_blocks < 0) return;
    Params hp{};
    const float** pp = (const float**)&hp;
    for (int i = 0; i < 22; ++i) pp[i] = (const float*)d_in[i];
    hp.out = (float*)d_out; hp.ws = (unsigned char*)d_ws;
#if N_LAUNCH_MODE == 1
    hp.ph_lo = 0; hp.ph_hi = N_PHASES;
    void* args[] = {&hp};
    hipError_t e = hipLaunchCooperativeKernel((const void*)fwd_megakernel, dim3(grid_blocks), dim3(512), args, LDS_BYTES, stream);
    if (e != hipSuccess) fprintf(stderr, "cooperative launch failed: %s (grid %d)\n", hipGetErrorString(e), grid_blocks);
#else
    for (int ph = 0; ph < N_PHASES; ++ph) { hp.ph_lo = ph; hp.ph_hi = ph + 1; hipLaunchKernelGGL(fwd_megakernel, dim3(grid_blocks), dim3(512), LDS_BYTES, stream, hp); }
#endif
}
```

```cpp
#include <hip/hip_runtime.h>
#include <hip/hip_cooperative_groups.h>
#include <cstdio>
namespace cg = cooperative_groups;

#define LAS __attribute__((address_space(3)))
typedef unsigned short bf16_t;
typedef short bf16x8 __attribute__((ext_vector_type(8)));
typedef short s16x4 __attribute__((ext_vector_type(4)));
typedef float f32x4 __attribute__((ext_vector_type(4)));
typedef float f32x16 __attribute__((ext_vector_type(16)));
typedef unsigned u32x4 __attribute__((ext_vector_type(4)));
typedef unsigned u32x2 __attribute__((ext_vector_type(2)));

#ifndef PROBE_Q
#define PROBE_Q (-1)
#endif
#ifndef N_LAUNCH_MODE
#define N_LAUNCH_MODE 1
#endif

constexpr int RL = 32768, RA = 33792, FH = 2816;
constexpr int PJW = 2304;
constexpr int C_NQ = 256, C_NK = 512, C_NV = 768, C_DQ = 1024, C_DK = 1280, C_DV = 1536, C_MQ = 1792, C_MKV = 2048, C_MKR = 2176;
constexpr float LOG2E = 1.4426950408889634f;
constexpr float NEPS = 1e-6f;
constexpr int XCD_BAR_WORDS_C = 3456;

constexpr size_t SZ_W1 = 2ull * 5632 * 1024 * 2, SZ_W2 = 2ull * 1024 * 2816 * 2, SZ_WM = 6400ull * 1024 * 2, SZ_WL = 1024ull * 384 * 2, SZ_WB = 4ull * 1024 * 256 * 2, SZ_WO = 1024ull * 1024 * 2;
constexpr size_t OFF_W1 = 0, OFF_W2 = OFF_W1 + SZ_W1, OFF_WM = OFF_W2 + SZ_W2, OFF_WL = OFF_WM + SZ_WM, OFF_WB = OFF_WL + SZ_WL, OFF_WO = OFF_WB + SZ_WB;
constexpr size_t OFF_HC = OFF_WO + SZ_WO;
constexpr size_t OFF_MOD = OFF_HC + 1024ull * 1024 * 4;
constexpr size_t OFF_ROPE = OFF_MOD + 2ull * 5 * 9216 * 4;
constexpr size_t OFF_RSTD = OFF_ROPE + 128 * 8 * 8;
constexpr size_t OFF_A = OFF_RSTD + (size_t)RA * 2 * 4;
constexpr size_t OFF_B = OFF_A + (size_t)RA * 1024 * 2;
constexpr size_t OFF_C = OFF_B + (size_t)RA * PJW * 2;
constexpr size_t OFF_D = OFF_C + (size_t)RA * 4096;
constexpr size_t OFF_MK = OFF_D + (size_t)RA * 384 * 2, OFF_MV = OFF_MK + (size_t)RA * 384 * 2;
constexpr size_t OFF_BAR = OFF_D + (size_t)RA * 1024 * 2;
constexpr size_t OFF_PB = OFF_BAR + 16384;
constexpr size_t WS_END = OFF_PB + 11ull * 1024 * 1024 * 4;

struct Params {
    const float *x, *c, *ctx, *c_ctx, *ada_w, *ada_b, *norm_g, *ffn_w_in, *ffn_w_out, *mix_w_in, *pool_w, *pool_scale, *na_rpb, *diff_lambda, *diff_subln_g,
        *mla_q_norm_g, *mla_kv_norm_g, *mla_w_qb, *mla_w_kvb, *branch_w_out, *mix_w_out, *final_norm_g;
    float* out; unsigned char* ws;
    int ph_lo, ph_hi;
};

typedef const __attribute__((address_space(4))) Params* PK;

typedef float f32x2_ __attribute__((ext_vector_type(2)));
typedef __bf16 bf16x2_ __attribute__((ext_vector_type(2)));
__device__ __forceinline__ unsigned cvt_pk_bf16(float lo, float hi) { const f32x2_ v = {lo, hi}; return __builtin_bit_cast(unsigned, __builtin_convertvector(v, bf16x2_)); }
__device__ __forceinline__ float bf_lo(unsigned u) { return __uint_as_float(u << 16); }
__device__ __forceinline__ float bf_hi(unsigned u) { return __uint_as_float(u & 0xffff0000u); }
__device__ __forceinline__ float fast_exp2(float x) { return __builtin_amdgcn_exp2f(x); }
__device__ __forceinline__ float fast_rcp(float x) { return __builtin_amdgcn_rcpf(x); }
__device__ __forceinline__ float sigmoidf_(float x) { return fast_rcp(1.0f + fast_exp2(-x * LOG2E)); }
__device__ __forceinline__ float shflx(float v, int m) {
    int lane = __builtin_amdgcn_mbcnt_hi(~0u, __builtin_amdgcn_mbcnt_lo(~0u, 0)); asm volatile("" : "+v"(lane));
    return __int_as_float(__builtin_amdgcn_ds_bpermute((lane ^ m) << 2, __float_as_int(v)));
}
__device__ __forceinline__ float wave_sum(float v) {
    v += shflx(v, 32); v += shflx(v, 16); v += shflx(v, 8); v += shflx(v, 4); v += shflx(v, 2); v += shflx(v, 1); return v;
}
__device__ __forceinline__ int opaque_tid() { int t = threadIdx.x; asm volatile("" : "+v"(t)); return t; }
__device__ __forceinline__ int opaque_bid() { int t = blockIdx.x; asm volatile("" : "+s"(t)); return t; }
__device__ __forceinline__ int opaque_gdim() { int t = gridDim.x; asm volatile("" : "+s"(t)); return t; }
__device__ __forceinline__ int clampi(int v, int lo, int hi) { return v < lo ? lo : (v > hi ? hi : v); }

#define XB_TMO      128
#define XB_XCNT(j)  (256  + 64 * (j))
#define XB_XSUB(j)  (1280 + 64 * (j))
#define XB_XGEN(j)  (2304 + 64 * (j))
#define XB_TOP      3328
#define XB_TOPGEN   3392
#define XCD_BAR_WORDS 3456
#define XB_SPIN_CAP (1u << 20)
__device__ __forceinline__ unsigned xb_ld(unsigned* p)              { return __hip_atomic_load(p, __ATOMIC_RELAXED, __HIP_MEMORY_SCOPE_AGENT); }
__device__ __forceinline__ unsigned xb_add(unsigned* p, unsigned v) { return __hip_atomic_fetch_add(p, v, __ATOMIC_RELAXED, __HIP_MEMORY_SCOPE_AGENT); }
__device__ __forceinline__ unsigned xb_xcc_id() { return (unsigned)__builtin_amdgcn_s_getreg((3 << 11) | 20) & 0xFu; }
#define XB_SPIN(cond, bar) do { unsigned _sp = 0; while (cond) { __builtin_amdgcn_s_sleep(1); \
    if ((++_sp & 255u) == 0u) { if (xb_ld(&(bar)[XB_TMO])) break; if (_sp > XB_SPIN_CAP) { atomicAdd(&(bar)[XB_TMO], 1u); break; } } } } while (0)
__device__ __forceinline__ void xcd_barrier_post(unsigned* bar) { if (opaque_tid() == 0) (void)xb_add(&bar[XB_XCNT(xb_xcc_id())], 1u); }
__device__ __forceinline__ void xcd_barrier_complete(unsigned* bar, unsigned x, unsigned& nloc, unsigned& nx) {
    const unsigned G = gridDim.x;
    unsigned sum, cnt, mine, sp = 0u;
    for (;;) {
        sum = 0u; cnt = 0u; mine = 0u;
#pragma unroll
        for (unsigned j = 0; j < 16; ++j) { const unsigned c = xb_ld(&bar[XB_XCNT(j)]); sum += c; cnt += (c > 0u) ? 1u : 0u; mine = (j == x) ? c : mine; }
        if (sum == G) break;
        __builtin_amdgcn_s_sleep(1);
        if ((++sp & 255u) == 0u) { if (xb_ld(&bar[XB_TMO])) break; if (sp > XB_SPIN_CAP) { atomicAdd(&bar[XB_TMO], 1u); break; } }
    }
    nloc = mine > 0u ? mine : 1u; nx = cnt > 0u ? cnt : 1u;
}
__device__ __forceinline__ void xcd_barrier(unsigned* bar, volatile LAS unsigned* st) {
    asm volatile("s_waitcnt vmcnt(0)" ::: "memory");
    __syncthreads();
    if (opaque_tid() == 0) {
        const unsigned x = xb_xcc_id();
        __builtin_amdgcn_s_waitcnt(0);
        unsigned nloc = st[0], nx = st[1];
        if (nloc == 0u) { xcd_barrier_complete(bar, x, nloc, nx); st[0] = nloc; st[1] = nx; }
        const unsigned old = xb_add(&bar[XB_XSUB(x)], 1u);
        const unsigned gen = old / nloc;
        if (old + 1u == (gen + 1u) * nloc) {
            __builtin_amdgcn_fence(__ATOMIC_RELEASE, "agent");
            asm volatile("s_waitcnt vmcnt(0)" ::: "memory");
            const unsigned og = xb_add(&bar[XB_TOP], 1u);
            const unsigned tg = og / nx;
            if (og + 1u == (tg + 1u) * nx) xb_add(&bar[XB_TOPGEN], 1u);
            else XB_SPIN(xb_ld(&bar[XB_TOPGEN]) == tg, bar);
            __builtin_amdgcn_fence(__ATOMIC_ACQUIRE, "agent");
            xb_add(&bar[XB_XGEN(x)], 1u);
            asm volatile("s_waitcnt vmcnt(0)" ::: "memory");
        } else {
            XB_SPIN(xb_ld(&bar[XB_XGEN(x)]) == gen, bar);
            __builtin_amdgcn_fence(__ATOMIC_ACQUIRE, "agent");
            asm volatile("s_waitcnt vmcnt(0)" ::: "memory");
        }
    }
    __syncthreads();
}

namespace pg8 {
constexpr int BM = 256, BK = 64, HALF = 128, HTB = HALF * BK * 2, STAGE_BYTES = 8 * HTB, NXCD = 8, WGM = 8;
__device__ __forceinline__ int lds_byte(int r, int c) { const int st = (r >> 4) * 2 + (c >> 5), rr = r & 15, cc = c & 31, ob = rr * 64 + cc * 2; return st * 1024 + (ob ^ (((ob >> 9) & 1) << 5)); }
__device__ __forceinline__ void stage_rc(int b, int& R, int& C) { const int st = b / 1024, sb = b % 1024, swz = sb ^ (((sb >> 9) & 1) << 5); R = (st >> 1) * 16 + swz / 64; C = (st & 1) * 32 + (swz % 64) / 2; }
__device__ __forceinline__ int perm32(int rho) { const int n = rho >> 4, i = rho & 15; return 8 * (i >> 2) + 4 * n + (i & 3); }
struct Unit { int pm, pn; };
struct Gemm { const bf16_t* A; const bf16_t* Bt; int M, N, K, lda, ldb; };
struct StaticOrder {
    int nM, nN, nwg, G, c;
    __device__ void init(int M, int N, int G_, int c_) { nM = M / BM; nN = N / BM; nwg = nM * nN; G = G_; c = c_; }
    __device__ bool next(int i, Unit& u) const {
        const long L = (long)i * G + c; if (L >= nwg) return false;
        int wgid = (int)L; { const int q = nwg / NXCD, r = nwg % NXCD, xcd = wgid % NXCD, off = wgid / NXCD; wgid = (xcd < r ? xcd * (q + 1) : r * (q + 1) + (xcd - r) * q) + off; }
        const int nig = WGM * nN, gid = wgid / nig, fm = gid * WGM, gsz = (nM - fm) < WGM ? (nM - fm) : WGM;
        u.pm = fm + ((wgid % nig) % gsz); u.pn = (wgid % nig) / gsz; return true;
    }
};

struct SingleUnit {
    int pm, pn; bool has;
    __device__ bool next(int i, Unit& u) const { if (i > 0 || !has) return false; u.pm = pm; u.pn = pn; return true; }
};
template <class Epi, class Sched>
__device__ __forceinline__ void gemm_phase(LAS unsigned char* lds, const Gemm g, const Sched& S, const Epi& E) {
    const int tid = opaque_tid(), wid = __builtin_amdgcn_readfirstlane(tid >> 6), lane = tid & 63, wr = wid >> 2, wc = wid & 3, fr = lane & 15, fq = lane >> 4;
    const int K = g.K, nt = K / BK;
    unsigned voffA[2], voffB[2];
#pragma unroll
    for (int i = 0; i < 2; ++i) { int R, C; stage_rc(tid * 16 + i * 8192, R, C); const int Rb = Epi::PERM ? ((R & ~31) + perm32(R & 31)) : R;
        voffA[i] = (unsigned)(R * g.lda + C) * 2u; voffB[i] = (unsigned)(Rb * g.ldb + C) * 2u; }
    const size_t kstep = (size_t)(BK * 2);
    const size_t hstepA = (size_t)HALF * g.lda * 2, hstepB = (size_t)HALF * g.ldb * 2;
    const size_t tstepA = 2 * hstepA, tstepB = 2 * hstepB;
    const unsigned ldsw = (unsigned)wid * 1024u;
    const int aoff = lds_byte(wr * 64 + fr, fq * 8), boff = lds_byte(wc * 32 + fr, fq * 8);
#define PG8_SA(b, h) (((b) * 2 + (h)) * HTB)
#define PG8_SB(b, h) ((4 + (b) * 2 + (h)) * HTB)
#define PG8_STAGE(bufoff, gbase, voff) do { _Pragma("unroll") for (int _i = 0; _i < 2; ++_i) \
        __builtin_amdgcn_global_load_lds((const unsigned*)((const char*)(gbase) + (voff)[_i]), (LAS unsigned*)(lds + (bufoff) + ldsw + _i * 8192), 16, 0, 0); } while (0)
#define PG8_LDA(dst, b, h) do { _Pragma("unroll") for (int m = 0; m < 4; ++m) _Pragma("unroll") for (int k = 0; k < 2; ++k) dst[m][k] = *(const LAS bf16x8*)(lds + PG8_SA(b, h) + aoff + m * 2048 + k * 1024); } while (0)
#define PG8_LDB(dst, b, h) do { _Pragma("unroll") for (int n = 0; n < 2; ++n) _Pragma("unroll") for (int k = 0; k < 2; ++k) dst[n][k] = *(const LAS bf16x8*)(lds + PG8_SB(b, h) + boff + n * 2048 + k * 1024); } while (0)
#define PG8_MMA(ai, bj, At, Bt) do { __builtin_amdgcn_s_setprio(1); _Pragma("unroll") for (int m = 0; m < 4; ++m) _Pragma("unroll") for (int n = 0; n < 2; ++n) _Pragma("unroll") for (int k = 0; k < 2; ++k) \
        acc[ai][bj][m][n] = __builtin_amdgcn_mfma_f32_16x16x32_bf16(Bt[n][k], At[m][k], acc[ai][bj][m][n], 0, 0, 0); __builtin_amdgcn_s_setprio(0); } while (0)
#define PG8_WAIT_V(n) asm volatile("s_waitcnt vmcnt(" #n ")" ::: "memory")
#define PG8_WAIT_L(n) asm volatile("s_waitcnt lgkmcnt(" #n ")" ::: "memory")
#define PG8_BAR __builtin_amdgcn_s_barrier()
#define PG8_SCHED __builtin_amdgcn_sched_barrier(0)
    Unit cur, nxt; int ui = 0;
    if (!S.next(0, cur)) return;
    f32x4 acc[2][2][4][2];
#pragma unroll
    for (int a = 0; a < 2; ++a)
#pragma unroll
        for (int b = 0; b < 2; ++b)
#pragma unroll
            for (int m = 0; m < 4; ++m)
#pragma unroll
                for (int n = 0; n < 2; ++n) acc[a][b][m][n] = (f32x4){0.f, 0.f, 0.f, 0.f};
    bf16x8 At[4][2], B0[2][2], B1[2][2];
    const char* cA = (const char*)g.A + (size_t)cur.pm * tstepA; const char* cB = (const char*)g.Bt + (size_t)cur.pn * tstepB;
    PG8_STAGE(PG8_SB(0, 0), cB, voffB); PG8_STAGE(PG8_SA(0, 0), cA, voffA); PG8_STAGE(PG8_SB(0, 1), cB + hstepB, voffB); PG8_STAGE(PG8_SA(0, 1), cA + hstepA, voffA);
    if (wr == 1) PG8_BAR;
    PG8_WAIT_V(4); PG8_BAR;
    PG8_STAGE(PG8_SB(1, 0), cB + kstep, voffB); PG8_STAGE(PG8_SA(1, 0), cA + kstep, voffA); PG8_STAGE(PG8_SB(1, 1), cB + hstepB + kstep, voffB);
    PG8_WAIT_V(6); PG8_BAR;
    for (;;) {
        const bool has_next = S.next(ui + 1, nxt);
        const char* nA = has_next ? (const char*)g.A + (size_t)nxt.pm * tstepA : cA; const char* nB = has_next ? (const char*)g.Bt + (size_t)nxt.pn * tstepB : cB;
        for (int t = 0; t < nt; t += 2) {
            const bool last = (t == nt - 2);
            const char* a1 = cA + (size_t)(t + 1) * kstep;
            const char* a2 = last ? nA : cA + (size_t)(t + 2) * kstep; const char* b2 = last ? nB : cB + (size_t)(t + 2) * kstep;
            const char* a3 = a2 + kstep; const char* b3 = b2 + kstep;
            PG8_LDB(B0, 0, 0); PG8_SCHED; PG8_LDA(At, 0, 0); PG8_STAGE(PG8_SA(1, 1), a1 + hstepA, voffA);
            PG8_WAIT_L(8); PG8_BAR; PG8_WAIT_L(0); PG8_MMA(0, 0, At, B0); PG8_BAR; PG8_SCHED;
            PG8_LDB(B1, 0, 1); PG8_STAGE(PG8_SB(0, 0), b2, voffB);
            PG8_BAR; PG8_WAIT_L(0); PG8_MMA(0, 1, At, B1); PG8_BAR;
            PG8_LDA(At, 0, 1); PG8_STAGE(PG8_SA(0, 0), a2, voffA);
            PG8_BAR; PG8_WAIT_L(0); PG8_MMA(1, 0, At, B0); PG8_BAR; PG8_SCHED;
            PG8_STAGE(PG8_SB(0, 1), b2 + hstepB, voffB);
            PG8_WAIT_V(6); PG8_BAR; PG8_MMA(1, 1, At, B1); PG8_BAR;
            PG8_LDB(B0, 1, 0); PG8_SCHED; PG8_LDA(At, 1, 0); PG8_STAGE(PG8_SA(0, 1), a2 + hstepA, voffA);
            PG8_WAIT_L(8); PG8_BAR; PG8_WAIT_L(0); PG8_MMA(0, 0, At, B0); PG8_BAR; PG8_SCHED;
            PG8_LDB(B1, 1, 1); PG8_STAGE(PG8_SB(1, 0), b3, voffB);
            PG8_BAR; PG8_WAIT_L(0); PG8_MMA(0, 1, At, B1); PG8_BAR;
            PG8_LDA(At, 1, 1); PG8_STAGE(PG8_SA(1, 0), a3, voffA);
            PG8_BAR; PG8_WAIT_L(0); PG8_MMA(1, 0, At, B0); PG8_BAR; PG8_SCHED;
            PG8_STAGE(PG8_SB(1, 1), b3 + hstepB, voffB);
            PG8_WAIT_V(6); PG8_BAR; PG8_MMA(1, 1, At, B1); PG8_BAR;
            if constexpr (Epi::HOOK) { if ((((t + 2) & 3) == 0) && !last) E.hook(acc, cur, (t + 2) >> 2, wr, wc, fr, fq); }
        }
        E(acc, cur, wr, wc, fr, fq);
        if (!has_next) break;
#pragma unroll
        for (int a = 0; a < 2; ++a)
#pragma unroll
            for (int b = 0; b < 2; ++b)
#pragma unroll
                for (int m = 0; m < 4; ++m)
#pragma unroll
                    for (int n = 0; n < 2; ++n) acc[a][b][m][n] = (f32x4){0.f, 0.f, 0.f, 0.f};
        cur = nxt; cA = nA; cB = nB; ++ui;
    }
    PG8_WAIT_V(0);
    if (wr == 0) PG8_BAR;
    PG8_BAR;
#undef PG8_SA
#undef PG8_SB
#undef PG8_STAGE
#undef PG8_LDA
#undef PG8_LDB
#undef PG8_MMA
#undef PG8_WAIT_V
#undef PG8_WAIT_L
#undef PG8_BAR
#undef PG8_SCHED
}
}
using pg8::Unit;

__device__ __forceinline__ size_t g8_off(int row, int colg) { return ((size_t)(row >> 4) * 128 + (colg >> 5)) * 512 + (row & 15) * 32 + (colg & 31); }

struct EpiSwiglu {
    static constexpr bool HOOK = false;
    static constexpr bool PERM = true;
    bf16_t* HID;
    __device__ __forceinline__ void operator()(const f32x4 (&acc)[2][2][4][2], const Unit& u, int wr, int wc, int fr, int fq) const {
        { const int t_ = opaque_tid(); wr = t_ >> 8; wc = (t_ >> 6) & 3; fr = t_ & 15; fq = (t_ >> 4) & 3; }
        const int row0 = u.pm * 256 + wr * 64 + fr, col0 = u.pn * 128 + wc * 32 + 8 * fq;
#pragma unroll
        for (int ai = 0; ai < 2; ++ai)
#pragma unroll
            for (int m = 0; m < 4; ++m) {
                const int row = row0 + ai * 128 + m * 16;
                float hv[8];
#pragma unroll
                for (int n = 0; n < 2; ++n)
#pragma unroll
                    for (int j = 0; j < 4; ++j) { const float a = acc[ai][0][m][n][j], b = acc[ai][1][m][n][j]; hv[4 * n + j] = a * sigmoidf_(a) * b; }
                u32x4 w; w.x = cvt_pk_bf16(hv[0], hv[1]); w.y = cvt_pk_bf16(hv[2], hv[3]); w.z = cvt_pk_bf16(hv[4], hv[5]); w.w = cvt_pk_bf16(hv[6], hv[7]);
                *(u32x4*)(HID + (size_t)row * FH + col0) = w;
            }
    }
};
struct EpiResid {
    static constexpr bool HOOK = false;
    static constexpr bool PERM = false;
    float* Hl; float* Hc; const float* gate; float coef;
    __device__ __forceinline__ void operator()(const f32x4 (&acc)[2][2][4][2], const Unit& u, int wr, int wc, int fr, int fq) const {
        { const int t_ = opaque_tid(); wr = t_ >> 8; wc = (t_ >> 6) & 3; fr = t_ & 15; fq = (t_ >> 4) & 3; }
        const int row0 = u.pm * 256 + wr * 64 + fr, col0 = u.pn * 256 + wc * 32 + 4 * fq;
#pragma unroll
        for (int ai = 0; ai < 2; ++ai)
#pragma unroll
            for (int m = 0; m < 4; ++m) {
                const int row = row0 + ai * 128 + m * 16;
                float* hp = row < RL ? Hl + (size_t)row * 1024 : Hc + (size_t)(row - RL) * 1024;
                const float* gp = gate + (row < RL ? (row >> 13) : 4) * 9216;
#pragma unroll
                for (int bj = 0; bj < 2; ++bj)
#pragma unroll
                    for (int n = 0; n < 2; ++n) {
                        const int c = col0 + bj * 128 + n * 16;
                        const f32x4 g4 = *(const f32x4*)(gp + c); f32x4 h4 = *(const f32x4*)(hp + c);
                        h4 += (g4 * coef) * acc[ai][bj][m][n];
                        *(f32x4*)(hp + c) = h4;
                    }
            }
    }
};
struct EpiPartial {
    static constexpr bool HOOK = false;
    static constexpr bool PERM = false;
    float* PB; const float* gate; float coef;
    __device__ __forceinline__ void operator()(const f32x4 (&acc)[2][2][4][2], const Unit& u, int wr, int wc, int fr, int fq) const {
        { const int t_ = opaque_tid(); wr = t_ >> 8; wc = (t_ >> 6) & 3; fr = t_ & 15; fq = (t_ >> 4) & 3; }
        const int row0 = u.pm * 256 + wr * 64 + fr - RL, col0 = u.pn * 256 + wc * 32 + 4 * fq;
#pragma unroll
        for (int ai = 0; ai < 2; ++ai)
#pragma unroll
            for (int m = 0; m < 4; ++m) {
                float* hp = PB + (size_t)(row0 + ai * 128 + m * 16) * 1024;
#pragma unroll
                for (int bj = 0; bj < 2; ++bj)
#pragma unroll
                    for (int n = 0; n < 2; ++n) {
                        const int c = col0 + bj * 128 + n * 16;
                        const f32x4 g4 = *(const f32x4*)(gate + c);
                        *(f32x4*)(hp + c) = (g4 * coef) * acc[ai][bj][m][n];
                    }
            }
    }
};
struct EpiPJ {
    static constexpr bool HOOK = false;
    static constexpr bool PERM = true;
    bf16_t* PJ; unsigned char* G8;
    __device__ __forceinline__ void operator()(const f32x4 (&acc)[2][2][4][2], const Unit& u, int wr, int wc, int fr, int fq) const {
        { const int t_ = opaque_tid(); wr = t_ >> 8; wc = (t_ >> 6) & 3; fr = t_ & 15; fq = (t_ >> 4) & 3; }
        const int row0 = u.pm * 256 + wr * 64 + fr, c0 = wc * 32 + 8 * fq;
        if (u.pn < 9) {
#pragma unroll
            for (int ai = 0; ai < 2; ++ai)
#pragma unroll
                for (int m = 0; m < 4; ++m) {
                    const int row = row0 + ai * 128 + m * 16;
#pragma unroll
                    for (int bj = 0; bj < 2; ++bj) {
                        const f32x4 v0 = acc[ai][bj][m][0], v1 = acc[ai][bj][m][1];
                        u32x4 w; w.x = cvt_pk_bf16(v0[0], v0[1]); w.y = cvt_pk_bf16(v0[2], v0[3]); w.z = cvt_pk_bf16(v1[0], v1[1]); w.w = cvt_pk_bf16(v1[2], v1[3]);
                        *(u32x4*)(PJ + (size_t)row * PJW + u.pn * 256 + bj * 128 + c0) = w;
                    }
                }
        } else {
#pragma unroll
            for (int ai = 0; ai < 2; ++ai)
#pragma unroll
                for (int m = 0; m < 4; ++m) {
                    const int row = row0 + ai * 128 + m * 16;
#pragma unroll
                    for (int bj = 0; bj < 2; ++bj) {
                        unsigned q[8];
#pragma unroll
                        for (int n = 0; n < 2; ++n)
#pragma unroll
                            for (int j = 0; j < 4; ++j) { int v = (int)(sigmoidf_(acc[ai][bj][m][n][j]) * 256.0f); q[4 * n + j] = (unsigned)(v > 255 ? 255 : v); }
                        u32x2 w; w.x = q[0] | (q[1] << 8) | (q[2] << 16) | (q[3] << 24); w.y = q[4] | (q[5] << 8) | (q[6] << 16) | (q[7] << 24);
                        *(u32x2*)(G8 + g8_off(row, (u.pn - 9) * 256 + bj * 128 + c0)) = w;
                    }
                }
        }
    }
};
struct EpiMLA {
    static constexpr bool HOOK = false;
    static constexpr bool PERM = true;
    bf16_t *MQ, *MK, *MV; const float* RSTD; const float2* RT;
    __device__ __forceinline__ void operator()(const f32x4 (&acc)[2][2][4][2], const Unit& u, int wr, int wc, int fr, int fq) const {
        { const int t_ = opaque_tid(); wr = t_ >> 8; wc = (t_ >> 6) & 3; fr = t_ & 15; fq = (t_ >> 4) & 3; }
        const int row0 = u.pm * 256 + wr * 64 + fr;
#pragma unroll
        for (int bj = 0; bj < 2; ++bj) {
            const int cg0 = u.pn * 256 + bj * 128 + wc * 32;
            if (cg0 >= 896) continue;
#pragma unroll
            for (int ai = 0; ai < 2; ++ai)
#pragma unroll
                for (int m = 0; m < 4; ++m) {
                    __builtin_amdgcn_sched_barrier(0);
                    const int row = row0 + ai * 128 + m * 16;
                    float v[8];
                    if (cg0 < 384) {
                        const float rs = RSTD[row * 2];
#pragma unroll
                        for (int n = 0; n < 2; ++n)
#pragma unroll
                            for (int j = 0; j < 4; ++j) v[4 * n + j] = acc[ai][bj][m][n][j] * rs;
                        const int d0 = cg0 % 96;
                        if (d0 == 64) {
                            const bool lat = row < RL; const int t = row & 8191; const int pos = (fq >> 1) ? (t & 63) : (t >> 6); const bool isx2 = fq & 1;
#pragma unroll
                            for (int e = 0; e < 8; ++e) {
                                const float pr = shflx(v[e], 16);
                                const float2 cs = RT[pos * 8 + e];
                                const float r = isx2 ? (pr * cs.y + v[e] * cs.x) : (v[e] * cs.x - pr * cs.y);
                                v[e] = lat ? r : v[e];
                            }
                        }
                        u32x4 w; w.x = cvt_pk_bf16(v[0], v[1]); w.y = cvt_pk_bf16(v[2], v[3]); w.z = cvt_pk_bf16(v[4], v[5]); w.w = cvt_pk_bf16(v[6], v[7]);
                        *(u32x4*)(MQ + (size_t)row * 384 + cg0 + 8 * fq) = w;
                    } else {
                        const float rs = RSTD[row * 2 + 1];
#pragma unroll
                        for (int n = 0; n < 2; ++n)
#pragma unroll
                            for (int j = 0; j < 4; ++j) v[4 * n + j] = acc[ai][bj][m][n][j] * rs;
                        const int cp = cg0 - 384, hd = cp >> 7, d0 = cp & 127;
                        u32x4 w; w.x = cvt_pk_bf16(v[0], v[1]); w.y = cvt_pk_bf16(v[2], v[3]); w.z = cvt_pk_bf16(v[4], v[5]); w.w = cvt_pk_bf16(v[6], v[7]);
                        if (d0 < 64) *(u32x4*)(MK + (size_t)row * 384 + hd * 96 + d0 + 8 * fq) = w;
                        else *(u32x4*)(MV + (size_t)row * 256 + hd * 64 + (d0 - 64) + 8 * fq) = w;
                    }
                }
        }
    }
};
struct EpiMerge {
    static constexpr bool PERM = true, HOOK = true;
    const unsigned char* G8; bf16_t* MG;
    __device__ __forceinline__ void hook(f32x4 (&acc)[2][2][4][2], const Unit& u, int nb, int wr, int wc, int fr, int fq) const {
        { const int t_ = opaque_tid(); wr = t_ >> 8; wc = (t_ >> 6) & 3; fr = t_ & 15; fq = (t_ >> 4) & 3; }
        const int row0 = u.pm * 256 + wr * 64 + fr, c0 = u.pn * 256 + wc * 32 + 8 * fq;
#pragma unroll
        for (int ai = 0; ai < 2; ++ai) {
            u32x2 ga[4][2], gb[4][2];
#pragma unroll
            for (int m = 0; m < 4; ++m)
#pragma unroll
                for (int bj = 0; bj < 2; ++bj) { const int row = row0 + ai * 128 + m * 16, c = c0 + bj * 128;
                    ga[m][bj] = *(const u32x2*)(G8 + g8_off(row, (nb - 1) * 1024 + c)); gb[m][bj] = *(const u32x2*)(G8 + g8_off(row, nb * 1024 + c)); }
#pragma unroll
            for (int m = 0; m < 4; ++m)
#pragma unroll
                for (int bj = 0; bj < 2; ++bj)
#pragma unroll
                    for (int e = 0; e < 8; ++e) { const unsigned qa = ((e < 4 ? ga[m][bj].x : ga[m][bj].y) >> (8 * (e & 3))) & 255u, qb = ((e < 4 ? gb[m][bj].x : gb[m][bj].y) >> (8 * (e & 3))) & 255u;
                        acc[ai][bj][m][e >> 2][e & 3] *= ((float)qa + 0.5f) * fast_rcp((float)qb + 0.5f); }
            __builtin_amdgcn_sched_barrier(0);
        }
    }
    __device__ __forceinline__ void operator()(const f32x4 (&acc)[2][2][4][2], const Unit& u, int wr, int wc, int fr, int fq) const {
        { const int t_ = opaque_tid(); wr = t_ >> 8; wc = (t_ >> 6) & 3; fr = t_ & 15; fq = (t_ >> 4) & 3; }
        const int row0 = u.pm * 256 + wr * 64 + fr, c0 = u.pn * 256 + wc * 32 + 8 * fq;
#pragma unroll
        for (int ai = 0; ai < 2; ++ai) {
            u32x2 gq[4][2];
#pragma unroll
            for (int m = 0; m < 4; ++m)
#pragma unroll
                for (int bj = 0; bj < 2; ++bj) gq[m][bj] = *(const u32x2*)(G8 + g8_off(row0 + ai * 128 + m * 16, 3 * 1024 + c0 + bj * 128));
#pragma unroll
            for (int m = 0; m < 4; ++m)
#pragma unroll
                for (int bj = 0; bj < 2; ++bj) {
                    const int row = row0 + ai * 128 + m * 16, c = c0 + bj * 128;
                    float v[8];
#pragma unroll
                    for (int e = 0; e < 8; ++e) { const unsigned q = ((e < 4 ? gq[m][bj].x : gq[m][bj].y) >> (8 * (e & 3))) & 255u; v[e] = ((float)q + 0.5f) * (1.0f / 256.0f) * acc[ai][bj][m][e >> 2][e & 3]; }
                    u32x4 w; w.x = cvt_pk_bf16(v[0], v[1]); w.y = cvt_pk_bf16(v[2], v[3]); w.z = cvt_pk_bf16(v[4], v[5]); w.w = cvt_pk_bf16(v[6], v[7]);
                    *(u32x4*)(MG + (size_t)row * 1024 + c) = w;
                }
            __builtin_amdgcn_sched_barrier(0);
        }
    }
};

template <class F>
__device__ __forceinline__ void wt_rows64(bf16_t* dst, int K, F srcval, int ldd, int kbeg, int kend) {
    if (ldd == 0) ldd = K;
    if (kend > K) kend = K;
    const int tid_ = opaque_tid(); const int nl = tid_ & 63, kq = tid_ >> 6;
    for (int k0 = kbeg + kq * 8; k0 < kend; k0 += 64) {
        float v[8];
#pragma unroll
        for (int j = 0; j < 8; ++j) v[j] = srcval(nl, k0 + j);
        u32x4 w; w.x = cvt_pk_bf16(v[0], v[1]); w.y = cvt_pk_bf16(v[2], v[3]); w.z = cvt_pk_bf16(v[4], v[5]); w.w = cvt_pk_bf16(v[6], v[7]);
        *(u32x4*)(dst + (size_t)nl * ldd + k0) = w;
    }
}

__device__ void layer_prep_phase(PK p, int l, LAS unsigned char* lds) {
    unsigned char* ws = p->ws;
    const int nW = 1648, nItems = nW + (l == 0 ? 288 + 1 : 0);
    for (int it2 = opaque_bid(); it2 < nItems; it2 += opaque_gdim()) {
        int it, kbeg = 0, kend = 1 << 30;
        if (it2 < 704) { it = it2 >> 2; kbeg = (it2 & 3) * 256; kend = kbeg + 256; }
        else if (it2 < 1056) { const int q = it2 - 704; it = 176 + q / 11; kbeg = (q % 11) * 256; kend = kbeg + 256; }
        else if (it2 < 1456) { const int q = it2 - 1056; it = 208 + (q >> 2); kbeg = (q & 3) * 256; kend = kbeg + 256; }
        else if (it2 < 1520) { const int q = it2 - 1456; it = 308 + (q >> 2); kbeg = (q & 3) * 256; kend = kbeg + 256; }
        else if (it2 < 1568) { it = 324 + (it2 - 1520); }
        else if (it2 < 1632) { const int q = it2 - 1568; it = 372 + (q >> 2); kbeg = (q & 3) * 64; kend = kbeg + 64; }
        else if (it2 < 1648) { it = 388 + (it2 - 1632); }
        else it = 404 + (it2 - 1648);
        if (it < 176) {
            const int f = it / 88, j = it % 88; const float* src = p->ffn_w_in + ((size_t)(l * 2 + f) * 1024) * 5632;
            bf16_t* dst = (bf16_t*)(ws + OFF_W1) + ((size_t)f * 5632 + j * 64) * 1024;
            wt_rows64(dst, 1024, [&](int nl, int k) { const int np = j * 64 + nl, pn = np >> 8, wi = np & 255; const int col = wi < 128 ? pn * 128 + wi : FH + pn * 128 + (wi - 128); return src[(size_t)k * 5632 + col]; }, 0, kbeg, kend);
        } else if (it < 208) {
            const int q = it - 176, f = q / 16, j = q % 16; const float* src = p->ffn_w_out + ((size_t)(l * 2 + f) * FH) * 1024;
            bf16_t* dst = (bf16_t*)(ws + OFF_W2) + ((size_t)f * 1024 + j * 64) * FH;
            wt_rows64(dst, FH, [&](int nl, int k) { return src[(size_t)k * 1024 + j * 64 + nl]; }, 0, kbeg, kend);
        } else if (it < 308) {
            const int j = it - 208; const float* src = p->mix_w_in + (size_t)l * 1024 * 6304;
            bf16_t* dst = (bf16_t*)(ws + OFF_WM) + (size_t)j * 64 * 1024;
            wt_rows64(dst, 1024, [&](int nl, int k) { const int np = j * 64 + nl; const int col = np < 2208 ? np : (np < 2304 ? -1 : np - 96); return col < 0 ? 0.f : src[(size_t)k * 6304 + col]; }, 0, kbeg, kend);
        } else if (it < 324) {
            const int j = it - 308; const float* src = p->mix_w_out + (size_t)l * 1024 * 1024;
            bf16_t* dst = (bf16_t*)(ws + OFF_WO) + (size_t)j * 64 * 1024;
            wt_rows64(dst, 1024, [&](int nl, int k) { return src[(size_t)k * 1024 + j * 64 + nl]; }, 0, kbeg, kend);
        } else if (it < 372) {
            const int q = it - 324, bi = 1 + q / 16, j = q % 16; const float* src = p->branch_w_out + ((size_t)(l * 4 + bi) * 256) * 1024;
            bf16_t* dst = (bf16_t*)(ws + OFF_WB) + (size_t)j * 64 * 1024 + bi * 256;
            wt_rows64(dst, 256, [&](int nl, int k) { return src[(size_t)k * 1024 + j * 64 + nl]; }, 1024, kbeg, kend);
        } else if (it < 388) {
            const int j = it - 372; const float* wb = p->branch_w_out + ((size_t)(l * 4) * 256) * 1024; const float* pw = p->pool_w + (size_t)l * 4 * 64 * 64; const float* ps = p->pool_scale + l * 256;
            bf16_t* dst = (bf16_t*)(ws + OFF_WB) + (size_t)j * 64 * 1024;
            wt_rows64(dst, 256, [&](int nl, int k) { const int gI = k >> 6, n = j * 64 + nl; const float* pr = pw + (size_t)k * 64; float s = 0.f;
                for (int e = 0; e < 64; ++e) s += pr[e] * ps[gI * 64 + e] * wb[(size_t)(gI * 64 + e) * 1024 + n]; return s; }, 1024, kbeg, kend);
        } else if (it < 404) {
            const int j = it - 388; const float* wq = p->mla_w_qb + (size_t)l * 256 * 384; const float* wk = p->mla_w_kvb + (size_t)l * 128 * 512;
            const float* gq = p->mla_q_norm_g + l * 256; const float* gk = p->mla_kv_norm_g + l * 128;
            bf16_t* dst = (bf16_t*)(ws + OFF_WL) + (size_t)j * 64 * 384;
            wt_rows64(dst, 384, [&](int nl, int k) { const int n = j * 64 + nl;
                if (n < 384) return k < 256 ? gq[k] * wq[(size_t)k * 384 + n] : 0.f;
                if (n < 896) return k >= 256 ? gk[k - 256] * wk[(size_t)(k - 256) * 512 + (n - 384)] : 0.f;
                return 0.f; }, 0, kbeg, kend);
        } else if (it < 404 + 288) {
            const int q = it - 404, ll = q / 144, cb = q % 144;
            LAS float* sc = (LAS float*)lds;
            LAS float* red = (LAS float*)(lds + 5 * 1024 * 4);
            __syncthreads();
            for (int i = opaque_tid(); i < 5 * 1024; i += 512) { const int r = i >> 10, k = i & 1023; const float cv = r < 4 ? p->c[r * 1024 + k] : p->c_ctx[k]; sc[i] = cv * sigmoidf_(cv); }
            __syncthreads();
            const int jl = opaque_tid() & 63, kg = opaque_tid() >> 6; const int col = cb * 64 + jl;
            const float* wsrc = p->ada_w + (size_t)ll * 1024 * 9216 + col;
            float a0 = 0.f, a1 = 0.f, a2 = 0.f, a3 = 0.f, a4 = 0.f;
            for (int k = kg * 128; k < kg * 128 + 128; ++k) { const float wv = wsrc[(size_t)k * 9216]; a0 += sc[k] * wv; a1 += sc[1024 + k] * wv; a2 += sc[2048 + k] * wv; a3 += sc[3072 + k] * wv; a4 += sc[4096 + k] * wv; }
            red[(kg * 5 + 0) * 64 + jl] = a0; red[(kg * 5 + 1) * 64 + jl] = a1; red[(kg * 5 + 2) * 64 + jl] = a2; red[(kg * 5 + 3) * 64 + jl] = a3; red[(kg * 5 + 4) * 64 + jl] = a4;
            __syncthreads();
            if (opaque_tid() < 320) { const int r = opaque_tid() >> 6; float s = p->ada_b[ll * 9216 + col];
                for (int q2 = 0; q2 < 8; ++q2) s += red[(q2 * 5 + r) * 64 + jl];
                ((float*)(ws + OFF_MOD))[(size_t)(ll * 5 + r) * 9216 + col] = s; }
        } else {
            for (int i = opaque_tid(); i < 1024; i += 512) { const int pos = i >> 3, fi = i & 7; const float inv = exp2f(-(float)fi * 0.125f * 13.287712379549449f); const float ang = (float)pos * inv;
                ((float2*)(ws + OFF_ROPE))[i] = make_float2(cosf(ang), sinf(ang)); }
        }
    }
}

__device__ void norm_mod_phase(const float* srcL, const float* srcC, float* cpyL, float* cpyC, const float* g, const float* mod, bf16_t* TN, int nrows, const float* pb, int nsl) {
    const int tid_ = opaque_tid(); const int lane = tid_ & 63, gw = opaque_bid() * 8 + (tid_ >> 6), nw = opaque_gdim() * 8;
    for (int row = gw; row < nrows; row += nw) {
        const bool lat = row < RL;
        const float* sp = lat ? srcL + (size_t)row * 1024 : srcC + (size_t)(row - RL) * 1024;
        const float* mp = mod + (lat ? (row >> 13) : 4) * 9216;
        f32x4 v[4]; float ss = 0.f;
#pragma unroll
        for (int j = 0; j < 4; ++j) v[j] = *(const f32x4*)(sp + 256 * j + 4 * lane);
        if (!lat && nsl > 0) {
            for (int sl = 0; sl < nsl; ++sl) { const float* pp = pb + ((size_t)sl * 1024 + (row - RL)) * 1024;
#pragma unroll
                for (int j = 0; j < 4; ++j) v[j] += *(const f32x4*)(pp + 256 * j + 4 * lane); }
            float* wp = (float*)sp;
#pragma unroll
            for (int j = 0; j < 4; ++j) *(f32x4*)(wp + 256 * j + 4 * lane) = v[j];
        }
#pragma unroll
        for (int j = 0; j < 4; ++j) ss += v[j][0] * v[j][0] + v[j][1] * v[j][1] + v[j][2] * v[j][2] + v[j][3] * v[j][3];
        if (cpyL) { float* cp = lat ? cpyL + (size_t)row * 1024 : cpyC + (size_t)(row - RL) * 1024;
#pragma unroll
            for (int j = 0; j < 4; ++j) *(f32x4*)(cp + 256 * j + 4 * lane) = v[j]; }
        ss = wave_sum(ss);
        const float rstd = rsqrtf(ss * (1.0f / 1024.0f) + NEPS);
#pragma unroll
        for (int j = 0; j < 4; ++j) {
            const int col = 256 * j + 4 * lane;
            const f32x4 gg = *(const f32x4*)(g + col), sh = *(const f32x4*)(mp + col), sc = *(const f32x4*)(mp + 1024 + col);
            float o[4];
#pragma unroll
            for (int e = 0; e < 4; ++e) o[e] = (v[j][e] * rstd * gg[e]) * (1.0f + sc[e]) + sh[e];
            u32x2 w; w.x = cvt_pk_bf16(o[0], o[1]); w.y = cvt_pk_bf16(o[2], o[3]);
            *(u32x2*)(TN + (size_t)row * 1024 + col) = w;
        }
    }
}
__device__ void final_norm_phase(float* H, const float* g) {
    const int tid_ = opaque_tid(); const int lane = tid_ & 63, gw = opaque_bid() * 8 + (tid_ >> 6), nw = opaque_gdim() * 8;
    for (int row = gw; row < RL; row += nw) {
        float* sp = H + (size_t)row * 1024; f32x4 v[4]; float ss = 0.f;
#pragma unroll
        for (int j = 0; j < 4; ++j) { v[j] = *(const f32x4*)(sp + 256 * j + 4 * lane); ss += v[j][0] * v[j][0] + v[j][1] * v[j][1] + v[j][2] * v[j][2] + v[j][3] * v[j][3]; }
        ss = wave_sum(ss);
        const float rstd = rsqrtf(ss * (1.0f / 1024.0f) + NEPS);
#pragma unroll
        for (int j = 0; j < 4; ++j) { const f32x4 gg = *(const f32x4*)(g + 256 * j + 4 * lane); *(f32x4*)(sp + 256 * j + 4 * lane) = v[j] * rstd * gg; }
    }
}

__device__ void prep_phase(PK p) {
    unsigned char* ws = p->ws;
    bf16_t* PJ = (bf16_t*)(ws + OFF_B); bf16_t* YB = (bf16_t*)(ws + OFF_A); bf16_t* MK = (bf16_t*)(ws + OFF_MK); float* RSTD = (float*)(ws + OFF_RSTD);
    const float2* RT = (const float2*)(ws + OFF_ROPE);
    const int tid_ = opaque_tid(); const int lane = tid_ & 63, gw = opaque_bid() * 8 + (tid_ >> 6), nw = opaque_gdim() * 8;
    for (int row = gw; row < RA; row += nw) {
        const bool lat = row < RL;
        int t, n; if (lat) { t = row & 8191; n = 8192; } else { t = (row - RL) & 255; n = 256; }
        const int sbase = row - t;
        bf16_t* prow = PJ + (size_t)row * PJW;
        {
            const int wdw = 2 << (lane >> 4), hw = wdw >> 1; const int lo = max(t - hw, 0), hi = min(t + hw, n);
            float s0 = 0.f, s1 = 0.f, s2 = 0.f, s3 = 0.f;
#pragma unroll
            for (int i = 0; i < 16; ++i) {
                const int off = i - 8, tt = t + off; const bool ok = (off >= -hw) && (off < hw) && (tt >= 0) && (tt < n);
                const u32x2 v = *(const u32x2*)(PJ + (size_t)(sbase + (ok ? tt : t)) * PJW + 4 * lane); const float wg = ok ? 1.0f : 0.0f;
                s0 += wg * bf_lo(v.x); s1 += wg * bf_hi(v.x); s2 += wg * bf_lo(v.y); s3 += wg * bf_hi(v.y); }
            const float ic = 1.0f / (float)(hi - lo); const u32x2 sv = *(const u32x2*)(prow + 4 * lane);
            u32x2 w; w.x = cvt_pk_bf16(s0 * ic - bf_lo(sv.x), s1 * ic - bf_hi(sv.x)); w.y = cvt_pk_bf16(s2 * ic - bf_lo(sv.y), s3 * ic - bf_hi(sv.y));
            *(u32x2*)(YB + (size_t)row * 1024 + 4 * lane) = w;
        }
        {
            const u32x2 q = *(const u32x2*)(prow + C_MQ + 4 * lane); const unsigned kv = *(const unsigned*)(prow + C_MKV + 2 * lane);
            float sq = bf_lo(q.x) * bf_lo(q.x) + bf_hi(q.x) * bf_hi(q.x) + bf_lo(q.y) * bf_lo(q.y) + bf_hi(q.y) * bf_hi(q.y);
            float sk = bf_lo(kv) * bf_lo(kv) + bf_hi(kv) * bf_hi(kv);
            sq = wave_sum(sq); sk = wave_sum(sk);
            if (lane == 0) { RSTD[row * 2] = rsqrtf(sq * (1.0f / 256.0f) + NEPS); RSTD[row * 2 + 1] = rsqrtf(sk * (1.0f / 128.0f) + NEPS); }
        }
        if (lane < 34) {
            const bool iskr = lane >= 32; const int a = lane & 1;
            bf16_t* ep = iskr ? prow + C_MKR + a * 16 : prow + ((lane >> 4) ? C_DK : C_DQ) + ((lane >> 1) & 7) * 32 + a * 16;
            const u32x4 e0 = *(const u32x4*)ep, e1 = *(const u32x4*)(ep + 8);
            float x1[8], x2[8];
            x1[0] = bf_lo(e0.x); x1[1] = bf_hi(e0.x); x1[2] = bf_lo(e0.y); x1[3] = bf_hi(e0.y); x1[4] = bf_lo(e0.z); x1[5] = bf_hi(e0.z); x1[6] = bf_lo(e0.w); x1[7] = bf_hi(e0.w);
            x2[0] = bf_lo(e1.x); x2[1] = bf_hi(e1.x); x2[2] = bf_lo(e1.y); x2[3] = bf_hi(e1.y); x2[4] = bf_lo(e1.z); x2[5] = bf_hi(e1.z); x2[6] = bf_lo(e1.w); x2[7] = bf_hi(e1.w);
            if (lat) { const int pos = a ? (t & 63) : (t >> 6);
#pragma unroll
                for (int i = 0; i < 8; ++i) { const float2 cs = RT[pos * 8 + i]; const float o1 = x1[i] * cs.x - x2[i] * cs.y, o2 = x1[i] * cs.y + x2[i] * cs.x; x1[i] = o1; x2[i] = o2; } }
            u32x4 w0, w1; w0.x = cvt_pk_bf16(x1[0], x1[1]); w0.y = cvt_pk_bf16(x1[2], x1[3]); w0.z = cvt_pk_bf16(x1[4], x1[5]); w0.w = cvt_pk_bf16(x1[6], x1[7]);
            w1.x = cvt_pk_bf16(x2[0], x2[1]); w1.y = cvt_pk_bf16(x2[2], x2[3]); w1.z = cvt_pk_bf16(x2[4], x2[5]); w1.w = cvt_pk_bf16(x2[6], x2[7]);
            if (iskr) {
#pragma unroll
                for (int hh = 0; hh < 4; ++hh) { bf16_t* kp = MK + (size_t)row * 384 + hh * 96 + 64 + a * 16; *(u32x4*)kp = w0; *(u32x4*)(kp + 8) = w1; }
            } else if (lat) { *(u32x4*)ep = w0; *(u32x4*)(ep + 8) = w1; }
        }
    }
}

#define MFMA32(a, b, c) __builtin_amdgcn_mfma_f32_32x32x16_bf16((a), (b), (c), 0, 0, 0)
typedef float f32x2 __attribute__((ext_vector_type(2)));
template <int MODE>
__device__ __forceinline__ void attn_item(PK p, int l, LAS unsigned char* lds, int b, int h, int qb, bool ctxq, float lam, float lam_init) {
    constexpr int NCOMP = (MODE == 1) ? 2 : 1, NKS = (MODE == 0) ? 4 : ((MODE == 1) ? 2 : 6), KW = NCOMP * NKS * 16, KCH = KW / 8, KSTR = KW * 2 + 16, VSTR = 192;
    constexpr int KBUF = 64 * KSTR, VBUF = 64 * VSTR, BUFSZ = KBUF + VBUF, BIAS_OFF = 3 * BUFSZ;
    constexpr bool STAG = (MODE != 0);
    const int tid = opaque_tid(), w = tid >> 6, lane = tid & 63, g = lane >> 5, l32 = lane & 31;
    unsigned char* ws = p->ws;
    const bf16_t* PJ = (const bf16_t*)(ws + OFF_B);
    const bf16_t *Qp, *Kp, *Vp; int ldq, ldk, ldv, outoff; float scale;
    if (MODE == 0) { Qp = PJ + C_NQ + 64 * h; Kp = PJ + C_NK + 64 * h; Vp = PJ + C_NV + 64 * h; ldq = ldk = ldv = PJW; outoff = 256 + 64 * h; scale = 0.125f; }
    else if (MODE == 1) { Qp = PJ + C_DQ + 64 * h; Kp = PJ + C_DK + 64 * h; Vp = PJ + C_DV + 64 * h; ldq = ldk = ldv = PJW; outoff = 512 + 64 * h; scale = 0.17677669529663687f; }
    else { Qp = (const bf16_t*)(ws + OFF_D) + 96 * h; Kp = (const bf16_t*)(ws + OFF_MK) + 96 * h; Vp = (const bf16_t*)(ws + OFF_MV) + 64 * h; ldq = ldk = 384; ldv = 256; outoff = 768 + 64 * h; scale = 0.10206207261596575f; }
    const float cs = scale * LOG2E;
    int qrow0, loc0, nloc;
    if (ctxq) { qrow0 = RL + b * 256; loc0 = 0; nloc = 0; }
    else { qrow0 = b * 8192 + qb * 256;
        if (MODE == 0) { const int r0 = qb * 4; loc0 = clampi(r0 - 4, 0, 120); nloc = clampi(r0 - 1, 0, 120) + 8 - loc0; } else { loc0 = 0; nloc = 128; } }
    const int nt = nloc + 4;
    const bool nabias = (MODE == 0) && !ctxq;
    const bool late = STAG && (w >= 4);
    const int rw = qb * 4 + (w >> 1), sw = clampi(rw - 4, 0, 120);
    const int jq = 32 * (w & 1) + l32, cst = clampi(jq - 8, 0, 48);
    if (nabias && tid < 465) ((LAS float*)(lds + BIAS_OFF))[tid] = p->na_rpb[(size_t)(l * 4 + h) * 465 + tid] * LOG2E;

    const size_t qrow = (size_t)qrow0 + 32 * w + l32;
    bf16x8 qf[NCOMP * NKS];
#pragma unroll
    for (int i = 0; i < NCOMP * NKS; ++i) {
        const u32x4 raw = *(const u32x4*)(Qp + qrow * ldq + 16 * i + 8 * g);
        u32x4 sc4; sc4.x = cvt_pk_bf16(bf_lo(raw.x) * cs, bf_hi(raw.x) * cs); sc4.y = cvt_pk_bf16(bf_lo(raw.y) * cs, bf_hi(raw.y) * cs);
        sc4.z = cvt_pk_bf16(bf_lo(raw.z) * cs, bf_hi(raw.z) * cs); sc4.w = cvt_pk_bf16(bf_lo(raw.w) * cs, bf_hi(raw.w) * cs);
        qf[i] = __builtin_bit_cast(bf16x8, sc4);
    }

    const int kr0 = tid / KCH, kc0 = tid % KCH, kr1 = (tid + 512) / KCH, kc1 = (tid + 512) % KCH, vr = tid >> 3, vc = tid & 7;
    const bool hask1 = (KCH == 12) && (tid < 256);
    u32x4 rk0, rk1 = (u32x4){0u, 0u, 0u, 0u}, rv;
#define TILE_ROW(t) ((t) < nloc ? (b * 8192 + 64 * (loc0 + (t))) : (RL + b * 256 + 64 * ((t) - nloc)))
#define LOAD_TILE(t) do { const size_t _tb = (size_t)TILE_ROW(t); rk0 = *(const u32x4*)(Kp + (_tb + kr0) * ldk + kc0 * 8); \
        if (hask1) rk1 = *(const u32x4*)(Kp + (_tb + kr1) * ldk + kc1 * 8); rv = *(const u32x4*)(Vp + (_tb + vr) * ldv + vc * 8); } while (0)
#define STORE_TILE(buf) do { LAS unsigned char* _kb = lds + (buf) * BUFSZ; *(LAS u32x4*)(_kb + kr0 * KSTR + kc0 * 16) = rk0; \
        if (hask1) *(LAS u32x4*)(_kb + kr1 * KSTR + kc1 * 16) = rk1; *(LAS u32x4*)(_kb + KBUF + vr * VSTR + vc * 16) = rv; } while (0)

    float mrun[NCOMP], lsum[NCOMP]; f32x16 O[NCOMP][2];
#pragma unroll
    for (int c = 0; c < NCOMP; ++c) { mrun[c] = -1e30f; lsum[c] = 0.f;
#pragma unroll
        for (int dt = 0; dt < 2; ++dt)
#pragma unroll
            for (int r = 0; r < 16; ++r) O[c][dt][r] = 0.f; }
    bf16x8 P[NCOMP][2][2];
#pragma unroll
    for (int c = 0; c < NCOMP; ++c)
#pragma unroll
        for (int kt = 0; kt < 2; ++kt)
#pragma unroll
            for (int s2 = 0; s2 < 2; ++s2) P[c][kt][s2] = (bf16x8){0, 0, 0, 0, 0, 0, 0, 0};

    LOAD_TILE(0); STORE_TILE(0); __syncthreads();
    const int koff = l32 * KSTR + g * 16;
    const int i16 = lane & 15, tq = i16 >> 2, tp = i16 & 3, blk = (lane >> 4) & 1;
    const int voff = (4 * g + tq) * VSTR + (16 * blk + 4 * tp) * 2;
#define PV_TILE(buf) do { LAS unsigned char* _vb = lds + (buf) * BUFSZ + KBUF + voff; \
        _Pragma("unroll") for (int kt = 0; kt < 2; ++kt) { bf16x8 vf[2][2]; \
            _Pragma("unroll") for (int s2 = 0; s2 < 2; ++s2) _Pragma("unroll") for (int dt = 0; dt < 2; ++dt) { LAS unsigned char* vp = _vb + (32 * kt + 16 * s2) * VSTR + dt * 64; \
                const s16x4 lo = __builtin_amdgcn_ds_read_tr16_b64_v4i16((LAS s16x4*)vp); const s16x4 hi = __builtin_amdgcn_ds_read_tr16_b64_v4i16((LAS s16x4*)(vp + 8 * VSTR)); \
                vf[s2][dt] = __builtin_shufflevector(lo, hi, 0, 1, 2, 3, 4, 5, 6, 7); } \
            __builtin_amdgcn_s_setprio(1); \
            _Pragma("unroll") for (int s2 = 0; s2 < 2; ++s2) _Pragma("unroll") for (int dt = 0; dt < 2; ++dt) _Pragma("unroll") for (int c = 0; c < NCOMP; ++c) O[c][dt] = MFMA32(vf[s2][dt], P[c][kt][s2], O[c][dt]); \
            __builtin_amdgcn_s_setprio(0); } } while (0)

#define PV_TILE_C(buf, cc) do { LAS unsigned char* _vb = lds + (buf) * BUFSZ + KBUF + voff; \
        _Pragma("unroll") for (int kt = 0; kt < 2; ++kt) { bf16x8 vf[2][2]; \
            _Pragma("unroll") for (int s2 = 0; s2 < 2; ++s2) _Pragma("unroll") for (int dt = 0; dt < 2; ++dt) { LAS unsigned char* vp = _vb + (32 * kt + 16 * s2) * VSTR + dt * 64; \
                const s16x4 lo = __builtin_amdgcn_ds_read_tr16_b64_v4i16((LAS s16x4*)vp); const s16x4 hi = __builtin_amdgcn_ds_read_tr16_b64_v4i16((LAS s16x4*)(vp + 8 * VSTR)); \
                vf[s2][dt] = __builtin_shufflevector(lo, hi, 0, 1, 2, 3, 4, 5, 6, 7); } \
            __builtin_amdgcn_s_setprio(1); \
            _Pragma("unroll") for (int s2 = 0; s2 < 2; ++s2) _Pragma("unroll") for (int dt = 0; dt < 2; ++dt) O[cc][dt] = MFMA32(vf[s2][dt], P[cc][kt][s2], O[cc][dt]); \
            __builtin_amdgcn_s_setprio(0); } } while (0)
    bool pend = false; int pbuf = 0, cbuf = 0;
    for (int t = 0; t < nt; ++t) {
        const bool more = (t + 1 < nt);
        if (more) LOAD_TILE(t + 1);
        bool active = true; int krow = 0;
        if (nabias && t < nloc) { krow = loc0 + t; active = (krow >= sw) && (krow < sw + 8); }
        bool slow = (MODE == 0) || (t == 0);
        if (active) {
          again:
            LAS unsigned char* Kb = lds + cbuf * BUFSZ + koff;
            f32x16 S[NCOMP][2];
#pragma unroll
            for (int c = 0; c < NCOMP; ++c)
#pragma unroll
                for (int kt = 0; kt < 2; ++kt) {
                    bf16x8 kf[NKS];
#pragma unroll
                    for (int ks = 0; ks < NKS; ++ks) kf[ks] = *(const LAS bf16x8*)(Kb + kt * 32 * KSTR + (c * NKS + ks) * 32);
#pragma unroll
                    for (int r = 0; r < 16; ++r) S[c][kt][r] = 0.f;
                    __builtin_amdgcn_s_setprio(1);
#pragma unroll
                    for (int ks = 0; ks < NKS; ++ks) S[c][kt] = MFMA32(kf[ks], qf[c * NKS + ks], S[c][kt]);
                    __builtin_amdgcn_s_setprio(0);
                }
            if (STAG && late && pend) { PV_TILE(pbuf); pend = false; }
            float mxc[NCOMP], mnw[NCOMP];
            if (!slow) {
#pragma unroll
                for (int c = 0; c < NCOMP; ++c) mnw[c] = mrun[c];
            } else {
#pragma unroll
            for (int c = 0; c < NCOMP; ++c) {
                float mx = -1e30f;
                if (nabias && t < nloc) {
                    const LAS float* bt = (const LAS float*)(lds + BIAS_OFF) + (krow - rw + 7) * 31;
#pragma unroll
                    for (int kt = 0; kt < 2; ++kt)
#pragma unroll
                        for (int r = 0; r < 16; ++r) { const int jk = 32 * kt + (r & 3) + 8 * (r >> 2) + 4 * g; const bool ok = (jk >= cst) && (jk < cst + 16);
                            const float bv = bt[clampi(jk - jq + 15, 0, 30)]; const float xv = ok ? (S[c][kt][r] + bv) : -1e30f; S[c][kt][r] = xv; mx = fmaxf(mx, xv); }
                } else {
#pragma unroll
                    for (int kt = 0; kt < 2; ++kt)
#pragma unroll
                        for (int r = 0; r < 16; r += 2) mx = fmaxf(fmaxf(mx, S[c][kt][r]), S[c][kt][r + 1]);
                }
                mxc[c] = mx;
            }
#pragma unroll
            for (int c = 0; c < NCOMP; ++c) mxc[c] = fmaxf(mxc[c], shflx(mxc[c], 32));
            bool grow = false;
#pragma unroll
            for (int c = 0; c < NCOMP; ++c) { mnw[c] = fmaxf(mrun[c], mxc[c]); grow = grow || (mnw[c] > mrun[c]); }
            if (__any(grow)) {
#pragma unroll
                for (int c = 0; c < NCOMP; ++c) { const float alpha = fast_exp2(mrun[c] - mnw[c]); lsum[c] *= alpha;
#pragma unroll
                    for (int dt = 0; dt < 2; ++dt) O[c][dt] *= alpha;
                    mrun[c] = mnw[c]; }
            }
            }
#pragma unroll
            for (int c = 0; c < NCOMP; ++c) { const f32x2 m2 = (f32x2){mnw[c], mnw[c]};
#pragma unroll
                for (int kt = 0; kt < 2; ++kt)
#pragma unroll
                    for (int r = 0; r < 16; r += 2) { const f32x2 d = (f32x2){S[c][kt][r], S[c][kt][r + 1]} - m2; S[c][kt][r] = d.x; S[c][kt][r + 1] = d.y; } }
#pragma unroll
            for (int c = 0; c < NCOMP; ++c)
#pragma unroll
                for (int kt = 0; kt < 2; ++kt)
#pragma unroll
                    for (int r = 0; r < 16; ++r) S[c][kt][r] = fast_exp2(S[c][kt][r]);
#pragma unroll
            for (int c = 0; c < NCOMP; ++c) { f32x2 rs2 = (f32x2){0.f, 0.f};
#pragma unroll
                for (int kt = 0; kt < 2; ++kt)
#pragma unroll
                    for (int s2 = 0; s2 < 2; ++s2) { u32x4 pk;
#pragma unroll
                        for (int e = 0; e < 4; ++e) { const f32x2 ev = (f32x2){S[c][kt][8 * s2 + 2 * e], S[c][kt][8 * s2 + 2 * e + 1]}; rs2 += ev; pk[e] = cvt_pk_bf16(ev.x, ev.y); }
                        P[c][kt][s2] = __builtin_bit_cast(bf16x8, pk); }
                mxc[c] = rs2.x + rs2.y; }
            if (!slow) { bool bad = false;
#pragma unroll
                for (int c = 0; c < NCOMP; ++c) bad = bad || !(mxc[c] < 1.0e18f);
                if (__any(bad)) { slow = true; goto again; } }
#pragma unroll
            for (int c = 0; c < NCOMP; ++c) lsum[c] += mxc[c];
            if (!(STAG && late)) PV_TILE(cbuf);
            if (STAG && late) { pend = true; pbuf = cbuf; }
        }
        const int nbuf = (cbuf == 2) ? 0 : cbuf + 1;
        if (more) STORE_TILE(nbuf);
        __syncthreads();
        cbuf = nbuf;
    }
    if (STAG && late && pend) PV_TILE(pbuf);
#undef PV_TILE
#undef PV_TILE_C
#undef TILE_ROW
#undef LOAD_TILE
#undef STORE_TILE
    float inv[NCOMP];
#pragma unroll
    for (int c = 0; c < NCOMP; ++c) { const float lt = lsum[c] + shflx(lsum[c], 32); inv[c] = 1.0f / lt; }
    bf16_t* op = (bf16_t*)(ws + OFF_A) + qrow * 1024 + outoff;
    if (MODE == 1) {
        const float li1 = lam * inv[NCOMP - 1]; float ss = 0.f;
#pragma unroll
        for (int dt = 0; dt < 2; ++dt)
#pragma unroll
            for (int r = 0; r < 16; ++r) { const float o = O[0][dt][r] * inv[0] - li1 * O[NCOMP - 1][dt][r]; O[0][dt][r] = o; ss += o * o; }
        ss += shflx(ss, 32);
        const float rstd = rsqrtf(ss * (1.0f / 64.0f) + NEPS) * (1.0f - lam_init);
        const float* sg = p->diff_subln_g + l * 64;
#pragma unroll
        for (int dt = 0; dt < 2; ++dt)
#pragma unroll
            for (int rq = 0; rq < 4; ++rq) { const int dv = 32 * dt + 8 * rq + 4 * g; const f32x4 gg = *(const f32x4*)(sg + dv);
                u32x2 wv; wv.x = cvt_pk_bf16(O[0][dt][4 * rq] * rstd * gg[0], O[0][dt][4 * rq + 1] * rstd * gg[1]); wv.y = cvt_pk_bf16(O[0][dt][4 * rq + 2] * rstd * gg[2], O[0][dt][4 * rq + 3] * rstd * gg[3]);
                *(u32x2*)(op + dv) = wv; }
    } else {
#pragma unroll
        for (int dt = 0; dt < 2; ++dt)
#pragma unroll
            for (int rq = 0; rq < 4; ++rq) { const int dv = 32 * dt + 8 * rq + 4 * g;
                u32x2 wv; wv.x = cvt_pk_bf16(O[0][dt][4 * rq] * inv[0], O[0][dt][4 * rq + 1] * inv[0]); wv.y = cvt_pk_bf16(O[0][dt][4 * rq + 2] * inv[0], O[0][dt][4 * rq + 3] * inv[0]);
                *(u32x2*)(op + dv) = wv; }
    }
    __syncthreads();
}

__device__ void attn_phase(PK p, int l, LAS unsigned char* lds) {
    const float lam_init = (l == 0) ? 0.2f : 0.35550906759502f;
    const float* dl = p->diff_lambda + l * 128;
    float d01 = 0.f, d23 = 0.f;
    for (int i = 0; i < 32; ++i) { d01 += dl[i] * dl[32 + i]; d23 += dl[64 + i] * dl[96 + i]; }
    const float lam = expf(d01) - expf(d23) + lam_init;
    const int nItems = 1536 + (l == 0 ? 48 : 0);
    for (int it = opaque_bid(); it < nItems; it += opaque_gdim()) {
        if (it < 1536) {
            const int ty = it >> 9, idx = it & 511, bh = ((idx & 7) << 1) | (idx >> 8), b = bh >> 2, h = bh & 3, qb = (idx >> 3) & 31;
            if (ty == 0) attn_item<1>(p, l, lds, b, h, qb, false, lam, lam_init);
            else if (ty == 1) attn_item<2>(p, l, lds, b, h, qb, false, lam, lam_init);
            else attn_item<0>(p, l, lds, b, h, qb, false, lam, lam_init);
        } else {
            const int idx = it - 1536, ty = idx >> 4, b = (idx >> 2) & 3, h = idx & 3;
            if (ty == 0) attn_item<1>(p, l, lds, b, h, 0, true, lam, lam_init);
            else if (ty == 1) attn_item<2>(p, l, lds, b, h, 0, true, lam, lam_init);
            else attn_item<0>(p, l, lds, b, h, 0, true, lam, lam_init);
        }
    }
}

constexpr int PH_PER_LAYER = 14, N_PHASES = 2 * PH_PER_LAYER + 1;

__device__ __forceinline__ void run_phase(PK p, int ph, LAS unsigned char* lds, float rcoef) {
    unsigned char* ws = p->ws;
    pg8::StaticOrder S;
    if (ph == N_PHASES - 1) { final_norm_phase(p->out, p->final_norm_g); return; }
    int l = ph / PH_PER_LAYER; const int q = ph % PH_PER_LAYER;
#define OPQL asm volatile("" : "+s"(l))
#define HC ((float*)(ws + OFF_HC))
#define MOD ((const float*)(ws + OFF_MOD) + (size_t)l * 5 * 9216)
#define TN ((bf16_t*)(ws + OFF_A))
#define HID ((bf16_t*)(ws + OFF_B))
#define Mlate ((l == 0) ? RA : RL)
    switch (q) {
    case 0: OPQL; layer_prep_phase(p, l, lds); break;
    case 1: OPQL; if (l == 0) norm_mod_phase(p->x, p->ctx, p->out, HC, p->norm_g + (l * 3 + 0) * 1024, MOD, TN, RA, nullptr, 0);
            else norm_mod_phase(p->out, HC, nullptr, nullptr, p->norm_g + (l * 3 + 0) * 1024, MOD, TN, RA, (const float*)(ws + OFF_PB), 11); break;
    case 2: case 12: { OPQL; const int f = (q == 2) ? 0 : 1; const int M = (q == 2) ? RA : Mlate;
        pg8::Gemm g{TN, (const bf16_t*)(ws + OFF_W1) + (size_t)f * 5632 * 1024, M, 5632, 1024, 1024, 1024}; S.init(M, 5632, opaque_gdim(), opaque_bid());
        EpiSwiglu E{HID}; pg8::gemm_phase(lds, g, S, E); } break;
    case 4: OPQL; norm_mod_phase(p->out, HC, nullptr, nullptr, p->norm_g + (l * 3 + 1) * 1024, MOD + 3 * 1024, TN, RA, (const float*)(ws + OFF_PB), 11); break;
    case 5: { OPQL; pg8::Gemm g{TN, (const bf16_t*)(ws + OFF_WM), RA, 6400, 1024, 1024, 1024}; S.init(RA, 6400, opaque_gdim(), opaque_bid());
        EpiPJ E{(bf16_t*)(ws + OFF_B), ws + OFF_C}; pg8::gemm_phase(lds, g, S, E); } break;
    case 6: prep_phase(p); break;
    case 7: { OPQL; pg8::Gemm g{(const bf16_t*)(ws + OFF_B) + C_MQ, (const bf16_t*)(ws + OFF_WL), RA, 1024, 384, PJW, 384}; S.init(RA, 1024, opaque_gdim(), opaque_bid());
        EpiMLA E{(bf16_t*)(ws + OFF_D), (bf16_t*)(ws + OFF_MK), (bf16_t*)(ws + OFF_MV), (const float*)(ws + OFF_RSTD), (const float2*)(ws + OFF_ROPE)}; pg8::gemm_phase(lds, g, S, E); } break;
    case 8: OPQL; attn_phase(p, l, lds); break;
    case 9: { OPQL; pg8::Gemm g{(const bf16_t*)(ws + OFF_A), (const bf16_t*)(ws + OFF_WB), Mlate, 1024, 1024, 1024, 1024}; S.init(Mlate, 1024, opaque_gdim(), opaque_bid());
        EpiMerge E{ws + OFF_C, (bf16_t*)(ws + OFF_D)}; pg8::gemm_phase(lds, g, S, E); } break;
    case 3: case 13: case 10: { OPQL;
        const bool isout = (q == 10); const int f = (q == 13) ? 1 : 0;
        const bf16_t* A = isout ? (const bf16_t*)(ws + OFF_D) : (const bf16_t*)HID;
        const bf16_t* Bt = isout ? (const bf16_t*)(ws + OFF_WO) : (const bf16_t*)(ws + OFF_W2) + (size_t)f * 1024 * FH;
        const int K = isout ? 1024 : FH;
        const float* gate = MOD + (isout ? 5 : (q == 3 ? 2 : 8)) * 1024;
        const float coef = (isout ? 1.0f : 0.5f) * rcoef;
        const bool withctx = (q == 3) || (l == 0);
        { pg8::Gemm g{A, Bt, RL, 1024, K, K, K}; S.init(RL, 1024, opaque_gdim(), opaque_bid());
          EpiResid E{p->out, HC, gate, coef}; pg8::gemm_phase(lds, g, S, E); }
        if (withctx) {
            const int nsu = 16 * (K / 256);
            for (int su = opaque_bid(); su < nsu; su += opaque_gdim()) {
                const int ks = su >> 4, pmn = su & 15;
                pg8::SingleUnit SU; SU.pm = 128 + (pmn >> 2); SU.pn = pmn & 3; SU.has = true;
                pg8::Gemm g2{A + ks * 256, Bt + ks * 256, RA, 1024, 256, K, K};
                EpiPartial E2{(float*)(ws + OFF_PB) + (size_t)ks * 1024 * 1024, gate + 4 * 9216, coef}; pg8::gemm_phase(lds, g2, SU, E2);
            }
        }
    } break;
    case 11: OPQL; norm_mod_phase(p->out, HC, nullptr, nullptr, p->norm_g + (l * 3 + 2) * 1024, MOD + 6 * 1024, TN, Mlate, (const float*)(ws + OFF_PB), 4); break;
    }
#undef OPQL
#undef HC
#undef MOD
#undef TN
#undef HID
#undef Mlate
}

__global__ void __launch_bounds__(512, 2) fwd_megakernel(Params p) {
    extern __shared__ __attribute__((aligned(16))) unsigned char shm[];
    LAS unsigned char* lds = (LAS unsigned char*)shm;
#if N_LAUNCH_MODE == 1
    cg::grid_group grid = cg::this_grid();
    const int ph_lo = p.ph_lo, ph_hi = p.ph_hi;
    volatile LAS unsigned* st = (volatile LAS unsigned*)(lds + pg8::STAGE_BYTES);
    unsigned* bar = (unsigned*)(p.ws + OFF_BAR);
    if (opaque_tid() < 4) st[opaque_tid()] = 0u;
    if (opaque_bid() == 0) for (int i = opaque_tid(); i < XCD_BAR_WORDS; i += 512) bar[i] = 0u;
    __syncthreads();
#if PROBE_Q >= 0
    const int nseq = 2 * (PH_PER_LAYER + 1) + 1;
    for (int i = 0; i < nseq; ++i) {
        int ph;
        if (i == nseq - 1) ph = N_PHASES - 1;
        else { const int li = i / (PH_PER_LAYER + 1), r = i % (PH_PER_LAYER + 1); ph = li * PH_PER_LAYER + (r <= PROBE_Q ? r : r - 1); }
        PK pk = (PK)__builtin_amdgcn_kernarg_segment_ptr();
        asm volatile("" : "+s"(pk));
        run_phase(pk, ph, lds, 1.0f);
        if (i == 0) { grid.sync(); xcd_barrier_post(bar); }
        else if (i + 1 < nseq) xcd_barrier(bar, st);
    }
#else
    for (int ph = ph_lo; ph < ph_hi; ++ph) {
        PK pk = (PK)__builtin_amdgcn_kernarg_segment_ptr();
        asm volatile("" : "+s"(pk));
        run_phase(pk, ph, lds, 1.0f);
        if (ph == ph_lo) { grid.sync(); xcd_barrier_post(bar); }
        else if (ph + 1 < ph_hi) xcd_barrier(bar, st);
    }
#endif
#else
    const int ph_lo = p.ph_lo, ph_hi = p.ph_hi;
    for (int ph = ph_lo; ph < ph_hi; ++ph) { PK pk = (PK)__builtin_amdgcn_kernarg_segment_ptr(); asm volatile("" : "+s"(pk)); run_phase(pk, ph, lds, 1.0f); }
#endif
}

extern "C" void kernel_launch(void* const* d_in, const int* in_sizes, int n_in, void* d_out, int out_size, void* d_ws, size_t ws_size, hipStream_t stream) {
    constexpr int LDS_BYTES = pg8::STAGE_BYTES + 16;
    static int grid_blocks = 0;
    if (grid_blocks == 0) {
        if (n_in != 22 || ws_size < WS_END) { fprintf(stderr, "kernel_launch: unexpected inputs (n_in %d, ws %zu < %zu)\n", n_in, ws_size, (size_t)WS_END); grid_blocks = -1; return; }
        int dev = 0, cus = 0, per_cu = 0;
        hipGetDevice(&dev); hipDeviceGetAttribute(&cus, hipDeviceAttributeMultiprocessorCount, dev);
        if (hipFuncSetAttribute((const void*)fwd_megakernel, hipFuncAttributeMaxDynamicSharedMemorySize, LDS_BYTES) != hipSuccess) { fprintf(stderr, "hipFuncSetAttribute failed\n"); grid_blocks = -1; return; }
        if (hipOccupancyMaxActiveBlocksPerMultiprocessor(&per_cu, (const void*)fwd_megakernel, 512, LDS_BYTES) != hipSuccess || per_cu < 1) per_cu = 1;
        (void)hipGetLastError();
        grid_blocks = cus * 1;
    }
    if (grid_blocks < 0) return;
    Params hp{};
    const float** pp = (const float**)&hp;
    for (int i = 0; i < 22; ++i) pp[i] = (const float*)d_in[i];
    hp.out = (float*)d_out; hp.ws = (unsigned char*)d_ws;
#if N_LAUNCH_MODE == 1
    hp.ph_lo = 0; hp.ph_hi = N_PHASES;
    void* args[] = {&hp};
    hipError_t e = hipLaunchCooperativeKernel((const void*)fwd_megakernel, dim3(grid_blocks), dim3(512), args, LDS_BYTES, stream);
    if (e != hipSuccess) fprintf(stderr, "cooperative launch failed: %s (grid %d)\n", hipGetErrorString(e), grid_blocks);
#else
    for (int ph = 0; ph < N_PHASES; ++ph) { hp.ph_lo = ph; hp.ph_hi = ph + 1; hipLaunchKernelGGL(fwd_megakernel, dim3(grid_blocks), dim3(512), LDS_BYTES, stream, hp); }
#endif
}
```

```cpp
#include <hip/hip_runtime.h>
#include <hip/hip_cooperative_groups.h>
#include <cstdio>
namespace cg = cooperative_groups;

#define LAS __attribute__((address_space(3)))
typedef unsigned short bf16_t;
typedef short bf16x8 __attribute__((ext_vector_type(8)));
typedef short s16x4 __attribute__((ext_vector_type(4)));
typedef float f32x4 __attribute__((ext_vector_type(4)));
typedef float f32x16 __attribute__((ext_vector_type(16)));
typedef unsigned u32x4 __attribute__((ext_vector_type(4)));
typedef unsigned u32x2 __attribute__((ext_vector_type(2)));

#ifndef PROBE_Q
#define PROBE_Q (-1)
#endif
#ifndef N_LAUNCH_MODE
#define N_LAUNCH_MODE 1
#endif

constexpr int RL = 32768, RA = 33792, FH = 2816;
constexpr int PJW = 2304;
constexpr int C_NQ = 256, C_NK = 512, C_NV = 768, C_DQ = 1024, C_DK = 1280, C_DV = 1536, C_MQ = 1792, C_MKV = 2048, C_MKR = 2176;
constexpr float LOG2E = 1.4426950408889634f;
constexpr float NEPS = 1e-6f;
constexpr int XCD_BAR_WORDS_C = 3456;

constexpr size_t SZ_W1 = 2ull * 5632 * 1024 * 2, SZ_W2 = 2ull * 1024 * 2816 * 2, SZ_WM = 6400ull * 1024 * 2, SZ_WL = 1024ull * 384 * 2, SZ_WB = 4ull * 1024 * 256 * 2, SZ_WO = 1024ull * 1024 * 2;
constexpr size_t OFF_W1 = 0, OFF_W2 = OFF_W1 + SZ_W1, OFF_WM = OFF_W2 + SZ_W2, OFF_WL = OFF_WM + SZ_WM, OFF_WB = OFF_WL + SZ_WL, OFF_WO = OFF_WB + SZ_WB;
constexpr size_t OFF_HC = OFF_WO + SZ_WO;
constexpr size_t OFF_MOD = OFF_HC + 1024ull * 1024 * 4;
constexpr size_t OFF_ROPE = OFF_MOD + 2ull * 5 * 9216 * 4;
constexpr size_t OFF_RSTD = OFF_ROPE + 128 * 8 * 8;
constexpr size_t OFF_A = OFF_RSTD + (size_t)RA * 2 * 4;
constexpr size_t OFF_B = OFF_A + (size_t)RA * 1024 * 2;
constexpr size_t OFF_C = OFF_B + (size_t)RA * PJW * 2;
constexpr size_t OFF_D = OFF_C + (size_t)RA * 4096;
constexpr size_t OFF_MK = OFF_D + (size_t)RA * 384 * 2, OFF_MV = OFF_MK + (size_t)RA * 384 * 2;
constexpr size_t OFF_BAR = OFF_D + (size_t)RA * 1024 * 2;
constexpr size_t OFF_PB = OFF_BAR + 16384;
constexpr size_t WS_END = OFF_PB + 11ull * 1024 * 1024 * 4;

struct Params {
    const float *x, *c, *ctx, *c_ctx, *ada_w, *ada_b, *norm_g, *ffn_w_in, *ffn_w_out, *mix_w_in, *pool_w, *pool_scale, *na_rpb, *diff_lambda, *diff_subln_g,
        *mla_q_norm_g, *mla_kv_norm_g, *mla_w_qb, *mla_w_kvb, *branch_w_out, *mix_w_out, *final_norm_g;
    float* out; unsigned char* ws;
    int ph_lo, ph_hi;
};

typedef const __attribute__((address_space(4))) Params* PK;

typedef float f32x2_ __attribute__((ext_vector_type(2)));
typedef __bf16 bf16x2_ __attribute__((ext_vector_type(2)));
__device__ __forceinline__ unsigned cvt_pk_bf16(float lo, float hi) { const f32x2_ v = {lo, hi}; return __builtin_bit_cast(unsigned, __builtin_convertvector(v, bf16x2_)); }
__device__ __forceinline__ float bf_lo(unsigned u) { return __uint_as_float(u << 16); }
__device__ __forceinline__ float bf_hi(unsigned u) { return __uint_as_float(u & 0xffff0000u); }
__device__ __forceinline__ float fast_exp2(float x) { return __builtin_amdgcn_exp2f(x); }
__device__ __forceinline__ float fast_rcp(float x) { return __builtin_amdgcn_rcpf(x); }
__device__ __forceinline__ float sigmoidf_(float x) { return fast_rcp(1.0f + fast_exp2(-x * LOG2E)); }
__device__ __forceinline__ float shflx(float v, int m) {
    int lane = __builtin_amdgcn_mbcnt_hi(~0u, __builtin_amdgcn_mbcnt_lo(~0u, 0)); asm volatile("" : "+v"(lane));
    return __int_as_float(__builtin_amdgcn_ds_bpermute((lane ^ m) << 2, __float_as_int(v)));
}
__device__ __forceinline__ float wave_sum(float v) {
    v += shflx(v, 32); v += shflx(v, 16); v += shflx(v, 8); v += shflx(v, 4); v += shflx(v, 2); v += shflx(v, 1); return v;
}
__device__ __forceinline__ int opaque_tid() { int t = threadIdx.x; asm volatile("" : "+v"(t)); return t; }
__device__ __forceinline__ int opaque_bid() { int t = blockIdx.x; asm volatile("" : "+s"(t)); return t; }
__device__ __forceinline__ int opaque_gdim() { int t = gridDim.x; asm volatile("" : "+s"(t)); return t; }
__device__ __forceinline__ int clampi(int v, int lo, int hi) { return v < lo ? lo : (v > hi ? hi : v); }

#define XB_TMO      128
#define XB_XCNT(j)  (256  + 64 * (j))
#define XB_XSUB(j)  (1280 + 64 * (j))
#define XB_XGEN(j)  (2304 + 64 * (j))
#define XB_TOP      3328
#define XB_TOPGEN   3392
#define XCD_BAR_WORDS 3456
#define XB_SPIN_CAP (1u << 20)
__device__ __forceinline__ unsigned xb_ld(unsigned* p)              { return __hip_atomic_load(p, __ATOMIC_RELAXED, __HIP_MEMORY_SCOPE_AGENT); }
__device__ __forceinline__ unsigned xb_add(unsigned* p, unsigned v) { return __hip_atomic_fetch_add(p, v, __ATOMIC_RELAXED, __HIP_MEMORY_SCOPE_AGENT); }
__device__ __forceinline__ unsigned xb_xcc_id() { return (unsigned)__builtin_amdgcn_s_getreg((3 << 11) | 20) & 0xFu; }
#define XB_SPIN(cond, bar) do { unsigned _sp = 0; while (cond) { __builtin_amdgcn_s_sleep(1); \
    if ((++_sp & 255u) == 0u) { if (xb_ld(&(bar)[XB_TMO])) break; if (_sp > XB_SPIN_CAP) { atomicAdd(&(bar)[XB_TMO], 1u); break; } } } } while (0)
__device__ __forceinline__ void xcd_barrier_post(unsigned* bar) { if (opaque_tid() == 0) (void)xb_add(&bar[XB_XCNT(xb_xcc_id())], 1u); }
__device__ __forceinline__ void xcd_barrier_complete(unsigned* bar, unsigned x, unsigned& nloc, unsigned& nx) {
    const unsigned G = gridDim.x;
    unsigned sum, cnt, mine, sp = 0u;
    for (;;) {
        sum = 0u; cnt = 0u; mine = 0u;
#pragma unroll
        for (unsigned j = 0; j < 16; ++j) { const unsigned c = xb_ld(&bar[XB_XCNT(j)]); sum += c; cnt += (c > 0u) ? 1u : 0u; mine = (j == x) ? c : mine; }
        if (sum == G) break;
        __builtin_amdgcn_s_sleep(1);
        if ((++sp & 255u) == 0u) { if (xb_ld(&bar[XB_TMO])) break; if (sp > XB_SPIN_CAP) { atomicAdd(&bar[XB_TMO], 1u); break; } }
    }
    nloc = mine > 0u ? mine : 1u; nx = cnt > 0u ? cnt : 1u;
}
__device__ __forceinline__ void xcd_barrier(unsigned* bar, volatile LAS unsigned* st) {
    asm volatile("s_waitcnt vmcnt(0)" ::: "memory");
    __syncthreads();
    if (opaque_tid() == 0) {
        const unsigned x = xb_xcc_id();
        __builtin_amdgcn_s_waitcnt(0);
        unsigned nloc = st[0], nx = st[1];
        if (nloc == 0u) { xcd_barrier_complete(bar, x, nloc, nx); st[0] = nloc; st[1] = nx; }
        const unsigned old = xb_add(&bar[XB_XSUB(x)], 1u);
        const unsigned gen = old / nloc;
        if (old + 1u == (gen + 1u) * nloc) {
            __builtin_amdgcn_fence(__ATOMIC_RELEASE, "agent");
            asm volatile("s_waitcnt vmcnt(0)" ::: "memory");
            const unsigned og = xb_add(&bar[XB_TOP], 1u);
            const unsigned tg = og / nx;
            if (og + 1u == (tg + 1u) * nx) xb_add(&bar[XB_TOPGEN], 1u);
            else XB_SPIN(xb_ld(&bar[XB_TOPGEN]) == tg, bar);
            __builtin_amdgcn_fence(__ATOMIC_ACQUIRE, "agent");
            xb_add(&bar[XB_XGEN(x)], 1u);
            asm volatile("s_waitcnt vmcnt(0)" ::: "memory");
        } else {
            XB_SPIN(xb_ld(&bar[XB_XGEN(x)]) == gen, bar);
            __builtin_amdgcn_fence(__ATOMIC_ACQUIRE, "agent");
            asm volatile("s_waitcnt vmcnt(0)" ::: "memory");
        }
    }
    __syncthreads();
}

namespace pg8 {
constexpr int BM = 256, BK = 64, HALF = 128, HTB = HALF * BK * 2, STAGE_BYTES = 8 * HTB, NXCD = 8, WGM = 8;
__device__ __forceinline__ int lds_byte(int r, int c) { const int st = (r >> 4) * 2 + (c >> 5), rr = r & 15, cc = c & 31, ob = rr * 64 + cc * 2; return st * 1024 + (ob ^ (((ob >> 9) & 1) << 5)); }
__device__ __forceinline__ void stage_rc(int b, int& R, int& C) { const int st = b / 1024, sb = b % 1024, swz = sb ^ (((sb >> 9) & 1) << 5); R = (st >> 1) * 16 + swz / 64; C = (st & 1) * 32 + (swz % 64) / 2; }
__device__ __forceinline__ int perm32(int rho) { const int n = rho >> 4, i = rho & 15; return 8 * (i >> 2) + 4 * n + (i & 3); }
struct Unit { int pm, pn; };
struct Gemm { const bf16_t* A; const bf16_t* Bt; int M, N, K, lda, ldb; };
struct StaticOrder {
    int nM, nN, nwg, G, c;
    __device__ void init(int M, int N, int G_, int c_) { nM = M / BM; nN = N / BM; nwg = nM * nN; G = G_; c = c_; }
    __device__ bool next(int i, Unit& u) const {
        const long L = (long)i * G + c; if (L >= nwg) return false;
        int wgid = (int)L; { const int q = nwg / NXCD, r = nwg % NXCD, xcd = wgid % NXCD, off = wgid / NXCD; wgid = (xcd < r ? xcd * (q + 1) : r * (q + 1) + (xcd - r) * q) + off; }
        const int nig = WGM * nN, gid = wgid / nig, fm = gid * WGM, gsz = (nM - fm) < WGM ? (nM - fm) : WGM;
        u.pm = fm + ((wgid % nig) % gsz); u.pn = (wgid % nig) / gsz; return true;
    }
};

struct SingleUnit {
    int pm, pn; bool has;
    __device__ bool next(int i, Unit& u) const { if (i > 0 || !has) return false; u.pm = pm; u.pn = pn; return true; }
};
template <class Epi, class Sched>
__device__ __forceinline__ void gemm_phase(LAS unsigned char* lds, const Gemm g, const Sched& S, const Epi& E) {
    const int tid = opaque_tid(), wid = __builtin_amdgcn_readfirstlane(tid >> 6), lane = tid & 63, wr = wid >> 2, wc = wid & 3, fr = lane & 15, fq = lane >> 4;
    const int K = g.K, nt = K / BK;
    unsigned voffA[2], voffB[2];
#pragma unroll
    for (int i = 0; i < 2; ++i) { int R, C; stage_rc(tid * 16 + i * 8192, R, C); const int Rb = Epi::PERM ? ((R & ~31) + perm32(R & 31)) : R;
        voffA[i] = (unsigned)(R * g.lda + C) * 2u; voffB[i] = (unsigned)(Rb * g.ldb + C) * 2u; }
    const size_t kstep = (size_t)(BK * 2);
    const size_t hstepA = (size_t)HALF * g.lda * 2, hstepB = (size_t)HALF * g.ldb * 2;
    const size_t tstepA = 2 * hstepA, tstepB = 2 * hstepB;
    const unsigned ldsw = (unsigned)wid * 1024u;
    const int aoff = lds_byte(wr * 64 + fr, fq * 8), boff = lds_byte(wc * 32 + fr, fq * 8);
#define PG8_SA(b, h) (((b) * 2 + (h)) * HTB)
#define PG8_SB(b, h) ((4 + (b) * 2 + (h)) * HTB)
#define PG8_STAGE(bufoff, gbase, voff) do { _Pragma("unroll") for (int _i = 0; _i < 2; ++_i) \
        __builtin_amdgcn_global_load_lds((const unsigned*)((const char*)(gbase) + (voff)[_i]), (LAS unsigned*)(lds + (bufoff) + ldsw + _i * 8192), 16, 0, 0); } while (0)
#define PG8_LDA(dst, b, h) do { _Pragma("unroll") for (int m = 0; m < 4; ++m) _Pragma("unroll") for (int k = 0; k < 2; ++k) dst[m][k] = *(const LAS bf16x8*)(lds + PG8_SA(b, h) + aoff + m * 2048 + k * 1024); } while (0)
#define PG8_LDB(dst, b, h) do { _Pragma("unroll") for (int n = 0; n < 2; ++n) _Pragma("unroll") for (int k = 0; k < 2; ++k) dst[n][k] = *(const LAS bf16x8*)(lds + PG8_SB(b, h) + boff + n * 2048 + k * 1024); } while (0)
#define PG8_MMA(ai, bj, At, Bt) do { __builtin_amdgcn_s_setprio(1); _Pragma("unroll") for (int m = 0; m < 4; ++m) _Pragma("unroll") for (int n = 0; n < 2; ++n) _Pragma("unroll") for (int k = 0; k < 2; ++k) \
        acc[ai][bj][m][n] = __builtin_amdgcn_mfma_f32_16x16x32_bf16(Bt[n][k], At[m][k], acc[ai][bj][m][n], 0, 0, 0); __builtin_amdgcn_s_setprio(0); } while (0)
#define PG8_WAIT_V(n) asm volatile("s_waitcnt vmcnt(" #n ")" ::: "memory")
#define PG8_WAIT_L(n) asm volatile("s_waitcnt lgkmcnt(" #n ")" ::: "memory")
#define PG8_BAR __builtin_amdgcn_s_barrier()
#define PG8_SCHED __builtin_amdgcn_sched_barrier(0)
    Unit cur, nxt; int ui = 0;
    if (!S.next(0, cur)) return;
    f32x4 acc[2][2][4][2];
#pragma unroll
    for (int a = 0; a < 2; ++a)
#pragma unroll
        for (int b = 0; b < 2; ++b)
#pragma unroll
            for (int m = 0; m < 4; ++m)
#pragma unroll
                for (int n = 0; n < 2; ++n) acc[a][b][m][n] = (f32x4){0.f, 0.f, 0.f, 0.f};
    bf16x8 At[4][2], B0[2][2], B1[2][2];
    const char* cA = (const char*)g.A + (size_t)cur.pm * tstepA; const char* cB = (const char*)g.Bt + (size_t)cur.pn * tstepB;
    PG8_STAGE(PG8_SB(0, 0), cB, voffB); PG8_STAGE(PG8_SA(0, 0), cA, voffA); PG8_STAGE(PG8_SB(0, 1), cB + hstepB, voffB); PG8_STAGE(PG8_SA(0, 1), cA + hstepA, voffA);
    if (wr == 1) PG8_BAR;
    PG8_WAIT_V(4); PG8_BAR;
    PG8_STAGE(PG8_SB(1, 0), cB + kstep, voffB); PG8_STAGE(PG8_SA(1, 0), cA + kstep, voffA); PG8_STAGE(PG8_SB(1, 1), cB + hstepB + kstep, voffB);
    PG8_WAIT_V(6); PG8_BAR;
    for (;;) {
        const bool has_next = S.next(ui + 1, nxt);
        const char* nA = has_next ? (const char*)g.A + (size_t)nxt.pm * tstepA : cA; const char* nB = has_next ? (const char*)g.Bt + (size_t)nxt.pn * tstepB : cB;
        for (int t = 0; t < nt; t += 2) {
            const bool last = (t == nt - 2);
            const char* a1 = cA + (size_t)(t + 1) * kstep;
            const char* a2 = last ? nA : cA + (size_t)(t + 2) * kstep; const char* b2 = last ? nB : cB + (size_t)(t + 2) * kstep;
            const char* a3 = a2 + kstep; const char* b3 = b2 + kstep;
            PG8_LDB(B0, 0, 0); PG8_SCHED; PG8_LDA(At, 0, 0); PG8_STAGE(PG8_SA(1, 1), a1 + hstepA, voffA);
            PG8_WAIT_L(8); PG8_BAR; PG8_WAIT_L(0); PG8_MMA(0, 0, At, B0); PG8_BAR; PG8_SCHED;
            PG8_LDB(B1, 0, 1); PG8_STAGE(PG8_SB(0, 0), b2, voffB);
            PG8_BAR; PG8_WAIT_L(0); PG8_MMA(0, 1, At, B1); PG8_BAR;
            PG8_LDA(At, 0, 1); PG8_STAGE(PG8_SA(0, 0), a2, voffA);
            PG8_BAR; PG8_WAIT_L(0); PG8_MMA(1, 0, At, B0); PG8_BAR; PG8_SCHED;
            PG8_STAGE(PG8_SB(0, 1), b2 + hstepB, voffB);
            PG8_WAIT_V(6); PG8_BAR; PG8_MMA(1, 1, At, B1); PG8_BAR;
            PG8_LDB(B0, 1, 0); PG8_SCHED; PG8_LDA(At, 1, 0); PG8_STAGE(PG8_SA(0, 1), a2 + hstepA, voffA);
            PG8_WAIT_L(8); PG8_BAR; PG8_WAIT_L(0); PG8_MMA(0, 0, At, B0); PG8_BAR; PG8_SCHED;
            PG8_LDB(B1, 1, 1); PG8_STAGE(PG8_SB(1, 0), b3, voffB);
            PG8_BAR; PG8_WAIT_L(0); PG8_MMA(0, 1, At, B1); PG8_BAR;
            PG8_LDA(At, 1, 1); PG8_STAGE(PG8_SA(1, 0), a3, voffA);
            PG8_BAR; PG8_WAIT_L(0); PG8_MMA(1, 0, At, B0); PG8_BAR; PG8_SCHED;
            PG8_STAGE(PG8_SB(1, 1), b3 + hstepB, voffB);
            PG8_WAIT_V(6); PG8_BAR; PG8_MMA(1, 1, At, B1); PG8_BAR;
            if constexpr (Epi::HOOK) { if ((((t + 2) & 3) == 0) && !last) E.hook(acc, cur, (t + 2) >> 2, wr, wc, fr, fq); }
        }
        E(acc, cur, wr, wc, fr, fq);
        if (!has_next) break;
#pragma unroll
        for (int a = 0; a < 2; ++a)
#pragma unroll
            for (int b = 0; b < 2; ++b)
#pragma unroll
                for (int m = 0; m < 4; ++m)
#pragma unroll
                    for (int n = 0; n < 2; ++n) acc[a][b][m][n] = (f32x4){0.f, 0.f, 0.f, 0.f};
        cur = nxt; cA = nA; cB = nB; ++ui;
    }
    PG8_WAIT_V(0);
    if (wr == 0) PG8_BAR;
    PG8_BAR;
#undef PG8_SA
#undef PG8_SB
#undef PG8_STAGE
#undef PG8_LDA
#undef PG8_LDB
#undef PG8_MMA
#undef PG8_WAIT_V
#undef PG8_WAIT_L
#undef PG8_BAR
#undef PG8_SCHED
}
}
using pg8::Unit;

__device__ __forceinline__ size_t g8_off(int row, int colg) { return ((size_t)(row >> 4) * 128 + (colg >> 5)) * 512 + (row & 15) * 32 + (colg & 31); }

struct EpiSwiglu {
    static constexpr bool HOOK = false;
    static constexpr bool PERM = true;
    bf16_t* HID;
    __device__ __forceinline__ void operator()(const f32x4 (&acc)[2][2][4][2], const Unit& u, int wr, int wc, int fr, int fq) const {
        { const int t_ = opaque_tid(); wr = t_ >> 8; wc = (t_ >> 6) & 3; fr = t_ & 15; fq = (t_ >> 4) & 3; }
        const int row0 = u.pm * 256 + wr * 64 + fr, col0 = u.pn * 128 + wc * 32 + 8 * fq;
#pragma unroll
        for (int ai = 0; ai < 2; ++ai)
#pragma unroll
            for (int m = 0; m < 4; ++m) {
                const int row = row0 + ai * 128 + m * 16;
                float hv[8];
#pragma unroll
                for (int n = 0; n < 2; ++n)
#pragma unroll
                    for (int j = 0; j < 4; ++j) { const float a = acc[ai][0][m][n][j], b = acc[ai][1][m][n][j]; hv[4 * n + j] = a * sigmoidf_(a) * b; }
                u32x4 w; w.x = cvt_pk_bf16(hv[0], hv[1]); w.y = cvt_pk_bf16(hv[2], hv[3]); w.z = cvt_pk_bf16(hv[4], hv[5]); w.w = cvt_pk_bf16(hv[6], hv[7]);
                *(u32x4*)(HID + (size_t)row * FH + col0) = w;
            }
    }
};
struct EpiResid {
    static constexpr bool HOOK = false;
    static constexpr bool PERM = false;
    float* Hl; float* Hc; const float* gate; float coef;
    __device__ __forceinline__ void operator()(const f32x4 (&acc)[2][2][4][2], const Unit& u, int wr, int wc, int fr, int fq) const {
        { const int t_ = opaque_tid(); wr = t_ >> 8; wc = (t_ >> 6) & 3; fr = t_ & 15; fq = (t_ >> 4) & 3; }
        const int row0 = u.pm * 256 + wr * 64 + fr, col0 = u.pn * 256 + wc * 32 + 4 * fq;
#pragma unroll
        for (int ai = 0; ai < 2; ++ai)
#pragma unroll
            for (int m = 0; m < 4; ++m) {
                const int row = row0 + ai * 128 + m * 16;
                float* hp = row < RL ? Hl + (size_t)row * 1024 : Hc + (size_t)(row - RL) * 1024;
                const float* gp = gate + (row < RL ? (row >> 13) : 4) * 9216;
#pragma unroll
                for (int bj = 0; bj < 2; ++bj)
#pragma unroll
                    for (int n = 0; n < 2; ++n) {
                        const int c = col0 + bj * 128 + n * 16;
                        const f32x4 g4 = *(const f32x4*)(gp + c); f32x4 h4 = *(const f32x4*)(hp + c);
                        h4 += (g4 * coef) * acc[ai][bj][m][n];
                        *(f32x4*)(hp + c) = h4;
                    }
            }
    }
};
struct EpiPartial {
    static constexpr bool HOOK = false;
    static constexpr bool PERM = false;
    float* PB; const float* gate; float coef;
    __device__ __forceinline__ void operator()(const f32x4 (&acc)[2][2][4][2], const Unit& u, int wr, int wc, int fr, int fq) const {
        { const int t_ = opaque_tid(); wr = t_ >> 8; wc = (t_ >> 6) & 3; fr = t_ & 15; fq = (t_ >> 4) & 3; }
        const int row0 = u.pm * 256 + wr * 64 + fr - RL, col0 = u.pn * 256 + wc * 32 + 4 * fq;
#pragma unroll
        for (int ai = 0; ai < 2; ++ai)
#pragma unroll
            for (int m = 0; m < 4; ++m) {
                float* hp = PB + (size_t)(row0 + ai * 128 + m * 16) * 1024;
#pragma unroll
                for (int bj = 0; bj < 2; ++bj)
#pragma unroll
                    for (int n = 0; n < 2; ++n) {
                        const int c = col0 + bj * 128 + n * 16;
                        const f32x4 g4 = *(const f32x4*)(gate + c);
                        *(f32x4*)(hp + c) = (g4 * coef) * acc[ai][bj][m][n];
                    }
            }
    }
};
struct EpiPJ {
    static constexpr bool HOOK = false;
    static constexpr bool PERM = true;
    bf16_t* PJ; unsigned char* G8;
    __device__ __forceinline__ void operator()(const f32x4 (&acc)[2][2][4][2], const Unit& u, int wr, int wc, int fr, int fq) const {
        { const int t_ = opaque_tid(); wr = t_ >> 8; wc = (t_ >> 6) & 3; fr = t_ & 15; fq = (t_ >> 4) & 3; }
        const int row0 = u.pm * 256 + wr * 64 + fr, c0 = wc * 32 + 8 * fq;
        if (u.pn < 9) {
#pragma unroll
            for (int ai = 0; ai < 2; ++ai)
#pragma unroll
                for (int m = 0; m < 4; ++m) {
                    const int row = row0 + ai * 128 + m * 16;
#pragma unroll
                    for (int bj = 0; bj < 2; ++bj) {
                        const f32x4 v0 = acc[ai][bj][m][0], v1 = acc[ai][bj][m][1];
                        u32x4 w; w.x = cvt_pk_bf16(v0[0], v0[1]); w.y = cvt_pk_bf16(v0[2], v0[3]); w.z = cvt_pk_bf16(v1[0], v1[1]); w.w = cvt_pk_bf16(v1[2], v1[3]);
                        *(u32x4*)(PJ + (size_t)row * PJW + u.pn * 256 + bj * 128 + c0) = w;
                    }
                }
        } else {
#pragma unroll
            for (int ai = 0; ai < 2; ++ai)
#pragma unroll
                for (int m = 0; m < 4; ++m) {
                    const int row = row0 + ai * 128 + m * 16;
#pragma unroll
                    for (int bj = 0; bj < 2; ++bj) {
                        unsigned q[8];
#pragma unroll
                        for (int n = 0; n < 2; ++n)
#pragma unroll
                            for (int j = 0; j < 4; ++j) { int v = (int)(sigmoidf_(acc[ai][bj][m][n][j]) * 256.0f); q[4 * n + j] = (unsigned)(v > 255 ? 255 : v); }
                        u32x2 w; w.x = q[0] | (q[1] << 8) | (q[2] << 16) | (q[3] << 24); w.y = q[4] | (q[5] << 8) | (q[6] << 16) | (q[7] << 24);
                        *(u32x2*)(G8 + g8_off(row, (u.pn - 9) * 256 + bj * 128 + c0)) = w;
                    }
                }
        }
    }
};
struct EpiMLA {
    static constexpr bool HOOK = false;
    static constexpr bool PERM = true;
    bf16_t *MQ, *MK, *MV; const float* RSTD; const float2* RT;
    __device__ __forceinline__ void operator()(const f32x4 (&acc)[2][2][4][2], const Unit& u, int wr, int wc, int fr, int fq) const {
        { const int t_ = opaque_tid(); wr = t_ >> 8; wc = (t_ >> 6) & 3; fr = t_ & 15; fq = (t_ >> 4) & 3; }
        const int row0 = u.pm * 256 + wr * 64 + fr;
#pragma unroll
        for (int bj = 0; bj < 2; ++bj) {
            const int cg0 = u.pn * 256 + bj * 128 + wc * 32;
            if (cg0 >= 896) continue;
#pragma unroll
            for (int ai = 0; ai < 2; ++ai)
#pragma unroll
                for (int m = 0; m < 4; ++m) {
                    __builtin_amdgcn_sched_barrier(0);
                    const int row = row0 + ai * 128 + m * 16;
                    float v[8];
                    if (cg0 < 384) {
                        const float rs = RSTD[row * 2];
#pragma unroll
                        for (int n = 0; n < 2; ++n)
#pragma unroll
                            for (int j = 0; j < 4; ++j) v[4 * n + j] = acc[ai][bj][m][n][j] * rs;
                        const int d0 = cg0 % 96;
                        if (d0 == 64) {
                            const bool lat = row < RL; const int t = row & 8191; const int pos = (fq >> 1) ? (t & 63) : (t >> 6); const bool isx2 = fq & 1;
#pragma unroll
                            for (int e = 0; e < 8; ++e) {
                                const float pr = shflx(v[e], 16);
                                const float2 cs = RT[pos * 8 + e];
                                const float r = isx2 ? (pr * cs.y + v[e] * cs.x) : (v[e] * cs.x - pr * cs.y);
                                v[e] = lat ? r : v[e];
                            }
                        }
                        u32x4 w; w.x = cvt_pk_bf16(v[0], v[1]); w.y = cvt_pk_bf16(v[2], v[3]); w.z = cvt_pk_bf16(v[4], v[5]); w.w = cvt_pk_bf16(v[6], v[7]);
                        *(u32x4*)(MQ + (size_t)row * 384 + cg0 + 8 * fq) = w;
                    } else {
                        const float rs = RSTD[row * 2 + 1];
#pragma unroll
                        for (int n = 0; n < 2; ++n)
#pragma unroll
                            for (int j = 0; j < 4; ++j) v[4 * n + j] = acc[ai][bj][m][n][j] * rs;
                        const int cp = cg0 - 384, hd = cp >> 7, d0 = cp & 127;
                        u32x4 w; w.x = cvt_pk_bf16(v[0], v[1]); w.y = cvt_pk_bf16(v[2], v[3]); w.z = cvt_pk_bf16(v[4], v[5]); w.w = cvt_pk_bf16(v[6], v[7]);
                        if (d0 < 64) *(u32x4*)(MK + (size_t)row * 384 + hd * 96 + d0 + 8 * fq) = w;
                        else *(u32x4*)(MV + (size_t)row * 256 + hd * 64 + (d0 - 64) + 8 * fq) = w;
                    }
                }
        }
    }
};
struct EpiMerge {
    static constexpr bool PERM = true, HOOK = true;
    const unsigned char* G8; bf16_t* MG;
    __device__ __forceinline__ void hook(f32x4 (&acc)[2][2][4][2], const Unit& u, int nb, int wr, int wc, int fr, int fq) const {
        { const int t_ = opaque_tid(); wr = t_ >> 8; wc = (t_ >> 6) & 3; fr = t_ & 15; fq = (t_ >> 4) & 3; }
        const int row0 = u.pm * 256 + wr * 64 + fr, c0 = u.pn * 256 + wc * 32 + 8 * fq;
#pragma unroll
        for (int ai = 0; ai < 2; ++ai) {
            u32x2 ga[4][2], gb[4][2];
#pragma unroll
            for (int m = 0; m < 4; ++m)
#pragma unroll
                for (int bj = 0; bj < 2; ++bj) { const int row = row0 + ai * 128 + m * 16, c = c0 + bj * 128;
                    ga[m][bj] = *(const u32x2*)(G8 + g8_off(row, (nb - 1) * 1024 + c)); gb[m][bj] = *(const u32x2*)(G8 + g8_off(row, nb * 1024 + c)); }
#pragma unroll
            for (int m = 0; m < 4; ++m)
#pragma unroll
                for (int bj = 0; bj < 2; ++bj)
#pragma unroll
                    for (int e = 0; e < 8; ++e) { const unsigned qa = ((e < 4 ? ga[m][bj].x : ga[m][bj].y) >> (8 * (e & 3))) & 255u, qb = ((e < 4 ? gb[m][bj].x : gb[m][bj].y) >> (8 * (e & 3))) & 255u;
                        acc[ai][bj][m][e >> 2][e & 3] *= ((float)qa + 0.5f) * fast_rcp((float)qb + 0.5f); }
            __builtin_amdgcn_sched_barrier(0);
        }
    }
    __device__ __forceinline__ void operator()(const f32x4 (&acc)[2][2][4][2], const Unit& u, int wr, int wc, int fr, int fq) const {
        { const int t_ = opaque_tid(); wr = t_ >> 8; wc = (t_ >> 6) & 3; fr = t_ & 15; fq = (t_ >> 4) & 3; }
        const int row0 = u.pm * 256 + wr * 64 + fr, c0 = u.pn * 256 + wc * 32 + 8 * fq;
#pragma unroll
        for (int ai = 0; ai < 2; ++ai) {
            u32x2 gq[4][2];
#pragma unroll
            for (int m = 0; m < 4; ++m)
#pragma unroll
                for (int bj = 0; bj < 2; ++bj) gq[m][bj] = *(const u32x2*)(G8 + g8_off(row0 + ai * 128 + m * 16, 3 * 1024 + c0 + bj * 128));
#pragma unroll
            for (int m = 0; m < 4; ++m)
#pragma unroll
                for (int bj = 0; bj < 2; ++bj) {
                    const int row = row0 + ai * 128 + m * 16, c = c0 + bj * 128;
                    float v[8];
#pragma unroll
                    for (int e = 0; e < 8; ++e) { const unsigned q = ((e < 4 ? gq[m][bj].x : gq[m][bj].y) >> (8 * (e & 3))) & 255u; v[e] = ((float)q + 0.5f) * (1.0f / 256.0f) * acc[ai][bj][m][e >> 2][e & 3]; }
                    u32x4 w; w.x = cvt_pk_bf16(v[0], v[1]); w.y = cvt_pk_bf16(v[2], v[3]); w.z = cvt_pk_bf16(v[4], v[5]); w.w = cvt_pk_bf16(v[6], v[7]);
                    *(u32x4*)(MG + (size_t)row * 1024 + c) = w;
                }
            __builtin_amdgcn_sched_barrier(0);
        }
    }
};

template <class F>
__device__ __forceinline__ void wt_rows64(bf16_t* dst, int K, F srcval, int ldd, int kbeg, int kend) {
    if (ldd == 0) ldd = K;
    if (kend > K) kend = K;
    const int tid_ = opaque_tid(); const int nl = tid_ & 63, kq = tid_ >> 6;
    for (int k0 = kbeg + kq * 8; k0 < kend; k0 += 64) {
        float v[8];
#pragma unroll
        for (int j = 0; j < 8; ++j) v[j] = srcval(nl, k0 + j);
        u32x4 w; w.x = cvt_pk_bf16(v[0], v[1]); w.y = cvt_pk_bf16(v[2], v[3]); w.z = cvt_pk_bf16(v[4], v[5]); w.w = cvt_pk_bf16(v[6], v[7]);
        *(u32x4*)(dst + (size_t)nl * ldd + k0) = w;
    }
}

__device__ void layer_prep_phase(PK p, int l, LAS unsigned char* lds) {
    unsigned char* ws = p->ws;
    const int nW = 1648, nItems = nW + (l == 0 ? 288 + 1 : 0);
    for (int it2 = opaque_bid(); it2 < nItems; it2 += opaque_gdim()) {
        int it, kbeg = 0, kend = 1 << 30;
        if (it2 < 704) { it = it2 >> 2; kbeg = (it2 & 3) * 256; kend = kbeg + 256; }
        else if (it2 < 1056) { const int q = it2 - 704; it = 176 + q / 11; kbeg = (q % 11) * 256; kend = kbeg + 256; }
        else if (it2 < 1456) { const int q = it2 - 1056; it = 208 + (q >> 2); kbeg = (q & 3) * 256; kend = kbeg + 256; }
        else if (it2 < 1520) { const int q = it2 - 1456; it = 308 + (q >> 2); kbeg = (q & 3) * 256; kend = kbeg + 256; }
        else if (it2 < 1568) { it = 324 + (it2 - 1520); }
        else if (it2 < 1632) { const int q = it2 - 1568; it = 372 + (q >> 2); kbeg = (q & 3) * 64; kend = kbeg + 64; }
        else if (it2 < 1648) { it = 388 + (it2 - 1632); }
        else it = 404 + (it2 - 1648);
        if (it < 176) {
            const int f = it / 88, j = it % 88; const float* src = p->ffn_w_in + ((size_t)(l * 2 + f) * 1024) * 5632;
            bf16_t* dst = (bf16_t*)(ws + OFF_W1) + ((size_t)f * 5632 + j * 64) * 1024;
            wt_rows64(dst, 1024, [&](int nl, int k) { const int np = j * 64 + nl, pn = np >> 8, wi = np & 255; const int col = wi < 128 ? pn * 128 + wi : FH + pn * 128 + (wi - 128); return src[(size_t)k * 5632 + col]; }, 0, kbeg, kend);
        } else if (it < 208) {
            const int q = it - 176, f = q / 16, j = q % 16; const float* src = p->ffn_w_out + ((size_t)(l * 2 + f) * FH) * 1024;
            bf16_t* dst = (bf16_t*)(ws + OFF_W2) + ((size_t)f * 1024 + j * 64) * FH;
            wt_rows64(dst, FH, [&](int nl, int k) { return src[(size_t)k * 1024 + j * 64 + nl]; }, 0, kbeg, kend);
        } else if (it < 308) {
            const int j = it - 208; const float* src = p->mix_w_in + (size_t)l * 1024 * 6304;
            bf16_t* dst = (bf16_t*)(ws + OFF_WM) + (size_t)j * 64 * 1024;
            wt_rows64(dst, 1024, [&](int nl, int k) { const int np = j * 64 + nl; const int col = np < 2208 ? np : (np < 2304 ? -1 : np - 96); return col < 0 ? 0.f : src[(size_t)k * 6304 + col]; }, 0, kbeg, kend);
        } else if (it < 324) {
            const int j = it - 308; const float* src = p->mix_w_out + (size_t)l * 1024 * 1024;
            bf16_t* dst = (bf16_t*)(ws + OFF_WO) + (size_t)j * 64 * 1024;
            wt_rows64(dst, 1024, [&](int nl, int k) { return src[(size_t)k * 1024 + j * 64 + nl]; }, 0, kbeg, kend);
        } else if (it < 372) {
            const int q = it - 324, bi = 1 + q / 16, j = q % 16; const float* src = p->branch_w_out + ((size_t)(l * 4 + bi) * 256) * 1024;
            bf16_t* dst = (bf16_t*)(ws + OFF_WB) + (size_t)j * 64 * 1024 + bi * 256;
            wt_rows64(dst, 256, [&](int nl, int k) { return src[(size_t)k * 1024 + j * 64 + nl]; }, 1024, kbeg, kend);
        } else if (it < 388) {
            const int j = it - 372; const float* wb = p->branch_w_out + ((size_t)(l * 4) * 256) * 1024; const float* pw = p->pool_w + (size_t)l * 4 * 64 * 64; const float* ps = p->pool_scale + l * 256;
            bf16_t* dst = (bf16_t*)(ws + OFF_WB) + (size_t)j * 64 * 1024;
            wt_rows64(dst, 256, [&](int nl, int k) { const int gI = k >> 6, n = j * 64 + nl; const float* pr = pw + (size_t)k * 64; float s = 0.f;
                for (int e = 0; e < 64; ++e) s += pr[e] * ps[gI * 64 + e] * wb[(size_t)(gI * 64 + e) * 1024 + n]; return s; }, 1024, kbeg, kend);
        } else if (it < 404) {
            const int j = it - 388; const float* wq = p->mla_w_qb + (size_t)l * 256 * 384; const float* wk = p->mla_w_kvb + (size_t)l * 128 * 512;
            const float* gq = p->mla_q_norm_g + l * 256; const float* gk = p->mla_kv_norm_g + l * 128;
            bf16_t* dst = (bf16_t*)(ws + OFF_WL) + (size_t)j * 64 * 384;
            wt_rows64(dst, 384, [&](int nl, int k) { const int n = j * 64 + nl;
                if (n < 384) return k < 256 ? gq[k] * wq[(size_t)k * 384 + n] : 0.f;
                if (n < 896) return k >= 256 ? gk[k - 256] * wk[(size_t)(k - 256) * 512 + (n - 384)] : 0.f;
                return 0.f; }, 0, kbeg, kend);
        } else if (it < 404 + 288) {
            const int q = it - 404, ll = q / 144, cb = q % 144;
            LAS float* sc = (LAS float*)lds;
            LAS float* red = (LAS float*)(lds + 5 * 1024 * 4);
            __syncthreads();
            for (int i = opaque_tid(); i < 5 * 1024; i += 512) { const int r = i >> 10, k = i & 1023; const float cv = r < 4 ? p->c[r * 1024 + k] : p->c_ctx[k]; sc[i] = cv * sigmoidf_(cv); }
            __syncthreads();
            const int jl = opaque_tid() & 63, kg = opaque_tid() >> 6; const int col = cb * 64 + jl;
            const float* wsrc = p->ada_w + (size_t)ll * 1024 * 9216 + col;
            float a0 = 0.f, a1 = 0.f, a2 = 0.f, a3 = 0.f, a4 = 0.f;
            for (int k = kg * 128; k < kg * 128 + 128; ++k) { const float wv = wsrc[(size_t)k * 9216]; a0 += sc[k] * wv; a1 += sc[1024 + k] * wv; a2 += sc[2048 + k] * wv; a3 += sc[3072 + k] * wv; a4 += sc[4096 + k] * wv; }
            red[(kg * 5 + 0) * 64 + jl] = a0; red[(kg * 5 + 1) * 64 + jl] = a1; red[(kg * 5 + 2) * 64 + jl] = a2; red[(kg * 5 + 3) * 64 + jl] = a3; red[(kg * 5 + 4) * 64 + jl] = a4;
            __syncthreads();
            if (opaque_tid() < 320) { const int r = opaque_tid() >> 6; float s = p->ada_b[ll * 9216 + col];
                for (int q2 = 0; q2 < 8; ++q2) s += red[(q2 * 5 + r) * 64 + jl];
                ((float*)(ws + OFF_MOD))[(size_t)(ll * 5 + r) * 9216 + col] = s; }
        } else {
            for (int i = opaque_tid(); i < 1024; i += 512) { const int pos = i >> 3, fi = i & 7; const float inv = exp2f(-(float)fi * 0.125f * 13.287712379549449f); const float ang = (float)pos * inv;
                ((float2*)(ws + OFF_ROPE))[i] = make_float2(cosf(ang), sinf(ang)); }
        }
    }
}

__device__ void norm_mod_phase(const float* srcL, const float* srcC, float* cpyL, float* cpyC, const float* g, const float* mod, bf16_t* TN, int nrows, const float* pb, int nsl) {
    const int tid_ = opaque_tid(); const int lane = tid_ & 63, gw = opaque_bid() * 8 + (tid_ >> 6), nw = opaque_gdim() * 8;
    for (int row = gw; row < nrows; row += nw) {
        const bool lat = row < RL;
        const float* sp = lat ? srcL + (size_t)row * 1024 : srcC + (size_t)(row - RL) * 1024;
        const float* mp = mod + (lat ? (row >> 13) : 4) * 9216;
        f32x4 v[4]; float ss = 0.f;
#pragma unroll
        for (int j = 0; j < 4; ++j) v[j] = *(const f32x4*)(sp + 256 * j + 4 * lane);
        if (!lat && nsl > 0) {
            for (int sl = 0; sl < nsl; ++sl) { const float* pp = pb + ((size_t)sl * 1024 + (row - RL)) * 1024;
#pragma unroll
                for (int j = 0; j < 4; ++j) v[j] += *(const f32x4*)(pp + 256 * j + 4 * lane); }
            float* wp = (float*)sp;
#pragma unroll
            for (int j = 0; j < 4; ++j) *(f32x4*)(wp + 256 * j + 4 * lane) = v[j];
        }
#pragma unroll
        for (int j = 0; j < 4; ++j) ss += v[j][0] * v[j][0] + v[j][1] * v[j][1] + v[j][2] * v[j][2] + v[j][3] * v[j][3];
        if (cpyL) { float* cp = lat ? cpyL + (size_t)row * 1024 : cpyC + (size_t)(row - RL) * 1024;
#pragma unroll
            for (int j = 0; j < 4; ++j) *(f32x4*)(cp + 256 * j + 4 * lane) = v[j]; }
        ss = wave_sum(ss);
        const float rstd = rsqrtf(ss * (1.0f / 1024.0f) + NEPS);
#pragma unroll
        for (int j = 0; j < 4; ++j) {
            const int col = 256 * j + 4 * lane;
            const f32x4 gg = *(const f32x4*)(g + col), sh = *(const f32x4*)(mp + col), sc = *(const f32x4*)(mp + 1024 + col);
            float o[4];
#pragma unroll
            for (int e = 0; e < 4; ++e) o[e] = (v[j][e] * rstd * gg[e]) * (1.0f + sc[e]) + sh[e];
            u32x2 w; w.x = cvt_pk_bf16(o[0], o[1]); w.y = cvt_pk_bf16(o[2], o[3]);
            *(u32x2*)(TN + (size_t)row * 1024 + col) = w;
        }
    }
}
__device__ void final_norm_phase(float* H, const float* g) {
    const int tid_ = opaque_tid(); const int lane = tid_ & 63, gw = opaque_bid() * 8 + (tid_ >> 6), nw = opaque_gdim() * 8;
    for (int row = gw; row < RL; row += nw) {
        float* sp = H + (size_t)row * 1024; f32x4 v[4]; float ss = 0.f;
#pragma unroll
        for (int j = 0; j < 4; ++j) { v[j] = *(const f32x4*)(sp + 256 * j + 4 * lane); ss += v[j][0] * v[j][0] + v[j][1] * v[j][1] + v[j][2] * v[j][2] + v[j][3] * v[j][3]; }
        ss = wave_sum(ss);
        const float rstd = rsqrtf(ss * (1.0f / 1024.0f) + NEPS);
#pragma unroll
        for (int j = 0; j < 4; ++j) { const f32x4 gg = *(const f32x4*)(g + 256 * j + 4 * lane); *(f32x4*)(sp + 256 * j + 4 * lane) = v[j] * rstd * gg; }
    }
}

__device__ void prep_phase(PK p) {
    unsigned char* ws = p->ws;
    bf16_t* PJ = (bf16_t*)(ws + OFF_B); bf16_t* YB = (bf16_t*)(ws + OFF_A); bf16_t* MK = (bf16_t*)(ws + OFF_MK); float* RSTD = (float*)(ws + OFF_RSTD);
    const float2* RT = (const float2*)(ws + OFF_ROPE);
    const int tid_ = opaque_tid(); const int lane = tid_ & 63, gw = opaque_bid() * 8 + (tid_ >> 6), nw = opaque_gdim() * 8;
    for (int row = gw; row < RA; row += nw) {
        const bool lat = row < RL;
        int t, n; if (lat) { t = row & 8191; n = 8192; } else { t = (row - RL) & 255; n = 256; }
        const int sbase = row - t;
        bf16_t* prow = PJ + (size_t)row * PJW;
        {
            const int wdw = 2 << (lane >> 4), hw = wdw >> 1; const int lo = max(t - hw, 0), hi = min(t + hw, n);
            float s0 = 0.f, s1 = 0.f, s2 = 0.f, s3 = 0.f;
#pragma unroll
            for (int i = 0; i < 16; ++i) {
                const int off = i - 8, tt = t + off; const bool ok = (off >= -hw) && (off < hw) && (tt >= 0) && (tt < n);
                const u32x2 v = *(const u32x2*)(PJ + (size_t)(sbase + (ok ? tt : t)) * PJW + 4 * lane); const float wg = ok ? 1.0f : 0.0f;
                s0 += wg * bf_lo(v.x); s1 += wg * bf_hi(v.x); s2 += wg * bf_lo(v.y); s3 += wg * bf_hi(v.y); }
            const float ic = 1.0f / (float)(hi - lo); const u32x2 sv = *(const u32x2*)(prow + 4 * lane);
            u32x2 w; w.x = cvt_pk_bf16(s0 * ic - bf_lo(sv.x), s1 * ic - bf_hi(sv.x)); w.y = cvt_pk_bf16(s2 * ic - bf_lo(sv.y), s3 * ic - bf_hi(sv.y));
            *(u32x2*)(YB + (size_t)row * 1024 + 4 * lane) = w;
        }
        {
            const u32x2 q = *(const u32x2*)(prow + C_MQ + 4 * lane); const unsigned kv = *(const unsigned*)(prow + C_MKV + 2 * lane);
            float sq = bf_lo(q.x) * bf_lo(q.x) + bf_hi(q.x) * bf_hi(q.x) + bf_lo(q.y) * bf_lo(q.y) + bf_hi(q.y) * bf_hi(q.y);
            float sk = bf_lo(kv) * bf_lo(kv) + bf_hi(kv) * bf_hi(kv);
            sq = wave_sum(sq); sk = wave_sum(sk);
            if (lane == 0) { RSTD[row * 2] = rsqrtf(sq * (1.0f / 256.0f) + NEPS); RSTD[row * 2 + 1] = rsqrtf(sk * (1.0f / 128.0f) + NEPS); }
        }
        if (lane < 34) {
            const bool iskr = lane >= 32; const int a = lane & 1;
            bf16_t* ep = iskr ? prow + C_MKR + a * 16 : prow + ((lane >> 4) ? C_DK : C_DQ) + ((lane >> 1) & 7) * 32 + a * 16;
            const u32x4 e0 = *(const u32x4*)ep, e1 = *(const u32x4*)(ep + 8);
            float x1[8], x2[8];
            x1[0] = bf_lo(e0.x); x1[1] = bf_hi(e0.x); x1[2] = bf_lo(e0.y); x1[3] = bf_hi(e0.y); x1[4] = bf_lo(e0.z); x1[5] = bf_hi(e0.z); x1[6] = bf_lo(e0.w); x1[7] = bf_hi(e0.w);
            x2[0] = bf_lo(e1.x); x2[1] = bf_hi(e1.x); x2[2] = bf_lo(e1.y); x2[3] = bf_hi(e1.y); x2[4] = bf_lo(e1.z); x2[5] = bf_hi(e1.z); x2[6] = bf_lo(e1.w); x2[7] = bf_hi(e1.w);
            if (lat) { const int pos = a ? (t & 63) : (t >> 6);
#pragma unroll
                for (int i = 0; i < 8; ++i) { const float2 cs = RT[pos * 8 + i]; const float o1 = x1[i] * cs.x - x2[i] * cs.y, o2 = x1[i] * cs.y + x2[i] * cs.x; x1[i] = o1; x2[i] = o2; } }
            u32x4 w0, w1; w0.x = cvt_pk_bf16(x1[0], x1[1]); w0.y = cvt_pk_bf16(x1[2], x1[3]); w0.z = cvt_pk_bf16(x1[4], x1[5]); w0.w = cvt_pk_bf16(x1[6], x1[7]);
            w1.x = cvt_pk_bf16(x2[0], x2[1]); w1.y = cvt_pk_bf16(x2[2], x2[3]); w1.z = cvt_pk_bf16(x2[4], x2[5]); w1.w = cvt_pk_bf16(x2[6], x2[7]);
            if (iskr) {
#pragma unroll
                for (int hh = 0; hh < 4; ++hh) { bf16_t* kp = MK + (size_t)row * 384 + hh * 96 + 64 + a * 16; *(u32x4*)kp = w0; *(u32x4*)(kp + 8) = w1; }
            } else if (lat) { *(u32x4*)ep = w0; *(u32x4*)(ep + 8) = w1; }
        }
    }
}

#define MFMA32(a, b, c) __builtin_amdgcn_mfma_f32_32x32x16_bf16((a), (b), (c), 0, 0, 0)
typedef float f32x2 __attribute__((ext_vector_type(2)));
template <int MODE>
__device__ __forceinline__ void attn_item(PK p, int l, LAS unsigned char* lds, int b, int h, int qb, bool ctxq, float lam, float lam_init) {
    constexpr int NCOMP = (MODE == 1) ? 2 : 1, NKS = (MODE == 0) ? 4 : ((MODE == 1) ? 2 : 6), KW = NCOMP * NKS * 16, KCH = KW / 8, KSTR = KW * 2 + 16, VSTR = 192;
    constexpr int KBUF = 64 * KSTR, VBUF = 64 * VSTR, BUFSZ = KBUF + VBUF, BIAS_OFF = 3 * BUFSZ;
    constexpr bool STAG = (MODE != 0);
    const int tid = opaque_tid(), w = tid >> 6, lane = tid & 63, g = lane >> 5, l32 = lane & 31;
    unsigned char* ws = p->ws;
    const bf16_t* PJ = (const bf16_t*)(ws + OFF_B);
    const bf16_t *Qp, *Kp, *Vp; int ldq, ldk, ldv, outoff; float scale;
    if (MODE == 0) { Qp = PJ + C_NQ + 64 * h; Kp = PJ + C_NK + 64 * h; Vp = PJ + C_NV + 64 * h; ldq = ldk = ldv = PJW; outoff = 256 + 64 * h; scale = 0.125f; }
    else if (MODE == 1) { Qp = PJ + C_DQ + 64 * h; Kp = PJ + C_DK + 64 * h; Vp = PJ + C_DV + 64 * h; ldq = ldk = ldv = PJW; outoff = 512 + 64 * h; scale = 0.17677669529663687f; }
    else { Qp = (const bf16_t*)(ws + OFF_D) + 96 * h; Kp = (const bf16_t*)(ws + OFF_MK) + 96 * h; Vp = (const bf16_t*)(ws + OFF_MV) + 64 * h; ldq = ldk = 384; ldv = 256; outoff = 768 + 64 * h; scale = 0.10206207261596575f; }
    const float cs = scale * LOG2E;
    int qrow0, loc0, nloc;
    if (ctxq) { qrow0 = RL + b * 256; loc0 = 0; nloc = 0; }
    else { qrow0 = b * 8192 + qb * 256;
        if (MODE == 0) { const int r0 = qb * 4; loc0 = clampi(r0 - 4, 0, 120); nloc = clampi(r0 - 1, 0, 120) + 8 - loc0; } else { loc0 = 0; nloc = 128; } }
    const int nt = nloc + 4;
    const bool nabias = (MODE == 0) && !ctxq;
    const bool late = STAG && (w >= 4);
    const int rw = qb * 4 + (w >> 1), sw = clampi(rw - 4, 0, 120);
    const int jq = 32 * (w & 1) + l32, cst = clampi(jq - 8, 0, 48);
    if (nabias && tid < 465) ((LAS float*)(lds + BIAS_OFF))[tid] = p->na_rpb[(size_t)(l * 4 + h) * 465 + tid] * LOG2E;

    const size_t qrow = (size_t)qrow0 + 32 * w + l32;
    bf16x8 qf[NCOMP * NKS];
#pragma unroll
    for (int i = 0; i < NCOMP * NKS; ++i) {
        const u32x4 raw = *(const u32x4*)(Qp + qrow * ldq + 16 * i + 8 * g);
        u32x4 sc4; sc4.x = cvt_pk_bf16(bf_lo(raw.x) * cs, bf_hi(raw.x) * cs); sc4.y = cvt_pk_bf16(bf_lo(raw.y) * cs, bf_hi(raw.y) * cs);
        sc4.z = cvt_pk_bf16(bf_lo(raw.z) * cs, bf_hi(raw.z) * cs); sc4.w = cvt_pk_bf16(bf_lo(raw.w) * cs, bf_hi(raw.w) * cs);
        qf[i] = __builtin_bit_cast(bf16x8, sc4);
    }

    const int kr0 = tid / KCH, kc0 = tid % KCH, kr1 = (tid + 512) / KCH, kc1 = (tid + 512) % KCH, vr = tid >> 3, vc = tid & 7;
    const bool hask1 = (KCH == 12) && (tid < 256);
    u32x4 rk0, rk1 = (u32x4){0u, 0u, 0u, 0u}, rv;
#define TILE_ROW(t) ((t) < nloc ? (b * 8192 + 64 * (loc0 + (t))) : (RL + b * 256 + 64 * ((t) - nloc)))
#define LOAD_TILE(t) do { const size_t _tb = (size_t)TILE_ROW(t); rk0 = *(const u32x4*)(Kp + (_tb + kr0) * ldk + kc0 * 8); \
        if (hask1) rk1 = *(const u32x4*)(Kp + (_tb + kr1) * ldk + kc1 * 8); rv = *(const u32x4*)(Vp + (_tb + vr) * ldv + vc * 8); } while (0)
#define STORE_TILE(buf) do { LAS unsigned char* _kb = lds + (buf) * BUFSZ; *(LAS u32x4*)(_kb + kr0 * KSTR + kc0 * 16) = rk0; \
        if (hask1) *(LAS u32x4*)(_kb + kr1 * KSTR + kc1 * 16) = rk1; *(LAS u32x4*)(_kb + KBUF + vr * VSTR + vc * 16) = rv; } while (0)

    float mrun[NCOMP], lsum[NCOMP]; f32x16 O[NCOMP][2];
#pragma unroll
    for (int c = 0; c < NCOMP; ++c) { mrun[c] = -1e30f; lsum[c] = 0.f;
#pragma unroll
        for (int dt = 0; dt < 2; ++dt)
#pragma unroll
            for (int r = 0; r < 16; ++r) O[c][dt][r] = 0.f; }
    bf16x8 P[NCOMP][2][2];
#pragma unroll
    for (int c = 0; c < NCOMP; ++c)
#pragma unroll
        for (int kt = 0; kt < 2; ++kt)
#pragma unroll
            for (int s2 = 0; s2 < 2; ++s2) P[c][kt][s2] = (bf16x8){0, 0, 0, 0, 0, 0, 0, 0};

    LOAD_TILE(0); STORE_TILE(0); __syncthreads();
    const int koff = l32 * KSTR + g * 16;
    const int i16 = lane & 15, tq = i16 >> 2, tp = i16 & 3, blk = (lane >> 4) & 1;
    const int voff = (4 * g + tq) * VSTR + (16 * blk + 4 * tp) * 2;
#define PV_TILE(buf) do { LAS unsigned char* _vb = lds + (buf) * BUFSZ + KBUF + voff; \
        _Pragma("unroll") for (int kt = 0; kt < 2; ++kt) { bf16x8 vf[2][2]; \
            _Pragma("unroll") for (int s2 = 0; s2 < 2; ++s2) _Pragma("unroll") for (int dt = 0; dt < 2; ++dt) { LAS unsigned char* vp = _vb + (32 * kt + 16 * s2) * VSTR + dt * 64; \
                const s16x4 lo = __builtin_amdgcn_ds_read_tr16_b64_v4i16((LAS s16x4*)vp); const s16x4 hi = __builtin_amdgcn_ds_read_tr16_b64_v4i16((LAS s16x4*)(vp + 8 * VSTR)); \
                vf[s2][dt] = __builtin_shufflevector(lo, hi, 0, 1, 2, 3, 4, 5, 6, 7); } \
            __builtin_amdgcn_s_setprio(1); \
            _Pragma("unroll") for (int s2 = 0; s2 < 2; ++s2) _Pragma("unroll") for (int dt = 0; dt < 2; ++dt) _Pragma("unroll") for (int c = 0; c < NCOMP; ++c) O[c][dt] = MFMA32(vf[s2][dt], P[c][kt][s2], O[c][dt]); \
            __builtin_amdgcn_s_setprio(0); } } while (0)

#define PV_TILE_C(buf, cc) do { LAS unsigned char* _vb = lds + (buf) * BUFSZ + KBUF + voff; \
        _Pragma("unroll") for (int kt = 0; kt < 2; ++kt) { bf16x8 vf[2][2]; \
            _Pragma("unroll") for (int s2 = 0; s2 < 2; ++s2) _Pragma("unroll") for (int dt = 0; dt < 2; ++dt) { LAS unsigned char* vp = _vb + (32 * kt + 16 * s2) * VSTR + dt * 64; \
                const s16x4 lo = __builtin_amdgcn_ds_read_tr16_b64_v4i16((LAS s16x4*)vp); const s16x4 hi = __builtin_amdgcn_ds_read_tr16_b64_v4i16((LAS s16x4*)(vp + 8 * VSTR)); \
                vf[s2][dt] = __builtin_shufflevector(lo, hi, 0, 1, 2, 3, 4, 5, 6, 7); } \
            __builtin_amdgcn_s_setprio(1); \
            _Pragma("unroll") for (int s2 = 0; s2 < 2; ++s2) _Pragma("unroll") for (int dt = 0; dt < 2; ++dt) O[cc][dt] = MFMA32(vf[s2][dt], P[cc][kt][s2], O[cc][dt]); \
            __builtin_amdgcn_s_setprio(0); } } while (0)
    bool pend = false, zref = false; int pbuf = 0, cbuf = 0;
    for (int t = 0; t < nt; ++t) {
        const bool more = (t + 1 < nt);
        if (more) LOAD_TILE(t + 1);
        bool active = true; int krow = 0;
        if (nabias && t < nloc) { krow = loc0 + t; active = (krow >= sw) && (krow < sw + 8); }
        bool slow = (MODE == 0) || (t == 0);
        if (active) {
          again:
            LAS unsigned char* Kb = lds + cbuf * BUFSZ + koff;
            f32x16 S[NCOMP][2];
#pragma unroll
            for (int c = 0; c < NCOMP; ++c)
#pragma unroll
                for (int kt = 0; kt < 2; ++kt) {
                    bf16x8 kf[NKS];
#pragma unroll
                    for (int ks = 0; ks < NKS; ++ks) kf[ks] = *(const LAS bf16x8*)(Kb + kt * 32 * KSTR + (c * NKS + ks) * 32);
#pragma unroll
                    for (int r = 0; r < 16; ++r) S[c][kt][r] = 0.f;
                    __builtin_amdgcn_s_setprio(1);
#pragma unroll
                    for (int ks = 0; ks < NKS; ++ks) S[c][kt] = MFMA32(kf[ks], qf[c * NKS + ks], S[c][kt]);
                    __builtin_amdgcn_s_setprio(0);
                }
            if (STAG && late && pend) { PV_TILE(pbuf); pend = false; }
            float mxc[NCOMP], mnw[NCOMP];
            if (!slow) {
#pragma unroll
                for (int c = 0; c < NCOMP; ++c) mnw[c] = mrun[c];
            } else {
#pragma unroll
            for (int c = 0; c < NCOMP; ++c) {
                float mx = -1e30f;
                if (nabias && t < nloc) {
                    const LAS float* bt = (const LAS float*)(lds + BIAS_OFF) + (krow - rw + 7) * 31;
#pragma unroll
                    for (int kt = 0; kt < 2; ++kt)
#pragma unroll
                        for (int r = 0; r < 16; ++r) { const int jk = 32 * kt + (r & 3) + 8 * (r >> 2) + 4 * g; const bool ok = (jk >= cst) && (jk < cst + 16);
                            const float bv = bt[clampi(jk - jq + 15, 0, 30)]; const float xv = ok ? (S[c][kt][r] + bv) : -1e30f; S[c][kt][r] = xv; mx = fmaxf(mx, xv); }
                } else {
#pragma unroll
                    for (int kt = 0; kt < 2; ++kt)
#pragma unroll
                        for (int r = 0; r < 16; r += 2) mx = fmaxf(fmaxf(mx, S[c][kt][r]), S[c][kt][r + 1]);
                }
                mxc[c] = mx;
            }
#pragma unroll
            for (int c = 0; c < NCOMP; ++c) mxc[c] = fmaxf(mxc[c], shflx(mxc[c], 32));
            bool grow = false;
#pragma unroll
            for (int c = 0; c < NCOMP; ++c) { mnw[c] = fmaxf(mrun[c], mxc[c]); grow = grow || (mnw[c] > mrun[c]); }
            if (MODE != 0) {
                bool big = false;
#pragma unroll
                for (int c = 0; c < NCOMP; ++c) big = big || !(fabsf(mnw[c]) < 40.0f);
                zref = (t == 0) && !__any(big);
                if (zref) {
#pragma unroll
                    for (int c = 0; c < NCOMP; ++c) mnw[c] = 0.0f; }
            }
            if (__any(grow)) {
#pragma unroll
                for (int c = 0; c < NCOMP; ++c) { const float alpha = fast_exp2(mrun[c] - mnw[c]); lsum[c] *= alpha;
#pragma unroll
                    for (int dt = 0; dt < 2; ++dt) O[c][dt] *= alpha;
                    mrun[c] = mnw[c]; }
            }
            }
            if (!zref) {
#pragma unroll
            for (int c = 0; c < NCOMP; ++c) { const f32x2 m2 = (f32x2){mnw[c], mnw[c]};
#pragma unroll
                for (int kt = 0; kt < 2; ++kt)
#pragma unroll
                    for (int r = 0; r < 16; r += 2) { const f32x2 d = (f32x2){S[c][kt][r], S[c][kt][r + 1]} - m2; S[c][kt][r] = d.x; S[c][kt][r + 1] = d.y; } }
            }
#pragma unroll
            for (int c = 0; c < NCOMP; ++c)
#pragma unroll
                for (int kt = 0; kt < 2; ++kt)
#pragma unroll
                    for (int r = 0; r < 16; ++r) S[c][kt][r] = fast_exp2(S[c][kt][r]);
#pragma unroll
            for (int c = 0; c < NCOMP; ++c) { f32x2 rs2 = (f32x2){0.f, 0.f};
#pragma unroll
                for (int kt = 0; kt < 2; ++kt)
#pragma unroll
                    for (int s2 = 0; s2 < 2; ++s2) { u32x4 pk;
#pragma unroll
                        for (int e = 0; e < 4; ++e) { const f32x2 ev = (f32x2){S[c][kt][8 * s2 + 2 * e], S[c][kt][8 * s2 + 2 * e + 1]}; rs2 += ev; pk[e] = cvt_pk_bf16(ev.x, ev.y); }
                        P[c][kt][s2] = __builtin_bit_cast(bf16x8, pk); }
                mxc[c] = rs2.x + rs2.y; }
            if (!slow) { bool bad = false;
#pragma unroll
                for (int c = 0; c < NCOMP; ++c) bad = bad || !(mxc[c] < 1.0e18f);
                if (__any(bad)) { slow = true; goto again; } }
#pragma unroll
            for (int c = 0; c < NCOMP; ++c) lsum[c] += mxc[c];
            if (!(STAG && late)) PV_TILE(cbuf);
            if (STAG && late) { pend = true; pbuf = cbuf; }
        }
        const int nbuf = (cbuf == 2) ? 0 : cbuf + 1;
        if (more) STORE_TILE(nbuf);
        __syncthreads();
        cbuf = nbuf;
    }
    if (STAG && late && pend) PV_TILE(pbuf);
#undef PV_TILE
#undef PV_TILE_C
#undef TILE_ROW
#undef LOAD_TILE
#undef STORE_TILE
    float inv[NCOMP];
#pragma unroll
    for (int c = 0; c < NCOMP; ++c) { const float lt = lsum[c] + shflx(lsum[c], 32); inv[c] = 1.0f / lt; }
    bf16_t* op = (bf16_t*)(ws + OFF_A) + qrow * 1024 + outoff;
    if (MODE == 1) {
        const float li1 = lam * inv[NCOMP - 1]; float ss = 0.f;
#pragma unroll
        for (int dt = 0; dt < 2; ++dt)
#pragma unroll
            for (int r = 0; r < 16; ++r) { const float o = O[0][dt][r] * inv[0] - li1 * O[NCOMP - 1][dt][r]; O[0][dt][r] = o; ss += o * o; }
        ss += shflx(ss, 32);
        const float rstd = rsqrtf(ss * (1.0f / 64.0f) + NEPS) * (1.0f - lam_init);
        const float* sg = p->diff_subln_g + l * 64;
#pragma unroll
        for (int dt = 0; dt < 2; ++dt)
#pragma unroll
            for (int rq = 0; rq < 4; ++rq) { const int dv = 32 * dt + 8 * rq + 4 * g; const f32x4 gg = *(const f32x4*)(sg + dv);
                u32x2 wv; wv.x = cvt_pk_bf16(O[0][dt][4 * rq] * rstd * gg[0], O[0][dt][4 * rq + 1] * rstd * gg[1]); wv.y = cvt_pk_bf16(O[0][dt][4 * rq + 2] * rstd * gg[2], O[0][dt][4 * rq + 3] * rstd * gg[3]);
                *(u32x2*)(op + dv) = wv; }
    } else {
#pragma unroll
        for (int dt = 0; dt < 2; ++dt)
#pragma unroll
            for (int rq = 0; rq < 4; ++rq) { const int dv = 32 * dt + 8 * rq + 4 * g;
                u32x2 wv; wv.x = cvt_pk_bf16(O[0][dt][4 * rq] * inv[0], O[0][dt][4 * rq + 1] * inv[0]); wv.y = cvt_pk_bf16(O[0][dt][4 * rq + 2] * inv[0], O[0][dt][4 * rq + 3] * inv[0]);
                *(u32x2*)(op + dv) = wv; }
    }
    __syncthreads();
}

__device__ void attn_phase(PK p, int l, LAS unsigned char* lds) {
    const float lam_init = (l == 0) ? 0.2f : 0.35550906759502f;
    const float* dl = p->diff_lambda + l * 128;
    float d01 = 0.f, d23 = 0.f;
    for (int i = 0; i < 32; ++i) { d01 += dl[i] * dl[32 + i]; d23 += dl[64 + i] * dl[96 + i]; }
    const float lam = expf(d01) - expf(d23) + lam_init;
    const int nItems = 1536 + (l == 0 ? 48 : 0);
    for (int it = opaque_bid(); it < nItems; it += opaque_gdim()) {
        if (it < 1536) {
            const int ty = it >> 9, idx = it & 511, bh = ((idx & 7) << 1) | (idx >> 8), b = bh >> 2, h = bh & 3, qb = (idx >> 3) & 31;
            if (ty == 0) attn_item<1>(p, l, lds, b, h, qb, false, lam, lam_init);
            else if (ty == 1) attn_item<2>(p, l, lds, b, h, qb, false, lam, lam_init);
            else attn_item<0>(p, l, lds, b, h, qb, false, lam, lam_init);
        } else {
            const int idx = it - 1536, ty = idx >> 4, b = (idx >> 2) & 3, h = idx & 3;
            if (ty == 0) attn_item<1>(p, l, lds, b, h, 0, true, lam, lam_init);
            else if (ty == 1) attn_item<2>(p, l, lds, b, h, 0, true, lam, lam_init);
            else attn_item<0>(p, l, lds, b, h, 0, true, lam, lam_init);
        }
    }
}

constexpr int PH_PER_LAYER = 14, N_PHASES = 2 * PH_PER_LAYER + 1;

__device__ __forceinline__ void run_phase(PK p, int ph, LAS unsigned char* lds, float rcoef) {
    unsigned char* ws = p->ws;
    pg8::StaticOrder S;
    if (ph == N_PHASES - 1) { final_norm_phase(p->out, p->final_norm_g); return; }
    int l = ph / PH_PER_LAYER; const int q = ph % PH_PER_LAYER;
#define OPQL asm volatile("" : "+s"(l))
#define HC ((float*)(ws + OFF_HC))
#define MOD ((const float*)(ws + OFF_MOD) + (size_t)l * 5 * 9216)
#define TN ((bf16_t*)(ws + OFF_A))
#define HID ((bf16_t*)(ws + OFF_B))
#define Mlate ((l == 0) ? RA : RL)
    switch (q) {
    case 0: OPQL; layer_prep_phase(p, l, lds); break;
    case 1: OPQL; if (l == 0) norm_mod_phase(p->x, p->ctx, p->out, HC, p->norm_g + (l * 3 + 0) * 1024, MOD, TN, RA, nullptr, 0);
            else norm_mod_phase(p->out, HC, nullptr, nullptr, p->norm_g + (l * 3 + 0) * 1024, MOD, TN, RA, (const float*)(ws + OFF_PB), 11); break;
    case 2: case 12: { OPQL; const int f = (q == 2) ? 0 : 1; const int M = (q == 2) ? RA : Mlate;
        pg8::Gemm g{TN, (const bf16_t*)(ws + OFF_W1) + (size_t)f * 5632 * 1024, M, 5632, 1024, 1024, 1024}; S.init(M, 5632, opaque_gdim(), opaque_bid());
        EpiSwiglu E{HID}; pg8::gemm_phase(lds, g, S, E); } break;
    case 4: OPQL; norm_mod_phase(p->out, HC, nullptr, nullptr, p->norm_g + (l * 3 + 1) * 1024, MOD + 3 * 1024, TN, RA, (const float*)(ws + OFF_PB), 11); break;
    case 5: { OPQL; pg8::Gemm g{TN, (const bf16_t*)(ws + OFF_WM), RA, 6400, 1024, 1024, 1024}; S.init(RA, 6400, opaque_gdim(), opaque_bid());
        EpiPJ E{(bf16_t*)(ws + OFF_B), ws + OFF_C}; pg8::gemm_phase(lds, g, S, E); } break;
    case 6: prep_phase(p); break;
    case 7: { OPQL; pg8::Gemm g{(const bf16_t*)(ws + OFF_B) + C_MQ, (const bf16_t*)(ws + OFF_WL), RA, 1024, 384, PJW, 384}; S.init(RA, 1024, opaque_gdim(), opaque_bid());
        EpiMLA E{(bf16_t*)(ws + OFF_D), (bf16_t*)(ws + OFF_MK), (bf16_t*)(ws + OFF_MV), (const float*)(ws + OFF_RSTD), (const float2*)(ws + OFF_ROPE)}; pg8::gemm_phase(lds, g, S, E); } break;
    case 8: OPQL; attn_phase(p, l, lds); break;
    case 9: { OPQL; pg8::Gemm g{(const bf16_t*)(ws + OFF_A), (const bf16_t*)(ws + OFF_WB), Mlate, 1024, 1024, 1024, 1024}; S.init(Mlate, 1024, opaque_gdim(), opaque_bid());
        EpiMerge E{ws + OFF_C, (bf16_t*)(ws + OFF_D)}; pg8::gemm_phase(lds, g, S, E); } break;
    case 3: case 13: case 10: { OPQL;
        const bool isout = (q == 10); const int f = (q == 13) ? 1 : 0;
        const bf16_t* A = isout ? (const bf16_t*)(ws + OFF_D) : (const bf16_t*)HID;
        const bf16_t* Bt = isout ? (const bf16_t*)(ws + OFF_WO) : (const bf16_t*)(ws + OFF_W2) + (size_t)f * 1024 * FH;
        const int K = isout ? 1024 : FH;
        const float* gate = MOD + (isout ? 5 : (q == 3 ? 2 : 8)) * 1024;
        const float coef = (isout ? 1.0f : 0.5f) * rcoef;
        const bool withctx = (q == 3) || (l == 0);
        { pg8::Gemm g{A, Bt, RL, 1024, K, K, K}; S.init(RL, 1024, opaque_gdim(), opaque_bid());
          EpiResid E{p->out, HC, gate, coef}; pg8::gemm_phase(lds, g, S, E); }
        if (withctx) {
            const int nsu = 16 * (K / 256);
            for (int su = opaque_bid(); su < nsu; su += opaque_gdim()) {
                const int ks = su >> 4, pmn = su & 15;
                pg8::SingleUnit SU; SU.pm = 128 + (pmn >> 2); SU.pn = pmn & 3; SU.has = true;
                pg8::Gemm g2{A + ks * 256, Bt + ks * 256, RA, 1024, 256, K, K};
                EpiPartial E2{(float*)(ws + OFF_PB) + (size_t)ks * 1024 * 1024, gate + 4 * 9216, coef}; pg8::gemm_phase(lds, g2, SU, E2);
            }
        }
    } break;
    case 11: OPQL; norm_mod_phase(p->out, HC, nullptr, nullptr, p->norm_g + (l * 3 + 2) * 1024, MOD + 6 * 1024, TN, Mlate, (const float*)(ws + OFF_PB), 4); break;
    }
#undef OPQL
#undef HC
#undef MOD
#undef TN
#undef HID
#undef Mlate
}

__global__ void __launch_bounds__(512, 2) fwd_megakernel(Params p) {
    extern __shared__ __attribute__((aligned(16))) unsigned char shm[];
    LAS unsigned char* lds = (LAS unsigned char*)shm;
#if N_LAUNCH_MODE == 1
    cg::grid_group grid = cg::this_grid();
    const int ph_lo = p.ph_lo, ph_hi = p.ph_hi;
    volatile LAS unsigned* st = (volatile LAS unsigned*)(lds + pg8::STAGE_BYTES);
    unsigned* bar = (unsigned*)(p.ws + OFF_BAR);
    if (opaque_tid() < 4) st[opaque_tid()] = 0u;
    if (opaque_bid() == 0) for (int i = opaque_tid(); i < XCD_BAR_WORDS; i += 512) bar[i] = 0u;
    __syncthreads();
#if PROBE_Q >= 0
    const int nseq = 2 * (PH_PER_LAYER + 1) + 1;
    for (int i = 0; i < nseq; ++i) {
        int ph;
        if (i == nseq - 1) ph = N_PHASES - 1;
        else { const int li = i / (PH_PER_LAYER + 1), r = i % (PH_PER_LAYER + 1); ph = li * PH_PER_LAYER + (r <= PROBE_Q ? r : r - 1); }
        PK pk = (PK)__builtin_amdgcn_kernarg_segment_ptr();
        asm volatile("" : "+s"(pk));
        run_phase(pk, ph, lds, 1.0f);
        if (i == 0) { grid.sync(); xcd_barrier_post(bar); }
        else if (i + 1 < nseq) xcd_barrier(bar, st);
    }
#else
    for (int ph = ph_lo; ph < ph_hi; ++ph) {
        PK pk = (PK)__builtin_amdgcn_kernarg_segment_ptr();
        asm volatile("" : "+s"(pk));
        run_phase(pk, ph, lds, 1.0f);
        if (ph == ph_lo) { grid.sync(); xcd_barrier_post(bar); }
        else if (ph + 1 < ph_hi) xcd_barrier(bar, st);
    }
#endif
#else
    const int ph_lo = p.ph_lo, ph_hi = p.ph_hi;
    for (int ph = ph_lo; ph < ph_hi; ++ph) { PK pk = (PK)__builtin_amdgcn_kernarg_segment_ptr(); asm volatile("" : "+s"(pk)); run_phase(pk, ph, lds, 1.0f); }
#endif
}

extern "C" void kernel_launch(void* const* d_in, const int* in_sizes, int n_in, void* d_out, int out_size, void* d_ws, size_t ws_size, hipStream_t stream) {
    constexpr int LDS_BYTES = pg8::STAGE_BYTES + 16;
    static int grid_blocks = 0;
    if (grid_blocks == 0) {
        if (n_in != 22 || ws_size < WS_END) { fprintf(stderr, "kernel_launch: unexpected inputs (n_in %d, ws %zu < %zu)\n", n_in, ws_size, (size_t)WS_END); grid_blocks = -1; return; }
        int dev = 0, cus = 0, per_cu = 0;
        hipGetDevice(&dev); hipDeviceGetAttribute(&cus, hipDeviceAttributeMultiprocessorCount, dev);
        if (hipFuncSetAttribute((const void*)fwd_megakernel, hipFuncAttributeMaxDynamicSharedMemorySize, LDS_BYTES) != hipSuccess) { fprintf(stderr, "hipFuncSetAttribute failed\n"); grid_blocks = -1; return; }
        if (hipOccupancyMaxActiveBlocksPerMultiprocessor(&per_cu, (const void*)fwd_megakernel, 512, LDS_BYTES) != hipSuccess || per_cu < 1) per_cu = 1;
        (void)hipGetLastError();
        grid_blocks = cus * 1;
    }
    if (grid_blocks < 0) return;
    Params hp{};
    const float** pp = (const float**)&hp;
    for (int i = 0; i < 22; ++i) pp[i] = (const float*)d_in[i];
    hp.out = (float*)d_out; hp.ws = (unsigned char*)d_ws;
#if N_LAUNCH_MODE == 1
    hp.ph_lo = 0; hp.ph_hi = N_PHASES;
    void* args[] = {&hp};
    hipError_t e = hipLaunchCooperativeKernel((const void*)fwd_megakernel, dim3(grid_blocks), dim3(512), args, LDS_BYTES, stream);
    if (e != hipSuccess) fprintf(stderr, "cooperative launch failed: %s (grid %d)\n", hipGetErrorString(e), grid_blocks);
#else
    for (int ph = 0; ph < N_PHASES; ++ph) { hp.ph_lo = ph; hp.ph_hi = ph + 1; hipLaunchKernelGGL(fwd_megakernel, dim3(grid_blocks), dim3(512), LDS_BYTES, stream, hp); }
#endif
}
```

```cpp
#include <hip/hip_runtime.h>
#include <hip/hip_cooperative_groups.h>
#include <cstdio>
namespace cg = cooperative_groups;

#define LAS __attribute__((address_space(3)))
typedef unsigned short bf16_t;
typedef short bf16x8 __attribute__((ext_vector_type(8)));
typedef short s16x4 __attribute__((ext_vector_type(4)));
typedef float f32x4 __attribute__((ext_vector_type(4)));
typedef float f32x16 __attribute__((ext_vector_type(16)));
typedef unsigned u32x4 __attribute__((ext_vector_type(4)));
typedef unsigned u32x2 __attribute__((ext_vector_type(2)));

#ifndef PROBE_Q
#define PROBE_Q (-1)
#endif
#ifndef N_LAUNCH_MODE
#define N_LAUNCH_MODE 1
#endif

constexpr int RL = 32768, RA = 33792, FH = 2816;
constexpr int PJW = 2304;
constexpr int C_NQ = 256, C_NK = 512, C_NV = 768, C_DQ = 1024, C_DK = 1280, C_DV = 1536, C_MQ = 1792, C_MKV = 2048, C_MKR = 2176;
constexpr float LOG2E = 1.4426950408889634f;
constexpr float NEPS = 1e-6f;
constexpr int XCD_BAR_WORDS_C = 3456;

constexpr size_t SZ_W1 = 2ull * 5632 * 1024 * 2, SZ_W2 = 2ull * 1024 * 2816 * 2, SZ_WM = 6400ull * 1024 * 2, SZ_WL = 1024ull * 384 * 2, SZ_WB = 4ull * 1024 * 256 * 2, SZ_WO = 1024ull * 1024 * 2;
constexpr size_t OFF_W1 = 0, OFF_W2 = OFF_W1 + SZ_W1, OFF_WM = OFF_W2 + SZ_W2, OFF_WL = OFF_WM + SZ_WM, OFF_WB = OFF_WL + SZ_WL, OFF_WO = OFF_WB + SZ_WB;
constexpr size_t OFF_HC = OFF_WO + SZ_WO;
constexpr size_t OFF_MOD = OFF_HC + 1024ull * 1024 * 4;
constexpr size_t OFF_ROPE = OFF_MOD + 2ull * 5 * 9216 * 4;
constexpr size_t OFF_RSTD = OFF_ROPE + 128 * 8 * 8;
constexpr size_t OFF_A = OFF_RSTD + (size_t)RA * 2 * 4;
constexpr size_t OFF_B = OFF_A + (size_t)RA * 1024 * 2;
constexpr size_t OFF_C = OFF_B + (size_t)RA * PJW * 2;
constexpr size_t OFF_D = OFF_C + (size_t)RA * 4096;
constexpr size_t OFF_MK = OFF_D + (size_t)RA * 384 * 2, OFF_MV = OFF_MK + (size_t)RA * 384 * 2;
constexpr size_t OFF_BAR = OFF_D + (size_t)RA * 1024 * 2;
constexpr size_t OFF_PB = OFF_BAR + 16384;
constexpr size_t WS_END = OFF_PB + 11ull * 1024 * 1024 * 4;

struct Params {
    const float *x, *c, *ctx, *c_ctx, *ada_w, *ada_b, *norm_g, *ffn_w_in, *ffn_w_out, *mix_w_in, *pool_w, *pool_scale, *na_rpb, *diff_lambda, *diff_subln_g,
        *mla_q_norm_g, *mla_kv_norm_g, *mla_w_qb, *mla_w_kvb, *branch_w_out, *mix_w_out, *final_norm_g;
    float* out; unsigned char* ws;
    int ph_lo, ph_hi;
};

typedef const __attribute__((address_space(4))) Params* PK;

typedef float f32x2_ __attribute__((ext_vector_type(2)));
typedef __bf16 bf16x2_ __attribute__((ext_vector_type(2)));
__device__ __forceinline__ unsigned cvt_pk_bf16(float lo, float hi) { const f32x2_ v = {lo, hi}; return __builtin_bit_cast(unsigned, __builtin_convertvector(v, bf16x2_)); }
__device__ __forceinline__ float bf_lo(unsigned u) { return __uint_as_float(u << 16); }
__device__ __forceinline__ float bf_hi(unsigned u) { return __uint_as_float(u & 0xffff0000u); }
__device__ __forceinline__ float fast_exp2(float x) { return __builtin_amdgcn_exp2f(x); }
__device__ __forceinline__ float fast_rcp(float x) { return __builtin_amdgcn_rcpf(x); }
__device__ __forceinline__ float sigmoidf_(float x) { return fast_rcp(1.0f + fast_exp2(-x * LOG2E)); }
__device__ __forceinline__ float shflx(float v, int m) {
    int lane = __builtin_amdgcn_mbcnt_hi(~0u, __builtin_amdgcn_mbcnt_lo(~0u, 0)); asm volatile("" : "+v"(lane));
    return __int_as_float(__builtin_amdgcn_ds_bpermute((lane ^ m) << 2, __float_as_int(v)));
}
__device__ __forceinline__ float wave_sum(float v) {
    v += shflx(v, 32); v += shflx(v, 16); v += shflx(v, 8); v += shflx(v, 4); v += shflx(v, 2); v += shflx(v, 1); return v;
}
__device__ __forceinline__ int opaque_tid() { int t = threadIdx.x; asm volatile("" : "+v"(t)); return t; }
__device__ __forceinline__ int opaque_bid() { int t = blockIdx.x; asm volatile("" : "+s"(t)); return t; }
__device__ __forceinline__ int opaque_gdim() { int t = gridDim.x; asm volatile("" : "+s"(t)); return t; }
__device__ __forceinline__ int clampi(int v, int lo, int hi) { return v < lo ? lo : (v > hi ? hi : v); }

#define XB_TMO      128
#define XB_XCNT(j)  (256  + 64 * (j))
#define XB_XSUB(j)  (1280 + 64 * (j))
#define XB_XGEN(j)  (2304 + 64 * (j))
#define XB_TOP      3328
#define XB_TOPGEN   3392
#define XCD_BAR_WORDS 3456
#define XB_SPIN_CAP (1u << 20)
__device__ __forceinline__ unsigned xb_ld(unsigned* p)              { return __hip_atomic_load(p, __ATOMIC_RELAXED, __HIP_MEMORY_SCOPE_AGENT); }
__device__ __forceinline__ unsigned xb_add(unsigned* p, unsigned v) { return __hip_atomic_fetch_add(p, v, __ATOMIC_RELAXED, __HIP_MEMORY_SCOPE_AGENT); }
__device__ __forceinline__ unsigned xb_xcc_id() { return (unsigned)__builtin_amdgcn_s_getreg((3 << 11) | 20) & 0xFu; }
#define XB_SPIN(cond, bar) do { unsigned _sp = 0; while (cond) { __builtin_amdgcn_s_sleep(1); \
    if ((++_sp & 255u) == 0u) { if (xb_ld(&(bar)[XB_TMO])) break; if (_sp > XB_SPIN_CAP) { atomicAdd(&(bar)[XB_TMO], 1u); break; } } } } while (0)
__device__ __forceinline__ void xcd_barrier_post(unsigned* bar) { if (opaque_tid() == 0) (void)xb_add(&bar[XB_XCNT(xb_xcc_id())], 1u); }
__device__ __forceinline__ void xcd_barrier_complete(unsigned* bar, unsigned x, unsigned& nloc, unsigned& nx) {
    const unsigned G = gridDim.x;
    unsigned sum, cnt, mine, sp = 0u;
    for (;;) {
        sum = 0u; cnt = 0u; mine = 0u;
#pragma unroll
        for (unsigned j = 0; j < 16; ++j) { const unsigned c = xb_ld(&bar[XB_XCNT(j)]); sum += c; cnt += (c > 0u) ? 1u : 0u; mine = (j == x) ? c : mine; }
        if (sum == G) break;
        __builtin_amdgcn_s_sleep(1);
        if ((++sp & 255u) == 0u) { if (xb_ld(&bar[XB_TMO])) break; if (sp > XB_SPIN_CAP) { atomicAdd(&bar[XB_TMO], 1u); break; } }
    }
    nloc = mine > 0u ? mine : 1u; nx = cnt > 0u ? cnt : 1u;
}
__device__ __forceinline__ void xcd_barrier(unsigned* bar, volatile LAS unsigned* st) {
    asm volatile("s_waitcnt vmcnt(0)" ::: "memory");
    __syncthreads();
    if (opaque_tid() == 0) {
        const unsigned x = xb_xcc_id();
        __builtin_amdgcn_s_waitcnt(0);
        unsigned nloc = st[0], nx = st[1];
        if (nloc == 0u) { xcd_barrier_complete(bar, x, nloc, nx); st[0] = nloc; st[1] = nx; }
        const unsigned old = xb_add(&bar[XB_XSUB(x)], 1u);
        const unsigned gen = old / nloc;
        if (old + 1u == (gen + 1u) * nloc) {
            __builtin_amdgcn_fence(__ATOMIC_RELEASE, "agent");
            asm volatile("s_waitcnt vmcnt(0)" ::: "memory");
            const unsigned og = xb_add(&bar[XB_TOP], 1u);
            const unsigned tg = og / nx;
            if (og + 1u == (tg + 1u) * nx) xb_add(&bar[XB_TOPGEN], 1u);
            else XB_SPIN(xb_ld(&bar[XB_TOPGEN]) == tg, bar);
            __builtin_amdgcn_fence(__ATOMIC_ACQUIRE, "agent");
            xb_add(&bar[XB_XGEN(x)], 1u);
            asm volatile("s_waitcnt vmcnt(0)" ::: "memory");
        } else {
            XB_SPIN(xb_ld(&bar[XB_XGEN(x)]) == gen, bar);
            __builtin_amdgcn_fence(__ATOMIC_ACQUIRE, "agent");
            asm volatile("s_waitcnt vmcnt(0)" ::: "memory");
        }
    }
    __syncthreads();
}

namespace pg8 {
constexpr int BM = 256, BK = 64, HALF = 128, HTB = HALF * BK * 2, STAGE_BYTES = 8 * HTB, NXCD = 8, WGM = 8;
__device__ __forceinline__ int lds_byte(int r, int c) { const int st = (r >> 4) * 2 + (c >> 5), rr = r & 15, cc = c & 31, ob = rr * 64 + cc * 2; return st * 1024 + (ob ^ (((ob >> 9) & 1) << 5)); }
__device__ __forceinline__ void stage_rc(int b, int& R, int& C) { const int st = b / 1024, sb = b % 1024, swz = sb ^ (((sb >> 9) & 1) << 5); R = (st >> 1) * 16 + swz / 64; C = (st & 1) * 32 + (swz % 64) / 2; }
__device__ __forceinline__ int perm32(int rho) { const int n = rho >> 4, i = rho & 15; return 8 * (i >> 2) + 4 * n + (i & 3); }
struct Unit { int pm, pn; };
struct Gemm { const bf16_t* A; const bf16_t* Bt; int M, N, K, lda, ldb; };
struct StaticOrder {
    int nM, nN, nwg, G, c;
    __device__ void init(int M, int N, int G_, int c_) { nM = M / BM; nN = N / BM; nwg = nM * nN; G = G_; c = c_; }
    __device__ bool next(int i, Unit& u) const {
        const long L = (long)i * G + c; if (L >= nwg) return false;
        int wgid = (int)L; { const int q = nwg / NXCD, r = nwg % NXCD, xcd = wgid % NXCD, off = wgid / NXCD; wgid = (xcd < r ? xcd * (q + 1) : r * (q + 1) + (xcd - r) * q) + off; }
        const int nig = WGM * nN, gid = wgid / nig, fm = gid * WGM, gsz = (nM - fm) < WGM ? (nM - fm) : WGM;
        u.pm = fm + ((wgid % nig) % gsz); u.pn = (wgid % nig) / gsz; return true;
    }
};

struct SingleUnit {
    int pm, pn; bool has;
    __device__ bool next(int i, Unit& u) const { if (i > 0 || !has) return false; u.pm = pm; u.pn = pn; return true; }
};
template <class Epi, class Sched>
__device__ __forceinline__ void gemm_phase(LAS unsigned char* lds, const Gemm g, const Sched& S, const Epi& E) {
    const int tid = opaque_tid(), wid = __builtin_amdgcn_readfirstlane(tid >> 6), lane = tid & 63, wr = wid >> 2, wc = wid & 3, fr = lane & 15, fq = lane >> 4;
    const int K = g.K, nt = K / BK;
    unsigned voffA[2], voffB[2];
#pragma unroll
    for (int i = 0; i < 2; ++i) { int R, C; stage_rc(tid * 16 + i * 8192, R, C); const int Rb = Epi::PERM ? ((R & ~31) + perm32(R & 31)) : R;
        voffA[i] = (unsigned)(R * g.lda + C) * 2u; voffB[i] = (unsigned)(Rb * g.ldb + C) * 2u; }
    const size_t kstep = (size_t)(BK * 2);
    const size_t hstepA = (size_t)HALF * g.lda * 2, hstepB = (size_t)HALF * g.ldb * 2;
    const size_t tstepA = 2 * hstepA, tstepB = 2 * hstepB;
    const unsigned ldsw = (unsigned)wid * 1024u;
    const int aoff = lds_byte(wr * 64 + fr, fq * 8), boff = lds_byte(wc * 32 + fr, fq * 8);
#define PG8_SA(b, h) (((b) * 2 + (h)) * HTB)
#define PG8_SB(b, h) ((4 + (b) * 2 + (h)) * HTB)
#define PG8_STAGE(bufoff, gbase, voff) do { _Pragma("unroll") for (int _i = 0; _i < 2; ++_i) \
        __builtin_amdgcn_global_load_lds((const unsigned*)((const char*)(gbase) + (voff)[_i]), (LAS unsigned*)(lds + (bufoff) + ldsw + _i * 8192), 16, 0, 0); } while (0)
#define PG8_LDA(dst, b, h) do { _Pragma("unroll") for (int m = 0; m < 4; ++m) _Pragma("unroll") for (int k = 0; k < 2; ++k) dst[m][k] = *(const LAS bf16x8*)(lds + PG8_SA(b, h) + aoff + m * 2048 + k * 1024); } while (0)
#define PG8_LDB(dst, b, h) do { _Pragma("unroll") for (int n = 0; n < 2; ++n) _Pragma("unroll") for (int k = 0; k < 2; ++k) dst[n][k] = *(const LAS bf16x8*)(lds + PG8_SB(b, h) + boff + n * 2048 + k * 1024); } while (0)
#define PG8_MMA(ai, bj, At, Bt) do { __builtin_amdgcn_s_setprio(1); _Pragma("unroll") for (int m = 0; m < 4; ++m) _Pragma("unroll") for (int n = 0; n < 2; ++n) _Pragma("unroll") for (int k = 0; k < 2; ++k) \
        acc[ai][bj][m][n] = __builtin_amdgcn_mfma_f32_16x16x32_bf16(Bt[n][k], At[m][k], acc[ai][bj][m][n], 0, 0, 0); __builtin_amdgcn_s_setprio(0); } while (0)
#define PG8_WAIT_V(n) asm volatile("s_waitcnt vmcnt(" #n ")" ::: "memory")
#define PG8_WAIT_L(n) asm volatile("s_waitcnt lgkmcnt(" #n ")" ::: "memory")
#define PG8_BAR __builtin_amdgcn_s_barrier()
#define PG8_SCHED __builtin_amdgcn_sched_barrier(0)
    Unit cur, nxt; int ui = 0;
    if (!S.next(0, cur)) return;
    f32x4 acc[2][2][4][2];
#pragma unroll
    for (int a = 0; a < 2; ++a)
#pragma unroll
        for (int b = 0; b < 2; ++b)
#pragma unroll
            for (int m = 0; m < 4; ++m)
#pragma unroll
                for (int n = 0; n < 2; ++n) acc[a][b][m][n] = (f32x4){0.f, 0.f, 0.f, 0.f};
    bf16x8 At[4][2], B0[2][2], B1[2][2];
    const char* cA = (const char*)g.A + (size_t)cur.pm * tstepA; const char* cB = (const char*)g.Bt + (size_t)cur.pn * tstepB;
    PG8_STAGE(PG8_SB(0, 0), cB, voffB); PG8_STAGE(PG8_SA(0, 0), cA, voffA); PG8_STAGE(PG8_SB(0, 1), cB + hstepB, voffB); PG8_STAGE(PG8_SA(0, 1), cA + hstepA, voffA);
    if (wr == 1) PG8_BAR;
    PG8_WAIT_V(4); PG8_BAR;
    PG8_STAGE(PG8_SB(1, 0), cB + kstep, voffB); PG8_STAGE(PG8_SA(1, 0), cA + kstep, voffA); PG8_STAGE(PG8_SB(1, 1), cB + hstepB + kstep, voffB);
    PG8_WAIT_V(6); PG8_BAR;
    for (;;) {
        const bool has_next = S.next(ui + 1, nxt);
        const char* nA = has_next ? (const char*)g.A + (size_t)nxt.pm * tstepA : cA; const char* nB = has_next ? (const char*)g.Bt + (size_t)nxt.pn * tstepB : cB;
        for (int t = 0; t < nt; t += 2) {
            const bool last = (t == nt - 2);
            const char* a1 = cA + (size_t)(t + 1) * kstep;
            const char* a2 = last ? nA : cA + (size_t)(t + 2) * kstep; const char* b2 = last ? nB : cB + (size_t)(t + 2) * kstep;
            const char* a3 = a2 + kstep; const char* b3 = b2 + kstep;
            PG8_LDB(B0, 0, 0); PG8_SCHED; PG8_LDA(At, 0, 0); PG8_STAGE(PG8_SA(1, 1), a1 + hstepA, voffA);
            PG8_WAIT_L(8); PG8_BAR; PG8_WAIT_L(0); PG8_MMA(0, 0, At, B0); PG8_BAR; PG8_SCHED;
            PG8_LDB(B1, 0, 1); PG8_STAGE(PG8_SB(0, 0), b2, voffB);
            PG8_BAR; PG8_WAIT_L(0); PG8_MMA(0, 1, At, B1); PG8_BAR;
            PG8_LDA(At, 0, 1); PG8_STAGE(PG8_SA(0, 0), a2, voffA);
            PG8_BAR; PG8_WAIT_L(0); PG8_MMA(1, 0, At, B0); PG8_BAR; PG8_SCHED;
            PG8_STAGE(PG8_SB(0, 1), b2 + hstepB, voffB);
            PG8_WAIT_V(6); PG8_BAR; PG8_MMA(1, 1, At, B1); PG8_BAR;
            PG8_LDB(B0, 1, 0); PG8_SCHED; PG8_LDA(At, 1, 0); PG8_STAGE(PG8_SA(0, 1), a2 + hstepA, voffA);
            PG8_WAIT_L(8); PG8_BAR; PG8_WAIT_L(0); PG8_MMA(0, 0, At, B0); PG8_BAR; PG8_SCHED;
            PG8_LDB(B1, 1, 1); PG8_STAGE(PG8_SB(1, 0), b3, voffB);
            PG8_BAR; PG8_WAIT_L(0); PG8_MMA(0, 1, At, B1); PG8_BAR;
            PG8_LDA(At, 1, 1); PG8_STAGE(PG8_SA(1, 0), a3, voffA);
            PG8_BAR; PG8_WAIT_L(0); PG8_MMA(1, 0, At, B0); PG8_BAR; PG8_SCHED;
            PG8_STAGE(PG8_SB(1, 1), b3 + hstepB, voffB);
            PG8_WAIT_V(6); PG8_BAR; PG8_MMA(1, 1, At, B1); PG8_BAR;
            if constexpr (Epi::HOOK) { if ((((t + 2) & 3) == 0) && !last) E.hook(acc, cur, (t + 2) >> 2, wr, wc, fr, fq); }
        }
        E(acc, cur, wr, wc, fr, fq);
        if (!has_next) break;
#pragma unroll
        for (int a = 0; a < 2; ++a)
#pragma unroll
            for (int b = 0; b < 2; ++b)
#pragma unroll
                for (int m = 0; m < 4; ++m)
#pragma unroll
                    for (int n = 0; n < 2; ++n) acc[a][b][m][n] = (f32x4){0.f, 0.f, 0.f, 0.f};
        cur = nxt; cA = nA; cB = nB; ++ui;
    }
    PG8_WAIT_V(0);
    if (wr == 0) PG8_BAR;
    PG8_BAR;
#undef PG8_SA
#undef PG8_SB
#undef PG8_STAGE
#undef PG8_LDA
#undef PG8_LDB
#undef PG8_MMA
#undef PG8_WAIT_V
#undef PG8_WAIT_L
#undef PG8_BAR
#undef PG8_SCHED
}
}
using pg8::Unit;

__device__ __forceinline__ size_t g8_off(int row, int colg) { return ((size_t)(row >> 4) * 128 + (colg >> 5)) * 512 + (row & 15) * 32 + (colg & 31); }

struct EpiSwiglu {
    static constexpr bool HOOK = false;
    static constexpr bool PERM = true;
    bf16_t* HID;
    __device__ __forceinline__ void operator()(const f32x4 (&acc)[2][2][4][2], const Unit& u, int wr, int wc, int fr, int fq) const {
        { const int t_ = opaque_tid(); wr = t_ >> 8; wc = (t_ >> 6) & 3; fr = t_ & 15; fq = (t_ >> 4) & 3; }
        const int row0 = u.pm * 256 + wr * 64 + fr, col0 = u.pn * 128 + wc * 32 + 8 * fq;
#pragma unroll
        for (int ai = 0; ai < 2; ++ai)
#pragma unroll
            for (int m = 0; m < 4; ++m) {
                const int row = row0 + ai * 128 + m * 16;
                float hv[8];
#pragma unroll
                for (int n = 0; n < 2; ++n)
#pragma unroll
                    for (int j = 0; j < 4; ++j) { const float a = acc[ai][0][m][n][j], b = acc[ai][1][m][n][j]; hv[4 * n + j] = a * sigmoidf_(a) * b; }
                u32x4 w; w.x = cvt_pk_bf16(hv[0], hv[1]); w.y = cvt_pk_bf16(hv[2], hv[3]); w.z = cvt_pk_bf16(hv[4], hv[5]); w.w = cvt_pk_bf16(hv[6], hv[7]);
                *(u32x4*)(HID + (size_t)row * FH + col0) = w;
            }
    }
};
struct EpiResid {
    static constexpr bool HOOK = false;
    static constexpr bool PERM = false;
    float* Hl; float* Hc; const float* gate; float coef;
    __device__ __forceinline__ void operator()(const f32x4 (&acc)[2][2][4][2], const Unit& u, int wr, int wc, int fr, int fq) const {
        { const int t_ = opaque_tid(); wr = t_ >> 8; wc = (t_ >> 6) & 3; fr = t_ & 15; fq = (t_ >> 4) & 3; }
        const int row0 = u.pm * 256 + wr * 64 + fr, col0 = u.pn * 256 + wc * 32 + 4 * fq;
#pragma unroll
        for (int ai = 0; ai < 2; ++ai)
#pragma unroll
            for (int m = 0; m < 4; ++m) {
                const int row = row0 + ai * 128 + m * 16;
                float* hp = row < RL ? Hl + (size_t)row * 1024 : Hc + (size_t)(row - RL) * 1024;
                const float* gp = gate + (row < RL ? (row >> 13) : 4) * 9216;
#pragma unroll
                for (int bj = 0; bj < 2; ++bj)
#pragma unroll
                    for (int n = 0; n < 2; ++n) {
                        const int c = col0 + bj * 128 + n * 16;
                        const f32x4 g4 = *(const f32x4*)(gp + c); f32x4 h4 = *(const f32x4*)(hp + c);
                        h4 += (g4 * coef) * acc[ai][bj][m][n];
                        *(f32x4*)(hp + c) = h4;
                    }
            }
    }
};
struct EpiPartial {
    static constexpr bool HOOK = false;
    static constexpr bool PERM = false;
    float* PB; const float* gate; float coef;
    __device__ __forceinline__ void operator()(const f32x4 (&acc)[2][2][4][2], const Unit& u, int wr, int wc, int fr, int fq) const {
        { const int t_ = opaque_tid(); wr = t_ >> 8; wc = (t_ >> 6) & 3; fr = t_ & 15; fq = (t_ >> 4) & 3; }
        const int row0 = u.pm * 256 + wr * 64 + fr - RL, col0 = u.pn * 256 + wc * 32 + 4 * fq;
#pragma unroll
        for (int ai = 0; ai < 2; ++ai)
#pragma unroll
            for (int m = 0; m < 4; ++m) {
                float* hp = PB + (size_t)(row0 + ai * 128 + m * 16) * 1024;
#pragma unroll
                for (int bj = 0; bj < 2; ++bj)
#pragma unroll
                    for (int n = 0; n < 2; ++n) {
                        const int c = col0 + bj * 128 + n * 16;
                        const f32x4 g4 = *(const f32x4*)(gate + c);
                        *(f32x4*)(hp + c) = (g4 * coef) * acc[ai][bj][m][n];
                    }
            }
    }
};
struct EpiPJ {
    static constexpr bool HOOK = false;
    static constexpr bool PERM = true;
    bf16_t* PJ; unsigned char* G8;
    __device__ __forceinline__ void operator()(const f32x4 (&acc)[2][2][4][2], const Unit& u, int wr, int wc, int fr, int fq) const {
        { const int t_ = opaque_tid(); wr = t_ >> 8; wc = (t_ >> 6) & 3; fr = t_ & 15; fq = (t_ >> 4) & 3; }
        const int row0 = u.pm * 256 + wr * 64 + fr, c0 = wc * 32 + 8 * fq;
        if (u.pn < 9) {
#pragma unroll
            for (int ai = 0; ai < 2; ++ai)
#pragma unroll
                for (int m = 0; m < 4; ++m) {
                    const int row = row0 + ai * 128 + m * 16;
#pragma unroll
                    for (int bj = 0; bj < 2; ++bj) {
                        const f32x4 v0 = acc[ai][bj][m][0], v1 = acc[ai][bj][m][1];
                        u32x4 w; w.x = cvt_pk_bf16(v0[0], v0[1]); w.y = cvt_pk_bf16(v0[2], v0[3]); w.z = cvt_pk_bf16(v1[0], v1[1]); w.w = cvt_pk_bf16(v1[2], v1[3]);
                        *(u32x4*)(PJ + (size_t)row * PJW + u.pn * 256 + bj * 128 + c0) = w;
                    }
                }
        } else {
#pragma unroll
            for (int ai = 0; ai < 2; ++ai)
#pragma unroll
                for (int m = 0; m < 4; ++m) {
                    const int row = row0 + ai * 128 + m * 16;
#pragma unroll
                    for (int bj = 0; bj < 2; ++bj) {
                        unsigned q[8];
#pragma unroll
                        for (int n = 0; n < 2; ++n)
#pragma unroll
                            for (int j = 0; j < 4; ++j) { int v = (int)(sigmoidf_(acc[ai][bj][m][n][j]) * 256.0f); q[4 * n + j] = (unsigned)(v > 255 ? 255 : v); }
                        u32x2 w; w.x = q[0] | (q[1] << 8) | (q[2] << 16) | (q[3] << 24); w.y = q[4] | (q[5] << 8) | (q[6] << 16) | (q[7] << 24);
                        *(u32x2*)(G8 + g8_off(row, (u.pn - 9) * 256 + bj * 128 + c0)) = w;
                    }
                }
        }
    }
};
struct EpiMLA {
    static constexpr bool HOOK = false;
    static constexpr bool PERM = true;
    bf16_t *MQ, *MK, *MV; const float* RSTD; const float2* RT;
    __device__ __forceinline__ void operator()(const f32x4 (&acc)[2][2][4][2], const Unit& u, int wr, int wc, int fr, int fq) const {
        { const int t_ = opaque_tid(); wr = t_ >> 8; wc = (t_ >> 6) & 3; fr = t_ & 15; fq = (t_ >> 4) & 3; }
        const int row0 = u.pm * 256 + wr * 64 + fr;
#pragma unroll
        for (int bj = 0; bj < 2; ++bj) {
            const int cg0 = u.pn * 256 + bj * 128 + wc * 32;
            if (cg0 >= 896) continue;
#pragma unroll
            for (int ai = 0; ai < 2; ++ai)
#pragma unroll
                for (int m = 0; m < 4; ++m) {
                    __builtin_amdgcn_sched_barrier(0);
                    const int row = row0 + ai * 128 + m * 16;
                    float v[8];
                    if (cg0 < 384) {
                        const float rs = RSTD[row * 2];
#pragma unroll
                        for (int n = 0; n < 2; ++n)
#pragma unroll
                            for (int j = 0; j < 4; ++j) v[4 * n + j] = acc[ai][bj][m][n][j] * rs;
                        const int d0 = cg0 % 96;
                        if (d0 == 64) {
                            const bool lat = row < RL; const int t = row & 8191; const int pos = (fq >> 1) ? (t & 63) : (t >> 6); const bool isx2 = fq & 1;
#pragma unroll
                            for (int e = 0; e < 8; ++e) {
                                const float pr = shflx(v[e], 16);
                                const float2 cs = RT[pos * 8 + e];
                                const float r = isx2 ? (pr * cs.y + v[e] * cs.x) : (v[e] * cs.x - pr * cs.y);
                                v[e] = lat ? r : v[e];
                            }
                        }
                        u32x4 w; w.x = cvt_pk_bf16(v[0], v[1]); w.y = cvt_pk_bf16(v[2], v[3]); w.z = cvt_pk_bf16(v[4], v[5]); w.w = cvt_pk_bf16(v[6], v[7]);
                        *(u32x4*)(MQ + (size_t)row * 384 + cg0 + 8 * fq) = w;
                    } else {
                        const float rs = RSTD[row * 2 + 1];
#pragma unroll
                        for (int n = 0; n < 2; ++n)
#pragma unroll
                            for (int j = 0; j < 4; ++j) v[4 * n + j] = acc[ai][bj][m][n][j] * rs;
                        const int cp = cg0 - 384, hd = cp >> 7, d0 = cp & 127;
                        u32x4 w; w.x = cvt_pk_bf16(v[0], v[1]); w.y = cvt_pk_bf16(v[2], v[3]); w.z = cvt_pk_bf16(v[4], v[5]); w.w = cvt_pk_bf16(v[6], v[7]);
                        if (d0 < 64) *(u32x4*)(MK + (size_t)row * 384 + hd * 96 + d0 + 8 * fq) = w;
                        else *(u32x4*)(MV + (size_t)row * 256 + hd * 64 + (d0 - 64) + 8 * fq) = w;
                    }
                }
        }
    }
};
struct EpiMerge {
    static constexpr bool PERM = true, HOOK = true;
    const unsigned char* G8; bf16_t* MG;
    __device__ __forceinline__ void hook(f32x4 (&acc)[2][2][4][2], const Unit& u, int nb, int wr, int wc, int fr, int fq) const {
        { const int t_ = opaque_tid(); wr = t_ >> 8; wc = (t_ >> 6) & 3; fr = t_ & 15; fq = (t_ >> 4) & 3; }
        const int row0 = u.pm * 256 + wr * 64 + fr, c0 = u.pn * 256 + wc * 32 + 8 * fq;
#pragma unroll
        for (int ai = 0; ai < 2; ++ai) {
            u32x2 ga[4][2], gb[4][2];
#pragma unroll
            for (int m = 0; m < 4; ++m)
#pragma unroll
                for (int bj = 0; bj < 2; ++bj) { const int row = row0 + ai * 128 + m * 16, c = c0 + bj * 128;
                    ga[m][bj] = *(const u32x2*)(G8 + g8_off(row, (nb - 1) * 1024 + c)); gb[m][bj] = *(const u32x2*)(G8 + g8_off(row, nb * 1024 + c)); }
#pragma unroll
            for (int m = 0; m < 4; ++m)
#pragma unroll
                for (int bj = 0; bj < 2; ++bj)
#pragma unroll
                    for (int e = 0; e < 8; ++e) { const unsigned qa = ((e < 4 ? ga[m][bj].x : ga[m][bj].y) >> (8 * (e & 3))) & 255u, qb = ((e < 4 ? gb[m][bj].x : gb[m][bj].y) >> (8 * (e & 3))) & 255u;
                        acc[ai][bj][m][e >> 2][e & 3] *= ((float)qa + 0.5f) * fast_rcp((float)qb + 0.5f); }
            __builtin_amdgcn_sched_barrier(0);
        }
    }
    __device__ __forceinline__ void operator()(const f32x4 (&acc)[2][2][4][2], const Unit& u, int wr, int wc, int fr, int fq) const {
        { const int t_ = opaque_tid(); wr = t_ >> 8; wc = (t_ >> 6) & 3; fr = t_ & 15; fq = (t_ >> 4) & 3; }
        const int row0 = u.pm * 256 + wr * 64 + fr, c0 = u.pn * 256 + wc * 32 + 8 * fq;
#pragma unroll
        for (int ai = 0; ai < 2; ++ai) {
            u32x2 gq[4][2];
#pragma unroll
            for (int m = 0; m < 4; ++m)
#pragma unroll
                for (int bj = 0; bj < 2; ++bj) gq[m][bj] = *(const u32x2*)(G8 + g8_off(row0 + ai * 128 + m * 16, 3 * 1024 + c0 + bj * 128));
#pragma unroll
            for (int m = 0; m < 4; ++m)
#pragma unroll
                for (int bj = 0; bj < 2; ++bj) {
                    const int row = row0 + ai * 128 + m * 16, c = c0 + bj * 128;
                    float v[8];
#pragma unroll
                    for (int e = 0; e < 8; ++e) { const unsigned q = ((e < 4 ? gq[m][bj].x : gq[m][bj].y) >> (8 * (e & 3))) & 255u; v[e] = ((float)q + 0.5f) * (1.0f / 256.0f) * acc[ai][bj][m][e >> 2][e & 3]; }
                    u32x4 w; w.x = cvt_pk_bf16(v[0], v[1]); w.y = cvt_pk_bf16(v[2], v[3]); w.z = cvt_pk_bf16(v[4], v[5]); w.w = cvt_pk_bf16(v[6], v[7]);
                    *(u32x4*)(MG + (size_t)row * 1024 + c) = w;
                }
            __builtin_amdgcn_sched_barrier(0);
        }
    }
};

template <class F>
__device__ __forceinline__ void wt_rows64(bf16_t* dst, int K, F srcval, int ldd, int kbeg, int kend) {
    if (ldd == 0) ldd = K;
    if (kend > K) kend = K;
    const int tid_ = opaque_tid(); const int nl = tid_ & 63, kq = tid_ >> 6;
    for (int k0 = kbeg + kq * 8; k0 < kend; k0 += 64) {
        float v[8];
#pragma unroll
        for (int j = 0; j < 8; ++j) v[j] = srcval(nl, k0 + j);
        u32x4 w; w.x = cvt_pk_bf16(v[0], v[1]); w.y = cvt_pk_bf16(v[2], v[3]); w.z = cvt_pk_bf16(v[4], v[5]); w.w = cvt_pk_bf16(v[6], v[7]);
        *(u32x4*)(dst + (size_t)nl * ldd + k0) = w;
    }
}

__device__ void layer_prep_phase(PK p, int l, LAS unsigned char* lds) {
    unsigned char* ws = p->ws;
    const int nW = 1648, nItems = nW + (l == 0 ? 288 + 1 : 0);
    for (int it2 = opaque_bid(); it2 < nItems; it2 += opaque_gdim()) {
        int it, kbeg = 0, kend = 1 << 30;
        if (it2 < 704) { it = it2 >> 2; kbeg = (it2 & 3) * 256; kend = kbeg + 256; }
        else if (it2 < 1056) { const int q = it2 - 704; it = 176 + q / 11; kbeg = (q % 11) * 256; kend = kbeg + 256; }
        else if (it2 < 1456) { const int q = it2 - 1056; it = 208 + (q >> 2); kbeg = (q & 3) * 256; kend = kbeg + 256; }
        else if (it2 < 1520) { const int q = it2 - 1456; it = 308 + (q >> 2); kbeg = (q & 3) * 256; kend = kbeg + 256; }
        else if (it2 < 1568) { it = 324 + (it2 - 1520); }
        else if (it2 < 1632) { const int q = it2 - 1568; it = 372 + (q >> 2); kbeg = (q & 3) * 64; kend = kbeg + 64; }
        else if (it2 < 1648) { it = 388 + (it2 - 1632); }
        else it = 404 + (it2 - 1648);
        if (it < 176) {
            const int f = it / 88, j = it % 88; const float* src = p->ffn_w_in + ((size_t)(l * 2 + f) * 1024) * 5632;
            bf16_t* dst = (bf16_t*)(ws + OFF_W1) + ((size_t)f * 5632 + j * 64) * 1024;
            wt_rows64(dst, 1024, [&](int nl, int k) { const int np = j * 64 + nl, pn = np >> 8, wi = np & 255; const int col = wi < 128 ? pn * 128 + wi : FH + pn * 128 + (wi - 128); return src[(size_t)k * 5632 + col]; }, 0, kbeg, kend);
        } else if (it < 208) {
            const int q = it - 176, f = q / 16, j = q % 16; const float* src = p->ffn_w_out + ((size_t)(l * 2 + f) * FH) * 1024;
            bf16_t* dst = (bf16_t*)(ws + OFF_W2) + ((size_t)f * 1024 + j * 64) * FH;
            wt_rows64(dst, FH, [&](int nl, int k) { return src[(size_t)k * 1024 + j * 64 + nl]; }, 0, kbeg, kend);
        } else if (it < 308) {
            const int j = it - 208; const float* src = p->mix_w_in + (size_t)l * 1024 * 6304;
            bf16_t* dst = (bf16_t*)(ws + OFF_WM) + (size_t)j * 64 * 1024;
            wt_rows64(dst, 1024, [&](int nl, int k) { const int np = j * 64 + nl; const int col = np < 2208 ? np : (np < 2304 ? -1 : np - 96); return col < 0 ? 0.f : src[(size_t)k * 6304 + col]; }, 0, kbeg, kend);
        } else if (it < 324) {
            const int j = it - 308; const float* src = p->mix_w_out + (size_t)l * 1024 * 1024;
            bf16_t* dst = (bf16_t*)(ws + OFF_WO) + (size_t)j * 64 * 1024;
            wt_rows64(dst, 1024, [&](int nl, int k) { return src[(size_t)k * 1024 + j * 64 + nl]; }, 0, kbeg, kend);
        } else if (it < 372) {
            const int q = it - 324, bi = 1 + q / 16, j = q % 16; const float* src = p->branch_w_out + ((size_t)(l * 4 + bi) * 256) * 1024;
            bf16_t* dst = (bf16_t*)(ws + OFF_WB) + (size_t)j * 64 * 1024 + bi * 256;
            wt_rows64(dst, 256, [&](int nl, int k) { return src[(size_t)k * 1024 + j * 64 + nl]; }, 1024, kbeg, kend);
        } else if (it < 388) {
            const int j = it - 372; const float* wb = p->branch_w_out + ((size_t)(l * 4) * 256) * 1024; const float* pw = p->pool_w + (size_t)l * 4 * 64 * 64; const float* ps = p->pool_scale + l * 256;
            bf16_t* dst = (bf16_t*)(ws + OFF_WB) + (size_t)j * 64 * 1024;
            wt_rows64(dst, 256, [&](int nl, int k) { const int gI = k >> 6, n = j * 64 + nl; const float* pr = pw + (size_t)k * 64; float s = 0.f;
                for (int e = 0; e < 64; ++e) s += pr[e] * ps[gI * 64 + e] * wb[(size_t)(gI * 64 + e) * 1024 + n]; return s; }, 1024, kbeg, kend);
        } else if (it < 404) {
            const int j = it - 388; const float* wq = p->mla_w_qb + (size_t)l * 256 * 384; const float* wk = p->mla_w_kvb + (size_t)l * 128 * 512;
            const float* gq = p->mla_q_norm_g + l * 256; const float* gk = p->mla_kv_norm_g + l * 128;
            bf16_t* dst = (bf16_t*)(ws + OFF_WL) + (size_t)j * 64 * 384;
            wt_rows64(dst, 384, [&](int nl, int k) { const int n = j * 64 + nl;
                if (n < 384) return k < 256 ? gq[k] * wq[(size_t)k * 384 + n] : 0.f;
                if (n < 896) return k >= 256 ? gk[k - 256] * wk[(size_t)(k - 256) * 512 + (n - 384)] : 0.f;
                return 0.f; }, 0, kbeg, kend);
        } else if (it < 404 + 288) {
            const int q = it - 404, ll = q / 144, cb = q % 144;
            LAS float* sc = (LAS float*)lds;
            LAS float* red = (LAS float*)(lds + 5 * 1024 * 4);
            __syncthreads();
            for (int i = opaque_tid(); i < 5 * 1024; i += 512) { const int r = i >> 10, k = i & 1023; const float cv = r < 4 ? p->c[r * 1024 + k] : p->c_ctx[k]; sc[i] = cv * sigmoidf_(cv); }
            __syncthreads();
            const int jl = opaque_tid() & 63, kg = opaque_tid() >> 6; const int col = cb * 64 + jl;
            const float* wsrc = p->ada_w + (size_t)ll * 1024 * 9216 + col;
            float a0 = 0.f, a1 = 0.f, a2 = 0.f, a3 = 0.f, a4 = 0.f;
            for (int k = kg * 128; k < kg * 128 + 128; ++k) { const float wv = wsrc[(size_t)k * 9216]; a0 += sc[k] * wv; a1 += sc[1024 + k] * wv; a2 += sc[2048 + k] * wv; a3 += sc[3072 + k] * wv; a4 += sc[4096 + k] * wv; }
            red[(kg * 5 + 0) * 64 + jl] = a0; red[(kg * 5 + 1) * 64 + jl] = a1; red[(kg * 5 + 2) * 64 + jl] = a2; red[(kg * 5 + 3) * 64 + jl] = a3; red[(kg * 5 + 4) * 64 + jl] = a4;
            __syncthreads();
            if (opaque_tid() < 320) { const int r = opaque_tid() >> 6; float s = p->ada_b[ll * 9216 + col];
                for (int q2 = 0; q2 < 8; ++q2) s += red[(q2 * 5 + r) * 64 + jl];
                ((float*)(ws + OFF_MOD))[(size_t)(ll * 5 + r) * 9216 + col] = s; }
        } else {
            for (int i = opaque_tid(); i < 1024; i += 512) { const int pos = i >> 3, fi = i & 7; const float inv = exp2f(-(float)fi * 0.125f * 13.287712379549449f); const float ang = (float)pos * inv;
                ((float2*)(ws + OFF_ROPE))[i] = make_float2(cosf(ang), sinf(ang)); }
        }
    }
}

__device__ void norm_mod_phase(const float* srcL, const float* srcC, float* cpyL, float* cpyC, const float* g, const float* mod, bf16_t* TN, int nrows, const float* pb, int nsl) {
    const int tid_ = opaque_tid(); const int lane = tid_ & 63, gw = opaque_bid() * 8 + (tid_ >> 6), nw = opaque_gdim() * 8;
    for (int row = gw; row < nrows; row += nw) {
        const bool lat = row < RL;
        const float* sp = lat ? srcL + (size_t)row * 1024 : srcC + (size_t)(row - RL) * 1024;
        const float* mp = mod + (lat ? (row >> 13) : 4) * 9216;
        f32x4 v[4]; float ss = 0.f;
#pragma unroll
        for (int j = 0; j < 4; ++j) v[j] = *(const f32x4*)(sp + 256 * j + 4 * lane);
        if (!lat && nsl > 0) {
            for (int sl = 0; sl < nsl; ++sl) { const float* pp = pb + ((size_t)sl * 1024 + (row - RL)) * 1024;
#pragma unroll
                for (int j = 0; j < 4; ++j) v[j] += *(const f32x4*)(pp + 256 * j + 4 * lane); }
            float* wp = (float*)sp;
#pragma unroll
            for (int j = 0; j < 4; ++j) *(f32x4*)(wp + 256 * j + 4 * lane) = v[j];
        }
#pragma unroll
        for (int j = 0; j < 4; ++j) ss += v[j][0] * v[j][0] + v[j][1] * v[j][1] + v[j][2] * v[j][2] + v[j][3] * v[j][3];
        if (cpyL) { float* cp = lat ? cpyL + (size_t)row * 1024 : cpyC + (size_t)(row - RL) * 1024;
#pragma unroll
            for (int j = 0; j < 4; ++j) *(f32x4*)(cp + 256 * j + 4 * lane) = v[j]; }
        ss = wave_sum(ss);
        const float rstd = rsqrtf(ss * (1.0f / 1024.0f) + NEPS);
#pragma unroll
        for (int j = 0; j < 4; ++j) {
            const int col = 256 * j + 4 * lane;
            const f32x4 gg = *(const f32x4*)(g + col), sh = *(const f32x4*)(mp + col), sc = *(const f32x4*)(mp + 1024 + col);
            float o[4];
#pragma unroll
            for (int e = 0; e < 4; ++e) o[e] = (v[j][e] * rstd * gg[e]) * (1.0f + sc[e]) + sh[e];
            u32x2 w; w.x = cvt_pk_bf16(o[0], o[1]); w.y = cvt_pk_bf16(o[2], o[3]);
            *(u32x2*)(TN + (size_t)row * 1024 + col) = w;
        }
    }
}
__device__ void final_norm_phase(float* H, const float* g) {
    const int tid_ = opaque_tid(); const int lane = tid_ & 63, gw = opaque_bid() * 8 + (tid_ >> 6), nw = opaque_gdim() * 8;
    for (int row = gw; row < RL; row += nw) {
        float* sp = H + (size_t)row * 1024; f32x4 v[4]; float ss = 0.f;
#pragma unroll
        for (int j = 0; j < 4; ++j) { v[j] = *(const f32x4*)(sp + 256 * j + 4 * lane); ss += v[j][0] * v[j][0] + v[j][1] * v[j][1] + v[j][2] * v[j][2] + v[j][3] * v[j][3]; }
        ss = wave_sum(ss);
        const float rstd = rsqrtf(ss * (1.0f / 1024.0f) + NEPS);
#pragma unroll
        for (int j = 0; j < 4; ++j) { const f32x4 gg = *(const f32x4*)(g + 256 * j + 4 * lane); *(f32x4*)(sp + 256 * j + 4 * lane) = v[j] * rstd * gg; }
    }
}

__device__ void prep_phase(PK p) {
    unsigned char* ws = p->ws;
    bf16_t* PJ = (bf16_t*)(ws + OFF_B); bf16_t* YB = (bf16_t*)(ws + OFF_A); bf16_t* MK = (bf16_t*)(ws + OFF_MK); float* RSTD = (float*)(ws + OFF_RSTD);
    const float2* RT = (const float2*)(ws + OFF_ROPE);
    const int tid_ = opaque_tid(); const int lane = tid_ & 63, gw = opaque_bid() * 8 + (tid_ >> 6), nw = opaque_gdim() * 8;
    for (int row = gw; row < RA; row += nw) {
        const bool lat = row < RL;
        int t, n; if (lat) { t = row & 8191; n = 8192; } else { t = (row - RL) & 255; n = 256; }
        const int sbase = row - t;
        bf16_t* prow = PJ + (size_t)row * PJW;
        {
            const int wdw = 2 << (lane >> 4), hw = wdw >> 1; const int lo = max(t - hw, 0), hi = min(t + hw, n);
            float s0 = 0.f, s1 = 0.f, s2 = 0.f, s3 = 0.f;
#pragma unroll
            for (int i = 0; i < 16; ++i) {
                const int off = i - 8, tt = t + off; const bool ok = (off >= -hw) && (off < hw) && (tt >= 0) && (tt < n);
                const u32x2 v = *(const u32x2*)(PJ + (size_t)(sbase + (ok ? tt : t)) * PJW + 4 * lane); const float wg = ok ? 1.0f : 0.0f;
                s0 += wg * bf_lo(v.x); s1 += wg * bf_hi(v.x); s2 += wg * bf_lo(v.y); s3 += wg * bf_hi(v.y); }
            const float ic = 1.0f / (float)(hi - lo); const u32x2 sv = *(const u32x2*)(prow + 4 * lane);
            u32x2 w; w.x = cvt_pk_bf16(s0 * ic - bf_lo(sv.x), s1 * ic - bf_hi(sv.x)); w.y = cvt_pk_bf16(s2 * ic - bf_lo(sv.y), s3 * ic - bf_hi(sv.y));
            *(u32x2*)(YB + (size_t)row * 1024 + 4 * lane) = w;
        }
        {
            const u32x2 q = *(const u32x2*)(prow + C_MQ + 4 * lane); const unsigned kv = *(const unsigned*)(prow + C_MKV + 2 * lane);
            float sq = bf_lo(q.x) * bf_lo(q.x) + bf_hi(q.x) * bf_hi(q.x) + bf_lo(q.y) * bf_lo(q.y) + bf_hi(q.y) * bf_hi(q.y);
            float sk = bf_lo(kv) * bf_lo(kv) + bf_hi(kv) * bf_hi(kv);
            sq = wave_sum(sq); sk = wave_sum(sk);
            if (lane == 0) { RSTD[row * 2] = rsqrtf(sq * (1.0f / 256.0f) + NEPS); RSTD[row * 2 + 1] = rsqrtf(sk * (1.0f / 128.0f) + NEPS); }
        }
        if (lane < 34) {
            const bool iskr = lane >= 32; const int a = lane & 1;
            bf16_t* ep = iskr ? prow + C_MKR + a * 16 : prow + ((lane >> 4) ? C_DK : C_DQ) + ((lane >> 1) & 7) * 32 + a * 16;
            const u32x4 e0 = *(const u32x4*)ep, e1 = *(const u32x4*)(ep + 8);
            float x1[8], x2[8];
            x1[0] = bf_lo(e0.x); x1[1] = bf_hi(e0.x); x1[2] = bf_lo(e0.y); x1[3] = bf_hi(e0.y); x1[4] = bf_lo(e0.z); x1[5] = bf_hi(e0.z); x1[6] = bf_lo(e0.w); x1[7] = bf_hi(e0.w);
            x2[0] = bf_lo(e1.x); x2[1] = bf_hi(e1.x); x2[2] = bf_lo(e1.y); x2[3] = bf_hi(e1.y); x2[4] = bf_lo(e1.z); x2[5] = bf_hi(e1.z); x2[6] = bf_lo(e1.w); x2[7] = bf_hi(e1.w);
            if (lat) { const int pos = a ? (t & 63) : (t >> 6);
#pragma unroll
                for (int i = 0; i < 8; ++i) { const float2 cs = RT[pos * 8 + i]; const float o1 = x1[i] * cs.x - x2[i] * cs.y, o2 = x1[i] * cs.y + x2[i] * cs.x; x1[i] = o1; x2[i] = o2; } }
            u32x4 w0, w1; w0.x = cvt_pk_bf16(x1[0], x1[1]); w0.y = cvt_pk_bf16(x1[2], x1[3]); w0.z = cvt_pk_bf16(x1[4], x1[5]); w0.w = cvt_pk_bf16(x1[6], x1[7]);
            w1.x = cvt_pk_bf16(x2[0], x2[1]); w1.y = cvt_pk_bf16(x2[2], x2[3]); w1.z = cvt_pk_bf16(x2[4], x2[5]); w1.w = cvt_pk_bf16(x2[6], x2[7]);
            if (iskr) {
#pragma unroll
                for (int hh = 0; hh < 4; ++hh) { bf16_t* kp = MK + (size_t)row * 384 + hh * 96 + 64 + a * 16; *(u32x4*)kp = w0; *(u32x4*)(kp + 8) = w1; }
            } else if (lat) { *(u32x4*)ep = w0; *(u32x4*)(ep + 8) = w1; }
        }
    }
}

#define MFMA32(a, b, c) __builtin_amdgcn_mfma_f32_32x32x16_bf16((a), (b), (c), 0, 0, 0)
typedef float f32x2 __attribute__((ext_vector_type(2)));
template <int MODE>
__device__ __forceinline__ void attn_item(PK p, int l, LAS unsigned char* lds, int b, int h, int qb, bool ctxq, float lam, float lam_init) {
    constexpr int NCOMP = (MODE == 1) ? 2 : 1, NKS = (MODE == 0) ? 4 : ((MODE == 1) ? 2 : 6), KW = NCOMP * NKS * 16, KCH = KW / 8, KSTR = KW * 2 + 16, VSTR = 192;
    constexpr int KBUF = 64 * KSTR, VBUF = 64 * VSTR, BUFSZ = KBUF + VBUF, BIAS_OFF = 3 * BUFSZ;
    constexpr bool STAG = (MODE != 0);
    const int tid = opaque_tid(), w = tid >> 6, lane = tid & 63, g = lane >> 5, l32 = lane & 31;
    unsigned char* ws = p->ws;
    const bf16_t* PJ = (const bf16_t*)(ws + OFF_B);
    const bf16_t *Qp, *Kp, *Vp; int ldq, ldk, ldv, outoff; float scale;
    if (MODE == 0) { Qp = PJ + C_NQ + 64 * h; Kp = PJ + C_NK + 64 * h; Vp = PJ + C_NV + 64 * h; ldq = ldk = ldv = PJW; outoff = 256 + 64 * h; scale = 0.125f; }
    else if (MODE == 1) { Qp = PJ + C_DQ + 64 * h; Kp = PJ + C_DK + 64 * h; Vp = PJ + C_DV + 64 * h; ldq = ldk = ldv = PJW; outoff = 512 + 64 * h; scale = 0.17677669529663687f; }
    else { Qp = (const bf16_t*)(ws + OFF_D) + 96 * h; Kp = (const bf16_t*)(ws + OFF_MK) + 96 * h; Vp = (const bf16_t*)(ws + OFF_MV) + 64 * h; ldq = ldk = 384; ldv = 256; outoff = 768 + 64 * h; scale = 0.10206207261596575f; }
    const float cs = scale * LOG2E;
    int qrow0, loc0, nloc;
    if (ctxq) { qrow0 = RL + b * 256; loc0 = 0; nloc = 0; }
    else { qrow0 = b * 8192 + qb * 256;
        if (MODE == 0) { const int r0 = qb * 4; loc0 = clampi(r0 - 4, 0, 120); nloc = clampi(r0 - 1, 0, 120) + 8 - loc0; } else { loc0 = 0; nloc = 128; } }
    const int nt = nloc + 4;
    const bool nabias = (MODE == 0) && !ctxq;
    constexpr bool PIPE = (MODE == 2);
    const bool late = STAG && !PIPE && (w >= 4);
    const int rw = qb * 4 + (w >> 1), sw = clampi(rw - 4, 0, 120);
    const int jq = 32 * (w & 1) + l32, cst = clampi(jq - 8, 0, 48);
    if (nabias && tid < 465) ((LAS float*)(lds + BIAS_OFF))[tid] = p->na_rpb[(size_t)(l * 4 + h) * 465 + tid] * LOG2E;

    const size_t qrow = (size_t)qrow0 + 32 * w + l32;
    bf16x8 qf[NCOMP * NKS];
#pragma unroll
    for (int i = 0; i < NCOMP * NKS; ++i) {
        const u32x4 raw = *(const u32x4*)(Qp + qrow * ldq + 16 * i + 8 * g);
        u32x4 sc4; sc4.x = cvt_pk_bf16(bf_lo(raw.x) * cs, bf_hi(raw.x) * cs); sc4.y = cvt_pk_bf16(bf_lo(raw.y) * cs, bf_hi(raw.y) * cs);
        sc4.z = cvt_pk_bf16(bf_lo(raw.z) * cs, bf_hi(raw.z) * cs); sc4.w = cvt_pk_bf16(bf_lo(raw.w) * cs, bf_hi(raw.w) * cs);
        qf[i] = __builtin_bit_cast(bf16x8, sc4);
    }

    const int kr0 = tid / KCH, kc0 = tid % KCH, kr1 = (tid + 512) / KCH, kc1 = (tid + 512) % KCH, vr = tid >> 3, vc = tid & 7;
    const bool hask1 = (KCH == 12) && (tid < 256);
    u32x4 rk0, rk1 = (u32x4){0u, 0u, 0u, 0u}, rv;
#define TILE_ROW(t) ((t) < nloc ? (b * 8192 + 64 * (loc0 + (t))) : (RL + b * 256 + 64 * ((t) - nloc)))
#define LOAD_TILE(t) do { const size_t _tb = (size_t)TILE_ROW(t); rk0 = *(const u32x4*)(Kp + (_tb + kr0) * ldk + kc0 * 8); \
        if (hask1) rk1 = *(const u32x4*)(Kp + (_tb + kr1) * ldk + kc1 * 8); rv = *(const u32x4*)(Vp + (_tb + vr) * ldv + vc * 8); } while (0)
#define STORE_TILE(buf) do { LAS unsigned char* _kb = lds + (buf) * BUFSZ; *(LAS u32x4*)(_kb + kr0 * KSTR + kc0 * 16) = rk0; \
        if (hask1) *(LAS u32x4*)(_kb + kr1 * KSTR + kc1 * 16) = rk1; *(LAS u32x4*)(_kb + KBUF + vr * VSTR + vc * 16) = rv; } while (0)

    float mrun[NCOMP], lsum[NCOMP]; f32x16 O[NCOMP][2];
#pragma unroll
    for (int c = 0; c < NCOMP; ++c) { mrun[c] = -1e30f; lsum[c] = 0.f;
#pragma unroll
        for (int dt = 0; dt < 2; ++dt)
#pragma unroll
            for (int r = 0; r < 16; ++r) O[c][dt][r] = 0.f; }
    bf16x8 P[NCOMP][2][2];
#pragma unroll
    for (int c = 0; c < NCOMP; ++c)
#pragma unroll
        for (int kt = 0; kt < 2; ++kt)
#pragma unroll
            for (int s2 = 0; s2 < 2; ++s2) P[c][kt][s2] = (bf16x8){0, 0, 0, 0, 0, 0, 0, 0};

    LOAD_TILE(0); STORE_TILE(0); __syncthreads();
    const int koff = l32 * KSTR + g * 16;
    const int i16 = lane & 15, tq = i16 >> 2, tp = i16 & 3, blk = (lane >> 4) & 1;
    const int voff = (4 * g + tq) * VSTR + (16 * blk + 4 * tp) * 2;
#define PV_TILE(buf) do { LAS unsigned char* _vb = lds + (buf) * BUFSZ + KBUF + voff; \
        _Pragma("unroll") for (int kt = 0; kt < 2; ++kt) { bf16x8 vf[2][2]; \
            _Pragma("unroll") for (int s2 = 0; s2 < 2; ++s2) _Pragma("unroll") for (int dt = 0; dt < 2; ++dt) { LAS unsigned char* vp = _vb + (32 * kt + 16 * s2) * VSTR + dt * 64; \
                const s16x4 lo = __builtin_amdgcn_ds_read_tr16_b64_v4i16((LAS s16x4*)vp); const s16x4 hi = __builtin_amdgcn_ds_read_tr16_b64_v4i16((LAS s16x4*)(vp + 8 * VSTR)); \
                vf[s2][dt] = __builtin_shufflevector(lo, hi, 0, 1, 2, 3, 4, 5, 6, 7); } \
            __builtin_amdgcn_s_setprio(1); \
            _Pragma("unroll") for (int s2 = 0; s2 < 2; ++s2) _Pragma("unroll") for (int dt = 0; dt < 2; ++dt) _Pragma("unroll") for (int c = 0; c < NCOMP; ++c) O[c][dt] = MFMA32(vf[s2][dt], P[c][kt][s2], O[c][dt]); \
            __builtin_amdgcn_s_setprio(0); } } while (0)

#define PV_TILE_C(buf, cc) do { LAS unsigned char* _vb = lds + (buf) * BUFSZ + KBUF + voff; \
        _Pragma("unroll") for (int kt = 0; kt < 2; ++kt) { bf16x8 vf[2][2]; \
            _Pragma("unroll") for (int s2 = 0; s2 < 2; ++s2) _Pragma("unroll") for (int dt = 0; dt < 2; ++dt) { LAS unsigned char* vp = _vb + (32 * kt + 16 * s2) * VSTR + dt * 64; \
                const s16x4 lo = __builtin_amdgcn_ds_read_tr16_b64_v4i16((LAS s16x4*)vp); const s16x4 hi = __builtin_amdgcn_ds_read_tr16_b64_v4i16((LAS s16x4*)(vp + 8 * VSTR)); \
                vf[s2][dt] = __builtin_shufflevector(lo, hi, 0, 1, 2, 3, 4, 5, 6, 7); } \
            __builtin_amdgcn_s_setprio(1); \
            _Pragma("unroll") for (int s2 = 0; s2 < 2; ++s2) _Pragma("unroll") for (int dt = 0; dt < 2; ++dt) O[cc][dt] = MFMA32(vf[s2][dt], P[cc][kt][s2], O[cc][dt]); \
            __builtin_amdgcn_s_setprio(0); } } while (0)
    bf16x8 Pold[NCOMP][2][2];
#pragma unroll
    for (int c = 0; c < NCOMP; ++c)
#pragma unroll
        for (int kt = 0; kt < 2; ++kt)
#pragma unroll
            for (int s2 = 0; s2 < 2; ++s2) Pold[c][kt][s2] = (bf16x8){0, 0, 0, 0, 0, 0, 0, 0};
#define PV_TILE_OLD(buf) do { LAS unsigned char* _vb = lds + (buf) * BUFSZ + KBUF + voff; \
        _Pragma("unroll") for (int kt = 0; kt < 2; ++kt) { bf16x8 vf[2][2]; \
            _Pragma("unroll") for (int s2 = 0; s2 < 2; ++s2) _Pragma("unroll") for (int dt = 0; dt < 2; ++dt) { LAS unsigned char* vp = _vb + (32 * kt + 16 * s2) * VSTR + dt * 64; \
                const s16x4 lo = __builtin_amdgcn_ds_read_tr16_b64_v4i16((LAS s16x4*)vp); const s16x4 hi = __builtin_amdgcn_ds_read_tr16_b64_v4i16((LAS s16x4*)(vp + 8 * VSTR)); \
                vf[s2][dt] = __builtin_shufflevector(lo, hi, 0, 1, 2, 3, 4, 5, 6, 7); } \
            _Pragma("unroll") for (int s2 = 0; s2 < 2; ++s2) _Pragma("unroll") for (int dt = 0; dt < 2; ++dt) _Pragma("unroll") for (int c = 0; c < NCOMP; ++c) O[c][dt] = MFMA32(vf[s2][dt], Pold[c][kt][s2], O[c][dt]); } } while (0)
    bool pend = false, zref = false; int pbuf = 0, cbuf = 0;
    for (int t = 0; t < nt; ++t) {
        const bool more = (t + 1 < nt);
        if (more) LOAD_TILE(t + 1);
        bool active = true; int krow = 0;
        if (nabias && t < nloc) { krow = loc0 + t; active = (krow >= sw) && (krow < sw + 8); }
        bool slow = (MODE == 0) || (t == 0);
        if (active) {
          again:
            LAS unsigned char* Kb = lds + cbuf * BUFSZ + koff;
            f32x16 S[NCOMP][2];
#pragma unroll
            for (int c = 0; c < NCOMP; ++c)
#pragma unroll
                for (int kt = 0; kt < 2; ++kt) {
                    bf16x8 kf[NKS];
#pragma unroll
                    for (int ks = 0; ks < NKS; ++ks) kf[ks] = *(const LAS bf16x8*)(Kb + kt * 32 * KSTR + (c * NKS + ks) * 32);
#pragma unroll
                    for (int r = 0; r < 16; ++r) S[c][kt][r] = 0.f;
                    __builtin_amdgcn_s_setprio(1);
#pragma unroll
                    for (int ks = 0; ks < NKS; ++ks) S[c][kt] = MFMA32(kf[ks], qf[c * NKS + ks], S[c][kt]);
                    __builtin_amdgcn_s_setprio(0);
                }
            if (STAG && late && pend) { PV_TILE(pbuf); pend = false; }
            float mxc[NCOMP], mnw[NCOMP];
            if (!slow) {
#pragma unroll
                for (int c = 0; c < NCOMP; ++c) mnw[c] = mrun[c];
            } else {
#pragma unroll
            for (int c = 0; c < NCOMP; ++c) {
                float mx = -1e30f;
                if (nabias && t < nloc) {
                    const LAS float* bt = (const LAS float*)(lds + BIAS_OFF) + (krow - rw + 7) * 31;
#pragma unroll
                    for (int kt = 0; kt < 2; ++kt)
#pragma unroll
                        for (int r = 0; r < 16; ++r) { const int jk = 32 * kt + (r & 3) + 8 * (r >> 2) + 4 * g; const bool ok = (jk >= cst) && (jk < cst + 16);
                            const float bv = bt[clampi(jk - jq + 15, 0, 30)]; const float xv = ok ? (S[c][kt][r] + bv) : -1e30f; S[c][kt][r] = xv; mx = fmaxf(mx, xv); }
                } else {
#pragma unroll
                    for (int kt = 0; kt < 2; ++kt)
#pragma unroll
                        for (int r = 0; r < 16; r += 2) mx = fmaxf(fmaxf(mx, S[c][kt][r]), S[c][kt][r + 1]);
                }
                mxc[c] = mx;
            }
#pragma unroll
            for (int c = 0; c < NCOMP; ++c) mxc[c] = fmaxf(mxc[c], shflx(mxc[c], 32));
            bool grow = false;
#pragma unroll
            for (int c = 0; c < NCOMP; ++c) { mnw[c] = fmaxf(mrun[c], mxc[c]); grow = grow || (mnw[c] > mrun[c]); }
            if (MODE != 0) {
                bool big = false;
#pragma unroll
                for (int c = 0; c < NCOMP; ++c) big = big || !(fabsf(mnw[c]) < 40.0f);
                zref = (t == 0) && !__any(big);
                if (zref) {
#pragma unroll
                    for (int c = 0; c < NCOMP; ++c) mnw[c] = 0.0f; }
            }
            if (__any(grow)) {
#pragma unroll
                for (int c = 0; c < NCOMP; ++c) { const float alpha = fast_exp2(mrun[c] - mnw[c]); lsum[c] *= alpha;
#pragma unroll
                    for (int dt = 0; dt < 2; ++dt) O[c][dt] *= alpha;
                    mrun[c] = mnw[c]; }
            }
            }
            if (!zref) {
#pragma unroll
            for (int c = 0; c < NCOMP; ++c) { const f32x2 m2 = (f32x2){mnw[c], mnw[c]};
#pragma unroll
                for (int kt = 0; kt < 2; ++kt)
#pragma unroll
                    for (int r = 0; r < 16; r += 2) { const f32x2 d = (f32x2){S[c][kt][r], S[c][kt][r + 1]} - m2; S[c][kt][r] = d.x; S[c][kt][r + 1] = d.y; } }
            }
            if (PIPE) PV_TILE_OLD(pbuf);
#pragma unroll
            for (int c = 0; c < NCOMP; ++c)
#pragma unroll
                for (int kt = 0; kt < 2; ++kt)
#pragma unroll
                    for (int r = 0; r < 16; ++r) S[c][kt][r] = fast_exp2(S[c][kt][r]);
#pragma unroll
            for (int c = 0; c < NCOMP; ++c) { f32x2 rs2 = (f32x2){0.f, 0.f};
#pragma unroll
                for (int kt = 0; kt < 2; ++kt)
#pragma unroll
                    for (int s2 = 0; s2 < 2; ++s2) { u32x4 pk;
#pragma unroll
                        for (int e = 0; e < 4; ++e) { const f32x2 ev = (f32x2){S[c][kt][8 * s2 + 2 * e], S[c][kt][8 * s2 + 2 * e + 1]}; rs2 += ev; pk[e] = cvt_pk_bf16(ev.x, ev.y); }
                        P[c][kt][s2] = __builtin_bit_cast(bf16x8, pk); }
                mxc[c] = rs2.x + rs2.y; }
            if (PIPE) {
                __builtin_amdgcn_sched_group_barrier(0x100, 16, 0);
#pragma unroll
                for (int i = 0; i < 8; ++i) { __builtin_amdgcn_sched_group_barrier(0x008, 1, 0); __builtin_amdgcn_sched_group_barrier(0x400, 4, 0); __builtin_amdgcn_sched_group_barrier(0x002, 4, 0); }
            }
            if (!slow) { bool bad = false;
#pragma unroll
                for (int c = 0; c < NCOMP; ++c) bad = bad || !(mxc[c] < 1.0e18f);
                if (__any(bad)) { slow = true;
                    if (PIPE) {
#pragma unroll
                        for (int c = 0; c < NCOMP; ++c)
#pragma unroll
                            for (int kt = 0; kt < 2; ++kt)
#pragma unroll
                                for (int s2 = 0; s2 < 2; ++s2) Pold[c][kt][s2] = (bf16x8){0, 0, 0, 0, 0, 0, 0, 0}; }
                    goto again; } }
#pragma unroll
            for (int c = 0; c < NCOMP; ++c) lsum[c] += mxc[c];
            if (PIPE) {
#pragma unroll
                for (int c = 0; c < NCOMP; ++c)
#pragma unroll
                    for (int kt = 0; kt < 2; ++kt)
#pragma unroll
                        for (int s2 = 0; s2 < 2; ++s2) Pold[c][kt][s2] = P[c][kt][s2];
                pbuf = cbuf;
            } else {
            if (!(STAG && late)) PV_TILE(cbuf);
            if (STAG && late) { pend = true; pbuf = cbuf; }
            }
        }
        const int nbuf = (cbuf == 2) ? 0 : cbuf + 1;
        if (more) STORE_TILE(nbuf);
        __syncthreads();
        cbuf = nbuf;
    }
    if (STAG && late && pend) PV_TILE(pbuf);
    if (PIPE) PV_TILE_OLD(pbuf);
#undef PV_TILE_OLD
#undef PV_TILE
#undef PV_TILE_C
#undef TILE_ROW
#undef LOAD_TILE
#undef STORE_TILE
    float inv[NCOMP];
#pragma unroll
    for (int c = 0; c < NCOMP; ++c) { const float lt = lsum[c] + shflx(lsum[c], 32); inv[c] = 1.0f / lt; }
    bf16_t* op = (bf16_t*)(ws + OFF_A) + qrow * 1024 + outoff;
    if (MODE == 1) {
        const float li1 = lam * inv[NCOMP - 1]; float ss = 0.f;
#pragma unroll
        for (int dt = 0; dt < 2; ++dt)
#pragma unroll
            for (int r = 0; r < 16; ++r) { const float o = O[0][dt][r] * inv[0] - li1 * O[NCOMP - 1][dt][r]; O[0][dt][r] = o; ss += o * o; }
        ss += shflx(ss, 32);
        const float rstd = rsqrtf(ss * (1.0f / 64.0f) + NEPS) * (1.0f - lam_init);
        const float* sg = p->diff_subln_g + l * 64;
#pragma unroll
        for (int dt = 0; dt < 2; ++dt)
#pragma unroll
            for (int rq = 0; rq < 4; ++rq) { const int dv = 32 * dt + 8 * rq + 4 * g; const f32x4 gg = *(const f32x4*)(sg + dv);
                u32x2 wv; wv.x = cvt_pk_bf16(O[0][dt][4 * rq] * rstd * gg[0], O[0][dt][4 * rq + 1] * rstd * gg[1]); wv.y = cvt_pk_bf16(O[0][dt][4 * rq + 2] * rstd * gg[2], O[0][dt][4 * rq + 3] * rstd * gg[3]);
                *(u32x2*)(op + dv) = wv; }
    } else {
#pragma unroll
        for (int dt = 0; dt < 2; ++dt)
#pragma unroll
            for (int rq = 0; rq < 4; ++rq) { const int dv = 32 * dt + 8 * rq + 4 * g;
                u32x2 wv; wv.x = cvt_pk_bf16(O[0][dt][4 * rq] * inv[0], O[0][dt][4 * rq + 1] * inv[0]); wv.y = cvt_pk_bf16(O[0][dt][4 * rq + 2] * inv[0], O[0][dt][4 * rq + 3] * inv[0]);
                *(u32x2*)(op + dv) = wv; }
    }
    __syncthreads();
}

__device__ void attn_phase(PK p, int l, LAS unsigned char* lds) {
    const float lam_init = (l == 0) ? 0.2f : 0.35550906759502f;
    const float* dl = p->diff_lambda + l * 128;
    float d01 = 0.f, d23 = 0.f;
    for (int i = 0; i < 32; ++i) { d01 += dl[i] * dl[32 + i]; d23 += dl[64 + i] * dl[96 + i]; }
    const float lam = expf(d01) - expf(d23) + lam_init;
    const int nItems = 1536 + (l == 0 ? 48 : 0);
    for (int it = opaque_bid(); it < nItems; it += opaque_gdim()) {
        if (it < 1536) {
            const int ty = it >> 9, idx = it & 511, bh = ((idx & 7) << 1) | (idx >> 8), b = bh >> 2, h = bh & 3, qb = (idx >> 3) & 31;
            if (ty == 0) attn_item<1>(p, l, lds, b, h, qb, false, lam, lam_init);
            else if (ty == 1) attn_item<2>(p, l, lds, b, h, qb, false, lam, lam_init);
            else attn_item<0>(p, l, lds, b, h, qb, false, lam, lam_init);
        } else {
            const int idx = it - 1536, ty = idx >> 4, b = (idx >> 2) & 3, h = idx & 3;
            if (ty == 0) attn_item<1>(p, l, lds, b, h, 0, true, lam, lam_init);
            else if (ty == 1) attn_item<2>(p, l, lds, b, h, 0, true, lam, lam_init);
            else attn_item<0>(p, l, lds, b, h, 0, true, lam, lam_init);
        }
    }
}

constexpr int PH_PER_LAYER = 14, N_PHASES = 2 * PH_PER_LAYER + 1;

__device__ __forceinline__ void run_phase(PK p, int ph, LAS unsigned char* lds, float rcoef) {
    unsigned char* ws = p->ws;
    pg8::StaticOrder S;
    if (ph == N_PHASES - 1) { final_norm_phase(p->out, p->final_norm_g); return; }
    int l = ph / PH_PER_LAYER; const int q = ph % PH_PER_LAYER;
#define OPQL asm volatile("" : "+s"(l))
#define HC ((float*)(ws + OFF_HC))
#define MOD ((const float*)(ws + OFF_MOD) + (size_t)l * 5 * 9216)
#define TN ((bf16_t*)(ws + OFF_A))
#define HID ((bf16_t*)(ws + OFF_B))
#define Mlate ((l == 0) ? RA : RL)
    switch (q) {
    case 0: OPQL; layer_prep_phase(p, l, lds); break;
    case 1: OPQL; if (l == 0) norm_mod_phase(p->x, p->ctx, p->out, HC, p->norm_g + (l * 3 + 0) * 1024, MOD, TN, RA, nullptr, 0);
            else norm_mod_phase(p->out, HC, nullptr, nullptr, p->norm_g + (l * 3 + 0) * 1024, MOD, TN, RA, (const float*)(ws + OFF_PB), 11); break;
    case 2: case 12: { OPQL; const int f = (q == 2) ? 0 : 1; const int M = (q == 2) ? RA : Mlate;
        pg8::Gemm g{TN, (const bf16_t*)(ws + OFF_W1) + (size_t)f * 5632 * 1024, M, 5632, 1024, 1024, 1024}; S.init(M, 5632, opaque_gdim(), opaque_bid());
        EpiSwiglu E{HID}; pg8::gemm_phase(lds, g, S, E); } break;
    case 4: OPQL; norm_mod_phase(p->out, HC, nullptr, nullptr, p->norm_g + (l * 3 + 1) * 1024, MOD + 3 * 1024, TN, RA, (const float*)(ws + OFF_PB), 11); break;
    case 5: { OPQL; pg8::Gemm g{TN, (const bf16_t*)(ws + OFF_WM), RA, 6400, 1024, 1024, 1024}; S.init(RA, 6400, opaque_gdim(), opaque_bid());
        EpiPJ E{(bf16_t*)(ws + OFF_B), ws + OFF_C}; pg8::gemm_phase(lds, g, S, E); } break;
    case 6: prep_phase(p); break;
    case 7: { OPQL; pg8::Gemm g{(const bf16_t*)(ws + OFF_B) + C_MQ, (const bf16_t*)(ws + OFF_WL), RA, 1024, 384, PJW, 384}; S.init(RA, 1024, opaque_gdim(), opaque_bid());
        EpiMLA E{(bf16_t*)(ws + OFF_D), (bf16_t*)(ws + OFF_MK), (bf16_t*)(ws + OFF_MV), (const float*)(ws + OFF_RSTD), (const float2*)(ws + OFF_ROPE)}; pg8::gemm_phase(lds, g, S, E); } break;
    case 8: OPQL; attn_phase(p, l, lds); break;
    case 9: { OPQL; pg8::Gemm g{(const bf16_t*)(ws + OFF_A), (const bf16_t*)(ws + OFF_WB), Mlate, 1024, 1024, 1024, 1024}; S.init(Mlate, 1024, opaque_gdim(), opaque_bid());
        EpiMerge E{ws + OFF_C, (bf16_t*)(ws + OFF_D)}; pg8::gemm_phase(lds, g, S, E); } break;
    case 3: case 13: case 10: { OPQL;
        const bool isout = (q == 10); const int f = (q == 13) ? 1 : 0;
        const bf16_t* A = isout ? (const bf16_t*)(ws + OFF_D) : (const bf16_t*)HID;
        const bf16_t* Bt = isout ? (const bf16_t*)(ws + OFF_WO) : (const bf16_t*)(ws + OFF_W2) + (size_t)f * 1024 * FH;
        const int K = isout ? 1024 : FH;
        const float* gate = MOD + (isout ? 5 : (q == 3 ? 2 : 8)) * 1024;
        const float coef = (isout ? 1.0f : 0.5f) * rcoef;
        const bool withctx = (q == 3) || (l == 0);
        { pg8::Gemm g{A, Bt, RL, 1024, K, K, K}; S.init(RL, 1024, opaque_gdim(), opaque_bid());
          EpiResid E{p->out, HC, gate, coef}; pg8::gemm_phase(lds, g, S, E); }
        if (withctx) {
            const int nsu = 16 * (K / 256);
            for (int su = opaque_bid(); su < nsu; su += opaque_gdim()) {
                const int ks = su >> 4, pmn = su & 15;
                pg8::SingleUnit SU; SU.pm = 128 + (pmn >> 2); SU.pn = pmn & 3; SU.has = true;
                pg8::Gemm g2{A + ks * 256, Bt + ks * 256, RA, 1024, 256, K, K};
                EpiPartial E2{(float*)(ws + OFF_PB) + (size_t)ks * 1024 * 1024, gate + 4 * 9216, coef}; pg8::gemm_phase(lds, g2, SU, E2);
            }
        }
    } break;
    case 11: OPQL; norm_mod_phase(p->out, HC, nullptr, nullptr, p->norm_g + (l * 3 + 2) * 1024, MOD + 6 * 1024, TN, Mlate, (const float*)(ws + OFF_PB), 4); break;
    }
#undef OPQL
#undef HC
#undef MOD
#undef TN
#undef HID
#undef Mlate
}

__global__ void __launch_bounds__(512, 2) fwd_megakernel(Params p) {
    extern __shared__ __attribute__((aligned(16))) unsigned char shm[];
    LAS unsigned char* lds = (LAS unsigned char*)shm;
#if N_LAUNCH_MODE == 1
    cg::grid_group grid = cg::this_grid();
    const int ph_lo = p.ph_lo, ph_hi = p.ph_hi;
    volatile LAS unsigned* st = (volatile LAS unsigned*)(lds + pg8::STAGE_BYTES);
    unsigned* bar = (unsigned*)(p.ws + OFF_BAR);
    if (opaque_tid() < 4) st[opaque_tid()] = 0u;
    if (opaque_bid() == 0) for (int i = opaque_tid(); i < XCD_BAR_WORDS; i += 512) bar[i] = 0u;
    __syncthreads();
#if PROBE_Q >= 0
    const int nseq = 2 * (PH_PER_LAYER + 1) + 1;
    for (int i = 0; i < nseq; ++i) {
        int ph;
        if (i == nseq - 1) ph = N_PHASES - 1;
        else { const int li = i / (PH_PER_LAYER + 1), r = i % (PH_PER_LAYER + 1); ph = li * PH_PER_LAYER + (r <= PROBE_Q ? r : r - 1); }
        PK pk = (PK)__builtin_amdgcn_kernarg_segment_ptr();
        asm volatile("" : "+s"(pk));
        run_phase(pk, ph, lds, 1.0f);
        if (i == 0) { grid.sync(); xcd_barrier_post(bar); }
        else if (i + 1 < nseq) xcd_barrier(bar, st);
    }
#else
    for (int ph = ph_lo; ph < ph_hi; ++ph) {
        PK pk = (PK)__builtin_amdgcn_kernarg_segment_ptr();
        asm volatile("" : "+s"(pk));
        run_phase(pk, ph, lds, 1.0f);
        if (ph == ph_lo) { grid.sync(); xcd_barrier_post(bar); }
        else if (ph + 1 < ph_hi) xcd_barrier(bar, st);
    }
#endif
#else
    const int ph_lo = p.ph_lo, ph_hi = p.ph_hi;
    for (int ph = ph_lo; ph < ph_hi; ++ph) { PK pk = (PK)__builtin_amdgcn_kernarg_segment_ptr(); asm volatile("" : "+s"(pk)); run_phase(pk, ph, lds, 1.0f); }
#endif
}

extern "C" void kernel_launch(void* const* d_in, const int* in_sizes, int n_in, void* d_out, int out_size, void* d_ws, size_t ws_size, hipStream_t stream) {
    constexpr int LDS_BYTES = pg8::STAGE_BYTES + 16;
    static int grid_blocks = 0;
    if (grid_blocks == 0) {
        if (n_in != 22 || ws_size < WS_END) { fprintf(stderr, "kernel_launch: unexpected inputs (n_in %d, ws %zu < %zu)\n", n_in, ws_size, (size_t)WS_END); grid_blocks = -1; return; }
        int dev = 0, cus = 0, per_cu = 0;
        hipGetDevice(&dev); hipDeviceGetAttribute(&cus, hipDeviceAttributeMultiprocessorCount, dev);
        if (hipFuncSetAttribute((const void*)fwd_megakernel, hipFuncAttributeMaxDynamicSharedMemorySize, LDS_BYTES) != hipSuccess) { fprintf(stderr, "hipFuncSetAttribute failed\n"); grid_blocks = -1; return; }
        if (hipOccupancyMaxActiveBlocksPerMultiprocessor(&per_cu, (const void*)fwd_megakernel, 512, LDS_BYTES) != hipSuccess || per_cu < 1) per_cu = 1;
        (void)hipGetLastError();
        grid_blocks = cus * 1;
    }
    if (grid_blocks < 0) return;
    Params hp{};
    const float** pp = (const float**)&hp;
    for (int i = 0; i < 22; ++i) pp[i] = (const float*)d_in[i];
    hp.out = (float*)d_out; hp.ws = (unsigned char*)d_ws;
#if N_LAUNCH_MODE == 1
    hp.ph_lo = 0; hp.ph_hi = N_PHASES;
    void* args[] = {&hp};
    hipError_t e = hipLaunchCooperativeKernel((const void*)fwd_megakernel, dim3(grid_blocks), dim3(512), args, LDS_BYTES, stream);
    if (e != hipSuccess) fprintf(stderr, "cooperative launch failed: %s (grid %d)\n", hipGetErrorString(e), grid_blocks);
#else
    for (int ph = 0; ph < N_PHASES; ++ph) { hp.ph_lo = ph; hp.ph_hi = ph + 1; hipLaunchKernelGGL(fwd_megakernel, dim3(grid_blocks), dim3(512), LDS_BYTES, stream, hp); }
#endif
}
```

```cpp
#include <hip/hip_runtime.h>
#include <hip/hip_cooperative_groups.h>
#include <cstdio>
namespace cg = cooperative_groups;

#define LAS __attribute__((address_space(3)))
typedef unsigned short bf16_t;
typedef short bf16x8 __attribute__((ext_vector_type(8)));
typedef short s16x4 __attribute__((ext_vector_type(4)));
typedef float f32x4 __attribute__((ext_vector_type(4)));
typedef float f32x16 __attribute__((ext_vector_type(16)));
typedef unsigned u32x4 __attribute__((ext_vector_type(4)));
typedef unsigned u32x2 __attribute__((ext_vector_type(2)));

#ifndef PROBE_Q
#define PROBE_Q (-1)
#endif
#ifndef N_LAUNCH_MODE
#define N_LAUNCH_MODE 1
#endif

constexpr int RL = 32768, RA = 33792, FH = 2816;
constexpr int PJW = 2304;
constexpr int C_NQ = 256, C_NK = 512, C_NV = 768, C_DQ = 1024, C_DK = 1280, C_DV = 1536, C_MQ = 1792, C_MKV = 2048, C_MKR = 2176;
constexpr float LOG2E = 1.4426950408889634f;
constexpr float NEPS = 1e-6f;
constexpr int XCD_BAR_WORDS_C = 3456;

constexpr size_t SZ_W1 = 2ull * 5632 * 1024 * 2, SZ_W2 = 2ull * 1024 * 2816 * 2, SZ_WM = 6400ull * 1024 * 2, SZ_WL = 1024ull * 384 * 2, SZ_WB = 4ull * 1024 * 256 * 2, SZ_WO = 1024ull * 1024 * 2;
constexpr size_t OFF_W1 = 0, OFF_W2 = OFF_W1 + SZ_W1, OFF_WM = OFF_W2 + SZ_W2, OFF_WL = OFF_WM + SZ_WM, OFF_WB = OFF_WL + SZ_WL, OFF_WO = OFF_WB + SZ_WB;
constexpr size_t OFF_HC = OFF_WO + SZ_WO;
constexpr size_t OFF_MOD = OFF_HC + 1024ull * 1024 * 4;
constexpr size_t OFF_ROPE = OFF_MOD + 2ull * 5 * 9216 * 4;
constexpr size_t OFF_RSTD = OFF_ROPE + 128 * 8 * 8;
constexpr size_t OFF_A = OFF_RSTD + (size_t)RA * 2 * 4;
constexpr size_t OFF_B = OFF_A + (size_t)RA * 1024 * 2;
constexpr size_t OFF_C = OFF_B + (size_t)RA * PJW * 2;
constexpr size_t OFF_D = OFF_C + (size_t)RA * 4096;
constexpr size_t OFF_MK = OFF_D + (size_t)RA * 384 * 2, OFF_MV = OFF_MK + (size_t)RA * 384 * 2;
constexpr size_t OFF_BAR = OFF_D + (size_t)RA * 1024 * 2;
constexpr size_t OFF_PB = OFF_BAR + 16384;
constexpr size_t WS_END = OFF_PB + 11ull * 1024 * 1024 * 4;

struct Params {
    const float *x, *c, *ctx, *c_ctx, *ada_w, *ada_b, *norm_g, *ffn_w_in, *ffn_w_out, *mix_w_in, *pool_w, *pool_scale, *na_rpb, *diff_lambda, *diff_subln_g,
        *mla_q_norm_g, *mla_kv_norm_g, *mla_w_qb, *mla_w_kvb, *branch_w_out, *mix_w_out, *final_norm_g;
    float* out; unsigned char* ws;
    int ph_lo, ph_hi;
};

typedef const __attribute__((address_space(4))) Params* PK;

typedef float f32x2_ __attribute__((ext_vector_type(2)));
typedef __bf16 bf16x2_ __attribute__((ext_vector_type(2)));
__device__ __forceinline__ unsigned cvt_pk_bf16(float lo, float hi) { const f32x2_ v = {lo, hi}; return __builtin_bit_cast(unsigned, __builtin_convertvector(v, bf16x2_)); }
__device__ __forceinline__ float bf_lo(unsigned u) { return __uint_as_float(u << 16); }
__device__ __forceinline__ float bf_hi(unsigned u) { return __uint_as_float(u & 0xffff0000u); }
__device__ __forceinline__ float fast_exp2(float x) { return __builtin_amdgcn_exp2f(x); }
__device__ __forceinline__ float fast_rcp(float x) { return __builtin_amdgcn_rcpf(x); }
__device__ __forceinline__ float sigmoidf_(float x) { return fast_rcp(1.0f + fast_exp2(-x * LOG2E)); }
__device__ __forceinline__ float shflx(float v, int m) {
    int lane = __builtin_amdgcn_mbcnt_hi(~0u, __builtin_amdgcn_mbcnt_lo(~0u, 0)); asm volatile("" : "+v"(lane));
    return __int_as_float(__builtin_amdgcn_ds_bpermute((lane ^ m) << 2, __float_as_int(v)));
}
__device__ __forceinline__ float wave_sum(float v) {
    v += shflx(v, 32); v += shflx(v, 16); v += shflx(v, 8); v += shflx(v, 4); v += shflx(v, 2); v += shflx(v, 1); return v;
}
__device__ __forceinline__ int opaque_tid() { int t = threadIdx.x; asm volatile("" : "+v"(t)); return t; }
__device__ __forceinline__ int opaque_bid() { int t = blockIdx.x; asm volatile("" : "+s"(t)); return t; }
__device__ __forceinline__ int opaque_gdim() { int t = gridDim.x; asm volatile("" : "+s"(t)); return t; }
__device__ __forceinline__ int clampi(int v, int lo, int hi) { return v < lo ? lo : (v > hi ? hi : v); }

#define XB_TMO      128
#define XB_XCNT(j)  (256  + 64 * (j))
#define XB_XSUB(j)  (1280 + 64 * (j))
#define XB_XGEN(j)  (2304 + 64 * (j))
#define XB_TOP      3328
#define XB_TOPGEN   3392
#define XCD_BAR_WORDS 3456
#define XB_SPIN_CAP (1u << 20)
__device__ __forceinline__ unsigned xb_ld(unsigned* p)              { return __hip_atomic_load(p, __ATOMIC_RELAXED, __HIP_MEMORY_SCOPE_AGENT); }
__device__ __forceinline__ unsigned xb_add(unsigned* p, unsigned v) { return __hip_atomic_fetch_add(p, v, __ATOMIC_RELAXED, __HIP_MEMORY_SCOPE_AGENT); }
__device__ __forceinline__ unsigned xb_xcc_id() { return (unsigned)__builtin_amdgcn_s_getreg((3 << 11) | 20) & 0xFu; }
#define XB_SPIN(cond, bar) do { unsigned _sp = 0; while (cond) { __builtin_amdgcn_s_sleep(1); \
    if ((++_sp & 255u) == 0u) { if (xb_ld(&(bar)[XB_TMO])) break; if (_sp > XB_SPIN_CAP) { atomicAdd(&(bar)[XB_TMO], 1u); break; } } } } while (0)
__device__ __forceinline__ void xcd_barrier_post(unsigned* bar) { if (opaque_tid() == 0) (void)xb_add(&bar[XB_XCNT(xb_xcc_id())], 1u); }
__device__ __forceinline__ void xcd_barrier_complete(unsigned* bar, unsigned x, unsigned& nloc, unsigned& nx) {
    const unsigned G = gridDim.x;
    unsigned sum, cnt, mine, sp = 0u;
    for (;;) {
        sum = 0u; cnt = 0u; mine = 0u;
#pragma unroll
        for (unsigned j = 0; j < 16; ++j) { const unsigned c = xb_ld(&bar[XB_XCNT(j)]); sum += c; cnt += (c > 0u) ? 1u : 0u; mine = (j == x) ? c : mine; }
        if (sum == G) break;
        __builtin_amdgcn_s_sleep(1);
        if ((++sp & 255u) == 0u) { if (xb_ld(&bar[XB_TMO])) break; if (sp > XB_SPIN_CAP) { atomicAdd(&bar[XB_TMO], 1u); break; } }
    }
    nloc = mine > 0u ? mine : 1u; nx = cnt > 0u ? cnt : 1u;
}
__device__ __forceinline__ void xcd_barrier(unsigned* bar, volatile LAS unsigned* st) {
    asm volatile("s_waitcnt vmcnt(0)" ::: "memory");
    __syncthreads();
    if (opaque_tid() == 0) {
        const unsigned x = xb_xcc_id();
        __builtin_amdgcn_s_waitcnt(0);
        unsigned nloc = st[0], nx = st[1];
        if (nloc == 0u) { xcd_barrier_complete(bar, x, nloc, nx); st[0] = nloc; st[1] = nx; }
        const unsigned old = xb_add(&bar[XB_XSUB(x)], 1u);
        const unsigned gen = old / nloc;
        if (old + 1u == (gen + 1u) * nloc) {
            __builtin_amdgcn_fence(__ATOMIC_RELEASE, "agent");
            asm volatile("s_waitcnt vmcnt(0)" ::: "memory");
            const unsigned og = xb_add(&bar[XB_TOP], 1u);
            const unsigned tg = og / nx;
            if (og + 1u == (tg + 1u) * nx) xb_add(&bar[XB_TOPGEN], 1u);
            else XB_SPIN(xb_ld(&bar[XB_TOPGEN]) == tg, bar);
            __builtin_amdgcn_fence(__ATOMIC_ACQUIRE, "agent");
            xb_add(&bar[XB_XGEN(x)], 1u);
            asm volatile("s_waitcnt vmcnt(0)" ::: "memory");
        } else {
            XB_SPIN(xb_ld(&bar[XB_XGEN(x)]) == gen, bar);
            __builtin_amdgcn_fence(__ATOMIC_ACQUIRE, "agent");
            asm volatile("s_waitcnt vmcnt(0)" ::: "memory");
        }
    }
    __syncthreads();
}

namespace pg8 {
constexpr int BM = 256, BK = 64, HALF = 128, HTB = HALF * BK * 2, STAGE_BYTES = 8 * HTB, NXCD = 8, WGM = 8;
__device__ __forceinline__ int lds_byte(int r, int c) { const int st = (r >> 4) * 2 + (c >> 5), rr = r & 15, cc = c & 31, ob = rr * 64 + cc * 2; return st * 1024 + (ob ^ (((ob >> 9) & 1) << 5)); }
__device__ __forceinline__ void stage_rc(int b, int& R, int& C) { const int st = b / 1024, sb = b % 1024, swz = sb ^ (((sb >> 9) & 1) << 5); R = (st >> 1) * 16 + swz / 64; C = (st & 1) * 32 + (swz % 64) / 2; }
__device__ __forceinline__ int perm32(int rho) { const int n = rho >> 4, i = rho & 15; return 8 * (i >> 2) + 4 * n + (i & 3); }
struct Unit { int pm, pn; };
struct Gemm { const bf16_t* A; const bf16_t* Bt; int M, N, K, lda, ldb; };
struct StaticOrder {
    int nM, nN, nwg, G, c;
    __device__ void init(int M, int N, int G_, int c_) { nM = M / BM; nN = N / BM; nwg = nM * nN; G = G_; c = c_; }
    __device__ bool next(int i, Unit& u) const {
        const long L = (long)i * G + c; if (L >= nwg) return false;
        int wgid = (int)L; { const int q = nwg / NXCD, r = nwg % NXCD, xcd = wgid % NXCD, off = wgid / NXCD; wgid = (xcd < r ? xcd * (q + 1) : r * (q + 1) + (xcd - r) * q) + off; }
        const int nig = WGM * nN, gid = wgid / nig, fm = gid * WGM, gsz = (nM - fm) < WGM ? (nM - fm) : WGM;
        u.pm = fm + ((wgid % nig) % gsz); u.pn = (wgid % nig) / gsz; return true;
    }
};

struct SingleUnit {
    int pm, pn; bool has;
    __device__ bool next(int i, Unit& u) const { if (i > 0 || !has) return false; u.pm = pm; u.pn = pn; return true; }
};
template <class Epi, class Sched>
__device__ __forceinline__ void gemm_phase(LAS unsigned char* lds, const Gemm g, const Sched& S, const Epi& E) {
    const int tid = opaque_tid(), wid = __builtin_amdgcn_readfirstlane(tid >> 6), lane = tid & 63, wr = wid >> 2, wc = wid & 3, fr = lane & 15, fq = lane >> 4;
    const int K = g.K, nt = K / BK;
    unsigned voffA[2], voffB[2];
#pragma unroll
    for (int i = 0; i < 2; ++i) { int R, C; stage_rc(tid * 16 + i * 8192, R, C); const int Rb = Epi::PERM ? ((R & ~31) + perm32(R & 31)) : R;
        voffA[i] = (unsigned)(R * g.lda + C) * 2u; voffB[i] = (unsigned)(Rb * g.ldb + C) * 2u; }
    const size_t kstep = (size_t)(BK * 2);
    const size_t hstepA = (size_t)HALF * g.lda * 2, hstepB = (size_t)HALF * g.ldb * 2;
    const size_t tstepA = 2 * hstepA, tstepB = 2 * hstepB;
    const unsigned ldsw = (unsigned)wid * 1024u;
    const int aoff = lds_byte(wr * 64 + fr, fq * 8), boff = lds_byte(wc * 32 + fr, fq * 8);
#define PG8_SA(b, h) (((b) * 2 + (h)) * HTB)
#define PG8_SB(b, h) ((4 + (b) * 2 + (h)) * HTB)
#define PG8_STAGE(bufoff, gbase, voff) do { _Pragma("unroll") for (int _i = 0; _i < 2; ++_i) \
        __builtin_amdgcn_global_load_lds((const unsigned*)((const char*)(gbase) + (voff)[_i]), (LAS unsigned*)(lds + (bufoff) + ldsw + _i * 8192), 16, 0, 0); } while (0)
#define PG8_LDA(dst, b, h) do { _Pragma("unroll") for (int m = 0; m < 4; ++m) _Pragma("unroll") for (int k = 0; k < 2; ++k) dst[m][k] = *(const LAS bf16x8*)(lds + PG8_SA(b, h) + aoff + m * 2048 + k * 1024); } while (0)
#define PG8_LDB(dst, b, h) do { _Pragma("unroll") for (int n = 0; n < 2; ++n) _Pragma("unroll") for (int k = 0; k < 2; ++k) dst[n][k] = *(const LAS bf16x8*)(lds + PG8_SB(b, h) + boff + n * 2048 + k * 1024); } while (0)
#define PG8_MMA(ai, bj, At, Bt) do { __builtin_amdgcn_s_setprio(1); _Pragma("unroll") for (int m = 0; m < 4; ++m) _Pragma("unroll") for (int n = 0; n < 2; ++n) _Pragma("unroll") for (int k = 0; k < 2; ++k) \
        acc[ai][bj][m][n] = __builtin_amdgcn_mfma_f32_16x16x32_bf16(Bt[n][k], At[m][k], acc[ai][bj][m][n], 0, 0, 0); __builtin_amdgcn_s_setprio(0); } while (0)
#define PG8_WAIT_V(n) asm volatile("s_waitcnt vmcnt(" #n ")" ::: "memory")
#define PG8_WAIT_L(n) asm volatile("s_waitcnt lgkmcnt(" #n ")" ::: "memory")
#define PG8_BAR __builtin_amdgcn_s_barrier()
#define PG8_SCHED __builtin_amdgcn_sched_barrier(0)
    Unit cur, nxt; int ui = 0;
    if (!S.next(0, cur)) return;
    f32x4 acc[2][2][4][2];
#pragma unroll
    for (int a = 0; a < 2; ++a)
#pragma unroll
        for (int b = 0; b < 2; ++b)
#pragma unroll
            for (int m = 0; m < 4; ++m)
#pragma unroll
                for (int n = 0; n < 2; ++n) acc[a][b][m][n] = (f32x4){0.f, 0.f, 0.f, 0.f};
    bf16x8 At[4][2], B0[2][2], B1[2][2];
    const char* cA = (const char*)g.A + (size_t)cur.pm * tstepA; const char* cB = (const char*)g.Bt + (size_t)cur.pn * tstepB;
    PG8_STAGE(PG8_SB(0, 0), cB, voffB); PG8_STAGE(PG8_SA(0, 0), cA, voffA); PG8_STAGE(PG8_SB(0, 1), cB + hstepB, voffB); PG8_STAGE(PG8_SA(0, 1), cA + hstepA, voffA);
    if (wr == 1) PG8_BAR;
    PG8_WAIT_V(4); PG8_BAR;
    PG8_STAGE(PG8_SB(1, 0), cB + kstep, voffB); PG8_STAGE(PG8_SA(1, 0), cA + kstep, voffA); PG8_STAGE(PG8_SB(1, 1), cB + hstepB + kstep, voffB);
    PG8_WAIT_V(6); PG8_BAR;
    for (;;) {
        const bool has_next = S.next(ui + 1, nxt);
        const char* nA = has_next ? (const char*)g.A + (size_t)nxt.pm * tstepA : cA; const char* nB = has_next ? (const char*)g.Bt + (size_t)nxt.pn * tstepB : cB;
        for (int t = 0; t < nt; t += 2) {
            const bool last = (t == nt - 2);
            const char* a1 = cA + (size_t)(t + 1) * kstep;
            const char* a2 = last ? nA : cA + (size_t)(t + 2) * kstep; const char* b2 = last ? nB : cB + (size_t)(t + 2) * kstep;
            const char* a3 = a2 + kstep; const char* b3 = b2 + kstep;
            PG8_LDB(B0, 0, 0); PG8_SCHED; PG8_LDA(At, 0, 0); PG8_STAGE(PG8_SA(1, 1), a1 + hstepA, voffA);
            PG8_WAIT_L(8); PG8_BAR; PG8_WAIT_L(0); PG8_MMA(0, 0, At, B0); PG8_BAR; PG8_SCHED;
            PG8_LDB(B1, 0, 1); PG8_STAGE(PG8_SB(0, 0), b2, voffB);
            PG8_BAR; PG8_WAIT_L(0); PG8_MMA(0, 1, At, B1); PG8_BAR;
            PG8_LDA(At, 0, 1); PG8_STAGE(PG8_SA(0, 0), a2, voffA);
            PG8_BAR; PG8_WAIT_L(0); PG8_MMA(1, 0, At, B0); PG8_BAR; PG8_SCHED;
            PG8_STAGE(PG8_SB(0, 1), b2 + hstepB, voffB);
            PG8_WAIT_V(6); PG8_BAR; PG8_MMA(1, 1, At, B1); PG8_BAR;
            PG8_LDB(B0, 1, 0); PG8_SCHED; PG8_LDA(At, 1, 0); PG8_STAGE(PG8_SA(0, 1), a2 + hstepA, voffA);
            PG8_WAIT_L(8); PG8_BAR; PG8_WAIT_L(0); PG8_MMA(0, 0, At, B0); PG8_BAR; PG8_SCHED;
            PG8_LDB(B1, 1, 1); PG8_STAGE(PG8_SB(1, 0), b3, voffB);
            PG8_BAR; PG8_WAIT_L(0); PG8_MMA(0, 1, At, B1); PG8_BAR;
            PG8_LDA(At, 1, 1); PG8_STAGE(PG8_SA(1, 0), a3, voffA);
            PG8_BAR; PG8_WAIT_L(0); PG8_MMA(1, 0, At, B0); PG8_BAR; PG8_SCHED;
            PG8_STAGE(PG8_SB(1, 1), b3 + hstepB, voffB);
            PG8_WAIT_V(6); PG8_BAR; PG8_MMA(1, 1, At, B1); PG8_BAR;
            if constexpr (Epi::HOOK) { if ((((t + 2) & 3) == 0) && !last) E.hook(acc, cur, (t + 2) >> 2, wr, wc, fr, fq); }
        }
        E(acc, cur, wr, wc, fr, fq);
        if (!has_next) break;
#pragma unroll
        for (int a = 0; a < 2; ++a)
#pragma unroll
            for (int b = 0; b < 2; ++b)
#pragma unroll
                for (int m = 0; m < 4; ++m)
#pragma unroll
                    for (int n = 0; n < 2; ++n) acc[a][b][m][n] = (f32x4){0.f, 0.f, 0.f, 0.f};
        cur = nxt; cA = nA; cB = nB; ++ui;
    }
    PG8_WAIT_V(0);
    if (wr == 0) PG8_BAR;
    PG8_BAR;
#undef PG8_SA
#undef PG8_SB
#undef PG8_STAGE
#undef PG8_LDA
#undef PG8_LDB
#undef PG8_MMA
#undef PG8_WAIT_V
#undef PG8_WAIT_L
#undef PG8_BAR
#undef PG8_SCHED
}
}
using pg8::Unit;

__device__ __forceinline__ size_t g8_off(int row, int colg) { return ((size_t)(row >> 4) * 128 + (colg >> 5)) * 512 + (row & 15) * 32 + (colg & 31); }

struct EpiSwiglu {
    static constexpr bool HOOK = false;
    static constexpr bool PERM = true;
    bf16_t* HID;
    __device__ __forceinline__ void operator()(const f32x4 (&acc)[2][2][4][2], const Unit& u, int wr, int wc, int fr, int fq) const {
        { const int t_ = opaque_tid(); wr = t_ >> 8; wc = (t_ >> 6) & 3; fr = t_ & 15; fq = (t_ >> 4) & 3; }
        const int row0 = u.pm * 256 + wr * 64 + fr, col0 = u.pn * 128 + wc * 32 + 8 * fq;
#pragma unroll
        for (int ai = 0; ai < 2; ++ai)
#pragma unroll
            for (int m = 0; m < 4; ++m) {
                const int row = row0 + ai * 128 + m * 16;
                float hv[8];
#pragma unroll
                for (int n = 0; n < 2; ++n)
#pragma unroll
                    for (int j = 0; j < 4; ++j) { const float a = acc[ai][0][m][n][j], b = acc[ai][1][m][n][j]; hv[4 * n + j] = a * sigmoidf_(a) * b; }
                u32x4 w; w.x = cvt_pk_bf16(hv[0], hv[1]); w.y = cvt_pk_bf16(hv[2], hv[3]); w.z = cvt_pk_bf16(hv[4], hv[5]); w.w = cvt_pk_bf16(hv[6], hv[7]);
                *(u32x4*)(HID + (size_t)row * FH + col0) = w;
            }
    }
};
struct EpiResid {
    static constexpr bool HOOK = false;
    static constexpr bool PERM = false;
    float* Hl; float* Hc; const float* gate; float coef;
    __device__ __forceinline__ void operator()(const f32x4 (&acc)[2][2][4][2], const Unit& u, int wr, int wc, int fr, int fq) const {
        { const int t_ = opaque_tid(); wr = t_ >> 8; wc = (t_ >> 6) & 3; fr = t_ & 15; fq = (t_ >> 4) & 3; }
        const int row0 = u.pm * 256 + wr * 64 + fr, col0 = u.pn * 256 + wc * 32 + 4 * fq;
#pragma unroll
        for (int ai = 0; ai < 2; ++ai)
#pragma unroll
            for (int m = 0; m < 4; ++m) {
                const int row = row0 + ai * 128 + m * 16;
                float* hp = row < RL ? Hl + (size_t)row * 1024 : Hc + (size_t)(row - RL) * 1024;
                const float* gp = gate + (row < RL ? (row >> 13) : 4) * 9216;
#pragma unroll
                for (int bj = 0; bj < 2; ++bj)
#pragma unroll
                    for (int n = 0; n < 2; ++n) {
                        const int c = col0 + bj * 128 + n * 16;
                        const f32x4 g4 = *(const f32x4*)(gp + c); f32x4 h4 = *(const f32x4*)(hp + c);
                        h4 += (g4 * coef) * acc[ai][bj][m][n];
                        *(f32x4*)(hp + c) = h4;
                    }
            }
    }
};
struct EpiPartial {
    static constexpr bool HOOK = false;
    static constexpr bool PERM = false;
    float* PB; const float* gate; float coef;
    __device__ __forceinline__ void operator()(const f32x4 (&acc)[2][2][4][2], const Unit& u, int wr, int wc, int fr, int fq) const {
        { const int t_ = opaque_tid(); wr = t_ >> 8; wc = (t_ >> 6) & 3; fr = t_ & 15; fq = (t_ >> 4) & 3; }
        const int row0 = u.pm * 256 + wr * 64 + fr - RL, col0 = u.pn * 256 + wc * 32 + 4 * fq;
#pragma unroll
        for (int ai = 0; ai < 2; ++ai)
#pragma unroll
            for (int m = 0; m < 4; ++m) {
                float* hp = PB + (size_t)(row0 + ai * 128 + m * 16) * 1024;
#pragma unroll
                for (int bj = 0; bj < 2; ++bj)
#pragma unroll
                    for (int n = 0; n < 2; ++n) {
                        const int c = col0 + bj * 128 + n * 16;
                        const f32x4 g4 = *(const f32x4*)(gate + c);
                        *(f32x4*)(hp + c) = (g4 * coef) * acc[ai][bj][m][n];
                    }
            }
    }
};
struct EpiPJ {
    static constexpr bool HOOK = false;
    static constexpr bool PERM = true;
    bf16_t* PJ; unsigned char* G8;
    __device__ __forceinline__ void operator()(const f32x4 (&acc)[2][2][4][2], const Unit& u, int wr, int wc, int fr, int fq) const {
        { const int t_ = opaque_tid(); wr = t_ >> 8; wc = (t_ >> 6) & 3; fr = t_ & 15; fq = (t_ >> 4) & 3; }
        const int row0 = u.pm * 256 + wr * 64 + fr, c0 = wc * 32 + 8 * fq;
        if (u.pn < 9) {
#pragma unroll
            for (int ai = 0; ai < 2; ++ai)
#pragma unroll
                for (int m = 0; m < 4; ++m) {
                    const int row = row0 + ai * 128 + m * 16;
#pragma unroll
                    for (int bj = 0; bj < 2; ++bj) {
                        const f32x4 v0 = acc[ai][bj][m][0], v1 = acc[ai][bj][m][1];
                        u32x4 w; w.x = cvt_pk_bf16(v0[0], v0[1]); w.y = cvt_pk_bf16(v0[2], v0[3]); w.z = cvt_pk_bf16(v1[0], v1[1]); w.w = cvt_pk_bf16(v1[2], v1[3]);
                        *(u32x4*)(PJ + (size_t)row * PJW + u.pn * 256 + bj * 128 + c0) = w;
                    }
                }
        } else {
#pragma unroll
            for (int ai = 0; ai < 2; ++ai)
#pragma unroll
                for (int m = 0; m < 4; ++m) {
                    const int row = row0 + ai * 128 + m * 16;
#pragma unroll
                    for (int bj = 0; bj < 2; ++bj) {
                        unsigned q[8];
#pragma unroll
                        for (int n = 0; n < 2; ++n)
#pragma unroll
                            for (int j = 0; j < 4; ++j) { int v = (int)(sigmoidf_(acc[ai][bj][m][n][j]) * 256.0f); q[4 * n + j] = (unsigned)(v > 255 ? 255 : v); }
                        u32x2 w; w.x = q[0] | (q[1] << 8) | (q[2] << 16) | (q[3] << 24); w.y = q[4] | (q[5] << 8) | (q[6] << 16) | (q[7] << 24);
                        *(u32x2*)(G8 + g8_off(row, (u.pn - 9) * 256 + bj * 128 + c0)) = w;
                    }
                }
        }
    }
};
struct EpiMLA {
    static constexpr bool HOOK = false;
    static constexpr bool PERM = true;
    bf16_t *MQ, *MK, *MV; const float* RSTD; const float2* RT;
    __device__ __forceinline__ void operator()(const f32x4 (&acc)[2][2][4][2], const Unit& u, int wr, int wc, int fr, int fq) const {
        { const int t_ = opaque_tid(); wr = t_ >> 8; wc = (t_ >> 6) & 3; fr = t_ & 15; fq = (t_ >> 4) & 3; }
        const int row0 = u.pm * 256 + wr * 64 + fr;
#pragma unroll
        for (int bj = 0; bj < 2; ++bj) {
            const int cg0 = u.pn * 256 + bj * 128 + wc * 32;
            if (cg0 >= 896) continue;
#pragma unroll
            for (int ai = 0; ai < 2; ++ai)
#pragma unroll
                for (int m = 0; m < 4; ++m) {
                    __builtin_amdgcn_sched_barrier(0);
                    const int row = row0 + ai * 128 + m * 16;
                    float v[8];
                    if (cg0 < 384) {
                        const float rs = RSTD[row * 2];
#pragma unroll
                        for (int n = 0; n < 2; ++n)
#pragma unroll
                            for (int j = 0; j < 4; ++j) v[4 * n + j] = acc[ai][bj][m][n][j] * rs;
                        const int d0 = cg0 % 96;
                        if (d0 == 64) {
                            const bool lat = row < RL; const int t = row & 8191; const int pos = (fq >> 1) ? (t & 63) : (t >> 6); const bool isx2 = fq & 1;
#pragma unroll
                            for (int e = 0; e < 8; ++e) {
                                const float pr = shflx(v[e], 16);
                                const float2 cs = RT[pos * 8 + e];
                                const float r = isx2 ? (pr * cs.y + v[e] * cs.x) : (v[e] * cs.x - pr * cs.y);
                                v[e] = lat ? r : v[e];
                            }
                        }
                        u32x4 w; w.x = cvt_pk_bf16(v[0], v[1]); w.y = cvt_pk_bf16(v[2], v[3]); w.z = cvt_pk_bf16(v[4], v[5]); w.w = cvt_pk_bf16(v[6], v[7]);
                        *(u32x4*)(MQ + (size_t)row * 384 + cg0 + 8 * fq) = w;
                    } else {
                        const float rs = RSTD[row * 2 + 1];
#pragma unroll
                        for (int n = 0; n < 2; ++n)
#pragma unroll
                            for (int j = 0; j < 4; ++j) v[4 * n + j] = acc[ai][bj][m][n][j] * rs;
                        const int cp = cg0 - 384, hd = cp >> 7, d0 = cp & 127;
                        u32x4 w; w.x = cvt_pk_bf16(v[0], v[1]); w.y = cvt_pk_bf16(v[2], v[3]); w.z = cvt_pk_bf16(v[4], v[5]); w.w = cvt_pk_bf16(v[6], v[7]);
                        if (d0 < 64) *(u32x4*)(MK + (size_t)row * 384 + hd * 96 + d0 + 8 * fq) = w;
                        else *(u32x4*)(MV + (size_t)row * 256 + hd * 64 + (d0 - 64) + 8 * fq) = w;
                    }
                }
        }
    }
};
struct EpiMerge {
    static constexpr bool PERM = true, HOOK = true;
    const unsigned char* G8; bf16_t* MG;
    __device__ __forceinline__ void hook(f32x4 (&acc)[2][2][4][2], const Unit& u, int nb, int wr, int wc, int fr, int fq) const {
        { const int t_ = opaque_tid(); wr = t_ >> 8; wc = (t_ >> 6) & 3; fr = t_ & 15; fq = (t_ >> 4) & 3; }
        const int row0 = u.pm * 256 + wr * 64 + fr, c0 = u.pn * 256 + wc * 32 + 8 * fq;
#pragma unroll
        for (int ai = 0; ai < 2; ++ai) {
            u32x2 ga[4][2], gb[4][2];
#pragma unroll
            for (int m = 0; m < 4; ++m)
#pragma unroll
                for (int bj = 0; bj < 2; ++bj) { const int row = row0 + ai * 128 + m * 16, c = c0 + bj * 128;
                    ga[m][bj] = *(const u32x2*)(G8 + g8_off(row, (nb - 1) * 1024 + c)); gb[m][bj] = *(const u32x2*)(G8 + g8_off(row, nb * 1024 + c)); }
#pragma unroll
            for (int m = 0; m < 4; ++m)
#pragma unroll
                for (int bj = 0; bj < 2; ++bj)
#pragma unroll
                    for (int e = 0; e < 8; ++e) { const unsigned qa = ((e < 4 ? ga[m][bj].x : ga[m][bj].y) >> (8 * (e & 3))) & 255u, qb = ((e < 4 ? gb[m][bj].x : gb[m][bj].y) >> (8 * (e & 3))) & 255u;
                        acc[ai][bj][m][e >> 2][e & 3] *= ((float)qa + 0.5f) * fast_rcp((float)qb + 0.5f); }
            __builtin_amdgcn_sched_barrier(0);
        }
    }
    __device__ __forceinline__ void operator()(const f32x4 (&acc)[2][2][4][2], const Unit& u, int wr, int wc, int fr, int fq) const {
        { const int t_ = opaque_tid(); wr = t_ >> 8; wc = (t_ >> 6) & 3; fr = t_ & 15; fq = (t_ >> 4) & 3; }
        const int row0 = u.pm * 256 + wr * 64 + fr, c0 = u.pn * 256 + wc * 32 + 8 * fq;
#pragma unroll
        for (int ai = 0; ai < 2; ++ai) {
            u32x2 gq[4][2];
#pragma unroll
            for (int m = 0; m < 4; ++m)
#pragma unroll
                for (int bj = 0; bj < 2; ++bj) gq[m][bj] = *(const u32x2*)(G8 + g8_off(row0 + ai * 128 + m * 16, 3 * 1024 + c0 + bj * 128));
#pragma unroll
            for (int m = 0; m < 4; ++m)
#pragma unroll
                for (int bj = 0; bj < 2; ++bj) {
                    const int row = row0 + ai * 128 + m * 16, c = c0 + bj * 128;
                    float v[8];
#pragma unroll
                    for (int e = 0; e < 8; ++e) { const unsigned q = ((e < 4 ? gq[m][bj].x : gq[m][bj].y) >> (8 * (e & 3))) & 255u; v[e] = ((float)q + 0.5f) * (1.0f / 256.0f) * acc[ai][bj][m][e >> 2][e & 3]; }
                    u32x4 w; w.x = cvt_pk_bf16(v[0], v[1]); w.y = cvt_pk_bf16(v[2], v[3]); w.z = cvt_pk_bf16(v[4], v[5]); w.w = cvt_pk_bf16(v[6], v[7]);
                    *(u32x4*)(MG + (size_t)row * 1024 + c) = w;
                }
            __builtin_amdgcn_sched_barrier(0);
        }
    }
};

template <class F>
__device__ __forceinline__ void wt_rows64(bf16_t* dst, int K, F srcval, int ldd, int kbeg, int kend) {
    if (ldd == 0) ldd = K;
    if (kend > K) kend = K;
    const int tid_ = opaque_tid(); const int nl = tid_ & 63, kq = tid_ >> 6;
    for (int k0 = kbeg + kq * 8; k0 < kend; k0 += 64) {
        float v[8];
#pragma unroll
        for (int j = 0; j < 8; ++j) v[j] = srcval(nl, k0 + j);
        u32x4 w; w.x = cvt_pk_bf16(v[0], v[1]); w.y = cvt_pk_bf16(v[2], v[3]); w.z = cvt_pk_bf16(v[4], v[5]); w.w = cvt_pk_bf16(v[6], v[7]);
        *(u32x4*)(dst + (size_t)nl * ldd + k0) = w;
    }
}

__device__ void layer_prep_phase(PK p, int l, LAS unsigned char* lds) {
    unsigned char* ws = p->ws;
    const int nW = 1648, nItems = nW + (l == 0 ? 288 + 1 : 0);
    for (int it2 = opaque_bid(); it2 < nItems; it2 += opaque_gdim()) {
        int it, kbeg = 0, kend = 1 << 30;
        if (it2 < 704) { it = it2 >> 2; kbeg = (it2 & 3) * 256; kend = kbeg + 256; }
        else if (it2 < 1056) { const int q = it2 - 704; it = 176 + q / 11; kbeg = (q % 11) * 256; kend = kbeg + 256; }
        else if (it2 < 1456) { const int q = it2 - 1056; it = 208 + (q >> 2); kbeg = (q & 3) * 256; kend = kbeg + 256; }
        else if (it2 < 1520) { const int q = it2 - 1456; it = 308 + (q >> 2); kbeg = (q & 3) * 256; kend = kbeg + 256; }
        else if (it2 < 1568) { it = 324 + (it2 - 1520); }
        else if (it2 < 1632) { const int q = it2 - 1568; it = 372 + (q >> 2); kbeg = (q & 3) * 64; kend = kbeg + 64; }
        else if (it2 < 1648) { it = 388 + (it2 - 1632); }
        else it = 404 + (it2 - 1648);
        if (it < 176) {
            const int f = it / 88, j = it % 88; const float* src = p->ffn_w_in + ((size_t)(l * 2 + f) * 1024) * 5632;
            bf16_t* dst = (bf16_t*)(ws + OFF_W1) + ((size_t)f * 5632 + j * 64) * 1024;
            wt_rows64(dst, 1024, [&](int nl, int k) { const int np = j * 64 + nl, pn = np >> 8, wi = np & 255; const int col = wi < 128 ? pn * 128 + wi : FH + pn * 128 + (wi - 128); return src[(size_t)k * 5632 + col]; }, 0, kbeg, kend);
        } else if (it < 208) {
            const int q = it - 176, f = q / 16, j = q % 16; const float* src = p->ffn_w_out + ((size_t)(l * 2 + f) * FH) * 1024;
            bf16_t* dst = (bf16_t*)(ws + OFF_W2) + ((size_t)f * 1024 + j * 64) * FH;
            wt_rows64(dst, FH, [&](int nl, int k) { return src[(size_t)k * 1024 + j * 64 + nl]; }, 0, kbeg, kend);
        } else if (it < 308) {
            const int j = it - 208; const float* src = p->mix_w_in + (size_t)l * 1024 * 6304;
            bf16_t* dst = (bf16_t*)(ws + OFF_WM) + (size_t)j * 64 * 1024;
            wt_rows64(dst, 1024, [&](int nl, int k) { const int np = j * 64 + nl; const int col = np < 2208 ? np : (np < 2304 ? -1 : np - 96); return col < 0 ? 0.f : src[(size_t)k * 6304 + col]; }, 0, kbeg, kend);
        } else if (it < 324) {
            const int j = it - 308; const float* src = p->mix_w_out + (size_t)l * 1024 * 1024;
            bf16_t* dst = (bf16_t*)(ws + OFF_WO) + (size_t)j * 64 * 1024;
            wt_rows64(dst, 1024, [&](int nl, int k) { return src[(size_t)k * 1024 + j * 64 + nl]; }, 0, kbeg, kend);
        } else if (it < 372) {
            const int q = it - 324, bi = 1 + q / 16, j = q % 16; const float* src = p->branch_w_out + ((size_t)(l * 4 + bi) * 256) * 1024;
            bf16_t* dst = (bf16_t*)(ws + OFF_WB) + (size_t)j * 64 * 1024 + bi * 256;
            wt_rows64(dst, 256, [&](int nl, int k) { return src[(size_t)k * 1024 + j * 64 + nl]; }, 1024, kbeg, kend);
        } else if (it < 388) {
            const int j = it - 372; const float* wb = p->branch_w_out + ((size_t)(l * 4) * 256) * 1024; const float* pw = p->pool_w + (size_t)l * 4 * 64 * 64; const float* ps = p->pool_scale + l * 256;
            bf16_t* dst = (bf16_t*)(ws + OFF_WB) + (size_t)j * 64 * 1024;
            wt_rows64(dst, 256, [&](int nl, int k) { const int gI = k >> 6, n = j * 64 + nl; const float* pr = pw + (size_t)k * 64; float s = 0.f;
                for (int e = 0; e < 64; ++e) s += pr[e] * ps[gI * 64 + e] * wb[(size_t)(gI * 64 + e) * 1024 + n]; return s; }, 1024, kbeg, kend);
        } else if (it < 404) {
            const int j = it - 388; const float* wq = p->mla_w_qb + (size_t)l * 256 * 384; const float* wk = p->mla_w_kvb + (size_t)l * 128 * 512;
            const float* gq = p->mla_q_norm_g + l * 256; const float* gk = p->mla_kv_norm_g + l * 128;
            bf16_t* dst = (bf16_t*)(ws + OFF_WL) + (size_t)j * 64 * 384;
            wt_rows64(dst, 384, [&](int nl, int k) { const int n = j * 64 + nl;
                if (n < 384) return k < 256 ? gq[k] * wq[(size_t)k * 384 + n] : 0.f;
                if (n < 896) return k >= 256 ? gk[k - 256] * wk[(size_t)(k - 256) * 512 + (n - 384)] : 0.f;
                return 0.f; }, 0, kbeg, kend);
        } else if (it < 404 + 288) {
            const int q = it - 404, ll = q / 144, cb = q % 144;
            LAS float* sc = (LAS float*)lds;
            LAS float* red = (LAS float*)(lds + 5 * 1024 * 4);
            __syncthreads();
            for (int i = opaque_tid(); i < 5 * 1024; i += 512) { const int r = i >> 10, k = i & 1023; const float cv = r < 4 ? p->c[r * 1024 + k] : p->c_ctx[k]; sc[i] = cv * sigmoidf_(cv); }
            __syncthreads();
            const int jl = opaque_tid() & 63, kg = opaque_tid() >> 6; const int col = cb * 64 + jl;
            const float* wsrc = p->ada_w + (size_t)ll * 1024 * 9216 + col;
            float a0 = 0.f, a1 = 0.f, a2 = 0.f, a3 = 0.f, a4 = 0.f;
            for (int k = kg * 128; k < kg * 128 + 128; ++k) { const float wv = wsrc[(size_t)k * 9216]; a0 += sc[k] * wv; a1 += sc[1024 + k] * wv; a2 += sc[2048 + k] * wv; a3 += sc[3072 + k] * wv; a4 += sc[4096 + k] * wv; }
            red[(kg * 5 + 0) * 64 + jl] = a0; red[(kg * 5 + 1) * 64 + jl] = a1; red[(kg * 5 + 2) * 64 + jl] = a2; red[(kg * 5 + 3) * 64 + jl] = a3; red[(kg * 5 + 4) * 64 + jl] = a4;
            __syncthreads();
            if (opaque_tid() < 320) { const int r = opaque_tid() >> 6; float s = p->ada_b[ll * 9216 + col];
                for (int q2 = 0; q2 < 8; ++q2) s += red[(q2 * 5 + r) * 64 + jl];
                ((float*)(ws + OFF_MOD))[(size_t)(ll * 5 + r) * 9216 + col] = s; }
        } else {
            for (int i = opaque_tid(); i < 1024; i += 512) { const int pos = i >> 3, fi = i & 7; const float inv = exp2f(-(float)fi * 0.125f * 13.287712379549449f); const float ang = (float)pos * inv;
                ((float2*)(ws + OFF_ROPE))[i] = make_float2(cosf(ang), sinf(ang)); }
        }
    }
}

__device__ void norm_mod_phase(const float* srcL, const float* srcC, float* cpyL, float* cpyC, const float* g, const float* mod, bf16_t* TN, int nrows, const float* pb, int nsl) {
    const int tid_ = opaque_tid(); const int lane = tid_ & 63, gw = opaque_bid() * 8 + (tid_ >> 6), nw = opaque_gdim() * 8;
    for (int row = gw; row < nrows; row += nw) {
        const bool lat = row < RL;
        const float* sp = lat ? srcL + (size_t)row * 1024 : srcC + (size_t)(row - RL) * 1024;
        const float* mp = mod + (lat ? (row >> 13) : 4) * 9216;
        f32x4 v[4]; float ss = 0.f;
#pragma unroll
        for (int j = 0; j < 4; ++j) v[j] = *(const f32x4*)(sp + 256 * j + 4 * lane);
        if (!lat && nsl > 0) {
            for (int sl = 0; sl < nsl; ++sl) { const float* pp = pb + ((size_t)sl * 1024 + (row - RL)) * 1024;
#pragma unroll
                for (int j = 0; j < 4; ++j) v[j] += *(const f32x4*)(pp + 256 * j + 4 * lane); }
            float* wp = (float*)sp;
#pragma unroll
            for (int j = 0; j < 4; ++j) *(f32x4*)(wp + 256 * j + 4 * lane) = v[j];
        }
#pragma unroll
        for (int j = 0; j < 4; ++j) ss += v[j][0] * v[j][0] + v[j][1] * v[j][1] + v[j][2] * v[j][2] + v[j][3] * v[j][3];
        if (cpyL) { float* cp = lat ? cpyL + (size_t)row * 1024 : cpyC + (size_t)(row - RL) * 1024;
#pragma unroll
            for (int j = 0; j < 4; ++j) *(f32x4*)(cp + 256 * j + 4 * lane) = v[j]; }
        ss = wave_sum(ss);
        const float rstd = rsqrtf(ss * (1.0f / 1024.0f) + NEPS);
#pragma unroll
        for (int j = 0; j < 4; ++j) {
            const int col = 256 * j + 4 * lane;
            const f32x4 gg = *(const f32x4*)(g + col), sh = *(const f32x4*)(mp + col), sc = *(const f32x4*)(mp + 1024 + col);
            float o[4];
#pragma unroll
            for (int e = 0; e < 4; ++e) o[e] = (v[j][e] * rstd * gg[e]) * (1.0f + sc[e]) + sh[e];
            u32x2 w; w.x = cvt_pk_bf16(o[0], o[1]); w.y = cvt_pk_bf16(o[2], o[3]);
            *(u32x2*)(TN + (size_t)row * 1024 + col) = w;
        }
    }
}
__device__ void final_norm_phase(float* H, const float* g) {
    const int tid_ = opaque_tid(); const int lane = tid_ & 63, gw = opaque_bid() * 8 + (tid_ >> 6), nw = opaque_gdim() * 8;
    for (int row = gw; row < RL; row += nw) {
        float* sp = H + (size_t)row * 1024; f32x4 v[4]; float ss = 0.f;
#pragma unroll
        for (int j = 0; j < 4; ++j) { v[j] = *(const f32x4*)(sp + 256 * j + 4 * lane); ss += v[j][0] * v[j][0] + v[j][1] * v[j][1] + v[j][2] * v[j][2] + v[j][3] * v[j][3]; }
        ss = wave_sum(ss);
        const float rstd = rsqrtf(ss * (1.0f / 1024.0f) + NEPS);
#pragma unroll
        for (int j = 0; j < 4; ++j) { const f32x4 gg = *(const f32x4*)(g + 256 * j + 4 * lane); *(f32x4*)(sp + 256 * j + 4 * lane) = v[j] * rstd * gg; }
    }
}

__device__ void prep_phase(PK p) {
    unsigned char* ws = p->ws;
    bf16_t* PJ = (bf16_t*)(ws + OFF_B); bf16_t* YB = (bf16_t*)(ws + OFF_A); bf16_t* MK = (bf16_t*)(ws + OFF_MK); float* RSTD = (float*)(ws + OFF_RSTD);
    const float2* RT = (const float2*)(ws + OFF_ROPE);
    const int tid_ = opaque_tid(); const int lane = tid_ & 63, gw = opaque_bid() * 8 + (tid_ >> 6), nw = opaque_gdim() * 8;
    for (int row = gw; row < RA; row += nw) {
        const bool lat = row < RL;
        int t, n; if (lat) { t = row & 8191; n = 8192; } else { t = (row - RL) & 255; n = 256; }
        const int sbase = row - t;
        bf16_t* prow = PJ + (size_t)row * PJW;
        {
            const int wdw = 2 << (lane >> 4), hw = wdw >> 1; const int lo = max(t - hw, 0), hi = min(t + hw, n);
            float s0 = 0.f, s1 = 0.f, s2 = 0.f, s3 = 0.f;
#pragma unroll
            for (int i = 0; i < 16; ++i) {
                const int off = i - 8, tt = t + off; const bool ok = (off >= -hw) && (off < hw) && (tt >= 0) && (tt < n);
                const u32x2 v = *(const u32x2*)(PJ + (size_t)(sbase + (ok ? tt : t)) * PJW + 4 * lane); const float wg = ok ? 1.0f : 0.0f;
                s0 += wg * bf_lo(v.x); s1 += wg * bf_hi(v.x); s2 += wg * bf_lo(v.y); s3 += wg * bf_hi(v.y); }
            const float ic = 1.0f / (float)(hi - lo); const u32x2 sv = *(const u32x2*)(prow + 4 * lane);
            u32x2 w; w.x = cvt_pk_bf16(s0 * ic - bf_lo(sv.x), s1 * ic - bf_hi(sv.x)); w.y = cvt_pk_bf16(s2 * ic - bf_lo(sv.y), s3 * ic - bf_hi(sv.y));
            *(u32x2*)(YB + (size_t)row * 1024 + 4 * lane) = w;
        }
        {
            const u32x2 q = *(const u32x2*)(prow + C_MQ + 4 * lane); const unsigned kv = *(const unsigned*)(prow + C_MKV + 2 * lane);
            float sq = bf_lo(q.x) * bf_lo(q.x) + bf_hi(q.x) * bf_hi(q.x) + bf_lo(q.y) * bf_lo(q.y) + bf_hi(q.y) * bf_hi(q.y);
            float sk = bf_lo(kv) * bf_lo(kv) + bf_hi(kv) * bf_hi(kv);
            sq = wave_sum(sq); sk = wave_sum(sk);
            if (lane == 0) { RSTD[row * 2] = rsqrtf(sq * (1.0f / 256.0f) + NEPS); RSTD[row * 2 + 1] = rsqrtf(sk * (1.0f / 128.0f) + NEPS); }
        }
        if (lane < 34) {
            const bool iskr = lane >= 32; const int a = lane & 1;
            bf16_t* ep = iskr ? prow + C_MKR + a * 16 : prow + ((lane >> 4) ? C_DK : C_DQ) + ((lane >> 1) & 7) * 32 + a * 16;
            const u32x4 e0 = *(const u32x4*)ep, e1 = *(const u32x4*)(ep + 8);
            float x1[8], x2[8];
            x1[0] = bf_lo(e0.x); x1[1] = bf_hi(e0.x); x1[2] = bf_lo(e0.y); x1[3] = bf_hi(e0.y); x1[4] = bf_lo(e0.z); x1[5] = bf_hi(e0.z); x1[6] = bf_lo(e0.w); x1[7] = bf_hi(e0.w);
            x2[0] = bf_lo(e1.x); x2[1] = bf_hi(e1.x); x2[2] = bf_lo(e1.y); x2[3] = bf_hi(e1.y); x2[4] = bf_lo(e1.z); x2[5] = bf_hi(e1.z); x2[6] = bf_lo(e1.w); x2[7] = bf_hi(e1.w);
            if (lat) { const int pos = a ? (t & 63) : (t >> 6);
#pragma unroll
                for (int i = 0; i < 8; ++i) { const float2 cs = RT[pos * 8 + i]; const float o1 = x1[i] * cs.x - x2[i] * cs.y, o2 = x1[i] * cs.y + x2[i] * cs.x; x1[i] = o1; x2[i] = o2; } }
            u32x4 w0, w1; w0.x = cvt_pk_bf16(x1[0], x1[1]); w0.y = cvt_pk_bf16(x1[2], x1[3]); w0.z = cvt_pk_bf16(x1[4], x1[5]); w0.w = cvt_pk_bf16(x1[6], x1[7]);
            w1.x = cvt_pk_bf16(x2[0], x2[1]); w1.y = cvt_pk_bf16(x2[2], x2[3]); w1.z = cvt_pk_bf16(x2[4], x2[5]); w1.w = cvt_pk_bf16(x2[6], x2[7]);
            if (iskr) {
#pragma unroll
                for (int hh = 0; hh < 4; ++hh) { bf16_t* kp = MK + (size_t)row * 384 + hh * 96 + 64 + a * 16; *(u32x4*)kp = w0; *(u32x4*)(kp + 8) = w1; }
            } else if (lat) { *(u32x4*)ep = w0; *(u32x4*)(ep + 8) = w1; }
        }
    }
}

#define MFMA32(a, b, c) __builtin_amdgcn_mfma_f32_32x32x16_bf16((a), (b), (c), 0, 0, 0)
typedef float f32x2 __attribute__((ext_vector_type(2)));
template <int MODE>
__device__ __forceinline__ void attn_item(PK p, int l, LAS unsigned char* lds, int b, int h, int qb, bool ctxq, float lam, float lam_init) {
    constexpr int NCOMP = (MODE == 1) ? 2 : 1, NKS = (MODE == 0) ? 4 : ((MODE == 1) ? 2 : 6), KW = NCOMP * NKS * 16, KCH = KW / 8, KSTR = KW * 2 + 16, VSTR = 192;
    constexpr int KBUF = 64 * KSTR, VBUF = 64 * VSTR, BUFSZ = KBUF + VBUF, BIAS_OFF = 3 * BUFSZ;
    constexpr bool STAG = (MODE != 0);
    const int tid = opaque_tid(), w = tid >> 6, lane = tid & 63, g = lane >> 5, l32 = lane & 31;
    unsigned char* ws = p->ws;
    const bf16_t* PJ = (const bf16_t*)(ws + OFF_B);
    const bf16_t *Qp, *Kp, *Vp; int ldq, ldk, ldv, outoff; float scale;
    if (MODE == 0) { Qp = PJ + C_NQ + 64 * h; Kp = PJ + C_NK + 64 * h; Vp = PJ + C_NV + 64 * h; ldq = ldk = ldv = PJW; outoff = 256 + 64 * h; scale = 0.125f; }
    else if (MODE == 1) { Qp = PJ + C_DQ + 64 * h; Kp = PJ + C_DK + 64 * h; Vp = PJ + C_DV + 64 * h; ldq = ldk = ldv = PJW; outoff = 512 + 64 * h; scale = 0.17677669529663687f; }
    else { Qp = (const bf16_t*)(ws + OFF_D) + 96 * h; Kp = (const bf16_t*)(ws + OFF_MK) + 96 * h; Vp = (const bf16_t*)(ws + OFF_MV) + 64 * h; ldq = ldk = 384; ldv = 256; outoff = 768 + 64 * h; scale = 0.10206207261596575f; }
    const float cs = scale * LOG2E;
    int qrow0, loc0, nloc;
    if (ctxq) { qrow0 = RL + b * 256; loc0 = 0; nloc = 0; }
    else { qrow0 = b * 8192 + qb * 256;
        if (MODE == 0) { const int r0 = qb * 4; loc0 = clampi(r0 - 4, 0, 120); nloc = clampi(r0 - 1, 0, 120) + 8 - loc0; } else { loc0 = 0; nloc = 128; } }
    const int nt = nloc + 4;
    const bool nabias = (MODE == 0) && !ctxq;
    constexpr bool PIPE = (MODE == 2);
    const bool late = STAG && !PIPE && (w >= 4);
    const int rw = qb * 4 + (w >> 1), sw = clampi(rw - 4, 0, 120);
    const int jq = 32 * (w & 1) + l32, cst = clampi(jq - 8, 0, 48);
    if (nabias && tid < 465) ((LAS float*)(lds + BIAS_OFF))[tid] = p->na_rpb[(size_t)(l * 4 + h) * 465 + tid] * LOG2E;

    const size_t qrow = (size_t)qrow0 + 32 * w + l32;
    bf16x8 qf[NCOMP * NKS];
#pragma unroll
    for (int i = 0; i < NCOMP * NKS; ++i) {
        const u32x4 raw = *(const u32x4*)(Qp + qrow * ldq + 16 * i + 8 * g);
        u32x4 sc4; sc4.x = cvt_pk_bf16(bf_lo(raw.x) * cs, bf_hi(raw.x) * cs); sc4.y = cvt_pk_bf16(bf_lo(raw.y) * cs, bf_hi(raw.y) * cs);
        sc4.z = cvt_pk_bf16(bf_lo(raw.z) * cs, bf_hi(raw.z) * cs); sc4.w = cvt_pk_bf16(bf_lo(raw.w) * cs, bf_hi(raw.w) * cs);
        qf[i] = __builtin_bit_cast(bf16x8, sc4);
    }

    const int kr0 = tid / KCH, kc0 = tid % KCH, kr1 = (tid + 512) / KCH, kc1 = (tid + 512) % KCH, vr = tid >> 3, vc = tid & 7;
    const bool hask1 = (KCH == 12) && (tid < 256);
    u32x4 rk0, rk1 = (u32x4){0u, 0u, 0u, 0u}, rv;
#define TILE_ROW(t) ((t) < nloc ? (b * 8192 + 64 * (loc0 + (t))) : (RL + b * 256 + 64 * ((t) - nloc)))
#define LOAD_TILE(t) do { const size_t _tb = (size_t)TILE_ROW(t); rk0 = *(const u32x4*)(Kp + (_tb + kr0) * ldk + kc0 * 8); \
        if (hask1) rk1 = *(const u32x4*)(Kp + (_tb + kr1) * ldk + kc1 * 8); rv = *(const u32x4*)(Vp + (_tb + vr) * ldv + vc * 8); } while (0)
#define STORE_TILE(buf) do { LAS unsigned char* _kb = lds + (buf) * BUFSZ; *(LAS u32x4*)(_kb + kr0 * KSTR + kc0 * 16) = rk0; \
        if (hask1) *(LAS u32x4*)(_kb + kr1 * KSTR + kc1 * 16) = rk1; *(LAS u32x4*)(_kb + KBUF + vr * VSTR + vc * 16) = rv; } while (0)

    float mrun[NCOMP], lsum[NCOMP]; f32x16 O[NCOMP][2];
#pragma unroll
    for (int c = 0; c < NCOMP; ++c) { mrun[c] = -1e30f; lsum[c] = 0.f;
#pragma unroll
        for (int dt = 0; dt < 2; ++dt)
#pragma unroll
            for (int r = 0; r < 16; ++r) O[c][dt][r] = 0.f; }
    bf16x8 P[NCOMP][2][2];
#pragma unroll
    for (int c = 0; c < NCOMP; ++c)
#pragma unroll
        for (int kt = 0; kt < 2; ++kt)
#pragma unroll
            for (int s2 = 0; s2 < 2; ++s2) P[c][kt][s2] = (bf16x8){0, 0, 0, 0, 0, 0, 0, 0};

    LOAD_TILE(0); STORE_TILE(0); __syncthreads();
    const int koff = l32 * KSTR + g * 16;
    const int i16 = lane & 15, tq = i16 >> 2, tp = i16 & 3, blk = (lane >> 4) & 1;
    const int voff = (4 * g + tq) * VSTR + (16 * blk + 4 * tp) * 2;
#define PV_TILE(buf) do { LAS unsigned char* _vb = lds + (buf) * BUFSZ + KBUF + voff; \
        _Pragma("unroll") for (int kt = 0; kt < 2; ++kt) { bf16x8 vf[2][2]; \
            _Pragma("unroll") for (int s2 = 0; s2 < 2; ++s2) _Pragma("unroll") for (int dt = 0; dt < 2; ++dt) { LAS unsigned char* vp = _vb + (32 * kt + 16 * s2) * VSTR + dt * 64; \
                const s16x4 lo = __builtin_amdgcn_ds_read_tr16_b64_v4i16((LAS s16x4*)vp); const s16x4 hi = __builtin_amdgcn_ds_read_tr16_b64_v4i16((LAS s16x4*)(vp + 8 * VSTR)); \
                vf[s2][dt] = __builtin_shufflevector(lo, hi, 0, 1, 2, 3, 4, 5, 6, 7); } \
            __builtin_amdgcn_s_setprio(1); \
            _Pragma("unroll") for (int s2 = 0; s2 < 2; ++s2) _Pragma("unroll") for (int dt = 0; dt < 2; ++dt) _Pragma("unroll") for (int c = 0; c < NCOMP; ++c) O[c][dt] = MFMA32(vf[s2][dt], P[c][kt][s2], O[c][dt]); \
            __builtin_amdgcn_s_setprio(0); } } while (0)

#define PV_TILE_C(buf, cc) do { LAS unsigned char* _vb = lds + (buf) * BUFSZ + KBUF + voff; \
        _Pragma("unroll") for (int kt = 0; kt < 2; ++kt) { bf16x8 vf[2][2]; \
            _Pragma("unroll") for (int s2 = 0; s2 < 2; ++s2) _Pragma("unroll") for (int dt = 0; dt < 2; ++dt) { LAS unsigned char* vp = _vb + (32 * kt + 16 * s2) * VSTR + dt * 64; \
                const s16x4 lo = __builtin_amdgcn_ds_read_tr16_b64_v4i16((LAS s16x4*)vp); const s16x4 hi = __builtin_amdgcn_ds_read_tr16_b64_v4i16((LAS s16x4*)(vp + 8 * VSTR)); \
                vf[s2][dt] = __builtin_shufflevector(lo, hi, 0, 1, 2, 3, 4, 5, 6, 7); } \
            __builtin_amdgcn_s_setprio(1); \
            _Pragma("unroll") for (int s2 = 0; s2 < 2; ++s2) _Pragma("unroll") for (int dt = 0; dt < 2; ++dt) O[cc][dt] = MFMA32(vf[s2][dt], P[cc][kt][s2], O[cc][dt]); \
            __builtin_amdgcn_s_setprio(0); } } while (0)
    bf16x8 Pold[NCOMP][2][2];
#pragma unroll
    for (int c = 0; c < NCOMP; ++c)
#pragma unroll
        for (int kt = 0; kt < 2; ++kt)
#pragma unroll
            for (int s2 = 0; s2 < 2; ++s2) Pold[c][kt][s2] = (bf16x8){0, 0, 0, 0, 0, 0, 0, 0};
#define PV_TILE_OLD(buf) do { LAS unsigned char* _vb = lds + (buf) * BUFSZ + KBUF + voff; \
        _Pragma("unroll") for (int kt = 0; kt < 2; ++kt) { bf16x8 vf[2][2]; \
            _Pragma("unroll") for (int s2 = 0; s2 < 2; ++s2) _Pragma("unroll") for (int dt = 0; dt < 2; ++dt) { LAS unsigned char* vp = _vb + (32 * kt + 16 * s2) * VSTR + dt * 64; \
                const s16x4 lo = __builtin_amdgcn_ds_read_tr16_b64_v4i16((LAS s16x4*)vp); const s16x4 hi = __builtin_amdgcn_ds_read_tr16_b64_v4i16((LAS s16x4*)(vp + 8 * VSTR)); \
                vf[s2][dt] = __builtin_shufflevector(lo, hi, 0, 1, 2, 3, 4, 5, 6, 7); } \
            _Pragma("unroll") for (int s2 = 0; s2 < 2; ++s2) _Pragma("unroll") for (int dt = 0; dt < 2; ++dt) _Pragma("unroll") for (int c = 0; c < NCOMP; ++c) O[c][dt] = MFMA32(vf[s2][dt], Pold[c][kt][s2], O[c][dt]); } } while (0)
    bool pend = false, zref = false; int pbuf = 0, cbuf = 0;
    for (int t = 0; t < nt; ++t) {
        const bool more = (t + 1 < nt);
        if (more) LOAD_TILE(t + 1);
        bool active = true; int krow = 0;
        if (nabias && t < nloc) { krow = loc0 + t; active = (krow >= sw) && (krow < sw + 8); }
        bool slow = (MODE == 0) || (t == 0);
        if (active) {
          again:
            LAS unsigned char* Kb = lds + cbuf * BUFSZ + koff;
            f32x16 S[NCOMP][2];
#pragma unroll
            for (int c = 0; c < NCOMP; ++c)
#pragma unroll
                for (int kt = 0; kt < 2; ++kt) {
                    bf16x8 kf[NKS];
#pragma unroll
                    for (int ks = 0; ks < NKS; ++ks) kf[ks] = *(const LAS bf16x8*)(Kb + kt * 32 * KSTR + (c * NKS + ks) * 32);
#pragma unroll
                    for (int r = 0; r < 16; ++r) S[c][kt][r] = 0.f;
                    __builtin_amdgcn_s_setprio(1);
#pragma unroll
                    for (int ks = 0; ks < NKS; ++ks) S[c][kt] = MFMA32(kf[ks], qf[c * NKS + ks], S[c][kt]);
                    __builtin_amdgcn_s_setprio(0);
                }
            if (STAG && late && pend) { PV_TILE(pbuf); pend = false; }
            float mxc[NCOMP], mnw[NCOMP];
            if (!slow) {
#pragma unroll
                for (int c = 0; c < NCOMP; ++c) mnw[c] = mrun[c];
            } else {
#pragma unroll
            for (int c = 0; c < NCOMP; ++c) {
                float mx = -1e30f;
                if (nabias && t < nloc) {
                    const LAS float* bt = (const LAS float*)(lds + BIAS_OFF) + (krow - rw + 7) * 31;
#pragma unroll
                    for (int kt = 0; kt < 2; ++kt)
#pragma unroll
                        for (int r = 0; r < 16; ++r) { const int jk = 32 * kt + (r & 3) + 8 * (r >> 2) + 4 * g; const bool ok = (jk >= cst) && (jk < cst + 16);
                            const float bv = bt[clampi(jk - jq + 15, 0, 30)]; const float xv = ok ? (S[c][kt][r] + bv) : -1e30f; S[c][kt][r] = xv; mx = fmaxf(mx, xv); }
                } else {
#pragma unroll
                    for (int kt = 0; kt < 2; ++kt)
#pragma unroll
                        for (int r = 0; r < 16; r += 2) mx = fmaxf(fmaxf(mx, S[c][kt][r]), S[c][kt][r + 1]);
                }
                mxc[c] = mx;
            }
#pragma unroll
            for (int c = 0; c < NCOMP; ++c) mxc[c] = fmaxf(mxc[c], shflx(mxc[c], 32));
            bool grow = false;
#pragma unroll
            for (int c = 0; c < NCOMP; ++c) { mnw[c] = fmaxf(mrun[c], mxc[c]); grow = grow || (mnw[c] > mrun[c]); }
            if (MODE != 0) {
                bool big = false;
#pragma unroll
                for (int c = 0; c < NCOMP; ++c) big = big || !(fabsf(mnw[c]) < 40.0f);
                zref = (t == 0) && !__any(big);
                if (zref) {
#pragma unroll
                    for (int c = 0; c < NCOMP; ++c) mnw[c] = 0.0f; }
            }
            if (__any(grow)) {
#pragma unroll
                for (int c = 0; c < NCOMP; ++c) { const float alpha = fast_exp2(mrun[c] - mnw[c]); lsum[c] *= alpha;
#pragma unroll
                    for (int dt = 0; dt < 2; ++dt) O[c][dt] *= alpha;
                    mrun[c] = mnw[c]; }
            }
            }
            if (!zref) {
#pragma unroll
            for (int c = 0; c < NCOMP; ++c) { const f32x2 m2 = (f32x2){mnw[c], mnw[c]};
#pragma unroll
                for (int kt = 0; kt < 2; ++kt)
#pragma unroll
                    for (int r = 0; r < 16; r += 2) { const f32x2 d = (f32x2){S[c][kt][r], S[c][kt][r + 1]} - m2; S[c][kt][r] = d.x; S[c][kt][r + 1] = d.y; } }
            }
            if (PIPE) PV_TILE_OLD(pbuf);
#pragma unroll
            for (int c = 0; c < NCOMP; ++c)
#pragma unroll
                for (int kt = 0; kt < 2; ++kt)
#pragma unroll
                    for (int r = 0; r < 16; ++r) S[c][kt][r] = fast_exp2(S[c][kt][r]);
#pragma unroll
            for (int c = 0; c < NCOMP; ++c) { f32x2 rs2 = (f32x2){0.f, 0.f};
#pragma unroll
                for (int kt = 0; kt < 2; ++kt)
#pragma unroll
                    for (int s2 = 0; s2 < 2; ++s2) { u32x4 pk;
#pragma unroll
                        for (int e = 0; e < 4; ++e) { const f32x2 ev = (f32x2){S[c][kt][8 * s2 + 2 * e], S[c][kt][8 * s2 + 2 * e + 1]}; rs2 += ev; pk[e] = cvt_pk_bf16(ev.x, ev.y); }
                        P[c][kt][s2] = __builtin_bit_cast(bf16x8, pk); }
                mxc[c] = rs2.x + rs2.y; }
            if (PIPE) {
                __builtin_amdgcn_sched_group_barrier(0x100, 16, 0);
#pragma unroll
                for (int i = 0; i < 8; ++i) { __builtin_amdgcn_sched_group_barrier(0x008, 1, 0); __builtin_amdgcn_sched_group_barrier(0x400, 4, 0); __builtin_amdgcn_sched_group_barrier(0x002, 4, 0); }
            }
            if (!slow) { bool bad = false;
#pragma unroll
                for (int c = 0; c < NCOMP; ++c) bad = bad || !(mxc[c] < 1.0e18f);
                if (__any(bad)) { slow = true;
                    if (PIPE) {
#pragma unroll
                        for (int c = 0; c < NCOMP; ++c)
#pragma unroll
                            for (int kt = 0; kt < 2; ++kt)
#pragma unroll
                                for (int s2 = 0; s2 < 2; ++s2) Pold[c][kt][s2] = (bf16x8){0, 0, 0, 0, 0, 0, 0, 0}; }
                    goto again; } }
#pragma unroll
            for (int c = 0; c < NCOMP; ++c) lsum[c] += mxc[c];
            if (PIPE) {
#pragma unroll
                for (int c = 0; c < NCOMP; ++c)
#pragma unroll
                    for (int kt = 0; kt < 2; ++kt)
#pragma unroll
                        for (int s2 = 0; s2 < 2; ++s2) Pold[c][kt][s2] = P[c][kt][s2];
                pbuf = cbuf;
            } else {
            if (!(STAG && late)) PV_TILE(cbuf);
            if (STAG && late) { pend = true; pbuf = cbuf; }
            }
        }
        const int nbuf = (cbuf == 2) ? 0 : cbuf + 1;
        if (more) STORE_TILE(nbuf);
        __syncthreads();
        cbuf = nbuf;
    }
    if (STAG && late && pend) PV_TILE(pbuf);
    if (PIPE) PV_TILE_OLD(pbuf);
#undef PV_TILE_OLD
#undef PV_TILE
#undef PV_TILE_C
#undef TILE_ROW
#undef LOAD_TILE
#undef STORE_TILE
    float inv[NCOMP];
#pragma unroll
    for (int c = 0; c < NCOMP; ++c) { const float lt = lsum[c] + shflx(lsum[c], 32); inv[c] = 1.0f / lt; }
    bf16_t* op = (bf16_t*)(ws + OFF_A) + qrow * 1024 + outoff;
    if (MODE == 1) {
        const float li1 = lam * inv[NCOMP - 1]; float ss = 0.f;
#pragma unroll
        for (int dt = 0; dt < 2; ++dt)
#pragma unroll
            for (int r = 0; r < 16; ++r) { const float o = O[0][dt][r] * inv[0] - li1 * O[NCOMP - 1][dt][r]; O[0][dt][r] = o; ss += o * o; }
        ss += shflx(ss, 32);
        const float rstd = rsqrtf(ss * (1.0f / 64.0f) + NEPS) * (1.0f - lam_init);
        const float* sg = p->diff_subln_g + l * 64;
#pragma unroll
        for (int dt = 0; dt < 2; ++dt)
#pragma unroll
            for (int rq = 0; rq < 4; ++rq) { const int dv = 32 * dt + 8 * rq + 4 * g; const f32x4 gg = *(const f32x4*)(sg + dv);
                u32x2 wv; wv.x = cvt_pk_bf16(O[0][dt][4 * rq] * rstd * gg[0], O[0][dt][4 * rq + 1] * rstd * gg[1]); wv.y = cvt_pk_bf16(O[0][dt][4 * rq + 2] * rstd * gg[2], O[0][dt][4 * rq + 3] * rstd * gg[3]);
                *(u32x2*)(op + dv) = wv; }
    } else {
#pragma unroll
        for (int dt = 0; dt < 2; ++dt)
#pragma unroll
            for (int rq = 0; rq < 4; ++rq) { const int dv = 32 * dt + 8 * rq + 4 * g;
                u32x2 wv; wv.x = cvt_pk_bf16(O[0][dt][4 * rq] * inv[0], O[0][dt][4 * rq + 1] * inv[0]); wv.y = cvt_pk_bf16(O[0][dt][4 * rq + 2] * inv[0], O[0][dt][4 * rq + 3] * inv[0]);
                *(u32x2*)(op + dv) = wv; }
    }
    __syncthreads();
}

__device__ __forceinline__ void attn_item_mla2(PK p, int l, LAS unsigned char* lds, int b, int h, int qb, bool ctxq) {
    constexpr int NKS = 6, KCH = 12, KSTR = 208, VSTR = 192, KBUF = 64 * KSTR, VBUF = 64 * VSTR, BUFSZ = KBUF + VBUF;
    const int tid = opaque_tid(), w = tid >> 6, lane = tid & 63, g = lane >> 5, l32 = lane & 31;
    unsigned char* ws = p->ws;
    const bf16_t* Qp = (const bf16_t*)(ws + OFF_D) + 96 * h; const bf16_t* Kp = (const bf16_t*)(ws + OFF_MK) + 96 * h; const bf16_t* Vp = (const bf16_t*)(ws + OFF_MV) + 64 * h;
    constexpr int ldq = 384, ldk = 384, ldv = 256; const int outoff = 768 + 64 * h;
    const float cs = 0.10206207261596575f * LOG2E;
    const int qrow0 = ctxq ? RL + b * 256 : b * 8192 + qb * 256, nloc = ctxq ? 0 : 128, nt = nloc + 4;
    const size_t qrow = (size_t)qrow0 + 32 * w + l32;
    bf16x8 qf[NKS];
#pragma unroll
    for (int i = 0; i < NKS; ++i) {
        const u32x4 raw = *(const u32x4*)(Qp + qrow * ldq + 16 * i + 8 * g);
        u32x4 sc4; sc4.x = cvt_pk_bf16(bf_lo(raw.x) * cs, bf_hi(raw.x) * cs); sc4.y = cvt_pk_bf16(bf_lo(raw.y) * cs, bf_hi(raw.y) * cs);
        sc4.z = cvt_pk_bf16(bf_lo(raw.z) * cs, bf_hi(raw.z) * cs); sc4.w = cvt_pk_bf16(bf_lo(raw.w) * cs, bf_hi(raw.w) * cs);
        qf[i] = __builtin_bit_cast(bf16x8, sc4);
    }
    const int kr0 = tid / KCH, kc0 = tid % KCH, kr1 = (tid + 512) / KCH, kc1 = (tid + 512) % KCH, vr = tid >> 3, vc = tid & 7;
    const bool hask1 = tid < 256;
    u32x4 rk0, rk1 = (u32x4){0u, 0u, 0u, 0u}, rv;
#define M2_ROW(t) ((t) < nloc ? (b * 8192 + 64 * (t)) : (RL + b * 256 + 64 * ((t) - nloc)))
#define M2_LOAD(t) do { const size_t _tb = (size_t)M2_ROW(t); rk0 = *(const u32x4*)(Kp + (_tb + kr0) * ldk + kc0 * 8); \
        if (hask1) rk1 = *(const u32x4*)(Kp + (_tb + kr1) * ldk + kc1 * 8); rv = *(const u32x4*)(Vp + (_tb + vr) * ldv + vc * 8); } while (0)
#define M2_STORE(buf) do { LAS unsigned char* _kb = lds + (buf) * BUFSZ; *(LAS u32x4*)(_kb + kr0 * KSTR + kc0 * 16) = rk0; \
        if (hask1) *(LAS u32x4*)(_kb + kr1 * KSTR + kc1 * 16) = rk1; *(LAS u32x4*)(_kb + KBUF + vr * VSTR + vc * 16) = rv; } while (0)
    const int koff = l32 * KSTR + g * 16;
    const int i16 = lane & 15, tq = i16 >> 2, tp = i16 & 3, blk = (lane >> 4) & 1;
    const int voff = (4 * g + tq) * VSTR + (16 * blk + 4 * tp) * 2;
#define M2_QK(SX, buf) do { LAS unsigned char* _kb = lds + (buf) * BUFSZ + koff; \
        _Pragma("unroll") for (int kt = 0; kt < 2; ++kt) { bf16x8 kf[NKS]; \
            _Pragma("unroll") for (int ks = 0; ks < NKS; ++ks) kf[ks] = *(const LAS bf16x8*)(_kb + kt * 32 * KSTR + ks * 32); \
            _Pragma("unroll") for (int r = 0; r < 16; ++r) SX[kt][r] = 0.f; \
            _Pragma("unroll") for (int ks = 0; ks < NKS; ++ks) SX[kt] = MFMA32(kf[ks], qf[ks], SX[kt]); } } while (0)
#define M2_PVOLD(buf) do { LAS unsigned char* _vb = lds + (buf) * BUFSZ + KBUF + voff; \
        _Pragma("unroll") for (int kt = 0; kt < 2; ++kt) { bf16x8 vf[2][2]; \
            _Pragma("unroll") for (int s2 = 0; s2 < 2; ++s2) _Pragma("unroll") for (int dt = 0; dt < 2; ++dt) { LAS unsigned char* vp = _vb + (32 * kt + 16 * s2) * VSTR + dt * 64; \
                const s16x4 lo = __builtin_amdgcn_ds_read_tr16_b64_v4i16((LAS s16x4*)vp); const s16x4 hi = __builtin_amdgcn_ds_read_tr16_b64_v4i16((LAS s16x4*)(vp + 8 * VSTR)); \
                vf[s2][dt] = __builtin_shufflevector(lo, hi, 0, 1, 2, 3, 4, 5, 6, 7); } \
            _Pragma("unroll") for (int s2 = 0; s2 < 2; ++s2) _Pragma("unroll") for (int dt = 0; dt < 2; ++dt) O[dt] = MFMA32(vf[s2][dt], Pold[kt][s2], O[dt]); } } while (0)
#define M2_EXP(SX, PX, RS) do { _Pragma("unroll") for (int kt = 0; kt < 2; ++kt) _Pragma("unroll") for (int r = 0; r < 16; ++r) SX[kt][r] = fast_exp2(SX[kt][r]); \
        f32x2 _rs2 = (f32x2){0.f, 0.f}; \
        _Pragma("unroll") for (int kt = 0; kt < 2; ++kt) _Pragma("unroll") for (int s2 = 0; s2 < 2; ++s2) { u32x4 pk; \
            _Pragma("unroll") for (int e = 0; e < 4; ++e) { const f32x2 ev = (f32x2){SX[kt][8 * s2 + 2 * e], SX[kt][8 * s2 + 2 * e + 1]}; _rs2 += ev; pk[e] = cvt_pk_bf16(ev.x, ev.y); } \
            PX[kt][s2] = __builtin_bit_cast(bf16x8, pk); } \
        RS = _rs2.x + _rs2.y; } while (0)
#define M2_SUB(SX, mref) do { const f32x2 _m2 = (f32x2){mref, mref}; \
        _Pragma("unroll") for (int kt = 0; kt < 2; ++kt) _Pragma("unroll") for (int r = 0; r < 16; r += 2) { const f32x2 d = (f32x2){SX[kt][r], SX[kt][r + 1]} - _m2; SX[kt][r] = d.x; SX[kt][r + 1] = d.y; } } while (0)
#define M2_MAX(SX, MX) do { float _mx = -1e30f; _Pragma("unroll") for (int kt = 0; kt < 2; ++kt) _Pragma("unroll") for (int r = 0; r < 16; r += 2) _mx = fmaxf(fmaxf(_mx, SX[kt][r]), SX[kt][r + 1]); \
        MX = fmaxf(_mx, shflx(_mx, 32)); } while (0)
    float lsum = 0.f, mrun; f32x16 O[2];
#pragma unroll
    for (int dt = 0; dt < 2; ++dt)
#pragma unroll
        for (int r = 0; r < 16; ++r) O[dt][r] = 0.f;
    bf16x8 Pold[2][2];
#pragma unroll
    for (int kt = 0; kt < 2; ++kt)
#pragma unroll
        for (int s2 = 0; s2 < 2; ++s2) Pold[kt][s2] = (bf16x8){0, 0, 0, 0, 0, 0, 0, 0};
    f32x16 SA[2], SB[2];
    M2_LOAD(0); M2_STORE(0); M2_LOAD(1); M2_STORE(1); __syncthreads();
    M2_QK(SA, 0);
    bool zref;
    { float mx0; M2_MAX(SA, mx0); zref = !__any(!(fabsf(mx0) < 40.0f)); mrun = zref ? 0.0f : mx0; }
    int pbuf = 0;
#define M2_BODY(SC, SN, tt) do { const int _cb = (tt) & 3; \
        if ((tt) + 2 < nt) M2_LOAD((tt) + 2); \
        if (!zref) M2_SUB(SC, mrun); \
        bf16x8 Pn[2][2]; float rs; \
        M2_QK(SN, ((tt) + 1) & 3); \
        M2_PVOLD(pbuf); \
        M2_EXP(SC, Pn, rs); \
        _Pragma("unroll") for (int i = 0; i < 20; ++i) { __builtin_amdgcn_sched_group_barrier(0x100, 2, 0); __builtin_amdgcn_sched_group_barrier(0x008, 1, 0); \
            __builtin_amdgcn_sched_group_barrier(0x400, 2, 0); __builtin_amdgcn_sched_group_barrier(0x002, 2, 0); } \
        if (__any(!(rs < 1.0e18f))) {        \
            M2_QK(SC, _cb); float mxr; M2_MAX(SC, mxr); const float mnew = fmaxf(mrun, mxr); const float alpha = fast_exp2(mrun - mnew); \
            lsum *= alpha; O[0] *= alpha; O[1] *= alpha; mrun = mnew; zref = false; M2_SUB(SC, mrun); M2_EXP(SC, Pn, rs); } \
        lsum += rs; \
        _Pragma("unroll") for (int kt = 0; kt < 2; ++kt) _Pragma("unroll") for (int s2 = 0; s2 < 2; ++s2) Pold[kt][s2] = Pn[kt][s2]; \
        pbuf = _cb; \
        if ((tt) + 2 < nt) M2_STORE(((tt) + 2) & 3); \
        __syncthreads(); } while (0)
    for (int t = 0; t < nt; t += 2) { M2_BODY(SA, SB, t); M2_BODY(SB, SA, t + 1); }
    M2_PVOLD(pbuf);
    const float lt = lsum + shflx(lsum, 32); const float inv = 1.0f / lt;
    bf16_t* op = (bf16_t*)(ws + OFF_A) + qrow * 1024 + outoff;
#pragma unroll
    for (int dt = 0; dt < 2; ++dt)
#pragma unroll
        for (int rq = 0; rq < 4; ++rq) { const int dv = 32 * dt + 8 * rq + 4 * g;
            u32x2 wv; wv.x = cvt_pk_bf16(O[dt][4 * rq] * inv, O[dt][4 * rq + 1] * inv); wv.y = cvt_pk_bf16(O[dt][4 * rq + 2] * inv, O[dt][4 * rq + 3] * inv);
            *(u32x2*)(op + dv) = wv; }
    __syncthreads();
#undef M2_ROW
#undef M2_LOAD
#undef M2_STORE
#undef M2_QK
#undef M2_PVOLD
#undef M2_EXP
#undef M2_SUB
#undef M2_MAX
#undef M2_BODY
}

__device__ void attn_phase(PK p, int l, LAS unsigned char* lds) {
    const float lam_init = (l == 0) ? 0.2f : 0.35550906759502f;
    const float* dl = p->diff_lambda + l * 128;
    float d01 = 0.f, d23 = 0.f;
    for (int i = 0; i < 32; ++i) { d01 += dl[i] * dl[32 + i]; d23 += dl[64 + i] * dl[96 + i]; }
    const float lam = expf(d01) - expf(d23) + lam_init;
    const int nItems = 1536 + (l == 0 ? 48 : 0);
    for (int it = opaque_bid(); it < nItems; it += opaque_gdim()) {
        if (it < 1536) {
            const int ty = it >> 9, idx = it & 511, bh = ((idx & 7) << 1) | (idx >> 8), b = bh >> 2, h = bh & 3, qb = (idx >> 3) & 31;
            if (ty == 0) attn_item<1>(p, l, lds, b, h, qb, false, lam, lam_init);
            else if (ty == 1) attn_item_mla2(p, l, lds, b, h, qb, false);
            else attn_item<0>(p, l, lds, b, h, qb, false, lam, lam_init);
        } else {
            const int idx = it - 1536, ty = idx >> 4, b = (idx >> 2) & 3, h = idx & 3;
            if (ty == 0) attn_item<1>(p, l, lds, b, h, 0, true, lam, lam_init);
            else if (ty == 1) attn_item_mla2(p, l, lds, b, h, 0, true);
            else attn_item<0>(p, l, lds, b, h, 0, true, lam, lam_init);
        }
    }
}

constexpr int PH_PER_LAYER = 14, N_PHASES = 2 * PH_PER_LAYER + 1;

__device__ __forceinline__ void run_phase(PK p, int ph, LAS unsigned char* lds, float rcoef) {
    unsigned char* ws = p->ws;
    pg8::StaticOrder S;
    if (ph == N_PHASES - 1) { final_norm_phase(p->out, p->final_norm_g); return; }
    int l = ph / PH_PER_LAYER; const int q = ph % PH_PER_LAYER;
#define OPQL asm volatile("" : "+s"(l))
#define HC ((float*)(ws + OFF_HC))
#define MOD ((const float*)(ws + OFF_MOD) + (size_t)l * 5 * 9216)
#define TN ((bf16_t*)(ws + OFF_A))
#define HID ((bf16_t*)(ws + OFF_B))
#define Mlate ((l == 0) ? RA : RL)
    switch (q) {
    case 0: OPQL; layer_prep_phase(p, l, lds); break;
    case 1: OPQL; if (l == 0) norm_mod_phase(p->x, p->ctx, p->out, HC, p->norm_g + (l * 3 + 0) * 1024, MOD, TN, RA, nullptr, 0);
            else norm_mod_phase(p->out, HC, nullptr, nullptr, p->norm_g + (l * 3 + 0) * 1024, MOD, TN, RA, (const float*)(ws + OFF_PB), 11); break;
    case 2: case 12: { OPQL; const int f = (q == 2) ? 0 : 1; const int M = (q == 2) ? RA : Mlate;
        pg8::Gemm g{TN, (const bf16_t*)(ws + OFF_W1) + (size_t)f * 5632 * 1024, M, 5632, 1024, 1024, 1024}; S.init(M, 5632, opaque_gdim(), opaque_bid());
        EpiSwiglu E{HID}; pg8::gemm_phase(lds, g, S, E); } break;
    case 4: OPQL; norm_mod_phase(p->out, HC, nullptr, nullptr, p->norm_g + (l * 3 + 1) * 1024, MOD + 3 * 1024, TN, RA, (const float*)(ws + OFF_PB), 11); break;
    case 5: { OPQL; pg8::Gemm g{TN, (const bf16_t*)(ws + OFF_WM), RA, 6400, 1024, 1024, 1024}; S.init(RA, 6400, opaque_gdim(), opaque_bid());
        EpiPJ E{(bf16_t*)(ws + OFF_B), ws + OFF_C}; pg8::gemm_phase(lds, g, S, E); } break;
    case 6: prep_phase(p); break;
    case 7: { OPQL; pg8::Gemm g{(const bf16_t*)(ws + OFF_B) + C_MQ, (const bf16_t*)(ws + OFF_WL), RA, 1024, 384, PJW, 384}; S.init(RA, 1024, opaque_gdim(), opaque_bid());
        EpiMLA E{(bf16_t*)(ws + OFF_D), (bf16_t*)(ws + OFF_MK), (bf16_t*)(ws + OFF_MV), (const float*)(ws + OFF_RSTD), (const float2*)(ws + OFF_ROPE)}; pg8::gemm_phase(lds, g, S, E); } break;
    case 8: OPQL; attn_phase(p, l, lds); break;
    case 9: { OPQL; pg8::Gemm g{(const bf16_t*)(ws + OFF_A), (const bf16_t*)(ws + OFF_WB), Mlate, 1024, 1024, 1024, 1024}; S.init(Mlate, 1024, opaque_gdim(), opaque_bid());
        EpiMerge E{ws + OFF_C, (bf16_t*)(ws + OFF_D)}; pg8::gemm_phase(lds, g, S, E); } break;
    case 3: case 13: case 10: { OPQL;
        const bool isout = (q == 10); const int f = (q == 13) ? 1 : 0;
        const bf16_t* A = isout ? (const bf16_t*)(ws + OFF_D) : (const bf16_t*)HID;
        const bf16_t* Bt = isout ? (const bf16_t*)(ws + OFF_WO) : (const bf16_t*)(ws + OFF_W2) + (size_t)f * 1024 * FH;
        const int K = isout ? 1024 : FH;
        const float* gate = MOD + (isout ? 5 : (q == 3 ? 2 : 8)) * 1024;
        const float coef = (isout ? 1.0f : 0.5f) * rcoef;
        const bool withctx = (q == 3) || (l == 0);
        { pg8::Gemm g{A, Bt, RL, 1024, K, K, K}; S.init(RL, 1024, opaque_gdim(), opaque_bid());
          EpiResid E{p->out, HC, gate, coef}; pg8::gemm_phase(lds, g, S, E); }
        if (withctx) {
            const int nsu = 16 * (K / 256);
            for (int su = opaque_bid(); su < nsu; su += opaque_gdim()) {
                const int ks = su >> 4, pmn = su & 15;
                pg8::SingleUnit SU; SU.pm = 128 + (pmn >> 2); SU.pn = pmn & 3; SU.has = true;
                pg8::Gemm g2{A + ks * 256, Bt + ks * 256, RA, 1024, 256, K, K};
                EpiPartial E2{(float*)(ws + OFF_PB) + (size_t)ks * 1024 * 1024, gate + 4 * 9216, coef}; pg8::gemm_phase(lds, g2, SU, E2);
            }
        }
    } break;
    case 11: OPQL; norm_mod_phase(p->out, HC, nullptr, nullptr, p->norm_g + (l * 3 + 2) * 1024, MOD + 6 * 1024, TN, Mlate, (const float*)(ws + OFF_PB), 4); break;
    }
#undef OPQL
#undef HC
#undef MOD
#undef TN
#undef HID
#undef Mlate
}

__global__ void __launch_bounds__(512, 2) fwd_megakernel(Params p) {
    extern __shared__ __attribute__((aligned(16))) unsigned char shm[];
    LAS unsigned char* lds = (LAS unsigned char*)shm;
#if N_LAUNCH_MODE == 1
    cg::grid_group grid = cg::this_grid();
    const int ph_lo = p.ph_lo, ph_hi = p.ph_hi;
    volatile LAS unsigned* st = (volatile LAS unsigned*)(lds + pg8::STAGE_BYTES);
    unsigned* bar = (unsigned*)(p.ws + OFF_BAR);
    if (opaque_tid() < 4) st[opaque_tid()] = 0u;
    if (opaque_bid() == 0) for (int i = opaque_tid(); i < XCD_BAR_WORDS; i += 512) bar[i] = 0u;
    __syncthreads();
#if PROBE_Q >= 0
    const int nseq = 2 * (PH_PER_LAYER + 1) + 1;
    for (int i = 0; i < nseq; ++i) {
        int ph;
        if (i == nseq - 1) ph = N_PHASES - 1;
        else { const int li = i / (PH_PER_LAYER + 1), r = i % (PH_PER_LAYER + 1); ph = li * PH_PER_LAYER + (r <= PROBE_Q ? r : r - 1); }
        PK pk = (PK)__builtin_amdgcn_kernarg_segment_ptr();
        asm volatile("" : "+s"(pk));
        run_phase(pk, ph, lds, 1.0f);
        if (i == 0) { grid.sync(); xcd_barrier_post(bar); }
        else if (i + 1 < nseq) xcd_barrier(bar, st);
    }
#else
    for (int ph = ph_lo; ph < ph_hi; ++ph) {
        PK pk = (PK)__builtin_amdgcn_kernarg_segment_ptr();
        asm volatile("" : "+s"(pk));
        run_phase(pk, ph, lds, 1.0f);
        if (ph == ph_lo) { grid.sync(); xcd_barrier_post(bar); }
        else if (ph + 1 < ph_hi) xcd_barrier(bar, st);
    }
#endif
#else
    const int ph_lo = p.ph_lo, ph_hi = p.ph_hi;
    for (int ph = ph_lo; ph < ph_hi; ++ph) { PK pk = (PK)__builtin_amdgcn_kernarg_segment_ptr(); asm volatile("" : "+s"(pk)); run_phase(pk, ph, lds, 1.0f); }
#endif
}

extern "C" void kernel_launch(void* const* d_in, const int* in_sizes, int n_in, void* d_out, int out_size, void* d_ws, size_t ws_size, hipStream_t stream) {
    constexpr int LDS_BYTES = pg8::STAGE_BYTES + 16;
    static int grid_blocks = 0;
    if (grid_blocks == 0) {
        if (n_in != 22 || ws_size < WS_END) { fprintf(stderr, "kernel_launch: unexpected inputs (n_in %d, ws %zu < %zu)\n", n_in, ws_size, (size_t)WS_END); grid_blocks = -1; return; }
        int dev = 0, cus = 0, per_cu = 0;
        hipGetDevice(&dev); hipDeviceGetAttribute(&cus, hipDeviceAttributeMultiprocessorCount, dev);
        if (hipFuncSetAttribute((const void*)fwd_megakernel, hipFuncAttributeMaxDynamicSharedMemorySize, LDS_BYTES) != hipSuccess) { fprintf(stderr, "hipFuncSetAttribute failed\n"); grid_blocks = -1; return; }
        if (hipOccupancyMaxActiveBlocksPerMultiprocessor(&per_cu, (const void*)fwd_megakernel, 512, LDS_BYTES) != hipSuccess || per_cu < 1) per_cu = 1;
        (void)hipGetLastError();
        grid_blocks = cus * 1;
    }
    if (grid_blocks < 0) return;
    Params hp{};
    const float** pp = (const float**)&hp;
    for (int i = 0; i < 22; ++i) pp[i] = (const float*)d_in[i];
    hp.out = (float*)d_out; hp.ws = (unsigned char*)d_ws;
#if N_LAUNCH_MODE == 1
    hp.ph_lo = 0; hp.ph_hi = N_PHASES;
    void* args[] = {&hp};
    hipError_t e = hipLaunchCooperativeKernel((const void*)fwd_megakernel, dim3(grid_blocks), dim3(512), args, LDS_BYTES, stream);
    if (e != hipSuccess) fprintf(stderr, "cooperative launch failed: %s (grid %d)\n", hipGetErrorString(e), grid_blocks);
#else
    for (int ph = 0; ph < N_PHASES; ++ph) { hp.ph_lo = ph; hp.ph_hi = ph + 1; hipLaunchKernelGGL(fwd_megakernel, dim3(grid_blocks), dim3(512), LDS_BYTES, stream, hp); }
#endif
}
```

```cpp
#include <hip/hip_runtime.h>
#include <hip/hip_cooperative_groups.h>
#include <cstdio>
namespace cg = cooperative_groups;

#define LAS __attribute__((address_space(3)))
typedef unsigned short bf16_t;
typedef short bf16x8 __attribute__((ext_vector_type(8)));
typedef short s16x4 __attribute__((ext_vector_type(4)));
typedef float f32x4 __attribute__((ext_vector_type(4)));
typedef float f32x16 __attribute__((ext_vector_type(16)));
typedef unsigned u32x4 __attribute__((ext_vector_type(4)));
typedef unsigned u32x2 __attribute__((ext_vector_type(2)));

#ifndef PROBE_Q
#define PROBE_Q (-1)
#endif
#ifndef N_LAUNCH_MODE
#define N_LAUNCH_MODE 1
#endif

constexpr int RL = 32768, RA = 33792, FH = 2816;
constexpr int PJW = 2304;
constexpr int C_NQ = 256, C_NK = 512, C_NV = 768, C_DQ = 1024, C_DK = 1280, C_DV = 1536, C_MQ = 1792, C_MKV = 2048, C_MKR = 2176;
constexpr float LOG2E = 1.4426950408889634f;
constexpr float NEPS = 1e-6f;
constexpr int XCD_BAR_WORDS_C = 3456;

constexpr size_t SZ_W1 = 2ull * 5632 * 1024 * 2, SZ_W2 = 2ull * 1024 * 2816 * 2, SZ_WM = 6400ull * 1024 * 2, SZ_WL = 1024ull * 384 * 2, SZ_WB = 4ull * 1024 * 256 * 2, SZ_WO = 1024ull * 1024 * 2;
constexpr size_t OFF_W1 = 0, OFF_W2 = OFF_W1 + SZ_W1, OFF_WM = OFF_W2 + SZ_W2, OFF_WL = OFF_WM + SZ_WM, OFF_WB = OFF_WL + SZ_WL, OFF_WO = OFF_WB + SZ_WB;
constexpr size_t OFF_HC = OFF_WO + SZ_WO;
constexpr size_t OFF_MOD = OFF_HC + 1024ull * 1024 * 4;
constexpr size_t OFF_ROPE = OFF_MOD + 2ull * 5 * 9216 * 4;
constexpr size_t OFF_RSTD = OFF_ROPE + 128 * 8 * 8;
constexpr size_t OFF_A = OFF_RSTD + (size_t)RA * 2 * 4;
constexpr size_t OFF_B = OFF_A + (size_t)RA * 1024 * 2;
constexpr size_t OFF_C = OFF_B + (size_t)RA * PJW * 2;
constexpr size_t OFF_D = OFF_C + (size_t)RA * 4096;
constexpr size_t OFF_MK = OFF_D + (size_t)RA * 384 * 2, OFF_MV = OFF_MK + (size_t)RA * 384 * 2;
constexpr size_t OFF_BAR = OFF_D + (size_t)RA * 1024 * 2;
constexpr size_t OFF_PB = OFF_BAR + 16384;
constexpr size_t WS_END = OFF_PB + 11ull * 1024 * 1024 * 4;

struct Params {
    const float *x, *c, *ctx, *c_ctx, *ada_w, *ada_b, *norm_g, *ffn_w_in, *ffn_w_out, *mix_w_in, *pool_w, *pool_scale, *na_rpb, *diff_lambda, *diff_subln_g,
        *mla_q_norm_g, *mla_kv_norm_g, *mla_w_qb, *mla_w_kvb, *branch_w_out, *mix_w_out, *final_norm_g;
    float* out; unsigned char* ws;
    int ph_lo, ph_hi;
};

typedef const __attribute__((address_space(4))) Params* PK;

typedef float f32x2_ __attribute__((ext_vector_type(2)));
typedef __bf16 bf16x2_ __attribute__((ext_vector_type(2)));
__device__ __forceinline__ unsigned cvt_pk_bf16(float lo, float hi) { const f32x2_ v = {lo, hi}; return __builtin_bit_cast(unsigned, __builtin_convertvector(v, bf16x2_)); }
__device__ __forceinline__ float bf_lo(unsigned u) { return __uint_as_float(u << 16); }
__device__ __forceinline__ float bf_hi(unsigned u) { return __uint_as_float(u & 0xffff0000u); }
__device__ __forceinline__ float fast_exp2(float x) { return __builtin_amdgcn_exp2f(x); }
__device__ __forceinline__ float fast_rcp(float x) { return __builtin_amdgcn_rcpf(x); }
__device__ __forceinline__ float sigmoidf_(float x) { return fast_rcp(1.0f + fast_exp2(-x * LOG2E)); }
__device__ __forceinline__ float shflx(float v, int m) {
    int lane = __builtin_amdgcn_mbcnt_hi(~0u, __builtin_amdgcn_mbcnt_lo(~0u, 0)); asm volatile("" : "+v"(lane));
    return __int_as_float(__builtin_amdgcn_ds_bpermute((lane ^ m) << 2, __float_as_int(v)));
}
__device__ __forceinline__ float wave_sum(float v) {
    v += shflx(v, 32); v += shflx(v, 16); v += shflx(v, 8); v += shflx(v, 4); v += shflx(v, 2); v += shflx(v, 1); return v;
}
__device__ __forceinline__ int opaque_tid() { int t = threadIdx.x; asm volatile("" : "+v"(t)); return t; }
__device__ __forceinline__ int opaque_bid() { int t = blockIdx.x; asm volatile("" : "+s"(t)); return t; }
__device__ __forceinline__ int opaque_gdim() { int t = gridDim.x; asm volatile("" : "+s"(t)); return t; }
__device__ __forceinline__ int clampi(int v, int lo, int hi) { return v < lo ? lo : (v > hi ? hi : v); }

#define XB_TMO      128
#define XB_XCNT(j)  (256  + 64 * (j))
#define XB_XSUB(j)  (1280 + 64 * (j))
#define XB_XGEN(j)  (2304 + 64 * (j))
#define XB_TOP      3328
#define XB_TOPGEN   3392
#define XCD_BAR_WORDS 3456
#define XB_SPIN_CAP (1u << 20)
__device__ __forceinline__ unsigned xb_ld(unsigned* p)              { return __hip_atomic_load(p, __ATOMIC_RELAXED, __HIP_MEMORY_SCOPE_AGENT); }
__device__ __forceinline__ unsigned xb_add(unsigned* p, unsigned v) { return __hip_atomic_fetch_add(p, v, __ATOMIC_RELAXED, __HIP_MEMORY_SCOPE_AGENT); }
__device__ __forceinline__ unsigned xb_xcc_id() { return (unsigned)__builtin_amdgcn_s_getreg((3 << 11) | 20) & 0xFu; }
#define XB_SPIN(cond, bar) do { unsigned _sp = 0; while (cond) { __builtin_amdgcn_s_sleep(1); \
    if ((++_sp & 255u) == 0u) { if (xb_ld(&(bar)[XB_TMO])) break; if (_sp > XB_SPIN_CAP) { atomicAdd(&(bar)[XB_TMO], 1u); break; } } } } while (0)
__device__ __forceinline__ void xcd_barrier_post(unsigned* bar) { if (opaque_tid() == 0) (void)xb_add(&bar[XB_XCNT(xb_xcc_id())], 1u); }
__device__ __forceinline__ void xcd_barrier_complete(unsigned* bar, unsigned x, unsigned& nloc, unsigned& nx) {
    const unsigned G = gridDim.x;
    unsigned sum, cnt, mine, sp = 0u;
    for (;;) {
        sum = 0u; cnt = 0u; mine = 0u;
#pragma unroll
        for (unsigned j = 0; j < 16; ++j) { const unsigned c = xb_ld(&bar[XB_XCNT(j)]); sum += c; cnt += (c > 0u) ? 1u : 0u; mine = (j == x) ? c : mine; }
        if (sum == G) break;
        __builtin_amdgcn_s_sleep(1);
        if ((++sp & 255u) == 0u) { if (xb_ld(&bar[XB_TMO])) break; if (sp > XB_SPIN_CAP) { atomicAdd(&bar[XB_TMO], 1u); break; } }
    }
    nloc = mine > 0u ? mine : 1u; nx = cnt > 0u ? cnt : 1u;
}
__device__ __forceinline__ void xcd_barrier(unsigned* bar, volatile LAS unsigned* st) {
    asm volatile("s_waitcnt vmcnt(0)" ::: "memory");
    __syncthreads();
    if (opaque_tid() == 0) {
        const unsigned x = xb_xcc_id();
        __builtin_amdgcn_s_waitcnt(0);
        unsigned nloc = st[0], nx = st[1];
        if (nloc == 0u) { xcd_barrier_complete(bar, x, nloc, nx); st[0] = nloc; st[1] = nx; }
        const unsigned old = xb_add(&bar[XB_XSUB(x)], 1u);
        const unsigned gen = old / nloc;
        if (old + 1u == (gen + 1u) * nloc) {
            __builtin_amdgcn_fence(__ATOMIC_RELEASE, "agent");
            asm volatile("s_waitcnt vmcnt(0)" ::: "memory");
            const unsigned og = xb_add(&bar[XB_TOP], 1u);
            const unsigned tg = og / nx;
            if (og + 1u == (tg + 1u) * nx) xb_add(&bar[XB_TOPGEN], 1u);
            else XB_SPIN(xb_ld(&bar[XB_TOPGEN]) == tg, bar);
            __builtin_amdgcn_fence(__ATOMIC_ACQUIRE, "agent");
            xb_add(&bar[XB_XGEN(x)], 1u);
            asm volatile("s_waitcnt vmcnt(0)" ::: "memory");
        } else {
            XB_SPIN(xb_ld(&bar[XB_XGEN(x)]) == gen, bar);
            __builtin_amdgcn_fence(__ATOMIC_ACQUIRE, "agent");
            asm volatile("s_waitcnt vmcnt(0)" ::: "memory");
        }
    }
    __syncthreads();
}

namespace pg8 {
constexpr int BM = 256, BK = 64, HALF = 128, HTB = HALF * BK * 2, STAGE_BYTES = 8 * HTB, NXCD = 8, WGM = 8;
__device__ __forceinline__ int lds_byte(int r, int c) { const int st = (r >> 4) * 2 + (c >> 5), rr = r & 15, cc = c & 31, ob = rr * 64 + cc * 2; return st * 1024 + (ob ^ (((ob >> 9) & 1) << 5)); }
__device__ __forceinline__ void stage_rc(int b, int& R, int& C) { const int st = b / 1024, sb = b % 1024, swz = sb ^ (((sb >> 9) & 1) << 5); R = (st >> 1) * 16 + swz / 64; C = (st & 1) * 32 + (swz % 64) / 2; }
__device__ __forceinline__ int perm32(int rho) { const int n = rho >> 4, i = rho & 15; return 8 * (i >> 2) + 4 * n + (i & 3); }
struct Unit { int pm, pn; };
struct Gemm { const bf16_t* A; const bf16_t* Bt; int M, N, K, lda, ldb; };
struct StaticOrder {
    int nM, nN, nwg, G, c;
    __device__ void init(int M, int N, int G_, int c_) { nM = M / BM; nN = N / BM; nwg = nM * nN; G = G_; c = c_; }
    __device__ bool next(int i, Unit& u) const {
        const long L = (long)i * G + c; if (L >= nwg) return false;
        int wgid = (int)L; { const int q = nwg / NXCD, r = nwg % NXCD, xcd = wgid % NXCD, off = wgid / NXCD; wgid = (xcd < r ? xcd * (q + 1) : r * (q + 1) + (xcd - r) * q) + off; }
        const int nig = WGM * nN, gid = wgid / nig, fm = gid * WGM, gsz = (nM - fm) < WGM ? (nM - fm) : WGM;
        u.pm = fm + ((wgid % nig) % gsz); u.pn = (wgid % nig) / gsz; return true;
    }
};

struct SingleUnit {
    int pm, pn; bool has;
    __device__ bool next(int i, Unit& u) const { if (i > 0 || !has) return false; u.pm = pm; u.pn = pn; return true; }
};
template <class Epi, class Sched>
__device__ __forceinline__ void gemm_phase(LAS unsigned char* lds, const Gemm g, const Sched& S, const Epi& E) {
    const int tid = opaque_tid(), wid = __builtin_amdgcn_readfirstlane(tid >> 6), lane = tid & 63, wr = wid >> 2, wc = wid & 3, fr = lane & 15, fq = lane >> 4;
    const int K = g.K, nt = K / BK;
    unsigned voffA[2], voffB[2];
#pragma unroll
    for (int i = 0; i < 2; ++i) { int R, C; stage_rc(tid * 16 + i * 8192, R, C); const int Rb = Epi::PERM ? ((R & ~31) + perm32(R & 31)) : R;
        voffA[i] = (unsigned)(R * g.lda + C) * 2u; voffB[i] = (unsigned)(Rb * g.ldb + C) * 2u; }
    const size_t kstep = (size_t)(BK * 2);
    const size_t hstepA = (size_t)HALF * g.lda * 2, hstepB = (size_t)HALF * g.ldb * 2;
    const size_t tstepA = 2 * hstepA, tstepB = 2 * hstepB;
    const unsigned ldsw = (unsigned)wid * 1024u;
    const int aoff = lds_byte(wr * 64 + fr, fq * 8), boff = lds_byte(wc * 32 + fr, fq * 8);
#define PG8_SA(b, h) (((b) * 2 + (h)) * HTB)
#define PG8_SB(b, h) ((4 + (b) * 2 + (h)) * HTB)
#define PG8_STAGE(bufoff, gbase, voff) do { _Pragma("unroll") for (int _i = 0; _i < 2; ++_i) \
        __builtin_amdgcn_global_load_lds((const unsigned*)((const char*)(gbase) + (voff)[_i]), (LAS unsigned*)(lds + (bufoff) + ldsw + _i * 8192), 16, 0, 0); } while (0)
#define PG8_LDA(dst, b, h) do { _Pragma("unroll") for (int m = 0; m < 4; ++m) _Pragma("unroll") for (int k = 0; k < 2; ++k) dst[m][k] = *(const LAS bf16x8*)(lds + PG8_SA(b, h) + aoff + m * 2048 + k * 1024); } while (0)
#define PG8_LDB(dst, b, h) do { _Pragma("unroll") for (int n = 0; n < 2; ++n) _Pragma("unroll") for (int k = 0; k < 2; ++k) dst[n][k] = *(const LAS bf16x8*)(lds + PG8_SB(b, h) + boff + n * 2048 + k * 1024); } while (0)
#define PG8_MMA(ai, bj, At, Bt) do { __builtin_amdgcn_s_setprio(1); _Pragma("unroll") for (int m = 0; m < 4; ++m) _Pragma("unroll") for (int n = 0; n < 2; ++n) _Pragma("unroll") for (int k = 0; k < 2; ++k) \
        acc[ai][bj][m][n] = __builtin_amdgcn_mfma_f32_16x16x32_bf16(Bt[n][k], At[m][k], acc[ai][bj][m][n], 0, 0, 0); __builtin_amdgcn_s_setprio(0); } while (0)
#define PG8_WAIT_V(n) asm volatile("s_waitcnt vmcnt(" #n ")" ::: "memory")
#define PG8_WAIT_L(n) asm volatile("s_waitcnt lgkmcnt(" #n ")" ::: "memory")
#define PG8_BAR __builtin_amdgcn_s_barrier()
#define PG8_SCHED __builtin_amdgcn_sched_barrier(0)
    Unit cur, nxt; int ui = 0;
    if (!S.next(0, cur)) return;
    f32x4 acc[2][2][4][2];
#pragma unroll
    for (int a = 0; a < 2; ++a)
#pragma unroll
        for (int b = 0; b < 2; ++b)
#pragma unroll
            for (int m = 0; m < 4; ++m)
#pragma unroll
                for (int n = 0; n < 2; ++n) acc[a][b][m][n] = (f32x4){0.f, 0.f, 0.f, 0.f};
    bf16x8 At[4][2], B0[2][2], B1[2][2];
    const char* cA = (const char*)g.A + (size_t)cur.pm * tstepA; const char* cB = (const char*)g.Bt + (size_t)cur.pn * tstepB;
    PG8_STAGE(PG8_SB(0, 0), cB, voffB); PG8_STAGE(PG8_SA(0, 0), cA, voffA); PG8_STAGE(PG8_SB(0, 1), cB + hstepB, voffB); PG8_STAGE(PG8_SA(0, 1), cA + hstepA, voffA);
    if (wr == 1) PG8_BAR;
    PG8_WAIT_V(4); PG8_BAR;
    PG8_STAGE(PG8_SB(1, 0), cB + kstep, voffB); PG8_STAGE(PG8_SA(1, 0), cA + kstep, voffA); PG8_STAGE(PG8_SB(1, 1), cB + hstepB + kstep, voffB);
    PG8_WAIT_V(6); PG8_BAR;
    for (;;) {
        const bool has_next = S.next(ui + 1, nxt);
        const char* nA = has_next ? (const char*)g.A + (size_t)nxt.pm * tstepA : cA; const char* nB = has_next ? (const char*)g.Bt + (size_t)nxt.pn * tstepB : cB;
        for (int t = 0; t < nt; t += 2) {
            const bool last = (t == nt - 2);
            const char* a1 = cA + (size_t)(t + 1) * kstep;
            const char* a2 = last ? nA : cA + (size_t)(t + 2) * kstep; const char* b2 = last ? nB : cB + (size_t)(t + 2) * kstep;
            const char* a3 = a2 + kstep; const char* b3 = b2 + kstep;
            PG8_LDB(B0, 0, 0); PG8_SCHED; PG8_LDA(At, 0, 0); PG8_STAGE(PG8_SA(1, 1), a1 + hstepA, voffA);
            PG8_WAIT_L(8); PG8_BAR; PG8_WAIT_L(0); PG8_MMA(0, 0, At, B0); PG8_BAR; PG8_SCHED;
            PG8_LDB(B1, 0, 1); PG8_STAGE(PG8_SB(0, 0), b2, voffB);
            PG8_BAR; PG8_WAIT_L(0); PG8_MMA(0, 1, At, B1); PG8_BAR;
            PG8_LDA(At, 0, 1); PG8_STAGE(PG8_SA(0, 0), a2, voffA);
            PG8_BAR; PG8_WAIT_L(0); PG8_MMA(1, 0, At, B0); PG8_BAR; PG8_SCHED;
            PG8_STAGE(PG8_SB(0, 1), b2 + hstepB, voffB);
            PG8_WAIT_V(6); PG8_BAR; PG8_MMA(1, 1, At, B1); PG8_BAR;
            PG8_LDB(B0, 1, 0); PG8_SCHED; PG8_LDA(At, 1, 0); PG8_STAGE(PG8_SA(0, 1), a2 + hstepA, voffA);
            PG8_WAIT_L(8); PG8_BAR; PG8_WAIT_L(0); PG8_MMA(0, 0, At, B0); PG8_BAR; PG8_SCHED;
            PG8_LDB(B1, 1, 1); PG8_STAGE(PG8_SB(1, 0), b3, voffB);
            PG8_BAR; PG8_WAIT_L(0); PG8_MMA(0, 1, At, B1); PG8_BAR;
            PG8_LDA(At, 1, 1); PG8_STAGE(PG8_SA(1, 0), a3, voffA);
            PG8_BAR; PG8_WAIT_L(0); PG8_MMA(1, 0, At, B0); PG8_BAR; PG8_SCHED;
            PG8_STAGE(PG8_SB(1, 1), b3 + hstepB, voffB);
            PG8_WAIT_V(6); PG8_BAR; PG8_MMA(1, 1, At, B1); PG8_BAR;
            if constexpr (Epi::HOOK) { if ((((t + 2) & 3) == 0) && !last) E.hook(acc, cur, (t + 2) >> 2, wr, wc, fr, fq); }
        }
        E(acc, cur, wr, wc, fr, fq);
        if (!has_next) break;
#pragma unroll
        for (int a = 0; a < 2; ++a)
#pragma unroll
            for (int b = 0; b < 2; ++b)
#pragma unroll
                for (int m = 0; m < 4; ++m)
#pragma unroll
                    for (int n = 0; n < 2; ++n) acc[a][b][m][n] = (f32x4){0.f, 0.f, 0.f, 0.f};
        cur = nxt; cA = nA; cB = nB; ++ui;
    }
    PG8_WAIT_V(0);
    if (wr == 0) PG8_BAR;
    PG8_BAR;
#undef PG8_SA
#undef PG8_SB
#undef PG8_STAGE
#undef PG8_LDA
#undef PG8_LDB
#undef PG8_MMA
#undef PG8_WAIT_V
#undef PG8_WAIT_L
#undef PG8_BAR
#undef PG8_SCHED
}
}
using pg8::Unit;

__device__ __forceinline__ size_t g8_off(int row, int colg) { return ((size_t)(row >> 4) * 128 + (colg >> 5)) * 512 + (row & 15) * 32 + (colg & 31); }

struct EpiSwiglu {
    static constexpr bool HOOK = false;
    static constexpr bool PERM = true;
    bf16_t* HID;
    __device__ __forceinline__ void operator()(const f32x4 (&acc)[2][2][4][2], const Unit& u, int wr, int wc, int fr, int fq) const {
        { const int t_ = opaque_tid(); wr = t_ >> 8; wc = (t_ >> 6) & 3; fr = t_ & 15; fq = (t_ >> 4) & 3; }
        const int row0 = u.pm * 256 + wr * 64 + fr, col0 = u.pn * 128 + wc * 32 + 8 * fq;
#pragma unroll
        for (int ai = 0; ai < 2; ++ai)
#pragma unroll
            for (int m = 0; m < 4; ++m) {
                const int row = row0 + ai * 128 + m * 16;
                float hv[8];
#pragma unroll
                for (int n = 0; n < 2; ++n)
#pragma unroll
                    for (int j = 0; j < 4; ++j) { const float a = acc[ai][0][m][n][j], b = acc[ai][1][m][n][j]; hv[4 * n + j] = a * sigmoidf_(a) * b; }
                u32x4 w; w.x = cvt_pk_bf16(hv[0], hv[1]); w.y = cvt_pk_bf16(hv[2], hv[3]); w.z = cvt_pk_bf16(hv[4], hv[5]); w.w = cvt_pk_bf16(hv[6], hv[7]);
                *(u32x4*)(HID + (size_t)row * FH + col0) = w;
            }
    }
};
struct EpiResid {
    static constexpr bool HOOK = false;
    static constexpr bool PERM = false;
    float* Hl; float* Hc; const float* gate; float coef;
    __device__ __forceinline__ void operator()(const f32x4 (&acc)[2][2][4][2], const Unit& u, int wr, int wc, int fr, int fq) const {
        { const int t_ = opaque_tid(); wr = t_ >> 8; wc = (t_ >> 6) & 3; fr = t_ & 15; fq = (t_ >> 4) & 3; }
        const int row0 = u.pm * 256 + wr * 64 + fr, col0 = u.pn * 256 + wc * 32 + 4 * fq;
#pragma unroll
        for (int ai = 0; ai < 2; ++ai)
#pragma unroll
            for (int m = 0; m < 4; ++m) {
                const int row = row0 + ai * 128 + m * 16;
                float* hp = row < RL ? Hl + (size_t)row * 1024 : Hc + (size_t)(row - RL) * 1024;
                const float* gp = gate + (row < RL ? (row >> 13) : 4) * 9216;
#pragma unroll
                for (int bj = 0; bj < 2; ++bj)
#pragma unroll
                    for (int n = 0; n < 2; ++n) {
                        const int c = col0 + bj * 128 + n * 16;
                        const f32x4 g4 = *(const f32x4*)(gp + c); f32x4 h4 = *(const f32x4*)(hp + c);
                        h4 += (g4 * coef) * acc[ai][bj][m][n];
                        *(f32x4*)(hp + c) = h4;
                    }
            }
    }
};
struct EpiPartial {
    static constexpr bool HOOK = false;
    static constexpr bool PERM = false;
    float* PB; const float* gate; float coef;
    __device__ __forceinline__ void operator()(const f32x4 (&acc)[2][2][4][2], const Unit& u, int wr, int wc, int fr, int fq) const {
        { const int t_ = opaque_tid(); wr = t_ >> 8; wc = (t_ >> 6) & 3; fr = t_ & 15; fq = (t_ >> 4) & 3; }
        const int row0 = u.pm * 256 + wr * 64 + fr - RL, col0 = u.pn * 256 + wc * 32 + 4 * fq;
#pragma unroll
        for (int ai = 0; ai < 2; ++ai)
#pragma unroll
            for (int m = 0; m < 4; ++m) {
                float* hp = PB + (size_t)(row0 + ai * 128 + m * 16) * 1024;
#pragma unroll
                for (int bj = 0; bj < 2; ++bj)
#pragma unroll
                    for (int n = 0; n < 2; ++n) {
                        const int c = col0 + bj * 128 + n * 16;
                        const f32x4 g4 = *(const f32x4*)(gate + c);
                        *(f32x4*)(hp + c) = (g4 * coef) * acc[ai][bj][m][n];
                    }
            }
    }
};
struct EpiPJ {
    static constexpr bool HOOK = false;
    static constexpr bool PERM = true;
    bf16_t* PJ; unsigned char* G8;
    __device__ __forceinline__ void operator()(const f32x4 (&acc)[2][2][4][2], const Unit& u, int wr, int wc, int fr, int fq) const {
        { const int t_ = opaque_tid(); wr = t_ >> 8; wc = (t_ >> 6) & 3; fr = t_ & 15; fq = (t_ >> 4) & 3; }
        const int row0 = u.pm * 256 + wr * 64 + fr, c0 = wc * 32 + 8 * fq;
        if (u.pn < 9) {
#pragma unroll
            for (int ai = 0; ai < 2; ++ai)
#pragma unroll
                for (int m = 0; m < 4; ++m) {
                    const int row = row0 + ai * 128 + m * 16;
#pragma unroll
                    for (int bj = 0; bj < 2; ++bj) {
                        const f32x4 v0 = acc[ai][bj][m][0], v1 = acc[ai][bj][m][1];
                        u32x4 w; w.x = cvt_pk_bf16(v0[0], v0[1]); w.y = cvt_pk_bf16(v0[2], v0[3]); w.z = cvt_pk_bf16(v1[0], v1[1]); w.w = cvt_pk_bf16(v1[2], v1[3]);
                        *(u32x4*)(PJ + (size_t)row * PJW + u.pn * 256 + bj * 128 + c0) = w;
                    }
                }
        } else {
#pragma unroll
            for (int ai = 0; ai < 2; ++ai)
#pragma unroll
                for (int m = 0; m < 4; ++m) {
                    const int row = row0 + ai * 128 + m * 16;
#pragma unroll
                    for (int bj = 0; bj < 2; ++bj) {
                        unsigned q[8];
#pragma unroll
                        for (int n = 0; n < 2; ++n)
#pragma unroll
                            for (int j = 0; j < 4; ++j) { int v = (int)(sigmoidf_(acc[ai][bj][m][n][j]) * 256.0f); q[4 * n + j] = (unsigned)(v > 255 ? 255 : v); }
                        u32x2 w; w.x = q[0] | (q[1] << 8) | (q[2] << 16) | (q[3] << 24); w.y = q[4] | (q[5] << 8) | (q[6] << 16) | (q[7] << 24);
                        *(u32x2*)(G8 + g8_off(row, (u.pn - 9) * 256 + bj * 128 + c0)) = w;
                    }
                }
        }
    }
};
struct EpiMLA {
    static constexpr bool HOOK = false;
    static constexpr bool PERM = true;
    bf16_t *MQ, *MK, *MV; const float* RSTD; const float2* RT;
    __device__ __forceinline__ void operator()(const f32x4 (&acc)[2][2][4][2], const Unit& u, int wr, int wc, int fr, int fq) const {
        { const int t_ = opaque_tid(); wr = t_ >> 8; wc = (t_ >> 6) & 3; fr = t_ & 15; fq = (t_ >> 4) & 3; }
        const int row0 = u.pm * 256 + wr * 64 + fr;
#pragma unroll
        for (int bj = 0; bj < 2; ++bj) {
            const int cg0 = u.pn * 256 + bj * 128 + wc * 32;
            if (cg0 >= 896) continue;
#pragma unroll
            for (int ai = 0; ai < 2; ++ai)
#pragma unroll
                for (int m = 0; m < 4; ++m) {
                    __builtin_amdgcn_sched_barrier(0);
                    const int row = row0 + ai * 128 + m * 16;
                    float v[8];
                    if (cg0 < 384) {
                        const float rs = RSTD[row * 2];
#pragma unroll
                        for (int n = 0; n < 2; ++n)
#pragma unroll
                            for (int j = 0; j < 4; ++j) v[4 * n + j] = acc[ai][bj][m][n][j] * rs;
                        const int d0 = cg0 % 96;
                        if (d0 == 64) {
                            const bool lat = row < RL; const int t = row & 8191; const int pos = (fq >> 1) ? (t & 63) : (t >> 6); const bool isx2 = fq & 1;
#pragma unroll
                            for (int e = 0; e < 8; ++e) {
                                const float pr = shflx(v[e], 16);
                                const float2 cs = RT[pos * 8 + e];
                                const float r = isx2 ? (pr * cs.y + v[e] * cs.x) : (v[e] * cs.x - pr * cs.y);
                                v[e] = lat ? r : v[e];
                            }
                        }
                        u32x4 w; w.x = cvt_pk_bf16(v[0], v[1]); w.y = cvt_pk_bf16(v[2], v[3]); w.z = cvt_pk_bf16(v[4], v[5]); w.w = cvt_pk_bf16(v[6], v[7]);
                        *(u32x4*)(MQ + (size_t)row * 384 + cg0 + 8 * fq) = w;
                    } else {
                        const float rs = RSTD[row * 2 + 1];
#pragma unroll
                        for (int n = 0; n < 2; ++n)
#pragma unroll
                            for (int j = 0; j < 4; ++j) v[4 * n + j] = acc[ai][bj][m][n][j] * rs;
                        const int cp = cg0 - 384, hd = cp >> 7, d0 = cp & 127;
                        u32x4 w; w.x = cvt_pk_bf16(v[0], v[1]); w.y = cvt_pk_bf16(v[2], v[3]); w.z = cvt_pk_bf16(v[4], v[5]); w.w = cvt_pk_bf16(v[6], v[7]);
                        if (d0 < 64) *(u32x4*)(MK + (size_t)row * 384 + hd * 96 + d0 + 8 * fq) = w;
                        else *(u32x4*)(MV + (size_t)row * 256 + hd * 64 + (d0 - 64) + 8 * fq) = w;
                    }
                }
        }
    }
};
struct EpiMerge {
    static constexpr bool PERM = true, HOOK = true;
    const unsigned char* G8; bf16_t* MG;
    __device__ __forceinline__ void hook(f32x4 (&acc)[2][2][4][2], const Unit& u, int nb, int wr, int wc, int fr, int fq) const {
        { const int t_ = opaque_tid(); wr = t_ >> 8; wc = (t_ >> 6) & 3; fr = t_ & 15; fq = (t_ >> 4) & 3; }
        const int row0 = u.pm * 256 + wr * 64 + fr, c0 = u.pn * 256 + wc * 32 + 8 * fq;
#pragma unroll
        for (int ai = 0; ai < 2; ++ai) {
            u32x2 ga[4][2], gb[4][2];
#pragma unroll
            for (int m = 0; m < 4; ++m)
#pragma unroll
                for (int bj = 0; bj < 2; ++bj) { const int row = row0 + ai * 128 + m * 16, c = c0 + bj * 128;
                    ga[m][bj] = *(const u32x2*)(G8 + g8_off(row, (nb - 1) * 1024 + c)); gb[m][bj] = *(const u32x2*)(G8 + g8_off(row, nb * 1024 + c)); }
#pragma unroll
            for (int m = 0; m < 4; ++m)
#pragma unroll
                for (int bj = 0; bj < 2; ++bj)
#pragma unroll
                    for (int e = 0; e < 8; ++e) { const unsigned qa = ((e < 4 ? ga[m][bj].x : ga[m][bj].y) >> (8 * (e & 3))) & 255u, qb = ((e < 4 ? gb[m][bj].x : gb[m][bj].y) >> (8 * (e & 3))) & 255u;
                        acc[ai][bj][m][e >> 2][e & 3] *= ((float)qa + 0.5f) * fast_rcp((float)qb + 0.5f); }
            __builtin_amdgcn_sched_barrier(0);
        }
    }
    __device__ __forceinline__ void operator()(const f32x4 (&acc)[2][2][4][2], const Unit& u, int wr, int wc, int fr, int fq) const {
        { const int t_ = opaque_tid(); wr = t_ >> 8; wc = (t_ >> 6) & 3; fr = t_ & 15; fq = (t_ >> 4) & 3; }
        const int row0 = u.pm * 256 + wr * 64 + fr, c0 = u.pn * 256 + wc * 32 + 8 * fq;
#pragma unroll
        for (int ai = 0; ai < 2; ++ai) {
            u32x2 gq[4][2];
#pragma unroll
            for (int m = 0; m < 4; ++m)
#pragma unroll
                for (int bj = 0; bj < 2; ++bj) gq[m][bj] = *(const u32x2*)(G8 + g8_off(row0 + ai * 128 + m * 16, 3 * 1024 + c0 + bj * 128));
#pragma unroll
            for (int m = 0; m < 4; ++m)
#pragma unroll
                for (int bj = 0; bj < 2; ++bj) {
                    const int row = row0 + ai * 128 + m * 16, c = c0 + bj * 128;
                    float v[8];
#pragma unroll
                    for (int e = 0; e < 8; ++e) { const unsigned q = ((e < 4 ? gq[m][bj].x : gq[m][bj].y) >> (8 * (e & 3))) & 255u; v[e] = ((float)q + 0.5f) * (1.0f / 256.0f) * acc[ai][bj][m][e >> 2][e & 3]; }
                    u32x4 w; w.x = cvt_pk_bf16(v[0], v[1]); w.y = cvt_pk_bf16(v[2], v[3]); w.z = cvt_pk_bf16(v[4], v[5]); w.w = cvt_pk_bf16(v[6], v[7]);
                    *(u32x4*)(MG + (size_t)row * 1024 + c) = w;
                }
            __builtin_amdgcn_sched_barrier(0);
        }
    }
};

template <class F>
__device__ __forceinline__ void wt_rows64(bf16_t* dst, int K, F srcval, int ldd, int kbeg, int kend) {
    if (ldd == 0) ldd = K;
    if (kend > K) kend = K;
    const int tid_ = opaque_tid(); const int nl = tid_ & 63, kq = tid_ >> 6;
    for (int k0 = kbeg + kq * 8; k0 < kend; k0 += 64) {
        float v[8];
#pragma unroll
        for (int j = 0; j < 8; ++j) v[j] = srcval(nl, k0 + j);
        u32x4 w; w.x = cvt_pk_bf16(v[0], v[1]); w.y = cvt_pk_bf16(v[2], v[3]); w.z = cvt_pk_bf16(v[4], v[5]); w.w = cvt_pk_bf16(v[6], v[7]);
        *(u32x4*)(dst + (size_t)nl * ldd + k0) = w;
    }
}

__device__ void layer_prep_phase(PK p, int l, LAS unsigned char* lds) {
    unsigned char* ws = p->ws;
    const int nW = 1648, nItems = nW + (l == 0 ? 288 + 1 : 0);
    for (int it2 = opaque_bid(); it2 < nItems; it2 += opaque_gdim()) {
        int it, kbeg = 0, kend = 1 << 30;
        if (it2 < 704) { it = it2 >> 2; kbeg = (it2 & 3) * 256; kend = kbeg + 256; }
        else if (it2 < 1056) { const int q = it2 - 704; it = 176 + q / 11; kbeg = (q % 11) * 256; kend = kbeg + 256; }
        else if (it2 < 1456) { const int q = it2 - 1056; it = 208 + (q >> 2); kbeg = (q & 3) * 256; kend = kbeg + 256; }
        else if (it2 < 1520) { const int q = it2 - 1456; it = 308 + (q >> 2); kbeg = (q & 3) * 256; kend = kbeg + 256; }
        else if (it2 < 1568) { it = 324 + (it2 - 1520); }
        else if (it2 < 1632) { const int q = it2 - 1568; it = 372 + (q >> 2); kbeg = (q & 3) * 64; kend = kbeg + 64; }
        else if (it2 < 1648) { it = 388 + (it2 - 1632); }
        else it = 404 + (it2 - 1648);
        if (it < 176) {
            const int f = it / 88, j = it % 88; const float* src = p->ffn_w_in + ((size_t)(l * 2 + f) * 1024) * 5632;
            bf16_t* dst = (bf16_t*)(ws + OFF_W1) + ((size_t)f * 5632 + j * 64) * 1024;
            wt_rows64(dst, 1024, [&](int nl, int k) { const int np = j * 64 + nl, pn = np >> 8, wi = np & 255; const int col = wi < 128 ? pn * 128 + wi : FH + pn * 128 + (wi - 128); return src[(size_t)k * 5632 + col]; }, 0, kbeg, kend);
        } else if (it < 208) {
            const int q = it - 176, f = q / 16, j = q % 16; const float* src = p->ffn_w_out + ((size_t)(l * 2 + f) * FH) * 1024;
            bf16_t* dst = (bf16_t*)(ws + OFF_W2) + ((size_t)f * 1024 + j * 64) * FH;
            wt_rows64(dst, FH, [&](int nl, int k) { return src[(size_t)k * 1024 + j * 64 + nl]; }, 0, kbeg, kend);
        } else if (it < 308) {
            const int j = it - 208; const float* src = p->mix_w_in + (size_t)l * 1024 * 6304;
            bf16_t* dst = (bf16_t*)(ws + OFF_WM) + (size_t)j * 64 * 1024;
            wt_rows64(dst, 1024, [&](int nl, int k) { const int np = j * 64 + nl; const int col = np < 2208 ? np : (np < 2304 ? -1 : np - 96); return col < 0 ? 0.f : src[(size_t)k * 6304 + col]; }, 0, kbeg, kend);
        } else if (it < 324) {
            const int j = it - 308; const float* src = p->mix_w_out + (size_t)l * 1024 * 1024;
            bf16_t* dst = (bf16_t*)(ws + OFF_WO) + (size_t)j * 64 * 1024;
            wt_rows64(dst, 1024, [&](int nl, int k) { return src[(size_t)k * 1024 + j * 64 + nl]; }, 0, kbeg, kend);
        } else if (it < 372) {
            const int q = it - 324, bi = 1 + q / 16, j = q % 16; const float* src = p->branch_w_out + ((size_t)(l * 4 + bi) * 256) * 1024;
            bf16_t* dst = (bf16_t*)(ws + OFF_WB) + (size_t)j * 64 * 1024 + bi * 256;
            wt_rows64(dst, 256, [&](int nl, int k) { return src[(size_t)k * 1024 + j * 64 + nl]; }, 1024, kbeg, kend);
        } else if (it < 388) {
            const int j = it - 372; const float* wb = p->branch_w_out + ((size_t)(l * 4) * 256) * 1024; const float* pw = p->pool_w + (size_t)l * 4 * 64 * 64; const float* ps = p->pool_scale + l * 256;
            bf16_t* dst = (bf16_t*)(ws + OFF_WB) + (size_t)j * 64 * 1024;
            wt_rows64(dst, 256, [&](int nl, int k) { const int gI = k >> 6, n = j * 64 + nl; const float* pr = pw + (size_t)k * 64; float s = 0.f;
                for (int e = 0; e < 64; ++e) s += pr[e] * ps[gI * 64 + e] * wb[(size_t)(gI * 64 + e) * 1024 + n]; return s; }, 1024, kbeg, kend);
        } else if (it < 404) {
            const int j = it - 388; const float* wq = p->mla_w_qb + (size_t)l * 256 * 384; const float* wk = p->mla_w_kvb + (size_t)l * 128 * 512;
            const float* gq = p->mla_q_norm_g + l * 256; const float* gk = p->mla_kv_norm_g + l * 128;
            bf16_t* dst = (bf16_t*)(ws + OFF_WL) + (size_t)j * 64 * 384;
            wt_rows64(dst, 384, [&](int nl, int k) { const int n = j * 64 + nl;
                if (n < 384) return k < 256 ? gq[k] * wq[(size_t)k * 384 + n] : 0.f;
                if (n < 896) return k >= 256 ? gk[k - 256] * wk[(size_t)(k - 256) * 512 + (n - 384)] : 0.f;
                return 0.f; }, 0, kbeg, kend);
        } else if (it < 404 + 288) {
            const int q = it - 404, ll = q / 144, cb = q % 144;
            LAS float* sc = (LAS float*)lds;
            LAS float* red = (LAS float*)(lds + 5 * 1024 * 4);
            __syncthreads();
            for (int i = opaque_tid(); i < 5 * 1024; i += 512) { const int r = i >> 10, k = i & 1023; const float cv = r < 4 ? p->c[r * 1024 + k] : p->c_ctx[k]; sc[i] = cv * sigmoidf_(cv); }
            __syncthreads();
            const int jl = opaque_tid() & 63, kg = opaque_tid() >> 6; const int col = cb * 64 + jl;
            const float* wsrc = p->ada_w + (size_t)ll * 1024 * 9216 + col;
            float a0 = 0.f, a1 = 0.f, a2 = 0.f, a3 = 0.f, a4 = 0.f;
            for (int k = kg * 128; k < kg * 128 + 128; ++k) { const float wv = wsrc[(size_t)k * 9216]; a0 += sc[k] * wv; a1 += sc[1024 + k] * wv; a2 += sc[2048 + k] * wv; a3 += sc[3072 + k] * wv; a4 += sc[4096 + k] * wv; }
            red[(kg * 5 + 0) * 64 + jl] = a0; red[(kg * 5 + 1) * 64 + jl] = a1; red[(kg * 5 + 2) * 64 + jl] = a2; red[(kg * 5 + 3) * 64 + jl] = a3; red[(kg * 5 + 4) * 64 + jl] = a4;
            __syncthreads();
            if (opaque_tid() < 320) { const int r = opaque_tid() >> 6; float s = p->ada_b[ll * 9216 + col];
                for (int q2 = 0; q2 < 8; ++q2) s += red[(q2 * 5 + r) * 64 + jl];
                ((float*)(ws + OFF_MOD))[(size_t)(ll * 5 + r) * 9216 + col] = s; }
        } else {
            for (int i = opaque_tid(); i < 1024; i += 512) { const int pos = i >> 3, fi = i & 7; const float inv = exp2f(-(float)fi * 0.125f * 13.287712379549449f); const float ang = (float)pos * inv;
                ((float2*)(ws + OFF_ROPE))[i] = make_float2(cosf(ang), sinf(ang)); }
        }
    }
}

__device__ void norm_mod_phase(const float* srcL, const float* srcC, float* cpyL, float* cpyC, const float* g, const float* mod, bf16_t* TN, int nrows, const float* pb, int nsl) {
    const int tid_ = opaque_tid(); const int lane = tid_ & 63, gw = opaque_bid() * 8 + (tid_ >> 6), nw = opaque_gdim() * 8;
    for (int row = gw; row < nrows; row += nw) {
        const bool lat = row < RL;
        const float* sp = lat ? srcL + (size_t)row * 1024 : srcC + (size_t)(row - RL) * 1024;
        const float* mp = mod + (lat ? (row >> 13) : 4) * 9216;
        f32x4 v[4]; float ss = 0.f;
#pragma unroll
        for (int j = 0; j < 4; ++j) v[j] = *(const f32x4*)(sp + 256 * j + 4 * lane);
        if (!lat && nsl > 0) {
            for (int sl = 0; sl < nsl; ++sl) { const float* pp = pb + ((size_t)sl * 1024 + (row - RL)) * 1024;
#pragma unroll
                for (int j = 0; j < 4; ++j) v[j] += *(const f32x4*)(pp + 256 * j + 4 * lane); }
            float* wp = (float*)sp;
#pragma unroll
            for (int j = 0; j < 4; ++j) *(f32x4*)(wp + 256 * j + 4 * lane) = v[j];
        }
#pragma unroll
        for (int j = 0; j < 4; ++j) ss += v[j][0] * v[j][0] + v[j][1] * v[j][1] + v[j][2] * v[j][2] + v[j][3] * v[j][3];
        if (cpyL) { float* cp = lat ? cpyL + (size_t)row * 1024 : cpyC + (size_t)(row - RL) * 1024;
#pragma unroll
            for (int j = 0; j < 4; ++j) *(f32x4*)(cp + 256 * j + 4 * lane) = v[j]; }
        ss = wave_sum(ss);
        const float rstd = rsqrtf(ss * (1.0f / 1024.0f) + NEPS);
#pragma unroll
        for (int j = 0; j < 4; ++j) {
            const int col = 256 * j + 4 * lane;
            const f32x4 gg = *(const f32x4*)(g + col), sh = *(const f32x4*)(mp + col), sc = *(const f32x4*)(mp + 1024 + col);
            float o[4];
#pragma unroll
            for (int e = 0; e < 4; ++e) o[e] = (v[j][e] * rstd * gg[e]) * (1.0f + sc[e]) + sh[e];
            u32x2 w; w.x = cvt_pk_bf16(o[0], o[1]); w.y = cvt_pk_bf16(o[2], o[3]);
            *(u32x2*)(TN + (size_t)row * 1024 + col) = w;
        }
    }
}
__device__ void final_norm_phase(float* H, const float* g) {
    const int tid_ = opaque_tid(); const int lane = tid_ & 63, gw = opaque_bid() * 8 + (tid_ >> 6), nw = opaque_gdim() * 8;
    for (int row = gw; row < RL; row += nw) {
        float* sp = H + (size_t)row * 1024; f32x4 v[4]; float ss = 0.f;
#pragma unroll
        for (int j = 0; j < 4; ++j) { v[j] = *(const f32x4*)(sp + 256 * j + 4 * lane); ss += v[j][0] * v[j][0] + v[j][1] * v[j][1] + v[j][2] * v[j][2] + v[j][3] * v[j][3]; }
        ss = wave_sum(ss);
        const float rstd = rsqrtf(ss * (1.0f / 1024.0f) + NEPS);
#pragma unroll
        for (int j = 0; j < 4; ++j) { const f32x4 gg = *(const f32x4*)(g + 256 * j + 4 * lane); *(f32x4*)(sp + 256 * j + 4 * lane) = v[j] * rstd * gg; }
    }
}

__device__ void prep_phase(PK p) {
    unsigned char* ws = p->ws;
    bf16_t* PJ = (bf16_t*)(ws + OFF_B); bf16_t* YB = (bf16_t*)(ws + OFF_A); bf16_t* MK = (bf16_t*)(ws + OFF_MK); float* RSTD = (float*)(ws + OFF_RSTD);
    const float2* RT = (const float2*)(ws + OFF_ROPE);
    const int tid_ = opaque_tid(); const int lane = tid_ & 63, gw = opaque_bid() * 8 + (tid_ >> 6), nw = opaque_gdim() * 8;
    for (int row = gw; row < RA; row += nw) {
        const bool lat = row < RL;
        int t, n; if (lat) { t = row & 8191; n = 8192; } else { t = (row - RL) & 255; n = 256; }
        const int sbase = row - t;
        bf16_t* prow = PJ + (size_t)row * PJW;
        {
            const int wdw = 2 << (lane >> 4), hw = wdw >> 1; const int lo = max(t - hw, 0), hi = min(t + hw, n);
            float s0 = 0.f, s1 = 0.f, s2 = 0.f, s3 = 0.f;
#pragma unroll
            for (int i = 0; i < 16; ++i) {
                const int off = i - 8, tt = t + off; const bool ok = (off >= -hw) && (off < hw) && (tt >= 0) && (tt < n);
                const u32x2 v = *(const u32x2*)(PJ + (size_t)(sbase + (ok ? tt : t)) * PJW + 4 * lane); const float wg = ok ? 1.0f : 0.0f;
                s0 += wg * bf_lo(v.x); s1 += wg * bf_hi(v.x); s2 += wg * bf_lo(v.y); s3 += wg * bf_hi(v.y); }
            const float ic = 1.0f / (float)(hi - lo); const u32x2 sv = *(const u32x2*)(prow + 4 * lane);
            u32x2 w; w.x = cvt_pk_bf16(s0 * ic - bf_lo(sv.x), s1 * ic - bf_hi(sv.x)); w.y = cvt_pk_bf16(s2 * ic - bf_lo(sv.y), s3 * ic - bf_hi(sv.y));
            *(u32x2*)(YB + (size_t)row * 1024 + 4 * lane) = w;
        }
        {
            const u32x2 q = *(const u32x2*)(prow + C_MQ + 4 * lane); const unsigned kv = *(const unsigned*)(prow + C_MKV + 2 * lane);
            float sq = bf_lo(q.x) * bf_lo(q.x) + bf_hi(q.x) * bf_hi(q.x) + bf_lo(q.y) * bf_lo(q.y) + bf_hi(q.y) * bf_hi(q.y);
            float sk = bf_lo(kv) * bf_lo(kv) + bf_hi(kv) * bf_hi(kv);
            sq = wave_sum(sq); sk = wave_sum(sk);
            if (lane == 0) { RSTD[row * 2] = rsqrtf(sq * (1.0f / 256.0f) + NEPS); RSTD[row * 2 + 1] = rsqrtf(sk * (1.0f / 128.0f) + NEPS); }
        }
        if (lane < 34) {
            const bool iskr = lane >= 32; const int a = lane & 1;
            bf16_t* ep = iskr ? prow + C_MKR + a * 16 : prow + ((lane >> 4) ? C_DK : C_DQ) + ((lane >> 1) & 7) * 32 + a * 16;
            const u32x4 e0 = *(const u32x4*)ep, e1 = *(const u32x4*)(ep + 8);
            float x1[8], x2[8];
            x1[0] = bf_lo(e0.x); x1[1] = bf_hi(e0.x); x1[2] = bf_lo(e0.y); x1[3] = bf_hi(e0.y); x1[4] = bf_lo(e0.z); x1[5] = bf_hi(e0.z); x1[6] = bf_lo(e0.w); x1[7] = bf_hi(e0.w);
            x2[0] = bf_lo(e1.x); x2[1] = bf_hi(e1.x); x2[2] = bf_lo(e1.y); x2[3] = bf_hi(e1.y); x2[4] = bf_lo(e1.z); x2[5] = bf_hi(e1.z); x2[6] = bf_lo(e1.w); x2[7] = bf_hi(e1.w);
            if (lat) { const int pos = a ? (t & 63) : (t >> 6);
#pragma unroll
                for (int i = 0; i < 8; ++i) { const float2 cs = RT[pos * 8 + i]; const float o1 = x1[i] * cs.x - x2[i] * cs.y, o2 = x1[i] * cs.y + x2[i] * cs.x; x1[i] = o1; x2[i] = o2; } }
            u32x4 w0, w1; w0.x = cvt_pk_bf16(x1[0], x1[1]); w0.y = cvt_pk_bf16(x1[2], x1[3]); w0.z = cvt_pk_bf16(x1[4], x1[5]); w0.w = cvt_pk_bf16(x1[6], x1[7]);
            w1.x = cvt_pk_bf16(x2[0], x2[1]); w1.y = cvt_pk_bf16(x2[2], x2[3]); w1.z = cvt_pk_bf16(x2[4], x2[5]); w1.w = cvt_pk_bf16(x2[6], x2[7]);
            if (iskr) {
#pragma unroll
                for (int hh = 0; hh < 4; ++hh) { bf16_t* kp = MK + (size_t)row * 384 + hh * 96 + 64 + a * 16; *(u32x4*)kp = w0; *(u32x4*)(kp + 8) = w1; }
            } else if (lat) { *(u32x4*)ep = w0; *(u32x4*)(ep + 8) = w1; }
        }
    }
}

#define MFMA32(a, b, c) __builtin_amdgcn_mfma_f32_32x32x16_bf16((a), (b), (c), 0, 0, 0)
typedef float f32x2 __attribute__((ext_vector_type(2)));
template <int MODE>
__device__ __forceinline__ void attn_item(PK p, int l, LAS unsigned char* lds, int b, int h, int qb, bool ctxq, float lam, float lam_init) {
    constexpr int NCOMP = (MODE == 1) ? 2 : 1, NKS = (MODE == 0) ? 4 : ((MODE == 1) ? 2 : 6), KW = NCOMP * NKS * 16, KCH = KW / 8, KSTR = KW * 2 + 16, VSTR = 192;
    constexpr int KBUF = 64 * KSTR, VBUF = 64 * VSTR, BUFSZ = KBUF + VBUF, BIAS_OFF = 3 * BUFSZ;
    constexpr bool STAG = (MODE != 0);
    const int tid = opaque_tid(), w = tid >> 6, lane = tid & 63, g = lane >> 5, l32 = lane & 31;
    unsigned char* ws = p->ws;
    const bf16_t* PJ = (const bf16_t*)(ws + OFF_B);
    const bf16_t *Qp, *Kp, *Vp; int ldq, ldk, ldv, outoff; float scale;
    if (MODE == 0) { Qp = PJ + C_NQ + 64 * h; Kp = PJ + C_NK + 64 * h; Vp = PJ + C_NV + 64 * h; ldq = ldk = ldv = PJW; outoff = 256 + 64 * h; scale = 0.125f; }
    else if (MODE == 1) { Qp = PJ + C_DQ + 64 * h; Kp = PJ + C_DK + 64 * h; Vp = PJ + C_DV + 64 * h; ldq = ldk = ldv = PJW; outoff = 512 + 64 * h; scale = 0.17677669529663687f; }
    else { Qp = (const bf16_t*)(ws + OFF_D) + 96 * h; Kp = (const bf16_t*)(ws + OFF_MK) + 96 * h; Vp = (const bf16_t*)(ws + OFF_MV) + 64 * h; ldq = ldk = 384; ldv = 256; outoff = 768 + 64 * h; scale = 0.10206207261596575f; }
    const float cs = scale * LOG2E;
    int qrow0, loc0, nloc;
    if (ctxq) { qrow0 = RL + b * 256; loc0 = 0; nloc = 0; }
    else { qrow0 = b * 8192 + qb * 256;
        if (MODE == 0) { const int r0 = qb * 4; loc0 = clampi(r0 - 4, 0, 120); nloc = clampi(r0 - 1, 0, 120) + 8 - loc0; } else { loc0 = 0; nloc = 128; } }
    const int nt = nloc + 4;
    const bool nabias = (MODE == 0) && !ctxq;
    constexpr bool PIPE = (MODE == 2);
    const bool late = STAG && !PIPE && (w >= 4);
    const int rw = qb * 4 + (w >> 1), sw = clampi(rw - 4, 0, 120);
    const int jq = 32 * (w & 1) + l32, cst = clampi(jq - 8, 0, 48);
    if (nabias && tid < 465) ((LAS float*)(lds + BIAS_OFF))[tid] = p->na_rpb[(size_t)(l * 4 + h) * 465 + tid] * LOG2E;

    const size_t qrow = (size_t)qrow0 + 32 * w + l32;
    bf16x8 qf[NCOMP * NKS];
#pragma unroll
    for (int i = 0; i < NCOMP * NKS; ++i) {
        const u32x4 raw = *(const u32x4*)(Qp + qrow * ldq + 16 * i + 8 * g);
        u32x4 sc4; sc4.x = cvt_pk_bf16(bf_lo(raw.x) * cs, bf_hi(raw.x) * cs); sc4.y = cvt_pk_bf16(bf_lo(raw.y) * cs, bf_hi(raw.y) * cs);
        sc4.z = cvt_pk_bf16(bf_lo(raw.z) * cs, bf_hi(raw.z) * cs); sc4.w = cvt_pk_bf16(bf_lo(raw.w) * cs, bf_hi(raw.w) * cs);
        qf[i] = __builtin_bit_cast(bf16x8, sc4);
    }

    const int kr0 = tid / KCH, kc0 = tid % KCH, kr1 = (tid + 512) / KCH, kc1 = (tid + 512) % KCH, vr = tid >> 3, vc = tid & 7;
    const bool hask1 = (KCH == 12) && (tid < 256);
    u32x4 rk0, rk1 = (u32x4){0u, 0u, 0u, 0u}, rv;
#define TILE_ROW(t) ((t) < nloc ? (b * 8192 + 64 * (loc0 + (t))) : (RL + b * 256 + 64 * ((t) - nloc)))
#define LOAD_TILE(t) do { const size_t _tb = (size_t)TILE_ROW(t); rk0 = *(const u32x4*)(Kp + (_tb + kr0) * ldk + kc0 * 8); \
        if (hask1) rk1 = *(const u32x4*)(Kp + (_tb + kr1) * ldk + kc1 * 8); rv = *(const u32x4*)(Vp + (_tb + vr) * ldv + vc * 8); } while (0)
#define STORE_TILE(buf) do { LAS unsigned char* _kb = lds + (buf) * BUFSZ; *(LAS u32x4*)(_kb + kr0 * KSTR + kc0 * 16) = rk0; \
        if (hask1) *(LAS u32x4*)(_kb + kr1 * KSTR + kc1 * 16) = rk1; *(LAS u32x4*)(_kb + KBUF + vr * VSTR + vc * 16) = rv; } while (0)

    float mrun[NCOMP], lsum[NCOMP]; f32x16 O[NCOMP][2];
#pragma unroll
    for (int c = 0; c < NCOMP; ++c) { mrun[c] = -1e30f; lsum[c] = 0.f;
#pragma unroll
        for (int dt = 0; dt < 2; ++dt)
#pragma unroll
            for (int r = 0; r < 16; ++r) O[c][dt][r] = 0.f; }
    bf16x8 P[NCOMP][2][2];
#pragma unroll
    for (int c = 0; c < NCOMP; ++c)
#pragma unroll
        for (int kt = 0; kt < 2; ++kt)
#pragma unroll
            for (int s2 = 0; s2 < 2; ++s2) P[c][kt][s2] = (bf16x8){0, 0, 0, 0, 0, 0, 0, 0};

    LOAD_TILE(0); STORE_TILE(0); __syncthreads();
    const int koff = l32 * KSTR + g * 16;
    const int i16 = lane & 15, tq = i16 >> 2, tp = i16 & 3, blk = (lane >> 4) & 1;
    const int voff = (4 * g + tq) * VSTR + (16 * blk + 4 * tp) * 2;
#define PV_TILE(buf) do { LAS unsigned char* _vb = lds + (buf) * BUFSZ + KBUF + voff; \
        _Pragma("unroll") for (int kt = 0; kt < 2; ++kt) { bf16x8 vf[2][2]; \
            _Pragma("unroll") for (int s2 = 0; s2 < 2; ++s2) _Pragma("unroll") for (int dt = 0; dt < 2; ++dt) { LAS unsigned char* vp = _vb + (32 * kt + 16 * s2) * VSTR + dt * 64; \
                const s16x4 lo = __builtin_amdgcn_ds_read_tr16_b64_v4i16((LAS s16x4*)vp); const s16x4 hi = __builtin_amdgcn_ds_read_tr16_b64_v4i16((LAS s16x4*)(vp + 8 * VSTR)); \
                vf[s2][dt] = __builtin_shufflevector(lo, hi, 0, 1, 2, 3, 4, 5, 6, 7); } \
            __builtin_amdgcn_s_setprio(1); \
            _Pragma("unroll") for (int s2 = 0; s2 < 2; ++s2) _Pragma("unroll") for (int dt = 0; dt < 2; ++dt) _Pragma("unroll") for (int c = 0; c < NCOMP; ++c) O[c][dt] = MFMA32(vf[s2][dt], P[c][kt][s2], O[c][dt]); \
            __builtin_amdgcn_s_setprio(0); } } while (0)

#define PV_TILE_C(buf, cc) do { LAS unsigned char* _vb = lds + (buf) * BUFSZ + KBUF + voff; \
        _Pragma("unroll") for (int kt = 0; kt < 2; ++kt) { bf16x8 vf[2][2]; \
            _Pragma("unroll") for (int s2 = 0; s2 < 2; ++s2) _Pragma("unroll") for (int dt = 0; dt < 2; ++dt) { LAS unsigned char* vp = _vb + (32 * kt + 16 * s2) * VSTR + dt * 64; \
                const s16x4 lo = __builtin_amdgcn_ds_read_tr16_b64_v4i16((LAS s16x4*)vp); const s16x4 hi = __builtin_amdgcn_ds_read_tr16_b64_v4i16((LAS s16x4*)(vp + 8 * VSTR)); \
                vf[s2][dt] = __builtin_shufflevector(lo, hi, 0, 1, 2, 3, 4, 5, 6, 7); } \
            __builtin_amdgcn_s_setprio(1); \
            _Pragma("unroll") for (int s2 = 0; s2 < 2; ++s2) _Pragma("unroll") for (int dt = 0; dt < 2; ++dt) O[cc][dt] = MFMA32(vf[s2][dt], P[cc][kt][s2], O[cc][dt]); \
            __builtin_amdgcn_s_setprio(0); } } while (0)
    bf16x8 Pold[NCOMP][2][2];
#pragma unroll
    for (int c = 0; c < NCOMP; ++c)
#pragma unroll
        for (int kt = 0; kt < 2; ++kt)
#pragma unroll
            for (int s2 = 0; s2 < 2; ++s2) Pold[c][kt][s2] = (bf16x8){0, 0, 0, 0, 0, 0, 0, 0};
#define PV_TILE_OLD(buf) do { LAS unsigned char* _vb = lds + (buf) * BUFSZ + KBUF + voff; \
        _Pragma("unroll") for (int kt = 0; kt < 2; ++kt) { bf16x8 vf[2][2]; \
            _Pragma("unroll") for (int s2 = 0; s2 < 2; ++s2) _Pragma("unroll") for (int dt = 0; dt < 2; ++dt) { LAS unsigned char* vp = _vb + (32 * kt + 16 * s2) * VSTR + dt * 64; \
                const s16x4 lo = __builtin_amdgcn_ds_read_tr16_b64_v4i16((LAS s16x4*)vp); const s16x4 hi = __builtin_amdgcn_ds_read_tr16_b64_v4i16((LAS s16x4*)(vp + 8 * VSTR)); \
                vf[s2][dt] = __builtin_shufflevector(lo, hi, 0, 1, 2, 3, 4, 5, 6, 7); } \
            _Pragma("unroll") for (int s2 = 0; s2 < 2; ++s2) _Pragma("unroll") for (int dt = 0; dt < 2; ++dt) _Pragma("unroll") for (int c = 0; c < NCOMP; ++c) O[c][dt] = MFMA32(vf[s2][dt], Pold[c][kt][s2], O[c][dt]); } } while (0)
    bool pend = false, zref = false; int pbuf = 0, cbuf = 0;
    for (int t = 0; t < nt; ++t) {
        const bool more = (t + 1 < nt);
        if (more) LOAD_TILE(t + 1);
        bool active = true; int krow = 0;
        if (nabias && t < nloc) { krow = loc0 + t; active = (krow >= sw) && (krow < sw + 8); }
        bool slow = (MODE == 0) || (t == 0);
        if (active) {
          again:
            LAS unsigned char* Kb = lds + cbuf * BUFSZ + koff;
            f32x16 S[NCOMP][2];
#pragma unroll
            for (int c = 0; c < NCOMP; ++c)
#pragma unroll
                for (int kt = 0; kt < 2; ++kt) {
                    bf16x8 kf[NKS];
#pragma unroll
                    for (int ks = 0; ks < NKS; ++ks) kf[ks] = *(const LAS bf16x8*)(Kb + kt * 32 * KSTR + (c * NKS + ks) * 32);
#pragma unroll
                    for (int r = 0; r < 16; ++r) S[c][kt][r] = 0.f;
                    __builtin_amdgcn_s_setprio(1);
#pragma unroll
                    for (int ks = 0; ks < NKS; ++ks) S[c][kt] = MFMA32(kf[ks], qf[c * NKS + ks], S[c][kt]);
                    __builtin_amdgcn_s_setprio(0);
                }
            if (STAG && late && pend) { PV_TILE(pbuf); pend = false; }
            float mxc[NCOMP], mnw[NCOMP];
            if (!slow) {
#pragma unroll
                for (int c = 0; c < NCOMP; ++c) mnw[c] = mrun[c];
            } else {
#pragma unroll
            for (int c = 0; c < NCOMP; ++c) {
                float mx = -1e30f;
                if (nabias && t < nloc) {
                    const LAS float* bt = (const LAS float*)(lds + BIAS_OFF) + (krow - rw + 7) * 31;
#pragma unroll
                    for (int kt = 0; kt < 2; ++kt)
#pragma unroll
                        for (int r = 0; r < 16; ++r) { const int jk = 32 * kt + (r & 3) + 8 * (r >> 2) + 4 * g; const bool ok = (jk >= cst) && (jk < cst + 16);
                            const float bv = bt[clampi(jk - jq + 15, 0, 30)]; const float xv = ok ? (S[c][kt][r] + bv) : -1e30f; S[c][kt][r] = xv; mx = fmaxf(mx, xv); }
                } else {
#pragma unroll
                    for (int kt = 0; kt < 2; ++kt)
#pragma unroll
                        for (int r = 0; r < 16; r += 2) mx = fmaxf(fmaxf(mx, S[c][kt][r]), S[c][kt][r + 1]);
                }
                mxc[c] = mx;
            }
#pragma unroll
            for (int c = 0; c < NCOMP; ++c) mxc[c] = fmaxf(mxc[c], shflx(mxc[c], 32));
            bool grow = false;
#pragma unroll
            for (int c = 0; c < NCOMP; ++c) { mnw[c] = fmaxf(mrun[c], mxc[c]); grow = grow || (mnw[c] > mrun[c]); }
            if (MODE != 0) {
                bool big = false;
#pragma unroll
                for (int c = 0; c < NCOMP; ++c) big = big || !(fabsf(mnw[c]) < 40.0f);
                zref = (t == 0) && !__any(big);
                if (zref) {
#pragma unroll
                    for (int c = 0; c < NCOMP; ++c) mnw[c] = 0.0f; }
            }
            if (__any(grow)) {
#pragma unroll
                for (int c = 0; c < NCOMP; ++c) { const float alpha = fast_exp2(mrun[c] - mnw[c]); lsum[c] *= alpha;
#pragma unroll
                    for (int dt = 0; dt < 2; ++dt) O[c][dt] *= alpha;
                    mrun[c] = mnw[c]; }
            }
            }
            if (!zref) {
#pragma unroll
            for (int c = 0; c < NCOMP; ++c) { const f32x2 m2 = (f32x2){mnw[c], mnw[c]};
#pragma unroll
                for (int kt = 0; kt < 2; ++kt)
#pragma unroll
                    for (int r = 0; r < 16; r += 2) { const f32x2 d = (f32x2){S[c][kt][r], S[c][kt][r + 1]} - m2; S[c][kt][r] = d.x; S[c][kt][r + 1] = d.y; } }
            }
            if (PIPE) PV_TILE_OLD(pbuf);
#pragma unroll
            for (int c = 0; c < NCOMP; ++c)
#pragma unroll
                for (int kt = 0; kt < 2; ++kt)
#pragma unroll
                    for (int r = 0; r < 16; ++r) S[c][kt][r] = fast_exp2(S[c][kt][r]);
#pragma unroll
            for (int c = 0; c < NCOMP; ++c) { f32x2 rs2 = (f32x2){0.f, 0.f};
#pragma unroll
                for (int kt = 0; kt < 2; ++kt)
#pragma unroll
                    for (int s2 = 0; s2 < 2; ++s2) { u32x4 pk;
#pragma unroll
                        for (int e = 0; e < 4; ++e) { const f32x2 ev = (f32x2){S[c][kt][8 * s2 + 2 * e], S[c][kt][8 * s2 + 2 * e + 1]}; rs2 += ev; pk[e] = cvt_pk_bf16(ev.x, ev.y); }
                        P[c][kt][s2] = __builtin_bit_cast(bf16x8, pk); }
                mxc[c] = rs2.x + rs2.y; }
            if (PIPE) {
                __builtin_amdgcn_sched_group_barrier(0x100, 16, 0);
#pragma unroll
                for (int i = 0; i < 8; ++i) { __builtin_amdgcn_sched_group_barrier(0x008, 1, 0); __builtin_amdgcn_sched_group_barrier(0x400, 4, 0); __builtin_amdgcn_sched_group_barrier(0x002, 4, 0); }
            }
            if (!slow) { bool bad = false;
#pragma unroll
                for (int c = 0; c < NCOMP; ++c) bad = bad || !(mxc[c] < 1.0e18f);
                if (__any(bad)) { slow = true;
                    if (PIPE) {
#pragma unroll
                        for (int c = 0; c < NCOMP; ++c)
#pragma unroll
                            for (int kt = 0; kt < 2; ++kt)
#pragma unroll
                                for (int s2 = 0; s2 < 2; ++s2) Pold[c][kt][s2] = (bf16x8){0, 0, 0, 0, 0, 0, 0, 0}; }
                    goto again; } }
#pragma unroll
            for (int c = 0; c < NCOMP; ++c) lsum[c] += mxc[c];
            if (PIPE) {
#pragma unroll
                for (int c = 0; c < NCOMP; ++c)
#pragma unroll
                    for (int kt = 0; kt < 2; ++kt)
#pragma unroll
                        for (int s2 = 0; s2 < 2; ++s2) Pold[c][kt][s2] = P[c][kt][s2];
                pbuf = cbuf;
            } else {
            if (!(STAG && late)) PV_TILE(cbuf);
            if (STAG && late) { pend = true; pbuf = cbuf; }
            }
        }
        const int nbuf = (cbuf == 2) ? 0 : cbuf + 1;
        if (more) STORE_TILE(nbuf);
        __syncthreads();
        cbuf = nbuf;
    }
    if (STAG && late && pend) PV_TILE(pbuf);
    if (PIPE) PV_TILE_OLD(pbuf);
#undef PV_TILE_OLD
#undef PV_TILE
#undef PV_TILE_C
#undef TILE_ROW
#undef LOAD_TILE
#undef STORE_TILE
    float inv[NCOMP];
#pragma unroll
    for (int c = 0; c < NCOMP; ++c) { const float lt = lsum[c] + shflx(lsum[c], 32); inv[c] = 1.0f / lt; }
    bf16_t* op = (bf16_t*)(ws + OFF_A) + qrow * 1024 + outoff;
    if (MODE == 1) {
        const float li1 = lam * inv[NCOMP - 1]; float ss = 0.f;
#pragma unroll
        for (int dt = 0; dt < 2; ++dt)
#pragma unroll
            for (int r = 0; r < 16; ++r) { const float o = O[0][dt][r] * inv[0] - li1 * O[NCOMP - 1][dt][r]; O[0][dt][r] = o; ss += o * o; }
        ss += shflx(ss, 32);
        const float rstd = rsqrtf(ss * (1.0f / 64.0f) + NEPS) * (1.0f - lam_init);
        const float* sg = p->diff_subln_g + l * 64;
#pragma unroll
        for (int dt = 0; dt < 2; ++dt)
#pragma unroll
            for (int rq = 0; rq < 4; ++rq) { const int dv = 32 * dt + 8 * rq + 4 * g; const f32x4 gg = *(const f32x4*)(sg + dv);
                u32x2 wv; wv.x = cvt_pk_bf16(O[0][dt][4 * rq] * rstd * gg[0], O[0][dt][4 * rq + 1] * rstd * gg[1]); wv.y = cvt_pk_bf16(O[0][dt][4 * rq + 2] * rstd * gg[2], O[0][dt][4 * rq + 3] * rstd * gg[3]);
                *(u32x2*)(op + dv) = wv; }
    } else {
#pragma unroll
        for (int dt = 0; dt < 2; ++dt)
#pragma unroll
            for (int rq = 0; rq < 4; ++rq) { const int dv = 32 * dt + 8 * rq + 4 * g;
                u32x2 wv; wv.x = cvt_pk_bf16(O[0][dt][4 * rq] * inv[0], O[0][dt][4 * rq + 1] * inv[0]); wv.y = cvt_pk_bf16(O[0][dt][4 * rq + 2] * inv[0], O[0][dt][4 * rq + 3] * inv[0]);
                *(u32x2*)(op + dv) = wv; }
    }
    __syncthreads();
}

__device__ __forceinline__ void attn_item_mla2(PK p, int l, LAS unsigned char* lds, int b, int h, int qb, bool ctxq) {
    constexpr int NKS = 6, KCH = 12, KSTR = 208, VSTR = 192, KBUF = 64 * KSTR, VBUF = 64 * VSTR, BUFSZ = KBUF + VBUF;
    const int tid = opaque_tid(), w = tid >> 6, lane = tid & 63, g = lane >> 5, l32 = lane & 31;
    unsigned char* ws = p->ws;
    const bf16_t* Qp = (const bf16_t*)(ws + OFF_D) + 96 * h; const bf16_t* Kp = (const bf16_t*)(ws + OFF_MK) + 96 * h; const bf16_t* Vp = (const bf16_t*)(ws + OFF_MV) + 64 * h;
    constexpr int ldq = 384, ldk = 384, ldv = 256; const int outoff = 768 + 64 * h;
    const float cs = 0.10206207261596575f * LOG2E;
    const int qrow0 = ctxq ? RL + b * 256 : b * 8192 + qb * 256, nloc = ctxq ? 0 : 128, nt = nloc + 4;
    const size_t qrow = (size_t)qrow0 + 32 * w + l32;
    bf16x8 qf[NKS];
#pragma unroll
    for (int i = 0; i < NKS; ++i) {
        const u32x4 raw = *(const u32x4*)(Qp + qrow * ldq + 16 * i + 8 * g);
        u32x4 sc4; sc4.x = cvt_pk_bf16(bf_lo(raw.x) * cs, bf_hi(raw.x) * cs); sc4.y = cvt_pk_bf16(bf_lo(raw.y) * cs, bf_hi(raw.y) * cs);
        sc4.z = cvt_pk_bf16(bf_lo(raw.z) * cs, bf_hi(raw.z) * cs); sc4.w = cvt_pk_bf16(bf_lo(raw.w) * cs, bf_hi(raw.w) * cs);
        qf[i] = __builtin_bit_cast(bf16x8, sc4);
    }
    const int kr0 = tid / KCH, kc0 = tid % KCH, kr1 = (tid + 512) / KCH, kc1 = (tid + 512) % KCH, vr = tid >> 3, vc = tid & 7;
    const bool hask1 = tid < 256;
    u32x4 rk0, rk1 = (u32x4){0u, 0u, 0u, 0u}, rv;
#define M2_ROW(t) ((t) < nloc ? (b * 8192 + 64 * (t)) : (RL + b * 256 + 64 * ((t) - nloc)))
#define M2_LOAD(t) do { const size_t _tb = (size_t)M2_ROW(t); rk0 = *(const u32x4*)(Kp + (_tb + kr0) * ldk + kc0 * 8); \
        if (hask1) rk1 = *(const u32x4*)(Kp + (_tb + kr1) * ldk + kc1 * 8); rv = *(const u32x4*)(Vp + (_tb + vr) * ldv + vc * 8); } while (0)
#define M2_STORE(buf) do { LAS unsigned char* _kb = lds + (buf) * BUFSZ; *(LAS u32x4*)(_kb + kr0 * KSTR + kc0 * 16) = rk0; \
        if (hask1) *(LAS u32x4*)(_kb + kr1 * KSTR + kc1 * 16) = rk1; *(LAS u32x4*)(_kb + KBUF + vr * VSTR + vc * 16) = rv; } while (0)
    const int koff = l32 * KSTR + g * 16;
    const int i16 = lane & 15, tq = i16 >> 2, tp = i16 & 3, blk = (lane >> 4) & 1;
    const int voff = (4 * g + tq) * VSTR + (16 * blk + 4 * tp) * 2;
#define M2_QK(SX, buf) do { LAS unsigned char* _kb = lds + (buf) * BUFSZ + koff; \
        _Pragma("unroll") for (int kt = 0; kt < 2; ++kt) { bf16x8 kf[NKS]; \
            _Pragma("unroll") for (int ks = 0; ks < NKS; ++ks) kf[ks] = *(const LAS bf16x8*)(_kb + kt * 32 * KSTR + ks * 32); \
            _Pragma("unroll") for (int r = 0; r < 16; ++r) SX[kt][r] = 0.f; \
            _Pragma("unroll") for (int ks = 0; ks < NKS; ++ks) SX[kt] = MFMA32(kf[ks], qf[ks], SX[kt]); } } while (0)
#define M2_PVOLD(buf) do { LAS unsigned char* _vb = lds + (buf) * BUFSZ + KBUF + voff; \
        _Pragma("unroll") for (int kt = 0; kt < 2; ++kt) { bf16x8 vf[2][2]; \
            _Pragma("unroll") for (int s2 = 0; s2 < 2; ++s2) _Pragma("unroll") for (int dt = 0; dt < 2; ++dt) { LAS unsigned char* vp = _vb + (32 * kt + 16 * s2) * VSTR + dt * 64; \
                const s16x4 lo = __builtin_amdgcn_ds_read_tr16_b64_v4i16((LAS s16x4*)vp); const s16x4 hi = __builtin_amdgcn_ds_read_tr16_b64_v4i16((LAS s16x4*)(vp + 8 * VSTR)); \
                vf[s2][dt] = __builtin_shufflevector(lo, hi, 0, 1, 2, 3, 4, 5, 6, 7); } \
            _Pragma("unroll") for (int s2 = 0; s2 < 2; ++s2) _Pragma("unroll") for (int dt = 0; dt < 2; ++dt) O[dt] = MFMA32(vf[s2][dt], Pold[kt][s2], O[dt]); } } while (0)
#define M2_EXP(SX, PX, RS) do { _Pragma("unroll") for (int kt = 0; kt < 2; ++kt) _Pragma("unroll") for (int r = 0; r < 16; ++r) SX[kt][r] = fast_exp2(SX[kt][r]); \
        f32x2 _rs2 = (f32x2){0.f, 0.f}; \
        _Pragma("unroll") for (int kt = 0; kt < 2; ++kt) _Pragma("unroll") for (int s2 = 0; s2 < 2; ++s2) { u32x4 pk; \
            _Pragma("unroll") for (int e = 0; e < 4; ++e) { const f32x2 ev = (f32x2){SX[kt][8 * s2 + 2 * e], SX[kt][8 * s2 + 2 * e + 1]}; _rs2 += ev; pk[e] = cvt_pk_bf16(ev.x, ev.y); } \
            PX[kt][s2] = __builtin_bit_cast(bf16x8, pk); } \
        RS = _rs2.x + _rs2.y; } while (0)
#define M2_SUB(SX, mref) do { const f32x2 _m2 = (f32x2){mref, mref}; \
        _Pragma("unroll") for (int kt = 0; kt < 2; ++kt) _Pragma("unroll") for (int r = 0; r < 16; r += 2) { const f32x2 d = (f32x2){SX[kt][r], SX[kt][r + 1]} - _m2; SX[kt][r] = d.x; SX[kt][r + 1] = d.y; } } while (0)
#define M2_MAX(SX, MX) do { float _mx = -1e30f; _Pragma("unroll") for (int kt = 0; kt < 2; ++kt) _Pragma("unroll") for (int r = 0; r < 16; r += 2) _mx = fmaxf(fmaxf(_mx, SX[kt][r]), SX[kt][r + 1]); \
        MX = fmaxf(_mx, shflx(_mx, 32)); } while (0)
#define M2_OPLOAD(dst, idx) do { if ((idx) < 12) { const int kt_ = (idx) / 6, ks_ = (idx) % 6; dst = *(const LAS bf16x8*)(_kb + kt_ * 32 * KSTR + ks_ * 32); } \
        else if ((idx) < 20) { const int j_ = (idx) - 12, kt_ = j_ >> 2, s2_ = (j_ >> 1) & 1, dt_ = j_ & 1; LAS unsigned char* vp = _vb + (32 * kt_ + 16 * s2_) * VSTR + dt_ * 64; \
            const s16x4 lo = __builtin_amdgcn_ds_read_tr16_b64_v4i16((LAS s16x4*)vp); const s16x4 hi = __builtin_amdgcn_ds_read_tr16_b64_v4i16((LAS s16x4*)(vp + 8 * VSTR)); \
            dst = __builtin_shufflevector(lo, hi, 0, 1, 2, 3, 4, 5, 6, 7); } } while (0)
#define M2_FUSED(SC, SN, bufK, bufV, PX, RS) do { \
        LAS unsigned char* _kb = lds + (bufK) * BUFSZ + koff; LAS unsigned char* _vb = lds + (bufV) * BUFSZ + KBUF + voff; \
        f32x16 _z; _Pragma("unroll") for (int r = 0; r < 16; ++r) _z[r] = 0.f; \
        f32x2 _rs2 = (f32x2){0.f, 0.f}; u32x4 _pk[2][2]; \
        bf16x8 _op[23]; M2_OPLOAD(_op[0], 0); M2_OPLOAD(_op[1], 1); M2_OPLOAD(_op[2], 2); \
        __builtin_amdgcn_sched_barrier(0); \
        _Pragma("unroll") for (int i = 0; i < 20; ++i) { \
            M2_OPLOAD(_op[i + 3], i + 3);                       \
            if (i < 12) { const int kt = i / 6, ks = i % 6; SN[kt] = MFMA32(_op[i], qf[ks], ks == 0 ? _z : SN[kt]); } \
            else { const int j = i - 12, kt = j >> 2, s2 = (j >> 1) & 1, dt = j & 1; O[dt] = MFMA32(_op[i], Pold[kt][s2], O[dt]); } \
            if (i < 16) { const int e0 = 2 * i, e1 = 2 * i + 1; SC[e0 >> 4][e0 & 15] = fast_exp2(SC[e0 >> 4][e0 & 15]); SC[e1 >> 4][e1 & 15] = fast_exp2(SC[e1 >> 4][e1 & 15]); } \
            if (i >= 2 && i < 18) { const int j = i - 2, e0 = 2 * j; const f32x2 ev = (f32x2){SC[e0 >> 4][e0 & 15], SC[e0 >> 4][(e0 & 15) + 1]}; _rs2 += ev; \
                _pk[j >> 3][(j >> 2) & 1][j & 3] = cvt_pk_bf16(ev.x, ev.y); } \
            __builtin_amdgcn_sched_barrier(0); } \
        _Pragma("unroll") for (int kt = 0; kt < 2; ++kt) _Pragma("unroll") for (int s2 = 0; s2 < 2; ++s2) PX[kt][s2] = __builtin_bit_cast(bf16x8, _pk[kt][s2]); \
        RS = _rs2.x + _rs2.y; } while (0)
    float lsum = 0.f, mrun; f32x16 O[2];
#pragma unroll
    for (int dt = 0; dt < 2; ++dt)
#pragma unroll
        for (int r = 0; r < 16; ++r) O[dt][r] = 0.f;
    bf16x8 Pold[2][2];
#pragma unroll
    for (int kt = 0; kt < 2; ++kt)
#pragma unroll
        for (int s2 = 0; s2 < 2; ++s2) Pold[kt][s2] = (bf16x8){0, 0, 0, 0, 0, 0, 0, 0};
    f32x16 SA[2], SB[2];
    M2_LOAD(0); M2_STORE(0); M2_LOAD(1); M2_STORE(1); __syncthreads();
    M2_QK(SA, 0);
    bool zref;
    { float mx0; M2_MAX(SA, mx0); zref = !__any(!(fabsf(mx0) < 40.0f)); mrun = zref ? 0.0f : mx0; }
    int pbuf = 0;
#define M2_BODY(SC, SN, tt) do { const int _cb = (tt) & 3; \
        if ((tt) + 2 < nt) M2_LOAD((tt) + 2); \
        if (!zref) M2_SUB(SC, mrun); \
        bf16x8 Pn[2][2]; float rs; \
        M2_FUSED(SC, SN, ((tt) + 1) & 3, pbuf, Pn, rs); \
        if (__any(!(rs < 1.0e18f))) {        \
            M2_QK(SC, _cb); float mxr; M2_MAX(SC, mxr); const float mnew = fmaxf(mrun, mxr); const float alpha = fast_exp2(mrun - mnew); \
            lsum *= alpha; O[0] *= alpha; O[1] *= alpha; mrun = mnew; zref = false; M2_SUB(SC, mrun); M2_EXP(SC, Pn, rs); } \
        lsum += rs; \
        _Pragma("unroll") for (int kt = 0; kt < 2; ++kt) _Pragma("unroll") for (int s2 = 0; s2 < 2; ++s2) Pold[kt][s2] = Pn[kt][s2]; \
        pbuf = _cb; \
        if ((tt) + 2 < nt) M2_STORE(((tt) + 2) & 3); \
        __syncthreads(); } while (0)
    for (int t = 0; t < nt; t += 2) { M2_BODY(SA, SB, t); M2_BODY(SB, SA, t + 1); }
    M2_PVOLD(pbuf);
    const float lt = lsum + shflx(lsum, 32); const float inv = 1.0f / lt;
    bf16_t* op = (bf16_t*)(ws + OFF_A) + qrow * 1024 + outoff;
#pragma unroll
    for (int dt = 0; dt < 2; ++dt)
#pragma unroll
        for (int rq = 0; rq < 4; ++rq) { const int dv = 32 * dt + 8 * rq + 4 * g;
            u32x2 wv; wv.x = cvt_pk_bf16(O[dt][4 * rq] * inv, O[dt][4 * rq + 1] * inv); wv.y = cvt_pk_bf16(O[dt][4 * rq + 2] * inv, O[dt][4 * rq + 3] * inv);
            *(u32x2*)(op + dv) = wv; }
    __syncthreads();
#undef M2_ROW
#undef M2_LOAD
#undef M2_STORE
#undef M2_QK
#undef M2_PVOLD
#undef M2_EXP
#undef M2_SUB
#undef M2_MAX
#undef M2_BODY
#undef M2_FUSED
#undef M2_OPLOAD
}

__device__ void attn_phase(PK p, int l, LAS unsigned char* lds) {
    const float lam_init = (l == 0) ? 0.2f : 0.35550906759502f;
    const float* dl = p->diff_lambda + l * 128;
    float d01 = 0.f, d23 = 0.f;
    for (int i = 0; i < 32; ++i) { d01 += dl[i] * dl[32 + i]; d23 += dl[64 + i] * dl[96 + i]; }
    const float lam = expf(d01) - expf(d23) + lam_init;
    const int nItems = 1536 + (l == 0 ? 48 : 0);
    for (int it = opaque_bid(); it < nItems; it += opaque_gdim()) {
        if (it < 1536) {
            const int ty = it >> 9, idx = it & 511, bh = ((idx & 7) << 1) | (idx >> 8), b = bh >> 2, h = bh & 3, qb = (idx >> 3) & 31;
            if (ty == 0) attn_item<1>(p, l, lds, b, h, qb, false, lam, lam_init);
            else if (ty == 1) attn_item_mla2(p, l, lds, b, h, qb, false);
            else attn_item<0>(p, l, lds, b, h, qb, false, lam, lam_init);
        } else {
            const int idx = it - 1536, ty = idx >> 4, b = (idx >> 2) & 3, h = idx & 3;
            if (ty == 0) attn_item<1>(p, l, lds, b, h, 0, true, lam, lam_init);
            else if (ty == 1) attn_item_mla2(p, l, lds, b, h, 0, true);
            else attn_item<0>(p, l, lds, b, h, 0, true, lam, lam_init);
        }
    }
}

constexpr int PH_PER_LAYER = 14, N_PHASES = 2 * PH_PER_LAYER + 1;

__device__ __forceinline__ void run_phase(PK p, int ph, LAS unsigned char* lds, float rcoef) {
    unsigned char* ws = p->ws;
    pg8::StaticOrder S;
    if (ph == N_PHASES - 1) { final_norm_phase(p->out, p->final_norm_g); return; }
    int l = ph / PH_PER_LAYER; const int q = ph % PH_PER_LAYER;
#define OPQL asm volatile("" : "+s"(l))
#define HC ((float*)(ws + OFF_HC))
#define MOD ((const float*)(ws + OFF_MOD) + (size_t)l * 5 * 9216)
#define TN ((bf16_t*)(ws + OFF_A))
#define HID ((bf16_t*)(ws + OFF_B))
#define Mlate ((l == 0) ? RA : RL)
    switch (q) {
    case 0: OPQL; layer_prep_phase(p, l, lds); break;
    case 1: OPQL; if (l == 0) norm_mod_phase(p->x, p->ctx, p->out, HC, p->norm_g + (l * 3 + 0) * 1024, MOD, TN, RA, nullptr, 0);
            else norm_mod_phase(p->out, HC, nullptr, nullptr, p->norm_g + (l * 3 + 0) * 1024, MOD, TN, RA, (const float*)(ws + OFF_PB), 11); break;
    case 2: case 12: { OPQL; const int f = (q == 2) ? 0 : 1; const int M = (q == 2) ? RA : Mlate;
        pg8::Gemm g{TN, (const bf16_t*)(ws + OFF_W1) + (size_t)f * 5632 * 1024, M, 5632, 1024, 1024, 1024}; S.init(M, 5632, opaque_gdim(), opaque_bid());
        EpiSwiglu E{HID}; pg8::gemm_phase(lds, g, S, E); } break;
    case 4: OPQL; norm_mod_phase(p->out, HC, nullptr, nullptr, p->norm_g + (l * 3 + 1) * 1024, MOD + 3 * 1024, TN, RA, (const float*)(ws + OFF_PB), 11); break;
    case 5: { OPQL; pg8::Gemm g{TN, (const bf16_t*)(ws + OFF_WM), RA, 6400, 1024, 1024, 1024}; S.init(RA, 6400, opaque_gdim(), opaque_bid());
        EpiPJ E{(bf16_t*)(ws + OFF_B), ws + OFF_C}; pg8::gemm_phase(lds, g, S, E); } break;
    case 6: prep_phase(p); break;
    case 7: { OPQL; pg8::Gemm g{(const bf16_t*)(ws + OFF_B) + C_MQ, (const bf16_t*)(ws + OFF_WL), RA, 1024, 384, PJW, 384}; S.init(RA, 1024, opaque_gdim(), opaque_bid());
        EpiMLA E{(bf16_t*)(ws + OFF_D), (bf16_t*)(ws + OFF_MK), (bf16_t*)(ws + OFF_MV), (const float*)(ws + OFF_RSTD), (const float2*)(ws + OFF_ROPE)}; pg8::gemm_phase(lds, g, S, E); } break;
    case 8: OPQL; attn_phase(p, l, lds); break;
    case 9: { OPQL; pg8::Gemm g{(const bf16_t*)(ws + OFF_A), (const bf16_t*)(ws + OFF_WB), Mlate, 1024, 1024, 1024, 1024}; S.init(Mlate, 1024, opaque_gdim(), opaque_bid());
        EpiMerge E{ws + OFF_C, (bf16_t*)(ws + OFF_D)}; pg8::gemm_phase(lds, g, S, E); } break;
    case 3: case 13: case 10: { OPQL;
        const bool isout = (q == 10); const int f = (q == 13) ? 1 : 0;
        const bf16_t* A = isout ? (const bf16_t*)(ws + OFF_D) : (const bf16_t*)HID;
        const bf16_t* Bt = isout ? (const bf16_t*)(ws + OFF_WO) : (const bf16_t*)(ws + OFF_W2) + (size_t)f * 1024 * FH;
        const int K = isout ? 1024 : FH;
        const float* gate = MOD + (isout ? 5 : (q == 3 ? 2 : 8)) * 1024;
        const float coef = (isout ? 1.0f : 0.5f) * rcoef;
        const bool withctx = (q == 3) || (l == 0);
        { pg8::Gemm g{A, Bt, RL, 1024, K, K, K}; S.init(RL, 1024, opaque_gdim(), opaque_bid());
          EpiResid E{p->out, HC, gate, coef}; pg8::gemm_phase(lds, g, S, E); }
        if (withctx) {
            const int nsu = 16 * (K / 256);
            for (int su = opaque_bid(); su < nsu; su += opaque_gdim()) {
                const int ks = su >> 4, pmn = su & 15;
                pg8::SingleUnit SU; SU.pm = 128 + (pmn >> 2); SU.pn = pmn & 3; SU.has = true;
                pg8::Gemm g2{A + ks * 256, Bt + ks * 256, RA, 1024, 256, K, K};
                EpiPartial E2{(float*)(ws + OFF_PB) + (size_t)ks * 1024 * 1024, gate + 4 * 9216, coef}; pg8::gemm_phase(lds, g2, SU, E2);
            }
        }
    } break;
    case 11: OPQL; norm_mod_phase(p->out, HC, nullptr, nullptr, p->norm_g + (l * 3 + 2) * 1024, MOD + 6 * 1024, TN, Mlate, (const float*)(ws + OFF_PB), 4); break;
    }
#undef OPQL
#undef HC
#undef MOD
#undef TN
#undef HID
#undef Mlate
}

__global__ void __launch_bounds__(512, 2) fwd_megakernel(Params p) {
    extern __shared__ __attribute__((aligned(16))) unsigned char shm[];
    LAS unsigned char* lds = (LAS unsigned char*)shm;
#if N_LAUNCH_MODE == 1
    cg::grid_group grid = cg::this_grid();
    const int ph_lo = p.ph_lo, ph_hi = p.ph_hi;
    volatile LAS unsigned* st = (volatile LAS unsigned*)(lds + pg8::STAGE_BYTES);
    unsigned* bar = (unsigned*)(p.ws + OFF_BAR);
    if (opaque_tid() < 4) st[opaque_tid()] = 0u;
    if (opaque_bid() == 0) for (int i = opaque_tid(); i < XCD_BAR_WORDS; i += 512) bar[i] = 0u;
    __syncthreads();
#if PROBE_Q >= 0
    const int nseq = 2 * (PH_PER_LAYER + 1) + 1;
    for (int i = 0; i < nseq; ++i) {
        int ph;
        if (i == nseq - 1) ph = N_PHASES - 1;
        else { const int li = i / (PH_PER_LAYER + 1), r = i % (PH_PER_LAYER + 1); ph = li * PH_PER_LAYER + (r <= PROBE_Q ? r : r - 1); }
        PK pk = (PK)__builtin_amdgcn_kernarg_segment_ptr();
        asm volatile("" : "+s"(pk));
        run_phase(pk, ph, lds, 1.0f);
        if (i == 0) { grid.sync(); xcd_barrier_post(bar); }
        else if (i + 1 < nseq) xcd_barrier(bar, st);
    }
#else
    for (int ph = ph_lo; ph < ph_hi; ++ph) {
        PK pk = (PK)__builtin_amdgcn_kernarg_segment_ptr();
        asm volatile("" : "+s"(pk));
        run_phase(pk, ph, lds, 1.0f);
        if (ph == ph_lo) { grid.sync(); xcd_barrier_post(bar); }
        else if (ph + 1 < ph_hi) xcd_barrier(bar, st);
    }
#endif
#else
    const int ph_lo = p.ph_lo, ph_hi = p.ph_hi;
    for (int ph = ph_lo; ph < ph_hi; ++ph) { PK pk = (PK)__builtin_amdgcn_kernarg_segment_ptr(); asm volatile("" : "+s"(pk)); run_phase(pk, ph, lds, 1.0f); }
#endif
}

extern "C" void kernel_launch(void* const* d_in, const int* in_sizes, int n_in, void* d_out, int out_size, void* d_ws, size_t ws_size, hipStream_t stream) {
    constexpr int LDS_BYTES = pg8::STAGE_BYTES + 16;
    static int grid_blocks = 0;
    if (grid_blocks == 0) {
        if (n_in != 22 || ws_size < WS_END) { fprintf(stderr, "kernel_launch: unexpected inputs (n_in %d, ws %zu < %zu)\n", n_in, ws_size, (size_t)WS_END); grid_blocks = -1; return; }
        int dev = 0, cus = 0, per_cu = 0;
        hipGetDevice(&dev); hipDeviceGetAttribute(&cus, hipDeviceAttributeMultiprocessorCount, dev);
        if (hipFuncSetAttribute((const void*)fwd_megakernel, hipFuncAttributeMaxDynamicSharedMemorySize, LDS_BYTES) != hipSuccess) { fprintf(stderr, "hipFuncSetAttribute failed\n"); grid_blocks = -1; return; }
        if (hipOccupancyMaxActiveBlocksPerMultiprocessor(&per_cu, (const void*)fwd_megakernel, 512, LDS_BYTES) != hipSuccess || per_cu < 1) per_cu = 1;
        (void)hipGetLastError();
        grid_blocks = cus * 1;
    }
    if (grid_blocks < 0) return;
    Params hp{};
    const float** pp = (const float**)&hp;
    for (int i = 0; i < 22; ++i) pp[i] = (const float*)d_in[i];
    hp.out = (float*)d_out; hp.ws = (unsigned char*)d_ws;
#if N_LAUNCH_MODE == 1
    hp.ph_lo = 0; hp.ph_hi = N_PHASES;
    void* args[] = {&hp};
    hipError_t e = hipLaunchCooperativeKernel((const void*)fwd_megakernel, dim3(grid_blocks), dim3(512), args, LDS_BYTES, stream);
    if (e != hipSuccess) fprintf(stderr, "cooperative launch failed: %s (grid %d)\n", hipGetErrorString(e), grid_blocks);
#else
    for (int ph = 0; ph < N_PHASES; ++ph) { hp.ph_lo = ph; hp.ph_hi = ph + 1; hipLaunchKernelGGL(fwd_megakernel, dim3(grid_blocks), dim3(512), LDS_BYTES, stream, hp); }
#endif
}
```

```cpp
#include <hip/hip_runtime.h>
#include <hip/hip_cooperative_groups.h>
#include <cstdio>
namespace cg = cooperative_groups;

#define LAS __attribute__((address_space(3)))
typedef unsigned short bf16_t;
typedef short bf16x8 __attribute__((ext_vector_type(8)));
typedef short s16x4 __attribute__((ext_vector_type(4)));
typedef float f32x4 __attribute__((ext_vector_type(4)));
typedef float f32x16 __attribute__((ext_vector_type(16)));
typedef unsigned u32x4 __attribute__((ext_vector_type(4)));
typedef unsigned u32x2 __attribute__((ext_vector_type(2)));

#ifndef PROBE_Q
#define PROBE_Q (-1)
#endif
#ifndef N_LAUNCH_MODE
#define N_LAUNCH_MODE 1
#endif

constexpr int RL = 32768, RA = 33792, FH = 2816;
constexpr int PJW = 2304;
constexpr int C_NQ = 256, C_NK = 512, C_NV = 768, C_DQ = 1024, C_DK = 1280, C_DV = 1536, C_MQ = 1792, C_MKV = 2048, C_MKR = 2176;
constexpr float LOG2E = 1.4426950408889634f;
constexpr float NEPS = 1e-6f;
constexpr int XCD_BAR_WORDS_C = 3456;

constexpr size_t SZ_W1 = 2ull * 5632 * 1024 * 2, SZ_W2 = 2ull * 1024 * 2816 * 2, SZ_WM = 6400ull * 1024 * 2, SZ_WL = 1024ull * 384 * 2, SZ_WB = 4ull * 1024 * 256 * 2, SZ_WO = 1024ull * 1024 * 2;
constexpr size_t OFF_W1 = 0, OFF_W2 = OFF_W1 + SZ_W1, OFF_WM = OFF_W2 + SZ_W2, OFF_WL = OFF_WM + SZ_WM, OFF_WB = OFF_WL + SZ_WL, OFF_WO = OFF_WB + SZ_WB;
constexpr size_t OFF_HC = OFF_WO + SZ_WO;
constexpr size_t OFF_MOD = OFF_HC + 1024ull * 1024 * 4;
constexpr size_t OFF_ROPE = OFF_MOD + 2ull * 5 * 9216 * 4;
constexpr size_t OFF_RSTD = OFF_ROPE + 128 * 8 * 8;
constexpr size_t OFF_A = OFF_RSTD + (size_t)RA * 2 * 4;
constexpr size_t OFF_B = OFF_A + (size_t)RA * 1024 * 2;
constexpr size_t OFF_C = OFF_B + (size_t)RA * PJW * 2;
constexpr size_t OFF_D = OFF_C + (size_t)RA * 4096;
constexpr size_t OFF_MK = OFF_D + (size_t)RA * 384 * 2, OFF_MV = OFF_MK + (size_t)RA * 384 * 2;
constexpr size_t OFF_BAR = OFF_D + (size_t)RA * 1024 * 2;
constexpr size_t OFF_PB = OFF_BAR + 16384;
constexpr size_t WS_END = OFF_PB + 11ull * 1024 * 1024 * 4;

struct Params {
    const float *x, *c, *ctx, *c_ctx, *ada_w, *ada_b, *norm_g, *ffn_w_in, *ffn_w_out, *mix_w_in, *pool_w, *pool_scale, *na_rpb, *diff_lambda, *diff_subln_g,
        *mla_q_norm_g, *mla_kv_norm_g, *mla_w_qb, *mla_w_kvb, *branch_w_out, *mix_w_out, *final_norm_g;
    float* out; unsigned char* ws;
    int ph_lo, ph_hi;
};

typedef const __attribute__((address_space(4))) Params* PK;

typedef float f32x2_ __attribute__((ext_vector_type(2)));
typedef __bf16 bf16x2_ __attribute__((ext_vector_type(2)));
__device__ __forceinline__ unsigned cvt_pk_bf16(float lo, float hi) { const f32x2_ v = {lo, hi}; return __builtin_bit_cast(unsigned, __builtin_convertvector(v, bf16x2_)); }
__device__ __forceinline__ float bf_lo(unsigned u) { return __uint_as_float(u << 16); }
__device__ __forceinline__ float bf_hi(unsigned u) { return __uint_as_float(u & 0xffff0000u); }
__device__ __forceinline__ float fast_exp2(float x) { return __builtin_amdgcn_exp2f(x); }
__device__ __forceinline__ float fast_rcp(float x) { return __builtin_amdgcn_rcpf(x); }
__device__ __forceinline__ float sigmoidf_(float x) { return fast_rcp(1.0f + fast_exp2(-x * LOG2E)); }
__device__ __forceinline__ float shflx(float v, int m) {
    int lane = __builtin_amdgcn_mbcnt_hi(~0u, __builtin_amdgcn_mbcnt_lo(~0u, 0)); asm volatile("" : "+v"(lane));
    return __int_as_float(__builtin_amdgcn_ds_bpermute((lane ^ m) << 2, __float_as_int(v)));
}
__device__ __forceinline__ float wave_sum(float v) {
    v += shflx(v, 32); v += shflx(v, 16); v += shflx(v, 8); v += shflx(v, 4); v += shflx(v, 2); v += shflx(v, 1); return v;
}
__device__ __forceinline__ int opaque_tid() { int t = threadIdx.x; asm volatile("" : "+v"(t)); return t; }
__device__ __forceinline__ int opaque_bid() { int t = blockIdx.x; asm volatile("" : "+s"(t)); return t; }
__device__ __forceinline__ int opaque_gdim() { int t = gridDim.x; asm volatile("" : "+s"(t)); return t; }
__device__ __forceinline__ int clampi(int v, int lo, int hi) { return v < lo ? lo : (v > hi ? hi : v); }

#define XB_TMO      128
#define XB_XCNT(j)  (256  + 64 * (j))
#define XB_XSUB(j)  (1280 + 64 * (j))
#define XB_XGEN(j)  (2304 + 64 * (j))
#define XB_TOP      3328
#define XB_TOPGEN   3392
#define XCD_BAR_WORDS 3456
#define XB_SPIN_CAP (1u << 20)
__device__ __forceinline__ unsigned xb_ld(unsigned* p)              { return __hip_atomic_load(p, __ATOMIC_RELAXED, __HIP_MEMORY_SCOPE_AGENT); }
__device__ __forceinline__ unsigned xb_add(unsigned* p, unsigned v) { return __hip_atomic_fetch_add(p, v, __ATOMIC_RELAXED, __HIP_MEMORY_SCOPE_AGENT); }
__device__ __forceinline__ unsigned xb_xcc_id() { return (unsigned)__builtin_amdgcn_s_getreg((3 << 11) | 20) & 0xFu; }
#define XB_SPIN(cond, bar) do { unsigned _sp = 0; while (cond) { __builtin_amdgcn_s_sleep(1); \
    if ((++_sp & 255u) == 0u) { if (xb_ld(&(bar)[XB_TMO])) break; if (_sp > XB_SPIN_CAP) { atomicAdd(&(bar)[XB_TMO], 1u); break; } } } } while (0)
__device__ __forceinline__ void xcd_barrier_post(unsigned* bar) { if (opaque_tid() == 0) (void)xb_add(&bar[XB_XCNT(xb_xcc_id())], 1u); }
__device__ __forceinline__ void xcd_barrier_complete(unsigned* bar, unsigned x, unsigned& nloc, unsigned& nx) {
    const unsigned G = gridDim.x;
    unsigned sum, cnt, mine, sp = 0u;
    for (;;) {
        sum = 0u; cnt = 0u; mine = 0u;
#pragma unroll
        for (unsigned j = 0; j < 16; ++j) { const unsigned c = xb_ld(&bar[XB_XCNT(j)]); sum += c; cnt += (c > 0u) ? 1u : 0u; mine = (j == x) ? c : mine; }
        if (sum == G) break;
        __builtin_amdgcn_s_sleep(1);
        if ((++sp & 255u) == 0u) { if (xb_ld(&bar[XB_TMO])) break; if (sp > XB_SPIN_CAP) { atomicAdd(&bar[XB_TMO], 1u); break; } }
    }
    nloc = mine > 0u ? mine : 1u; nx = cnt > 0u ? cnt : 1u;
}
__device__ __forceinline__ void xcd_barrier(unsigned* bar, volatile LAS unsigned* st) {
    asm volatile("s_waitcnt vmcnt(0)" ::: "memory");
    __syncthreads();
    if (opaque_tid() == 0) {
        const unsigned x = xb_xcc_id();
        __builtin_amdgcn_s_waitcnt(0);
        unsigned nloc = st[0], nx = st[1];
        if (nloc == 0u) { xcd_barrier_complete(bar, x, nloc, nx); st[0] = nloc; st[1] = nx; }
        const unsigned old = xb_add(&bar[XB_XSUB(x)], 1u);
        const unsigned gen = old / nloc;
        if (old + 1u == (gen + 1u) * nloc) {
            __builtin_amdgcn_fence(__ATOMIC_RELEASE, "agent");
            asm volatile("s_waitcnt vmcnt(0)" ::: "memory");
            const unsigned og = xb_add(&bar[XB_TOP], 1u);
            const unsigned tg = og / nx;
            if (og + 1u == (tg + 1u) * nx) xb_add(&bar[XB_TOPGEN], 1u);
            else XB_SPIN(xb_ld(&bar[XB_TOPGEN]) == tg, bar);
            __builtin_amdgcn_fence(__ATOMIC_ACQUIRE, "agent");
            xb_add(&bar[XB_XGEN(x)], 1u);
            asm volatile("s_waitcnt vmcnt(0)" ::: "memory");
        } else {
            XB_SPIN(xb_ld(&bar[XB_XGEN(x)]) == gen, bar);
            __builtin_amdgcn_fence(__ATOMIC_ACQUIRE, "agent");
            asm volatile("s_waitcnt vmcnt(0)" ::: "memory");
        }
    }
    __syncthreads();
}

namespace pg8 {
constexpr int BM = 256, BK = 64, HALF = 128, HTB = HALF * BK * 2, STAGE_BYTES = 8 * HTB, NXCD = 8, WGM = 8;
__device__ __forceinline__ int lds_byte(int r, int c) { const int st = (r >> 4) * 2 + (c >> 5), rr = r & 15, cc = c & 31, ob = rr * 64 + cc * 2; return st * 1024 + (ob ^ (((ob >> 9) & 1) << 5)); }
__device__ __forceinline__ void stage_rc(int b, int& R, int& C) { const int st = b / 1024, sb = b % 1024, swz = sb ^ (((sb >> 9) & 1) << 5); R = (st >> 1) * 16 + swz / 64; C = (st & 1) * 32 + (swz % 64) / 2; }
__device__ __forceinline__ int perm32(int rho) { const int n = rho >> 4, i = rho & 15; return 8 * (i >> 2) + 4 * n + (i & 3); }
struct Unit { int pm, pn; };
struct Gemm { const bf16_t* A; const bf16_t* Bt; int M, N, K, lda, ldb; };
struct StaticOrder {
    int nM, nN, nwg, G, c;
    __device__ void init(int M, int N, int G_, int c_) { nM = M / BM; nN = N / BM; nwg = nM * nN; G = G_; c = c_; }
    __device__ bool next(int i, Unit& u) const {
        const long L = (long)i * G + c; if (L >= nwg) return false;
        int wgid = (int)L; { const int q = nwg / NXCD, r = nwg % NXCD, xcd = wgid % NXCD, off = wgid / NXCD; wgid = (xcd < r ? xcd * (q + 1) : r * (q + 1) + (xcd - r) * q) + off; }
        const int nig = WGM * nN, gid = wgid / nig, fm = gid * WGM, gsz = (nM - fm) < WGM ? (nM - fm) : WGM;
        u.pm = fm + ((wgid % nig) % gsz); u.pn = (wgid % nig) / gsz; return true;
    }
};

struct SingleUnit {
    int pm, pn; bool has;
    __device__ bool next(int i, Unit& u) const { if (i > 0 || !has) return false; u.pm = pm; u.pn = pn; return true; }
};
template <class Epi, class Sched>
__device__ __forceinline__ void gemm_phase(LAS unsigned char* lds, const Gemm g, const Sched& S, const Epi& E) {
    const int tid = opaque_tid(), wid = __builtin_amdgcn_readfirstlane(tid >> 6), lane = tid & 63, wr = wid >> 2, wc = wid & 3, fr = lane & 15, fq = lane >> 4;
    const int K = g.K, nt = K / BK;
    unsigned voffA[2], voffB[2];
#pragma unroll
    for (int i = 0; i < 2; ++i) { int R, C; stage_rc(tid * 16 + i * 8192, R, C); const int Rb = Epi::PERM ? ((R & ~31) + perm32(R & 31)) : R;
        voffA[i] = (unsigned)(R * g.lda + C) * 2u; voffB[i] = (unsigned)(Rb * g.ldb + C) * 2u; }
    const size_t kstep = (size_t)(BK * 2);
    const size_t hstepA = (size_t)HALF * g.lda * 2, hstepB = (size_t)HALF * g.ldb * 2;
    const size_t tstepA = 2 * hstepA, tstepB = 2 * hstepB;
    const unsigned ldsw = (unsigned)wid * 1024u;
    const int aoff = lds_byte(wr * 64 + fr, fq * 8), boff = lds_byte(wc * 32 + fr, fq * 8);
#define PG8_SA(b, h) (((b) * 2 + (h)) * HTB)
#define PG8_SB(b, h) ((4 + (b) * 2 + (h)) * HTB)
#define PG8_STAGE(bufoff, gbase, voff) do { _Pragma("unroll") for (int _i = 0; _i < 2; ++_i) \
        __builtin_amdgcn_global_load_lds((const unsigned*)((const char*)(gbase) + (voff)[_i]), (LAS unsigned*)(lds + (bufoff) + ldsw + _i * 8192), 16, 0, 0); } while (0)
#define PG8_LDA(dst, b, h) do { _Pragma("unroll") for (int m = 0; m < 4; ++m) _Pragma("unroll") for (int k = 0; k < 2; ++k) dst[m][k] = *(const LAS bf16x8*)(lds + PG8_SA(b, h) + aoff + m * 2048 + k * 1024); } while (0)
#define PG8_LDB(dst, b, h) do { _Pragma("unroll") for (int n = 0; n < 2; ++n) _Pragma("unroll") for (int k = 0; k < 2; ++k) dst[n][k] = *(const LAS bf16x8*)(lds + PG8_SB(b, h) + boff + n * 2048 + k * 1024); } while (0)
#define PG8_MMA(ai, bj, At, Bt) do { __builtin_amdgcn_s_setprio(1); _Pragma("unroll") for (int m = 0; m < 4; ++m) _Pragma("unroll") for (int n = 0; n < 2; ++n) _Pragma("unroll") for (int k = 0; k < 2; ++k) \
        acc[ai][bj][m][n] = __builtin_amdgcn_mfma_f32_16x16x32_bf16(Bt[n][k], At[m][k], acc[ai][bj][m][n], 0, 0, 0); __builtin_amdgcn_s_setprio(0); } while (0)
#define PG8_WAIT_V(n) asm volatile("s_waitcnt vmcnt(" #n ")" ::: "memory")
#define PG8_WAIT_L(n) asm volatile("s_waitcnt lgkmcnt(" #n ")" ::: "memory")
#define PG8_BAR __builtin_amdgcn_s_barrier()
#define PG8_SCHED __builtin_amdgcn_sched_barrier(0)
    Unit cur, nxt; int ui = 0;
    if (!S.next(0, cur)) return;
    f32x4 acc[2][2][4][2];
#pragma unroll
    for (int a = 0; a < 2; ++a)
#pragma unroll
        for (int b = 0; b < 2; ++b)
#pragma unroll
            for (int m = 0; m < 4; ++m)
#pragma unroll
                for (int n = 0; n < 2; ++n) acc[a][b][m][n] = (f32x4){0.f, 0.f, 0.f, 0.f};
    bf16x8 At[4][2], B0[2][2], B1[2][2];
    const char* cA = (const char*)g.A + (size_t)cur.pm * tstepA; const char* cB = (const char*)g.Bt + (size_t)cur.pn * tstepB;
    PG8_STAGE(PG8_SB(0, 0), cB, voffB); PG8_STAGE(PG8_SA(0, 0), cA, voffA); PG8_STAGE(PG8_SB(0, 1), cB + hstepB, voffB); PG8_STAGE(PG8_SA(0, 1), cA + hstepA, voffA);
    if (wr == 1) PG8_BAR;
    PG8_WAIT_V(4); PG8_BAR;
    PG8_STAGE(PG8_SB(1, 0), cB + kstep, voffB); PG8_STAGE(PG8_SA(1, 0), cA + kstep, voffA); PG8_STAGE(PG8_SB(1, 1), cB + hstepB + kstep, voffB);
    PG8_WAIT_V(6); PG8_BAR;
    for (;;) {
        const bool has_next = S.next(ui + 1, nxt);
        const char* nA = has_next ? (const char*)g.A + (size_t)nxt.pm * tstepA : cA; const char* nB = has_next ? (const char*)g.Bt + (size_t)nxt.pn * tstepB : cB;
        for (int t = 0; t < nt; t += 2) {
            const bool last = (t == nt - 2);
            const char* a1 = cA + (size_t)(t + 1) * kstep;
            const char* a2 = last ? nA : cA + (size_t)(t + 2) * kstep; const char* b2 = last ? nB : cB + (size_t)(t + 2) * kstep;
            const char* a3 = a2 + kstep; const char* b3 = b2 + kstep;
            PG8_LDB(B0, 0, 0); PG8_SCHED; PG8_LDA(At, 0, 0); PG8_STAGE(PG8_SA(1, 1), a1 + hstepA, voffA);
            PG8_WAIT_L(8); PG8_BAR; PG8_WAIT_L(0); PG8_MMA(0, 0, At, B0); PG8_BAR; PG8_SCHED;
            PG8_LDB(B1, 0, 1); PG8_STAGE(PG8_SB(0, 0), b2, voffB);
            PG8_BAR; PG8_WAIT_L(0); PG8_MMA(0, 1, At, B1); PG8_BAR;
            PG8_LDA(At, 0, 1); PG8_STAGE(PG8_SA(0, 0), a2, voffA);
            PG8_BAR; PG8_WAIT_L(0); PG8_MMA(1, 0, At, B0); PG8_BAR; PG8_SCHED;
            PG8_STAGE(PG8_SB(0, 1), b2 + hstepB, voffB);
            PG8_WAIT_V(6); PG8_BAR; PG8_MMA(1, 1, At, B1); PG8_BAR;
            PG8_LDB(B0, 1, 0); PG8_SCHED; PG8_LDA(At, 1, 0); PG8_STAGE(PG8_SA(0, 1), a2 + hstepA, voffA);
            PG8_WAIT_L(8); PG8_BAR; PG8_WAIT_L(0); PG8_MMA(0, 0, At, B0); PG8_BAR; PG8_SCHED;
            PG8_LDB(B1, 1, 1); PG8_STAGE(PG8_SB(1, 0), b3, voffB);
            PG8_BAR; PG8_WAIT_L(0); PG8_MMA(0, 1, At, B1); PG8_BAR;
            PG8_LDA(At, 1, 1); PG8_STAGE(PG8_SA(1, 0), a3, voffA);
            PG8_BAR; PG8_WAIT_L(0); PG8_MMA(1, 0, At, B0); PG8_BAR; PG8_SCHED;
            PG8_STAGE(PG8_SB(1, 1), b3 + hstepB, voffB);
            PG8_WAIT_V(6); PG8_BAR; PG8_MMA(1, 1, At, B1); PG8_BAR;
            if constexpr (Epi::HOOK) { if ((((t + 2) & 3) == 0) && !last) E.hook(acc, cur, (t + 2) >> 2, wr, wc, fr, fq); }
        }
        E(acc, cur, wr, wc, fr, fq);
        if (!has_next) break;
#pragma unroll
        for (int a = 0; a < 2; ++a)
#pragma unroll
            for (int b = 0; b < 2; ++b)
#pragma unroll
                for (int m = 0; m < 4; ++m)
#pragma unroll
                    for (int n = 0; n < 2; ++n) acc[a][b][m][n] = (f32x4){0.f, 0.f, 0.f, 0.f};
        cur = nxt; cA = nA; cB = nB; ++ui;
    }
    PG8_WAIT_V(0);
    if (wr == 0) PG8_BAR;
    PG8_BAR;
#undef PG8_SA
#undef PG8_SB
#undef PG8_STAGE
#undef PG8_LDA
#undef PG8_LDB
#undef PG8_MMA
#undef PG8_WAIT_V
#undef PG8_WAIT_L
#undef PG8_BAR
#undef PG8_SCHED
}
}
using pg8::Unit;

__device__ __forceinline__ size_t g8_off(int row, int colg) { return ((size_t)(row >> 4) * 128 + (colg >> 5)) * 512 + (row & 15) * 32 + (colg & 31); }

struct EpiSwiglu {
    static constexpr bool HOOK = false;
    static constexpr bool PERM = true;
    bf16_t* HID;
    __device__ __forceinline__ void operator()(const f32x4 (&acc)[2][2][4][2], const Unit& u, int wr, int wc, int fr, int fq) const {
        { const int t_ = opaque_tid(); wr = t_ >> 8; wc = (t_ >> 6) & 3; fr = t_ & 15; fq = (t_ >> 4) & 3; }
        const int row0 = u.pm * 256 + wr * 64 + fr, col0 = u.pn * 128 + wc * 32 + 8 * fq;
#pragma unroll
        for (int ai = 0; ai < 2; ++ai)
#pragma unroll
            for (int m = 0; m < 4; ++m) {
                const int row = row0 + ai * 128 + m * 16;
                float hv[8];
#pragma unroll
                for (int n = 0; n < 2; ++n)
#pragma unroll
                    for (int j = 0; j < 4; ++j) { const float a = acc[ai][0][m][n][j], b = acc[ai][1][m][n][j]; hv[4 * n + j] = a * sigmoidf_(a) * b; }
                u32x4 w; w.x = cvt_pk_bf16(hv[0], hv[1]); w.y = cvt_pk_bf16(hv[2], hv[3]); w.z = cvt_pk_bf16(hv[4], hv[5]); w.w = cvt_pk_bf16(hv[6], hv[7]);
                *(u32x4*)(HID + (size_t)row * FH + col0) = w;
            }
    }
};
struct EpiResid {
    static constexpr bool HOOK = false;
    static constexpr bool PERM = false;
    float* Hl; float* Hc; const float* gate; float coef;
    __device__ __forceinline__ void operator()(const f32x4 (&acc)[2][2][4][2], const Unit& u, int wr, int wc, int fr, int fq) const {
        { const int t_ = opaque_tid(); wr = t_ >> 8; wc = (t_ >> 6) & 3; fr = t_ & 15; fq = (t_ >> 4) & 3; }
        const int row0 = u.pm * 256 + wr * 64 + fr, col0 = u.pn * 256 + wc * 32 + 4 * fq;
#pragma unroll
        for (int ai = 0; ai < 2; ++ai)
#pragma unroll
            for (int m = 0; m < 4; ++m) {
                const int row = row0 + ai * 128 + m * 16;
                float* hp = row < RL ? Hl + (size_t)row * 1024 : Hc + (size_t)(row - RL) * 1024;
                const float* gp = gate + (row < RL ? (row >> 13) : 4) * 9216;
#pragma unroll
                for (int bj = 0; bj < 2; ++bj)
#pragma unroll
                    for (int n = 0; n < 2; ++n) {
                        const int c = col0 + bj * 128 + n * 16;
                        const f32x4 g4 = *(const f32x4*)(gp + c); f32x4 h4 = *(const f32x4*)(hp + c);
                        h4 += (g4 * coef) * acc[ai][bj][m][n];
                        *(f32x4*)(hp + c) = h4;
                    }
            }
    }
};
struct EpiPartial {
    static constexpr bool HOOK = false;
    static constexpr bool PERM = false;
    float* PB; const float* gate; float coef;
    __device__ __forceinline__ void operator()(const f32x4 (&acc)[2][2][4][2], const Unit& u, int wr, int wc, int fr, int fq) const {
        { const int t_ = opaque_tid(); wr = t_ >> 8; wc = (t_ >> 6) & 3; fr = t_ & 15; fq = (t_ >> 4) & 3; }
        const int row0 = u.pm * 256 + wr * 64 + fr - RL, col0 = u.pn * 256 + wc * 32 + 4 * fq;
#pragma unroll
        for (int ai = 0; ai < 2; ++ai)
#pragma unroll
            for (int m = 0; m < 4; ++m) {
                float* hp = PB + (size_t)(row0 + ai * 128 + m * 16) * 1024;
#pragma unroll
                for (int bj = 0; bj < 2; ++bj)
#pragma unroll
                    for (int n = 0; n < 2; ++n) {
                        const int c = col0 + bj * 128 + n * 16;
                        const f32x4 g4 = *(const f32x4*)(gate + c);
                        *(f32x4*)(hp + c) = (g4 * coef) * acc[ai][bj][m][n];
                    }
            }
    }
};
struct EpiPJ {
    static constexpr bool HOOK = false;
    static constexpr bool PERM = true;
    bf16_t* PJ; unsigned char* G8;
    __device__ __forceinline__ void operator()(const f32x4 (&acc)[2][2][4][2], const Unit& u, int wr, int wc, int fr, int fq) const {
        { const int t_ = opaque_tid(); wr = t_ >> 8; wc = (t_ >> 6) & 3; fr = t_ & 15; fq = (t_ >> 4) & 3; }
        const int row0 = u.pm * 256 + wr * 64 + fr, c0 = wc * 32 + 8 * fq;
        if (u.pn < 9) {
#pragma unroll
            for (int ai = 0; ai < 2; ++ai)
#pragma unroll
                for (int m = 0; m < 4; ++m) {
                    const int row = row0 + ai * 128 + m * 16;
#pragma unroll
                    for (int bj = 0; bj < 2; ++bj) {
                        const f32x4 v0 = acc[ai][bj][m][0], v1 = acc[ai][bj][m][1];
                        u32x4 w; w.x = cvt_pk_bf16(v0[0], v0[1]); w.y = cvt_pk_bf16(v0[2], v0[3]); w.z = cvt_pk_bf16(v1[0], v1[1]); w.w = cvt_pk_bf16(v1[2], v1[3]);
                        *(u32x4*)(PJ + (size_t)row * PJW + u.pn * 256 + bj * 128 + c0) = w;
                    }
                }
        } else {
#pragma unroll
            for (int ai = 0; ai < 2; ++ai)
#pragma unroll
                for (int m = 0; m < 4; ++m) {
                    const int row = row0 + ai * 128 + m * 16;
#pragma unroll
                    for (int bj = 0; bj < 2; ++bj) {
                        unsigned q[8];
#pragma unroll
                        for (int n = 0; n < 2; ++n)
#pragma unroll
                            for (int j = 0; j < 4; ++j) { int v = (int)(sigmoidf_(acc[ai][bj][m][n][j]) * 256.0f); q[4 * n + j] = (unsigned)(v > 255 ? 255 : v); }
                        u32x2 w; w.x = q[0] | (q[1] << 8) | (q[2] << 16) | (q[3] << 24); w.y = q[4] | (q[5] << 8) | (q[6] << 16) | (q[7] << 24);
                        *(u32x2*)(G8 + g8_off(row, (u.pn - 9) * 256 + bj * 128 + c0)) = w;
                    }
                }
        }
    }
};
struct EpiMLA {
    static constexpr bool HOOK = false;
    static constexpr bool PERM = true;
    bf16_t *MQ, *MK, *MV; const float* RSTD; const float2* RT;
    __device__ __forceinline__ void operator()(const f32x4 (&acc)[2][2][4][2], const Unit& u, int wr, int wc, int fr, int fq) const {
        { const int t_ = opaque_tid(); wr = t_ >> 8; wc = (t_ >> 6) & 3; fr = t_ & 15; fq = (t_ >> 4) & 3; }
        const int row0 = u.pm * 256 + wr * 64 + fr;
#pragma unroll
        for (int bj = 0; bj < 2; ++bj) {
            const int cg0 = u.pn * 256 + bj * 128 + wc * 32;
            if (cg0 >= 896) continue;
#pragma unroll
            for (int ai = 0; ai < 2; ++ai)
#pragma unroll
                for (int m = 0; m < 4; ++m) {
                    __builtin_amdgcn_sched_barrier(0);
                    const int row = row0 + ai * 128 + m * 16;
                    float v[8];
                    if (cg0 < 384) {
                        const float rs = RSTD[row * 2];
#pragma unroll
                        for (int n = 0; n < 2; ++n)
#pragma unroll
                            for (int j = 0; j < 4; ++j) v[4 * n + j] = acc[ai][bj][m][n][j] * rs;
                        const int d0 = cg0 % 96;
                        if (d0 == 64) {
                            const bool lat = row < RL; const int t = row & 8191; const int pos = (fq >> 1) ? (t & 63) : (t >> 6); const bool isx2 = fq & 1;
#pragma unroll
                            for (int e = 0; e < 8; ++e) {
                                const float pr = shflx(v[e], 16);
                                const float2 cs = RT[pos * 8 + e];
                                const float r = isx2 ? (pr * cs.y + v[e] * cs.x) : (v[e] * cs.x - pr * cs.y);
                                v[e] = lat ? r : v[e];
                            }
                        }
                        u32x4 w; w.x = cvt_pk_bf16(v[0], v[1]); w.y = cvt_pk_bf16(v[2], v[3]); w.z = cvt_pk_bf16(v[4], v[5]); w.w = cvt_pk_bf16(v[6], v[7]);
                        *(u32x4*)(MQ + (size_t)row * 384 + cg0 + 8 * fq) = w;
                    } else {
                        const float rs = RSTD[row * 2 + 1];
#pragma unroll
                        for (int n = 0; n < 2; ++n)
#pragma unroll
                            for (int j = 0; j < 4; ++j) v[4 * n + j] = acc[ai][bj][m][n][j] * rs;
                        const int cp = cg0 - 384, hd = cp >> 7, d0 = cp & 127;
                        u32x4 w; w.x = cvt_pk_bf16(v[0], v[1]); w.y = cvt_pk_bf16(v[2], v[3]); w.z = cvt_pk_bf16(v[4], v[5]); w.w = cvt_pk_bf16(v[6], v[7]);
                        if (d0 < 64) *(u32x4*)(MK + (size_t)row * 384 + hd * 96 + d0 + 8 * fq) = w;
                        else *(u32x4*)(MV + (size_t)row * 256 + hd * 64 + (d0 - 64) + 8 * fq) = w;
                    }
                }
        }
    }
};
struct EpiMerge {
    static constexpr bool PERM = true, HOOK = true;
    const unsigned char* G8; bf16_t* MG;
    __device__ __forceinline__ void hook(f32x4 (&acc)[2][2][4][2], const Unit& u, int nb, int wr, int wc, int fr, int fq) const {
        { const int t_ = opaque_tid(); wr = t_ >> 8; wc = (t_ >> 6) & 3; fr = t_ & 15; fq = (t_ >> 4) & 3; }
        const int row0 = u.pm * 256 + wr * 64 + fr, c0 = u.pn * 256 + wc * 32 + 8 * fq;
#pragma unroll
        for (int ai = 0; ai < 2; ++ai) {
            u32x2 ga[4][2], gb[4][2];
#pragma unroll
            for (int m = 0; m < 4; ++m)
#pragma unroll
                for (int bj = 0; bj < 2; ++bj) { const int row = row0 + ai * 128 + m * 16, c = c0 + bj * 128;
                    ga[m][bj] = *(const u32x2*)(G8 + g8_off(row, (nb - 1) * 1024 + c)); gb[m][bj] = *(const u32x2*)(G8 + g8_off(row, nb * 1024 + c)); }
#pragma unroll
            for (int m = 0; m < 4; ++m)
#pragma unroll
                for (int bj = 0; bj < 2; ++bj)
#pragma unroll
                    for (int e = 0; e < 8; ++e) { const unsigned qa = ((e < 4 ? ga[m][bj].x : ga[m][bj].y) >> (8 * (e & 3))) & 255u, qb = ((e < 4 ? gb[m][bj].x : gb[m][bj].y) >> (8 * (e & 3))) & 255u;
                        acc[ai][bj][m][e >> 2][e & 3] *= ((float)qa + 0.5f) * fast_rcp((float)qb + 0.5f); }
            __builtin_amdgcn_sched_barrier(0);
        }
    }
    __device__ __forceinline__ void operator()(const f32x4 (&acc)[2][2][4][2], const Unit& u, int wr, int wc, int fr, int fq) const {
        { const int t_ = opaque_tid(); wr = t_ >> 8; wc = (t_ >> 6) & 3; fr = t_ & 15; fq = (t_ >> 4) & 3; }
        const int row0 = u.pm * 256 + wr * 64 + fr, c0 = u.pn * 256 + wc * 32 + 8 * fq;
#pragma unroll
        for (int ai = 0; ai < 2; ++ai) {
            u32x2 gq[4][2];
#pragma unroll
            for (int m = 0; m < 4; ++m)
#pragma unroll
                for (int bj = 0; bj < 2; ++bj) gq[m][bj] = *(const u32x2*)(G8 + g8_off(row0 + ai * 128 + m * 16, 3 * 1024 + c0 + bj * 128));
#pragma unroll
            for (int m = 0; m < 4; ++m)
#pragma unroll
                for (int bj = 0; bj < 2; ++bj) {
                    const int row = row0 + ai * 128 + m * 16, c = c0 + bj * 128;
                    float v[8];
#pragma unroll
                    for (int e = 0; e < 8; ++e) { const unsigned q = ((e < 4 ? gq[m][bj].x : gq[m][bj].y) >> (8 * (e & 3))) & 255u; v[e] = ((float)q + 0.5f) * (1.0f / 256.0f) * acc[ai][bj][m][e >> 2][e & 3]; }
                    u32x4 w; w.x = cvt_pk_bf16(v[0], v[1]); w.y = cvt_pk_bf16(v[2], v[3]); w.z = cvt_pk_bf16(v[4], v[5]); w.w = cvt_pk_bf16(v[6], v[7]);
                    *(u32x4*)(MG + (size_t)row * 1024 + c) = w;
                }
            __builtin_amdgcn_sched_barrier(0);
        }
    }
};

template <class F>
__device__ __forceinline__ void wt_rows64(bf16_t* dst, int K, F srcval, int ldd, int kbeg, int kend) {
    if (ldd == 0) ldd = K;
    if (kend > K) kend = K;
    const int tid_ = opaque_tid(); const int nl = tid_ & 63, kq = tid_ >> 6;
    for (int k0 = kbeg + kq * 8; k0 < kend; k0 += 64) {
        float v[8];
#pragma unroll
        for (int j = 0; j < 8; ++j) v[j] = srcval(nl, k0 + j);
        u32x4 w; w.x = cvt_pk_bf16(v[0], v[1]); w.y = cvt_pk_bf16(v[2], v[3]); w.z = cvt_pk_bf16(v[4], v[5]); w.w = cvt_pk_bf16(v[6], v[7]);
        *(u32x4*)(dst + (size_t)nl * ldd + k0) = w;
    }
}

__device__ void layer_prep_phase(PK p, int l, LAS unsigned char* lds) {
    unsigned char* ws = p->ws;
    const int nW = 1648, nItems = nW + (l == 0 ? 288 + 1 : 0);
    for (int it2 = opaque_bid(); it2 < nItems; it2 += opaque_gdim()) {
        int it, kbeg = 0, kend = 1 << 30;
        if (it2 < 704) { it = it2 >> 2; kbeg = (it2 & 3) * 256; kend = kbeg + 256; }
        else if (it2 < 1056) { const int q = it2 - 704; it = 176 + q / 11; kbeg = (q % 11) * 256; kend = kbeg + 256; }
        else if (it2 < 1456) { const int q = it2 - 1056; it = 208 + (q >> 2); kbeg = (q & 3) * 256; kend = kbeg + 256; }
        else if (it2 < 1520) { const int q = it2 - 1456; it = 308 + (q >> 2); kbeg = (q & 3) * 256; kend = kbeg + 256; }
        else if (it2 < 1568) { it = 324 + (it2 - 1520); }
        else if (it2 < 1632) { const int q = it2 - 1568; it = 372 + (q >> 2); kbeg = (q & 3) * 64; kend = kbeg + 64; }
        else if (it2 < 1648) { it = 388 + (it2 - 1632); }
        else it = 404 + (it2 - 1648);
        if (it < 176) {
            const int f = it / 88, j = it % 88; const float* src = p->ffn_w_in + ((size_t)(l * 2 + f) * 1024) * 5632;
            bf16_t* dst = (bf16_t*)(ws + OFF_W1) + ((size_t)f * 5632 + j * 64) * 1024;
            wt_rows64(dst, 1024, [&](int nl, int k) { const int np = j * 64 + nl, pn = np >> 8, wi = np & 255; const int col = wi < 128 ? pn * 128 + wi : FH + pn * 128 + (wi - 128); return src[(size_t)k * 5632 + col]; }, 0, kbeg, kend);
        } else if (it < 208) {
            const int q = it - 176, f = q / 16, j = q % 16; const float* src = p->ffn_w_out + ((size_t)(l * 2 + f) * FH) * 1024;
            bf16_t* dst = (bf16_t*)(ws + OFF_W2) + ((size_t)f * 1024 + j * 64) * FH;
            wt_rows64(dst, FH, [&](int nl, int k) { return src[(size_t)k * 1024 + j * 64 + nl]; }, 0, kbeg, kend);
        } else if (it < 308) {
            const int j = it - 208; const float* src = p->mix_w_in + (size_t)l * 1024 * 6304;
            bf16_t* dst = (bf16_t*)(ws + OFF_WM) + (size_t)j * 64 * 1024;
            wt_rows64(dst, 1024, [&](int nl, int k) { const int np = j * 64 + nl; const int col = np < 2208 ? np : (np < 2304 ? -1 : np - 96); return col < 0 ? 0.f : src[(size_t)k * 6304 + col]; }, 0, kbeg, kend);
        } else if (it < 324) {
            const int j = it - 308; const float* src = p->mix_w_out + (size_t)l * 1024 * 1024;
            bf16_t* dst = (bf16_t*)(ws + OFF_WO) + (size_t)j * 64 * 1024;
            wt_rows64(dst, 1024, [&](int nl, int k) { return src[(size_t)k * 1024 + j * 64 + nl]; }, 0, kbeg, kend);
        } else if (it < 372) {
            const int q = it - 324, bi = 1 + q / 16, j = q % 16; const float* src = p->branch_w_out + ((size_t)(l * 4 + bi) * 256) * 1024;
            bf16_t* dst = (bf16_t*)(ws + OFF_WB) + (size_t)j * 64 * 1024 + bi * 256;
            wt_rows64(dst, 256, [&](int nl, int k) { return src[(size_t)k * 1024 + j * 64 + nl]; }, 1024, kbeg, kend);
        } else if (it < 388) {
            const int j = it - 372; const float* wb = p->branch_w_out + ((size_t)(l * 4) * 256) * 1024; const float* pw = p->pool_w + (size_t)l * 4 * 64 * 64; const float* ps = p->pool_scale + l * 256;
            bf16_t* dst = (bf16_t*)(ws + OFF_WB) + (size_t)j * 64 * 1024;
            wt_rows64(dst, 256, [&](int nl, int k) { const int gI = k >> 6, n = j * 64 + nl; const float* pr = pw + (size_t)k * 64; float s = 0.f;
                for (int e = 0; e < 64; ++e) s += pr[e] * ps[gI * 64 + e] * wb[(size_t)(gI * 64 + e) * 1024 + n]; return s; }, 1024, kbeg, kend);
        } else if (it < 404) {
            const int j = it - 388; const float* wq = p->mla_w_qb + (size_t)l * 256 * 384; const float* wk = p->mla_w_kvb + (size_t)l * 128 * 512;
            const float* gq = p->mla_q_norm_g + l * 256; const float* gk = p->mla_kv_norm_g + l * 128;
            bf16_t* dst = (bf16_t*)(ws + OFF_WL) + (size_t)j * 64 * 384;
            wt_rows64(dst, 384, [&](int nl, int k) { const int n = j * 64 + nl;
                if (n < 384) return k < 256 ? gq[k] * wq[(size_t)k * 384 + n] : 0.f;
                if (n < 896) return k >= 256 ? gk[k - 256] * wk[(size_t)(k - 256) * 512 + (n - 384)] : 0.f;
                return 0.f; }, 0, kbeg, kend);
        } else if (it < 404 + 288) {
            const int q = it - 404, ll = q / 144, cb = q % 144;
            LAS float* sc = (LAS float*)lds;
            LAS float* red = (LAS float*)(lds + 5 * 1024 * 4);
            __syncthreads();
            for (int i = opaque_tid(); i < 5 * 1024; i += 512) { const int r = i >> 10, k = i & 1023; const float cv = r < 4 ? p->c[r * 1024 + k] : p->c_ctx[k]; sc[i] = cv * sigmoidf_(cv); }
            __syncthreads();
            const int jl = opaque_tid() & 63, kg = opaque_tid() >> 6; const int col = cb * 64 + jl;
            const float* wsrc = p->ada_w + (size_t)ll * 1024 * 9216 + col;
            float a0 = 0.f, a1 = 0.f, a2 = 0.f, a3 = 0.f, a4 = 0.f;
            for (int k = kg * 128; k < kg * 128 + 128; ++k) { const float wv = wsrc[(size_t)k * 9216]; a0 += sc[k] * wv; a1 += sc[1024 + k] * wv; a2 += sc[2048 + k] * wv; a3 += sc[3072 + k] * wv; a4 += sc[4096 + k] * wv; }
            red[(kg * 5 + 0) * 64 + jl] = a0; red[(kg * 5 + 1) * 64 + jl] = a1; red[(kg * 5 + 2) * 64 + jl] = a2; red[(kg * 5 + 3) * 64 + jl] = a3; red[(kg * 5 + 4) * 64 + jl] = a4;
            __syncthreads();
            if (opaque_tid() < 320) { const int r = opaque_tid() >> 6; float s = p->ada_b[ll * 9216 + col];
                for (int q2 = 0; q2 < 8; ++q2) s += red[(q2 * 5 + r) * 64 + jl];
                ((float*)(ws + OFF_MOD))[(size_t)(ll * 5 + r) * 9216 + col] = s; }
        } else {
            for (int i = opaque_tid(); i < 1024; i += 512) { const int pos = i >> 3, fi = i & 7; const float inv = exp2f(-(float)fi * 0.125f * 13.287712379549449f); const float ang = (float)pos * inv;
                ((float2*)(ws + OFF_ROPE))[i] = make_float2(cosf(ang), sinf(ang)); }
        }
    }
}

__device__ void norm_mod_phase(const float* srcL, const float* srcC, float* cpyL, float* cpyC, const float* g, const float* mod, bf16_t* TN, int nrows, const float* pb, int nsl) {
    const int tid_ = opaque_tid(); const int lane = tid_ & 63, gw = opaque_bid() * 8 + (tid_ >> 6), nw = opaque_gdim() * 8;
    for (int row = gw; row < nrows; row += nw) {
        const bool lat = row < RL;
        const float* sp = lat ? srcL + (size_t)row * 1024 : srcC + (size_t)(row - RL) * 1024;
        const float* mp = mod + (lat ? (row >> 13) : 4) * 9216;
        f32x4 v[4]; float ss = 0.f;
#pragma unroll
        for (int j = 0; j < 4; ++j) v[j] = *(const f32x4*)(sp + 256 * j + 4 * lane);
        if (!lat && nsl > 0) {
            for (int sl = 0; sl < nsl; ++sl) { const float* pp = pb + ((size_t)sl * 1024 + (row - RL)) * 1024;
#pragma unroll
                for (int j = 0; j < 4; ++j) v[j] += *(const f32x4*)(pp + 256 * j + 4 * lane); }
            float* wp = (float*)sp;
#pragma unroll
            for (int j = 0; j < 4; ++j) *(f32x4*)(wp + 256 * j + 4 * lane) = v[j];
        }
#pragma unroll
        for (int j = 0; j < 4; ++j) ss += v[j][0] * v[j][0] + v[j][1] * v[j][1] + v[j][2] * v[j][2] + v[j][3] * v[j][3];
        if (cpyL) { float* cp = lat ? cpyL + (size_t)row * 1024 : cpyC + (size_t)(row - RL) * 1024;
#pragma unroll
            for (int j = 0; j < 4; ++j) *(f32x4*)(cp + 256 * j + 4 * lane) = v[j]; }
        ss = wave_sum(ss);
        const float rstd = rsqrtf(ss * (1.0f / 1024.0f) + NEPS);
#pragma unroll
        for (int j = 0; j < 4; ++j) {
            const int col = 256 * j + 4 * lane;
            const f32x4 gg = *(const f32x4*)(g + col), sh = *(const f32x4*)(mp + col), sc = *(const f32x4*)(mp + 1024 + col);
            float o[4];
#pragma unroll
            for (int e = 0; e < 4; ++e) o[e] = (v[j][e] * rstd * gg[e]) * (1.0f + sc[e]) + sh[e];
            u32x2 w; w.x = cvt_pk_bf16(o[0], o[1]); w.y = cvt_pk_bf16(o[2], o[3]);
            *(u32x2*)(TN + (size_t)row * 1024 + col) = w;
        }
    }
}
__device__ void final_norm_phase(float* H, const float* g) {
    const int tid_ = opaque_tid(); const int lane = tid_ & 63, gw = opaque_bid() * 8 + (tid_ >> 6), nw = opaque_gdim() * 8;
    for (int row = gw; row < RL; row += nw) {
        float* sp = H + (size_t)row * 1024; f32x4 v[4]; float ss = 0.f;
#pragma unroll
        for (int j = 0; j < 4; ++j) { v[j] = *(const f32x4*)(sp + 256 * j + 4 * lane); ss += v[j][0] * v[j][0] + v[j][1] * v[j][1] + v[j][2] * v[j][2] + v[j][3] * v[j][3]; }
        ss = wave_sum(ss);
        const float rstd = rsqrtf(ss * (1.0f / 1024.0f) + NEPS);
#pragma unroll
        for (int j = 0; j < 4; ++j) { const f32x4 gg = *(const f32x4*)(g + 256 * j + 4 * lane); *(f32x4*)(sp + 256 * j + 4 * lane) = v[j] * rstd * gg; }
    }
}

__device__ void prep_phase(PK p) {
    unsigned char* ws = p->ws;
    bf16_t* PJ = (bf16_t*)(ws + OFF_B); bf16_t* YB = (bf16_t*)(ws + OFF_A); bf16_t* MK = (bf16_t*)(ws + OFF_MK); float* RSTD = (float*)(ws + OFF_RSTD);
    const float2* RT = (const float2*)(ws + OFF_ROPE);
    const int tid_ = opaque_tid(); const int lane = tid_ & 63, gw = opaque_bid() * 8 + (tid_ >> 6), nw = opaque_gdim() * 8;
    for (int row = gw; row < RA; row += nw) {
        const bool lat = row < RL;
        int t, n; if (lat) { t = row & 8191; n = 8192; } else { t = (row - RL) & 255; n = 256; }
        const int sbase = row - t;
        bf16_t* prow = PJ + (size_t)row * PJW;
        {
            const int wdw = 2 << (lane >> 4), hw = wdw >> 1; const int lo = max(t - hw, 0), hi = min(t + hw, n);
            float s0 = 0.f, s1 = 0.f, s2 = 0.f, s3 = 0.f;
#pragma unroll
            for (int i = 0; i < 16; ++i) {
                const int off = i - 8, tt = t + off; const bool ok = (off >= -hw) && (off < hw) && (tt >= 0) && (tt < n);
                const u32x2 v = *(const u32x2*)(PJ + (size_t)(sbase + (ok ? tt : t)) * PJW + 4 * lane); const float wg = ok ? 1.0f : 0.0f;
                s0 += wg * bf_lo(v.x); s1 += wg * bf_hi(v.x); s2 += wg * bf_lo(v.y); s3 += wg * bf_hi(v.y); }
            const float ic = 1.0f / (float)(hi - lo); const u32x2 sv = *(const u32x2*)(prow + 4 * lane);
            u32x2 w; w.x = cvt_pk_bf16(s0 * ic - bf_lo(sv.x), s1 * ic - bf_hi(sv.x)); w.y = cvt_pk_bf16(s2 * ic - bf_lo(sv.y), s3 * ic - bf_hi(sv.y));
            *(u32x2*)(YB + (size_t)row * 1024 + 4 * lane) = w;
        }
        {
            const u32x2 q = *(const u32x2*)(prow + C_MQ + 4 * lane); const unsigned kv = *(const unsigned*)(prow + C_MKV + 2 * lane);
            float sq = bf_lo(q.x) * bf_lo(q.x) + bf_hi(q.x) * bf_hi(q.x) + bf_lo(q.y) * bf_lo(q.y) + bf_hi(q.y) * bf_hi(q.y);
            float sk = bf_lo(kv) * bf_lo(kv) + bf_hi(kv) * bf_hi(kv);
            sq = wave_sum(sq); sk = wave_sum(sk);
            if (lane == 0) { RSTD[row * 2] = rsqrtf(sq * (1.0f / 256.0f) + NEPS); RSTD[row * 2 + 1] = rsqrtf(sk * (1.0f / 128.0f) + NEPS); }
        }
        if (lane < 34) {
            const bool iskr = lane >= 32; const int a = lane & 1;
            bf16_t* ep = iskr ? prow + C_MKR + a * 16 : prow + ((lane >> 4) ? C_DK : C_DQ) + ((lane >> 1) & 7) * 32 + a * 16;
            const u32x4 e0 = *(const u32x4*)ep, e1 = *(const u32x4*)(ep + 8);
            float x1[8], x2[8];
            x1[0] = bf_lo(e0.x); x1[1] = bf_hi(e0.x); x1[2] = bf_lo(e0.y); x1[3] = bf_hi(e0.y); x1[4] = bf_lo(e0.z); x1[5] = bf_hi(e0.z); x1[6] = bf_lo(e0.w); x1[7] = bf_hi(e0.w);
            x2[0] = bf_lo(e1.x); x2[1] = bf_hi(e1.x); x2[2] = bf_lo(e1.y); x2[3] = bf_hi(e1.y); x2[4] = bf_lo(e1.z); x2[5] = bf_hi(e1.z); x2[6] = bf_lo(e1.w); x2[7] = bf_hi(e1.w);
            if (lat) { const int pos = a ? (t & 63) : (t >> 6);
#pragma unroll
                for (int i = 0; i < 8; ++i) { const float2 cs = RT[pos * 8 + i]; const float o1 = x1[i] * cs.x - x2[i] * cs.y, o2 = x1[i] * cs.y + x2[i] * cs.x; x1[i] = o1; x2[i] = o2; } }
            u32x4 w0, w1; w0.x = cvt_pk_bf16(x1[0], x1[1]); w0.y = cvt_pk_bf16(x1[2], x1[3]); w0.z = cvt_pk_bf16(x1[4], x1[5]); w0.w = cvt_pk_bf16(x1[6], x1[7]);
            w1.x = cvt_pk_bf16(x2[0], x2[1]); w1.y = cvt_pk_bf16(x2[2], x2[3]); w1.z = cvt_pk_bf16(x2[4], x2[5]); w1.w = cvt_pk_bf16(x2[6], x2[7]);
            if (iskr) {
#pragma unroll
                for (int hh = 0; hh < 4; ++hh) { bf16_t* kp = MK + (size_t)row * 384 + hh * 96 + 64 + a * 16; *(u32x4*)kp = w0; *(u32x4*)(kp + 8) = w1; }
            } else if (lat) { *(u32x4*)ep = w0; *(u32x4*)(ep + 8) = w1; }
        }
    }
}

#define MFMA32(a, b, c) __builtin_amdgcn_mfma_f32_32x32x16_bf16((a), (b), (c), 0, 0, 0)
typedef float f32x2 __attribute__((ext_vector_type(2)));
template <int MODE>
__device__ __forceinline__ void attn_item(PK p, int l, LAS unsigned char* lds, int b, int h, int qb, bool ctxq, float lam, float lam_init) {
    constexpr int NCOMP = (MODE == 1) ? 2 : 1, NKS = (MODE == 0) ? 4 : ((MODE == 1) ? 2 : 6), KW = NCOMP * NKS * 16, KCH = KW / 8, KSTR = KW * 2 + 16, VSTR = 192;
    constexpr int KBUF = 64 * KSTR, VBUF = 64 * VSTR, BUFSZ = KBUF + VBUF, BIAS_OFF = 3 * BUFSZ;
    constexpr bool STAG = (MODE != 0);
    const int tid = opaque_tid(), w = tid >> 6, lane = tid & 63, g = lane >> 5, l32 = lane & 31;
    unsigned char* ws = p->ws;
    const bf16_t* PJ = (const bf16_t*)(ws + OFF_B);
    const bf16_t *Qp, *Kp, *Vp; int ldq, ldk, ldv, outoff; float scale;
    if (MODE == 0) { Qp = PJ + C_NQ + 64 * h; Kp = PJ + C_NK + 64 * h; Vp = PJ + C_NV + 64 * h; ldq = ldk = ldv = PJW; outoff = 256 + 64 * h; scale = 0.125f; }
    else if (MODE == 1) { Qp = PJ + C_DQ + 64 * h; Kp = PJ + C_DK + 64 * h; Vp = PJ + C_DV + 64 * h; ldq = ldk = ldv = PJW; outoff = 512 + 64 * h; scale = 0.17677669529663687f; }
    else { Qp = (const bf16_t*)(ws + OFF_D) + 96 * h; Kp = (const bf16_t*)(ws + OFF_MK) + 96 * h; Vp = (const bf16_t*)(ws + OFF_MV) + 64 * h; ldq = ldk = 384; ldv = 256; outoff = 768 + 64 * h; scale = 0.10206207261596575f; }
    const float cs = scale * LOG2E;
    int qrow0, loc0, nloc;
    if (ctxq) { qrow0 = RL + b * 256; loc0 = 0; nloc = 0; }
    else { qrow0 = b * 8192 + qb * 256;
        if (MODE == 0) { const int r0 = qb * 4; loc0 = clampi(r0 - 4, 0, 120); nloc = clampi(r0 - 1, 0, 120) + 8 - loc0; } else { loc0 = 0; nloc = 128; } }
    const int nt = nloc + 4;
    const bool nabias = (MODE == 0) && !ctxq;
    constexpr bool PIPE = (MODE == 1);
    const bool late = STAG && !PIPE && (w >= 4);
    const int rw = qb * 4 + (w >> 1), sw = clampi(rw - 4, 0, 120);
    const int jq = 32 * (w & 1) + l32, cst = clampi(jq - 8, 0, 48);
    if (nabias && tid < 465) ((LAS float*)(lds + BIAS_OFF))[tid] = p->na_rpb[(size_t)(l * 4 + h) * 465 + tid] * LOG2E;

    const size_t qrow = (size_t)qrow0 + 32 * w + l32;
    bf16x8 qf[NCOMP * NKS];
#pragma unroll
    for (int i = 0; i < NCOMP * NKS; ++i) {
        const u32x4 raw = *(const u32x4*)(Qp + qrow * ldq + 16 * i + 8 * g);
        u32x4 sc4; sc4.x = cvt_pk_bf16(bf_lo(raw.x) * cs, bf_hi(raw.x) * cs); sc4.y = cvt_pk_bf16(bf_lo(raw.y) * cs, bf_hi(raw.y) * cs);
        sc4.z = cvt_pk_bf16(bf_lo(raw.z) * cs, bf_hi(raw.z) * cs); sc4.w = cvt_pk_bf16(bf_lo(raw.w) * cs, bf_hi(raw.w) * cs);
        qf[i] = __builtin_bit_cast(bf16x8, sc4);
    }

    const int kr0 = tid / KCH, kc0 = tid % KCH, kr1 = (tid + 512) / KCH, kc1 = (tid + 512) % KCH, vr = tid >> 3, vc = tid & 7;
    const bool hask1 = (KCH == 12) && (tid < 256);
    u32x4 rk0, rk1 = (u32x4){0u, 0u, 0u, 0u}, rv;
#define TILE_ROW(t) ((t) < nloc ? (b * 8192 + 64 * (loc0 + (t))) : (RL + b * 256 + 64 * ((t) - nloc)))
#define LOAD_TILE(t) do { const size_t _tb = (size_t)TILE_ROW(t); rk0 = *(const u32x4*)(Kp + (_tb + kr0) * ldk + kc0 * 8); \
        if (hask1) rk1 = *(const u32x4*)(Kp + (_tb + kr1) * ldk + kc1 * 8); rv = *(const u32x4*)(Vp + (_tb + vr) * ldv + vc * 8); } while (0)
#define STORE_TILE(buf) do { LAS unsigned char* _kb = lds + (buf) * BUFSZ; *(LAS u32x4*)(_kb + kr0 * KSTR + kc0 * 16) = rk0; \
        if (hask1) *(LAS u32x4*)(_kb + kr1 * KSTR + kc1 * 16) = rk1; *(LAS u32x4*)(_kb + KBUF + vr * VSTR + vc * 16) = rv; } while (0)

    float mrun[NCOMP], lsum[NCOMP]; f32x16 O[NCOMP][2];
#pragma unroll
    for (int c = 0; c < NCOMP; ++c) { mrun[c] = -1e30f; lsum[c] = 0.f;
#pragma unroll
        for (int dt = 0; dt < 2; ++dt)
#pragma unroll
            for (int r = 0; r < 16; ++r) O[c][dt][r] = 0.f; }
    bf16x8 P[NCOMP][2][2];
#pragma unroll
    for (int c = 0; c < NCOMP; ++c)
#pragma unroll
        for (int kt = 0; kt < 2; ++kt)
#pragma unroll
            for (int s2 = 0; s2 < 2; ++s2) P[c][kt][s2] = (bf16x8){0, 0, 0, 0, 0, 0, 0, 0};

    LOAD_TILE(0); STORE_TILE(0); __syncthreads();
    const int koff = l32 * KSTR + g * 16;
    const int i16 = lane & 15, tq = i16 >> 2, tp = i16 & 3, blk = (lane >> 4) & 1;
    const int voff = (4 * g + tq) * VSTR + (16 * blk + 4 * tp) * 2;
#define PV_TILE(buf) do { LAS unsigned char* _vb = lds + (buf) * BUFSZ + KBUF + voff; \
        _Pragma("unroll") for (int kt = 0; kt < 2; ++kt) { bf16x8 vf[2][2]; \
            _Pragma("unroll") for (int s2 = 0; s2 < 2; ++s2) _Pragma("unroll") for (int dt = 0; dt < 2; ++dt) { LAS unsigned char* vp = _vb + (32 * kt + 16 * s2) * VSTR + dt * 64; \
                const s16x4 lo = __builtin_amdgcn_ds_read_tr16_b64_v4i16((LAS s16x4*)vp); const s16x4 hi = __builtin_amdgcn_ds_read_tr16_b64_v4i16((LAS s16x4*)(vp + 8 * VSTR)); \
                vf[s2][dt] = __builtin_shufflevector(lo, hi, 0, 1, 2, 3, 4, 5, 6, 7); } \
            __builtin_amdgcn_s_setprio(1); \
            _Pragma("unroll") for (int s2 = 0; s2 < 2; ++s2) _Pragma("unroll") for (int dt = 0; dt < 2; ++dt) _Pragma("unroll") for (int c = 0; c < NCOMP; ++c) O[c][dt] = MFMA32(vf[s2][dt], P[c][kt][s2], O[c][dt]); \
            __builtin_amdgcn_s_setprio(0); } } while (0)

#define PV_TILE_C(buf, cc) do { LAS unsigned char* _vb = lds + (buf) * BUFSZ + KBUF + voff; \
        _Pragma("unroll") for (int kt = 0; kt < 2; ++kt) { bf16x8 vf[2][2]; \
            _Pragma("unroll") for (int s2 = 0; s2 < 2; ++s2) _Pragma("unroll") for (int dt = 0; dt < 2; ++dt) { LAS unsigned char* vp = _vb + (32 * kt + 16 * s2) * VSTR + dt * 64; \
                const s16x4 lo = __builtin_amdgcn_ds_read_tr16_b64_v4i16((LAS s16x4*)vp); const s16x4 hi = __builtin_amdgcn_ds_read_tr16_b64_v4i16((LAS s16x4*)(vp + 8 * VSTR)); \
                vf[s2][dt] = __builtin_shufflevector(lo, hi, 0, 1, 2, 3, 4, 5, 6, 7); } \
            __builtin_amdgcn_s_setprio(1); \
            _Pragma("unroll") for (int s2 = 0; s2 < 2; ++s2) _Pragma("unroll") for (int dt = 0; dt < 2; ++dt) O[cc][dt] = MFMA32(vf[s2][dt], P[cc][kt][s2], O[cc][dt]); \
            __builtin_amdgcn_s_setprio(0); } } while (0)
    bf16x8 Pold[NCOMP][2][2];
#pragma unroll
    for (int c = 0; c < NCOMP; ++c)
#pragma unroll
        for (int kt = 0; kt < 2; ++kt)
#pragma unroll
            for (int s2 = 0; s2 < 2; ++s2) Pold[c][kt][s2] = (bf16x8){0, 0, 0, 0, 0, 0, 0, 0};
#define PV_TILE_OLD(buf) do { LAS unsigned char* _vb = lds + (buf) * BUFSZ + KBUF + voff; \
        _Pragma("unroll") for (int kt = 0; kt < 2; ++kt) { bf16x8 vf[2][2]; \
            _Pragma("unroll") for (int s2 = 0; s2 < 2; ++s2) _Pragma("unroll") for (int dt = 0; dt < 2; ++dt) { LAS unsigned char* vp = _vb + (32 * kt + 16 * s2) * VSTR + dt * 64; \
                const s16x4 lo = __builtin_amdgcn_ds_read_tr16_b64_v4i16((LAS s16x4*)vp); const s16x4 hi = __builtin_amdgcn_ds_read_tr16_b64_v4i16((LAS s16x4*)(vp + 8 * VSTR)); \
                vf[s2][dt] = __builtin_shufflevector(lo, hi, 0, 1, 2, 3, 4, 5, 6, 7); } \
            _Pragma("unroll") for (int s2 = 0; s2 < 2; ++s2) _Pragma("unroll") for (int dt = 0; dt < 2; ++dt) _Pragma("unroll") for (int c = 0; c < NCOMP; ++c) O[c][dt] = MFMA32(vf[s2][dt], Pold[c][kt][s2], O[c][dt]); } } while (0)
    bool pend = false, zref = false; int pbuf = 0, cbuf = 0;
    for (int t = 0; t < nt; ++t) {
        const bool more = (t + 1 < nt);
        if (more) LOAD_TILE(t + 1);
        bool active = true; int krow = 0;
        if (nabias && t < nloc) { krow = loc0 + t; active = (krow >= sw) && (krow < sw + 8); }
        bool slow = (MODE == 0) || (t == 0);
        if (active) {
          again:
            LAS unsigned char* Kb = lds + cbuf * BUFSZ + koff;
            f32x16 S[NCOMP][2];
#pragma unroll
            for (int c = 0; c < NCOMP; ++c)
#pragma unroll
                for (int kt = 0; kt < 2; ++kt) {
                    bf16x8 kf[NKS];
#pragma unroll
                    for (int ks = 0; ks < NKS; ++ks) kf[ks] = *(const LAS bf16x8*)(Kb + kt * 32 * KSTR + (c * NKS + ks) * 32);
#pragma unroll
                    for (int r = 0; r < 16; ++r) S[c][kt][r] = 0.f;
                    __builtin_amdgcn_s_setprio(1);
#pragma unroll
                    for (int ks = 0; ks < NKS; ++ks) S[c][kt] = MFMA32(kf[ks], qf[c * NKS + ks], S[c][kt]);
                    __builtin_amdgcn_s_setprio(0);
                }
            if (STAG && late && pend) { PV_TILE(pbuf); pend = false; }
            float mxc[NCOMP], mnw[NCOMP];
            if (!slow) {
#pragma unroll
                for (int c = 0; c < NCOMP; ++c) mnw[c] = mrun[c];
            } else {
#pragma unroll
            for (int c = 0; c < NCOMP; ++c) {
                float mx = -1e30f;
                if (nabias && t < nloc) {
                    const LAS float* bt = (const LAS float*)(lds + BIAS_OFF) + (krow - rw + 7) * 31;
#pragma unroll
                    for (int kt = 0; kt < 2; ++kt)
#pragma unroll
                        for (int r = 0; r < 16; ++r) { const int jk = 32 * kt + (r & 3) + 8 * (r >> 2) + 4 * g; const bool ok = (jk >= cst) && (jk < cst + 16);
                            const float bv = bt[clampi(jk - jq + 15, 0, 30)]; const float xv = ok ? (S[c][kt][r] + bv) : -1e30f; S[c][kt][r] = xv; mx = fmaxf(mx, xv); }
                } else {
#pragma unroll
                    for (int kt = 0; kt < 2; ++kt)
#pragma unroll
                        for (int r = 0; r < 16; r += 2) mx = fmaxf(fmaxf(mx, S[c][kt][r]), S[c][kt][r + 1]);
                }
                mxc[c] = mx;
            }
#pragma unroll
            for (int c = 0; c < NCOMP; ++c) mxc[c] = fmaxf(mxc[c], shflx(mxc[c], 32));
            bool grow = false;
#pragma unroll
            for (int c = 0; c < NCOMP; ++c) { mnw[c] = fmaxf(mrun[c], mxc[c]); grow = grow || (mnw[c] > mrun[c]); }
            if (MODE != 0) {
                bool big = false;
#pragma unroll
                for (int c = 0; c < NCOMP; ++c) big = big || !(fabsf(mnw[c]) < 40.0f);
                zref = (t == 0) && !__any(big);
                if (zref) {
#pragma unroll
                    for (int c = 0; c < NCOMP; ++c) mnw[c] = 0.0f; }
            }
            if (__any(grow)) {
#pragma unroll
                for (int c = 0; c < NCOMP; ++c) { const float alpha = fast_exp2(mrun[c] - mnw[c]); lsum[c] *= alpha;
#pragma unroll
                    for (int dt = 0; dt < 2; ++dt) O[c][dt] *= alpha;
                    mrun[c] = mnw[c]; }
            }
            }
            if (!zref) {
#pragma unroll
            for (int c = 0; c < NCOMP; ++c) { const f32x2 m2 = (f32x2){mnw[c], mnw[c]};
#pragma unroll
                for (int kt = 0; kt < 2; ++kt)
#pragma unroll
                    for (int r = 0; r < 16; r += 2) { const f32x2 d = (f32x2){S[c][kt][r], S[c][kt][r + 1]} - m2; S[c][kt][r] = d.x; S[c][kt][r + 1] = d.y; } }
            }
            if (PIPE) {
                LAS unsigned char* _vb = lds + pbuf * BUFSZ + KBUF + voff;
                f32x2 _rs[NCOMP]; u32x4 _pk[NCOMP][2][2];
#pragma unroll
                for (int c = 0; c < NCOMP; ++c) _rs[c] = (f32x2){0.f, 0.f};
                bf16x8 _vf[10];
#define VLOAD_(dst, v_) do { if ((v_) < 8) { LAS unsigned char* vp = _vb + (32 * ((v_) >> 2) + 16 * (((v_) >> 1) & 1)) * VSTR + ((v_) & 1) * 64; \
                    const s16x4 lo = __builtin_amdgcn_ds_read_tr16_b64_v4i16((LAS s16x4*)vp); const s16x4 hi = __builtin_amdgcn_ds_read_tr16_b64_v4i16((LAS s16x4*)(vp + 8 * VSTR)); \
                    dst = __builtin_shufflevector(lo, hi, 0, 1, 2, 3, 4, 5, 6, 7); } } while (0)
                VLOAD_(_vf[0], 0); VLOAD_(_vf[1], 1);
                __builtin_amdgcn_sched_barrier(0);
#pragma unroll
                for (int i = 0; i < 17; ++i) {
                    if (i < 16 && (i & 1) == 0) VLOAD_(_vf[(i >> 1) + 2], (i >> 1) + 2);
                    if (i < 16) { const int v = i >> 1, c = (NCOMP == 2) ? (i & 1) : 0, kt = v >> 2, s2 = (v >> 1) & 1, dt = v & 1; O[c][dt] = MFMA32(_vf[v], Pold[c][kt][s2], O[c][dt]); }
                    if (i < 16) {
#pragma unroll
                        for (int q2 = 0; q2 < 4; ++q2) { const int idx = 4 * i + q2, c = (idx >> 5) % NCOMP, kt = (idx >> 4) & 1, r = idx & 15; S[c][kt][r] = fast_exp2(S[c][kt][r]); } }
                    if (i >= 1) {
#pragma unroll
                        for (int q2 = 0; q2 < 2; ++q2) { const int j = 2 * (i - 1) + q2, c = (j >> 4) % NCOMP, kt = (j >> 3) & 1, s2 = (j >> 2) & 1, e = j & 3;
                            const f32x2 ev = (f32x2){S[c][kt][8 * s2 + 2 * e], S[c][kt][8 * s2 + 2 * e + 1]}; _rs[c] += ev; _pk[c][kt][s2][e] = cvt_pk_bf16(ev.x, ev.y); } }
                    __builtin_amdgcn_sched_barrier(0);
                }
#undef VLOAD_
#pragma unroll
                for (int c = 0; c < NCOMP; ++c) { mxc[c] = _rs[c].x + _rs[c].y;
#pragma unroll
                    for (int kt = 0; kt < 2; ++kt)
#pragma unroll
                        for (int s2 = 0; s2 < 2; ++s2) P[c][kt][s2] = __builtin_bit_cast(bf16x8, _pk[c][kt][s2]); }
            } else {
#pragma unroll
            for (int c = 0; c < NCOMP; ++c)
#pragma unroll
                for (int kt = 0; kt < 2; ++kt)
#pragma unroll
                    for (int r = 0; r < 16; ++r) S[c][kt][r] = fast_exp2(S[c][kt][r]);
#pragma unroll
            for (int c = 0; c < NCOMP; ++c) { f32x2 rs2 = (f32x2){0.f, 0.f};
#pragma unroll
                for (int kt = 0; kt < 2; ++kt)
#pragma unroll
                    for (int s2 = 0; s2 < 2; ++s2) { u32x4 pk;
#pragma unroll
                        for (int e = 0; e < 4; ++e) { const f32x2 ev = (f32x2){S[c][kt][8 * s2 + 2 * e], S[c][kt][8 * s2 + 2 * e + 1]}; rs2 += ev; pk[e] = cvt_pk_bf16(ev.x, ev.y); }
                        P[c][kt][s2] = __builtin_bit_cast(bf16x8, pk); }
                mxc[c] = rs2.x + rs2.y; }
            }
            if (!slow) { bool bad = false;
#pragma unroll
                for (int c = 0; c < NCOMP; ++c) bad = bad || !(mxc[c] < 1.0e18f);
                if (__any(bad)) { slow = true;
                    if (PIPE) {
#pragma unroll
                        for (int c = 0; c < NCOMP; ++c)
#pragma unroll
                            for (int kt = 0; kt < 2; ++kt)
#pragma unroll
                                for (int s2 = 0; s2 < 2; ++s2) Pold[c][kt][s2] = (bf16x8){0, 0, 0, 0, 0, 0, 0, 0}; }
                    goto again; } }
#pragma unroll
            for (int c = 0; c < NCOMP; ++c) lsum[c] += mxc[c];
            if (PIPE) {
#pragma unroll
                for (int c = 0; c < NCOMP; ++c)
#pragma unroll
                    for (int kt = 0; kt < 2; ++kt)
#pragma unroll
                        for (int s2 = 0; s2 < 2; ++s2) Pold[c][kt][s2] = P[c][kt][s2];
                pbuf = cbuf;
            } else {
            if (!(STAG && late)) PV_TILE(cbuf);
            if (STAG && late) { pend = true; pbuf = cbuf; }
            }
        }
        const int nbuf = (cbuf == 2) ? 0 : cbuf + 1;
        if (more) STORE_TILE(nbuf);
        __syncthreads();
        cbuf = nbuf;
    }
    if (STAG && late && pend) PV_TILE(pbuf);
    if (PIPE) PV_TILE_OLD(pbuf);
#undef PV_TILE_OLD
#undef PV_TILE
#undef PV_TILE_C
#undef TILE_ROW
#undef LOAD_TILE
#undef STORE_TILE
    float inv[NCOMP];
#pragma unroll
    for (int c = 0; c < NCOMP; ++c) { const float lt = lsum[c] + shflx(lsum[c], 32); inv[c] = 1.0f / lt; }
    bf16_t* op = (bf16_t*)(ws + OFF_A) + qrow * 1024 + outoff;
    if (MODE == 1) {
        const float li1 = lam * inv[NCOMP - 1]; float ss = 0.f;
#pragma unroll
        for (int dt = 0; dt < 2; ++dt)
#pragma unroll
            for (int r = 0; r < 16; ++r) { const float o = O[0][dt][r] * inv[0] - li1 * O[NCOMP - 1][dt][r]; O[0][dt][r] = o; ss += o * o; }
        ss += shflx(ss, 32);
        const float rstd = rsqrtf(ss * (1.0f / 64.0f) + NEPS) * (1.0f - lam_init);
        const float* sg = p->diff_subln_g + l * 64;
#pragma unroll
        for (int dt = 0; dt < 2; ++dt)
#pragma unroll
            for (int rq = 0; rq < 4; ++rq) { const int dv = 32 * dt + 8 * rq + 4 * g; const f32x4 gg = *(const f32x4*)(sg + dv);
                u32x2 wv; wv.x = cvt_pk_bf16(O[0][dt][4 * rq] * rstd * gg[0], O[0][dt][4 * rq + 1] * rstd * gg[1]); wv.y = cvt_pk_bf16(O[0][dt][4 * rq + 2] * rstd * gg[2], O[0][dt][4 * rq + 3] * rstd * gg[3]);
                *(u32x2*)(op + dv) = wv; }
    } else {
#pragma unroll
        for (int dt = 0; dt < 2; ++dt)
#pragma unroll
            for (int rq = 0; rq < 4; ++rq) { const int dv = 32 * dt + 8 * rq + 4 * g;
                u32x2 wv; wv.x = cvt_pk_bf16(O[0][dt][4 * rq] * inv[0], O[0][dt][4 * rq + 1] * inv[0]); wv.y = cvt_pk_bf16(O[0][dt][4 * rq + 2] * inv[0], O[0][dt][4 * rq + 3] * inv[0]);
                *(u32x2*)(op + dv) = wv; }
    }
    __syncthreads();
}

__device__ __forceinline__ void attn_item_mla2(PK p, int l, LAS unsigned char* lds, int b, int h, int qb, bool ctxq) {
    constexpr int NKS = 6, KCH = 12, KSTR = 208, VSTR = 192, KBUF = 64 * KSTR, VBUF = 64 * VSTR, BUFSZ = KBUF + VBUF;
    const int tid = opaque_tid(), w = tid >> 6, lane = tid & 63, g = lane >> 5, l32 = lane & 31;
    unsigned char* ws = p->ws;
    const bf16_t* Qp = (const bf16_t*)(ws + OFF_D) + 96 * h; const bf16_t* Kp = (const bf16_t*)(ws + OFF_MK) + 96 * h; const bf16_t* Vp = (const bf16_t*)(ws + OFF_MV) + 64 * h;
    constexpr int ldq = 384, ldk = 384, ldv = 256; const int outoff = 768 + 64 * h;
    const float cs = 0.10206207261596575f * LOG2E;
    const int qrow0 = ctxq ? RL + b * 256 : b * 8192 + qb * 256, nloc = ctxq ? 0 : 128, nt = nloc + 4;
    const size_t qrow = (size_t)qrow0 + 32 * w + l32;
    bf16x8 qf[NKS];
#pragma unroll
    for (int i = 0; i < NKS; ++i) {
        const u32x4 raw = *(const u32x4*)(Qp + qrow * ldq + 16 * i + 8 * g);
        u32x4 sc4; sc4.x = cvt_pk_bf16(bf_lo(raw.x) * cs, bf_hi(raw.x) * cs); sc4.y = cvt_pk_bf16(bf_lo(raw.y) * cs, bf_hi(raw.y) * cs);
        sc4.z = cvt_pk_bf16(bf_lo(raw.z) * cs, bf_hi(raw.z) * cs); sc4.w = cvt_pk_bf16(bf_lo(raw.w) * cs, bf_hi(raw.w) * cs);
        qf[i] = __builtin_bit_cast(bf16x8, sc4);
    }
    const int kr0 = tid / KCH, kc0 = tid % KCH, kr1 = (tid + 512) / KCH, kc1 = (tid + 512) % KCH, vr = tid >> 3, vc = tid & 7;
    const bool hask1 = tid < 256;
    u32x4 rk0, rk1 = (u32x4){0u, 0u, 0u, 0u}, rv;
#define M2_ROW(t) ((t) < nloc ? (b * 8192 + 64 * (t)) : (RL + b * 256 + 64 * ((t) - nloc)))
#define M2_LOAD(t) do { const size_t _tb = (size_t)M2_ROW(t); rk0 = *(const u32x4*)(Kp + (_tb + kr0) * ldk + kc0 * 8); \
        if (hask1) rk1 = *(const u32x4*)(Kp + (_tb + kr1) * ldk + kc1 * 8); rv = *(const u32x4*)(Vp + (_tb + vr) * ldv + vc * 8); } while (0)
#define M2_STORE(buf) do { LAS unsigned char* _kb = lds + (buf) * BUFSZ; *(LAS u32x4*)(_kb + kr0 * KSTR + kc0 * 16) = rk0; \
        if (hask1) *(LAS u32x4*)(_kb + kr1 * KSTR + kc1 * 16) = rk1; *(LAS u32x4*)(_kb + KBUF + vr * VSTR + vc * 16) = rv; } while (0)
    const int koff = l32 * KSTR + g * 16;
    const int i16 = lane & 15, tq = i16 >> 2, tp = i16 & 3, blk = (lane >> 4) & 1;
    const int voff = (4 * g + tq) * VSTR + (16 * blk + 4 * tp) * 2;
#define M2_QK(SX, buf) do { LAS unsigned char* _kb = lds + (buf) * BUFSZ + koff; \
        _Pragma("unroll") for (int kt = 0; kt < 2; ++kt) { bf16x8 kf[NKS]; \
            _Pragma("unroll") for (int ks = 0; ks < NKS; ++ks) kf[ks] = *(const LAS bf16x8*)(_kb + kt * 32 * KSTR + ks * 32); \
            _Pragma("unroll") for (int r = 0; r < 16; ++r) SX[kt][r] = 0.f; \
            _Pragma("unroll") for (int ks = 0; ks < NKS; ++ks) SX[kt] = MFMA32(kf[ks], qf[ks], SX[kt]); } } while (0)
#define M2_PVOLD(buf) do { LAS unsigned char* _vb = lds + (buf) * BUFSZ + KBUF + voff; \
        _Pragma("unroll") for (int kt = 0; kt < 2; ++kt) { bf16x8 vf[2][2]; \
            _Pragma("unroll") for (int s2 = 0; s2 < 2; ++s2) _Pragma("unroll") for (int dt = 0; dt < 2; ++dt) { LAS unsigned char* vp = _vb + (32 * kt + 16 * s2) * VSTR + dt * 64; \
                const s16x4 lo = __builtin_amdgcn_ds_read_tr16_b64_v4i16((LAS s16x4*)vp); const s16x4 hi = __builtin_amdgcn_ds_read_tr16_b64_v4i16((LAS s16x4*)(vp + 8 * VSTR)); \
                vf[s2][dt] = __builtin_shufflevector(lo, hi, 0, 1, 2, 3, 4, 5, 6, 7); } \
            _Pragma("unroll") for (int s2 = 0; s2 < 2; ++s2) _Pragma("unroll") for (int dt = 0; dt < 2; ++dt) O[dt] = MFMA32(vf[s2][dt], Pold[kt][s2], O[dt]); } } while (0)
#define M2_EXP(SX, PX, RS) do { _Pragma("unroll") for (int kt = 0; kt < 2; ++kt) _Pragma("unroll") for (int r = 0; r < 16; ++r) SX[kt][r] = fast_exp2(SX[kt][r]); \
        f32x2 _rs2 = (f32x2){0.f, 0.f}; \
        _Pragma("unroll") for (int kt = 0; kt < 2; ++kt) _Pragma("unroll") for (int s2 = 0; s2 < 2; ++s2) { u32x4 pk; \
            _Pragma("unroll") for (int e = 0; e < 4; ++e) { const f32x2 ev = (f32x2){SX[kt][8 * s2 + 2 * e], SX[kt][8 * s2 + 2 * e + 1]}; _rs2 += ev; pk[e] = cvt_pk_bf16(ev.x, ev.y); } \
            PX[kt][s2] = __builtin_bit_cast(bf16x8, pk); } \
        RS = _rs2.x + _rs2.y; } while (0)
#define M2_SUB(SX, mref) do { const f32x2 _m2 = (f32x2){mref, mref}; \
        _Pragma("unroll") for (int kt = 0; kt < 2; ++kt) _Pragma("unroll") for (int r = 0; r < 16; r += 2) { const f32x2 d = (f32x2){SX[kt][r], SX[kt][r + 1]} - _m2; SX[kt][r] = d.x; SX[kt][r + 1] = d.y; } } while (0)
#define M2_MAX(SX, MX) do { float _mx = -1e30f; _Pragma("unroll") for (int kt = 0; kt < 2; ++kt) _Pragma("unroll") for (int r = 0; r < 16; r += 2) _mx = fmaxf(fmaxf(_mx, SX[kt][r]), SX[kt][r + 1]); \
        MX = fmaxf(_mx, shflx(_mx, 32)); } while (0)
#define M2_OPLOAD(dst, idx) do { if ((idx) < 12) { const int kt_ = (idx) / 6, ks_ = (idx) % 6; dst = *(const LAS bf16x8*)(_kb + kt_ * 32 * KSTR + ks_ * 32); } \
        else if ((idx) < 20) { const int j_ = (idx) - 12, kt_ = j_ >> 2, s2_ = (j_ >> 1) & 1, dt_ = j_ & 1; LAS unsigned char* vp = _vb + (32 * kt_ + 16 * s2_) * VSTR + dt_ * 64; \
            const s16x4 lo = __builtin_amdgcn_ds_read_tr16_b64_v4i16((LAS s16x4*)vp); const s16x4 hi = __builtin_amdgcn_ds_read_tr16_b64_v4i16((LAS s16x4*)(vp + 8 * VSTR)); \
            dst = __builtin_shufflevector(lo, hi, 0, 1, 2, 3, 4, 5, 6, 7); } } while (0)
#define M2_FUSED(SC, SN, bufK, bufV, PX, RS) do { \
        LAS unsigned char* _kb = lds + (bufK) * BUFSZ + koff; LAS unsigned char* _vb = lds + (bufV) * BUFSZ + KBUF + voff; \
        f32x16 _z; _Pragma("unroll") for (int r = 0; r < 16; ++r) _z[r] = 0.f; \
        f32x2 _rs2 = (f32x2){0.f, 0.f}; u32x4 _pk[2][2]; \
        bf16x8 _op[23]; M2_OPLOAD(_op[0], 0); M2_OPLOAD(_op[1], 1); M2_OPLOAD(_op[2], 2); \
        __builtin_amdgcn_sched_barrier(0); \
        _Pragma("unroll") for (int i = 0; i < 20; ++i) { \
            M2_OPLOAD(_op[i + 3], i + 3);                       \
            if (i < 12) { const int kt = i / 6, ks = i % 6; SN[kt] = MFMA32(_op[i], qf[ks], ks == 0 ? _z : SN[kt]); } \
            else { const int j = i - 12, kt = j >> 2, s2 = (j >> 1) & 1, dt = j & 1; O[dt] = MFMA32(_op[i], Pold[kt][s2], O[dt]); } \
            if (i < 16) { const int e0 = 2 * i, e1 = 2 * i + 1; SC[e0 >> 4][e0 & 15] = fast_exp2(SC[e0 >> 4][e0 & 15]); SC[e1 >> 4][e1 & 15] = fast_exp2(SC[e1 >> 4][e1 & 15]); } \
            if (i >= 2 && i < 18) { const int j = i - 2, e0 = 2 * j; const f32x2 ev = (f32x2){SC[e0 >> 4][e0 & 15], SC[e0 >> 4][(e0 & 15) + 1]}; _rs2 += ev; \
                _pk[j >> 3][(j >> 2) & 1][j & 3] = cvt_pk_bf16(ev.x, ev.y); } \
            __builtin_amdgcn_sched_barrier(0); } \
        _Pragma("unroll") for (int kt = 0; kt < 2; ++kt) _Pragma("unroll") for (int s2 = 0; s2 < 2; ++s2) PX[kt][s2] = __builtin_bit_cast(bf16x8, _pk[kt][s2]); \
        RS = _rs2.x + _rs2.y; } while (0)
    float lsum = 0.f, mrun; f32x16 O[2];
#pragma unroll
    for (int dt = 0; dt < 2; ++dt)
#pragma unroll
        for (int r = 0; r < 16; ++r) O[dt][r] = 0.f;
    bf16x8 Pold[2][2];
#pragma unroll
    for (int kt = 0; kt < 2; ++kt)
#pragma unroll
        for (int s2 = 0; s2 < 2; ++s2) Pold[kt][s2] = (bf16x8){0, 0, 0, 0, 0, 0, 0, 0};
    f32x16 SA[2], SB[2];
    M2_LOAD(0); M2_STORE(0); M2_LOAD(1); M2_STORE(1); __syncthreads();
    M2_QK(SA, 0);
    bool zref;
    { float mx0; M2_MAX(SA, mx0); zref = !__any(!(fabsf(mx0) < 40.0f)); mrun = zref ? 0.0f : mx0; }
    int pbuf = 0;
#define M2_BODY(SC, SN, tt) do { const int _cb = (tt) & 3; \
        if ((tt) + 2 < nt) M2_LOAD((tt) + 2); \
        if (!zref) M2_SUB(SC, mrun); \
        bf16x8 Pn[2][2]; float rs; \
        M2_FUSED(SC, SN, ((tt) + 1) & 3, pbuf, Pn, rs); \
        if (__any(!(rs < 1.0e18f))) {        \
            M2_QK(SC, _cb); float mxr; M2_MAX(SC, mxr); const float mnew = fmaxf(mrun, mxr); const float alpha = fast_exp2(mrun - mnew); \
            lsum *= alpha; O[0] *= alpha; O[1] *= alpha; mrun = mnew; zref = false; M2_SUB(SC, mrun); M2_EXP(SC, Pn, rs); } \
        lsum += rs; \
        _Pragma("unroll") for (int kt = 0; kt < 2; ++kt) _Pragma("unroll") for (int s2 = 0; s2 < 2; ++s2) Pold[kt][s2] = Pn[kt][s2]; \
        pbuf = _cb; \
        if ((tt) + 2 < nt) M2_STORE(((tt) + 2) & 3); \
        __syncthreads(); } while (0)
    for (int t = 0; t < nt; t += 2) { M2_BODY(SA, SB, t); M2_BODY(SB, SA, t + 1); }
    M2_PVOLD(pbuf);
    const float lt = lsum + shflx(lsum, 32); const float inv = 1.0f / lt;
    bf16_t* op = (bf16_t*)(ws + OFF_A) + qrow * 1024 + outoff;
#pragma unroll
    for (int dt = 0; dt < 2; ++dt)
#pragma unroll
        for (int rq = 0; rq < 4; ++rq) { const int dv = 32 * dt + 8 * rq + 4 * g;
            u32x2 wv; wv.x = cvt_pk_bf16(O[dt][4 * rq] * inv, O[dt][4 * rq + 1] * inv); wv.y = cvt_pk_bf16(O[dt][4 * rq + 2] * inv, O[dt][4 * rq + 3] * inv);
            *(u32x2*)(op + dv) = wv; }
    __syncthreads();
#undef M2_ROW
#undef M2_LOAD
#undef M2_STORE
#undef M2_QK
#undef M2_PVOLD
#undef M2_EXP
#undef M2_SUB
#undef M2_MAX
#undef M2_BODY
#undef M2_FUSED
#undef M2_OPLOAD
}

__device__ void attn_phase(PK p, int l, LAS unsigned char* lds) {
    const float lam_init = (l == 0) ? 0.2f : 0.35550906759502f;
    const float* dl = p->diff_lambda + l * 128;
    float d01 = 0.f, d23 = 0.f;
    for (int i = 0; i < 32; ++i) { d01 += dl[i] * dl[32 + i]; d23 += dl[64 + i] * dl[96 + i]; }
    const float lam = expf(d01) - expf(d23) + lam_init;
    const int nItems = 1536 + (l == 0 ? 48 : 0);
    for (int it = opaque_bid(); it < nItems; it += opaque_gdim()) {
        if (it < 1536) {
            const int ty = it >> 9, idx = it & 511, bh = ((idx & 7) << 1) | (idx >> 8), b = bh >> 2, h = bh & 3, qb = (idx >> 3) & 31;
            if (ty == 0) attn_item<1>(p, l, lds, b, h, qb, false, lam, lam_init);
            else if (ty == 1) attn_item_mla2(p, l, lds, b, h, qb, false);
            else attn_item<0>(p, l, lds, b, h, qb, false, lam, lam_init);
        } else {
            const int idx = it - 1536, ty = idx >> 4, b = (idx >> 2) & 3, h = idx & 3;
            if (ty == 0) attn_item<1>(p, l, lds, b, h, 0, true, lam, lam_init);
            else if (ty == 1) attn_item_mla2(p, l, lds, b, h, 0, true);
            else attn_item<0>(p, l, lds, b, h, 0, true, lam, lam_init);
        }
    }
}

constexpr int PH_PER_LAYER = 14, N_PHASES = 2 * PH_PER_LAYER + 1;

__device__ __forceinline__ void run_phase(PK p, int ph, LAS unsigned char* lds, float rcoef) {
    unsigned char* ws = p->ws;
    pg8::StaticOrder S;
    if (ph == N_PHASES - 1) { final_norm_phase(p->out, p->final_norm_g); return; }
    int l = ph / PH_PER_LAYER; const int q = ph % PH_PER_LAYER;
#define OPQL asm volatile("" : "+s"(l))
#define HC ((float*)(ws + OFF_HC))
#define MOD ((const float*)(ws + OFF_MOD) + (size_t)l * 5 * 9216)
#define TN ((bf16_t*)(ws + OFF_A))
#define HID ((bf16_t*)(ws + OFF_B))
#define Mlate ((l == 0) ? RA : RL)
    switch (q) {
    case 0: OPQL; layer_prep_phase(p, l, lds); break;
    case 1: OPQL; if (l == 0) norm_mod_phase(p->x, p->ctx, p->out, HC, p->norm_g + (l * 3 + 0) * 1024, MOD, TN, RA, nullptr, 0);
            else norm_mod_phase(p->out, HC, nullptr, nullptr, p->norm_g + (l * 3 + 0) * 1024, MOD, TN, RA, (const float*)(ws + OFF_PB), 11); break;
    case 2: case 12: { OPQL; const int f = (q == 2) ? 0 : 1; const int M = (q == 2) ? RA : Mlate;
        pg8::Gemm g{TN, (const bf16_t*)(ws + OFF_W1) + (size_t)f * 5632 * 1024, M, 5632, 1024, 1024, 1024}; S.init(M, 5632, opaque_gdim(), opaque_bid());
        EpiSwiglu E{HID}; pg8::gemm_phase(lds, g, S, E); } break;
    case 4: OPQL; norm_mod_phase(p->out, HC, nullptr, nullptr, p->norm_g + (l * 3 + 1) * 1024, MOD + 3 * 1024, TN, RA, (const float*)(ws + OFF_PB), 11); break;
    case 5: { OPQL; pg8::Gemm g{TN, (const bf16_t*)(ws + OFF_WM), RA, 6400, 1024, 1024, 1024}; S.init(RA, 6400, opaque_gdim(), opaque_bid());
        EpiPJ E{(bf16_t*)(ws + OFF_B), ws + OFF_C}; pg8::gemm_phase(lds, g, S, E); } break;
    case 6: prep_phase(p); break;
    case 7: { OPQL; pg8::Gemm g{(const bf16_t*)(ws + OFF_B) + C_MQ, (const bf16_t*)(ws + OFF_WL), RA, 1024, 384, PJW, 384}; S.init(RA, 1024, opaque_gdim(), opaque_bid());
        EpiMLA E{(bf16_t*)(ws + OFF_D), (bf16_t*)(ws + OFF_MK), (bf16_t*)(ws + OFF_MV), (const float*)(ws + OFF_RSTD), (const float2*)(ws + OFF_ROPE)}; pg8::gemm_phase(lds, g, S, E); } break;
    case 8: OPQL; attn_phase(p, l, lds); break;
    case 9: { OPQL; pg8::Gemm g{(const bf16_t*)(ws + OFF_A), (const bf16_t*)(ws + OFF_WB), Mlate, 1024, 1024, 1024, 1024}; S.init(Mlate, 1024, opaque_gdim(), opaque_bid());
        EpiMerge E{ws + OFF_C, (bf16_t*)(ws + OFF_D)}; pg8::gemm_phase(lds, g, S, E); } break;
    case 3: case 13: case 10: { OPQL;
        const bool isout = (q == 10); const int f = (q == 13) ? 1 : 0;
        const bf16_t* A = isout ? (const bf16_t*)(ws + OFF_D) : (const bf16_t*)HID;
        const bf16_t* Bt = isout ? (const bf16_t*)(ws + OFF_WO) : (const bf16_t*)(ws + OFF_W2) + (size_t)f * 1024 * FH;
        const int K = isout ? 1024 : FH;
        const float* gate = MOD + (isout ? 5 : (q == 3 ? 2 : 8)) * 1024;
        const float coef = (isout ? 1.0f : 0.5f) * rcoef;
        const bool withctx = (q == 3) || (l == 0);
        { pg8::Gemm g{A, Bt, RL, 1024, K, K, K}; S.init(RL, 1024, opaque_gdim(), opaque_bid());
          EpiResid E{p->out, HC, gate, coef}; pg8::gemm_phase(lds, g, S, E); }
        if (withctx) {
            const int nsu = 16 * (K / 256);
            for (int su = opaque_bid(); su < nsu; su += opaque_gdim()) {
                const int ks = su >> 4, pmn = su & 15;
                pg8::SingleUnit SU; SU.pm = 128 + (pmn >> 2); SU.pn = pmn & 3; SU.has = true;
                pg8::Gemm g2{A + ks * 256, Bt + ks * 256, RA, 1024, 256, K, K};
                EpiPartial E2{(float*)(ws + OFF_PB) + (size_t)ks * 1024 * 1024, gate + 4 * 9216, coef}; pg8::gemm_phase(lds, g2, SU, E2);
            }
        }
    } break;
    case 11: OPQL; norm_mod_phase(p->out, HC, nullptr, nullptr, p->norm_g + (l * 3 + 2) * 1024, MOD + 6 * 1024, TN, Mlate, (const float*)(ws + OFF_PB), 4); break;
    }
#undef OPQL
#undef HC
#undef MOD
#undef TN
#undef HID
#undef Mlate
}

__global__ void __launch_bounds__(512, 2) fwd_megakernel(Params p) {
    extern __shared__ __attribute__((aligned(16))) unsigned char shm[];
    LAS unsigned char* lds = (LAS unsigned char*)shm;
#if N_LAUNCH_MODE == 1
    cg::grid_group grid = cg::this_grid();
    const int ph_lo = p.ph_lo, ph_hi = p.ph_hi;
    volatile LAS unsigned* st = (volatile LAS unsigned*)(lds + pg8::STAGE_BYTES);
    unsigned* bar = (unsigned*)(p.ws + OFF_BAR);
    if (opaque_tid() < 4) st[opaque_tid()] = 0u;
    if (opaque_bid() == 0) for (int i = opaque_tid(); i < XCD_BAR_WORDS; i += 512) bar[i] = 0u;
    __syncthreads();
#if PROBE_Q >= 0
    const int nseq = 2 * (PH_PER_LAYER + 1) + 1;
    for (int i = 0; i < nseq; ++i) {
        int ph;
        if (i == nseq - 1) ph = N_PHASES - 1;
        else { const int li = i / (PH_PER_LAYER + 1), r = i % (PH_PER_LAYER + 1); ph = li * PH_PER_LAYER + (r <= PROBE_Q ? r : r - 1); }
        PK pk = (PK)__builtin_amdgcn_kernarg_segment_ptr();
        asm volatile("" : "+s"(pk));
        run_phase(pk, ph, lds, 1.0f);
        if (i == 0) { grid.sync(); xcd_barrier_post(bar); }
        else if (i + 1 < nseq) xcd_barrier(bar, st);
    }
#else
    for (int ph = ph_lo; ph < ph_hi; ++ph) {
        PK pk = (PK)__builtin_amdgcn_kernarg_segment_ptr();
        asm volatile("" : "+s"(pk));
        run_phase(pk, ph, lds, 1.0f);
        if (ph == ph_lo) { grid.sync(); xcd_barrier_post(bar); }
        else if (ph + 1 < ph_hi) xcd_barrier(bar, st);
    }
#endif
#else
    const int ph_lo = p.ph_lo, ph_hi = p.ph_hi;
    for (int ph = ph_lo; ph < ph_hi; ++ph) { PK pk = (PK)__builtin_amdgcn_kernarg_segment_ptr(); asm volatile("" : "+s"(pk)); run_phase(pk, ph, lds, 1.0f); }
#endif
}

extern "C" void kernel_launch(void* const* d_in, const int* in_sizes, int n_in, void* d_out, int out_size, void* d_ws, size_t ws_size, hipStream_t stream) {
    constexpr int LDS_BYTES = pg8::STAGE_BYTES + 16;
    static int grid_blocks = 0;
    if (grid_blocks == 0) {
        if (n_in != 22 || ws_size < WS_END) { fprintf(stderr, "kernel_launch: unexpected inputs (n_in %d, ws %zu < %zu)\n", n_in, ws_size, (size_t)WS_END); grid_blocks = -1; return; }
        int dev = 0, cus = 0, per_cu = 0;
        hipGetDevice(&dev); hipDeviceGetAttribute(&cus, hipDeviceAttributeMultiprocessorCount, dev);
        if (hipFuncSetAttribute((const void*)fwd_megakernel, hipFuncAttributeMaxDynamicSharedMemorySize, LDS_BYTES) != hipSuccess) { fprintf(stderr, "hipFuncSetAttribute failed\n"); grid_blocks = -1; return; }
        if (hipOccupancyMaxActiveBlocksPerMultiprocessor(&per_cu, (const void*)fwd_megakernel, 512, LDS_BYTES) != hipSuccess || per_cu < 1) per_cu = 1;
        (void)hipGetLastError();
        grid_blocks = cus * 1;
    }
    if (grid_blocks < 0) return;
    Params hp{};
    const float** pp = (const float**)&hp;
    for (int i = 0; i < 22; ++i) pp[i] = (const float*)d_in[i];
    hp.out = (float*)d_out; hp.ws = (unsigned char*)d_ws;
#if N_LAUNCH_MODE == 1
    hp.ph_lo = 0; hp.ph_hi = N_PHASES;
    void* args[] = {&hp};
    hipError_t e = hipLaunchCooperativeKernel((const void*)fwd_megakernel, dim3(grid_blocks), dim3(512), args, LDS_BYTES, stream);
    if (e != hipSuccess) fprintf(stderr, "cooperative launch failed: %s (grid %d)\n", hipGetErrorString(e), grid_blocks);
#else
    for (int ph = 0; ph < N_PHASES; ++ph) { hp.ph_lo = ph; hp.ph_hi = ph + 1; hipLaunchKernelGGL(fwd_megakernel, dim3(grid_blocks), dim3(512), LDS_BYTES, stream, hp); }
#endif
}
```
